# Optimizing an MI355X kernel written in HIP

```python
import math
import jax, jax.numpy as jnp
from jax import lax
import numpy as np

D_MODEL = 1024
BATCH = 8
SEQ = 4096
DEPTH = 2

MEM_LEN = 256
N_A_LAYERS = (DEPTH + 1) // 2
N_B_LAYERS = DEPTH // 2

D_MIX_SEQ = 3 * D_MODEL // 4
D_MIX_MEM = D_MODEL // 4
MEM_HEADS = 4
MEM_HEAD_DIM = D_MIX_MEM // MEM_HEADS

S5_GROUP = 16
S5_GROUPS = D_MIX_SEQ // S5_GROUP
S5_STATE = 64
S5_DT_MIN = 1e-3
S5_DT_MAX = 1e-1

RWKV_HEAD = 64
RWKV_HEADS = D_MIX_SEQ // RWKV_HEAD
DECAY_LORA = 64
AAA_LORA = 64
GATE_LORA = 128
RWKV_SHIFT_COLS = 3 * D_MIX_SEQ + DECAY_LORA + AAA_LORA + GATE_LORA
RWKV_IN_COLS = RWKV_SHIFT_COLS + D_MIX_MEM
LN_X_EPS = 64e-5

D_FF_DENSE = ((8 * D_MODEL // 3 + 127) // 128) * 128
N_EXPERTS = 8
TOP_K = 2
D_FF_EXPERT = 7 * D_MODEL // 2
MOE_BLOCK = 256
RMS_EPS = 1e-6

kernel_name = "hybrid_s5_rwkv7_memxattn_moe"


def rmsnorm(x, g):
    xf = x.astype(jnp.float32)
    y = xf * lax.rsqrt(jnp.mean(xf * xf, axis=-1, keepdims=True) + RMS_EPS)
    return (y * g.astype(jnp.float32)).astype(x.dtype)


def s5_mixer(u, lam_re, lam_im, log_dt, b_re, b_im, c_re, c_im, d_skip, w_glu, b_glu):
    f32 = jnp.float32
    bsz, seq, _ = u.shape
    ug = u.reshape(bsz, seq, S5_GROUPS, S5_GROUP).astype(f32)
    dt = jnp.exp(log_dt.astype(f32))[:, None]
    lr = lam_re.astype(f32)
    li = lam_im.astype(f32)
    mag = jnp.exp(lr * dt)
    ang = li * dt
    ab_re = mag * jnp.cos(ang)
    ab_im = mag * jnp.sin(ang)
    n_re = ab_re - 1.0
    n_im = ab_im
    den = lr * lr + li * li
    z_re = (n_re * lr + n_im * li) / den
    z_im = (n_im * lr - n_re * li) / den
    br = b_re.astype(f32)
    bi = b_im.astype(f32)
    bb_re = z_re[..., None] * br - z_im[..., None] * bi
    bb_im = z_re[..., None] * bi + z_im[..., None] * br
    bu_re = jnp.einsum('bsgj,gpj->bsgp', ug, bb_re)
    bu_im = jnp.einsum('bsgj,gpj->bsgp', ug, bb_im)
    a_re = jnp.broadcast_to(ab_re, (1, seq) + ab_re.shape)
    a_im = jnp.broadcast_to(ab_im, (1, seq) + ab_im.shape)

    def combine(left, right):
        ar_l, ai_l, xr_l, xi_l = left
        ar_r, ai_r, xr_r, xi_r = right
        ar = ar_r * ar_l - ai_r * ai_l
        ai = ar_r * ai_l + ai_r * ar_l
        xr = ar_r * xr_l - ai_r * xi_l + xr_r
        xi = ar_r * xi_l + ai_r * xr_l + xi_r
        return ar, ai, xr, xi

    _, _, xr, xi = lax.associative_scan(combine, (a_re, a_im, bu_re, bu_im), axis=1)
    y = (jnp.einsum('bsgp,gjp->bsgj', xr, c_re.astype(f32))
         - jnp.einsum('bsgp,gjp->bsgj', xi, c_im.astype(f32))
         + d_skip.astype(f32) * ug)
    y = jax.nn.gelu(y)
    y = y * jax.nn.sigmoid(jnp.einsum('bsgj,gjk->bsgk', y, w_glu.astype(f32)) + b_glu.astype(f32))
    return y.reshape(bsz, seq, D_MIX_SEQ).astype(u.dtype)


def rwkv7_mixer(p, mu, w0, w2, a0, a2, g2, k_k, k_a, r_k, lnx_w, lnx_b):
    f32 = jnp.float32
    bsz, seq, _ = p.shape
    H, N, C = RWKV_HEADS, RWKV_HEAD, D_MIX_SEQ
    p_prev = jnp.pad(p, ((0, 0), (1, 0), (0, 0)))[:, :-1]
    p = p + (p_prev - p) * mu
    r, k, v, wd, ad, gd = jnp.split(
        p, [C, 2 * C, 3 * C, 3 * C + DECAY_LORA, 3 * C + DECAY_LORA + AAA_LORA], axis=-1)
    w_log = -jax.nn.softplus(-(w0 + jnp.tanh(wd) @ w2)) - 0.5
    decay = jnp.exp(-jnp.exp(w_log.astype(f32)))
    a = jax.nn.sigmoid(a0 + ad @ a2)
    g = jax.nn.sigmoid(gd) @ g2
    kk = (k * k_k).astype(f32).reshape(bsz, seq, H, N)
    kk = kk / jnp.maximum(jnp.sqrt(jnp.sum(kk * kk, axis=-1, keepdims=True)), 1e-12)
    k = k * (1 + (a - 1) * k_a)

    def heads(t):
        return t.astype(f32).reshape(bsz, seq, H, N)

    r_h, k_h, v_h, a_h, w_h = heads(r), heads(k), heads(v), heads(a), heads(decay)
    tm = lambda t: jnp.transpose(t, (1, 0, 2, 3))
    xs = (tm(r_h), tm(w_h), tm(k_h), tm(v_h), tm(-kk), tm(kk * a_h))

    def step(state, inp):
        r_t, w_t, k_t, v_t, a_t, b_t = inp
        sa = jnp.einsum('bhij,bhj->bhi', state, a_t)
        state = (state * w_t[:, :, None, :]
                 + sa[..., None] * b_t[:, :, None, :]
                 + v_t[..., None] * k_t[:, :, None, :])
        y_t = jnp.einsum('bhij,bhj->bhi', state, r_t)
        return state, y_t

    s0 = jnp.zeros((bsz, H, N, N), f32)
    _, y = lax.scan(step, s0, xs)
    y = tm(y)
    mean = jnp.mean(y, axis=-1, keepdims=True)
    var = jnp.mean(jnp.square(y - mean), axis=-1, keepdims=True)
    y = ((y - mean) * lax.rsqrt(var + LN_X_EPS)).reshape(bsz, seq, C)
    y = y * lnx_w.astype(f32) + lnx_b.astype(f32)
    bonus = jnp.sum(r_h * k_h * r_k.astype(f32), axis=-1, keepdims=True) * v_h
    y = (y + bonus.reshape(bsz, seq, C)) * g.astype(f32)
    return y.astype(p.dtype)


def memory_cross_attn(q, memn, w_kv):
    bsz, seq, _ = q.shape
    kv = memn @ w_kv
    k, v = jnp.split(kv, 2, axis=-1)
    qh = q.reshape(bsz, seq, MEM_HEADS, MEM_HEAD_DIM)
    kh = k.reshape(bsz, -1, MEM_HEADS, MEM_HEAD_DIM)
    vh = v.reshape(bsz, -1, MEM_HEADS, MEM_HEAD_DIM)
    s = jnp.einsum('bshd,bmhd->bhsm', qh, kh).astype(jnp.float32) * (MEM_HEAD_DIM ** -0.5)
    pr = jax.nn.softmax(s, axis=-1).astype(vh.dtype)
    o = jnp.einsum('bhsm,bmhd->bshd', pr, vh)
    return o.reshape(bsz, seq, D_MIX_MEM)


def swiglu(h, w_gate, w_up, w_down):
    return (jax.nn.silu(h @ w_gate) * (h @ w_up)) @ w_down


def moe_swiglu(h, w_router, b_router, w_gate, w_up, w_down):
    f32 = jnp.float32
    bsz, seq, d = h.shape
    hf = h.reshape(-1, d)
    n_tok = hf.shape[0]
    n_asg = n_tok * TOP_K
    logits = (hf @ w_router).astype(f32) + b_router.astype(f32)
    top_logit, top_idx = lax.top_k(logits, TOP_K)
    top_w = jax.nn.softmax(top_logit, axis=-1)
    e_flat = top_idx.reshape(-1).astype(jnp.int32)
    tok_flat = jnp.repeat(jnp.arange(n_tok, dtype=jnp.int32), TOP_K)
    w_flat = top_w.reshape(-1)
    order = jnp.argsort(e_flat)
    e_sorted = e_flat[order]
    tok_sorted = tok_flat[order]
    w_sorted = w_flat[order]
    counts = jnp.bincount(e_flat, length=N_EXPERTS).astype(jnp.int32)
    starts = jnp.cumsum(counts) - counts
    padded = ((counts + MOE_BLOCK - 1) // MOE_BLOCK) * MOE_BLOCK
    pad_ends = jnp.cumsum(padded)
    pad_starts = pad_ends - padded
    rank = jnp.arange(n_asg, dtype=jnp.int32) - starts[e_sorted]
    dest = pad_starts[e_sorted] + rank
    n_blocks = -(-n_asg // MOE_BLOCK) + N_EXPERTS
    n_rows = n_blocks * MOE_BLOCK
    row_tok = jnp.zeros((n_rows,), jnp.int32).at[dest].set(tok_sorted)
    row_w = jnp.zeros((n_rows,), f32).at[dest].set(w_sorted)
    block_start = jnp.arange(n_blocks, dtype=jnp.int32) * MOE_BLOCK
    block_expert = jnp.minimum(jnp.searchsorted(pad_ends, block_start, side='right'),
                               N_EXPERTS - 1).astype(jnp.int32)
    xb = hf[row_tok].reshape(n_blocks, MOE_BLOCK, d)

    def expert_block(args):
        xblk, e = args
        return swiglu(xblk, w_gate[e], w_up[e], w_down[e])

    yb = lax.map(expert_block, (xb, block_expert)).reshape(n_rows, d)
    yb = yb * row_w[:, None].astype(yb.dtype)
    out = jnp.zeros_like(hf).at[row_tok].add(yb)
    return out.reshape(bsz, seq, d)


def setup_inputs(seed: int = 0) -> dict:
    key = jax.random.key(seed)
    ks = iter(list(jax.random.split(key, 48)))
    f32 = jnp.float32

    def nrm(shape, scale):
        return jax.random.normal(next(ks), shape, f32) * scale

    def gain(shape):
        return 1.0 + nrm(shape, 0.02)

    def unif(shape, lo, hi):
        return jax.random.uniform(next(ks), shape, f32, lo, hi)

    D, G, P, J, C = D_MODEL, S5_GROUPS, S5_STATE, S5_GROUP, D_MIX_SEQ
    na, nb = N_A_LAYERS, N_B_LAYERS
    E, FE, FD = N_EXPERTS, D_FF_EXPERT, D_FF_DENSE
    inp = {}
    inp["x"] = nrm((BATCH, SEQ, D), 1.0)
    inp["mem"] = nrm((BATCH, MEM_LEN, D), 1.0)
    inp["norm_mix"] = gain((DEPTH, D))
    inp["norm_mem"] = gain((DEPTH, D))
    inp["w_kv_mem"] = nrm((DEPTH, D, 2 * D_MIX_MEM), D ** -0.5)
    inp["w_out"] = nrm((DEPTH, D_MIX_SEQ + D_MIX_MEM, D), (D_MIX_SEQ + D_MIX_MEM) ** -0.5)
    inp["norm_ffn"] = gain((DEPTH, D))
    inp["norm_final"] = gain((D,))
    inp["w_in_a"] = nrm((na, D, D_MIX_SEQ + D_MIX_MEM), D ** -0.5)
    inp["s5_lam_re"] = -0.5 + nrm((na, G, P), 0.01)
    inp["s5_lam_im"] = math.pi * jnp.arange(P, dtype=f32) + nrm((na, G, P), 0.01)
    inp["s5_log_dt"] = unif((na, G), math.log(S5_DT_MIN), math.log(S5_DT_MAX))
    inp["s5_b_re"] = nrm((na, G, P, J), (2 * J) ** -0.5)
    inp["s5_b_im"] = nrm((na, G, P, J), (2 * J) ** -0.5)
    inp["s5_c_re"] = nrm((na, G, J, P), P ** -0.5)
    inp["s5_c_im"] = nrm((na, G, J, P), P ** -0.5)
    inp["s5_d"] = nrm((na, G, J), 1.0)
    inp["s5_w_glu"] = nrm((na, G, J, J), J ** -0.5)
    inp["s5_b_glu"] = nrm((na, G, J), 0.01)
    inp["ffn_w_gate"] = nrm((na, D, FD), D ** -0.5)
    inp["ffn_w_up"] = nrm((na, D, FD), D ** -0.5)
    inp["ffn_w_down"] = nrm((na, FD, D), FD ** -0.5)
    inp["w_in_b"] = nrm((nb, D, RWKV_IN_COLS), D ** -0.5)
    inp["rw_mu"] = unif((nb, RWKV_SHIFT_COLS), 0.0, 1.0)
    inp["rw_w0"] = unif((nb, C), -6.0, 1.0)
    inp["rw_w2"] = nrm((nb, DECAY_LORA, C), 0.1 * DECAY_LORA ** -0.5)
    inp["rw_a0"] = nrm((nb, C), 0.1)
    inp["rw_a2"] = nrm((nb, AAA_LORA, C), AAA_LORA ** -0.5)
    inp["rw_g2"] = nrm((nb, GATE_LORA, C), GATE_LORA ** -0.5)
    inp["rw_k_k"] = 0.85 + nrm((nb, C), 0.02)
    inp["rw_k_a"] = 1.0 + nrm((nb, C), 0.02)
    inp["rw_r_k"] = nrm((nb, RWKV_HEADS, RWKV_HEAD), 0.1)
    inp["rw_lnx_w"] = gain((nb, C))
    inp["rw_lnx_b"] = nrm((nb, C), 0.01)
    inp["moe_w_router"] = nrm((nb, D, E), D ** -0.5)
    inp["moe_b_router"] = nrm((nb, E), 0.01)
    inp["moe_w_gate"] = nrm((nb, E, D, FE), D ** -0.5)
    inp["moe_w_up"] = nrm((nb, E, D, FE), D ** -0.5)
    inp["moe_w_down"] = nrm((nb, E, FE, D), FE ** -0.5)
    return inp


def reference(x, mem, norm_mix, norm_mem, w_kv_mem, w_out, norm_ffn, norm_final,
              w_in_a, s5_lam_re, s5_lam_im, s5_log_dt, s5_b_re, s5_b_im, s5_c_re, s5_c_im,
              s5_d, s5_w_glu, s5_b_glu, ffn_w_gate, ffn_w_up, ffn_w_down,
              w_in_b, rw_mu, rw_w0, rw_w2, rw_a0, rw_a2, rw_g2, rw_k_k, rw_k_a, rw_r_k,
              rw_lnx_w, rw_lnx_b, moe_w_router, moe_b_router, moe_w_gate, moe_w_up, moe_w_down):
    for i in range(DEPTH):
        j = i // 2
        h = rmsnorm(x, norm_mix[i])
        memn = rmsnorm(mem, norm_mem[i])
        if i % 2 == 0:
            p = h @ w_in_a[j]
            mix = s5_mixer(p[..., :D_MIX_SEQ], s5_lam_re[j], s5_lam_im[j], s5_log_dt[j],
                           s5_b_re[j], s5_b_im[j], s5_c_re[j], s5_c_im[j], s5_d[j],
                           s5_w_glu[j], s5_b_glu[j])
            q = p[..., D_MIX_SEQ:]
        else:
            p = h @ w_in_b[j]
            mix = rwkv7_mixer(p[..., :RWKV_SHIFT_COLS], rw_mu[j], rw_w0[j], rw_w2[j],
                              rw_a0[j], rw_a2[j], rw_g2[j], rw_k_k[j], rw_k_a[j],
                              rw_r_k[j], rw_lnx_w[j], rw_lnx_b[j])
            q = p[..., RWKV_SHIFT_COLS:]
        ca = memory_cross_attn(q, memn, w_kv_mem[i])
        x = x + jnp.concatenate([mix, ca], axis=-1) @ w_out[i]
        h2 = rmsnorm(x, norm_ffn[i])
        if i % 2 == 0:
            x = x + swiglu(h2, ffn_w_gate[j], ffn_w_up[j], ffn_w_down[j])
        else:
            x = x + moe_swiglu(h2, moe_w_router[j], moe_b_router[j],
                               moe_w_gate[j], moe_w_up[j], moe_w_down[j])
    return rmsnorm(x, norm_final)
```

```cpp
#include <hip/hip_runtime.h>
#include <cstdio>
#include <cstdint>

#define LAS __attribute__((address_space(3)))
#define GAS __attribute__((address_space(1)))
typedef unsigned short bf16_t;
typedef short bf16x8 __attribute__((ext_vector_type(8)));
typedef short bf16x4 __attribute__((ext_vector_type(4)));
typedef float f32x4 __attribute__((ext_vector_type(4)));
typedef float f32x2 __attribute__((ext_vector_type(2)));
typedef unsigned u32x4 __attribute__((ext_vector_type(4)));
typedef unsigned u32x2 __attribute__((ext_vector_type(2)));

constexpr int NB = 8, SEQ = 4096, T = NB * SEQ, D = 1024, MEML = 256, MROWS = NB * MEML;
constexpr int CS = 768, CM = 256, NH_MEM = 4;
constexpr int S5G = 48, S5J = 16, S5P = 64;
constexpr int RH = 12, RN = 64, SHIFTC = 2560, INB = 2816;
constexpr int FD = 2816, NE = 8, FE = 3584;
constexpr float RMS_EPS = 1e-6f, LNX_EPS = 64e-5f;
constexpr int NWAVES = 8, NTHR = 512;

enum { I_X = 0, I_MEM, I_NORM_MIX, I_NORM_MEM, I_WKV, I_WOUT, I_NORM_FFN, I_NORM_FINAL, I_WINA, I_LAM_RE, I_LAM_IM, I_LOG_DT, I_B_RE, I_B_IM, I_C_RE, I_C_IM,
       I_S5D, I_WGLU, I_BGLU, I_FGATE, I_FUP, I_FDOWN, I_WINB, I_MU, I_W0, I_W2, I_A0, I_A2, I_G2, I_KK, I_KA, I_RK, I_LNXW, I_LNXB, I_WR, I_BR, I_MGATE, I_MUP, I_MDOWN, N_IN };

constexpr size_t MiB = 1u << 20;
constexpr size_t WS_CTL = 0, CTL_BYTES = 2 * MiB;
constexpr size_t WS_HA = 2 * MiB;
constexpr size_t WS_ROUTE = 66 * MiB;
constexpr size_t WS_WSMALL = 70 * MiB;
constexpr size_t WS_WINA = WS_WSMALL, WS_WOUT0 = WS_WINA + 2 * MiB, WS_WOUT1 = WS_WOUT0 + 2 * MiB, WS_WKV = WS_WOUT1 + 2 * MiB  ,
                 WS_WGU0 = WS_WKV + 2 * MiB  , WS_WD0 = WS_WGU0 + 11 * MiB  , WS_WINB = WS_WD0 + 6 * MiB  ,
                 WS_MEMN = WS_WINB + 6 * MiB  , WS_KV = WS_MEMN + 8 * MiB  , WS_WSMALL_END = WS_KV + 4 * MiB;
static_assert(WS_WSMALL_END <= 128 * MiB, "small weights");
constexpr size_t WS_P0U = 128 * MiB;
constexpr size_t WS_P0Q = 176 * MiB;
constexpr size_t WS_CAT = 192 * MiB;
constexpr size_t WS_ACT0 = 256 * MiB;
constexpr size_t WS_P1 = 256 * MiB;
constexpr size_t WS_RA = 432 * MiB, WS_RKK = 480 * MiB, WS_RLD = 128 * MiB, WS_RG = 2 * MiB;
constexpr size_t WS_WMOE_GU = 70 * MiB;
constexpr size_t WS_WMOE_D = 182 * MiB;
constexpr size_t WS_MACT = 238 * MiB;
constexpr size_t WS_YSLOT = 350 * MiB;
constexpr size_t WS_END = 482 * MiB, WS_NEED = 528 * MiB;
constexpr int CW_BAR = 4096;
constexpr int CW_CNT = 8192;
constexpr size_t CTL_ROWSS = 1 * MiB;
constexpr size_t RT_LIST = 0, RT_LRSTD = 1 * MiB, RT_TOKE = 2 * MiB  , RT_TOKR = 2 * MiB + 256 * 1024, RT_TOKW = 2 * MiB + 512 * 1024;

constexpr int LDS_STAGE = 131072, LDS_MISC = LDS_STAGE, LDS_BYTES = 147456;

__device__ __forceinline__ unsigned cvt_pk_bf16(float lo, float hi) { unsigned r; asm volatile("v_cvt_pk_bf16_f32 %0, %1, %2" : "=v"(r) : "v"(lo), "v"(hi)); return r; }
__device__ __forceinline__ float bf2f(unsigned short b) { return __uint_as_float(((unsigned)b) << 16); }
__device__ __forceinline__ float bflo(unsigned w) { return __uint_as_float(w << 16); }
__device__ __forceinline__ float bfhi(unsigned w) { return __uint_as_float(w & 0xffff0000u); }
__device__ __forceinline__ bf16_t f2bf(float f) { return (bf16_t)(cvt_pk_bf16(f, 0.f) & 0xffffu); }
__device__ __forceinline__ float wave_sum(float v) {
#pragma unroll
    for (int o = 1; o < 64; o <<= 1) v += __shfl_xor(v, o);
    return v;
}
__device__ __forceinline__ float sigmoidf_(float x) { return 1.0f / (1.0f + __expf(-x)); }
__device__ __forceinline__ float silu_(float x) { return x / (1.0f + __expf(-x)); }
__device__ __forceinline__ float gelu_tanh_(float x) { const float a = 0.7978845608028654f * (x + 0.044715f * x * x * x); return 0.5f * x * (1.0f + tanhf(a)); }
#define LDS_WAIT() asm volatile("s_waitcnt lgkmcnt(0)" ::: "memory")
#define VM_WAIT() asm volatile("s_waitcnt vmcnt(0)" ::: "memory")

#define XB_TMO      128
#define XB_XCNT(j)  (256  + 64 * (j))
#define XB_XSUB(j)  (1280 + 64 * (j))
#define XB_XGEN(j)  (2304 + 64 * (j))
#define XB_TOP      3328
#define XB_TOPGEN   3392
#define XCD_BAR_WORDS 3456
#define XB_SPIN_CAP (1u << 18)
__device__ __forceinline__ unsigned xb_ld(unsigned* p)              { return __hip_atomic_load(p, __ATOMIC_RELAXED, __HIP_MEMORY_SCOPE_AGENT); }
__device__ __forceinline__ unsigned xb_add(unsigned* p, unsigned v) { return __hip_atomic_fetch_add(p, v, __ATOMIC_RELAXED, __HIP_MEMORY_SCOPE_AGENT); }
__device__ __forceinline__ unsigned xb_xcc_id() { return (unsigned)__builtin_amdgcn_s_getreg((3 << 11) | 20) & 0xFu; }
#define XB_SPIN(cond, bar) do { unsigned _sp = 0; while (cond) { __builtin_amdgcn_s_sleep(1); \
    if ((++_sp & 255u) == 0u) { if (xb_ld(&(bar)[XB_TMO])) break; if (_sp > XB_SPIN_CAP) { atomicAdd(&(bar)[XB_TMO], 1u); break; } } } } while (0)
struct XcdBarrier { unsigned* bar; unsigned x; volatile LAS unsigned* st; };
__device__ __forceinline__ XcdBarrier xcd_barrier_post(unsigned* bar, volatile LAS unsigned* st) {
    XcdBarrier b; b.bar = bar; b.x = xb_xcc_id(); b.st = st;
    if (threadIdx.x == 0) (void)xb_add(&bar[XB_XCNT(b.x)], 1u);
    return b;
}
__device__ __forceinline__ void xcd_barrier_complete(unsigned* bar, unsigned x, unsigned& nloc, unsigned& nx) {
    const unsigned G = gridDim.x * gridDim.y * gridDim.z;
    unsigned sum, cnt, mine, sp = 0u;
    for (;;) {
        sum = 0u; cnt = 0u; mine = 0u;
#pragma unroll
        for (unsigned j = 0; j < 16; ++j) { const unsigned c = xb_ld(&bar[XB_XCNT(j)]); sum += c; cnt += (c > 0u) ? 1u : 0u; mine = (j == x) ? c : mine; }
        if (sum == G) break;
        __builtin_amdgcn_s_sleep(1);
        if ((++sp & 255u) == 0u) { if (xb_ld(&bar[XB_TMO])) break; if (sp > XB_SPIN_CAP) { atomicAdd(&bar[XB_TMO], 1u); break; } }
    }
    nloc = mine > 0u ? mine : 1u; nx = cnt > 0u ? cnt : 1u;
}
__device__ __forceinline__ void xcd_barrier(const XcdBarrier& b) {
    asm volatile("s_waitcnt vmcnt(0)" ::: "memory");
    __syncthreads();
    if (threadIdx.x == 0) {
        unsigned* bar = b.bar;
        __builtin_amdgcn_s_waitcnt(0);
        unsigned nloc = b.st[0], nx = b.st[1];
        if (nloc == 0u) { xcd_barrier_complete(bar, b.x, nloc, nx); b.st[0] = nloc; b.st[1] = nx; }
        const unsigned old = xb_add(&bar[XB_XSUB(b.x)], 1u);
        const unsigned gen = old / nloc;
        if (old + 1u == (gen + 1u) * nloc) {
            __builtin_amdgcn_fence(__ATOMIC_RELEASE, "agent");
            asm volatile("s_waitcnt vmcnt(0)" ::: "memory");
            const unsigned og = xb_add(&bar[XB_TOP], 1u);
            const unsigned tg = og / nx;
            if (og + 1u == (tg + 1u) * nx) xb_add(&bar[XB_TOPGEN], 1u);
            else XB_SPIN(xb_ld(&bar[XB_TOPGEN]) == tg, bar);
            __builtin_amdgcn_fence(__ATOMIC_ACQUIRE, "agent");
            xb_add(&bar[XB_XGEN(b.x)], 1u);
            asm volatile("s_waitcnt vmcnt(0)" ::: "memory");
        } else {
            XB_SPIN(xb_ld(&bar[XB_XGEN(b.x)]) == gen, bar);
            __builtin_amdgcn_fence(__ATOMIC_ACQUIRE, "agent");
            asm volatile("s_waitcnt vmcnt(0)" ::: "memory");
        }
    }
    __syncthreads();
}

namespace pg8 {
constexpr int BM = 256, BK = 64, HALF = 128, HTB = HALF * BK * 2, STAGE_BYTES = 8 * HTB, NXCD = 8, WGM = 8;
__host__ __device__ __forceinline__ int lds_byte(int r, int c) { const int st = (r >> 4) * 2 + (c >> 5), rr = r & 15, cc = c & 31, ob = rr * 64 + cc * 2; return st * 1024 + (ob ^ (((ob >> 9) & 1) << 5)); }
__host__ __device__ __forceinline__ void stage_rc(int b, int& R, int& C) { const int st = b / 1024, sb = b % 1024, swz = sb ^ (((sb >> 9) & 1) << 5); R = (st >> 1) * 16 + swz / 64; C = (st & 1) * 32 + (swz % 64) / 2; }
__host__ __device__ __forceinline__ int perm32(int rho) { const int n = rho >> 4, i = rho & 15; return 8 * (i >> 2) + 4 * n + (i & 3); }

struct Unit { int pm, pn, e, rb; };

struct TileOrder {
    int nM, nN, nwg, G, c;
    __device__ void init(int nM_, int nN_, int G_, int c_) { nM = nM_; nN = nN_; nwg = nM * nN; G = G_; c = c_; }
    __device__ bool tile(int i, int& pm, int& pn) const {
        const long L = (long)i * G + c; if (L >= nwg) return false;
        int wgid = (int)L; { const int q = nwg / NXCD, r = nwg % NXCD, xcd = wgid % NXCD, off = wgid / NXCD; wgid = (xcd < r ? xcd * (q + 1) : r * (q + 1) + (xcd - r) * q) + off; }
        const int nig = WGM * nN, gid = wgid / nig, fm = gid * WGM, gsz = (nM - fm) < WGM ? (nM - fm) : WGM;
        pm = fm + ((wgid % nig) % gsz); pn = (wgid % nig) / gsz; return true;
    }
};
struct DenseSched {
    static constexpr bool GATHER = false;
    TileOrder o; const char* A; const char* Bt; int K;
    __device__ void init(const void* A_, const void* Bt_, int M, int N, int K_, int G, int c) { o.init(M / BM, N / BM, G, c); A = (const char*)A_; Bt = (const char*)Bt_; K = K_; }
    __device__ __forceinline__ bool next(int i, Unit& u) const { u.e = 0; u.rb = 0; return o.tile(i, u.pm, u.pn); }
    __device__ __forceinline__ const char* a_base(const Unit& u) const { return A + (size_t)u.pm * BM * K * 2; }
    __device__ __forceinline__ const char* b_base(const Unit& u) const { return Bt + (size_t)u.pn * BM * K * 2; }
    __device__ __forceinline__ void gather_ids(const Unit&, int, int, int (&)[4]) const {}
};

template <class Epi, class Sched, bool ALIGN_EPI>
__device__ __forceinline__ void gemm_phase(LAS unsigned char* lds, const int K, const Sched& S, const Epi& E) {
    const int tid = threadIdx.x, wid = __builtin_amdgcn_readfirstlane(tid >> 6), lane = tid & 63, wr = wid >> 2, wc = wid & 3, fr = lane & 15, fq = lane >> 4;
    const int nt = K / BK;
    unsigned voffA[2][2], voffB[2];
#pragma unroll
    for (int i = 0; i < 2; ++i) { int R, C; stage_rc(tid * 16 + i * 8192, R, C); const int Rb = (R & ~31) + perm32(R & 31);
        voffA[0][i] = (unsigned)(R * K + C) * 2u; voffA[1][i] = (unsigned)((R + HALF) * K + C) * 2u; voffB[i] = (unsigned)(Rb * K + C) * 2u; }
    const size_t kstep = (size_t)(BK * 2);
    const size_t hstep = (size_t)HALF * K * 2;
    const unsigned ldsw = (unsigned)wid * 1024u;
    const int aoff = lds_byte(wr * 64 + fr, fq * 8), boff = lds_byte(wc * 32 + fr, fq * 8);
#define PG8_SA(b, h) (((b) * 2 + (h)) * HTB)
#define PG8_SB(b, h) ((4 + (b) * 2 + (h)) * HTB)
#define PG8_STAGE(bufoff, gbase, voff) do { _Pragma("unroll") for (int _i = 0; _i < 2; ++_i) \
        __builtin_amdgcn_global_load_lds((const unsigned*)((const char*)(gbase) + (voff)[_i]), (LAS unsigned*)(lds + (bufoff) + ldsw + _i * 8192), 16, 0, 0); } while (0)
#define PG8_STAGE_A(bufoff, gbase, h) do { if constexpr (Sched::GATHER) { \
        __builtin_amdgcn_global_load_lds((const unsigned*)((const char*)(gbase) + ((voffA[h][0] & 0xffffu) * (unsigned)(K * 2) + (cpk & 0xffffu))), (LAS unsigned*)(lds + (bufoff) + ldsw), 16, 0, 0); \
        __builtin_amdgcn_global_load_lds((const unsigned*)((const char*)(gbase) + ((voffA[h][0] >> 16) * (unsigned)(K * 2) + (cpk >> 16))), (LAS unsigned*)(lds + (bufoff) + ldsw + 8192), 16, 0, 0); \
        } else { PG8_STAGE(bufoff, gbase, voffA[h]); } } while (0)
#define PG8_LDA(dst, b, h) do { _Pragma("unroll") for (int m = 0; m < 4; ++m) _Pragma("unroll") for (int k = 0; k < 2; ++k) dst[m][k] = *(const LAS bf16x8*)(lds + PG8_SA(b, h) + aoff + m * 2048 + k * 1024); } while (0)
#define PG8_LDB(dst, b, h) do { _Pragma("unroll") for (int n = 0; n < 2; ++n) _Pragma("unroll") for (int k = 0; k < 2; ++k) dst[n][k] = *(const LAS bf16x8*)(lds + PG8_SB(b, h) + boff + n * 2048 + k * 1024); } while (0)
#define PG8_MMA(ai, bj, At, Bt) do { __builtin_amdgcn_s_setprio(1); _Pragma("unroll") for (int m = 0; m < 4; ++m) _Pragma("unroll") for (int n = 0; n < 2; ++n) _Pragma("unroll") for (int k = 0; k < 2; ++k) \
        acc[ai][bj][m][n] = __builtin_amdgcn_mfma_f32_16x16x32_bf16(Bt[n][k], At[m][k], acc[ai][bj][m][n], 0, 0, 0); __builtin_amdgcn_s_setprio(0); } while (0)
#define PG8_WAIT_V(n) asm volatile("s_waitcnt vmcnt(" #n ")" ::: "memory")
#define PG8_WAIT_L(n) asm volatile("s_waitcnt lgkmcnt(" #n ")" ::: "memory")
#define PG8_BAR __builtin_amdgcn_s_barrier()
#define PG8_SCHED __builtin_amdgcn_sched_barrier(0)
    Unit cur, nxt; int ui = 0;
    if (!S.next(0, cur)) return;
    unsigned cpk = 0u;
    if constexpr (Sched::GATHER) { int ids[4]; int R0, C0, R1, C1; stage_rc(tid * 16, R0, C0); stage_rc(tid * 16 + 8192, R1, C1); S.gather_ids(cur, R0, R1, ids);
        cpk = (unsigned)(C0 * 2) | ((unsigned)(C1 * 2) << 16);
#pragma unroll
        for (int h = 0; h < 2; ++h) voffA[h][0] = (unsigned)ids[h * 2 + 0] | ((unsigned)ids[h * 2 + 1] << 16); }
    f32x4 acc[2][2][4][2];
#pragma unroll
    for (int a = 0; a < 2; ++a)
#pragma unroll
        for (int b = 0; b < 2; ++b)
#pragma unroll
            for (int m = 0; m < 4; ++m)
#pragma unroll
                for (int n = 0; n < 2; ++n) acc[a][b][m][n] = (f32x4){0.f, 0.f, 0.f, 0.f};
    bf16x8 At[4][2], B0[2][2], B1[2][2];
    const char* cA = S.a_base(cur); const char* cB = S.b_base(cur);
    PG8_STAGE(PG8_SB(0, 0), cB, voffB); PG8_STAGE(PG8_SB(0, 1), cB + hstep, voffB); PG8_STAGE_A(PG8_SA(0, 0), cA, 0); PG8_STAGE_A(PG8_SA(0, 1), cA, 1);
    if (wr == 1) PG8_BAR;
    PG8_WAIT_V(2); PG8_BAR;
    PG8_STAGE(PG8_SB(1, 0), cB + kstep, voffB); PG8_STAGE_A(PG8_SA(1, 0), cA + kstep, 0); PG8_STAGE(PG8_SB(1, 1), cB + hstep + kstep, voffB);
    PG8_WAIT_V(6); PG8_BAR;
    for (;;) {
        const bool has_next = S.next(ui + 1, nxt);
        const char* nA = has_next ? S.a_base(nxt) : cA; const char* nB = has_next ? S.b_base(nxt) : cB;
        unsigned voffN[2] = {0u, 0u};
        for (int t = 0; t < nt; t += 2) {
            const bool last = (t == nt - 2);
            const char* a1 = cA + (size_t)(t + 1) * kstep;
            const char* a2 = last ? nA : cA + (size_t)(t + 2) * kstep; const char* b2 = last ? nB : cB + (size_t)(t + 2) * kstep;
            const char* a3 = a2 + kstep; const char* b3 = b2 + kstep;
            if constexpr (Sched::GATHER) { if (t == nt - 4 && has_next) { int ids[4]; int R0, C0, R1, C1; stage_rc(tid * 16, R0, C0); stage_rc(tid * 16 + 8192, R1, C1); S.gather_ids(nxt, R0, R1, ids);
#pragma unroll
                for (int h = 0; h < 2; ++h) voffN[h] = (unsigned)ids[h * 2 + 0] | ((unsigned)ids[h * 2 + 1] << 16); } }
            PG8_LDB(B0, 0, 0); PG8_LDB(B1, 0, 1); PG8_SCHED; PG8_LDA(At, 0, 0); PG8_STAGE_A(PG8_SA(1, 1), a1, 1);
            if constexpr (Sched::GATHER) { if (last && has_next) { voffA[0][0] = voffN[0]; voffA[1][0] = voffN[1]; } }
            PG8_WAIT_V(8); PG8_WAIT_L(0); PG8_BAR; PG8_MMA(0, 0, At, B0); PG8_MMA(0, 1, At, B1); PG8_BAR; PG8_SCHED;
            PG8_LDA(At, 0, 1); PG8_STAGE(PG8_SB(0, 0), b2, voffB); PG8_STAGE(PG8_SB(0, 1), b2 + hstep, voffB); PG8_STAGE_A(PG8_SA(0, 0), a2, 0);
            PG8_WAIT_V(8); PG8_WAIT_L(0); PG8_BAR; PG8_MMA(1, 0, At, B0); PG8_MMA(1, 1, At, B1); PG8_BAR; PG8_SCHED;
            PG8_LDB(B0, 1, 0); PG8_LDB(B1, 1, 1); PG8_SCHED; PG8_LDA(At, 1, 0); PG8_STAGE_A(PG8_SA(0, 1), a2, 1);
            PG8_WAIT_V(8); PG8_WAIT_L(0); PG8_BAR; PG8_MMA(0, 0, At, B0); PG8_MMA(0, 1, At, B1); PG8_BAR; PG8_SCHED;
            PG8_LDA(At, 1, 1); PG8_STAGE(PG8_SB(1, 0), b3, voffB); PG8_STAGE(PG8_SB(1, 1), b3 + hstep, voffB); PG8_STAGE_A(PG8_SA(1, 0), a3, 0);
            PG8_WAIT_V(8); PG8_WAIT_L(0); PG8_BAR; PG8_MMA(1, 0, At, B0); PG8_MMA(1, 1, At, B1); PG8_BAR; PG8_SCHED;
        }
        if constexpr (ALIGN_EPI) { if (wr == 0) PG8_BAR; }
        E(acc, cur, wr, wc, fr, fq);
        if (!has_next) break;
#pragma unroll
        for (int a = 0; a < 2; ++a)
#pragma unroll
            for (int b = 0; b < 2; ++b)
#pragma unroll
                for (int m = 0; m < 4; ++m)
#pragma unroll
                    for (int n = 0; n < 2; ++n) acc[a][b][m][n] = (f32x4){0.f, 0.f, 0.f, 0.f};
        cur = nxt; cA = nA; cB = nB; ++ui;
        if constexpr (ALIGN_EPI) { if (wr == 1) PG8_BAR; }
    }
    PG8_WAIT_V(0);
    if constexpr (!ALIGN_EPI) { if (wr == 0) PG8_BAR; }
    PG8_BAR;
#undef PG8_SA
#undef PG8_SB
#undef PG8_STAGE
#undef PG8_STAGE_A
#undef PG8_LDA
#undef PG8_LDB
#undef PG8_MMA
#undef PG8_WAIT_V
#undef PG8_WAIT_L
#undef PG8_BAR
#undef PG8_SCHED
}
}
using pg8::Unit;

__device__ __forceinline__ float rstd_of(float ss) { return 1.0f / sqrtf(ss * (1.0f / D) + RMS_EPS); }
typedef unsigned long long rss_t;
__device__ __forceinline__ float rstd_fx(rss_t s) { return rstd_of((float)((double)s * (1.0 / 16777216.0))); }
__device__ __forceinline__ rss_t rss_fx(float ss) { return (rss_t)__float2ull_rn(ss * 16777216.0f); }

struct EpiInA {
    bf16_t* U; bf16_t* Q; const rss_t* rowss;
    __device__ __forceinline__ void operator()(const f32x4 (&acc)[2][2][4][2], const Unit& u, int wr, int wc, int fr, int fq) const {
        const int row0 = u.pm * 256 + wr * 64 + fr, col0 = u.pn * 256 + wc * 32 + 8 * fq;
#pragma unroll
        for (int ai = 0; ai < 2; ++ai)
#pragma unroll
            for (int m = 0; m < 4; ++m) { const int row = row0 + ai * 128 + m * 16; const float rs = rstd_fx(rowss[row]);
#pragma unroll
                for (int bj = 0; bj < 2; ++bj) { const int c = col0 + bj * 128; const f32x4 v0 = acc[ai][bj][m][0] * rs, v1 = acc[ai][bj][m][1] * rs;
                    u32x4 w; w.x = cvt_pk_bf16(v0[0], v0[1]); w.y = cvt_pk_bf16(v0[2], v0[3]); w.z = cvt_pk_bf16(v1[0], v1[1]); w.w = cvt_pk_bf16(v1[2], v1[3]);
                    if (c < CS) { const int g = c >> 4, hf = (c >> 3) & 1, b = row >> 12, t = row & 4095; *(u32x4*)(U + (((size_t)(b * S5G + g) * SEQ + t) * 16 + 8 * hf)) = w; }
                    else *(u32x4*)(Q + (size_t)row * CM + (c - CS)) = w; } }
    }
};
struct EpiBf16 {
    bf16_t* O; int ldc; const rss_t* rowss; bf16_t* Q; int qcol0;
    __device__ __forceinline__ void operator()(const f32x4 (&acc)[2][2][4][2], const Unit& u, int wr, int wc, int fr, int fq) const {
        const int row0 = u.pm * 256 + wr * 64 + fr, col0 = u.pn * 256 + wc * 32 + 8 * fq;
#pragma unroll
        for (int ai = 0; ai < 2; ++ai)
#pragma unroll
            for (int m = 0; m < 4; ++m) { const int row = row0 + ai * 128 + m * 16; const float rs = rowss ? rstd_fx(rowss[row]) : 1.0f;
#pragma unroll
                for (int bj = 0; bj < 2; ++bj) { const int c = col0 + bj * 128; const f32x4 v0 = acc[ai][bj][m][0] * rs, v1 = acc[ai][bj][m][1] * rs;
                    u32x4 w; w.x = cvt_pk_bf16(v0[0], v0[1]); w.y = cvt_pk_bf16(v0[2], v0[3]); w.z = cvt_pk_bf16(v1[0], v1[1]); w.w = cvt_pk_bf16(v1[2], v1[3]);
                    if (Q && c >= qcol0) *(u32x4*)(Q + (size_t)row * CM + (c - qcol0)) = w;
                    else *(u32x4*)(O + (size_t)row * ldc + c) = w; } }
    }
};
struct EpiRes {
    const float* Xin; float* Xout; bf16_t* H; rss_t* rowss;
    __device__ __forceinline__ void operator()(const f32x4 (&acc)[2][2][4][2], const Unit& u, int wr, int wc, int fr, int fq) const {
        const int row0 = u.pm * 256 + wr * 64 + fr, col0 = u.pn * 256 + wc * 32 + 8 * fq;
#pragma unroll
        for (int ai = 0; ai < 2; ++ai)
#pragma unroll
            for (int m = 0; m < 4; ++m) { const int row = row0 + ai * 128 + m * 16; float ss = 0.f;
#pragma unroll
                for (int bj = 0; bj < 2; ++bj) { const size_t o = (size_t)row * D + col0 + bj * 128;
                    const f32x4 x0 = *(const f32x4*)(Xin + o), x1 = *(const f32x4*)(Xin + o + 4);
                    const f32x4 v0 = acc[ai][bj][m][0] + x0, v1 = acc[ai][bj][m][1] + x1;
                    *(f32x4*)(Xout + o) = v0; *(f32x4*)(Xout + o + 4) = v1;
                    u32x4 w; w.x = cvt_pk_bf16(v0[0], v0[1]); w.y = cvt_pk_bf16(v0[2], v0[3]); w.z = cvt_pk_bf16(v1[0], v1[1]); w.w = cvt_pk_bf16(v1[2], v1[3]);
                    *(u32x4*)(H + o) = w;
                    ss += (v0[0] * v0[0] + v0[1] * v0[1]) + (v0[2] * v0[2] + v0[3] * v0[3]) + (v1[0] * v1[0] + v1[1] * v1[1]) + (v1[2] * v1[2] + v1[3] * v1[3]); }
                ss += __shfl_xor(ss, 16); ss += __shfl_xor(ss, 32);
                if (fq == 0) atomicAdd(rowss + row, rss_fx(ss));
                asm volatile("" ::: "memory"); }
    }
};
struct EpiSwiglu {
    bf16_t* O; int ldo; const rss_t* rowss; const float* rsv;
    __device__ __forceinline__ void operator()(const f32x4 (&acc)[2][2][4][2], const Unit& u, int wr, int wc, int fr, int fq) const {
        const int lrow0 = wr * 64 + fr, col0 = u.pn * 128 + wc * 32 + 8 * fq;
#pragma unroll
        for (int ai = 0; ai < 2; ++ai)
#pragma unroll
            for (int m = 0; m < 4; ++m) { const int lrow = lrow0 + ai * 128 + m * 16;
                float rs; size_t orow;
                if (rsv) { rs = rsv[u.rb + lrow]; orow = (size_t)u.e + lrow; } else { const int row = u.pm * 256 + lrow; rs = rstd_fx(rowss[row]); orow = row; }
                const f32x4 g0 = acc[ai][0][m][0] * rs, g1 = acc[ai][0][m][1] * rs, u0 = acc[ai][1][m][0] * rs, u1 = acc[ai][1][m][1] * rs;
                u32x4 w; w.x = cvt_pk_bf16(silu_(g0[0]) * u0[0], silu_(g0[1]) * u0[1]); w.y = cvt_pk_bf16(silu_(g0[2]) * u0[2], silu_(g0[3]) * u0[3]);
                w.z = cvt_pk_bf16(silu_(g1[0]) * u1[0], silu_(g1[1]) * u1[1]); w.w = cvt_pk_bf16(silu_(g1[2]) * u1[2], silu_(g1[3]) * u1[3]);
                *(u32x4*)(O + orow * ldo + col0) = w; }
    }
};
struct EpiSlot {
    bf16_t* O;
    __device__ __forceinline__ void operator()(const f32x4 (&acc)[2][2][4][2], const Unit& u, int wr, int wc, int fr, int fq) const {
        const int lrow0 = wr * 64 + fr, col0 = u.pn * 256 + wc * 32 + 8 * fq;
#pragma unroll
        for (int ai = 0; ai < 2; ++ai)
#pragma unroll
            for (int m = 0; m < 4; ++m) { const size_t orow = (size_t)u.e + lrow0 + ai * 128 + m * 16;
#pragma unroll
                for (int bj = 0; bj < 2; ++bj) { const f32x4 v0 = acc[ai][bj][m][0], v1 = acc[ai][bj][m][1];
                    u32x4 w; w.x = cvt_pk_bf16(v0[0], v0[1]); w.y = cvt_pk_bf16(v0[2], v0[3]); w.z = cvt_pk_bf16(v1[0], v1[1]); w.w = cvt_pk_bf16(v1[2], v1[3]);
                    *(u32x4*)(O + orow * D + col0 + bj * 128) = w; } }
    }
};

struct MoeGuSched {
    static constexpr bool GATHER = true;
    pg8::TileOrder o; const char* A; const char* W; const int* list; const LAS int* tab; int tile0;
    __device__ __forceinline__ bool next(int i, Unit& u) const {
        if (!o.tile(i, u.pm, u.pn)) return false;
        const int gt = tile0 + u.pm; int e = 0;
#pragma unroll
        for (int k = 1; k < 8; ++k) e += (gt >= tab[k]) ? 1 : 0;
        e = __builtin_amdgcn_readfirstlane(e);
        u.rb = __builtin_amdgcn_readfirstlane(e * 32768 + (gt - tab[e]) * 256); u.e = u.pm * 256; return true;
    }
    __device__ __forceinline__ const char* a_base(const Unit&) const { return A; }
    __device__ __forceinline__ const char* b_base(const Unit& u) const { return W + ((size_t)(u.rb >> 15) * (2 * FE) + (size_t)u.pn * 256) * (D * 2); }
    __device__ __forceinline__ void gather_ids(const Unit& u, int R0, int R1, int (&ids)[4]) const {
        const int e = u.rb >> 15, rank0 = u.rb & 32767, cnt = __builtin_amdgcn_readfirstlane(tab[16 + e]);
#pragma unroll
        for (int h = 0; h < 2; ++h) { const int r0 = R0 + 128 * h, r1 = R1 + 128 * h;
            ids[h * 2 + 0] = (rank0 + r0 < cnt) ? list[u.rb + r0] : 0; ids[h * 2 + 1] = (rank0 + r1 < cnt) ? list[u.rb + r1] : 0; }
    }
};
struct MoeDownSched {
    static constexpr bool GATHER = false;
    pg8::TileOrder o; const char* A; const char* W; const LAS int* tab; int tile0;
    __device__ __forceinline__ bool next(int i, Unit& u) const {
        if (!o.tile(i, u.pm, u.pn)) return false;
        const int gt = tile0 + u.pm; int e = 0;
#pragma unroll
        for (int k = 1; k < 8; ++k) e += (gt >= tab[k]) ? 1 : 0;
        u.rb = __builtin_amdgcn_readfirstlane(e); u.e = gt * 256; return true;
    }
    __device__ __forceinline__ const char* a_base(const Unit& u) const { return A + (size_t)u.pm * 256 * (FE * 2); }
    __device__ __forceinline__ const char* b_base(const Unit& u) const { return W + ((size_t)u.rb * D + (size_t)u.pn * 256) * (FE * 2); }
    __device__ __forceinline__ void gather_ids(const Unit&, int, int, int (&)[4]) const {}
};

__device__ __forceinline__ void tr_item(const float* W, int K, int N, bf16_t* WT, const float* gain, int mode, LAS float* scr, int item, int lane) {
    const int nblk = N / 32, kb = item / nblk, nb = item % nblk, k0 = 64 * kb, n0 = 32 * nb;
#pragma unroll 8
    for (int i = 0; i < 32; ++i) { const int kk = 2 * i + (lane >> 5); float v = W[(size_t)(k0 + kk) * N + n0 + (lane & 31)]; if (gain) v *= gain[k0 + kk]; scr[kk * 33 + (lane & 31)] = v; }
    LDS_WAIT(); asm volatile("" ::: "memory");
    const int c = lane & 7;
#pragma unroll
    for (int j = 0; j < 4; ++j) { const int n = (lane >> 3) + 8 * j; const LAS float* s = scr + (8 * c) * 33 + n;
        u32x4 o; o.x = cvt_pk_bf16(s[0 * 33], s[1 * 33]); o.y = cvt_pk_bf16(s[2 * 33], s[3 * 33]); o.z = cvt_pk_bf16(s[4 * 33], s[5 * 33]); o.w = cvt_pk_bf16(s[6 * 33], s[7 * 33]);
        const int nn = n0 + n; const int row = (mode == 0) ? nn : (((nn >> 7) << 8) + (nn & 127) + (mode == 2 ? 128 : 0));
        *(u32x4*)(WT + (size_t)row * K + k0 + 8 * c) = o; }
    LDS_WAIT(); asm volatile("" ::: "memory");
}
struct TrJob { const float* W; bf16_t* WT; const float* gain; int K, N, mode, items; };


struct Args { const float* in[N_IN]; float* out; unsigned char* ws; int ph_lo, ph_hi, pass_lo, pass_hi; };

__device__ __forceinline__ void attn_naive(LAS unsigned char* lds, const bf16_t* Q, const bf16_t* KV, bf16_t* CAT, int bx, int G, int tid) {
    LAS float* Ks = (LAS float*)lds; LAS float* Vs = Ks + 256 * 64;
    for (int item = bx; item < NB * NH_MEM * 8; item += G) {
        const int b = item >> 5, h = (item >> 3) & 3, qb = item & 7;
#pragma unroll 4
        for (int i = 0; i < 32; ++i) { const int idx = tid + 512 * i, m = idx >> 6, d = idx & 63;
            const bf16_t* kr = KV + (size_t)(b * MEML + m) * 512 + h * 64 + d;
            Ks[idx] = bf2f(kr[0]); Vs[idx] = bf2f(kr[256]); }
        __syncthreads();
        const int row = b * SEQ + qb * 512 + tid;
        float q[64], o[64];
        { const u32x4* qp = (const u32x4*)(Q + (size_t)row * CM + h * 64);
#pragma unroll
          for (int i = 0; i < 8; ++i) { const u32x4 w = qp[i];
              q[8 * i + 0] = bflo(w.x) * 0.125f; q[8 * i + 1] = bfhi(w.x) * 0.125f; q[8 * i + 2] = bflo(w.y) * 0.125f; q[8 * i + 3] = bfhi(w.y) * 0.125f;
              q[8 * i + 4] = bflo(w.z) * 0.125f; q[8 * i + 5] = bfhi(w.z) * 0.125f; q[8 * i + 6] = bflo(w.w) * 0.125f; q[8 * i + 7] = bfhi(w.w) * 0.125f; } }
#pragma unroll
        for (int d = 0; d < 64; ++d) o[d] = 0.f;
        float mx = -1e30f, l = 0.f;
#pragma unroll 1
        for (int key = 0; key < MEML; ++key) {
            const LAS f32x4* kr = (const LAS f32x4*)(Ks + key * 64); float sc = 0.f;
#pragma unroll
            for (int d4 = 0; d4 < 16; ++d4) { const f32x4 kv = kr[d4]; sc += q[4 * d4] * kv[0] + q[4 * d4 + 1] * kv[1] + q[4 * d4 + 2] * kv[2] + q[4 * d4 + 3] * kv[3]; }
            const float mn = fmaxf(mx, sc), alpha = __expf(mx - mn), p = __expf(sc - mn); mx = mn; l = l * alpha + p;
            const LAS f32x4* vr = (const LAS f32x4*)(Vs + key * 64);
#pragma unroll
            for (int d4 = 0; d4 < 16; ++d4) { const f32x4 vv = vr[d4]; o[4 * d4] = o[4 * d4] * alpha + p * vv[0]; o[4 * d4 + 1] = o[4 * d4 + 1] * alpha + p * vv[1]; o[4 * d4 + 2] = o[4 * d4 + 2] * alpha + p * vv[2]; o[4 * d4 + 3] = o[4 * d4 + 3] * alpha + p * vv[3]; }
        }
        const float il = 1.0f / l;
        u32x4* op = (u32x4*)(CAT + (size_t)row * D + CS + h * 64);
#pragma unroll
        for (int i = 0; i < 8; ++i) { u32x4 w; w.x = cvt_pk_bf16(o[8 * i] * il, o[8 * i + 1] * il); w.y = cvt_pk_bf16(o[8 * i + 2] * il, o[8 * i + 3] * il);
            w.z = cvt_pk_bf16(o[8 * i + 4] * il, o[8 * i + 5] * il); w.w = cvt_pk_bf16(o[8 * i + 6] * il, o[8 * i + 7] * il); op[i] = w; }
        __syncthreads();
    }
}

__device__ __forceinline__ void s5_naive(const Args& a, LAS unsigned char* lds, const bf16_t* U, bf16_t* CAT, int bx, int G, int wave, int lane) {
    LAS float* xs = (LAS float*)(lds + wave * 1024);
    for (int it = bx + G * wave; it < NB * S5G; it += G * NWAVES) {
        const int b = it / S5G, g = it % S5G, p = lane;
        const double dt = exp((double)a.in[I_LOG_DT][g]), lr = a.in[I_LAM_RE][g * S5P + p], li = a.in[I_LAM_IM][g * S5P + p];
        const double mag = exp(lr * dt), ang = li * dt, abr_d = mag * cos(ang), abi_d = mag * sin(ang);
        const double nre = abr_d - 1.0, nim = abi_d, den = lr * lr + li * li, zr = (nre * lr + nim * li) / den, zi = (nim * lr - nre * li) / den;
        const float abr = (float)abr_d, abi = (float)abi_d;
        float bbr[16], bbi[16], cre[16], cim[16], wg[16];
#pragma unroll
        for (int j = 0; j < 16; ++j) { const double br = a.in[I_B_RE][(size_t)(g * S5P + p) * 16 + j], bi = a.in[I_B_IM][(size_t)(g * S5P + p) * 16 + j]; bbr[j] = (float)(zr * br - zi * bi); bbi[j] = (float)(zr * bi + zi * br); }
        const int jj = lane & 15, pq = lane >> 4;
#pragma unroll
        for (int q = 0; q < 16; ++q) { cre[q] = a.in[I_C_RE][(size_t)(g * 16 + jj) * S5P + 16 * pq + q]; cim[q] = a.in[I_C_IM][(size_t)(g * 16 + jj) * S5P + 16 * pq + q]; }
#pragma unroll
        for (int j = 0; j < 16; ++j) wg[j] = a.in[I_WGLU][(size_t)(g * 16 + j) * 16 + jj];
        const float dj = a.in[I_S5D][g * 16 + jj], bg = a.in[I_BGLU][g * 16 + jj];
        const bf16_t* up = U + (size_t)(b * S5G + g) * SEQ * 16;
        float xr = 0.f, xi = 0.f;
#pragma unroll 1
        for (int t = 0; t < SEQ; ++t) {
            const u32x4 w0 = *(const u32x4*)(up + (size_t)t * 16), w1 = *(const u32x4*)(up + (size_t)t * 16 + 8);
            float uf[16];
            uf[0] = bflo(w0.x); uf[1] = bfhi(w0.x); uf[2] = bflo(w0.y); uf[3] = bfhi(w0.y); uf[4] = bflo(w0.z); uf[5] = bfhi(w0.z); uf[6] = bflo(w0.w); uf[7] = bfhi(w0.w);
            uf[8] = bflo(w1.x); uf[9] = bfhi(w1.x); uf[10] = bflo(w1.y); uf[11] = bfhi(w1.y); uf[12] = bflo(w1.z); uf[13] = bfhi(w1.z); uf[14] = bflo(w1.w); uf[15] = bfhi(w1.w);
            const float uj = bf2f(up[(size_t)t * 16 + jj]);
            float bur = 0.f, bui = 0.f;
#pragma unroll
            for (int j = 0; j < 16; ++j) { bur += bbr[j] * uf[j]; bui += bbi[j] * uf[j]; }
            const float nxr = abr * xr - abi * xi + bur, nxi = abr * xi + abi * xr + bui; xr = nxr; xi = nxi;
            xs[p] = xr; xs[64 + p] = xi;
            LDS_WAIT(); asm volatile("" ::: "memory");
            float s = 0.f;
#pragma unroll
            for (int q4 = 0; q4 < 4; ++q4) { const f32x4 vr = *(const LAS f32x4*)(xs + 16 * pq + 4 * q4), vi = *(const LAS f32x4*)(xs + 64 + 16 * pq + 4 * q4);
#pragma unroll
                for (int e = 0; e < 4; ++e) s += cre[4 * q4 + e] * vr[e] - cim[4 * q4 + e] * vi[e]; }
            LDS_WAIT(); asm volatile("" ::: "memory");
            s += __shfl_xor(s, 16); s += __shfl_xor(s, 32);
            const float yg = gelu_tanh_(s + dj * uj);
            float z = bg;
#pragma unroll
            for (int j = 0; j < 16; ++j) z += __shfl(yg, j) * wg[j];
            const float o = yg * sigmoidf_(z);
            if (lane < 16) CAT[(size_t)(b * SEQ + t) * D + g * 16 + lane] = f2bf(o);
        }
    }
}

__device__ __forceinline__ void rwkv_prep(const Args& a, LAS unsigned char* lds, const bf16_t* P1, bf16_t* RA, bf16_t* RKK, bf16_t* RLD, bf16_t* RG, int bx, int G, int tid) {
    LAS float* twT = (LAS float*)lds; LAS float* adT = twT + 64 * 16; LAS float* sgT = adT + 64 * 16;
    const float* mu = a.in[I_MU];
    for (int tile = bx; tile < T / 16; tile += G) {
        __syncthreads();
#pragma unroll
        for (int i = 0; i < 8; ++i) { const int idx = tid + 512 * i, tok = idx >> 8, c = idx & 255, row = tile * 16 + tok, t = row & (SEQ - 1);
            const float cur = bf2f(P1[(size_t)row * INB + 2304 + c]), prev = t > 0 ? bf2f(P1[(size_t)(row - 1) * INB + 2304 + c]) : 0.f;
            const float xsv = cur + (prev - cur) * mu[2304 + c];
            if (c < 64) twT[c * 16 + tok] = tanhf(xsv); else if (c < 128) adT[(c - 64) * 16 + tok] = xsv; else sgT[(c - 128) * 16 + tok] = sigmoidf_(xsv); }
        __syncthreads();
        if (tid < 384) {
#pragma unroll 1
            for (int cc = 0; cc < 2; ++cc) { const int c = tid + 384 * cc;
                float aw[16], aa[16], ag[16];
#pragma unroll
                for (int k = 0; k < 16; ++k) { aw[k] = 0.f; aa[k] = 0.f; ag[k] = 0.f; }
#pragma unroll 2
                for (int m = 0; m < 64; ++m) { const float w2v = a.in[I_W2][(size_t)m * CS + c], a2v = a.in[I_A2][(size_t)m * CS + c];
#pragma unroll
                    for (int k4 = 0; k4 < 4; ++k4) { const f32x4 tw = *(const LAS f32x4*)(twT + m * 16 + 4 * k4), ad = *(const LAS f32x4*)(adT + m * 16 + 4 * k4);
#pragma unroll
                        for (int e = 0; e < 4; ++e) { aw[4 * k4 + e] += tw[e] * w2v; aa[4 * k4 + e] += ad[e] * a2v; } } }
#pragma unroll 2
                for (int m = 0; m < 128; ++m) { const float g2v = a.in[I_G2][(size_t)m * CS + c];
#pragma unroll
                    for (int k4 = 0; k4 < 4; ++k4) { const f32x4 sg = *(const LAS f32x4*)(sgT + m * 16 + 4 * k4);
#pragma unroll
                        for (int e = 0; e < 4; ++e) ag[4 * k4 + e] += sg[e] * g2v; } }
                const float w0 = a.in[I_W0][c], a0 = a.in[I_A0][c], kkw = a.in[I_KK][c], muk = mu[CS + c];
#pragma unroll
                for (int k = 0; k < 16; ++k) { const int row = tile * 16 + k, t = row & (SEQ - 1);
                    const float z = -(w0 + aw[k]);
                    const float sp = z > 20.f ? z : log1pf(__expf(z));
                    const float ld = -__expf(-sp - 0.5f);
                    const float av = sigmoidf_(a0 + aa[k]);
                    const float cur = bf2f(P1[(size_t)row * INB + CS + c]), prev = t > 0 ? bf2f(P1[(size_t)(row - 1) * INB + CS + c]) : 0.f;
                    const float kx = (cur + (prev - cur) * muk) * kkw;
                    const float ss = wave_sum(kx * kx);
                    const float kkv = kx / fmaxf(sqrtf(ss), 1e-12f);
                    const size_t o = (size_t)row * CS + c;
                    RA[o] = f2bf(av); RKK[o] = f2bf(kkv); RLD[o] = f2bf(ld); RG[o] = f2bf(ag[k]); }
            }
        }
    }
}

__device__ __forceinline__ void rwkv_naive(const Args& a, LAS unsigned char* lds, const bf16_t* P1, const bf16_t* RA, const bf16_t* RKK, const bf16_t* RLD, const bf16_t* RG, bf16_t* CAT, int bx, int G, int wave, int lane) {
    if (wave != 0) return;
    LAS float* vec = (LAS float*)lds;
    for (int item = bx; item < NB * RH; item += G) {
        const int b = item / RH, h = item % RH, c = h * 64 + lane;
        const float mur = a.in[I_MU][c], muk = a.in[I_MU][CS + c], muv = a.in[I_MU][2 * CS + c], ka = a.in[I_KA][c], rkc = a.in[I_RK][c], lw = a.in[I_LNXW][c], lb = a.in[I_LNXB][c];
        float S[64];
#pragma unroll
        for (int j = 0; j < 64; ++j) S[j] = 0.f;
        float prr = 0.f, prk = 0.f, prv = 0.f;
        const size_t row0 = (size_t)b * SEQ;
        bf16_t n_r = P1[row0 * INB + c], n_k = P1[row0 * INB + CS + c], n_v = P1[row0 * INB + 2 * CS + c], n_a = RA[row0 * CS + c], n_kk = RKK[row0 * CS + c], n_ld = RLD[row0 * CS + c], n_g = RG[row0 * CS + c];
#pragma unroll 1
        for (int t = 0; t < SEQ; ++t) {
            const float pr = bf2f(n_r), pk = bf2f(n_k), pv = bf2f(n_v), av = bf2f(n_a), kkv = bf2f(n_kk), ld = bf2f(n_ld), gv = bf2f(n_g);
            if (t + 1 < SEQ) { const size_t rn = row0 + t + 1; n_r = P1[rn * INB + c]; n_k = P1[rn * INB + CS + c]; n_v = P1[rn * INB + 2 * CS + c]; n_a = RA[rn * CS + c]; n_kk = RKK[rn * CS + c]; n_ld = RLD[rn * CS + c]; n_g = RG[rn * CS + c]; }
            const float r = pr + (prr - pr) * mur, k = pk + (prk - pk) * muk, v = pv + (prv - pv) * muv;
            prr = pr; prk = pk; prv = pv;
            const float kp = k * (1.f + (av - 1.f) * ka), ap = -kkv, bb = kkv * av, w = __expf(ld);
            vec[lane] = r; vec[64 + lane] = w; vec[128 + lane] = kp; vec[192 + lane] = ap; vec[256 + lane] = bb;
            LDS_WAIT(); asm volatile("" ::: "memory");
            float sa = 0.f;
#pragma unroll
            for (int j4 = 0; j4 < 16; ++j4) { const f32x4 x = *(const LAS f32x4*)(vec + 192 + 4 * j4); sa += S[4 * j4] * x[0] + S[4 * j4 + 1] * x[1] + S[4 * j4 + 2] * x[2] + S[4 * j4 + 3] * x[3]; }
            float y = 0.f;
#pragma unroll
            for (int j4 = 0; j4 < 16; ++j4) { const f32x4 wv = *(const LAS f32x4*)(vec + 64 + 4 * j4), bv = *(const LAS f32x4*)(vec + 256 + 4 * j4), kv = *(const LAS f32x4*)(vec + 128 + 4 * j4), rv = *(const LAS f32x4*)(vec + 4 * j4);
#pragma unroll
                for (int e = 0; e < 4; ++e) { const float s = S[4 * j4 + e] * wv[e] + sa * bv[e] + v * kv[e]; S[4 * j4 + e] = s; y += s * rv[e]; } }
            LDS_WAIT(); asm volatile("" ::: "memory");
            const float rkv = wave_sum(r * kp * rkc), bonus = rkv * v;
            const float mean = wave_sum(y) * (1.f / 64.f), dlt = y - mean, var = wave_sum(dlt * dlt) * (1.f / 64.f);
            const float yn = dlt * (1.0f / sqrtf(var + LNX_EPS)) * lw + lb;
            CAT[(row0 + t) * D + c] = f2bf((yn + bonus) * gv);
        }
    }
}

__device__ __forceinline__ void moe_router(const Args& a, const float* X, unsigned* ctl, unsigned char* ws, int gw, int NGW, int lane) {
    int* list = (int*)(ws + WS_ROUTE + RT_LIST); float* lrstd = (float*)(ws + WS_ROUTE + RT_LRSTD);
    int* toke = (int*)(ws + WS_ROUTE + RT_TOKE); int* tokr = (int*)(ws + WS_ROUTE + RT_TOKR); float* tokw = (float*)(ws + WS_ROUTE + RT_TOKW);
    const float* wr = a.in[I_WR]; const f32x4* gr = (const f32x4*)(a.in[I_NORM_FFN] + D) + lane;
    for (int r = gw; r < T; r += NGW) {
        const f32x4* xr = (const f32x4*)(X + (size_t)r * D) + lane; f32x4 v[4]; float s = 0.f;
#pragma unroll
        for (int j = 0; j < 4; ++j) { v[j] = xr[64 * j]; s += (v[j][0] * v[j][0] + v[j][1] * v[j][1]) + (v[j][2] * v[j][2] + v[j][3] * v[j][3]); }
        const float rs = rstd_of(wave_sum(s));
        float lg[8];
#pragma unroll
        for (int e = 0; e < 8; ++e) lg[e] = 0.f;
#pragma unroll
        for (int j = 0; j < 4; ++j) { const f32x4 g = gr[64 * j];
#pragma unroll
            for (int i = 0; i < 4; ++i) { const int k = 4 * (lane + 64 * j) + i; const float hv = v[j][i] * rs * g[i];
                const f32x4 w0 = *(const f32x4*)(wr + (size_t)k * 8), w1 = *(const f32x4*)(wr + (size_t)k * 8 + 4);
                lg[0] += hv * w0[0]; lg[1] += hv * w0[1]; lg[2] += hv * w0[2]; lg[3] += hv * w0[3]; lg[4] += hv * w1[0]; lg[5] += hv * w1[1]; lg[6] += hv * w1[2]; lg[7] += hv * w1[3]; } }
#pragma unroll
        for (int e = 0; e < 8; ++e) lg[e] = wave_sum(lg[e]) + a.in[I_BR][e];
        float bv = lg[0]; int bi = 0;
#pragma unroll
        for (int e = 1; e < 8; ++e) if (lg[e] > bv) { bv = lg[e]; bi = e; }
        float sv = -3.0e38f; int si = 0;
#pragma unroll
        for (int e = 0; e < 8; ++e) if (e != bi && lg[e] > sv) { sv = lg[e]; si = e; }
        const float w0 = 1.0f / (1.0f + __expf(sv - bv)), w1 = 1.0f - w0;
        if (lane == 0) {
            const int r0 = (int)atomicAdd(ctl + CW_CNT + 64 * bi, 1u), r1 = (int)atomicAdd(ctl + CW_CNT + 64 * si, 1u);
            list[bi * 32768 + r0] = r; lrstd[bi * 32768 + r0] = rs; list[si * 32768 + r1] = r; lrstd[si * 32768 + r1] = rs;
            toke[2 * r] = bi; toke[2 * r + 1] = si; tokr[2 * r] = r0; tokr[2 * r + 1] = r1; tokw[2 * r] = w0; tokw[2 * r + 1] = w1;
        }
    }
}
constexpr int N_PHASES = 14;

__device__ __forceinline__ TrJob small_job(const Args& a, int j) {
    unsigned char* ws = a.ws; TrJob r;
    switch (j) {
    case 0: r = TrJob{a.in[I_WINA], (bf16_t*)(ws + WS_WINA), a.in[I_NORM_MIX], D, D, 0, 0}; break;
    case 1: r = TrJob{a.in[I_WOUT], (bf16_t*)(ws + WS_WOUT0), nullptr, D, D, 0, 0}; break;
    case 2: r = TrJob{a.in[I_WOUT] + (size_t)D * D, (bf16_t*)(ws + WS_WOUT1), nullptr, D, D, 0, 0}; break;
    case 3: r = TrJob{a.in[I_WKV], (bf16_t*)(ws + WS_WKV), nullptr, D, 512, 0, 0}; break;
    case 4: r = TrJob{a.in[I_WKV] + (size_t)D * 512, (bf16_t*)(ws + WS_WKV) + (size_t)512 * D, nullptr, D, 512, 0, 0}; break;
    case 5: r = TrJob{a.in[I_FGATE], (bf16_t*)(ws + WS_WGU0), a.in[I_NORM_FFN], D, FD, 1, 0}; break;
    case 6: r = TrJob{a.in[I_FUP], (bf16_t*)(ws + WS_WGU0), a.in[I_NORM_FFN], D, FD, 2, 0}; break;
    case 7: r = TrJob{a.in[I_FDOWN], (bf16_t*)(ws + WS_WD0), nullptr, FD, D, 0, 0}; break;
    default: r = TrJob{a.in[I_WINB], (bf16_t*)(ws + WS_WINB), a.in[I_NORM_MIX] + D, D, INB, 0, 0}; break;
    }
    r.items = (r.K / 64) * (r.N / 32); return r;
}
__device__ __forceinline__ TrJob moe_job(const Args& a, int j) {
    unsigned char* ws = a.ws; const int kind = j >> 3, e = j & 7; TrJob r;
    if (kind == 0) r = TrJob{a.in[I_MGATE] + (size_t)e * D * FE, (bf16_t*)(ws + WS_WMOE_GU) + (size_t)e * 2 * FE * D, a.in[I_NORM_FFN] + D, D, FE, 1, 0};
    else if (kind == 1) r = TrJob{a.in[I_MUP] + (size_t)e * D * FE, (bf16_t*)(ws + WS_WMOE_GU) + (size_t)e * 2 * FE * D, a.in[I_NORM_FFN] + D, D, FE, 2, 0};
    else r = TrJob{a.in[I_MDOWN] + (size_t)e * FE * D, (bf16_t*)(ws + WS_WMOE_D) + (size_t)e * D * FE, nullptr, FE, D, 0, 0};
    r.items = (r.K / 64) * (r.N / 32); return r;
}

template <int LO, int HI> __global__ void __launch_bounds__(NTHR, 2) fwd(Args args) {
    extern __shared__ __attribute__((aligned(16))) unsigned char lds_raw[];
    LAS unsigned char* lds = (LAS unsigned char*)lds_raw;
    volatile LAS unsigned* MISC = (volatile LAS unsigned*)(lds + LDS_MISC);
    const int tid = threadIdx.x, lane = tid & 63, wave = __builtin_amdgcn_readfirstlane(tid >> 6);
    const int G = gridDim.x, bx = blockIdx.x;
    const int gw = bx * NWAVES + wave, NGW = G * NWAVES;
    unsigned char* ws = args.ws;
    unsigned* ctl = (unsigned*)(ws + WS_CTL);
    rss_t* rowss = (rss_t*)(ws + WS_CTL + CTL_ROWSS);
    float* X = args.out;
    bf16_t* HA = (bf16_t*)(ws + WS_HA);
    const int lo = args.ph_lo, hi = args.ph_hi;
    for (int u = tid; u < (LDS_BYTES - LDS_MISC) / 4; u += NTHR) ((LAS unsigned*)(lds + LDS_MISC))[u] = 0u;
    __syncthreads();
    XcdBarrier bar; bar.bar = ctl + CW_BAR; bar.x = 0; bar.st = nullptr;
    const bool multi = (hi - lo) > 1;
    if (multi) bar = xcd_barrier_post(ctl + CW_BAR, MISC + 8);
#define IN(k) (LO <= (k) && (k) < HI && lo <= (k) && (k) < hi)
#define SEAM(k) do { if (IN(k) && IN((k) + 1)) xcd_barrier(bar); } while (0)

    if (IN(0)) {
        LAS float* scr = (LAS float*)(lds + wave * 16384);
        {
            int base = 0;
            for (int j = 0; j < 9; ++j) { const TrJob jb = small_job(args, j);
                for (int it = gw - base; it < jb.items; it += NGW) { if (it >= 0) tr_item(jb.W, jb.K, jb.N, jb.WT, jb.gain, jb.mode, scr, it, lane); }
                base = (base + jb.items) % NGW; }
        }
        for (int r = gw; r < 2 * MROWS; r += NGW) { const int li = r / MROWS, row = r % MROWS;
            const f32x4* xr = (const f32x4*)(args.in[I_MEM] + (size_t)row * D) + lane; const f32x4* gr = (const f32x4*)(args.in[I_NORM_MEM] + li * D) + lane;
            f32x4 v[4]; float s = 0.f;
#pragma unroll
            for (int j = 0; j < 4; ++j) { v[j] = xr[64 * j]; s += (v[j][0] * v[j][0] + v[j][1] * v[j][1]) + (v[j][2] * v[j][2] + v[j][3] * v[j][3]); }
            const float rs = rstd_of(wave_sum(s));
            u32x2* o = (u32x2*)((bf16_t*)(ws + WS_MEMN) + ((size_t)li * MROWS + row) * D) + lane;
#pragma unroll
            for (int j = 0; j < 4; ++j) { const f32x4 g = gr[64 * j]; u32x2 w; w.x = cvt_pk_bf16(v[j][0] * rs * g[0], v[j][1] * rs * g[1]); w.y = cvt_pk_bf16(v[j][2] * rs * g[2], v[j][3] * rs * g[3]); o[64 * j] = w; }
        }
        for (int r = gw; r < T; r += NGW) {
            const f32x4* xr = (const f32x4*)(args.in[I_X] + (size_t)r * D) + lane; f32x4 v[4]; float s = 0.f;
#pragma unroll
            for (int j = 0; j < 4; ++j) { v[j] = xr[64 * j]; s += (v[j][0] * v[j][0] + v[j][1] * v[j][1]) + (v[j][2] * v[j][2] + v[j][3] * v[j][3]); }
            s = wave_sum(s); if (lane == 0) rowss[r] = rss_fx(s);
            u32x2* o = (u32x2*)(HA + (size_t)r * D) + lane;
#pragma unroll
            for (int j = 0; j < 4; ++j) { u32x2 w; w.x = cvt_pk_bf16(v[j][0], v[j][1]); w.y = cvt_pk_bf16(v[j][2], v[j][3]); o[64 * j] = w; }
        }
    }
    SEAM(0);

    if (IN(1)) {
        { pg8::DenseSched S; S.init(HA, ws + WS_WINA, T, D, D, G, bx);
          EpiInA E{(bf16_t*)(ws + WS_P0U), (bf16_t*)(ws + WS_P0Q), rowss};
          pg8::gemm_phase<EpiInA, pg8::DenseSched, true>(lds, D, S, E); }
        __syncthreads();
#pragma unroll 1
        for (int li = 0; li < 2; ++li) {
            pg8::DenseSched S; S.init((bf16_t*)(ws + WS_MEMN) + (size_t)li * MROWS * D, (bf16_t*)(ws + WS_WKV) + (size_t)li * 512 * D, MROWS, 512, D, G, (bx + 128 * li + 64) % G);
            EpiBf16 E{(bf16_t*)(ws + WS_KV) + (size_t)li * MROWS * 512, 512, nullptr, nullptr, 0};
            pg8::gemm_phase<EpiBf16, pg8::DenseSched, true>(lds, D, S, E);
            __syncthreads();
        }
    }
    SEAM(1);

    if (IN(2)) {
        bf16_t* CAT = (bf16_t*)(ws + WS_CAT);
        attn_naive(lds, (const bf16_t*)(ws + WS_P0Q), (const bf16_t*)(ws + WS_KV), CAT, bx, G, tid);
        __syncthreads();
        s5_naive(args, lds, (const bf16_t*)(ws + WS_P0U), CAT, bx, G, wave, lane);
    }
    SEAM(2);

    if (IN(3)) {
        pg8::DenseSched S; S.init(ws + WS_CAT, ws + WS_WOUT0, T, D, D, G, bx);
        EpiRes E{args.in[I_X], X, HA, rowss + T};
        pg8::gemm_phase<EpiRes, pg8::DenseSched, true>(lds, D, S, E);
    }
    SEAM(3);

    if (IN(4)) {
        pg8::DenseSched S; S.init(HA, ws + WS_WGU0, T, 2 * FD, D, G, bx);
        EpiSwiglu E{(bf16_t*)(ws + WS_ACT0), FD, rowss + T, nullptr};
        pg8::gemm_phase<EpiSwiglu, pg8::DenseSched, true>(lds, D, S, E);
    }
    SEAM(4);

    if (IN(5)) {
        pg8::DenseSched S; S.init(ws + WS_ACT0, ws + WS_WD0, T, D, FD, G, bx);
        EpiRes E{X, X, HA, rowss + 2 * T};
        pg8::gemm_phase<EpiRes, pg8::DenseSched, true>(lds, FD, S, E);
    }
    SEAM(5);

    if (IN(6)) {
        pg8::DenseSched S; S.init(HA, ws + WS_WINB, T, INB, D, G, bx);
        EpiBf16 E{(bf16_t*)(ws + WS_P1), INB, rowss + 2 * T, (bf16_t*)(ws + WS_P0Q), SHIFTC};
        pg8::gemm_phase<EpiBf16, pg8::DenseSched, true>(lds, D, S, E);
    }
    SEAM(6);

    if (IN(7)) {
        attn_naive(lds, (const bf16_t*)(ws + WS_P0Q), (const bf16_t*)(ws + WS_KV) + (size_t)MROWS * 512, (bf16_t*)(ws + WS_CAT), bx, G, tid);
        __syncthreads();
        rwkv_prep(args, lds, (const bf16_t*)(ws + WS_P1), (bf16_t*)(ws + WS_RA), (bf16_t*)(ws + WS_RKK), (bf16_t*)(ws + WS_RLD), (bf16_t*)(ws + WS_RG), bx, G, tid);
    }
    SEAM(7);

    if (IN(8)) {
        rwkv_naive(args, lds, (const bf16_t*)(ws + WS_P1), (const bf16_t*)(ws + WS_RA), (const bf16_t*)(ws + WS_RKK), (const bf16_t*)(ws + WS_RLD), (const bf16_t*)(ws + WS_RG), (bf16_t*)(ws + WS_CAT), bx, G, wave, lane);
    }
    SEAM(8);

    if (IN(9)) {
        pg8::DenseSched S; S.init(ws + WS_CAT, ws + WS_WOUT1, T, D, D, G, bx);
        EpiRes E{X, X, HA, rowss + 3 * T};
        pg8::gemm_phase<EpiRes, pg8::DenseSched, true>(lds, D, S, E);
    }
    SEAM(9);

    if (IN(10)) {
        moe_router(args, X, ctl, ws, gw, NGW, lane);
        LAS float* scr = (LAS float*)(lds + wave * 16384);
        int base = 0;
#pragma unroll 1
        for (int j = 0; j < 24; ++j) { const TrJob jb = moe_job(args, j);
            for (int it = gw - base; it < jb.items; it += NGW) { if (it >= 0) tr_item(jb.W, jb.K, jb.N, jb.WT, jb.gain, jb.mode, scr, it, lane); }
            base = (base + jb.items) % NGW; }
    }
    SEAM(10);

    if constexpr (HI > 11 && LO < 13) {
#pragma unroll 1
    for (int pass = args.pass_lo; pass < args.pass_hi; ++pass) {
        constexpr int pg = 11, pd = 12;
        LAS int* tab = (LAS int*)(lds + LDS_MISC + 256);
        if (IN(pg) || IN(pd)) {
            __syncthreads();
            if (tid == 0) { int acc = 0; for (int e = 0; e < 8; ++e) { const int c = (int)__hip_atomic_load(ctl + CW_CNT + 64 * e, __ATOMIC_RELAXED, __HIP_MEMORY_SCOPE_AGENT); tab[e] = acc; tab[16 + e] = c; acc += (c + 255) >> 8; } tab[8] = acc; }
            __syncthreads();
        }
        const int ntile = (IN(pg) || IN(pd)) ? __builtin_amdgcn_readfirstlane(tab[8]) : 0;
        const int tile0 = 64 * pass, nt_pass = min(64, ntile - tile0);
        if (IN(pg) && nt_pass > 0) {
            MoeGuSched S; S.o.init(nt_pass, 2 * FE / 256, G, bx); S.A = (const char*)HA; S.W = (const char*)(ws + WS_WMOE_GU); S.list = (const int*)(ws + WS_ROUTE + RT_LIST); S.tab = tab; S.tile0 = tile0;
            EpiSwiglu E{(bf16_t*)(ws + WS_MACT), FE, nullptr, (const float*)(ws + WS_ROUTE + RT_LRSTD)};
            pg8::gemm_phase<EpiSwiglu, MoeGuSched, true>(lds, D, S, E);
        }
        SEAM(pg);
        if (IN(pd) && nt_pass > 0) {
            MoeDownSched S; S.o.init(nt_pass, D / 256, G, bx); S.A = (const char*)(ws + WS_MACT); S.W = (const char*)(ws + WS_WMOE_D); S.tab = tab; S.tile0 = tile0;
            EpiSlot E{(bf16_t*)(ws + WS_YSLOT)};
            pg8::gemm_phase<EpiSlot, MoeDownSched, true>(lds, FE, S, E);
        }
        if (IN(pd) && (pass + 1 < args.pass_hi || IN(13))) xcd_barrier(bar);
    }
    }

    if (IN(13)) {
        LAS int* tab = (LAS int*)(lds + LDS_MISC + 256);
        __syncthreads();
        if (tid == 0) { int acc = 0; for (int e = 0; e < 8; ++e) { const int c = (int)__hip_atomic_load(ctl + CW_CNT + 64 * e, __ATOMIC_RELAXED, __HIP_MEMORY_SCOPE_AGENT); tab[e] = acc; acc += (c + 255) >> 8; } }
        __syncthreads();
        const int* toke = (const int*)(ws + WS_ROUTE + RT_TOKE); const int* tokr = (const int*)(ws + WS_ROUTE + RT_TOKR); const float* tokw = (const float*)(ws + WS_ROUTE + RT_TOKW);
        const bf16_t* Y = (const bf16_t*)(ws + WS_YSLOT);
        for (int r = gw; r < T; r += NGW) {
            const int e0 = toke[2 * r], e1 = toke[2 * r + 1]; const float w0 = tokw[2 * r], w1 = tokw[2 * r + 1];
            const size_t s0 = (size_t)tab[e0] * 256 + tokr[2 * r], s1 = (size_t)tab[e1] * 256 + tokr[2 * r + 1];
            const f32x4* xr = (const f32x4*)(X + (size_t)r * D) + lane; const u32x2* y0 = (const u32x2*)(Y + s0 * D) + lane; const u32x2* y1 = (const u32x2*)(Y + s1 * D) + lane;
            f32x4 v[4]; float s = 0.f;
#pragma unroll
            for (int j = 0; j < 4; ++j) { v[j] = xr[64 * j]; const u32x2 a = y0[64 * j], b = y1[64 * j];
                v[j][0] += w0 * bflo(a.x) + w1 * bflo(b.x); v[j][1] += w0 * bfhi(a.x) + w1 * bfhi(b.x); v[j][2] += w0 * bflo(a.y) + w1 * bflo(b.y); v[j][3] += w0 * bfhi(a.y) + w1 * bfhi(b.y);
                s += (v[j][0] * v[j][0] + v[j][1] * v[j][1]) + (v[j][2] * v[j][2] + v[j][3] * v[j][3]); }
            const float rs = rstd_of(wave_sum(s));
            const f32x4* gr = (const f32x4*)(args.in[I_NORM_FINAL]) + lane; f32x4* o = (f32x4*)(X + (size_t)r * D) + lane;
#pragma unroll
            for (int j = 0; j < 4; ++j) { const f32x4 g = gr[64 * j]; o[64 * j] = v[j] * rs * g; }
        }
    }
#undef IN
#undef SEAM
}

#ifndef N_LAUNCH_MODE
#define N_LAUNCH_MODE 0
#endif
extern "C" void kernel_launch(void* const* d_in, const int* in_sizes, int n_in, void* d_out, int out_size, void* d_ws, size_t ws_size, hipStream_t stream) {
    static int grid = 0;
    if (grid == 0) {
        if (n_in != N_IN || in_sizes[0] != T * D || out_size != T * D || ws_size < WS_NEED) {
            fprintf(stderr, "kernel_launch: unexpected shapes/workspace: n_in %d in0 %d out %d ws %zu (need %zu)\n", n_in, n_in > 0 ? in_sizes[0] : -1, out_size, ws_size, (size_t)WS_NEED); grid = -1; return; }
        int dev = 0, cus = 0;
        if (hipGetDevice(&dev) != hipSuccess || hipDeviceGetAttribute(&cus, hipDeviceAttributeMultiprocessorCount, dev) != hipSuccess) { grid = -1; return; }
        bool ok = true;
#define SETATTR(K) ok = ok && (hipFuncSetAttribute((const void*)K, hipFuncAttributeMaxDynamicSharedMemorySize, LDS_BYTES) == hipSuccess)
#if N_LAUNCH_MODE == 1
        SETATTR((fwd<0, N_PHASES>));
#else
        SETATTR((fwd<0, 1>)); SETATTR((fwd<1, 2>)); SETATTR((fwd<2, 3>)); SETATTR((fwd<3, 4>)); SETATTR((fwd<4, 5>)); SETATTR((fwd<5, 6>)); SETATTR((fwd<6, 7>)); SETATTR((fwd<7, 8>));
        SETATTR((fwd<8, 9>)); SETATTR((fwd<9, 10>)); SETATTR((fwd<10, 11>)); SETATTR((fwd<11, 12>)); SETATTR((fwd<12, 13>)); SETATTR((fwd<13, 14>));
#endif
        if (!ok) { fprintf(stderr, "kernel_launch: hipFuncSetAttribute failed\n"); grid = -1; return; }
        (void)hipGetLastError();
        grid = cus;
    }
    if (grid < 0) return;
    if (hipMemsetAsync((char*)d_ws + WS_CTL, 0, CTL_BYTES, stream) != hipSuccess) return;
    Args a{};
    for (int i = 0; i < N_IN; ++i) a.in[i] = (const float*)d_in[i];
    a.out = (float*)d_out; a.ws = (unsigned char*)d_ws;
#if N_LAUNCH_MODE == 1
    a.ph_lo = 0; a.ph_hi = N_PHASES; a.pass_lo = 0; a.pass_hi = 5;
    hipLaunchKernelGGL((fwd<0, N_PHASES>), dim3(grid), dim3(NTHR), LDS_BYTES, stream, a);
#else
#define LAUNCH1(P) do { a.ph_lo = (P); a.ph_hi = (P) + 1; hipLaunchKernelGGL((fwd<(P), (P) + 1>), dim3(grid), dim3(NTHR), LDS_BYTES, stream, a); } while (0)
    LAUNCH1(0); LAUNCH1(1); LAUNCH1(2); LAUNCH1(3); LAUNCH1(4); LAUNCH1(5); LAUNCH1(6); LAUNCH1(7); LAUNCH1(8); LAUNCH1(9); LAUNCH1(10);
    for (int pass = 0; pass < 5; ++pass) { a.pass_lo = pass; a.pass_hi = pass + 1; LAUNCH1(11); LAUNCH1(12); }
    LAUNCH1(13);
#endif
}
```

```cpp
#include <hip/hip_runtime.h>
#include <cstdio>
#include <cstdint>

#define LAS __attribute__((address_space(3)))
#define GAS __attribute__((address_space(1)))
typedef unsigned short bf16_t;
typedef short bf16x8 __attribute__((ext_vector_type(8)));
typedef short bf16x4 __attribute__((ext_vector_type(4)));
typedef float f32x4 __attribute__((ext_vector_type(4)));
typedef float f32x2 __attribute__((ext_vector_type(2)));
typedef unsigned u32x4 __attribute__((ext_vector_type(4)));
typedef unsigned u32x2 __attribute__((ext_vector_type(2)));

constexpr int NB = 8, SEQ = 4096, T = NB * SEQ, D = 1024, MEML = 256, MROWS = NB * MEML;
constexpr int CS = 768, CM = 256, NH_MEM = 4;
constexpr int S5G = 48, S5J = 16, S5P = 64;
constexpr int RH = 12, RN = 64, SHIFTC = 2560, INB = 2816;
constexpr int FD = 2816, NE = 8, FE = 3584;
constexpr float RMS_EPS = 1e-6f, LNX_EPS = 64e-5f;
constexpr int NWAVES = 8, NTHR = 512;

enum { I_X = 0, I_MEM, I_NORM_MIX, I_NORM_MEM, I_WKV, I_WOUT, I_NORM_FFN, I_NORM_FINAL, I_WINA, I_LAM_RE, I_LAM_IM, I_LOG_DT, I_B_RE, I_B_IM, I_C_RE, I_C_IM,
       I_S5D, I_WGLU, I_BGLU, I_FGATE, I_FUP, I_FDOWN, I_WINB, I_MU, I_W0, I_W2, I_A0, I_A2, I_G2, I_KK, I_KA, I_RK, I_LNXW, I_LNXB, I_WR, I_BR, I_MGATE, I_MUP, I_MDOWN, N_IN };

constexpr size_t MiB = 1u << 20;
constexpr size_t WS_CTL = 0, CTL_BYTES = 2 * MiB;
constexpr size_t WS_HA = 2 * MiB;
constexpr size_t WS_ROUTE = 66 * MiB;
constexpr size_t WS_WOUT1 = 70 * MiB;
constexpr size_t WS_KV = 72 * MiB;
constexpr size_t WS_LORA = 76 * MiB;
constexpr size_t WS_W2T = WS_LORA, WS_A2T = WS_LORA + 96 * 1024, WS_G2T = WS_LORA + 192 * 1024;
constexpr size_t WS_WINA = 78 * MiB, WS_WOUT0 = 80 * MiB, WS_WKV = 82 * MiB  , WS_WGU0 = 84 * MiB  , WS_WD0 = 95 * MiB  ,
                 WS_WINB = 101 * MiB  , WS_MEMN = 107 * MiB  , WS_S5TAB = 115 * MiB  ;
constexpr size_t WS_P0U = 128 * MiB;
constexpr size_t WS_P0Q = 176 * MiB;
constexpr size_t WS_CAT = 192 * MiB;
constexpr size_t WS_ACT0 = 256 * MiB;
constexpr size_t WS_P1 = 256 * MiB;
constexpr size_t WS_RPP = 2 * MiB, WS_RWL = 50 * MiB  , WS_RQP = 128 * MiB, WS_RRP = 432 * MiB, WS_RGA = 480 * MiB, WS_RGB = 78 * MiB;
constexpr size_t WS_WMOE_GU = 70 * MiB;
constexpr size_t WS_WMOE_D = 182 * MiB;
constexpr size_t WS_MACT = 238 * MiB;
constexpr size_t WS_YSLOT = 350 * MiB;
constexpr size_t WS_END = 482 * MiB, WS_NEED = 528 * MiB;
constexpr int CW_BAR = 4096;
constexpr int CW_CNT = 8192;
constexpr size_t CTL_ROWSS = 1 * MiB;
constexpr size_t RT_LIST = 0, RT_LRSTD = 1 * MiB, RT_TOKE = 2 * MiB  , RT_TOKR = 2 * MiB + 256 * 1024, RT_TOKW = 2 * MiB + 512 * 1024;

constexpr int LDS_STAGE = 131072, LDS_BYTES = 147456, LDS_MISC = LDS_BYTES - 1024;

typedef __bf16 bf16v2_t __attribute__((ext_vector_type(2)));
__device__ __forceinline__ unsigned cvt_pk_bf16(float lo, float hi) { const f32x2 v = {lo, hi}; const bf16v2_t b = __builtin_convertvector(v, bf16v2_t); return __builtin_bit_cast(unsigned, b); }
__device__ __forceinline__ float bf2f(unsigned short b) { return __uint_as_float(((unsigned)b) << 16); }
__device__ __forceinline__ float bflo(unsigned w) { return __uint_as_float(w << 16); }
__device__ __forceinline__ float bfhi(unsigned w) { return __uint_as_float(w & 0xffff0000u); }
__device__ __forceinline__ bf16_t f2bf(float f) { return (bf16_t)(cvt_pk_bf16(f, 0.f) & 0xffffu); }
__device__ __forceinline__ float wave_sum(float v) {
#pragma unroll
    for (int o = 1; o < 64; o <<= 1) v += __shfl_xor(v, o);
    return v;
}
__device__ __forceinline__ float sigmoidf_(float x) { return 1.0f / (1.0f + __expf(-x)); }
__device__ __forceinline__ float silu_(float x) { return x / (1.0f + __expf(-x)); }
__device__ __forceinline__ float gelu_tanh_(float x) { const float a = 0.7978845608028654f * (x + 0.044715f * x * x * x); return 0.5f * x * (1.0f + tanhf(a)); }
__device__ __forceinline__ int lane_now() { int l; asm volatile("v_mbcnt_lo_u32_b32 %0, -1, 0\n\tv_mbcnt_hi_u32_b32 %0, -1, %0" : "=v"(l)); return l; }
#define LDS_WAIT() asm volatile("s_waitcnt lgkmcnt(0)" ::: "memory")
#define VM_WAIT() asm volatile("s_waitcnt vmcnt(0)" ::: "memory")

#define XB_TMO      128
#define XB_XCNT(j)  (256  + 64 * (j))
#define XB_XSUB(j)  (1280 + 64 * (j))
#define XB_XGEN(j)  (2304 + 64 * (j))
#define XB_TOP      3328
#define XB_TOPGEN   3392
#define XCD_BAR_WORDS 3456
#define XB_SPIN_CAP (1u << 18)
__device__ __forceinline__ unsigned xb_ld(unsigned* p)              { return __hip_atomic_load(p, __ATOMIC_RELAXED, __HIP_MEMORY_SCOPE_AGENT); }
__device__ __forceinline__ unsigned xb_add(unsigned* p, unsigned v) { return __hip_atomic_fetch_add(p, v, __ATOMIC_RELAXED, __HIP_MEMORY_SCOPE_AGENT); }
__device__ __forceinline__ unsigned xb_xcc_id() { return (unsigned)__builtin_amdgcn_s_getreg((3 << 11) | 20) & 0xFu; }
#define XB_SPIN(cond, bar) do { unsigned _sp = 0; while (cond) { __builtin_amdgcn_s_sleep(1); \
    if ((++_sp & 255u) == 0u) { if (xb_ld(&(bar)[XB_TMO])) break; if (_sp > XB_SPIN_CAP) { atomicAdd(&(bar)[XB_TMO], 1u); break; } } } } while (0)
struct XcdBarrier { unsigned* bar; unsigned x; volatile LAS unsigned* st; };
__device__ __forceinline__ XcdBarrier xcd_barrier_post(unsigned* bar, volatile LAS unsigned* st) {
    XcdBarrier b; b.bar = bar; b.x = xb_xcc_id(); b.st = st;
    if (threadIdx.x == 0) (void)xb_add(&bar[XB_XCNT(b.x)], 1u);
    return b;
}
__device__ __forceinline__ void xcd_barrier_complete(unsigned* bar, unsigned x, unsigned& nloc, unsigned& nx) {
    const unsigned G = gridDim.x * gridDim.y * gridDim.z;
    unsigned sum, cnt, mine, sp = 0u;
    for (;;) {
        sum = 0u; cnt = 0u; mine = 0u;
#pragma unroll
        for (unsigned j = 0; j < 16; ++j) { const unsigned c = xb_ld(&bar[XB_XCNT(j)]); sum += c; cnt += (c > 0u) ? 1u : 0u; mine = (j == x) ? c : mine; }
        if (sum == G) break;
        __builtin_amdgcn_s_sleep(1);
        if ((++sp & 255u) == 0u) { if (xb_ld(&bar[XB_TMO])) break; if (sp > XB_SPIN_CAP) { atomicAdd(&bar[XB_TMO], 1u); break; } }
    }
    nloc = mine > 0u ? mine : 1u; nx = cnt > 0u ? cnt : 1u;
}
__device__ __forceinline__ void xcd_barrier(const XcdBarrier& b) {
    asm volatile("s_waitcnt vmcnt(0)" ::: "memory");
    __syncthreads();
    if (threadIdx.x == 0) {
        unsigned* bar = b.bar;
        __builtin_amdgcn_s_waitcnt(0);
        unsigned nloc = b.st[0], nx = b.st[1];
        if (nloc == 0u) { xcd_barrier_complete(bar, b.x, nloc, nx); b.st[0] = nloc; b.st[1] = nx; }
        const unsigned old = xb_add(&bar[XB_XSUB(b.x)], 1u);
        const unsigned gen = old / nloc;
        if (old + 1u == (gen + 1u) * nloc) {
            __builtin_amdgcn_fence(__ATOMIC_RELEASE, "agent");
            asm volatile("s_waitcnt vmcnt(0)" ::: "memory");
            const unsigned og = xb_add(&bar[XB_TOP], 1u);
            const unsigned tg = og / nx;
            if (og + 1u == (tg + 1u) * nx) xb_add(&bar[XB_TOPGEN], 1u);
            else XB_SPIN(xb_ld(&bar[XB_TOPGEN]) == tg, bar);
            __builtin_amdgcn_fence(__ATOMIC_ACQUIRE, "agent");
            xb_add(&bar[XB_XGEN(b.x)], 1u);
            asm volatile("s_waitcnt vmcnt(0)" ::: "memory");
        } else {
            XB_SPIN(xb_ld(&bar[XB_XGEN(b.x)]) == gen, bar);
            __builtin_amdgcn_fence(__ATOMIC_ACQUIRE, "agent");
            asm volatile("s_waitcnt vmcnt(0)" ::: "memory");
        }
    }
    __syncthreads();
}

namespace pg8 {
constexpr int BM = 256, BK = 64, HALF = 128, HTB = HALF * BK * 2, STAGE_BYTES = 8 * HTB, NXCD = 8, WGM = 8;
__host__ __device__ __forceinline__ int lds_byte(int r, int c) { const int st = (r >> 4) * 2 + (c >> 5), rr = r & 15, cc = c & 31, ob = rr * 64 + cc * 2; return st * 1024 + (ob ^ (((ob >> 9) & 1) << 5)); }
__host__ __device__ __forceinline__ void stage_rc(int b, int& R, int& C) { const int st = b / 1024, sb = b % 1024, swz = sb ^ (((sb >> 9) & 1) << 5); R = (st >> 1) * 16 + swz / 64; C = (st & 1) * 32 + (swz % 64) / 2; }
__host__ __device__ __forceinline__ int perm32(int rho) { const int n = rho >> 4, i = rho & 15; return 8 * (i >> 2) + 4 * n + (i & 3); }

struct Unit { int pm, pn, e, rb; };

struct TileOrder {
    int nM, nN, nwg, G, c;
    __device__ void init(int nM_, int nN_, int G_, int c_) { nM = nM_; nN = nN_; nwg = nM * nN; G = G_; c = c_; }
    __device__ bool tile(int i, int& pm, int& pn) const {
        const long L = (long)i * G + c; if (L >= nwg) return false;
        int wgid = (int)L; { const int q = nwg / NXCD, r = nwg % NXCD, xcd = wgid % NXCD, off = wgid / NXCD; wgid = (xcd < r ? xcd * (q + 1) : r * (q + 1) + (xcd - r) * q) + off; }
        const int nig = WGM * nN, gid = wgid / nig, fm = gid * WGM, gsz = (nM - fm) < WGM ? (nM - fm) : WGM;
        pm = fm + ((wgid % nig) % gsz); pn = (wgid % nig) / gsz; return true;
    }
};
struct DenseSched {
    static constexpr bool GATHER = false;
    TileOrder o; const char* A; const char* Bt; int K;
    __device__ void init(const void* A_, const void* Bt_, int M, int N, int K_, int G, int c) { o.init(M / BM, N / BM, G, c); A = (const char*)A_; Bt = (const char*)Bt_; K = K_; }
    __device__ __forceinline__ bool next(int i, Unit& u) const { u.e = 0; u.rb = 0; return o.tile(i, u.pm, u.pn); }
    __device__ __forceinline__ const char* a_base(const Unit& u) const { return A + (size_t)u.pm * BM * K * 2; }
    __device__ __forceinline__ const char* b_base(const Unit& u) const { return Bt + (size_t)u.pn * BM * K * 2; }
    __device__ __forceinline__ void gather_ids(const Unit&, int, int, int (&)[4]) const {}
};

template <class Epi, class Sched, bool ALIGN_EPI>
__device__ __forceinline__ void gemm_phase(LAS unsigned char* lds, const int K, const Sched& S, const Epi& E) {
    const int lane = lane_now(), wid = __builtin_amdgcn_readfirstlane(threadIdx.x >> 6), tid = wid * 64 + lane, wr = wid >> 2, wc = wid & 3, fr = lane & 15, fq = lane >> 4;
    const int nt = K / BK;
    unsigned voffA[2][2], voffB[2];
#pragma unroll
    for (int i = 0; i < 2; ++i) { int R, C; stage_rc(tid * 16 + i * 8192, R, C); const int Rb = (R & ~31) + perm32(R & 31);
        voffA[0][i] = (unsigned)(R * K + C) * 2u; voffA[1][i] = (unsigned)((R + HALF) * K + C) * 2u; voffB[i] = (unsigned)(Rb * K + C) * 2u; }
    const size_t kstep = (size_t)(BK * 2);
    const size_t hstep = (size_t)HALF * K * 2;
    const unsigned ldsw = (unsigned)wid * 1024u;
    const int aoff = lds_byte(wr * 64 + fr, fq * 8), boff = lds_byte(wc * 32 + fr, fq * 8);
#define PG8_SA(b, h) (((b) * 2 + (h)) * HTB)
#define PG8_SB(b, h) ((4 + (b) * 2 + (h)) * HTB)
#define PG8_STAGE(bufoff, gbase, voff) do { _Pragma("unroll") for (int _i = 0; _i < 2; ++_i) \
        __builtin_amdgcn_global_load_lds((const unsigned*)((const char*)(gbase) + (voff)[_i]), (LAS unsigned*)(lds + (bufoff) + ldsw + _i * 8192), 16, 0, 0); } while (0)
#define PG8_STAGE_A(bufoff, gbase, h) do { if constexpr (Sched::GATHER) { \
        __builtin_amdgcn_global_load_lds((const unsigned*)((const char*)(gbase) + ((voffA[h][0] & 0xffffu) * (unsigned)(K * 2) + (cpk & 0xffffu))), (LAS unsigned*)(lds + (bufoff) + ldsw), 16, 0, 0); \
        __builtin_amdgcn_global_load_lds((const unsigned*)((const char*)(gbase) + ((voffA[h][0] >> 16) * (unsigned)(K * 2) + (cpk >> 16))), (LAS unsigned*)(lds + (bufoff) + ldsw + 8192), 16, 0, 0); \
        } else { PG8_STAGE(bufoff, gbase, voffA[h]); } } while (0)
#define PG8_LDA(dst, b, h) do { _Pragma("unroll") for (int m = 0; m < 4; ++m) _Pragma("unroll") for (int k = 0; k < 2; ++k) dst[m][k] = *(const LAS bf16x8*)(lds + PG8_SA(b, h) + aoff + m * 2048 + k * 1024); } while (0)
#define PG8_LDB(dst, b, h) do { _Pragma("unroll") for (int n = 0; n < 2; ++n) _Pragma("unroll") for (int k = 0; k < 2; ++k) dst[n][k] = *(const LAS bf16x8*)(lds + PG8_SB(b, h) + boff + n * 2048 + k * 1024); } while (0)
#define PG8_MMA(ai, bj, At, Bt) do { __builtin_amdgcn_s_setprio(1); _Pragma("unroll") for (int m = 0; m < 4; ++m) _Pragma("unroll") for (int n = 0; n < 2; ++n) _Pragma("unroll") for (int k = 0; k < 2; ++k) \
        acc[ai][bj][m][n] = __builtin_amdgcn_mfma_f32_16x16x32_bf16(Bt[n][k], At[m][k], acc[ai][bj][m][n], 0, 0, 0); __builtin_amdgcn_s_setprio(0); } while (0)
#define PG8_WAIT_V(n) asm volatile("s_waitcnt vmcnt(" #n ")" ::: "memory")
#define PG8_WAIT_L(n) asm volatile("s_waitcnt lgkmcnt(" #n ")" ::: "memory")
#define PG8_BAR __builtin_amdgcn_s_barrier()
#define PG8_SCHED __builtin_amdgcn_sched_barrier(0)
    Unit cur, nxt; int ui = 0;
    if (!S.next(0, cur)) return;
    unsigned cpk = 0u;
    if constexpr (Sched::GATHER) { int ids[4]; int R0, C0, R1, C1; stage_rc(tid * 16, R0, C0); stage_rc(tid * 16 + 8192, R1, C1); S.gather_ids(cur, R0, R1, ids);
        cpk = (unsigned)(C0 * 2) | ((unsigned)(C1 * 2) << 16);
#pragma unroll
        for (int h = 0; h < 2; ++h) voffA[h][0] = (unsigned)ids[h * 2 + 0] | ((unsigned)ids[h * 2 + 1] << 16); }
    f32x4 acc[2][2][4][2];
#pragma unroll
    for (int a = 0; a < 2; ++a)
#pragma unroll
        for (int b = 0; b < 2; ++b)
#pragma unroll
            for (int m = 0; m < 4; ++m)
#pragma unroll
                for (int n = 0; n < 2; ++n) acc[a][b][m][n] = (f32x4){0.f, 0.f, 0.f, 0.f};
    bf16x8 At[4][2], B0[2][2], B1[2][2];
    const char* cA = S.a_base(cur); const char* cB = S.b_base(cur);
    PG8_STAGE(PG8_SB(0, 0), cB, voffB); PG8_STAGE(PG8_SB(0, 1), cB + hstep, voffB); PG8_STAGE_A(PG8_SA(0, 0), cA, 0); PG8_STAGE_A(PG8_SA(0, 1), cA, 1);
    if (wr == 1) PG8_BAR;
    PG8_WAIT_V(2); PG8_BAR;
    PG8_STAGE(PG8_SB(1, 0), cB + kstep, voffB); PG8_STAGE_A(PG8_SA(1, 0), cA + kstep, 0); PG8_STAGE(PG8_SB(1, 1), cB + hstep + kstep, voffB);
    PG8_WAIT_V(6); PG8_BAR;
    for (;;) {
        const bool has_next = S.next(ui + 1, nxt);
        const char* nA = has_next ? S.a_base(nxt) : cA; const char* nB = has_next ? S.b_base(nxt) : cB;
        unsigned voffN[2] = {0u, 0u};
        for (int t = 0; t < nt; t += 2) {
            const bool last = (t == nt - 2);
            const char* a1 = cA + (size_t)(t + 1) * kstep;
            const char* a2 = last ? nA : cA + (size_t)(t + 2) * kstep; const char* b2 = last ? nB : cB + (size_t)(t + 2) * kstep;
            const char* a3 = a2 + kstep; const char* b3 = b2 + kstep;
            if constexpr (Sched::GATHER) { if (t == nt - 4 && has_next) { int ids[4]; int R0, C0, R1, C1; const int tid2 = wid * 64 + lane_now(); stage_rc(tid2 * 16, R0, C0); stage_rc(tid2 * 16 + 8192, R1, C1); S.gather_ids(nxt, R0, R1, ids);
#pragma unroll
                for (int h = 0; h < 2; ++h) voffN[h] = (unsigned)ids[h * 2 + 0] | ((unsigned)ids[h * 2 + 1] << 16); } }
            PG8_LDB(B0, 0, 0); PG8_LDB(B1, 0, 1); PG8_SCHED; PG8_LDA(At, 0, 0); PG8_STAGE_A(PG8_SA(1, 1), a1, 1);
            if constexpr (Sched::GATHER) { if (last && has_next) { voffA[0][0] = voffN[0]; voffA[1][0] = voffN[1]; } }
            PG8_WAIT_V(8); PG8_WAIT_L(0); PG8_BAR; PG8_MMA(0, 0, At, B0); PG8_MMA(0, 1, At, B1); PG8_BAR; PG8_SCHED;
            PG8_LDA(At, 0, 1); PG8_STAGE(PG8_SB(0, 0), b2, voffB); PG8_STAGE(PG8_SB(0, 1), b2 + hstep, voffB); PG8_STAGE_A(PG8_SA(0, 0), a2, 0);
            PG8_WAIT_V(8); PG8_WAIT_L(0); PG8_BAR; PG8_MMA(1, 0, At, B0); PG8_MMA(1, 1, At, B1); PG8_BAR; PG8_SCHED;
            PG8_LDB(B0, 1, 0); PG8_LDB(B1, 1, 1); PG8_SCHED; PG8_LDA(At, 1, 0); PG8_STAGE_A(PG8_SA(0, 1), a2, 1);
            PG8_WAIT_V(8); PG8_WAIT_L(0); PG8_BAR; PG8_MMA(0, 0, At, B0); PG8_MMA(0, 1, At, B1); PG8_BAR; PG8_SCHED;
            PG8_LDA(At, 1, 1); PG8_STAGE(PG8_SB(1, 0), b3, voffB); PG8_STAGE(PG8_SB(1, 1), b3 + hstep, voffB); PG8_STAGE_A(PG8_SA(1, 0), a3, 0);
            PG8_WAIT_V(8); PG8_WAIT_L(0); PG8_BAR; PG8_MMA(1, 0, At, B0); PG8_MMA(1, 1, At, B1); PG8_BAR; PG8_SCHED;
        }
        if constexpr (ALIGN_EPI) { if (wr == 0) PG8_BAR; }
        E(acc, cur, wr, wc, fr, fq);
        if (!has_next) break;
#pragma unroll
        for (int a = 0; a < 2; ++a)
#pragma unroll
            for (int b = 0; b < 2; ++b)
#pragma unroll
                for (int m = 0; m < 4; ++m)
#pragma unroll
                    for (int n = 0; n < 2; ++n) acc[a][b][m][n] = (f32x4){0.f, 0.f, 0.f, 0.f};
        cur = nxt; cA = nA; cB = nB; ++ui;
        if constexpr (ALIGN_EPI) { if (wr == 1) PG8_BAR; }
    }
    PG8_WAIT_V(0);
    if constexpr (!ALIGN_EPI) { if (wr == 0) PG8_BAR; }
    PG8_BAR;
#undef PG8_SA
#undef PG8_SB
#undef PG8_STAGE
#undef PG8_STAGE_A
#undef PG8_LDA
#undef PG8_LDB
#undef PG8_MMA
#undef PG8_WAIT_V
#undef PG8_WAIT_L
#undef PG8_BAR
#undef PG8_SCHED
}
}
using pg8::Unit;

__device__ __forceinline__ float rstd_of(float ss) { return 1.0f / sqrtf(ss * (1.0f / D) + RMS_EPS); }
typedef unsigned long long rss_t;
__device__ __forceinline__ float rstd_fx(rss_t s) { return rstd_of((float)((double)s * (1.0 / 16777216.0))); }
__device__ __forceinline__ rss_t rss_fx(float ss) { return (rss_t)__float2ull_rn(ss * 16777216.0f); }

struct EpiInA {
    bf16_t* U; bf16_t* Q; const rss_t* rowss;
    __device__ __forceinline__ void operator()(const f32x4 (&acc)[2][2][4][2], const Unit& u, int wr, int wc, int fr, int fq) const {
        const int row0 = u.pm * 256 + wr * 64 + fr, col0 = u.pn * 256 + wc * 32 + 8 * fq;
#pragma unroll
        for (int ai = 0; ai < 2; ++ai)
#pragma unroll
            for (int m = 0; m < 4; ++m) { const int row = row0 + ai * 128 + m * 16; const float rs = rstd_fx(rowss[row]);
#pragma unroll
                for (int bj = 0; bj < 2; ++bj) { const int c = col0 + bj * 128; const f32x4 v0 = acc[ai][bj][m][0] * rs, v1 = acc[ai][bj][m][1] * rs;
                    u32x4 w; w.x = cvt_pk_bf16(v0[0], v0[1]); w.y = cvt_pk_bf16(v0[2], v0[3]); w.z = cvt_pk_bf16(v1[0], v1[1]); w.w = cvt_pk_bf16(v1[2], v1[3]);
                    if (c < CS) { const int g = c >> 4, hf = (c >> 3) & 1, b = row >> 12, t = row & 4095; *(u32x4*)(U + (((size_t)(b * S5G + g) * SEQ + t) * 16 + 8 * hf)) = w; }
                    else *(u32x4*)(Q + (size_t)row * CM + (c - CS)) = w; } }
    }
};
struct EpiBf16 {
    bf16_t* O; int ldc; const rss_t* rowss; bf16_t* Q; int qcol0;
    __device__ __forceinline__ void operator()(const f32x4 (&acc)[2][2][4][2], const Unit& u, int wr, int wc, int fr, int fq) const {
        const int row0 = u.pm * 256 + wr * 64 + fr, col0 = u.pn * 256 + wc * 32 + 8 * fq;
#pragma unroll
        for (int ai = 0; ai < 2; ++ai)
#pragma unroll
            for (int m = 0; m < 4; ++m) { const int row = row0 + ai * 128 + m * 16; const float rs = rowss ? rstd_fx(rowss[row]) : 1.0f;
#pragma unroll
                for (int bj = 0; bj < 2; ++bj) { const int c = col0 + bj * 128; const f32x4 v0 = acc[ai][bj][m][0] * rs, v1 = acc[ai][bj][m][1] * rs;
                    u32x4 w; w.x = cvt_pk_bf16(v0[0], v0[1]); w.y = cvt_pk_bf16(v0[2], v0[3]); w.z = cvt_pk_bf16(v1[0], v1[1]); w.w = cvt_pk_bf16(v1[2], v1[3]);
                    if (Q && c >= qcol0) *(u32x4*)(Q + (size_t)row * CM + (c - qcol0)) = w;
                    else *(u32x4*)(O + (size_t)row * ldc + c) = w; } }
    }
};
struct EpiRes {
    const float* Xin; float* Xout; bf16_t* H; rss_t* rowss;
    __device__ __forceinline__ void operator()(const f32x4 (&acc)[2][2][4][2], const Unit& u, int wr, int wc, int fr, int fq) const {
        const int row0 = u.pm * 256 + wr * 64 + fr, col0 = u.pn * 256 + wc * 32 + 8 * fq;
#pragma unroll
        for (int ai = 0; ai < 2; ++ai)
#pragma unroll
            for (int m = 0; m < 4; ++m) { const int row = row0 + ai * 128 + m * 16; float ss = 0.f;
#pragma unroll
                for (int bj = 0; bj < 2; ++bj) { const size_t o = (size_t)row * D + col0 + bj * 128;
                    const f32x4 x0 = *(const f32x4*)(Xin + o), x1 = *(const f32x4*)(Xin + o + 4);
                    const f32x4 v0 = acc[ai][bj][m][0] + x0, v1 = acc[ai][bj][m][1] + x1;
                    *(f32x4*)(Xout + o) = v0; *(f32x4*)(Xout + o + 4) = v1;
                    u32x4 w; w.x = cvt_pk_bf16(v0[0], v0[1]); w.y = cvt_pk_bf16(v0[2], v0[3]); w.z = cvt_pk_bf16(v1[0], v1[1]); w.w = cvt_pk_bf16(v1[2], v1[3]);
                    *(u32x4*)(H + o) = w;
                    ss += (v0[0] * v0[0] + v0[1] * v0[1]) + (v0[2] * v0[2] + v0[3] * v0[3]) + (v1[0] * v1[0] + v1[1] * v1[1]) + (v1[2] * v1[2] + v1[3] * v1[3]); }
                ss += __shfl_xor(ss, 16); ss += __shfl_xor(ss, 32);
                if (fq == 0) atomicAdd(rowss + row, rss_fx(ss));
                asm volatile("" ::: "memory"); }
    }
};
struct EpiSwiglu {
    bf16_t* O; int ldo; const rss_t* rowss; const float* rsv;
    __device__ __forceinline__ void operator()(const f32x4 (&acc)[2][2][4][2], const Unit& u, int wr, int wc, int fr, int fq) const {
        const int lrow0 = wr * 64 + fr, col0 = u.pn * 128 + wc * 32 + 8 * fq;
#pragma unroll
        for (int ai = 0; ai < 2; ++ai)
#pragma unroll
            for (int m = 0; m < 4; ++m) { const int lrow = lrow0 + ai * 128 + m * 16;
                float rs; size_t orow;
                if (rsv) { rs = rsv[u.rb + lrow]; orow = (size_t)u.e + lrow; } else { const int row = u.pm * 256 + lrow; rs = rstd_fx(rowss[row]); orow = row; }
                const f32x4 g0 = acc[ai][0][m][0] * rs, g1 = acc[ai][0][m][1] * rs, u0 = acc[ai][1][m][0] * rs, u1 = acc[ai][1][m][1] * rs;
                u32x4 w; w.x = cvt_pk_bf16(silu_(g0[0]) * u0[0], silu_(g0[1]) * u0[1]); w.y = cvt_pk_bf16(silu_(g0[2]) * u0[2], silu_(g0[3]) * u0[3]);
                w.z = cvt_pk_bf16(silu_(g1[0]) * u1[0], silu_(g1[1]) * u1[1]); w.w = cvt_pk_bf16(silu_(g1[2]) * u1[2], silu_(g1[3]) * u1[3]);
                *(u32x4*)(O + orow * ldo + col0) = w; }
    }
};
struct EpiSlot {
    bf16_t* O;
    __device__ __forceinline__ void operator()(const f32x4 (&acc)[2][2][4][2], const Unit& u, int wr, int wc, int fr, int fq) const {
        const int lrow0 = wr * 64 + fr, col0 = u.pn * 256 + wc * 32 + 8 * fq;
#pragma unroll
        for (int ai = 0; ai < 2; ++ai)
#pragma unroll
            for (int m = 0; m < 4; ++m) { const size_t orow = (size_t)u.e + lrow0 + ai * 128 + m * 16;
#pragma unroll
                for (int bj = 0; bj < 2; ++bj) { const f32x4 v0 = acc[ai][bj][m][0], v1 = acc[ai][bj][m][1];
                    u32x4 w; w.x = cvt_pk_bf16(v0[0], v0[1]); w.y = cvt_pk_bf16(v0[2], v0[3]); w.z = cvt_pk_bf16(v1[0], v1[1]); w.w = cvt_pk_bf16(v1[2], v1[3]);
                    *(u32x4*)(O + orow * D + col0 + bj * 128) = w; } }
    }
};

struct MoeGuSched {
    static constexpr bool GATHER = true;
    pg8::TileOrder o; const char* A; const char* W; const int* list; const LAS int* tab; int tile0;
    __device__ __forceinline__ bool next(int i, Unit& u) const {
        if (!o.tile(i, u.pm, u.pn)) return false;
        const int gt = tile0 + u.pm; int e = 0;
#pragma unroll
        for (int k = 1; k < 8; ++k) e += (gt >= tab[k]) ? 1 : 0;
        e = __builtin_amdgcn_readfirstlane(e);
        u.rb = __builtin_amdgcn_readfirstlane(e * 32768 + (gt - tab[e]) * 256); u.e = u.pm * 256; return true;
    }
    __device__ __forceinline__ const char* a_base(const Unit&) const { return A; }
    __device__ __forceinline__ const char* b_base(const Unit& u) const { return W + ((size_t)(u.rb >> 15) * (2 * FE) + (size_t)u.pn * 256) * (D * 2); }
    __device__ __forceinline__ void gather_ids(const Unit& u, int R0, int R1, int (&ids)[4]) const {
        const int e = u.rb >> 15, rank0 = u.rb & 32767, cnt = __builtin_amdgcn_readfirstlane(tab[16 + e]);
#pragma unroll
        for (int h = 0; h < 2; ++h) { const int r0 = R0 + 128 * h, r1 = R1 + 128 * h;
            ids[h * 2 + 0] = (rank0 + r0 < cnt) ? list[u.rb + r0] : 0; ids[h * 2 + 1] = (rank0 + r1 < cnt) ? list[u.rb + r1] : 0; }
    }
};
struct MoeDownSched {
    static constexpr bool GATHER = false;
    pg8::TileOrder o; const char* A; const char* W; const LAS int* tab; int tile0;
    __device__ __forceinline__ bool next(int i, Unit& u) const {
        if (!o.tile(i, u.pm, u.pn)) return false;
        const int gt = tile0 + u.pm; int e = 0;
#pragma unroll
        for (int k = 1; k < 8; ++k) e += (gt >= tab[k]) ? 1 : 0;
        u.rb = __builtin_amdgcn_readfirstlane(e); u.e = gt * 256; return true;
    }
    __device__ __forceinline__ const char* a_base(const Unit& u) const { return A + (size_t)u.pm * 256 * (FE * 2); }
    __device__ __forceinline__ const char* b_base(const Unit& u) const { return W + ((size_t)u.rb * D + (size_t)u.pn * 256) * (FE * 2); }
    __device__ __forceinline__ void gather_ids(const Unit&, int, int, int (&)[4]) const {}
};

__device__ __forceinline__ void tr_item(const float* W, int K, int N, bf16_t* WT, const float* gain, int mode, LAS float* scr, int item, int lane) {
    const int nblk = N / 32, kb = item / nblk, nb = item % nblk, k0 = 64 * kb, n0 = 32 * nb;
#pragma unroll 8
    for (int i = 0; i < 32; ++i) { const int kk = 2 * i + (lane >> 5); float v = W[(size_t)(k0 + kk) * N + n0 + (lane & 31)]; if (gain) v *= gain[k0 + kk]; scr[kk * 33 + (lane & 31)] = v; }
    LDS_WAIT(); asm volatile("" ::: "memory");
    const int c = lane & 7;
#pragma unroll
    for (int j = 0; j < 4; ++j) { const int n = (lane >> 3) + 8 * j; const LAS float* s = scr + (8 * c) * 33 + n;
        u32x4 o; o.x = cvt_pk_bf16(s[0 * 33], s[1 * 33]); o.y = cvt_pk_bf16(s[2 * 33], s[3 * 33]); o.z = cvt_pk_bf16(s[4 * 33], s[5 * 33]); o.w = cvt_pk_bf16(s[6 * 33], s[7 * 33]);
        const int nn = n0 + n; const int row = (mode == 0) ? nn : (((nn >> 7) << 8) + (nn & 127) + (mode == 2 ? 128 : 0));
        *(u32x4*)(WT + (size_t)row * K + k0 + 8 * c) = o; }
    LDS_WAIT(); asm volatile("" ::: "memory");
}
struct TrJob { const float* W; bf16_t* WT; const float* gain; int K, N, mode, items; };


struct Args { const float* in[N_IN]; float* out; unsigned char* ws; int ph_lo, ph_hi, pass_lo, pass_hi; };

__device__ __forceinline__ void attn_naive(LAS unsigned char* lds, const bf16_t* Q, const bf16_t* KV, bf16_t* CAT, int bx, int G, int tid) {
    LAS float* Ks = (LAS float*)lds; LAS float* Vs = Ks + 256 * 64;
    for (int item = bx; item < NB * NH_MEM * 8; item += G) {
        const int b = item >> 5, h = (item >> 3) & 3, qb = item & 7;
#pragma unroll 4
        for (int i = 0; i < 32; ++i) { const int idx = tid + 512 * i, m = idx >> 6, d = idx & 63;
            const bf16_t* kr = KV + (size_t)(b * MEML + m) * 512 + h * 64 + d;
            Ks[idx] = bf2f(kr[0]); Vs[idx] = bf2f(kr[256]); }
        __syncthreads();
        const int row = b * SEQ + qb * 512 + tid;
        float q[64], o[64];
        { const u32x4* qp = (const u32x4*)(Q + (size_t)row * CM + h * 64);
#pragma unroll
          for (int i = 0; i < 8; ++i) { const u32x4 w = qp[i];
              q[8 * i + 0] = bflo(w.x) * 0.125f; q[8 * i + 1] = bfhi(w.x) * 0.125f; q[8 * i + 2] = bflo(w.y) * 0.125f; q[8 * i + 3] = bfhi(w.y) * 0.125f;
              q[8 * i + 4] = bflo(w.z) * 0.125f; q[8 * i + 5] = bfhi(w.z) * 0.125f; q[8 * i + 6] = bflo(w.w) * 0.125f; q[8 * i + 7] = bfhi(w.w) * 0.125f; } }
#pragma unroll
        for (int d = 0; d < 64; ++d) o[d] = 0.f;
        float mx = -1e30f, l = 0.f;
#pragma unroll 1
        for (int key = 0; key < MEML; ++key) {
            const LAS f32x4* kr = (const LAS f32x4*)(Ks + key * 64); float sc = 0.f;
#pragma unroll
            for (int d4 = 0; d4 < 16; ++d4) { const f32x4 kv = kr[d4]; sc += q[4 * d4] * kv[0] + q[4 * d4 + 1] * kv[1] + q[4 * d4 + 2] * kv[2] + q[4 * d4 + 3] * kv[3]; }
            const float mn = fmaxf(mx, sc), alpha = __expf(mx - mn), p = __expf(sc - mn); mx = mn; l = l * alpha + p;
            const LAS f32x4* vr = (const LAS f32x4*)(Vs + key * 64);
#pragma unroll
            for (int d4 = 0; d4 < 16; ++d4) { const f32x4 vv = vr[d4]; o[4 * d4] = o[4 * d4] * alpha + p * vv[0]; o[4 * d4 + 1] = o[4 * d4 + 1] * alpha + p * vv[1]; o[4 * d4 + 2] = o[4 * d4 + 2] * alpha + p * vv[2]; o[4 * d4 + 3] = o[4 * d4 + 3] * alpha + p * vv[3]; }
        }
        const float il = 1.0f / l;
        u32x4* op = (u32x4*)(CAT + (size_t)row * D + CS + h * 64);
#pragma unroll
        for (int i = 0; i < 8; ++i) { u32x4 w; w.x = cvt_pk_bf16(o[8 * i] * il, o[8 * i + 1] * il); w.y = cvt_pk_bf16(o[8 * i + 2] * il, o[8 * i + 3] * il);
            w.z = cvt_pk_bf16(o[8 * i + 4] * il, o[8 * i + 5] * il); w.w = cvt_pk_bf16(o[8 * i + 6] * il, o[8 * i + 7] * il); op[i] = w; }
        __syncthreads();
    }
}

__device__ __forceinline__ void s5_naive(const Args& a, LAS unsigned char* lds, const bf16_t* U, bf16_t* CAT, int bx, int G, int wave, int lane) {
    LAS float* xs = (LAS float*)(lds + wave * 1024);
    for (int it = bx + G * wave; it < NB * S5G; it += G * NWAVES) {
        const int b = it / S5G, g = it % S5G, p = lane;
        const double dt = exp((double)a.in[I_LOG_DT][g]), lr = a.in[I_LAM_RE][g * S5P + p], li = a.in[I_LAM_IM][g * S5P + p];
        const double mag = exp(lr * dt), ang = li * dt, abr_d = mag * cos(ang), abi_d = mag * sin(ang);
        const double nre = abr_d - 1.0, nim = abi_d, den = lr * lr + li * li, zr = (nre * lr + nim * li) / den, zi = (nim * lr - nre * li) / den;
        const float abr = (float)abr_d, abi = (float)abi_d;
        float bbr[16], bbi[16], cre[16], cim[16], wg[16];
#pragma unroll
        for (int j = 0; j < 16; ++j) { const double br = a.in[I_B_RE][(size_t)(g * S5P + p) * 16 + j], bi = a.in[I_B_IM][(size_t)(g * S5P + p) * 16 + j]; bbr[j] = (float)(zr * br - zi * bi); bbi[j] = (float)(zr * bi + zi * br); }
        const int jj = lane & 15, pq = lane >> 4;
#pragma unroll
        for (int q = 0; q < 16; ++q) { cre[q] = a.in[I_C_RE][(size_t)(g * 16 + jj) * S5P + 16 * pq + q]; cim[q] = a.in[I_C_IM][(size_t)(g * 16 + jj) * S5P + 16 * pq + q]; }
#pragma unroll
        for (int j = 0; j < 16; ++j) wg[j] = a.in[I_WGLU][(size_t)(g * 16 + j) * 16 + jj];
        const float dj = a.in[I_S5D][g * 16 + jj], bg = a.in[I_BGLU][g * 16 + jj];
        const bf16_t* up = U + (size_t)(b * S5G + g) * SEQ * 16;
        float xr = 0.f, xi = 0.f;
#pragma unroll 1
        for (int t = 0; t < SEQ; ++t) {
            const u32x4 w0 = *(const u32x4*)(up + (size_t)t * 16), w1 = *(const u32x4*)(up + (size_t)t * 16 + 8);
            float uf[16];
            uf[0] = bflo(w0.x); uf[1] = bfhi(w0.x); uf[2] = bflo(w0.y); uf[3] = bfhi(w0.y); uf[4] = bflo(w0.z); uf[5] = bfhi(w0.z); uf[6] = bflo(w0.w); uf[7] = bfhi(w0.w);
            uf[8] = bflo(w1.x); uf[9] = bfhi(w1.x); uf[10] = bflo(w1.y); uf[11] = bfhi(w1.y); uf[12] = bflo(w1.z); uf[13] = bfhi(w1.z); uf[14] = bflo(w1.w); uf[15] = bfhi(w1.w);
            const float uj = bf2f(up[(size_t)t * 16 + jj]);
            float bur = 0.f, bui = 0.f;
#pragma unroll
            for (int j = 0; j < 16; ++j) { bur += bbr[j] * uf[j]; bui += bbi[j] * uf[j]; }
            const float nxr = abr * xr - abi * xi + bur, nxi = abr * xi + abi * xr + bui; xr = nxr; xi = nxi;
            xs[p] = xr; xs[64 + p] = xi;
            LDS_WAIT(); asm volatile("" ::: "memory");
            float s = 0.f;
#pragma unroll
            for (int q4 = 0; q4 < 4; ++q4) { const f32x4 vr = *(const LAS f32x4*)(xs + 16 * pq + 4 * q4), vi = *(const LAS f32x4*)(xs + 64 + 16 * pq + 4 * q4);
#pragma unroll
                for (int e = 0; e < 4; ++e) s += cre[4 * q4 + e] * vr[e] - cim[4 * q4 + e] * vi[e]; }
            LDS_WAIT(); asm volatile("" ::: "memory");
            s += __shfl_xor(s, 16); s += __shfl_xor(s, 32);
            const float yg = gelu_tanh_(s + dj * uj);
            float z = bg;
#pragma unroll
            for (int j = 0; j < 16; ++j) z += __shfl(yg, j) * wg[j];
            const float o = yg * sigmoidf_(z);
            if (lane < 16) CAT[(size_t)(b * SEQ + t) * D + g * 16 + lane] = f2bf(o);
        }
    }
}

__device__ __forceinline__ void rwkv_prep(const Args& a, LAS unsigned char* lds, const bf16_t* P1, bf16_t* RA, bf16_t* RKK, bf16_t* RLD, bf16_t* RG, int bx, int G, int tid) {
    LAS float* twT = (LAS float*)lds; LAS float* adT = twT + 64 * 16; LAS float* sgT = adT + 64 * 16;
    const float* mu = a.in[I_MU];
    for (int tile = bx; tile < T / 16; tile += G) {
        __syncthreads();
#pragma unroll
        for (int i = 0; i < 8; ++i) { const int idx = tid + 512 * i, tok = idx >> 8, c = idx & 255, row = tile * 16 + tok, t = row & (SEQ - 1);
            const float cur = bf2f(P1[(size_t)row * INB + 2304 + c]), prev = t > 0 ? bf2f(P1[(size_t)(row - 1) * INB + 2304 + c]) : 0.f;
            const float xsv = cur + (prev - cur) * mu[2304 + c];
            if (c < 64) twT[c * 16 + tok] = tanhf(xsv); else if (c < 128) adT[(c - 64) * 16 + tok] = xsv; else sgT[(c - 128) * 16 + tok] = sigmoidf_(xsv); }
        __syncthreads();
        if (tid < 384) {
#pragma unroll 1
            for (int cc = 0; cc < 2; ++cc) { const int c = tid + 384 * cc;
                float aw[16], aa[16], ag[16];
#pragma unroll
                for (int k = 0; k < 16; ++k) { aw[k] = 0.f; aa[k] = 0.f; ag[k] = 0.f; }
#pragma unroll 2
                for (int m = 0; m < 64; ++m) { const float w2v = a.in[I_W2][(size_t)m * CS + c], a2v = a.in[I_A2][(size_t)m * CS + c];
#pragma unroll
                    for (int k4 = 0; k4 < 4; ++k4) { const f32x4 tw = *(const LAS f32x4*)(twT + m * 16 + 4 * k4), ad = *(const LAS f32x4*)(adT + m * 16 + 4 * k4);
#pragma unroll
                        for (int e = 0; e < 4; ++e) { aw[4 * k4 + e] += tw[e] * w2v; aa[4 * k4 + e] += ad[e] * a2v; } } }
#pragma unroll 2
                for (int m = 0; m < 128; ++m) { const float g2v = a.in[I_G2][(size_t)m * CS + c];
#pragma unroll
                    for (int k4 = 0; k4 < 4; ++k4) { const f32x4 sg = *(const LAS f32x4*)(sgT + m * 16 + 4 * k4);
#pragma unroll
                        for (int e = 0; e < 4; ++e) ag[4 * k4 + e] += sg[e] * g2v; } }
                const float w0 = a.in[I_W0][c], a0 = a.in[I_A0][c], kkw = a.in[I_KK][c], muk = mu[CS + c];
#pragma unroll
                for (int k = 0; k < 16; ++k) { const int row = tile * 16 + k, t = row & (SEQ - 1);
                    const float z = -(w0 + aw[k]);
                    const float sp = z > 20.f ? z : log1pf(__expf(z));
                    const float ld = -__expf(-sp - 0.5f);
                    const float av = sigmoidf_(a0 + aa[k]);
                    const float cur = bf2f(P1[(size_t)row * INB + CS + c]), prev = t > 0 ? bf2f(P1[(size_t)(row - 1) * INB + CS + c]) : 0.f;
                    const float kx = (cur + (prev - cur) * muk) * kkw;
                    const float ss = wave_sum(kx * kx);
                    const float kkv = kx / fmaxf(sqrtf(ss), 1e-12f);
                    const size_t o = (size_t)row * CS + c;
                    RA[o] = f2bf(av); RKK[o] = f2bf(kkv); RLD[o] = f2bf(ld); RG[o] = f2bf(ag[k]); }
            }
        }
    }
}

__device__ __forceinline__ void rwkv_naive(const Args& a, LAS unsigned char* lds, const bf16_t* P1, const bf16_t* RA, const bf16_t* RKK, const bf16_t* RLD, const bf16_t* RG, bf16_t* CAT, int bx, int G, int wave, int lane) {
    if (wave != 4) return;
    LAS float* vec = (LAS float*)lds;
    for (int item = bx; item < NB * RH; item += G) {
        const int b = item / RH, h = item % RH, c = h * 64 + lane;
        const float mur = a.in[I_MU][c], muk = a.in[I_MU][CS + c], muv = a.in[I_MU][2 * CS + c], ka = a.in[I_KA][c], rkc = a.in[I_RK][c], lw = a.in[I_LNXW][c], lb = a.in[I_LNXB][c];
        float S[64];
#pragma unroll
        for (int j = 0; j < 64; ++j) S[j] = 0.f;
        float prr = 0.f, prk = 0.f, prv = 0.f;
        const size_t row0 = (size_t)b * SEQ;
        bf16_t n_r = P1[row0 * INB + c], n_k = P1[row0 * INB + CS + c], n_v = P1[row0 * INB + 2 * CS + c], n_a = RA[row0 * CS + c], n_kk = RKK[row0 * CS + c], n_ld = RLD[row0 * CS + c], n_g = RG[row0 * CS + c];
#pragma unroll 1
        for (int t = 0; t < SEQ; ++t) {
            const float pr = bf2f(n_r), pk = bf2f(n_k), pv = bf2f(n_v), av = bf2f(n_a), kkv = bf2f(n_kk), ld = bf2f(n_ld), gv = bf2f(n_g);
            if (t + 1 < SEQ) { const size_t rn = row0 + t + 1; n_r = P1[rn * INB + c]; n_k = P1[rn * INB + CS + c]; n_v = P1[rn * INB + 2 * CS + c]; n_a = RA[rn * CS + c]; n_kk = RKK[rn * CS + c]; n_ld = RLD[rn * CS + c]; n_g = RG[rn * CS + c]; }
            const float r = pr + (prr - pr) * mur, k = pk + (prk - pk) * muk, v = pv + (prv - pv) * muv;
            prr = pr; prk = pk; prv = pv;
            const float kp = k * (1.f + (av - 1.f) * ka), ap = -kkv, bb = kkv * av, w = __expf(ld);
            vec[lane] = r; vec[64 + lane] = w; vec[128 + lane] = kp; vec[192 + lane] = ap; vec[256 + lane] = bb;
            LDS_WAIT(); asm volatile("" ::: "memory");
            float sa = 0.f;
#pragma unroll
            for (int j4 = 0; j4 < 16; ++j4) { const f32x4 x = *(const LAS f32x4*)(vec + 192 + 4 * j4); sa += S[4 * j4] * x[0] + S[4 * j4 + 1] * x[1] + S[4 * j4 + 2] * x[2] + S[4 * j4 + 3] * x[3]; }
            float y = 0.f;
#pragma unroll
            for (int j4 = 0; j4 < 16; ++j4) { const f32x4 wv = *(const LAS f32x4*)(vec + 64 + 4 * j4), bv = *(const LAS f32x4*)(vec + 256 + 4 * j4), kv = *(const LAS f32x4*)(vec + 128 + 4 * j4), rv = *(const LAS f32x4*)(vec + 4 * j4);
#pragma unroll
                for (int e = 0; e < 4; ++e) { const float s = S[4 * j4 + e] * wv[e] + sa * bv[e] + v * kv[e]; S[4 * j4 + e] = s; y += s * rv[e]; } }
            LDS_WAIT(); asm volatile("" ::: "memory");
            const float rkv = wave_sum(r * kp * rkc), bonus = rkv * v;
            const float mean = wave_sum(y) * (1.f / 64.f), dlt = y - mean, var = wave_sum(dlt * dlt) * (1.f / 64.f);
            const float yn = dlt * (1.0f / sqrtf(var + LNX_EPS)) * lw + lb;
            CAT[(row0 + t) * D + c] = f2bf((yn + bonus) * gv);
        }
    }
}

__device__ __forceinline__ void moe_router(const Args& a, const float* X, unsigned* ctl, unsigned char* ws, int gw, int NGW, int lane) {
    int* list = (int*)(ws + WS_ROUTE + RT_LIST); float* lrstd = (float*)(ws + WS_ROUTE + RT_LRSTD);
    int* toke = (int*)(ws + WS_ROUTE + RT_TOKE); int* tokr = (int*)(ws + WS_ROUTE + RT_TOKR); float* tokw = (float*)(ws + WS_ROUTE + RT_TOKW);
    const float* wr = a.in[I_WR]; const f32x4* gr = (const f32x4*)(a.in[I_NORM_FFN] + D) + lane;
    for (int r = gw; r < T; r += NGW) {
        const f32x4* xr = (const f32x4*)(X + (size_t)r * D) + lane; f32x4 v[4]; float s = 0.f;
#pragma unroll
        for (int j = 0; j < 4; ++j) { v[j] = xr[64 * j]; s += (v[j][0] * v[j][0] + v[j][1] * v[j][1]) + (v[j][2] * v[j][2] + v[j][3] * v[j][3]); }
        const float rs = rstd_of(wave_sum(s));
        float lg[8];
#pragma unroll
        for (int e = 0; e < 8; ++e) lg[e] = 0.f;
#pragma unroll
        for (int j = 0; j < 4; ++j) { const f32x4 g = gr[64 * j];
#pragma unroll
            for (int i = 0; i < 4; ++i) { const int k = 4 * (lane + 64 * j) + i; const float hv = v[j][i] * rs * g[i];
                const f32x4 w0 = *(const f32x4*)(wr + (size_t)k * 8), w1 = *(const f32x4*)(wr + (size_t)k * 8 + 4);
                lg[0] += hv * w0[0]; lg[1] += hv * w0[1]; lg[2] += hv * w0[2]; lg[3] += hv * w0[3]; lg[4] += hv * w1[0]; lg[5] += hv * w1[1]; lg[6] += hv * w1[2]; lg[7] += hv * w1[3]; } }
#pragma unroll
        for (int e = 0; e < 8; ++e) lg[e] = wave_sum(lg[e]) + a.in[I_BR][e];
        float bv = lg[0]; int bi = 0;
#pragma unroll
        for (int e = 1; e < 8; ++e) if (lg[e] > bv) { bv = lg[e]; bi = e; }
        float sv = -3.0e38f; int si = 0;
#pragma unroll
        for (int e = 0; e < 8; ++e) if (e != bi && lg[e] > sv) { sv = lg[e]; si = e; }
        const float w0 = 1.0f / (1.0f + __expf(sv - bv)), w1 = 1.0f - w0;
        if (lane == 0) {
            const int r0 = (int)atomicAdd(ctl + CW_CNT + 64 * bi, 1u), r1 = (int)atomicAdd(ctl + CW_CNT + 64 * si, 1u);
            list[bi * 32768 + r0] = r; lrstd[bi * 32768 + r0] = rs; list[si * 32768 + r1] = r; lrstd[si * 32768 + r1] = rs;
            toke[2 * r] = bi; toke[2 * r + 1] = si; tokr[2 * r] = r0; tokr[2 * r + 1] = r1; tokw[2 * r] = w0; tokw[2 * r + 1] = w1;
        }
    }
}

constexpr int RW_LS = 72;
constexpr int RW_SLOT = 64 * RW_LS * 2;
constexpr int RW_FS = 65;
__device__ __forceinline__ LAS unsigned char* rw_slot(LAS unsigned char* lds, int s) { return lds + s * RW_SLOT; }
__device__ __forceinline__ bf16x8 rw_frag(const LAS unsigned char* m, int row, int kq, int ks) { return *(const LAS bf16x8*)(m + row * (RW_LS * 2) + (32 * ks + 8 * kq) * 2); }
__device__ __forceinline__ f32x4 rw_mm(const LAS unsigned char* A, const LAS unsigned char* Bt, int mt, int nt, int l15, int kq, f32x4 acc) {
#pragma unroll
    for (int ks = 0; ks < 2; ++ks) acc = __builtin_amdgcn_mfma_f32_16x16x32_bf16(rw_frag(A, 16 * mt + l15, kq, ks), rw_frag(Bt, 16 * nt + l15, kq, ks), acc, 0, 0, 0);
    return acc;
}
__device__ __forceinline__ void rw_store_T(LAS unsigned char* m, int mt, int nt, int q, int n, f32x4 v) {
    u32x2 w; w.x = cvt_pk_bf16(v[0], v[1]); w.y = cvt_pk_bf16(v[2], v[3]);
    *(LAS u32x2*)(m + (16 * nt + n) * (RW_LS * 2) + (16 * mt + 4 * q) * 2) = w;
}
__device__ __forceinline__ void rw_store_D(LAS unsigned char* m, int mt, int nt, int q, int n, f32x4 v) {
#pragma unroll
    for (int r = 0; r < 4; ++r) *(LAS bf16_t*)(m + (16 * mt + 4 * q + r) * (RW_LS * 2) + (16 * nt + n) * 2) = f2bf(v[r]);
}
__device__ __forceinline__ float rw_ld1(const LAS unsigned char* m, int row, int col) { return bf2f(*(const LAS bf16_t*)(m + row * (RW_LS * 2) + col * 2)); }

#ifdef DBG_RWKV
__device__ __forceinline__ void rw_dbg_scan(LAS unsigned char* lds, int slot, int bit, unsigned* word, int tid) {
    unsigned bad = 0u;
    for (int i = tid; i < 4096; i += NTHR) { const float v = rw_ld1(rw_slot(lds, slot), i >> 6, i & 63); if (!(v - v == 0.f)) bad = 1u; }
    if (bad) atomicOr(word, 1u << bit);
}
#define RW_DBG(slot, bit) rw_dbg_scan(lds, slot, bit, B.dbg, tid)
__device__ __forceinline__ void rw_dbg_max(LAS unsigned char* lds, int slot, unsigned* word, int tid) {
    float m = 0.f;
    for (int i = tid; i < 4096; i += NTHR) { const float v = fabsf(rw_ld1(rw_slot(lds, slot), i >> 6, i & 63)); if (v - v == 0.f) m = fmaxf(m, v); }
    atomicMax(word, __float_as_uint(m));
}
#else
#define RW_DBG(slot, bit)
#endif
struct RwBufs { unsigned* dbg;  bf16_t* Pp; bf16_t* Qp; bf16_t* Rp; float* WL; bf16_t* GA; bf16_t* GB; bf16_t* CAT; const bf16_t* P1; const bf16_t* w2T; const bf16_t* a2T; const bf16_t* g2T; };

__device__ __forceinline__ void rwkv_r1(const Args& a, LAS unsigned char* lds, const RwBufs& B, int bx, int G, int wave, int nitems) {
    const int lane = lane_now(), l15 = lane & 15, kq = lane >> 4, q = kq, n = l15, tid = wave * 64 + lane;
    LAS float* Fw = (LAS float*)lds; LAS float* Fa = Fw + 64 * RW_FS; LAS float* Fg = Fa + 64 * RW_FS;
    LAS float* gsum = (LAS float*)(lds + 15 * RW_SLOT);
    const float* mu = a.in[I_MU];
#pragma unroll 1
    for (int item = bx; item < nitems; item += G) {
        const int b = item / (64 * RH), c = (item / RH) & 63, h = item % RH;
        const size_t row0 = (size_t)b * SEQ + c * 64;
        __syncthreads();
        { const int t = tid >> 3, seg = tid & 7; const size_t row = row0 + t; const bool first = (c == 0 && t == 0);
          const bf16_t* cp = B.P1 + row * INB + 2304 + 32 * seg; const bf16_t* pp = cp - INB;
          LAS unsigned char* dst = rw_slot(lds, 6 + (seg >> 1)) + t * (RW_LS * 2) + (32 * (seg & 1)) * 2;
#pragma unroll
          for (int v8 = 0; v8 < 4; ++v8) { const u32x4 cw = *(const u32x4*)(cp + 8 * v8); u32x4 pw = first ? (u32x4){0u, 0u, 0u, 0u} : *(const u32x4*)(pp + 8 * v8);
              const f32x4 m0 = *(const f32x4*)(mu + 2304 + 32 * seg + 8 * v8), m1 = *(const f32x4*)(mu + 2304 + 32 * seg + 8 * v8 + 4);
              float x[8]; const unsigned cwa[4] = {cw.x, cw.y, cw.z, cw.w}, pwa[4] = {pw.x, pw.y, pw.z, pw.w};
#pragma unroll
              for (int e = 0; e < 4; ++e) { const float c0 = bflo(cwa[e]), c1 = bfhi(cwa[e]), p0 = bflo(pwa[e]), p1 = bfhi(pwa[e]);
                  const float mm0 = (e < 2) ? m0[2 * e] : m1[2 * e - 4], mm1 = (e < 2) ? m0[2 * e + 1] : m1[2 * e - 3];
                  x[2 * e] = c0 + (p0 - c0) * mm0; x[2 * e + 1] = c1 + (p1 - c1) * mm1; }
#pragma unroll
              for (int e = 0; e < 8; ++e) { if (seg < 2) x[e] = tanhf(x[e]); else if (seg >= 4) x[e] = sigmoidf_(x[e]); }
              u32x4 o; o.x = cvt_pk_bf16(x[0], x[1]); o.y = cvt_pk_bf16(x[2], x[3]); o.z = cvt_pk_bf16(x[4], x[5]); o.w = cvt_pk_bf16(x[6], x[7]);
              *(LAS u32x4*)(dst + 16 * v8) = o; } }
        __syncthreads();
#pragma unroll 1
        for (int ti = wave; ti < 48; ti += 8) { const int mat = ti >> 4, mt = (ti >> 2) & 3, nt = ti & 3; f32x4 acc = {0.f, 0.f, 0.f, 0.f};
            if (mat < 2) { const LAS unsigned char* X = rw_slot(lds, 6 + mat); const bf16_t* Wt = (mat == 0 ? B.w2T : B.a2T) + (size_t)(h * 64 + 16 * nt + l15) * 64;
#pragma unroll
                for (int ks = 0; ks < 2; ++ks) acc = __builtin_amdgcn_mfma_f32_16x16x32_bf16(rw_frag(X, 16 * mt + l15, kq, ks), *(const bf16x8*)(Wt + 32 * ks + 8 * kq), acc, 0, 0, 0);
            } else { const bf16_t* Wt = B.g2T + (size_t)(h * 64 + 16 * nt + l15) * 128;
#pragma unroll
                for (int ks = 0; ks < 4; ++ks) acc = __builtin_amdgcn_mfma_f32_16x16x32_bf16(rw_frag(rw_slot(lds, 8 + (ks >> 1)), 16 * mt + l15, kq, ks & 1), *(const bf16x8*)(Wt + 32 * ks + 8 * kq), acc, 0, 0, 0); }
            LAS float* F = (mat == 0) ? Fw : (mat == 1 ? Fa : Fg);
#pragma unroll
            for (int r = 0; r < 4; ++r) F[(16 * mt + 4 * q + r) * RW_FS + 16 * nt + n] = acc[r]; }
        __syncthreads();
        {   const int j = lane, cg = h * 64 + j, t0 = 8 * wave;
            const float w0 = a.in[I_W0][cg], a0 = a.in[I_A0][cg], kkw = a.in[I_KK][cg], kaw = a.in[I_KA][cg], rkw = a.in[I_RK][cg], lxw = a.in[I_LNXW][cg], lxb = a.in[I_LNXB][cg];
            const float mur = mu[cg], muk = mu[CS + cg], muv = mu[2 * CS + cg];
            float ldv[8], av[8], rv[8], kv[8], vv[8], kkv[8];
            const bf16_t* pr = B.P1 + (row0 + t0) * INB + cg;
            float pr_r, pr_k, pr_v;
            if (c == 0 && wave == 0) { pr_r = 0.f; pr_k = 0.f; pr_v = 0.f; } else { pr_r = bf2f(pr[-INB]); pr_k = bf2f(pr[-INB + CS]); pr_v = bf2f(pr[-INB + 2 * CS]); }
#pragma unroll
            for (int u = 0; u < 8; ++u) { const float cr = bf2f(pr[(size_t)u * INB]), ck = bf2f(pr[(size_t)u * INB + CS]), cv = bf2f(pr[(size_t)u * INB + 2 * CS]);
                rv[u] = cr + (pr_r - cr) * mur; kv[u] = ck + (pr_k - ck) * muk; vv[u] = cv + (pr_v - cv) * muv; pr_r = cr; pr_k = ck; pr_v = cv;
                const float z = -(w0 + Fw[(t0 + u) * RW_FS + j]); const float sp = z > 20.f ? z : log1pf(__expf(z));
                ldv[u] = -__expf(-sp - 0.5f);
                av[u] = sigmoidf_(a0 + Fa[(t0 + u) * RW_FS + j]);
                const float kx = kv[u] * kkw; const float ss = wave_sum(kx * kx); kkv[u] = kx / fmaxf(sqrtf(ss), 1e-12f); }
            float lw[8]; lw[0] = ldv[0];
#pragma unroll
            for (int u = 1; u < 8; ++u) lw[u] = lw[u - 1] + ldv[u];
            gsum[wave * 64 + j] = lw[7];
            __syncthreads();
            float off = 0.f, tot = 0.f;
#pragma unroll
            for (int w8 = 0; w8 < 8; ++w8) { const float gs = gsum[w8 * 64 + j]; tot += gs; if (w8 < wave) off += gs; }
            if (wave == 0) B.WL[(size_t)item * 64 + j] = __expf(tot);
            u32x4 oAt, oBh, oKh, oV; unsigned* pAt = (unsigned*)&oAt; unsigned* pBh = (unsigned*)&oBh; unsigned* pKh = (unsigned*)&oKh; unsigned* pV = (unsigned*)&oV;
            float ga[8], gb[8];
            float tAt[8], tBh[8], tKh[8];
#pragma unroll
            for (int u = 0; u < 8; ++u) { const float lwt = off + lw[u];
                const float kp = kv[u] * (1.f + (av[u] - 1.f) * kaw), ap = -kkv[u], bb = kkv[u] * av[u];
                const float Wt = __expf(lwt), Wm1 = __expf(lwt - ldv[u]), iW = __expf(-lwt), WLr = __expf(tot - lwt);
                const float bonus = wave_sum(rv[u] * kp * rkw);
                const float gv = Fg[(t0 + u) * RW_FS + j];
                ga[u] = lxw * gv; gb[u] = (lxb + bonus * vv[u]) * gv;
                const int t = t0 + u;
                *(LAS bf16_t*)(rw_slot(lds, 10) + t * (RW_LS * 2) + j * 2) = f2bf(ap * Wm1);
                *(LAS bf16_t*)(rw_slot(lds, 11) + t * (RW_LS * 2) + j * 2) = f2bf(bb * iW);
                *(LAS bf16_t*)(rw_slot(lds, 12) + t * (RW_LS * 2) + j * 2) = f2bf(kp * iW);
                *(LAS bf16_t*)(rw_slot(lds, 13) + t * (RW_LS * 2) + j * 2) = f2bf(rv[u] * Wt);
                tAt[u] = ap * Wm1; tBh[u] = bb * WLr; tKh[u] = kp * WLr; }
#pragma unroll
            for (int u2 = 0; u2 < 4; ++u2) { pAt[u2] = cvt_pk_bf16(tAt[2 * u2], tAt[2 * u2 + 1]); pBh[u2] = cvt_pk_bf16(tBh[2 * u2], tBh[2 * u2 + 1]); pKh[u2] = cvt_pk_bf16(tKh[2 * u2], tKh[2 * u2 + 1]); pV[u2] = cvt_pk_bf16(vv[2 * u2], vv[2 * u2 + 1]); }
            *(LAS u32x4*)(rw_slot(lds, 14) + j * (RW_LS * 2) + t0 * 2) = oAt;
            *(LAS u32x4*)(rw_slot(lds, 6) + j * (RW_LS * 2) + t0 * 2) = oBh;
            *(LAS u32x4*)(rw_slot(lds, 7) + j * (RW_LS * 2) + t0 * 2) = oKh;
            *(LAS u32x4*)(rw_slot(lds, 8) + j * (RW_LS * 2) + t0 * 2) = oV;
            { bf16_t* gap = B.GA + (size_t)item * 4096 + j * 64; bf16_t* gbp = B.GB + (size_t)item * 4096 + j * 64;
#pragma unroll
              for (int hh = 0; hh < 2; ++hh) { const int pos = (2 * (wave & 1) + hh) * 16 + (wave >> 1) * 4;
                  u32x2 wa, wb; wa.x = cvt_pk_bf16(ga[4 * hh], ga[4 * hh + 1]); wa.y = cvt_pk_bf16(ga[4 * hh + 2], ga[4 * hh + 3]); wb.x = cvt_pk_bf16(gb[4 * hh], gb[4 * hh + 1]); wb.y = cvt_pk_bf16(gb[4 * hh + 2], gb[4 * hh + 3]);
                  *(u32x2*)(gap + pos) = wa; *(u32x2*)(gbp + pos) = wb; } }
        }
        __syncthreads();
        RW_DBG(10, 0); RW_DBG(11, 1); RW_DBG(12, 2); RW_DBG(13, 3); RW_DBG(14, 4); RW_DBG(6, 5); RW_DBG(7, 6); RW_DBG(8, 7);
#pragma unroll 1
        for (int ti = wave; ti < 64; ti += 8) { const int prod = ti >> 4, mt = (ti >> 2) & 3, nt = ti & 3; f32x4 acc = {0.f, 0.f, 0.f, 0.f};
            const int sa = (prod == 0) ? 10 : (prod == 2 ? 11 : 12), sb = (prod == 0) ? 11 : (prod == 1 ? 10 : 13);
            const bool need = (prod == 0) ? (mt >= nt) : (mt <= nt);
            if (need) acc = rw_mm(rw_slot(lds, sa), rw_slot(lds, sb), mt, nt, l15, kq, acc);
#pragma unroll
            for (int r = 0; r < 4; ++r) { const int row = 16 * mt + 4 * q + r, col = 16 * nt + n;
                const bool keep = (prod == 0) ? (col < row) : ((prod == 1) ? (row < col) : (row <= col));
                if (!keep) acc[r] = 0.f; }
            rw_store_T(rw_slot(lds, prod), mt, nt, q, n, acc); }
        for (int i = tid; i < 2 * RW_SLOT / 16; i += NTHR) *(LAS u32x4*)(rw_slot(lds, 4) + i * 16) = (u32x4){0u, 0u, 0u, 0u};
        __syncthreads();
        RW_DBG(0, 8); RW_DBG(1, 9); RW_DBG(2, 10); RW_DBG(3, 11);
#ifdef DBG_RWKV
        rw_dbg_max(lds, DBG_MAXSLOT_A, B.dbg + 1, tid);
#endif
        if (wave < 4 && lane < 16) { const int i0 = 16 * wave, cc = lane; float Tc[16];
            const LAS unsigned char* AT = rw_slot(lds, 0);
#pragma unroll
            for (int t = 0; t < 16; ++t) { float s = (t == cc) ? 1.f : 0.f;
#pragma unroll
                for (int s2 = 0; s2 < t; ++s2) s += rw_ld1(AT, i0 + s2, i0 + t) * Tc[s2];
                Tc[t] = s; }
#pragma unroll
            for (int t = 0; t < 16; ++t) *(LAS bf16_t*)(rw_slot(lds, 4) + (i0 + t) * (RW_LS * 2) + (i0 + cc) * 2) = f2bf(Tc[t]);
            u32x4 o0, o1; o0.x = cvt_pk_bf16(Tc[0], Tc[1]); o0.y = cvt_pk_bf16(Tc[2], Tc[3]); o0.z = cvt_pk_bf16(Tc[4], Tc[5]); o0.w = cvt_pk_bf16(Tc[6], Tc[7]);
            o1.x = cvt_pk_bf16(Tc[8], Tc[9]); o1.y = cvt_pk_bf16(Tc[10], Tc[11]); o1.z = cvt_pk_bf16(Tc[12], Tc[13]); o1.w = cvt_pk_bf16(Tc[14], Tc[15]);
            *(LAS u32x4*)(rw_slot(lds, 5) + (i0 + cc) * (RW_LS * 2) + i0 * 2) = o0; *(LAS u32x4*)(rw_slot(lds, 5) + (i0 + cc) * (RW_LS * 2) + (i0 + 8) * 2) = o1;
            LDS_WAIT();
            *(LAS u32x4*)(rw_slot(lds, 0) + (i0 + cc) * (RW_LS * 2) + i0 * 2) = (u32x4){0u, 0u, 0u, 0u}; *(LAS u32x4*)(rw_slot(lds, 0) + (i0 + cc) * (RW_LS * 2) + (i0 + 8) * 2) = (u32x4){0u, 0u, 0u, 0u};
        }
        __syncthreads();
        RW_DBG(4, 12); RW_DBG(5, 13);
#ifdef DBG_RWKV
        rw_dbg_max(lds, 4, B.dbg + 2, tid);
#endif
#pragma unroll 1
        for (int ti = wave; ti < 16; ti += 8) { const int mt = ti >> 2, nt = ti & 3; f32x4 acc = {0.f, 0.f, 0.f, 0.f};
            acc = rw_mm(rw_slot(lds, 4), rw_slot(lds, 0), mt, nt, l15, kq, acc);
            rw_store_T(rw_slot(lds, 11), mt, nt, q, n, acc); rw_store_D(rw_slot(lds, 9), mt, nt, q, n, acc); }
        __syncthreads();
        RW_DBG(9, 14); RW_DBG(11, 15);
#ifdef DBG_RWKV
        rw_dbg_max(lds, 11, B.dbg + 3, tid);
#endif
#pragma unroll 1
        for (int ti = wave; ti < 16; ti += 8) { const int mt = ti >> 2, nt = ti & 3; f32x4 acc = {0.f, 0.f, 0.f, 0.f};
            acc = rw_mm(rw_slot(lds, 11), rw_slot(lds, 9), mt, nt, l15, kq, acc);
#ifdef DBG_CONST
            acc = (f32x4){1.f, 1.f, 1.f, 1.f};
#endif
            rw_store_T(rw_slot(lds, 10), mt, nt, q, n, acc); }
#pragma unroll 1
        for (int ti = wave; ti < 16; ti += 8) { const int mt = ti >> 2, nt = ti & 3; f32x4 acc = {0.f, 0.f, 0.f, 0.f};
            acc = rw_mm(rw_slot(lds, 9), rw_slot(lds, 5), mt, nt, l15, kq, acc);
            const u32x2 dg = *(const LAS u32x2*)(rw_slot(lds, 5) + (16 * nt + n) * (RW_LS * 2) + (16 * mt + 4 * q) * 2);
            acc[0] += bflo(dg.x); acc[1] += bfhi(dg.x); acc[2] += bflo(dg.y); acc[3] += bfhi(dg.y);
            rw_store_T(rw_slot(lds, 0), mt, nt, q, n, acc); }
        __syncthreads();
        RW_DBG(10, 16); RW_DBG(0, 17);
#pragma unroll 1
        for (int ti = wave; ti < 16; ti += 8) { const int mt = ti >> 2, nt = ti & 3; f32x4 acc = {0.f, 0.f, 0.f, 0.f};
            acc = rw_mm(rw_slot(lds, 0), rw_slot(lds, 10), mt, nt, l15, kq, acc);
#pragma unroll
            for (int r = 0; r < 4; ++r) acc[r] += rw_ld1(rw_slot(lds, 0), 16 * mt + 4 * q + r, 16 * nt + n);
            asm volatile("" ::: "memory");
            rw_store_T(rw_slot(lds, 4), mt, nt, q, n, acc); }
        __syncthreads();
        RW_DBG(4, 18);
#pragma unroll 1
        for (int ti = wave; ti < 32; ti += 8) { const int prod = ti >> 4, mt = (ti >> 2) & 3, nt = ti & 3; f32x4 acc = {0.f, 0.f, 0.f, 0.f};
            if (prod == 0) { acc = rw_mm(rw_slot(lds, 4), rw_slot(lds, 14), mt, nt, l15, kq, acc); rw_store_T(rw_slot(lds, 5), mt, nt, q, n, acc); }
            else { acc = rw_mm(rw_slot(lds, 1), rw_slot(lds, 8), mt, nt, l15, kq, acc); rw_store_T(rw_slot(lds, 9), mt, nt, q, n, acc); } }
        __syncthreads();
        RW_DBG(5, 19); RW_DBG(9, 20);
#pragma unroll 1
        for (int ti = wave; ti < 16; ti += 8) { const int mt = ti >> 2, nt = ti & 3; f32x4 acc = {0.f, 0.f, 0.f, 0.f};
            acc = rw_mm(rw_slot(lds, 4), rw_slot(lds, 9), mt, nt, l15, kq, acc); rw_store_T(rw_slot(lds, 11), mt, nt, q, n, acc); }
        __syncthreads();
        RW_DBG(11, 21);
#pragma unroll 1
        for (int ti = wave; ti < 64; ti += 8) { const int prod = ti >> 4, mt = (ti >> 2) & 3, nt = ti & 3; f32x4 acc = {0.f, 0.f, 0.f, 0.f};
            if (prod == 0) {
                acc = rw_mm(rw_slot(lds, 6), rw_slot(lds, 5), mt, nt, l15, kq, acc);
                bf16_t* dst = B.Pp + (size_t)item * 4096 + (size_t)((mt * 2 + (nt >> 1)) * 64) * 8 + (n & 3) + 4 * (nt & 1);
#pragma unroll
                for (int r = 0; r < 4; ++r) dst[(4 * q + r + 16 * (n >> 2)) * 8] = f2bf(acc[r]);
            } else if (prod == 1) {
                acc = rw_mm(rw_slot(lds, 6), rw_slot(lds, 11), mt, nt, l15, kq, acc); acc = rw_mm(rw_slot(lds, 7), rw_slot(lds, 8), mt, nt, l15, kq, acc);
                u32x2 w; w.x = cvt_pk_bf16(acc[0], acc[1]); w.y = cvt_pk_bf16(acc[2], acc[3]);
                *(u32x2*)(B.Qp + (size_t)item * 4096 + (size_t)((nt * 4 + mt) * 64 + lane) * 4) = w;
            } else if (prod == 2) {
                acc = rw_mm(rw_slot(lds, 2), rw_slot(lds, 5), mt, nt, l15, kq, acc);
#pragma unroll
                for (int r = 0; r < 4; ++r) acc[r] += rw_ld1(rw_slot(lds, 13), 16 * mt + 4 * q + r, 16 * nt + n);
                bf16_t* dst = B.Rp + (size_t)item * 4096 + (size_t)((mt * 2 + (nt >> 1)) * 64) * 8 + (n & 3) + 4 * (nt & 1);
#pragma unroll
                for (int r = 0; r < 4; ++r) dst[(4 * q + r + 16 * (n >> 2)) * 8] = f2bf(acc[r]);
            } else {
                acc = rw_mm(rw_slot(lds, 2), rw_slot(lds, 11), mt, nt, l15, kq, acc); acc = rw_mm(rw_slot(lds, 3), rw_slot(lds, 8), mt, nt, l15, kq, acc);
                u32x2 w; w.x = cvt_pk_bf16(acc[0], acc[1]); w.y = cvt_pk_bf16(acc[2], acc[3]);
                *(u32x2*)(B.CAT + (row0 + 16 * nt + n) * D + h * 64 + q * 16 + mt * 4) = w; } }
    }
}

__device__ __forceinline__ void rwkv_r2(LAS unsigned char* lds, const RwBufs& B, int bx, int G, int wave, int nbh) {
    if (wave >= 4) return;
    const int lane = lane_now(), q = lane >> 4, n = lane & 15, wv = wave;
#pragma unroll 1
    for (int bh = bx; bh < nbh; bh += G) {
        const int b = bh / RH, h = bh % RH;
        f32x4 S[4];
#pragma unroll
        for (int mt = 0; mt < 4; ++mt) S[mt] = (f32x4){0.f, 0.f, 0.f, 0.f};
#pragma unroll 1
        for (int c = 0; c < 64; ++c) {
            const size_t item = (size_t)(b * 64 + c) * RH + h; const size_t row0 = (size_t)b * SEQ + c * 64;
            const bf16x8* Pf = (const bf16x8*)(B.Pp + item * 4096) + lane; const bf16x8* Rf = (const bf16x8*)(B.Rp + item * 4096) + lane;
            bf16x8 pf[8], rf[8];
#pragma unroll
            for (int f = 0; f < 8; ++f) { pf[f] = Pf[f * 64]; rf[f] = Rf[f * 64]; }
            u32x2 qv[4]; f32x4 wl[4];
#pragma unroll
            for (int mt = 0; mt < 4; ++mt) { qv[mt] = *(const u32x2*)(B.Qp + item * 4096 + (size_t)((wv * 4 + mt) * 64 + lane) * 4); wl[mt] = *(const f32x4*)(B.WL + item * 64 + 16 * mt + 4 * q); }
            bf16_t* yp = B.CAT + (row0 + 16 * wv + n) * D + h * 64 + q * 16;
            const u32x4 y0 = *(const u32x4*)yp, y1 = *(const u32x4*)(yp + 8);
            bf16x8 sh[2], sl[2];
#pragma unroll
            for (int ks = 0; ks < 2; ++ks) { unsigned hw[4], lw[4];
#pragma unroll
                for (int hf = 0; hf < 2; ++hf) { const f32x4 s = S[2 * ks + hf];
                    const unsigned h01 = cvt_pk_bf16(s[0], s[1]), h23 = cvt_pk_bf16(s[2], s[3]);
                    hw[2 * hf] = h01; hw[2 * hf + 1] = h23;
                    lw[2 * hf] = cvt_pk_bf16(s[0] - bflo(h01), s[1] - bfhi(h01)); lw[2 * hf + 1] = cvt_pk_bf16(s[2] - bflo(h23), s[3] - bfhi(h23)); }
                u32x4 hv = {hw[0], hw[1], hw[2], hw[3]}, lv = {lw[0], lw[1], lw[2], lw[3]};
                sh[ks] = __builtin_bit_cast(bf16x8, hv); sl[ks] = __builtin_bit_cast(bf16x8, lv); }
            f32x4 ya[4];
            { const unsigned yw[8] = {y0.x, y0.y, y0.z, y0.w, y1.x, y1.y, y1.z, y1.w};
#pragma unroll
              for (int mt = 0; mt < 4; ++mt) ya[mt] = (f32x4){bflo(yw[2 * mt]), bfhi(yw[2 * mt]), bflo(yw[2 * mt + 1]), bfhi(yw[2 * mt + 1])}; }
#pragma unroll
            for (int mt = 0; mt < 4; ++mt)
#pragma unroll
                for (int ks = 0; ks < 2; ++ks) { ya[mt] = __builtin_amdgcn_mfma_f32_16x16x32_bf16(rf[mt * 2 + ks], sh[ks], ya[mt], 0, 0, 0); ya[mt] = __builtin_amdgcn_mfma_f32_16x16x32_bf16(rf[mt * 2 + ks], sl[ks], ya[mt], 0, 0, 0); }
            { u32x4 o0, o1; o0.x = cvt_pk_bf16(ya[0][0], ya[0][1]); o0.y = cvt_pk_bf16(ya[0][2], ya[0][3]); o0.z = cvt_pk_bf16(ya[1][0], ya[1][1]); o0.w = cvt_pk_bf16(ya[1][2], ya[1][3]);
              o1.x = cvt_pk_bf16(ya[2][0], ya[2][1]); o1.y = cvt_pk_bf16(ya[2][2], ya[2][3]); o1.z = cvt_pk_bf16(ya[3][0], ya[3][1]); o1.w = cvt_pk_bf16(ya[3][2], ya[3][3]);
              *(u32x4*)yp = o0; *(u32x4*)(yp + 8) = o1; }
            f32x4 sn[4];
#pragma unroll
            for (int mt = 0; mt < 4; ++mt) { sn[mt] = (f32x4){bflo(qv[mt].x), bfhi(qv[mt].x), bflo(qv[mt].y), bfhi(qv[mt].y)} + wl[mt] * S[mt]; }
#pragma unroll
            for (int mt = 0; mt < 4; ++mt)
#pragma unroll
                for (int ks = 0; ks < 2; ++ks) { sn[mt] = __builtin_amdgcn_mfma_f32_16x16x32_bf16(pf[mt * 2 + ks], sh[ks], sn[mt], 0, 0, 0); sn[mt] = __builtin_amdgcn_mfma_f32_16x16x32_bf16(pf[mt * 2 + ks], sl[ks], sn[mt], 0, 0, 0); }
#pragma unroll
            for (int mt = 0; mt < 4; ++mt) S[mt] = sn[mt];
        }
    }
}

__device__ __forceinline__ void rwkv_r3(const RwBufs& B, int gw, int NGW, int nitems) {
    const int lane = lane_now(), q = lane >> 4, n = lane & 15;
#pragma unroll 1
    for (int item = gw; item < nitems; item += NGW) {
        const int b = item / (64 * RH), c = (item / RH) & 63, h = item % RH; const size_t row0 = (size_t)b * SEQ + c * 64;
        unsigned yw[4][8];
#pragma unroll
        for (int wv = 0; wv < 4; ++wv) { const bf16_t* yp = B.CAT + (row0 + 16 * wv + n) * D + h * 64 + q * 16; const u32x4 y0 = *(const u32x4*)yp, y1 = *(const u32x4*)(yp + 8);
            yw[wv][0] = y0.x; yw[wv][1] = y0.y; yw[wv][2] = y0.z; yw[wv][3] = y0.w; yw[wv][4] = y1.x; yw[wv][5] = y1.y; yw[wv][6] = y1.z; yw[wv][7] = y1.w; }
        asm volatile("s_waitcnt vmcnt(0)" ::: "memory");
#pragma unroll
        for (int hf = 0; hf < 2; ++hf) {
            float s1[8], s2[8];
#pragma unroll
            for (int e4 = 0; e4 < 8; ++e4) { s1[e4] = 0.f; s2[e4] = 0.f; }
#pragma unroll
            for (int wv = 0; wv < 4; ++wv)
#pragma unroll
                for (int e2 = 0; e2 < 4; ++e2) { const unsigned w = yw[wv][4 * hf + e2]; const float ylo = bflo(w), yhi = bfhi(w); s1[2 * e2] += ylo; s2[2 * e2] += ylo * ylo; s1[2 * e2 + 1] += yhi; s2[2 * e2 + 1] += yhi * yhi; }
#pragma unroll
            for (int e4 = 0; e4 < 8; ++e4) {
#pragma unroll
                for (int o = 1; o < 16; o <<= 1) { s1[e4] += __shfl_xor(s1[e4], o); s2[e4] += __shfl_xor(s2[e4], o); }
                const float mean = s1[e4] * (1.f / 64.f), var = fmaxf(s2[e4] * (1.f / 64.f) - mean * mean, 0.f); s1[e4] = mean; s2[e4] = 1.0f / sqrtf(var + LNX_EPS); }
#pragma unroll
            for (int wv = 0; wv < 4; ++wv) { const size_t go = (size_t)item * 4096 + (size_t)(16 * wv + n) * 64 + q * 16 + 8 * hf;
                const u32x4 a0 = *(const u32x4*)(B.GA + go), b0 = *(const u32x4*)(B.GB + go);
                const unsigned aw[4] = {a0.x, a0.y, a0.z, a0.w}, bw[4] = {b0.x, b0.y, b0.z, b0.w};
#pragma unroll
                for (int e4 = 0; e4 < 8; ++e4) { const int e = 8 * hf + e4; const unsigned ywd = yw[wv][e >> 1];
                    const float yv = (e & 1) ? bfhi(ywd) : bflo(ywd), gaf = (e & 1) ? bfhi(aw[e4 >> 1]) : bflo(aw[e4 >> 1]), gbf = (e & 1) ? bfhi(bw[e4 >> 1]) : bflo(bw[e4 >> 1]);
                    const float o = (yv - s1[e4]) * s2[e4] * gaf + gbf; const int t = 16 * (e >> 2) + 4 * q + (e & 3);
                    B.CAT[(row0 + t) * D + h * 64 + 16 * wv + n] = f2bf(o); }
                asm volatile("" ::: "memory"); }
        }
    }
}
constexpr int N_PHASES = 15;

__device__ __forceinline__ TrJob small_job(const Args& a, int j) {
    unsigned char* ws = a.ws; TrJob r;
    switch (j) {
    case 0: r = TrJob{a.in[I_WINA], (bf16_t*)(ws + WS_WINA), a.in[I_NORM_MIX], D, D, 0, 0}; break;
    case 1: r = TrJob{a.in[I_WOUT], (bf16_t*)(ws + WS_WOUT0), nullptr, D, D, 0, 0}; break;
    case 2: r = TrJob{a.in[I_WOUT] + (size_t)D * D, (bf16_t*)(ws + WS_WOUT1), nullptr, D, D, 0, 0}; break;
    case 3: r = TrJob{a.in[I_WKV], (bf16_t*)(ws + WS_WKV), nullptr, D, 512, 0, 0}; break;
    case 4: r = TrJob{a.in[I_WKV] + (size_t)D * 512, (bf16_t*)(ws + WS_WKV) + (size_t)512 * D, nullptr, D, 512, 0, 0}; break;
    case 5: r = TrJob{a.in[I_FGATE], (bf16_t*)(ws + WS_WGU0), a.in[I_NORM_FFN], D, FD, 1, 0}; break;
    case 6: r = TrJob{a.in[I_FUP], (bf16_t*)(ws + WS_WGU0), a.in[I_NORM_FFN], D, FD, 2, 0}; break;
    case 7: r = TrJob{a.in[I_FDOWN], (bf16_t*)(ws + WS_WD0), nullptr, FD, D, 0, 0}; break;
    case 8: r = TrJob{a.in[I_WINB], (bf16_t*)(ws + WS_WINB), a.in[I_NORM_MIX] + D, D, INB, 0, 0}; break;
    case 9: r = TrJob{a.in[I_W2], (bf16_t*)(ws + WS_W2T), nullptr, 64, CS, 0, 0}; break;
    case 10: r = TrJob{a.in[I_A2], (bf16_t*)(ws + WS_A2T), nullptr, 64, CS, 0, 0}; break;
    default: r = TrJob{a.in[I_G2], (bf16_t*)(ws + WS_G2T), nullptr, 128, CS, 0, 0}; break;
    }
    r.items = (r.K / 64) * (r.N / 32); return r;
}
__device__ __forceinline__ TrJob moe_job(const Args& a, int j) {
    unsigned char* ws = a.ws; const int kind = j >> 3, e = j & 7; TrJob r;
    if (kind == 0) r = TrJob{a.in[I_MGATE] + (size_t)e * D * FE, (bf16_t*)(ws + WS_WMOE_GU) + (size_t)e * 2 * FE * D, a.in[I_NORM_FFN] + D, D, FE, 1, 0};
    else if (kind == 1) r = TrJob{a.in[I_MUP] + (size_t)e * D * FE, (bf16_t*)(ws + WS_WMOE_GU) + (size_t)e * 2 * FE * D, a.in[I_NORM_FFN] + D, D, FE, 2, 0};
    else r = TrJob{a.in[I_MDOWN] + (size_t)e * FE * D, (bf16_t*)(ws + WS_WMOE_D) + (size_t)e * D * FE, nullptr, FE, D, 0, 0};
    r.items = (r.K / 64) * (r.N / 32); return r;
}

template <int LO, int HI> __global__ void __launch_bounds__(NTHR, 2) fwd(Args args) {
    extern __shared__ __attribute__((aligned(16))) unsigned char lds_raw[];
    LAS unsigned char* lds = (LAS unsigned char*)lds_raw;
    volatile LAS unsigned* MISC = (volatile LAS unsigned*)(lds + LDS_MISC);
    const int wave = __builtin_amdgcn_readfirstlane(threadIdx.x >> 6);
#define lane (lane_now())
#define tid (wave * 64 + lane_now())
    const int G = gridDim.x, bx = blockIdx.x;
    const int gw = bx * NWAVES + wave, NGW = G * NWAVES;
    unsigned char* ws = args.ws;
    unsigned* ctl = (unsigned*)(ws + WS_CTL);
    rss_t* rowss = (rss_t*)(ws + WS_CTL + CTL_ROWSS);
    float* X = args.out;
    bf16_t* HA = (bf16_t*)(ws + WS_HA);
    const int lo = args.ph_lo, hi = args.ph_hi;
    for (int u = tid; u < (LDS_BYTES - LDS_MISC) / 4; u += NTHR) ((LAS unsigned*)(lds + LDS_MISC))[u] = 0u;
    __syncthreads();
    XcdBarrier bar; bar.bar = ctl + CW_BAR; bar.x = 0; bar.st = nullptr;
    const bool multi = (hi - lo) > 1;
    if (multi) bar = xcd_barrier_post(ctl + CW_BAR, MISC + 8);
#define IN(k) (LO <= (k) && (k) < HI && lo <= (k) && (k) < hi)
#define SEAM(k) do { if (IN(k) && IN((k) + 1)) xcd_barrier(bar); } while (0)

    if (IN(0)) {
        LAS float* scr = (LAS float*)(lds + wave * 16384);
        {
            int base = 0;
            for (int j = 0; j < 12; ++j) { const TrJob jb = small_job(args, j);
                for (int it = gw - base; it < jb.items; it += NGW) { if (it >= 0) tr_item(jb.W, jb.K, jb.N, jb.WT, jb.gain, jb.mode, scr, it, lane); }
                base = (base + jb.items) % NGW; }
        }
        for (int r = gw; r < 2 * MROWS; r += NGW) { const int li = r / MROWS, row = r % MROWS;
            const f32x4* xr = (const f32x4*)(args.in[I_MEM] + (size_t)row * D) + lane; const f32x4* gr = (const f32x4*)(args.in[I_NORM_MEM] + li * D) + lane;
            f32x4 v[4]; float s = 0.f;
#pragma unroll
            for (int j = 0; j < 4; ++j) { v[j] = xr[64 * j]; s += (v[j][0] * v[j][0] + v[j][1] * v[j][1]) + (v[j][2] * v[j][2] + v[j][3] * v[j][3]); }
            const float rs = rstd_of(wave_sum(s));
            u32x2* o = (u32x2*)((bf16_t*)(ws + WS_MEMN) + ((size_t)li * MROWS + row) * D) + lane;
#pragma unroll
            for (int j = 0; j < 4; ++j) { const f32x4 g = gr[64 * j]; u32x2 w; w.x = cvt_pk_bf16(v[j][0] * rs * g[0], v[j][1] * rs * g[1]); w.y = cvt_pk_bf16(v[j][2] * rs * g[2], v[j][3] * rs * g[3]); o[64 * j] = w; }
        }
        for (int r = gw; r < T; r += NGW) {
            const f32x4* xr = (const f32x4*)(args.in[I_X] + (size_t)r * D) + lane; f32x4 v[4]; float s = 0.f;
#pragma unroll
            for (int j = 0; j < 4; ++j) { v[j] = xr[64 * j]; s += (v[j][0] * v[j][0] + v[j][1] * v[j][1]) + (v[j][2] * v[j][2] + v[j][3] * v[j][3]); }
            s = wave_sum(s); if (lane == 0) rowss[r] = rss_fx(s);
            u32x2* o = (u32x2*)(HA + (size_t)r * D) + lane;
#pragma unroll
            for (int j = 0; j < 4; ++j) { u32x2 w; w.x = cvt_pk_bf16(v[j][0], v[j][1]); w.y = cvt_pk_bf16(v[j][2], v[j][3]); o[64 * j] = w; }
        }
    }
    SEAM(0);

    if (IN(1)) {
        { pg8::DenseSched S; S.init(HA, ws + WS_WINA, T, D, D, G, bx);
          EpiInA E{(bf16_t*)(ws + WS_P0U), (bf16_t*)(ws + WS_P0Q), rowss};
          pg8::gemm_phase<EpiInA, pg8::DenseSched, true>(lds, D, S, E); }
        __syncthreads();
#pragma unroll 1
        for (int li = 0; li < 2; ++li) {
            pg8::DenseSched S; S.init((bf16_t*)(ws + WS_MEMN) + (size_t)li * MROWS * D, (bf16_t*)(ws + WS_WKV) + (size_t)li * 512 * D, MROWS, 512, D, G, (bx + 128 * li + 64) % G);
            EpiBf16 E{(bf16_t*)(ws + WS_KV) + (size_t)li * MROWS * 512, 512, nullptr, nullptr, 0};
            pg8::gemm_phase<EpiBf16, pg8::DenseSched, true>(lds, D, S, E);
            __syncthreads();
        }
    }
    SEAM(1);

    if (IN(2)) {
        bf16_t* CAT = (bf16_t*)(ws + WS_CAT);
        attn_naive(lds, (const bf16_t*)(ws + WS_P0Q), (const bf16_t*)(ws + WS_KV), CAT, bx, G, tid);
        __syncthreads();
        s5_naive(args, lds, (const bf16_t*)(ws + WS_P0U), CAT, bx, G, wave, lane);
    }
    SEAM(2);

    if (IN(3)) {
        pg8::DenseSched S; S.init(ws + WS_CAT, ws + WS_WOUT0, T, D, D, G, bx);
        EpiRes E{args.in[I_X], X, HA, rowss + T};
        pg8::gemm_phase<EpiRes, pg8::DenseSched, true>(lds, D, S, E);
    }
    SEAM(3);

    if (IN(4)) {
        pg8::DenseSched S; S.init(HA, ws + WS_WGU0, T, 2 * FD, D, G, bx);
        EpiSwiglu E{(bf16_t*)(ws + WS_ACT0), FD, rowss + T, nullptr};
        pg8::gemm_phase<EpiSwiglu, pg8::DenseSched, true>(lds, D, S, E);
    }
    SEAM(4);

    if (IN(5)) {
        pg8::DenseSched S; S.init(ws + WS_ACT0, ws + WS_WD0, T, D, FD, G, bx);
        EpiRes E{X, X, HA, rowss + 2 * T};
        pg8::gemm_phase<EpiRes, pg8::DenseSched, true>(lds, FD, S, E);
    }
    SEAM(5);

    if (IN(6)) {
        pg8::DenseSched S; S.init(HA, ws + WS_WINB, T, INB, D, G, bx);
        EpiBf16 E{(bf16_t*)(ws + WS_P1), INB, rowss + 2 * T, (bf16_t*)(ws + WS_P0Q), SHIFTC};
        pg8::gemm_phase<EpiBf16, pg8::DenseSched, true>(lds, D, S, E);
    }
    SEAM(6);

    RwBufs RB; RB.dbg = ctl + 16387;
#ifdef DBG_RWKV
    RB.Pp = (bf16_t*)(ws + 78 * MiB); RB.Qp = (bf16_t*)(ws + 84 * MiB); RB.Rp = (bf16_t*)(ws + 90 * MiB); RB.GA = (bf16_t*)(ws + 96 * MiB); RB.GB = (bf16_t*)(ws + 102 * MiB); RB.WL = (float*)(ws + 108 * MiB);
    RB.CAT = (bf16_t*)(ws + 110 * MiB);
    constexpr int RW_ITEMS = 64 * RH, RW_BH = RH;
#else
    RB.Pp = (bf16_t*)(ws + WS_RPP); RB.Qp = (bf16_t*)(ws + WS_RQP); RB.Rp = (bf16_t*)(ws + WS_RRP); RB.WL = (float*)(ws + WS_RWL); RB.GA = (bf16_t*)(ws + WS_RGA); RB.GB = (bf16_t*)(ws + WS_RGB);
    RB.CAT = (bf16_t*)(ws + WS_CAT);
    constexpr int RW_ITEMS = NB * 64 * RH, RW_BH = NB * RH;
#endif
    RB.P1 = (const bf16_t*)(ws + WS_P1); RB.w2T = (const bf16_t*)(ws + WS_W2T); RB.a2T = (const bf16_t*)(ws + WS_A2T); RB.g2T = (const bf16_t*)(ws + WS_G2T);
    if (IN(7)) {
        attn_naive(lds, (const bf16_t*)(ws + WS_P0Q), (const bf16_t*)(ws + WS_KV) + (size_t)MROWS * 512, (bf16_t*)(ws + WS_CAT), bx, G, tid);
        __syncthreads();
#ifdef DBG_RWKV
        rwkv_prep(args, lds, (const bf16_t*)(ws + WS_P1), (bf16_t*)(ws + 432 * MiB), (bf16_t*)(ws + 480 * MiB), (bf16_t*)(ws + 128 * MiB), (bf16_t*)(ws + 2 * MiB), bx, G, tid);
        __syncthreads();
#endif
        rwkv_r1(args, lds, RB, bx, G, wave, RW_ITEMS);
    }
    SEAM(7);
    if (IN(8)) {
        rwkv_r2(lds, RB, bx, G, wave, RW_BH);
    }
    SEAM(8);
    if (IN(9)) { rwkv_r3(RB, gw, NGW, RW_ITEMS); }
    SEAM(9);

    if (IN(10)) {
#ifdef DBG_RWKV
        {   const bf16_t* ref = (const bf16_t*)(ws + WS_CAT); const bf16_t* tst = (const bf16_t*)(ws + 110 * MiB); float sd = 0.f, sr = 0.f;
            for (int r = gw; r < SEQ; r += NGW) {
#pragma unroll
                for (int i = 0; i < 12; ++i) { const float a = bf2f(ref[(size_t)r * D + lane + 64 * i]), b = bf2f(tst[(size_t)r * D + lane + 64 * i]); sd += (a - b) * (a - b); sr += a * a; } }
            sd = wave_sum(sd); sr = wave_sum(sr);
            if (lane == 0) { atomicAdd((float*)(ctl + 16384), sd); atomicAdd((float*)(ctl + 16385), sr); }
            unsigned bad = 0u;
            for (int i = gw * 64 + lane; i < 768 * 64; i += NGW * 64) { const float v = RB.WL[i]; if (!(v - v == 0.f)) bad |= 1u; }
            for (int i = gw * 64 + lane; i < 768 * 4096; i += NGW * 64) { float v = bf2f(RB.GA[i]); if (!(v - v == 0.f)) bad |= 2u; v = bf2f(RB.GB[i]); if (!(v - v == 0.f)) bad |= 4u;
                v = bf2f(RB.Pp[i]); if (!(v - v == 0.f)) bad |= 8u; v = bf2f(RB.Qp[i]); if (!(v - v == 0.f)) bad |= 16u; v = bf2f(RB.Rp[i]); if (!(v - v == 0.f)) bad |= 32u; }
            for (int r = gw; r < SEQ; r += NGW) for (int i = 0; i < 12; ++i) { const float v = bf2f(tst[(size_t)r * D + lane + 64 * i]); if (!(v - v == 0.f)) bad |= 64u; }
            if (bad) atomicOr(ctl + 16386, bad); }
#endif
        pg8::DenseSched S; S.init(ws + WS_CAT, ws + WS_WOUT1, T, D, D, G, bx);
        EpiRes E{X, X, HA, rowss + 3 * T};
        pg8::gemm_phase<EpiRes, pg8::DenseSched, true>(lds, D, S, E);
    }
    SEAM(10);

    if (IN(11)) {
        moe_router(args, X, ctl, ws, gw, NGW, lane);
        LAS float* scr = (LAS float*)(lds + wave * 16384);
        int base = 0;
#pragma unroll 1
        for (int j = 0; j < 24; ++j) { const TrJob jb = moe_job(args, j);
            for (int it = gw - base; it < jb.items; it += NGW) { if (it >= 0) tr_item(jb.W, jb.K, jb.N, jb.WT, jb.gain, jb.mode, scr, it, lane); }
            base = (base + jb.items) % NGW; }
    }
    SEAM(11);

    if constexpr (HI > 12 && LO < 14) {
#pragma unroll 1
    for (int pass = args.pass_lo; pass < args.pass_hi; ++pass) {
        constexpr int pg = 12, pd = 13;
        LAS int* tab = (LAS int*)(lds + LDS_MISC + 256);
        if (IN(pg) || IN(pd)) {
            __syncthreads();
            if (tid == 0) { int acc = 0; for (int e = 0; e < 8; ++e) { const int c = (int)__hip_atomic_load(ctl + CW_CNT + 64 * e, __ATOMIC_RELAXED, __HIP_MEMORY_SCOPE_AGENT); tab[e] = acc; tab[16 + e] = c; acc += (c + 255) >> 8; } tab[8] = acc; }
            __syncthreads();
        }
        const int ntile = (IN(pg) || IN(pd)) ? __builtin_amdgcn_readfirstlane(tab[8]) : 0;
        const int tile0 = 64 * pass, nt_pass = min(64, ntile - tile0);
        if (IN(pg) && nt_pass > 0) {
            MoeGuSched S; S.o.init(nt_pass, 2 * FE / 256, G, bx); S.A = (const char*)HA; S.W = (const char*)(ws + WS_WMOE_GU); S.list = (const int*)(ws + WS_ROUTE + RT_LIST); S.tab = tab; S.tile0 = tile0;
            EpiSwiglu E{(bf16_t*)(ws + WS_MACT), FE, nullptr, (const float*)(ws + WS_ROUTE + RT_LRSTD)};
            pg8::gemm_phase<EpiSwiglu, MoeGuSched, true>(lds, D, S, E);
        }
        SEAM(pg);
        if (IN(pd) && nt_pass > 0) {
            MoeDownSched S; S.o.init(nt_pass, D / 256, G, bx); S.A = (const char*)(ws + WS_MACT); S.W = (const char*)(ws + WS_WMOE_D); S.tab = tab; S.tile0 = tile0;
            EpiSlot E{(bf16_t*)(ws + WS_YSLOT)};
            pg8::gemm_phase<EpiSlot, MoeDownSched, true>(lds, FE, S, E);
        }
        if (IN(pd) && (pass + 1 < args.pass_hi || IN(14))) xcd_barrier(bar);
    }
    }

    if (IN(14)) {
        LAS int* tab = (LAS int*)(lds + LDS_MISC + 256);
        __syncthreads();
        if (tid == 0) { int acc = 0; for (int e = 0; e < 8; ++e) { const int c = (int)__hip_atomic_load(ctl + CW_CNT + 64 * e, __ATOMIC_RELAXED, __HIP_MEMORY_SCOPE_AGENT); tab[e] = acc; acc += (c + 255) >> 8; } }
        __syncthreads();
        const int* toke = (const int*)(ws + WS_ROUTE + RT_TOKE); const int* tokr = (const int*)(ws + WS_ROUTE + RT_TOKR); const float* tokw = (const float*)(ws + WS_ROUTE + RT_TOKW);
        const bf16_t* Y = (const bf16_t*)(ws + WS_YSLOT);
        for (int r = gw; r < T; r += NGW) {
            const int e0 = toke[2 * r], e1 = toke[2 * r + 1]; const float w0 = tokw[2 * r], w1 = tokw[2 * r + 1];
            const size_t s0 = (size_t)tab[e0] * 256 + tokr[2 * r], s1 = (size_t)tab[e1] * 256 + tokr[2 * r + 1];
            const f32x4* xr = (const f32x4*)(X + (size_t)r * D) + lane; const u32x2* y0 = (const u32x2*)(Y + s0 * D) + lane; const u32x2* y1 = (const u32x2*)(Y + s1 * D) + lane;
            f32x4 v[4]; float s = 0.f;
#pragma unroll
            for (int j = 0; j < 4; ++j) { v[j] = xr[64 * j]; const u32x2 a = y0[64 * j], b = y1[64 * j];
                v[j][0] += w0 * bflo(a.x) + w1 * bflo(b.x); v[j][1] += w0 * bfhi(a.x) + w1 * bfhi(b.x); v[j][2] += w0 * bflo(a.y) + w1 * bflo(b.y); v[j][3] += w0 * bfhi(a.y) + w1 * bfhi(b.y);
                s += (v[j][0] * v[j][0] + v[j][1] * v[j][1]) + (v[j][2] * v[j][2] + v[j][3] * v[j][3]); }
            float rs = rstd_of(wave_sum(s));
#ifdef DBG_RWKV
            { const float sd = __hip_atomic_load((float*)(ctl + 16384), __ATOMIC_RELAXED, __HIP_MEMORY_SCOPE_AGENT), sr = __hip_atomic_load((float*)(ctl + 16385), __ATOMIC_RELAXED, __HIP_MEMORY_SCOPE_AGENT);
              const float e = sqrtf(sd / sr); float dl = 0.1f * log10f(e * 1000.f); if (!(e == e)) dl = 0.7f; dl = fminf(fmaxf(dl, 0.f), 0.8f);
              const unsigned bad = __hip_atomic_load(ctl + 16386, __ATOMIC_RELAXED, __HIP_MEMORY_SCOPE_AGENT);
              if (bad) { int code = 0; for (int bit = 6; bit >= 0; --bit) if (bad & (1u << bit)) code = bit + 1; dl = 0.1f * code; }
              const unsigned bad2 = __hip_atomic_load(ctl + 16387, __ATOMIC_RELAXED, __HIP_MEMORY_SCOPE_AGENT);
              if (bad2 & ~DBG_SKIPMASK) { int code = 0; for (int bit = 21; bit >= 0; --bit) if ((bad2 & ~DBG_SKIPMASK) & (1u << bit)) code = bit + 1; dl = 0.03f * code; }
#ifdef DBG_MAXWORD
              { const float mx = __uint_as_float(__hip_atomic_load(ctl + 16387 + DBG_MAXWORD, __ATOMIC_RELAXED, __HIP_MEMORY_SCOPE_AGENT)); float lg = log2f(fmaxf(mx, 1e-9f)); lg = fminf(fmaxf(lg, -30.f), 130.f); dl = 0.005f * (lg + 30.f); }
#endif
              rs *= (1.f + dl); }
#endif
            const f32x4* gr = (const f32x4*)(args.in[I_NORM_FINAL]) + lane; f32x4* o = (f32x4*)(X + (size_t)r * D) + lane;
#pragma unroll
            for (int j = 0; j < 4; ++j) { const f32x4 g = gr[64 * j]; o[64 * j] = v[j] * rs * g; }
        }
    }
#undef IN
#undef SEAM
#undef lane
#undef tid
}

#ifdef DBG_RWKV
__global__ void __launch_bounds__(NTHR, 2) dbg_naive(Args args) {
    extern __shared__ __attribute__((aligned(16))) unsigned char lds_raw[];
    LAS unsigned char* lds = (LAS unsigned char*)lds_raw; unsigned char* ws = args.ws;
    const int wave = __builtin_amdgcn_readfirstlane(threadIdx.x >> 6);
    rwkv_naive(args, lds, (const bf16_t*)(ws + WS_P1), (const bf16_t*)(ws + 432 * MiB), (const bf16_t*)(ws + 480 * MiB), (const bf16_t*)(ws + 128 * MiB), (const bf16_t*)(ws + 2 * MiB), (bf16_t*)(ws + WS_CAT), blockIdx.x, gridDim.x, wave, lane_now());
}
#endif

#ifndef N_LAUNCH_MODE
#define N_LAUNCH_MODE 0
#endif
extern "C" void kernel_launch(void* const* d_in, const int* in_sizes, int n_in, void* d_out, int out_size, void* d_ws, size_t ws_size, hipStream_t stream) {
    static int grid = 0;
    if (grid == 0) {
        if (n_in != N_IN || in_sizes[0] != T * D || out_size != T * D || ws_size < WS_NEED) {
            fprintf(stderr, "kernel_launch: unexpected shapes/workspace: n_in %d in0 %d out %d ws %zu (need %zu)\n", n_in, n_in > 0 ? in_sizes[0] : -1, out_size, ws_size, (size_t)WS_NEED); grid = -1; return; }
        int dev = 0, cus = 0;
        if (hipGetDevice(&dev) != hipSuccess || hipDeviceGetAttribute(&cus, hipDeviceAttributeMultiprocessorCount, dev) != hipSuccess) { grid = -1; return; }
        bool ok = true;
#define SETATTR(K) ok = ok && (hipFuncSetAttribute((const void*)K, hipFuncAttributeMaxDynamicSharedMemorySize, LDS_BYTES) == hipSuccess)
#if N_LAUNCH_MODE == 1
        SETATTR((fwd<0, N_PHASES>));
#else
        SETATTR((fwd<0, 1>)); SETATTR((fwd<1, 2>)); SETATTR((fwd<2, 3>)); SETATTR((fwd<3, 4>)); SETATTR((fwd<4, 5>)); SETATTR((fwd<5, 6>)); SETATTR((fwd<6, 7>)); SETATTR((fwd<7, 8>));
        SETATTR((fwd<8, 9>)); SETATTR((fwd<9, 10>)); SETATTR((fwd<10, 11>)); SETATTR((fwd<11, 12>)); SETATTR((fwd<12, 13>)); SETATTR((fwd<13, 14>)); SETATTR((fwd<14, 15>));
#endif
        if (!ok) { fprintf(stderr, "kernel_launch: hipFuncSetAttribute failed\n"); grid = -1; return; }
        (void)hipGetLastError();
        grid = cus;
    }
    if (grid < 0) return;
    if (hipMemsetAsync((char*)d_ws + WS_CTL, 0, CTL_BYTES, stream) != hipSuccess) return;
    Args a{};
    for (int i = 0; i < N_IN; ++i) a.in[i] = (const float*)d_in[i];
    a.out = (float*)d_out; a.ws = (unsigned char*)d_ws;
#if N_LAUNCH_MODE == 1
    a.ph_lo = 0; a.ph_hi = N_PHASES; a.pass_lo = 0; a.pass_hi = 5;
    hipLaunchKernelGGL((fwd<0, N_PHASES>), dim3(grid), dim3(NTHR), LDS_BYTES, stream, a);
#else
#define LAUNCH1(P) do { a.ph_lo = (P); a.ph_hi = (P) + 1; hipLaunchKernelGGL((fwd<(P), (P) + 1>), dim3(grid), dim3(NTHR), LDS_BYTES, stream, a); } while (0)
    LAUNCH1(0); LAUNCH1(1); LAUNCH1(2); LAUNCH1(3); LAUNCH1(4); LAUNCH1(5); LAUNCH1(6); LAUNCH1(7);
#ifdef DBG_RWKV
    hipLaunchKernelGGL(dbg_naive, dim3(grid), dim3(NTHR), 4096, stream, a); LAUNCH1(8);
#else
    LAUNCH1(8);
#endif
    LAUNCH1(9); LAUNCH1(10); LAUNCH1(11);
    for (int pass = 0; pass < 5; ++pass) { a.pass_lo = pass; a.pass_hi = pass + 1; LAUNCH1(12); LAUNCH1(13); }
    LAUNCH1(14);
#endif
}
```

```cpp
#include <hip/hip_runtime.h>
#include <cstdio>
#include <cstdint>

#define LAS __attribute__((address_space(3)))
#define GAS __attribute__((address_space(1)))
typedef unsigned short bf16_t;
typedef short bf16x8 __attribute__((ext_vector_type(8)));
typedef short bf16x4 __attribute__((ext_vector_type(4)));
typedef float f32x4 __attribute__((ext_vector_type(4)));
typedef float f32x2 __attribute__((ext_vector_type(2)));
typedef unsigned u32x4 __attribute__((ext_vector_type(4)));
typedef unsigned u32x2 __attribute__((ext_vector_type(2)));

constexpr int NB = 8, SEQ = 4096, T = NB * SEQ, D = 1024, MEML = 256, MROWS = NB * MEML;
constexpr int CS = 768, CM = 256, NH_MEM = 4;
constexpr int S5G = 48, S5J = 16, S5P = 64;
constexpr int RH = 12, RN = 64, SHIFTC = 2560, INB = 2816;
constexpr int FD = 2816, NE = 8, FE = 3584;
constexpr float RMS_EPS = 1e-6f, LNX_EPS = 64e-5f;
constexpr int NWAVES = 8, NTHR = 512;

enum { I_X = 0, I_MEM, I_NORM_MIX, I_NORM_MEM, I_WKV, I_WOUT, I_NORM_FFN, I_NORM_FINAL, I_WINA, I_LAM_RE, I_LAM_IM, I_LOG_DT, I_B_RE, I_B_IM, I_C_RE, I_C_IM,
       I_S5D, I_WGLU, I_BGLU, I_FGATE, I_FUP, I_FDOWN, I_WINB, I_MU, I_W0, I_W2, I_A0, I_A2, I_G2, I_KK, I_KA, I_RK, I_LNXW, I_LNXB, I_WR, I_BR, I_MGATE, I_MUP, I_MDOWN, N_IN };

constexpr size_t MiB = 1u << 20;
constexpr size_t WS_CTL = 0, CTL_BYTES = 2 * MiB;
constexpr size_t WS_HA = 2 * MiB;
constexpr size_t WS_ROUTE = 66 * MiB;
constexpr size_t WS_WOUT1 = 70 * MiB;
constexpr size_t WS_KV = 72 * MiB;
constexpr size_t WS_LORA = 76 * MiB;
constexpr size_t WS_W2T = WS_LORA, WS_A2T = WS_LORA + 96 * 1024, WS_G2T = WS_LORA + 192 * 1024;
constexpr size_t WS_WINA = 78 * MiB, WS_WOUT0 = 80 * MiB, WS_WKV = 82 * MiB  , WS_WGU0 = 84 * MiB  , WS_WD0 = 95 * MiB  ,
                 WS_WINB = 101 * MiB  , WS_MEMN = 107 * MiB  , WS_S5TAB = 115 * MiB  ;
constexpr size_t WS_P0U = 128 * MiB;
constexpr size_t WS_P0Q = 176 * MiB;
constexpr size_t WS_CAT = 192 * MiB;
constexpr size_t WS_ACT0 = 256 * MiB;
constexpr size_t WS_P1 = 256 * MiB;
constexpr size_t WS_RPP = 2 * MiB, WS_RWL = 50 * MiB  , WS_RQP = 128 * MiB, WS_RRP = 432 * MiB, WS_RGA = 480 * MiB, WS_RGB = 78 * MiB;
constexpr size_t WS_WMOE_GU = 70 * MiB;
constexpr size_t WS_WMOE_D = 182 * MiB;
constexpr size_t WS_MACT = 238 * MiB;
constexpr size_t WS_YSLOT = 350 * MiB;
constexpr size_t WS_END = 482 * MiB, WS_NEED = 528 * MiB;
constexpr int CW_BAR = 4096;
constexpr int CW_CNT = 8192;
constexpr size_t CTL_ROWSS = 1 * MiB;
constexpr size_t RT_LIST = 0, RT_LRSTD = 1 * MiB, RT_TOKE = 2 * MiB  , RT_TOKR = 2 * MiB + 256 * 1024, RT_TOKW = 2 * MiB + 512 * 1024;

constexpr int LDS_STAGE = 131072, LDS_BYTES = 147456, LDS_MISC = LDS_BYTES - 1024;

typedef __bf16 bf16v2_t __attribute__((ext_vector_type(2)));
__device__ __forceinline__ unsigned cvt_pk_bf16(float lo, float hi) { const f32x2 v = {lo, hi}; const bf16v2_t b = __builtin_convertvector(v, bf16v2_t); return __builtin_bit_cast(unsigned, b); }
__device__ __forceinline__ float bf2f(unsigned short b) { return __uint_as_float(((unsigned)b) << 16); }
__device__ __forceinline__ float bflo(unsigned w) { return __uint_as_float(w << 16); }
__device__ __forceinline__ float bfhi(unsigned w) { return __uint_as_float(w & 0xffff0000u); }
__device__ __forceinline__ bf16_t f2bf(float f) { return (bf16_t)(cvt_pk_bf16(f, 0.f) & 0xffffu); }
__device__ __forceinline__ float wave_sum(float v) {
#pragma unroll
    for (int o = 1; o < 64; o <<= 1) v += __shfl_xor(v, o);
    return v;
}
__device__ __forceinline__ float sigmoidf_(float x) { return 1.0f / (1.0f + __expf(-x)); }
__device__ __forceinline__ float silu_(float x) { return x / (1.0f + __expf(-x)); }
__device__ __forceinline__ float gelu_tanh_(float x) { const float a = 0.7978845608028654f * (x + 0.044715f * x * x * x); return 0.5f * x * (1.0f + tanhf(a)); }
__device__ __forceinline__ int lane_now() { int l; asm volatile("v_mbcnt_lo_u32_b32 %0, -1, 0\n\tv_mbcnt_hi_u32_b32 %0, -1, %0" : "=v"(l)); return l; }
#define LDS_WAIT() asm volatile("s_waitcnt lgkmcnt(0)" ::: "memory")
#define VM_WAIT() asm volatile("s_waitcnt vmcnt(0)" ::: "memory")

#define XB_TMO      128
#define XB_XCNT(j)  (256  + 64 * (j))
#define XB_XSUB(j)  (1280 + 64 * (j))
#define XB_XGEN(j)  (2304 + 64 * (j))
#define XB_TOP      3328
#define XB_TOPGEN   3392
#define XCD_BAR_WORDS 3456
#define XB_SPIN_CAP (1u << 18)
__device__ __forceinline__ unsigned xb_ld(unsigned* p)              { return __hip_atomic_load(p, __ATOMIC_RELAXED, __HIP_MEMORY_SCOPE_AGENT); }
__device__ __forceinline__ unsigned xb_add(unsigned* p, unsigned v) { return __hip_atomic_fetch_add(p, v, __ATOMIC_RELAXED, __HIP_MEMORY_SCOPE_AGENT); }
__device__ __forceinline__ unsigned xb_xcc_id() { return (unsigned)__builtin_amdgcn_s_getreg((3 << 11) | 20) & 0xFu; }
#define XB_SPIN(cond, bar) do { unsigned _sp = 0; while (cond) { __builtin_amdgcn_s_sleep(1); \
    if ((++_sp & 255u) == 0u) { if (xb_ld(&(bar)[XB_TMO])) break; if (_sp > XB_SPIN_CAP) { atomicAdd(&(bar)[XB_TMO], 1u); break; } } } } while (0)
struct XcdBarrier { unsigned* bar; unsigned x; volatile LAS unsigned* st; };
__device__ __forceinline__ XcdBarrier xcd_barrier_post(unsigned* bar, volatile LAS unsigned* st) {
    XcdBarrier b; b.bar = bar; b.x = xb_xcc_id(); b.st = st;
    if (threadIdx.x == 0) (void)xb_add(&bar[XB_XCNT(b.x)], 1u);
    return b;
}
__device__ __forceinline__ void xcd_barrier_complete(unsigned* bar, unsigned x, unsigned& nloc, unsigned& nx) {
    const unsigned G = gridDim.x * gridDim.y * gridDim.z;
    unsigned sum, cnt, mine, sp = 0u;
    for (;;) {
        sum = 0u; cnt = 0u; mine = 0u;
#pragma unroll
        for (unsigned j = 0; j < 16; ++j) { const unsigned c = xb_ld(&bar[XB_XCNT(j)]); sum += c; cnt += (c > 0u) ? 1u : 0u; mine = (j == x) ? c : mine; }
        if (sum == G) break;
        __builtin_amdgcn_s_sleep(1);
        if ((++sp & 255u) == 0u) { if (xb_ld(&bar[XB_TMO])) break; if (sp > XB_SPIN_CAP) { atomicAdd(&bar[XB_TMO], 1u); break; } }
    }
    nloc = mine > 0u ? mine : 1u; nx = cnt > 0u ? cnt : 1u;
}
__device__ __forceinline__ void xcd_barrier(const XcdBarrier& b) {
    asm volatile("s_waitcnt vmcnt(0)" ::: "memory");
    __syncthreads();
    if (threadIdx.x == 0) {
        unsigned* bar = b.bar;
        __builtin_amdgcn_s_waitcnt(0);
        unsigned nloc = b.st[0], nx = b.st[1];
        if (nloc == 0u) { xcd_barrier_complete(bar, b.x, nloc, nx); b.st[0] = nloc; b.st[1] = nx; }
        const unsigned old = xb_add(&bar[XB_XSUB(b.x)], 1u);
        const unsigned gen = old / nloc;
        if (old + 1u == (gen + 1u) * nloc) {
            __builtin_amdgcn_fence(__ATOMIC_RELEASE, "agent");
            asm volatile("s_waitcnt vmcnt(0)" ::: "memory");
            const unsigned og = xb_add(&bar[XB_TOP], 1u);
            const unsigned tg = og / nx;
            if (og + 1u == (tg + 1u) * nx) xb_add(&bar[XB_TOPGEN], 1u);
            else XB_SPIN(xb_ld(&bar[XB_TOPGEN]) == tg, bar);
            __builtin_amdgcn_fence(__ATOMIC_ACQUIRE, "agent");
            xb_add(&bar[XB_XGEN(b.x)], 1u);
            asm volatile("s_waitcnt vmcnt(0)" ::: "memory");
        } else {
            XB_SPIN(xb_ld(&bar[XB_XGEN(b.x)]) == gen, bar);
            __builtin_amdgcn_fence(__ATOMIC_ACQUIRE, "agent");
            asm volatile("s_waitcnt vmcnt(0)" ::: "memory");
        }
    }
    __syncthreads();
}

namespace pg8 {
constexpr int BM = 256, BK = 64, HALF = 128, HTB = HALF * BK * 2, STAGE_BYTES = 8 * HTB, NXCD = 8, WGM = 8;
__host__ __device__ __forceinline__ int lds_byte(int r, int c) { const int st = (r >> 4) * 2 + (c >> 5), rr = r & 15, cc = c & 31, ob = rr * 64 + cc * 2; return st * 1024 + (ob ^ (((ob >> 9) & 1) << 5)); }
__host__ __device__ __forceinline__ void stage_rc(int b, int& R, int& C) { const int st = b / 1024, sb = b % 1024, swz = sb ^ (((sb >> 9) & 1) << 5); R = (st >> 1) * 16 + swz / 64; C = (st & 1) * 32 + (swz % 64) / 2; }
__host__ __device__ __forceinline__ int perm32(int rho) { const int n = rho >> 4, i = rho & 15; return 8 * (i >> 2) + 4 * n + (i & 3); }

struct Unit { int pm, pn, e, rb; };

struct TileOrder {
    int nM, nN, nwg, G, c;
    __device__ void init(int nM_, int nN_, int G_, int c_) { nM = nM_; nN = nN_; nwg = nM * nN; G = G_; c = c_; }
    __device__ bool tile(int i, int& pm, int& pn) const {
        const long L = (long)i * G + c; if (L >= nwg) return false;
        int wgid = (int)L; { const int q = nwg / NXCD, r = nwg % NXCD, xcd = wgid % NXCD, off = wgid / NXCD; wgid = (xcd < r ? xcd * (q + 1) : r * (q + 1) + (xcd - r) * q) + off; }
        const int nig = WGM * nN, gid = wgid / nig, fm = gid * WGM, gsz = (nM - fm) < WGM ? (nM - fm) : WGM;
        pm = fm + ((wgid % nig) % gsz); pn = (wgid % nig) / gsz; return true;
    }
};
struct DenseSched {
    static constexpr bool GATHER = false;
    TileOrder o; const char* A; const char* Bt; int K;
    __device__ void init(const void* A_, const void* Bt_, int M, int N, int K_, int G, int c) { o.init(M / BM, N / BM, G, c); A = (const char*)A_; Bt = (const char*)Bt_; K = K_; }
    __device__ __forceinline__ bool next(int i, Unit& u) const { u.e = 0; u.rb = 0; return o.tile(i, u.pm, u.pn); }
    __device__ __forceinline__ const char* a_base(const Unit& u) const { return A + (size_t)u.pm * BM * K * 2; }
    __device__ __forceinline__ const char* b_base(const Unit& u) const { return Bt + (size_t)u.pn * BM * K * 2; }
    __device__ __forceinline__ void gather_ids(const Unit&, int, int, int (&)[4]) const {}
};

template <class Epi, class Sched, bool ALIGN_EPI>
__device__ __forceinline__ void gemm_phase(LAS unsigned char* lds, const int K, const Sched& S, const Epi& E) {
    const int lane = lane_now(), wid = __builtin_amdgcn_readfirstlane(threadIdx.x >> 6), tid = wid * 64 + lane, wr = wid >> 2, wc = wid & 3, fr = lane & 15, fq = lane >> 4;
    const int nt = K / BK;
    unsigned voffA[2][2], voffB[2];
#pragma unroll
    for (int i = 0; i < 2; ++i) { int R, C; stage_rc(tid * 16 + i * 8192, R, C); const int Rb = (R & ~31) + perm32(R & 31);
        voffA[0][i] = (unsigned)(R * K + C) * 2u; voffA[1][i] = (unsigned)((R + HALF) * K + C) * 2u; voffB[i] = (unsigned)(Rb * K + C) * 2u; }
    const size_t kstep = (size_t)(BK * 2);
    const size_t hstep = (size_t)HALF * K * 2;
    const unsigned ldsw = (unsigned)wid * 1024u;
    const int aoff = lds_byte(wr * 64 + fr, fq * 8), boff = lds_byte(wc * 32 + fr, fq * 8);
#define PG8_SA(b, h) (((b) * 2 + (h)) * HTB)
#define PG8_SB(b, h) ((4 + (b) * 2 + (h)) * HTB)
#define PG8_STAGE(bufoff, gbase, voff) do { _Pragma("unroll") for (int _i = 0; _i < 2; ++_i) \
        __builtin_amdgcn_global_load_lds((const unsigned*)((const char*)(gbase) + (voff)[_i]), (LAS unsigned*)(lds + (bufoff) + ldsw + _i * 8192), 16, 0, 0); } while (0)
#define PG8_STAGE_A(bufoff, gbase, h) do { if constexpr (Sched::GATHER) { \
        __builtin_amdgcn_global_load_lds((const unsigned*)((const char*)(gbase) + ((voffA[h][0] & 0xffffu) * (unsigned)(K * 2) + (cpk & 0xffffu))), (LAS unsigned*)(lds + (bufoff) + ldsw), 16, 0, 0); \
        __builtin_amdgcn_global_load_lds((const unsigned*)((const char*)(gbase) + ((voffA[h][0] >> 16) * (unsigned)(K * 2) + (cpk >> 16))), (LAS unsigned*)(lds + (bufoff) + ldsw + 8192), 16, 0, 0); \
        } else { PG8_STAGE(bufoff, gbase, voffA[h]); } } while (0)
#define PG8_LDA(dst, b, h) do { _Pragma("unroll") for (int m = 0; m < 4; ++m) _Pragma("unroll") for (int k = 0; k < 2; ++k) dst[m][k] = *(const LAS bf16x8*)(lds + PG8_SA(b, h) + aoff + m * 2048 + k * 1024); } while (0)
#define PG8_LDB(dst, b, h) do { _Pragma("unroll") for (int n = 0; n < 2; ++n) _Pragma("unroll") for (int k = 0; k < 2; ++k) dst[n][k] = *(const LAS bf16x8*)(lds + PG8_SB(b, h) + boff + n * 2048 + k * 1024); } while (0)
#define PG8_MMA(ai, bj, At, Bt) do { __builtin_amdgcn_s_setprio(1); _Pragma("unroll") for (int m = 0; m < 4; ++m) _Pragma("unroll") for (int n = 0; n < 2; ++n) _Pragma("unroll") for (int k = 0; k < 2; ++k) \
        acc[ai][bj][m][n] = __builtin_amdgcn_mfma_f32_16x16x32_bf16(Bt[n][k], At[m][k], acc[ai][bj][m][n], 0, 0, 0); __builtin_amdgcn_s_setprio(0); } while (0)
#define PG8_WAIT_V(n) asm volatile("s_waitcnt vmcnt(" #n ")" ::: "memory")
#define PG8_WAIT_L(n) asm volatile("s_waitcnt lgkmcnt(" #n ")" ::: "memory")
#define PG8_BAR __builtin_amdgcn_s_barrier()
#define PG8_SCHED __builtin_amdgcn_sched_barrier(0)
    Unit cur, nxt; int ui = 0;
    if (!S.next(0, cur)) return;
    unsigned cpk = 0u;
    if constexpr (Sched::GATHER) { int ids[4]; int R0, C0, R1, C1; stage_rc(tid * 16, R0, C0); stage_rc(tid * 16 + 8192, R1, C1); S.gather_ids(cur, R0, R1, ids);
        cpk = (unsigned)(C0 * 2) | ((unsigned)(C1 * 2) << 16);
#pragma unroll
        for (int h = 0; h < 2; ++h) voffA[h][0] = (unsigned)ids[h * 2 + 0] | ((unsigned)ids[h * 2 + 1] << 16); }
    f32x4 acc[2][2][4][2];
#pragma unroll
    for (int a = 0; a < 2; ++a)
#pragma unroll
        for (int b = 0; b < 2; ++b)
#pragma unroll
            for (int m = 0; m < 4; ++m)
#pragma unroll
                for (int n = 0; n < 2; ++n) acc[a][b][m][n] = (f32x4){0.f, 0.f, 0.f, 0.f};
    bf16x8 At[4][2], B0[2][2], B1[2][2];
    const char* cA = S.a_base(cur); const char* cB = S.b_base(cur);
    PG8_STAGE(PG8_SB(0, 0), cB, voffB); PG8_STAGE(PG8_SB(0, 1), cB + hstep, voffB); PG8_STAGE_A(PG8_SA(0, 0), cA, 0); PG8_STAGE_A(PG8_SA(0, 1), cA, 1);
    if (wr == 1) PG8_BAR;
    PG8_WAIT_V(2); PG8_BAR;
    PG8_STAGE(PG8_SB(1, 0), cB + kstep, voffB); PG8_STAGE_A(PG8_SA(1, 0), cA + kstep, 0); PG8_STAGE(PG8_SB(1, 1), cB + hstep + kstep, voffB);
    PG8_WAIT_V(6); PG8_BAR;
    for (;;) {
        const bool has_next = S.next(ui + 1, nxt);
        const char* nA = has_next ? S.a_base(nxt) : cA; const char* nB = has_next ? S.b_base(nxt) : cB;
        unsigned voffN[2] = {0u, 0u};
        for (int t = 0; t < nt; t += 2) {
            const bool last = (t == nt - 2);
            const char* a1 = cA + (size_t)(t + 1) * kstep;
            const char* a2 = last ? nA : cA + (size_t)(t + 2) * kstep; const char* b2 = last ? nB : cB + (size_t)(t + 2) * kstep;
            const char* a3 = a2 + kstep; const char* b3 = b2 + kstep;
            if constexpr (Sched::GATHER) { if (t == nt - 4 && has_next) { int ids[4]; int R0, C0, R1, C1; const int tid2 = wid * 64 + lane_now(); stage_rc(tid2 * 16, R0, C0); stage_rc(tid2 * 16 + 8192, R1, C1); S.gather_ids(nxt, R0, R1, ids);
#pragma unroll
                for (int h = 0; h < 2; ++h) voffN[h] = (unsigned)ids[h * 2 + 0] | ((unsigned)ids[h * 2 + 1] << 16); } }
            PG8_LDB(B0, 0, 0); PG8_LDB(B1, 0, 1); PG8_SCHED; PG8_LDA(At, 0, 0); PG8_STAGE_A(PG8_SA(1, 1), a1, 1);
            if constexpr (Sched::GATHER) { if (last && has_next) { voffA[0][0] = voffN[0]; voffA[1][0] = voffN[1]; } }
            PG8_WAIT_V(8); PG8_WAIT_L(0); PG8_BAR; PG8_MMA(0, 0, At, B0); PG8_MMA(0, 1, At, B1); PG8_BAR; PG8_SCHED;
            PG8_LDA(At, 0, 1); PG8_STAGE(PG8_SB(0, 0), b2, voffB); PG8_STAGE(PG8_SB(0, 1), b2 + hstep, voffB); PG8_STAGE_A(PG8_SA(0, 0), a2, 0);
            PG8_WAIT_V(8); PG8_WAIT_L(0); PG8_BAR; PG8_MMA(1, 0, At, B0); PG8_MMA(1, 1, At, B1); PG8_BAR; PG8_SCHED;
            PG8_LDB(B0, 1, 0); PG8_LDB(B1, 1, 1); PG8_SCHED; PG8_LDA(At, 1, 0); PG8_STAGE_A(PG8_SA(0, 1), a2, 1);
            PG8_WAIT_V(8); PG8_WAIT_L(0); PG8_BAR; PG8_MMA(0, 0, At, B0); PG8_MMA(0, 1, At, B1); PG8_BAR; PG8_SCHED;
            PG8_LDA(At, 1, 1); PG8_STAGE(PG8_SB(1, 0), b3, voffB); PG8_STAGE(PG8_SB(1, 1), b3 + hstep, voffB); PG8_STAGE_A(PG8_SA(1, 0), a3, 0);
            PG8_WAIT_V(8); PG8_WAIT_L(0); PG8_BAR; PG8_MMA(1, 0, At, B0); PG8_MMA(1, 1, At, B1); PG8_BAR; PG8_SCHED;
        }
        if constexpr (ALIGN_EPI) { if (wr == 0) PG8_BAR; }
        E(acc, cur, wr, wc, fr, fq);
        if (!has_next) break;
#pragma unroll
        for (int a = 0; a < 2; ++a)
#pragma unroll
            for (int b = 0; b < 2; ++b)
#pragma unroll
                for (int m = 0; m < 4; ++m)
#pragma unroll
                    for (int n = 0; n < 2; ++n) acc[a][b][m][n] = (f32x4){0.f, 0.f, 0.f, 0.f};
        cur = nxt; cA = nA; cB = nB; ++ui;
        if constexpr (ALIGN_EPI) { if (wr == 1) PG8_BAR; }
    }
    PG8_WAIT_V(0);
    if constexpr (!ALIGN_EPI) { if (wr == 0) PG8_BAR; }
    PG8_BAR;
#undef PG8_SA
#undef PG8_SB
#undef PG8_STAGE
#undef PG8_STAGE_A
#undef PG8_LDA
#undef PG8_LDB
#undef PG8_MMA
#undef PG8_WAIT_V
#undef PG8_WAIT_L
#undef PG8_BAR
#undef PG8_SCHED
}
}
using pg8::Unit;

__device__ __forceinline__ float rstd_of(float ss) { return 1.0f / sqrtf(ss * (1.0f / D) + RMS_EPS); }
typedef unsigned long long rss_t;
__device__ __forceinline__ float rstd_fx(rss_t s) { return rstd_of((float)((double)s * (1.0 / 16777216.0))); }
__device__ __forceinline__ rss_t rss_fx(float ss) { return (rss_t)__float2ull_rn(ss * 16777216.0f); }

struct EpiInA {
    bf16_t* U; bf16_t* Q; const rss_t* rowss;
    __device__ __forceinline__ void operator()(const f32x4 (&acc)[2][2][4][2], const Unit& u, int wr, int wc, int fr, int fq) const {
        const int row0 = u.pm * 256 + wr * 64 + fr, col0 = u.pn * 256 + wc * 32 + 8 * fq;
#pragma unroll
        for (int ai = 0; ai < 2; ++ai)
#pragma unroll
            for (int m = 0; m < 4; ++m) { const int row = row0 + ai * 128 + m * 16; const float rs = rstd_fx(rowss[row]);
#pragma unroll
                for (int bj = 0; bj < 2; ++bj) { const int c = col0 + bj * 128; const f32x4 v0 = acc[ai][bj][m][0] * rs, v1 = acc[ai][bj][m][1] * rs;
                    u32x4 w; w.x = cvt_pk_bf16(v0[0], v0[1]); w.y = cvt_pk_bf16(v0[2], v0[3]); w.z = cvt_pk_bf16(v1[0], v1[1]); w.w = cvt_pk_bf16(v1[2], v1[3]);
                    if (c < CS) { const int g = c >> 4, hf = (c >> 3) & 1, b = row >> 12, t = row & 4095; *(u32x4*)(U + (((size_t)(b * S5G + g) * SEQ + t) * 16 + 8 * hf)) = w; }
                    else *(u32x4*)(Q + (size_t)row * CM + (c - CS)) = w; } }
    }
};
struct EpiBf16 {
    bf16_t* O; int ldc; const rss_t* rowss; bf16_t* Q; int qcol0;
    __device__ __forceinline__ void operator()(const f32x4 (&acc)[2][2][4][2], const Unit& u, int wr, int wc, int fr, int fq) const {
        const int row0 = u.pm * 256 + wr * 64 + fr, col0 = u.pn * 256 + wc * 32 + 8 * fq;
#pragma unroll
        for (int ai = 0; ai < 2; ++ai)
#pragma unroll
            for (int m = 0; m < 4; ++m) { const int row = row0 + ai * 128 + m * 16; const float rs = rowss ? rstd_fx(rowss[row]) : 1.0f;
#pragma unroll
                for (int bj = 0; bj < 2; ++bj) { const int c = col0 + bj * 128; const f32x4 v0 = acc[ai][bj][m][0] * rs, v1 = acc[ai][bj][m][1] * rs;
                    u32x4 w; w.x = cvt_pk_bf16(v0[0], v0[1]); w.y = cvt_pk_bf16(v0[2], v0[3]); w.z = cvt_pk_bf16(v1[0], v1[1]); w.w = cvt_pk_bf16(v1[2], v1[3]);
                    if (Q && c >= qcol0) *(u32x4*)(Q + (size_t)row * CM + (c - qcol0)) = w;
                    else *(u32x4*)(O + (size_t)row * ldc + c) = w; } }
    }
};
struct EpiRes {
    const float* Xin; float* Xout; bf16_t* H; rss_t* rowss;
    __device__ __forceinline__ void operator()(const f32x4 (&acc)[2][2][4][2], const Unit& u, int wr, int wc, int fr, int fq) const {
        const int row0 = u.pm * 256 + wr * 64 + fr, col0 = u.pn * 256 + wc * 32 + 8 * fq;
#pragma unroll
        for (int ai = 0; ai < 2; ++ai)
#pragma unroll
            for (int m = 0; m < 4; ++m) { const int row = row0 + ai * 128 + m * 16; float ss = 0.f;
#pragma unroll
                for (int bj = 0; bj < 2; ++bj) { const size_t o = (size_t)row * D + col0 + bj * 128;
                    const f32x4 x0 = *(const f32x4*)(Xin + o), x1 = *(const f32x4*)(Xin + o + 4);
                    const f32x4 v0 = acc[ai][bj][m][0] + x0, v1 = acc[ai][bj][m][1] + x1;
                    *(f32x4*)(Xout + o) = v0; *(f32x4*)(Xout + o + 4) = v1;
                    u32x4 w; w.x = cvt_pk_bf16(v0[0], v0[1]); w.y = cvt_pk_bf16(v0[2], v0[3]); w.z = cvt_pk_bf16(v1[0], v1[1]); w.w = cvt_pk_bf16(v1[2], v1[3]);
                    *(u32x4*)(H + o) = w;
                    ss += (v0[0] * v0[0] + v0[1] * v0[1]) + (v0[2] * v0[2] + v0[3] * v0[3]) + (v1[0] * v1[0] + v1[1] * v1[1]) + (v1[2] * v1[2] + v1[3] * v1[3]); }
                ss += __shfl_xor(ss, 16); ss += __shfl_xor(ss, 32);
                if (fq == 0) atomicAdd(rowss + row, rss_fx(ss));
                asm volatile("" ::: "memory"); }
    }
};
struct EpiSwiglu {
    bf16_t* O; int ldo; const rss_t* rowss; const float* rsv;
    __device__ __forceinline__ void operator()(const f32x4 (&acc)[2][2][4][2], const Unit& u, int wr, int wc, int fr, int fq) const {
        const int lrow0 = wr * 64 + fr, col0 = u.pn * 128 + wc * 32 + 8 * fq;
#pragma unroll
        for (int ai = 0; ai < 2; ++ai)
#pragma unroll
            for (int m = 0; m < 4; ++m) { const int lrow = lrow0 + ai * 128 + m * 16;
                float rs; size_t orow;
                if (rsv) { rs = rsv[u.rb + lrow]; orow = (size_t)u.e + lrow; } else { const int row = u.pm * 256 + lrow; rs = rstd_fx(rowss[row]); orow = row; }
                const f32x4 g0 = acc[ai][0][m][0] * rs, g1 = acc[ai][0][m][1] * rs, u0 = acc[ai][1][m][0] * rs, u1 = acc[ai][1][m][1] * rs;
                u32x4 w; w.x = cvt_pk_bf16(silu_(g0[0]) * u0[0], silu_(g0[1]) * u0[1]); w.y = cvt_pk_bf16(silu_(g0[2]) * u0[2], silu_(g0[3]) * u0[3]);
                w.z = cvt_pk_bf16(silu_(g1[0]) * u1[0], silu_(g1[1]) * u1[1]); w.w = cvt_pk_bf16(silu_(g1[2]) * u1[2], silu_(g1[3]) * u1[3]);
                *(u32x4*)(O + orow * ldo + col0) = w; }
    }
};
struct EpiSlot {
    bf16_t* O;
    __device__ __forceinline__ void operator()(const f32x4 (&acc)[2][2][4][2], const Unit& u, int wr, int wc, int fr, int fq) const {
        const int lrow0 = wr * 64 + fr, col0 = u.pn * 256 + wc * 32 + 8 * fq;
#pragma unroll
        for (int ai = 0; ai < 2; ++ai)
#pragma unroll
            for (int m = 0; m < 4; ++m) { const size_t orow = (size_t)u.e + lrow0 + ai * 128 + m * 16;
#pragma unroll
                for (int bj = 0; bj < 2; ++bj) { const f32x4 v0 = acc[ai][bj][m][0], v1 = acc[ai][bj][m][1];
                    u32x4 w; w.x = cvt_pk_bf16(v0[0], v0[1]); w.y = cvt_pk_bf16(v0[2], v0[3]); w.z = cvt_pk_bf16(v1[0], v1[1]); w.w = cvt_pk_bf16(v1[2], v1[3]);
                    *(u32x4*)(O + orow * D + col0 + bj * 128) = w; } }
    }
};

struct MoeGuSched {
    static constexpr bool GATHER = true;
    pg8::TileOrder o; const char* A; const char* W; const int* list; const LAS int* tab; int tile0;
    __device__ __forceinline__ bool next(int i, Unit& u) const {
        if (!o.tile(i, u.pm, u.pn)) return false;
        const int gt = tile0 + u.pm; int e = 0;
#pragma unroll
        for (int k = 1; k < 8; ++k) e += (gt >= tab[k]) ? 1 : 0;
        e = __builtin_amdgcn_readfirstlane(e);
        u.rb = __builtin_amdgcn_readfirstlane(e * 32768 + (gt - tab[e]) * 256); u.e = u.pm * 256; return true;
    }
    __device__ __forceinline__ const char* a_base(const Unit&) const { return A; }
    __device__ __forceinline__ const char* b_base(const Unit& u) const { return W + ((size_t)(u.rb >> 15) * (2 * FE) + (size_t)u.pn * 256) * (D * 2); }
    __device__ __forceinline__ void gather_ids(const Unit& u, int R0, int R1, int (&ids)[4]) const {
        const int e = u.rb >> 15, rank0 = u.rb & 32767, cnt = __builtin_amdgcn_readfirstlane(tab[16 + e]);
#pragma unroll
        for (int h = 0; h < 2; ++h) { const int r0 = R0 + 128 * h, r1 = R1 + 128 * h;
            ids[h * 2 + 0] = (rank0 + r0 < cnt) ? list[u.rb + r0] : 0; ids[h * 2 + 1] = (rank0 + r1 < cnt) ? list[u.rb + r1] : 0; }
    }
};
struct MoeDownSched {
    static constexpr bool GATHER = false;
    pg8::TileOrder o; const char* A; const char* W; const LAS int* tab; int tile0;
    __device__ __forceinline__ bool next(int i, Unit& u) const {
        if (!o.tile(i, u.pm, u.pn)) return false;
        const int gt = tile0 + u.pm; int e = 0;
#pragma unroll
        for (int k = 1; k < 8; ++k) e += (gt >= tab[k]) ? 1 : 0;
        u.rb = __builtin_amdgcn_readfirstlane(e); u.e = gt * 256; return true;
    }
    __device__ __forceinline__ const char* a_base(const Unit& u) const { return A + (size_t)u.pm * 256 * (FE * 2); }
    __device__ __forceinline__ const char* b_base(const Unit& u) const { return W + ((size_t)u.rb * D + (size_t)u.pn * 256) * (FE * 2); }
    __device__ __forceinline__ void gather_ids(const Unit&, int, int, int (&)[4]) const {}
};

__device__ __forceinline__ void tr_item(const float* W, int K, int N, bf16_t* WT, const float* gain, int mode, LAS float* scr, int item, int lane) {
    const int nblk = N / 32, kb = item / nblk, nb = item % nblk, k0 = 64 * kb, n0 = 32 * nb;
#pragma unroll 8
    for (int i = 0; i < 32; ++i) { const int kk = 2 * i + (lane >> 5); float v = W[(size_t)(k0 + kk) * N + n0 + (lane & 31)]; if (gain) v *= gain[k0 + kk]; scr[kk * 33 + (lane & 31)] = v; }
    LDS_WAIT(); asm volatile("" ::: "memory");
    const int c = lane & 7;
#pragma unroll
    for (int j = 0; j < 4; ++j) { const int n = (lane >> 3) + 8 * j; const LAS float* s = scr + (8 * c) * 33 + n;
        u32x4 o; o.x = cvt_pk_bf16(s[0 * 33], s[1 * 33]); o.y = cvt_pk_bf16(s[2 * 33], s[3 * 33]); o.z = cvt_pk_bf16(s[4 * 33], s[5 * 33]); o.w = cvt_pk_bf16(s[6 * 33], s[7 * 33]);
        const int nn = n0 + n; const int row = (mode == 0) ? nn : (((nn >> 7) << 8) + (nn & 127) + (mode == 2 ? 128 : 0));
        *(u32x4*)(WT + (size_t)row * K + k0 + 8 * c) = o; }
    LDS_WAIT(); asm volatile("" ::: "memory");
}
struct TrJob { const float* W; bf16_t* WT; const float* gain; int K, N, mode, items; };


struct Args { const float* in[N_IN]; float* out; unsigned char* ws; int ph_lo, ph_hi, pass_lo, pass_hi; };

__device__ __forceinline__ void attn_naive(LAS unsigned char* lds, const bf16_t* Q, const bf16_t* KV, bf16_t* CAT, int bx, int G, int tid) {
    LAS float* Ks = (LAS float*)lds; LAS float* Vs = Ks + 256 * 64;
    for (int item = bx; item < NB * NH_MEM * 8; item += G) {
        const int b = item >> 5, h = (item >> 3) & 3, qb = item & 7;
#pragma unroll 4
        for (int i = 0; i < 32; ++i) { const int idx = tid + 512 * i, m = idx >> 6, d = idx & 63;
            const bf16_t* kr = KV + (size_t)(b * MEML + m) * 512 + h * 64 + d;
            Ks[idx] = bf2f(kr[0]); Vs[idx] = bf2f(kr[256]); }
        __syncthreads();
        const int row = b * SEQ + qb * 512 + tid;
        float q[64], o[64];
        { const u32x4* qp = (const u32x4*)(Q + (size_t)row * CM + h * 64);
#pragma unroll
          for (int i = 0; i < 8; ++i) { const u32x4 w = qp[i];
              q[8 * i + 0] = bflo(w.x) * 0.125f; q[8 * i + 1] = bfhi(w.x) * 0.125f; q[8 * i + 2] = bflo(w.y) * 0.125f; q[8 * i + 3] = bfhi(w.y) * 0.125f;
              q[8 * i + 4] = bflo(w.z) * 0.125f; q[8 * i + 5] = bfhi(w.z) * 0.125f; q[8 * i + 6] = bflo(w.w) * 0.125f; q[8 * i + 7] = bfhi(w.w) * 0.125f; } }
#pragma unroll
        for (int d = 0; d < 64; ++d) o[d] = 0.f;
        float mx = -1e30f, l = 0.f;
#pragma unroll 1
        for (int key = 0; key < MEML; ++key) {
            const LAS f32x4* kr = (const LAS f32x4*)(Ks + key * 64); float sc = 0.f;
#pragma unroll
            for (int d4 = 0; d4 < 16; ++d4) { const f32x4 kv = kr[d4]; sc += q[4 * d4] * kv[0] + q[4 * d4 + 1] * kv[1] + q[4 * d4 + 2] * kv[2] + q[4 * d4 + 3] * kv[3]; }
            const float mn = fmaxf(mx, sc), alpha = __expf(mx - mn), p = __expf(sc - mn); mx = mn; l = l * alpha + p;
            const LAS f32x4* vr = (const LAS f32x4*)(Vs + key * 64);
#pragma unroll
            for (int d4 = 0; d4 < 16; ++d4) { const f32x4 vv = vr[d4]; o[4 * d4] = o[4 * d4] * alpha + p * vv[0]; o[4 * d4 + 1] = o[4 * d4 + 1] * alpha + p * vv[1]; o[4 * d4 + 2] = o[4 * d4 + 2] * alpha + p * vv[2]; o[4 * d4 + 3] = o[4 * d4 + 3] * alpha + p * vv[3]; }
        }
        const float il = 1.0f / l;
        u32x4* op = (u32x4*)(CAT + (size_t)row * D + CS + h * 64);
#pragma unroll
        for (int i = 0; i < 8; ++i) { u32x4 w; w.x = cvt_pk_bf16(o[8 * i] * il, o[8 * i + 1] * il); w.y = cvt_pk_bf16(o[8 * i + 2] * il, o[8 * i + 3] * il);
            w.z = cvt_pk_bf16(o[8 * i + 4] * il, o[8 * i + 5] * il); w.w = cvt_pk_bf16(o[8 * i + 6] * il, o[8 * i + 7] * il); op[i] = w; }
        __syncthreads();
    }
}

__device__ __forceinline__ void s5_naive(const Args& a, LAS unsigned char* lds, const bf16_t* U, bf16_t* CAT, int bx, int G, int wave, int lane) {
    LAS float* xs = (LAS float*)(lds + wave * 1024);
    for (int it = bx + G * wave; it < NB * S5G; it += G * NWAVES) {
        const int b = it / S5G, g = it % S5G, p = lane;
        const double dt = exp((double)a.in[I_LOG_DT][g]), lr = a.in[I_LAM_RE][g * S5P + p], li = a.in[I_LAM_IM][g * S5P + p];
        const double mag = exp(lr * dt), ang = li * dt, abr_d = mag * cos(ang), abi_d = mag * sin(ang);
        const double nre = abr_d - 1.0, nim = abi_d, den = lr * lr + li * li, zr = (nre * lr + nim * li) / den, zi = (nim * lr - nre * li) / den;
        const float abr = (float)abr_d, abi = (float)abi_d;
        float bbr[16], bbi[16], cre[16], cim[16], wg[16];
#pragma unroll
        for (int j = 0; j < 16; ++j) { const double br = a.in[I_B_RE][(size_t)(g * S5P + p) * 16 + j], bi = a.in[I_B_IM][(size_t)(g * S5P + p) * 16 + j]; bbr[j] = (float)(zr * br - zi * bi); bbi[j] = (float)(zr * bi + zi * br); }
        const int jj = lane & 15, pq = lane >> 4;
#pragma unroll
        for (int q = 0; q < 16; ++q) { cre[q] = a.in[I_C_RE][(size_t)(g * 16 + jj) * S5P + 16 * pq + q]; cim[q] = a.in[I_C_IM][(size_t)(g * 16 + jj) * S5P + 16 * pq + q]; }
#pragma unroll
        for (int j = 0; j < 16; ++j) wg[j] = a.in[I_WGLU][(size_t)(g * 16 + j) * 16 + jj];
        const float dj = a.in[I_S5D][g * 16 + jj], bg = a.in[I_BGLU][g * 16 + jj];
        const bf16_t* up = U + (size_t)(b * S5G + g) * SEQ * 16;
        float xr = 0.f, xi = 0.f;
#pragma unroll 1
        for (int t = 0; t < SEQ; ++t) {
            const u32x4 w0 = *(const u32x4*)(up + (size_t)t * 16), w1 = *(const u32x4*)(up + (size_t)t * 16 + 8);
            float uf[16];
            uf[0] = bflo(w0.x); uf[1] = bfhi(w0.x); uf[2] = bflo(w0.y); uf[3] = bfhi(w0.y); uf[4] = bflo(w0.z); uf[5] = bfhi(w0.z); uf[6] = bflo(w0.w); uf[7] = bfhi(w0.w);
            uf[8] = bflo(w1.x); uf[9] = bfhi(w1.x); uf[10] = bflo(w1.y); uf[11] = bfhi(w1.y); uf[12] = bflo(w1.z); uf[13] = bfhi(w1.z); uf[14] = bflo(w1.w); uf[15] = bfhi(w1.w);
            const float uj = bf2f(up[(size_t)t * 16 + jj]);
            float bur = 0.f, bui = 0.f;
#pragma unroll
            for (int j = 0; j < 16; ++j) { bur += bbr[j] * uf[j]; bui += bbi[j] * uf[j]; }
            const float nxr = abr * xr - abi * xi + bur, nxi = abr * xi + abi * xr + bui; xr = nxr; xi = nxi;
            xs[p] = xr; xs[64 + p] = xi;
            LDS_WAIT(); asm volatile("" ::: "memory");
            float s = 0.f;
#pragma unroll
            for (int q4 = 0; q4 < 4; ++q4) { const f32x4 vr = *(const LAS f32x4*)(xs + 16 * pq + 4 * q4), vi = *(const LAS f32x4*)(xs + 64 + 16 * pq + 4 * q4);
#pragma unroll
                for (int e = 0; e < 4; ++e) s += cre[4 * q4 + e] * vr[e] - cim[4 * q4 + e] * vi[e]; }
            LDS_WAIT(); asm volatile("" ::: "memory");
            s += __shfl_xor(s, 16); s += __shfl_xor(s, 32);
            const float yg = gelu_tanh_(s + dj * uj);
            float z = bg;
#pragma unroll
            for (int j = 0; j < 16; ++j) z += __shfl(yg, j) * wg[j];
            const float o = yg * sigmoidf_(z);
            if (lane < 16) CAT[(size_t)(b * SEQ + t) * D + g * 16 + lane] = f2bf(o);
        }
    }
}

__device__ __forceinline__ void rwkv_prep(const Args& a, LAS unsigned char* lds, const bf16_t* P1, bf16_t* RA, bf16_t* RKK, bf16_t* RLD, bf16_t* RG, int bx, int G, int tid) {
    LAS float* twT = (LAS float*)lds; LAS float* adT = twT + 64 * 16; LAS float* sgT = adT + 64 * 16;
    const float* mu = a.in[I_MU];
    for (int tile = bx; tile < T / 16; tile += G) {
        __syncthreads();
#pragma unroll
        for (int i = 0; i < 8; ++i) { const int idx = tid + 512 * i, tok = idx >> 8, c = idx & 255, row = tile * 16 + tok, t = row & (SEQ - 1);
            const float cur = bf2f(P1[(size_t)row * INB + 2304 + c]), prev = t > 0 ? bf2f(P1[(size_t)(row - 1) * INB + 2304 + c]) : 0.f;
            const float xsv = cur + (prev - cur) * mu[2304 + c];
            if (c < 64) twT[c * 16 + tok] = tanhf(xsv); else if (c < 128) adT[(c - 64) * 16 + tok] = xsv; else sgT[(c - 128) * 16 + tok] = sigmoidf_(xsv); }
        __syncthreads();
        if (tid < 384) {
#pragma unroll 1
            for (int cc = 0; cc < 2; ++cc) { const int c = tid + 384 * cc;
                float aw[16], aa[16], ag[16];
#pragma unroll
                for (int k = 0; k < 16; ++k) { aw[k] = 0.f; aa[k] = 0.f; ag[k] = 0.f; }
#pragma unroll 2
                for (int m = 0; m < 64; ++m) { const float w2v = a.in[I_W2][(size_t)m * CS + c], a2v = a.in[I_A2][(size_t)m * CS + c];
#pragma unroll
                    for (int k4 = 0; k4 < 4; ++k4) { const f32x4 tw = *(const LAS f32x4*)(twT + m * 16 + 4 * k4), ad = *(const LAS f32x4*)(adT + m * 16 + 4 * k4);
#pragma unroll
                        for (int e = 0; e < 4; ++e) { aw[4 * k4 + e] += tw[e] * w2v; aa[4 * k4 + e] += ad[e] * a2v; } } }
#pragma unroll 2
                for (int m = 0; m < 128; ++m) { const float g2v = a.in[I_G2][(size_t)m * CS + c];
#pragma unroll
                    for (int k4 = 0; k4 < 4; ++k4) { const f32x4 sg = *(const LAS f32x4*)(sgT + m * 16 + 4 * k4);
#pragma unroll
                        for (int e = 0; e < 4; ++e) ag[4 * k4 + e] += sg[e] * g2v; } }
                const float w0 = a.in[I_W0][c], a0 = a.in[I_A0][c], kkw = a.in[I_KK][c], muk = mu[CS + c];
#pragma unroll
                for (int k = 0; k < 16; ++k) { const int row = tile * 16 + k, t = row & (SEQ - 1);
                    const float z = -(w0 + aw[k]);
                    const float sp = z > 20.f ? z : log1pf(__expf(z));
                    const float ld = -__expf(-sp - 0.5f);
                    const float av = sigmoidf_(a0 + aa[k]);
                    const float cur = bf2f(P1[(size_t)row * INB + CS + c]), prev = t > 0 ? bf2f(P1[(size_t)(row - 1) * INB + CS + c]) : 0.f;
                    const float kx = (cur + (prev - cur) * muk) * kkw;
                    const float ss = wave_sum(kx * kx);
                    const float kkv = kx / fmaxf(sqrtf(ss), 1e-12f);
                    const size_t o = (size_t)row * CS + c;
                    RA[o] = f2bf(av); RKK[o] = f2bf(kkv); RLD[o] = f2bf(ld); RG[o] = f2bf(ag[k]); }
            }
        }
    }
}

__device__ __forceinline__ void rwkv_naive(const Args& a, LAS unsigned char* lds, const bf16_t* P1, const bf16_t* RA, const bf16_t* RKK, const bf16_t* RLD, const bf16_t* RG, bf16_t* CAT, int bx, int G, int wave, int lane) {
    if (wave != 4) return;
    LAS float* vec = (LAS float*)lds;
    for (int item = bx; item < NB * RH; item += G) {
        const int b = item / RH, h = item % RH, c = h * 64 + lane;
        const float mur = a.in[I_MU][c], muk = a.in[I_MU][CS + c], muv = a.in[I_MU][2 * CS + c], ka = a.in[I_KA][c], rkc = a.in[I_RK][c], lw = a.in[I_LNXW][c], lb = a.in[I_LNXB][c];
        float S[64];
#pragma unroll
        for (int j = 0; j < 64; ++j) S[j] = 0.f;
        float prr = 0.f, prk = 0.f, prv = 0.f;
        const size_t row0 = (size_t)b * SEQ;
        bf16_t n_r = P1[row0 * INB + c], n_k = P1[row0 * INB + CS + c], n_v = P1[row0 * INB + 2 * CS + c], n_a = RA[row0 * CS + c], n_kk = RKK[row0 * CS + c], n_ld = RLD[row0 * CS + c], n_g = RG[row0 * CS + c];
#pragma unroll 1
        for (int t = 0; t < SEQ; ++t) {
            const float pr = bf2f(n_r), pk = bf2f(n_k), pv = bf2f(n_v), av = bf2f(n_a), kkv = bf2f(n_kk), ld = bf2f(n_ld), gv = bf2f(n_g);
            if (t + 1 < SEQ) { const size_t rn = row0 + t + 1; n_r = P1[rn * INB + c]; n_k = P1[rn * INB + CS + c]; n_v = P1[rn * INB + 2 * CS + c]; n_a = RA[rn * CS + c]; n_kk = RKK[rn * CS + c]; n_ld = RLD[rn * CS + c]; n_g = RG[rn * CS + c]; }
            const float r = pr + (prr - pr) * mur, k = pk + (prk - pk) * muk, v = pv + (prv - pv) * muv;
            prr = pr; prk = pk; prv = pv;
            const float kp = k * (1.f + (av - 1.f) * ka), ap = -kkv, bb = kkv * av, w = __expf(ld);
            vec[lane] = r; vec[64 + lane] = w; vec[128 + lane] = kp; vec[192 + lane] = ap; vec[256 + lane] = bb;
            LDS_WAIT(); asm volatile("" ::: "memory");
            float sa = 0.f;
#pragma unroll
            for (int j4 = 0; j4 < 16; ++j4) { const f32x4 x = *(const LAS f32x4*)(vec + 192 + 4 * j4); sa += S[4 * j4] * x[0] + S[4 * j4 + 1] * x[1] + S[4 * j4 + 2] * x[2] + S[4 * j4 + 3] * x[3]; }
            float y = 0.f;
#pragma unroll
            for (int j4 = 0; j4 < 16; ++j4) { const f32x4 wv = *(const LAS f32x4*)(vec + 64 + 4 * j4), bv = *(const LAS f32x4*)(vec + 256 + 4 * j4), kv = *(const LAS f32x4*)(vec + 128 + 4 * j4), rv = *(const LAS f32x4*)(vec + 4 * j4);
#pragma unroll
                for (int e = 0; e < 4; ++e) { const float s = S[4 * j4 + e] * wv[e] + sa * bv[e] + v * kv[e]; S[4 * j4 + e] = s; y += s * rv[e]; } }
            LDS_WAIT(); asm volatile("" ::: "memory");
            const float rkv = wave_sum(r * kp * rkc), bonus = rkv * v;
            const float mean = wave_sum(y) * (1.f / 64.f), dlt = y - mean, var = wave_sum(dlt * dlt) * (1.f / 64.f);
            const float yn = dlt * (1.0f / sqrtf(var + LNX_EPS)) * lw + lb;
            CAT[(row0 + t) * D + c] = f2bf((yn + bonus) * gv);
        }
    }
}

__device__ __forceinline__ void moe_router(const Args& a, const float* X, unsigned* ctl, unsigned char* ws, int gw, int NGW, int lane) {
    int* list = (int*)(ws + WS_ROUTE + RT_LIST); float* lrstd = (float*)(ws + WS_ROUTE + RT_LRSTD);
    int* toke = (int*)(ws + WS_ROUTE + RT_TOKE); int* tokr = (int*)(ws + WS_ROUTE + RT_TOKR); float* tokw = (float*)(ws + WS_ROUTE + RT_TOKW);
    const float* wr = a.in[I_WR]; const f32x4* gr = (const f32x4*)(a.in[I_NORM_FFN] + D) + lane;
    for (int r = gw; r < T; r += NGW) {
        const f32x4* xr = (const f32x4*)(X + (size_t)r * D) + lane; f32x4 v[4]; float s = 0.f;
#pragma unroll
        for (int j = 0; j < 4; ++j) { v[j] = xr[64 * j]; s += (v[j][0] * v[j][0] + v[j][1] * v[j][1]) + (v[j][2] * v[j][2] + v[j][3] * v[j][3]); }
        const float rs = rstd_of(wave_sum(s));
        float lg[8];
#pragma unroll
        for (int e = 0; e < 8; ++e) lg[e] = 0.f;
#pragma unroll
        for (int j = 0; j < 4; ++j) { const f32x4 g = gr[64 * j];
#pragma unroll
            for (int i = 0; i < 4; ++i) { const int k = 4 * (lane + 64 * j) + i; const float hv = v[j][i] * rs * g[i];
                const f32x4 w0 = *(const f32x4*)(wr + (size_t)k * 8), w1 = *(const f32x4*)(wr + (size_t)k * 8 + 4);
                lg[0] += hv * w0[0]; lg[1] += hv * w0[1]; lg[2] += hv * w0[2]; lg[3] += hv * w0[3]; lg[4] += hv * w1[0]; lg[5] += hv * w1[1]; lg[6] += hv * w1[2]; lg[7] += hv * w1[3]; } }
#pragma unroll
        for (int e = 0; e < 8; ++e) lg[e] = wave_sum(lg[e]) + a.in[I_BR][e];
        float bv = lg[0]; int bi = 0;
#pragma unroll
        for (int e = 1; e < 8; ++e) if (lg[e] > bv) { bv = lg[e]; bi = e; }
        float sv = -3.0e38f; int si = 0;
#pragma unroll
        for (int e = 0; e < 8; ++e) if (e != bi && lg[e] > sv) { sv = lg[e]; si = e; }
        const float w0 = 1.0f / (1.0f + __expf(sv - bv)), w1 = 1.0f - w0;
        if (lane == 0) {
            const int r0 = (int)atomicAdd(ctl + CW_CNT + 64 * bi, 1u), r1 = (int)atomicAdd(ctl + CW_CNT + 64 * si, 1u);
            list[bi * 32768 + r0] = r; lrstd[bi * 32768 + r0] = rs; list[si * 32768 + r1] = r; lrstd[si * 32768 + r1] = rs;
            toke[2 * r] = bi; toke[2 * r + 1] = si; tokr[2 * r] = r0; tokr[2 * r + 1] = r1; tokw[2 * r] = w0; tokw[2 * r + 1] = w1;
        }
    }
}

constexpr int RW_LS = 72;
constexpr int RW_SLOT = 64 * RW_LS * 2;
constexpr int RW_FS = 65;
__device__ __forceinline__ LAS unsigned char* rw_slot(LAS unsigned char* lds, int s) { return lds + s * RW_SLOT; }
__device__ __forceinline__ bf16x8 rw_frag(const LAS unsigned char* m, int row, int kq, int ks) { return *(const LAS bf16x8*)(m + row * (RW_LS * 2) + (32 * ks + 8 * kq) * 2); }
__device__ __forceinline__ f32x4 rw_mm(const LAS unsigned char* A, const LAS unsigned char* Bt, int mt, int nt, int l15, int kq, f32x4 acc) {
#pragma unroll
    for (int ks = 0; ks < 2; ++ks) acc = __builtin_amdgcn_mfma_f32_16x16x32_bf16(rw_frag(A, 16 * mt + l15, kq, ks), rw_frag(Bt, 16 * nt + l15, kq, ks), acc, 0, 0, 0);
    return acc;
}
__device__ __forceinline__ void rw_store_T(LAS unsigned char* m, int mt, int nt, int q, int n, f32x4 v) {
    u32x2 w; w.x = cvt_pk_bf16(v[0], v[1]); w.y = cvt_pk_bf16(v[2], v[3]);
    *(LAS u32x2*)(m + (16 * nt + n) * (RW_LS * 2) + (16 * mt + 4 * q) * 2) = w;
}
__device__ __forceinline__ void rw_store_D(LAS unsigned char* m, int mt, int nt, int q, int n, f32x4 v) {
#pragma unroll
    for (int r = 0; r < 4; ++r) *(LAS bf16_t*)(m + (16 * mt + 4 * q + r) * (RW_LS * 2) + (16 * nt + n) * 2) = f2bf(v[r]);
}
__device__ __forceinline__ float rw_ld1(const LAS unsigned char* m, int row, int col) { return bf2f(*(const LAS bf16_t*)(m + row * (RW_LS * 2) + col * 2)); }

#ifdef DBG_RWKV
__device__ __forceinline__ void rw_dbg_scan(LAS unsigned char* lds, int slot, int bit, unsigned* word, int tid) {
    unsigned bad = 0u;
    for (int i = tid; i < 4096; i += NTHR) { const float v = rw_ld1(rw_slot(lds, slot), i >> 6, i & 63); if (!(v - v == 0.f)) bad = 1u; }
    if (bad) atomicOr(word, 1u << bit);
}
#define RW_DBG(slot, bit) rw_dbg_scan(lds, slot, bit, B.dbg, tid)
__device__ __forceinline__ void rw_dbg_max(LAS unsigned char* lds, int slot, unsigned* word, int tid) {
    float m = 0.f;
    for (int i = tid; i < 4096; i += NTHR) { const float v = fabsf(rw_ld1(rw_slot(lds, slot), i >> 6, i & 63)); if (v - v == 0.f) m = fmaxf(m, v); }
    atomicMax(word, __float_as_uint(m));
}
#else
#define RW_DBG(slot, bit)
#endif
struct RwBufs { unsigned* dbg;  bf16_t* Pp; bf16_t* Qp; bf16_t* Rp; float* WL; bf16_t* GA; bf16_t* GB; bf16_t* CAT; const bf16_t* P1; const bf16_t* w2T; const bf16_t* a2T; const bf16_t* g2T; };

__device__ __forceinline__ void rwkv_r1(const Args& a, LAS unsigned char* lds, const RwBufs& B, int bx, int G, int wave, int nitems) {
    const int lane = lane_now(), l15 = lane & 15, kq = lane >> 4, q = kq, n = l15, tid = wave * 64 + lane;
    LAS float* Fw = (LAS float*)lds; LAS float* Fa = Fw + 64 * RW_FS; LAS float* Fg = Fa + 64 * RW_FS;
    LAS float* gsum = (LAS float*)(lds + 15 * RW_SLOT);
    const float* mu = a.in[I_MU];
#pragma unroll 1
    for (int item = bx; item < nitems; item += G) {
        const int b = item / (64 * RH), c = (item / RH) & 63, h = item % RH;
        const size_t row0 = (size_t)b * SEQ + c * 64;
        __syncthreads();
        { const int t = tid >> 3, seg = tid & 7; const size_t row = row0 + t; const bool first = (c == 0 && t == 0);
          const bf16_t* cp = B.P1 + row * INB + 2304 + 32 * seg; const bf16_t* pp = cp - INB;
          LAS unsigned char* dst = rw_slot(lds, 6 + (seg >> 1)) + t * (RW_LS * 2) + (32 * (seg & 1)) * 2;
#pragma unroll
          for (int v8 = 0; v8 < 4; ++v8) { const u32x4 cw = *(const u32x4*)(cp + 8 * v8); u32x4 pw = first ? (u32x4){0u, 0u, 0u, 0u} : *(const u32x4*)(pp + 8 * v8);
              const f32x4 m0 = *(const f32x4*)(mu + 2304 + 32 * seg + 8 * v8), m1 = *(const f32x4*)(mu + 2304 + 32 * seg + 8 * v8 + 4);
              float x[8]; const unsigned cwa[4] = {cw.x, cw.y, cw.z, cw.w}, pwa[4] = {pw.x, pw.y, pw.z, pw.w};
#pragma unroll
              for (int e = 0; e < 4; ++e) { const float c0 = bflo(cwa[e]), c1 = bfhi(cwa[e]), p0 = bflo(pwa[e]), p1 = bfhi(pwa[e]);
                  const float mm0 = (e < 2) ? m0[2 * e] : m1[2 * e - 4], mm1 = (e < 2) ? m0[2 * e + 1] : m1[2 * e - 3];
                  x[2 * e] = c0 + (p0 - c0) * mm0; x[2 * e + 1] = c1 + (p1 - c1) * mm1; }
#pragma unroll
              for (int e = 0; e < 8; ++e) { if (seg < 2) x[e] = tanhf(x[e]); else if (seg >= 4) x[e] = sigmoidf_(x[e]); }
              u32x4 o; o.x = cvt_pk_bf16(x[0], x[1]); o.y = cvt_pk_bf16(x[2], x[3]); o.z = cvt_pk_bf16(x[4], x[5]); o.w = cvt_pk_bf16(x[6], x[7]);
              *(LAS u32x4*)(dst + 16 * v8) = o; } }
        __syncthreads();
#pragma unroll 1
        for (int ti = wave; ti < 48; ti += 8) { const int mat = ti >> 4, mt = (ti >> 2) & 3, nt = ti & 3; f32x4 acc = {0.f, 0.f, 0.f, 0.f};
            if (mat < 2) { const LAS unsigned char* X = rw_slot(lds, 6 + mat); const bf16_t* Wt = (mat == 0 ? B.w2T : B.a2T) + (size_t)(h * 64 + 16 * nt + l15) * 64;
#pragma unroll
                for (int ks = 0; ks < 2; ++ks) acc = __builtin_amdgcn_mfma_f32_16x16x32_bf16(rw_frag(X, 16 * mt + l15, kq, ks), *(const bf16x8*)(Wt + 32 * ks + 8 * kq), acc, 0, 0, 0);
            } else { const bf16_t* Wt = B.g2T + (size_t)(h * 64 + 16 * nt + l15) * 128;
#pragma unroll
                for (int ks = 0; ks < 4; ++ks) acc = __builtin_amdgcn_mfma_f32_16x16x32_bf16(rw_frag(rw_slot(lds, 8 + (ks >> 1)), 16 * mt + l15, kq, ks & 1), *(const bf16x8*)(Wt + 32 * ks + 8 * kq), acc, 0, 0, 0); }
            LAS float* F = (mat == 0) ? Fw : (mat == 1 ? Fa : Fg);
#pragma unroll
            for (int r = 0; r < 4; ++r) F[(16 * mt + 4 * q + r) * RW_FS + 16 * nt + n] = acc[r]; }
        __syncthreads();
        {   const int j = lane, cg = h * 64 + j, t0 = 8 * wave;
            const float w0 = a.in[I_W0][cg], a0 = a.in[I_A0][cg], kkw = a.in[I_KK][cg], kaw = a.in[I_KA][cg], rkw = a.in[I_RK][cg], lxw = a.in[I_LNXW][cg], lxb = a.in[I_LNXB][cg];
            const float mur = mu[cg], muk = mu[CS + cg], muv = mu[2 * CS + cg];
            float ldv[8], av[8], rv[8], kv[8], vv[8], kkv[8];
            const bf16_t* pr = B.P1 + (row0 + t0) * INB + cg;
            float pr_r, pr_k, pr_v;
            if (c == 0 && wave == 0) { pr_r = 0.f; pr_k = 0.f; pr_v = 0.f; } else { pr_r = bf2f(pr[-INB]); pr_k = bf2f(pr[-INB + CS]); pr_v = bf2f(pr[-INB + 2 * CS]); }
#pragma unroll
            for (int u = 0; u < 8; ++u) { const float cr = bf2f(pr[(size_t)u * INB]), ck = bf2f(pr[(size_t)u * INB + CS]), cv = bf2f(pr[(size_t)u * INB + 2 * CS]);
                rv[u] = cr + (pr_r - cr) * mur; kv[u] = ck + (pr_k - ck) * muk; vv[u] = cv + (pr_v - cv) * muv; pr_r = cr; pr_k = ck; pr_v = cv;
                const float z = -(w0 + Fw[(t0 + u) * RW_FS + j]); const float sp = z > 20.f ? z : log1pf(__expf(z));
                ldv[u] = -__expf(-sp - 0.5f);
                av[u] = sigmoidf_(a0 + Fa[(t0 + u) * RW_FS + j]);
                const float kx = kv[u] * kkw; const float ss = wave_sum(kx * kx); kkv[u] = kx / fmaxf(sqrtf(ss), 1e-12f); }
            float lw[8]; lw[0] = ldv[0];
#pragma unroll
            for (int u = 1; u < 8; ++u) lw[u] = lw[u - 1] + ldv[u];
            gsum[wave * 64 + j] = lw[7];
            __syncthreads();
            float off = 0.f, tot = 0.f;
#pragma unroll
            for (int w8 = 0; w8 < 8; ++w8) { const float gs = gsum[w8 * 64 + j]; tot += gs; if (w8 < wave) off += gs; }
            if (wave == 0) B.WL[(size_t)item * 64 + j] = __expf(tot);
            u32x4 oAt, oBh, oKh, oV; unsigned* pAt = (unsigned*)&oAt; unsigned* pBh = (unsigned*)&oBh; unsigned* pKh = (unsigned*)&oKh; unsigned* pV = (unsigned*)&oV;
            float ga[8], gb[8];
            float tAt[8], tBh[8], tKh[8];
#pragma unroll
            for (int u = 0; u < 8; ++u) { const float lwt = off + lw[u];
                const float kp = kv[u] * (1.f + (av[u] - 1.f) * kaw), ap = -kkv[u], bb = kkv[u] * av[u];
                const float Wt = __expf(lwt), Wm1 = __expf(lwt - ldv[u]), iW = __expf(-lwt), WLr = __expf(tot - lwt);
                const float bonus = wave_sum(rv[u] * kp * rkw);
                const float gv = Fg[(t0 + u) * RW_FS + j];
                ga[u] = lxw * gv; gb[u] = (lxb + bonus * vv[u]) * gv;
                const int t = t0 + u;
                *(LAS bf16_t*)(rw_slot(lds, 10) + t * (RW_LS * 2) + j * 2) = f2bf(ap * Wm1);
                *(LAS bf16_t*)(rw_slot(lds, 11) + t * (RW_LS * 2) + j * 2) = f2bf(bb * iW);
                *(LAS bf16_t*)(rw_slot(lds, 12) + t * (RW_LS * 2) + j * 2) = f2bf(kp * iW);
                *(LAS bf16_t*)(rw_slot(lds, 13) + t * (RW_LS * 2) + j * 2) = f2bf(rv[u] * Wt);
                tAt[u] = ap * Wm1; tBh[u] = bb * WLr; tKh[u] = kp * WLr; }
#pragma unroll
            for (int u2 = 0; u2 < 4; ++u2) { pAt[u2] = cvt_pk_bf16(tAt[2 * u2], tAt[2 * u2 + 1]); pBh[u2] = cvt_pk_bf16(tBh[2 * u2], tBh[2 * u2 + 1]); pKh[u2] = cvt_pk_bf16(tKh[2 * u2], tKh[2 * u2 + 1]); pV[u2] = cvt_pk_bf16(vv[2 * u2], vv[2 * u2 + 1]); }
            *(LAS u32x4*)(rw_slot(lds, 14) + j * (RW_LS * 2) + t0 * 2) = oAt;
            *(LAS u32x4*)(rw_slot(lds, 6) + j * (RW_LS * 2) + t0 * 2) = oBh;
            *(LAS u32x4*)(rw_slot(lds, 7) + j * (RW_LS * 2) + t0 * 2) = oKh;
            *(LAS u32x4*)(rw_slot(lds, 8) + j * (RW_LS * 2) + t0 * 2) = oV;
            { bf16_t* gap = B.GA + (size_t)item * 4096 + j * 64; bf16_t* gbp = B.GB + (size_t)item * 4096 + j * 64;
#pragma unroll
              for (int hh = 0; hh < 2; ++hh) { const int pos = (2 * (wave & 1) + hh) * 16 + (wave >> 1) * 4;
                  u32x2 wa, wb; wa.x = cvt_pk_bf16(ga[4 * hh], ga[4 * hh + 1]); wa.y = cvt_pk_bf16(ga[4 * hh + 2], ga[4 * hh + 3]); wb.x = cvt_pk_bf16(gb[4 * hh], gb[4 * hh + 1]); wb.y = cvt_pk_bf16(gb[4 * hh + 2], gb[4 * hh + 3]);
                  *(u32x2*)(gap + pos) = wa; *(u32x2*)(gbp + pos) = wb; } }
        }
        __syncthreads();
        RW_DBG(10, 0); RW_DBG(11, 1); RW_DBG(12, 2); RW_DBG(13, 3); RW_DBG(14, 4); RW_DBG(6, 5); RW_DBG(7, 6); RW_DBG(8, 7);
#pragma unroll 1
        for (int ti = wave; ti < 64; ti += 8) { const int prod = ti >> 4, mt = (ti >> 2) & 3, nt = ti & 3; f32x4 acc = {0.f, 0.f, 0.f, 0.f};
            const int sa = (prod == 0) ? 10 : (prod == 2 ? 11 : 12), sb = (prod == 0) ? 11 : (prod == 1 ? 10 : 13);
            const bool need = (prod == 0) ? (mt >= nt) : (mt <= nt);
            if (need) acc = rw_mm(rw_slot(lds, sa), rw_slot(lds, sb), mt, nt, l15, kq, acc);
#pragma unroll
            for (int r = 0; r < 4; ++r) { const int row = 16 * mt + 4 * q + r, col = 16 * nt + n;
                const bool keep = (prod == 0) ? (col < row) : ((prod == 1) ? (row < col) : (row <= col));
                if (!keep) acc[r] = 0.f; }
            rw_store_T(rw_slot(lds, prod), mt, nt, q, n, acc); }
        for (int i = tid; i < 2 * RW_SLOT / 16; i += NTHR) *(LAS u32x4*)(rw_slot(lds, 4) + i * 16) = (u32x4){0u, 0u, 0u, 0u};
        __syncthreads();
        RW_DBG(0, 8); RW_DBG(1, 9); RW_DBG(2, 10); RW_DBG(3, 11);
#ifdef DBG_RWKV
        rw_dbg_max(lds, DBG_MAXSLOT_A, B.dbg + 1, tid);
#endif
        if (wave < 4 && lane < 16) { const int i0 = 16 * wave, cc = lane; float Tc[16];
            const LAS unsigned char* AT = rw_slot(lds, 0);
#pragma unroll
            for (int t = 0; t < 16; ++t) { float s = (t == cc) ? 1.f : 0.f;
#pragma unroll
                for (int s2 = 0; s2 < t; ++s2) s += rw_ld1(AT, i0 + s2, i0 + t) * Tc[s2];
                Tc[t] = s; }
#pragma unroll
            for (int t = 0; t < 16; ++t) *(LAS bf16_t*)(rw_slot(lds, 4) + (i0 + t) * (RW_LS * 2) + (i0 + cc) * 2) = f2bf(Tc[t]);
            u32x4 o0, o1; o0.x = cvt_pk_bf16(Tc[0], Tc[1]); o0.y = cvt_pk_bf16(Tc[2], Tc[3]); o0.z = cvt_pk_bf16(Tc[4], Tc[5]); o0.w = cvt_pk_bf16(Tc[6], Tc[7]);
            o1.x = cvt_pk_bf16(Tc[8], Tc[9]); o1.y = cvt_pk_bf16(Tc[10], Tc[11]); o1.z = cvt_pk_bf16(Tc[12], Tc[13]); o1.w = cvt_pk_bf16(Tc[14], Tc[15]);
            *(LAS u32x4*)(rw_slot(lds, 5) + (i0 + cc) * (RW_LS * 2) + i0 * 2) = o0; *(LAS u32x4*)(rw_slot(lds, 5) + (i0 + cc) * (RW_LS * 2) + (i0 + 8) * 2) = o1;
            LDS_WAIT();
            *(LAS u32x4*)(rw_slot(lds, 0) + (i0 + cc) * (RW_LS * 2) + i0 * 2) = (u32x4){0u, 0u, 0u, 0u}; *(LAS u32x4*)(rw_slot(lds, 0) + (i0 + cc) * (RW_LS * 2) + (i0 + 8) * 2) = (u32x4){0u, 0u, 0u, 0u};
        }
        __syncthreads();
        RW_DBG(4, 12); RW_DBG(5, 13);
#ifdef DBG_RWKV
        rw_dbg_max(lds, 4, B.dbg + 2, tid);
#endif
#pragma unroll 1
        for (int ti = wave; ti < 16; ti += 8) { const int mt = ti >> 2, nt = ti & 3; f32x4 acc = {0.f, 0.f, 0.f, 0.f};
            acc = rw_mm(rw_slot(lds, 4), rw_slot(lds, 0), mt, nt, l15, kq, acc);
            rw_store_T(rw_slot(lds, 11), mt, nt, q, n, acc); rw_store_D(rw_slot(lds, 9), mt, nt, q, n, acc); }
        __syncthreads();
        RW_DBG(9, 14); RW_DBG(11, 15);
#ifdef DBG_RWKV
        rw_dbg_max(lds, 11, B.dbg + 3, tid);
#endif
#pragma unroll 1
        for (int ti = wave; ti < 16; ti += 8) { const int mt = ti >> 2, nt = ti & 3; f32x4 acc = {0.f, 0.f, 0.f, 0.f};
            acc = rw_mm(rw_slot(lds, 11), rw_slot(lds, 9), mt, nt, l15, kq, acc);
#ifdef DBG_CONST
            acc = (f32x4){1.f, 1.f, 1.f, 1.f};
#endif
            rw_store_T(rw_slot(lds, 10), mt, nt, q, n, acc); }
#pragma unroll 1
        for (int ti = wave; ti < 16; ti += 8) { const int mt = ti >> 2, nt = ti & 3; f32x4 acc = {0.f, 0.f, 0.f, 0.f};
            acc = rw_mm(rw_slot(lds, 9), rw_slot(lds, 5), mt, nt, l15, kq, acc);
            const u32x2 dg = *(const LAS u32x2*)(rw_slot(lds, 5) + (16 * nt + n) * (RW_LS * 2) + (16 * mt + 4 * q) * 2);
            acc[0] += bflo(dg.x); acc[1] += bfhi(dg.x); acc[2] += bflo(dg.y); acc[3] += bfhi(dg.y);
            rw_store_T(rw_slot(lds, 0), mt, nt, q, n, acc); }
        __syncthreads();
        RW_DBG(10, 16); RW_DBG(0, 17);
#pragma unroll 1
        for (int ti = wave; ti < 16; ti += 8) { const int mt = ti >> 2, nt = ti & 3; f32x4 acc = {0.f, 0.f, 0.f, 0.f};
            acc = rw_mm(rw_slot(lds, 0), rw_slot(lds, 10), mt, nt, l15, kq, acc);
#pragma unroll
            for (int r = 0; r < 4; ++r) acc[r] += rw_ld1(rw_slot(lds, 0), 16 * mt + 4 * q + r, 16 * nt + n);
            asm volatile("" ::: "memory");
            rw_store_T(rw_slot(lds, 4), mt, nt, q, n, acc); }
        __syncthreads();
        RW_DBG(4, 18);
#pragma unroll 1
        for (int ti = wave; ti < 32; ti += 8) { const int prod = ti >> 4, mt = (ti >> 2) & 3, nt = ti & 3; f32x4 acc = {0.f, 0.f, 0.f, 0.f};
            if (prod == 0) { acc = rw_mm(rw_slot(lds, 4), rw_slot(lds, 14), mt, nt, l15, kq, acc); rw_store_T(rw_slot(lds, 5), mt, nt, q, n, acc); }
            else { acc = rw_mm(rw_slot(lds, 1), rw_slot(lds, 8), mt, nt, l15, kq, acc); rw_store_T(rw_slot(lds, 9), mt, nt, q, n, acc); } }
        __syncthreads();
        RW_DBG(5, 19); RW_DBG(9, 20);
#pragma unroll 1
        for (int ti = wave; ti < 16; ti += 8) { const int mt = ti >> 2, nt = ti & 3; f32x4 acc = {0.f, 0.f, 0.f, 0.f};
            acc = rw_mm(rw_slot(lds, 4), rw_slot(lds, 9), mt, nt, l15, kq, acc); rw_store_T(rw_slot(lds, 11), mt, nt, q, n, acc); }
        __syncthreads();
        RW_DBG(11, 21);
#pragma unroll 1
        for (int ti = wave; ti < 64; ti += 8) { const int prod = ti >> 4, mt = (ti >> 2) & 3, nt = ti & 3; f32x4 acc = {0.f, 0.f, 0.f, 0.f};
            if (prod == 0) {
                acc = rw_mm(rw_slot(lds, 6), rw_slot(lds, 5), mt, nt, l15, kq, acc);
                bf16_t* dst = B.Pp + (size_t)item * 4096 + (size_t)((mt * 2 + (nt >> 1)) * 64) * 8 + (n & 3) + 4 * (nt & 1);
#pragma unroll
                for (int r = 0; r < 4; ++r) dst[(4 * q + r + 16 * (n >> 2)) * 8] = f2bf(acc[r]);
            } else if (prod == 1) {
                acc = rw_mm(rw_slot(lds, 6), rw_slot(lds, 11), mt, nt, l15, kq, acc); acc = rw_mm(rw_slot(lds, 7), rw_slot(lds, 8), mt, nt, l15, kq, acc);
                u32x2 w; w.x = cvt_pk_bf16(acc[0], acc[1]); w.y = cvt_pk_bf16(acc[2], acc[3]);
                *(u32x2*)(B.Qp + (size_t)item * 4096 + (size_t)((nt * 4 + mt) * 64 + lane) * 4) = w;
            } else if (prod == 2) {
                acc = rw_mm(rw_slot(lds, 2), rw_slot(lds, 5), mt, nt, l15, kq, acc);
#pragma unroll
                for (int r = 0; r < 4; ++r) acc[r] += rw_ld1(rw_slot(lds, 13), 16 * mt + 4 * q + r, 16 * nt + n);
                bf16_t* dst = B.Rp + (size_t)item * 4096 + (size_t)((mt * 2 + (nt >> 1)) * 64) * 8 + (n & 3) + 4 * (nt & 1);
#pragma unroll
                for (int r = 0; r < 4; ++r) dst[(4 * q + r + 16 * (n >> 2)) * 8] = f2bf(acc[r]);
            } else {
                acc = rw_mm(rw_slot(lds, 2), rw_slot(lds, 11), mt, nt, l15, kq, acc); acc = rw_mm(rw_slot(lds, 3), rw_slot(lds, 8), mt, nt, l15, kq, acc);
                u32x2 w; w.x = cvt_pk_bf16(acc[0], acc[1]); w.y = cvt_pk_bf16(acc[2], acc[3]);
                *(u32x2*)(B.CAT + (row0 + 16 * nt + n) * D + h * 64 + q * 16 + mt * 4) = w; } }
    }
}

__device__ __forceinline__ void rwkv_r2(LAS unsigned char* lds, const RwBufs& B, int bx, int G, int wave, int nbh) {
    if (wave >= 4) return;
    const int lane = lane_now(), q = lane >> 4, n = lane & 15, wv = wave;
#pragma unroll 1
    for (int bh = bx; bh < nbh; bh += G) {
        const int b = bh / RH, h = bh % RH;
        f32x4 S[4];
#pragma unroll
        for (int mt = 0; mt < 4; ++mt) S[mt] = (f32x4){0.f, 0.f, 0.f, 0.f};
#pragma unroll 1
        for (int c = 0; c < 64; ++c) {
            const size_t item = (size_t)(b * 64 + c) * RH + h; const size_t row0 = (size_t)b * SEQ + c * 64;
            const bf16x8* Pf = (const bf16x8*)(B.Pp + item * 4096) + lane; const bf16x8* Rf = (const bf16x8*)(B.Rp + item * 4096) + lane;
            bf16x8 pf[8], rf[8];
#pragma unroll
            for (int f = 0; f < 8; ++f) { pf[f] = Pf[f * 64]; rf[f] = Rf[f * 64]; }
            u32x2 qv[4]; f32x4 wl[4];
#pragma unroll
            for (int mt = 0; mt < 4; ++mt) { qv[mt] = *(const u32x2*)(B.Qp + item * 4096 + (size_t)((wv * 4 + mt) * 64 + lane) * 4); wl[mt] = *(const f32x4*)(B.WL + item * 64 + 16 * mt + 4 * q); }
            bf16_t* yp = B.CAT + (row0 + 16 * wv + n) * D + h * 64 + q * 16;
            const u32x4 y0 = *(const u32x4*)yp, y1 = *(const u32x4*)(yp + 8);
            bf16x8 sh[2], sl[2];
#pragma unroll
            for (int ks = 0; ks < 2; ++ks) { unsigned hw[4], lw[4];
#pragma unroll
                for (int hf = 0; hf < 2; ++hf) { const f32x4 s = S[2 * ks + hf];
                    const unsigned h01 = cvt_pk_bf16(s[0], s[1]), h23 = cvt_pk_bf16(s[2], s[3]);
                    hw[2 * hf] = h01; hw[2 * hf + 1] = h23;
                    lw[2 * hf] = cvt_pk_bf16(s[0] - bflo(h01), s[1] - bfhi(h01)); lw[2 * hf + 1] = cvt_pk_bf16(s[2] - bflo(h23), s[3] - bfhi(h23)); }
                u32x4 hv = {hw[0], hw[1], hw[2], hw[3]}, lv = {lw[0], lw[1], lw[2], lw[3]};
                sh[ks] = __builtin_bit_cast(bf16x8, hv); sl[ks] = __builtin_bit_cast(bf16x8, lv); }
            f32x4 ya[4];
            { const unsigned yw[8] = {y0.x, y0.y, y0.z, y0.w, y1.x, y1.y, y1.z, y1.w};
#pragma unroll
              for (int mt = 0; mt < 4; ++mt) ya[mt] = (f32x4){bflo(yw[2 * mt]), bfhi(yw[2 * mt]), bflo(yw[2 * mt + 1]), bfhi(yw[2 * mt + 1])}; }
#pragma unroll
            for (int mt = 0; mt < 4; ++mt)
#pragma unroll
                for (int ks = 0; ks < 2; ++ks) { ya[mt] = __builtin_amdgcn_mfma_f32_16x16x32_bf16(rf[mt * 2 + ks], sh[ks], ya[mt], 0, 0, 0); ya[mt] = __builtin_amdgcn_mfma_f32_16x16x32_bf16(rf[mt * 2 + ks], sl[ks], ya[mt], 0, 0, 0); }
            { u32x4 o0, o1; o0.x = cvt_pk_bf16(ya[0][0], ya[0][1]); o0.y = cvt_pk_bf16(ya[0][2], ya[0][3]); o0.z = cvt_pk_bf16(ya[1][0], ya[1][1]); o0.w = cvt_pk_bf16(ya[1][2], ya[1][3]);
              o1.x = cvt_pk_bf16(ya[2][0], ya[2][1]); o1.y = cvt_pk_bf16(ya[2][2], ya[2][3]); o1.z = cvt_pk_bf16(ya[3][0], ya[3][1]); o1.w = cvt_pk_bf16(ya[3][2], ya[3][3]);
              *(u32x4*)yp = o0; *(u32x4*)(yp + 8) = o1; }
            f32x4 sn[4];
#pragma unroll
            for (int mt = 0; mt < 4; ++mt) { sn[mt] = (f32x4){bflo(qv[mt].x), bfhi(qv[mt].x), bflo(qv[mt].y), bfhi(qv[mt].y)} + wl[mt] * S[mt]; }
#pragma unroll
            for (int mt = 0; mt < 4; ++mt)
#pragma unroll
                for (int ks = 0; ks < 2; ++ks) { sn[mt] = __builtin_amdgcn_mfma_f32_16x16x32_bf16(pf[mt * 2 + ks], sh[ks], sn[mt], 0, 0, 0); sn[mt] = __builtin_amdgcn_mfma_f32_16x16x32_bf16(pf[mt * 2 + ks], sl[ks], sn[mt], 0, 0, 0); }
#pragma unroll
            for (int mt = 0; mt < 4; ++mt) S[mt] = sn[mt];
        }
    }
}

__device__ __forceinline__ void rwkv_r3(const RwBufs& B, int gw, int NGW, int nitems) {
    const int lane = lane_now(), q = lane >> 4, n = lane & 15;
#pragma unroll 1
    for (int item = gw; item < nitems; item += NGW) {
        const int b = item / (64 * RH), c = (item / RH) & 63, h = item % RH; const size_t row0 = (size_t)b * SEQ + c * 64;
        unsigned yw[4][8];
#pragma unroll
        for (int wv = 0; wv < 4; ++wv) { const bf16_t* yp = B.CAT + (row0 + 16 * wv + n) * D + h * 64 + q * 16; const u32x4 y0 = *(const u32x4*)yp, y1 = *(const u32x4*)(yp + 8);
            yw[wv][0] = y0.x; yw[wv][1] = y0.y; yw[wv][2] = y0.z; yw[wv][3] = y0.w; yw[wv][4] = y1.x; yw[wv][5] = y1.y; yw[wv][6] = y1.z; yw[wv][7] = y1.w; }
        asm volatile("s_waitcnt vmcnt(0)" ::: "memory");
#pragma unroll
        for (int hf = 0; hf < 2; ++hf) {
            float s1[8], s2[8];
#pragma unroll
            for (int e4 = 0; e4 < 8; ++e4) { s1[e4] = 0.f; s2[e4] = 0.f; }
#pragma unroll
            for (int wv = 0; wv < 4; ++wv)
#pragma unroll
                for (int e2 = 0; e2 < 4; ++e2) { const unsigned w = yw[wv][4 * hf + e2]; const float ylo = bflo(w), yhi = bfhi(w); s1[2 * e2] += ylo; s2[2 * e2] += ylo * ylo; s1[2 * e2 + 1] += yhi; s2[2 * e2 + 1] += yhi * yhi; }
#pragma unroll
            for (int e4 = 0; e4 < 8; ++e4) {
#pragma unroll
                for (int o = 1; o < 16; o <<= 1) { s1[e4] += __shfl_xor(s1[e4], o); s2[e4] += __shfl_xor(s2[e4], o); }
                const float mean = s1[e4] * (1.f / 64.f), var = fmaxf(s2[e4] * (1.f / 64.f) - mean * mean, 0.f); s1[e4] = mean; s2[e4] = 1.0f / sqrtf(var + LNX_EPS); }
#pragma unroll
            for (int wv = 0; wv < 4; ++wv) { const size_t go = (size_t)item * 4096 + (size_t)(16 * wv + n) * 64 + q * 16 + 8 * hf;
                const u32x4 a0 = *(const u32x4*)(B.GA + go), b0 = *(const u32x4*)(B.GB + go);
                const unsigned aw[4] = {a0.x, a0.y, a0.z, a0.w}, bw[4] = {b0.x, b0.y, b0.z, b0.w};
#pragma unroll
                for (int e4 = 0; e4 < 8; ++e4) { const int e = 8 * hf + e4; const unsigned ywd = yw[wv][e >> 1];
                    const float yv = (e & 1) ? bfhi(ywd) : bflo(ywd), gaf = (e & 1) ? bfhi(aw[e4 >> 1]) : bflo(aw[e4 >> 1]), gbf = (e & 1) ? bfhi(bw[e4 >> 1]) : bflo(bw[e4 >> 1]);
                    const float o = (yv - s1[e4]) * s2[e4] * gaf + gbf; const int t = 16 * (e >> 2) + 4 * q + (e & 3);
                    B.CAT[(row0 + t) * D + h * 64 + 16 * wv + n] = f2bf(o); }
                asm volatile("" ::: "memory"); }
        }
    }
}

constexpr int S5_TAB_EL = 128 * 256 + 256 * 384;
constexpr int S5_US = 264, S5_ZS = 65, S5_XS = 136;
typedef short bf16x4s __attribute__((ext_vector_type(4)));

__device__ __forceinline__ void s5_tables(const Args& a, LAS unsigned char* lds, bf16_t* TAB, float* A16T, int g, int tid) {
    LAS double* pwr = (LAS double*)lds; LAS double* pwi = pwr + 17 * 64;
    LAS double* bbr = pwi + 17 * 64; LAS double* bbi = bbr + 64 * 16;
    LAS float* crs = (LAS float*)(bbi + 64 * 16); LAS float* cis = crs + 16 * 64;
    LAS float* Kt = cis + 16 * 64;
    __syncthreads();
    if (tid < 64) { const int p = tid; const double dt = exp((double)a.in[I_LOG_DT][g]), lr = a.in[I_LAM_RE][g * S5P + p], li = a.in[I_LAM_IM][g * S5P + p];
        for (int t = 0; t <= 16; ++t) { const double m = exp(lr * dt * t), ang = li * dt * t; pwr[t * 64 + p] = m * cos(ang); pwi[t * 64 + p] = m * sin(ang); }
        const double abr = pwr[64 + p], abi = pwi[64 + p], nre = abr - 1.0, nim = abi, den = lr * lr + li * li, zr = (nre * lr + nim * li) / den, zi = (nim * lr - nre * li) / den;
        for (int j = 0; j < 16; ++j) { const double br = a.in[I_B_RE][(size_t)(g * S5P + p) * 16 + j], bi = a.in[I_B_IM][(size_t)(g * S5P + p) * 16 + j]; bbr[p * 16 + j] = zr * br - zi * bi; bbi[p * 16 + j] = zr * bi + zi * br; }
        A16T[g * 128 + p] = (float)pwr[16 * 64 + p]; A16T[g * 128 + 64 + p] = (float)pwi[16 * 64 + p]; }
    for (int i = tid; i < 1024; i += NTHR) { crs[i] = a.in[I_C_RE][(size_t)g * 1024 + i]; cis[i] = a.in[I_C_IM][(size_t)g * 1024 + i]; }
    __syncthreads();
    for (int idx = tid; idx < 4096; idx += NTHR) { const int t = idx >> 8, j = (idx >> 4) & 15, jp = idx & 15; double s = 0.0;
        for (int p = 0; p < 64; ++p) { const double cr = crs[j * 64 + p], ci = cis[j * 64 + p], ar = pwr[t * 64 + p], ai = pwi[t * 64 + p], br = bbr[p * 16 + jp], bi = bbi[p * 16 + jp];
            const double er = ar * br - ai * bi, ei = ar * bi + ai * br; s += cr * er - ci * ei; }
        if (t == 0 && j == jp) s += (double)a.in[I_S5D][g * 16 + j];
        Kt[idx] = (float)s; }
    __syncthreads();
    bf16_t* Gt = TAB + (size_t)g * S5_TAB_EL; bf16_t* MH = Gt + 128 * 256;
    for (int idx = tid; idx < 128 * 256; idx += NTHR) { const int pp = idx >> 8, k = idx & 255, s = k >> 4, jp = k & 15, p = pp & 63, t = 15 - s;
        const double ar = pwr[t * 64 + p], ai = pwi[t * 64 + p], br = bbr[p * 16 + jp], bi = bbi[p * 16 + jp];
        Gt[idx] = f2bf((float)(pp < 64 ? (ar * br - ai * bi) : (ar * bi + ai * br))); }
    for (int idx = tid; idx < 256 * 384; idx += NTHR) { const int row = idx / 384, k = idx % 384, t = row >> 4, j = row & 15; float v;
        if (k < 256) { const int s = k >> 4, jp = k & 15; v = (s <= t) ? Kt[((t - s) << 8) + (j << 4) + jp] : 0.f; }
        else { const int pp = k - 256, p = pp & 63; const double cr = crs[j * 64 + p], ci = cis[j * 64 + p], ar = pwr[(t + 1) * 64 + p], ai = pwi[(t + 1) * 64 + p];
            v = (float)(pp < 64 ? (cr * ar - ci * ai) : -(cr * ai + ci * ar)); }
        MH[idx] = f2bf(v); }
}

__device__ __forceinline__ float gelu_fast_(float x) { const float a2 = 1.5957691216057308f * (x + 0.044715f * x * x * x); return x / (1.0f + __expf(-a2)); }

__device__ __forceinline__ void s5_chunked(const Args& a, LAS unsigned char* lds, const bf16_t* U, const bf16_t* TAB, const float* A16T, bf16_t* CAT, int bx, int G, int wave) {
    const int lane = lane_now(), l15 = lane & 15, kq = lane >> 4, q = kq, n = l15, tid = wave * 64 + lane;
    LAS unsigned char* Us = lds; LAS float* Zs = (LAS float*)(lds + 64 * S5_US * 2); LAS unsigned char* Xp = lds + 64 * S5_US * 2 + 128 * S5_ZS * 4;
#pragma unroll 1
    for (int item = bx; item < NB * S5G; item += G) {
        const int b = item / S5G, g = item % S5G;
        const bf16_t* UT = U + (size_t)(b * S5G + g) * SEQ * 16;
        const bf16_t* Gt = TAB + (size_t)g * S5_TAB_EL; const bf16_t* MH = Gt + 128 * 256;
        bf16x8 ga[8], mh[2][12];
#pragma unroll
        for (int ks = 0; ks < 8; ++ks) ga[ks] = *(const bf16x8*)(Gt + (size_t)(16 * wave + l15) * 256 + 32 * ks + 8 * kq);
        const int tau0 = wave, tau1 = 15 - wave;
#pragma unroll
        for (int ks = 0; ks < 12; ++ks) { mh[0][ks] = *(const bf16x8*)(MH + (size_t)(16 * tau0 + l15) * 384 + 32 * ks + 8 * kq); mh[1][ks] = *(const bf16x8*)(MH + (size_t)(16 * tau1 + l15) * 384 + 32 * ks + 8 * kq); }
        bf16x4s wg; { unsigned short w4[4];
#pragma unroll
            for (int e = 0; e < 4; ++e) w4[e] = f2bf(a.in[I_WGLU][(size_t)(g * 16 + 4 * kq + e) * 16 + l15]);
            wg = (bf16x4s){(short)w4[0], (short)w4[1], (short)w4[2], (short)w4[3]}; }
        const f32x4 bq = *(const f32x4*)(a.in[I_BGLU] + g * 16 + 4 * q);
        float xr = 0.f, xi = 0.f; const float a16r = A16T[g * 128 + lane], a16i = A16T[g * 128 + 64 + lane];
#pragma unroll 1
        for (int nb = 0; nb < 4; ++nb) {
            __syncthreads();
#pragma unroll
            for (int i = 0; i < 4; ++i) { const int idx = tid + 512 * i, row = idx >> 5, c16 = idx & 31;
                *(LAS u32x4*)(Us + row * (S5_US * 2) + c16 * 16) = *(const u32x4*)(UT + (size_t)(nb * 64 + row) * 256 + c16 * 8); }
            __syncthreads();
#pragma unroll
            for (int nt = 0; nt < 4; ++nt) { f32x4 acc = {0.f, 0.f, 0.f, 0.f};
#pragma unroll
                for (int ks = 0; ks < 8; ++ks) acc = __builtin_amdgcn_mfma_f32_16x16x32_bf16(ga[ks], *(const LAS bf16x8*)(Us + (16 * nt + l15) * (S5_US * 2) + (32 * ks + 8 * kq) * 2), acc, 0, 0, 0);
#pragma unroll
                for (int r = 0; r < 4; ++r) Zs[(16 * wave + 4 * q + r) * S5_ZS + 16 * nt + n] = acc[r]; }
            __syncthreads();
            if (wave == 0) {
#pragma unroll 4
                for (int c = 0; c < 64; ++c) {
                    *(LAS bf16_t*)(Xp + c * (S5_XS * 2) + lane * 2) = f2bf(xr); *(LAS bf16_t*)(Xp + c * (S5_XS * 2) + (64 + lane) * 2) = f2bf(xi);
                    const float zr = Zs[lane * S5_ZS + c], zi = Zs[(64 + lane) * S5_ZS + c];
                    const float nr = a16r * xr - a16i * xi + zr, ni = a16r * xi + a16i * xr + zi; xr = nr; xi = ni; } }
            __syncthreads();
#pragma unroll
            for (int mi = 0; mi < 2; ++mi) { const int tau = mi ? tau1 : tau0, kmax = tau >> 1;
#pragma unroll 1
                for (int nt = 0; nt < 4; ++nt) { f32x4 acc = {0.f, 0.f, 0.f, 0.f};
                    const LAS unsigned char* ub = Us + (16 * nt + l15) * (S5_US * 2) + (8 * kq) * 2; const LAS unsigned char* xb = Xp + (16 * nt + l15) * (S5_XS * 2) + (8 * kq) * 2;
#pragma unroll
                    for (int ks = 0; ks < 8; ++ks) if (ks <= kmax) acc = __builtin_amdgcn_mfma_f32_16x16x32_bf16(mh[mi][ks], *(const LAS bf16x8*)(ub + 64 * ks), acc, 0, 0, 0);
#pragma unroll
                    for (int ks = 0; ks < 4; ++ks) acc = __builtin_amdgcn_mfma_f32_16x16x32_bf16(mh[mi][8 + ks], *(const LAS bf16x8*)(xb + 64 * ks), acc, 0, 0, 0);
                    f32x4 yg; yg[0] = gelu_fast_(acc[0]); yg[1] = gelu_fast_(acc[1]); yg[2] = gelu_fast_(acc[2]); yg[3] = gelu_fast_(acc[3]);
                    const unsigned p01 = cvt_pk_bf16(yg[0], yg[1]), p23 = cvt_pk_bf16(yg[2], yg[3]); const u32x2 pk = {p01, p23};
                    const f32x4 z = __builtin_amdgcn_mfma_f32_16x16x16bf16_1k(wg, __builtin_bit_cast(bf16x4s, pk), bq, 0, 0, 0);
                    const int t = (nb * 64 + 16 * nt + n) * 16 + tau;
                    u32x2 o; o.x = cvt_pk_bf16(yg[0] * sigmoidf_(z[0]), yg[1] * sigmoidf_(z[1])); o.y = cvt_pk_bf16(yg[2] * sigmoidf_(z[2]), yg[3] * sigmoidf_(z[3]));
                    *(u32x2*)(CAT + ((size_t)b * SEQ + t) * D + g * 16 + 4 * q) = o; } }
        }
    }
}
constexpr int N_PHASES = 15;

__device__ __forceinline__ TrJob small_job(const Args& a, int j) {
    unsigned char* ws = a.ws; TrJob r;
    switch (j) {
    case 0: r = TrJob{a.in[I_WINA], (bf16_t*)(ws + WS_WINA), a.in[I_NORM_MIX], D, D, 0, 0}; break;
    case 1: r = TrJob{a.in[I_WOUT], (bf16_t*)(ws + WS_WOUT0), nullptr, D, D, 0, 0}; break;
    case 2: r = TrJob{a.in[I_WOUT] + (size_t)D * D, (bf16_t*)(ws + WS_WOUT1), nullptr, D, D, 0, 0}; break;
    case 3: r = TrJob{a.in[I_WKV], (bf16_t*)(ws + WS_WKV), nullptr, D, 512, 0, 0}; break;
    case 4: r = TrJob{a.in[I_WKV] + (size_t)D * 512, (bf16_t*)(ws + WS_WKV) + (size_t)512 * D, nullptr, D, 512, 0, 0}; break;
    case 5: r = TrJob{a.in[I_FGATE], (bf16_t*)(ws + WS_WGU0), a.in[I_NORM_FFN], D, FD, 1, 0}; break;
    case 6: r = TrJob{a.in[I_FUP], (bf16_t*)(ws + WS_WGU0), a.in[I_NORM_FFN], D, FD, 2, 0}; break;
    case 7: r = TrJob{a.in[I_FDOWN], (bf16_t*)(ws + WS_WD0), nullptr, FD, D, 0, 0}; break;
    case 8: r = TrJob{a.in[I_WINB], (bf16_t*)(ws + WS_WINB), a.in[I_NORM_MIX] + D, D, INB, 0, 0}; break;
    case 9: r = TrJob{a.in[I_W2], (bf16_t*)(ws + WS_W2T), nullptr, 64, CS, 0, 0}; break;
    case 10: r = TrJob{a.in[I_A2], (bf16_t*)(ws + WS_A2T), nullptr, 64, CS, 0, 0}; break;
    default: r = TrJob{a.in[I_G2], (bf16_t*)(ws + WS_G2T), nullptr, 128, CS, 0, 0}; break;
    }
    r.items = (r.K / 64) * (r.N / 32); return r;
}
__device__ __forceinline__ TrJob moe_job(const Args& a, int j) {
    unsigned char* ws = a.ws; const int kind = j >> 3, e = j & 7; TrJob r;
    if (kind == 0) r = TrJob{a.in[I_MGATE] + (size_t)e * D * FE, (bf16_t*)(ws + WS_WMOE_GU) + (size_t)e * 2 * FE * D, a.in[I_NORM_FFN] + D, D, FE, 1, 0};
    else if (kind == 1) r = TrJob{a.in[I_MUP] + (size_t)e * D * FE, (bf16_t*)(ws + WS_WMOE_GU) + (size_t)e * 2 * FE * D, a.in[I_NORM_FFN] + D, D, FE, 2, 0};
    else r = TrJob{a.in[I_MDOWN] + (size_t)e * FE * D, (bf16_t*)(ws + WS_WMOE_D) + (size_t)e * D * FE, nullptr, FE, D, 0, 0};
    r.items = (r.K / 64) * (r.N / 32); return r;
}

template <int LO, int HI> __global__ void __launch_bounds__(NTHR, 2) fwd(Args args) {
    extern __shared__ __attribute__((aligned(16))) unsigned char lds_raw[];
    LAS unsigned char* lds = (LAS unsigned char*)lds_raw;
    volatile LAS unsigned* MISC = (volatile LAS unsigned*)(lds + LDS_MISC);
    const int wave = __builtin_amdgcn_readfirstlane(threadIdx.x >> 6);
#define lane (lane_now())
#define tid (wave * 64 + lane_now())
    const int G = gridDim.x, bx = blockIdx.x;
    const int gw = bx * NWAVES + wave, NGW = G * NWAVES;
    unsigned char* ws = args.ws;
    unsigned* ctl = (unsigned*)(ws + WS_CTL);
    rss_t* rowss = (rss_t*)(ws + WS_CTL + CTL_ROWSS);
    float* X = args.out;
    bf16_t* HA = (bf16_t*)(ws + WS_HA);
    const int lo = args.ph_lo, hi = args.ph_hi;
    for (int u = tid; u < (LDS_BYTES - LDS_MISC) / 4; u += NTHR) ((LAS unsigned*)(lds + LDS_MISC))[u] = 0u;
    __syncthreads();
    XcdBarrier bar; bar.bar = ctl + CW_BAR; bar.x = 0; bar.st = nullptr;
    const bool multi = (hi - lo) > 1;
    if (multi) bar = xcd_barrier_post(ctl + CW_BAR, MISC + 8);
#define IN(k) (LO <= (k) && (k) < HI && lo <= (k) && (k) < hi)
#define SEAM(k) do { if (IN(k) && IN((k) + 1)) xcd_barrier(bar); } while (0)

    if (IN(0)) {
        if (bx < S5G) { s5_tables(args, lds, (bf16_t*)(ws + WS_S5TAB), (float*)(ws + WS_S5TAB + 12 * MiB), bx, tid); __syncthreads(); }
        LAS float* scr = (LAS float*)(lds + wave * 16384);
        {
            int base = 0;
            for (int j = 0; j < 12; ++j) { const TrJob jb = small_job(args, j);
                for (int it = gw - base; it < jb.items; it += NGW) { if (it >= 0) tr_item(jb.W, jb.K, jb.N, jb.WT, jb.gain, jb.mode, scr, it, lane); }
                base = (base + jb.items) % NGW; }
        }
        for (int r = gw; r < 2 * MROWS; r += NGW) { const int li = r / MROWS, row = r % MROWS;
            const f32x4* xr = (const f32x4*)(args.in[I_MEM] + (size_t)row * D) + lane; const f32x4* gr = (const f32x4*)(args.in[I_NORM_MEM] + li * D) + lane;
            f32x4 v[4]; float s = 0.f;
#pragma unroll
            for (int j = 0; j < 4; ++j) { v[j] = xr[64 * j]; s += (v[j][0] * v[j][0] + v[j][1] * v[j][1]) + (v[j][2] * v[j][2] + v[j][3] * v[j][3]); }
            const float rs = rstd_of(wave_sum(s));
            u32x2* o = (u32x2*)((bf16_t*)(ws + WS_MEMN) + ((size_t)li * MROWS + row) * D) + lane;
#pragma unroll
            for (int j = 0; j < 4; ++j) { const f32x4 g = gr[64 * j]; u32x2 w; w.x = cvt_pk_bf16(v[j][0] * rs * g[0], v[j][1] * rs * g[1]); w.y = cvt_pk_bf16(v[j][2] * rs * g[2], v[j][3] * rs * g[3]); o[64 * j] = w; }
        }
        for (int r = gw; r < T; r += NGW) {
            const f32x4* xr = (const f32x4*)(args.in[I_X] + (size_t)r * D) + lane; f32x4 v[4]; float s = 0.f;
#pragma unroll
            for (int j = 0; j < 4; ++j) { v[j] = xr[64 * j]; s += (v[j][0] * v[j][0] + v[j][1] * v[j][1]) + (v[j][2] * v[j][2] + v[j][3] * v[j][3]); }
            s = wave_sum(s); if (lane == 0) rowss[r] = rss_fx(s);
            u32x2* o = (u32x2*)(HA + (size_t)r * D) + lane;
#pragma unroll
            for (int j = 0; j < 4; ++j) { u32x2 w; w.x = cvt_pk_bf16(v[j][0], v[j][1]); w.y = cvt_pk_bf16(v[j][2], v[j][3]); o[64 * j] = w; }
        }
    }
    SEAM(0);

    if (IN(1)) {
        { pg8::DenseSched S; S.init(HA, ws + WS_WINA, T, D, D, G, bx);
          EpiInA E{(bf16_t*)(ws + WS_P0U), (bf16_t*)(ws + WS_P0Q), rowss};
          pg8::gemm_phase<EpiInA, pg8::DenseSched, true>(lds, D, S, E); }
        __syncthreads();
#pragma unroll 1
        for (int li = 0; li < 2; ++li) {
            pg8::DenseSched S; S.init((bf16_t*)(ws + WS_MEMN) + (size_t)li * MROWS * D, (bf16_t*)(ws + WS_WKV) + (size_t)li * 512 * D, MROWS, 512, D, G, (bx + 128 * li + 64) % G);
            EpiBf16 E{(bf16_t*)(ws + WS_KV) + (size_t)li * MROWS * 512, 512, nullptr, nullptr, 0};
            pg8::gemm_phase<EpiBf16, pg8::DenseSched, true>(lds, D, S, E);
            __syncthreads();
        }
    }
    SEAM(1);

    if (IN(2)) {
        bf16_t* CAT = (bf16_t*)(ws + WS_CAT);
        attn_naive(lds, (const bf16_t*)(ws + WS_P0Q), (const bf16_t*)(ws + WS_KV), CAT, bx, G, tid);
        __syncthreads();
#ifdef S5_NAIVE
        s5_naive(args, lds, (const bf16_t*)(ws + WS_P0U), CAT, bx, G, wave, lane);
#else
        s5_chunked(args, lds, (const bf16_t*)(ws + WS_P0U), (const bf16_t*)(ws + WS_S5TAB), (const float*)(ws + WS_S5TAB + 12 * MiB), CAT, bx, G, wave);
#endif
    }
    SEAM(2);

    if (IN(3)) {
        pg8::DenseSched S; S.init(ws + WS_CAT, ws + WS_WOUT0, T, D, D, G, bx);
        EpiRes E{args.in[I_X], X, HA, rowss + T};
        pg8::gemm_phase<EpiRes, pg8::DenseSched, true>(lds, D, S, E);
    }
    SEAM(3);

    if (IN(4)) {
        pg8::DenseSched S; S.init(HA, ws + WS_WGU0, T, 2 * FD, D, G, bx);
        EpiSwiglu E{(bf16_t*)(ws + WS_ACT0), FD, rowss + T, nullptr};
        pg8::gemm_phase<EpiSwiglu, pg8::DenseSched, true>(lds, D, S, E);
    }
    SEAM(4);

    if (IN(5)) {
        pg8::DenseSched S; S.init(ws + WS_ACT0, ws + WS_WD0, T, D, FD, G, bx);
        EpiRes E{X, X, HA, rowss + 2 * T};
        pg8::gemm_phase<EpiRes, pg8::DenseSched, true>(lds, FD, S, E);
    }
    SEAM(5);

    if (IN(6)) {
        pg8::DenseSched S; S.init(HA, ws + WS_WINB, T, INB, D, G, bx);
        EpiBf16 E{(bf16_t*)(ws + WS_P1), INB, rowss + 2 * T, (bf16_t*)(ws + WS_P0Q), SHIFTC};
        pg8::gemm_phase<EpiBf16, pg8::DenseSched, true>(lds, D, S, E);
    }
    SEAM(6);

    RwBufs RB; RB.dbg = ctl + 16387;
#ifdef DBG_RWKV
    RB.Pp = (bf16_t*)(ws + 78 * MiB); RB.Qp = (bf16_t*)(ws + 84 * MiB); RB.Rp = (bf16_t*)(ws + 90 * MiB); RB.GA = (bf16_t*)(ws + 96 * MiB); RB.GB = (bf16_t*)(ws + 102 * MiB); RB.WL = (float*)(ws + 108 * MiB);
    RB.CAT = (bf16_t*)(ws + 110 * MiB);
    constexpr int RW_ITEMS = 64 * RH, RW_BH = RH;
#else
    RB.Pp = (bf16_t*)(ws + WS_RPP); RB.Qp = (bf16_t*)(ws + WS_RQP); RB.Rp = (bf16_t*)(ws + WS_RRP); RB.WL = (float*)(ws + WS_RWL); RB.GA = (bf16_t*)(ws + WS_RGA); RB.GB = (bf16_t*)(ws + WS_RGB);
    RB.CAT = (bf16_t*)(ws + WS_CAT);
    constexpr int RW_ITEMS = NB * 64 * RH, RW_BH = NB * RH;
#endif
    RB.P1 = (const bf16_t*)(ws + WS_P1); RB.w2T = (const bf16_t*)(ws + WS_W2T); RB.a2T = (const bf16_t*)(ws + WS_A2T); RB.g2T = (const bf16_t*)(ws + WS_G2T);
    if (IN(7)) {
        attn_naive(lds, (const bf16_t*)(ws + WS_P0Q), (const bf16_t*)(ws + WS_KV) + (size_t)MROWS * 512, (bf16_t*)(ws + WS_CAT), bx, G, tid);
        __syncthreads();
#ifdef DBG_RWKV
        rwkv_prep(args, lds, (const bf16_t*)(ws + WS_P1), (bf16_t*)(ws + 432 * MiB), (bf16_t*)(ws + 480 * MiB), (bf16_t*)(ws + 128 * MiB), (bf16_t*)(ws + 2 * MiB), bx, G, tid);
        __syncthreads();
#endif
        rwkv_r1(args, lds, RB, bx, G, wave, RW_ITEMS);
    }
    SEAM(7);
    if (IN(8)) {
        rwkv_r2(lds, RB, bx, G, wave, RW_BH);
    }
    SEAM(8);
    if (IN(9)) { rwkv_r3(RB, gw, NGW, RW_ITEMS); }
    SEAM(9);

    if (IN(10)) {
#ifdef DBG_RWKV
        {   const bf16_t* ref = (const bf16_t*)(ws + WS_CAT); const bf16_t* tst = (const bf16_t*)(ws + 110 * MiB); float sd = 0.f, sr = 0.f;
            for (int r = gw; r < SEQ; r += NGW) {
#pragma unroll
                for (int i = 0; i < 12; ++i) { const float a = bf2f(ref[(size_t)r * D + lane + 64 * i]), b = bf2f(tst[(size_t)r * D + lane + 64 * i]); sd += (a - b) * (a - b); sr += a * a; } }
            sd = wave_sum(sd); sr = wave_sum(sr);
            if (lane == 0) { atomicAdd((float*)(ctl + 16384), sd); atomicAdd((float*)(ctl + 16385), sr); }
            unsigned bad = 0u;
            for (int i = gw * 64 + lane; i < 768 * 64; i += NGW * 64) { const float v = RB.WL[i]; if (!(v - v == 0.f)) bad |= 1u; }
            for (int i = gw * 64 + lane; i < 768 * 4096; i += NGW * 64) { float v = bf2f(RB.GA[i]); if (!(v - v == 0.f)) bad |= 2u; v = bf2f(RB.GB[i]); if (!(v - v == 0.f)) bad |= 4u;
                v = bf2f(RB.Pp[i]); if (!(v - v == 0.f)) bad |= 8u; v = bf2f(RB.Qp[i]); if (!(v - v == 0.f)) bad |= 16u; v = bf2f(RB.Rp[i]); if (!(v - v == 0.f)) bad |= 32u; }
            for (int r = gw; r < SEQ; r += NGW) for (int i = 0; i < 12; ++i) { const float v = bf2f(tst[(size_t)r * D + lane + 64 * i]); if (!(v - v == 0.f)) bad |= 64u; }
            if (bad) atomicOr(ctl + 16386, bad); }
#endif
        pg8::DenseSched S; S.init(ws + WS_CAT, ws + WS_WOUT1, T, D, D, G, bx);
        EpiRes E{X, X, HA, rowss + 3 * T};
        pg8::gemm_phase<EpiRes, pg8::DenseSched, true>(lds, D, S, E);
    }
    SEAM(10);

    if (IN(11)) {
        moe_router(args, X, ctl, ws, gw, NGW, lane);
        LAS float* scr = (LAS float*)(lds + wave * 16384);
        int base = 0;
#pragma unroll 1
        for (int j = 0; j < 24; ++j) { const TrJob jb = moe_job(args, j);
            for (int it = gw - base; it < jb.items; it += NGW) { if (it >= 0) tr_item(jb.W, jb.K, jb.N, jb.WT, jb.gain, jb.mode, scr, it, lane); }
            base = (base + jb.items) % NGW; }
    }
    SEAM(11);

    if constexpr (HI > 12 && LO < 14) {
#pragma unroll 1
    for (int pass = args.pass_lo; pass < args.pass_hi; ++pass) {
        constexpr int pg = 12, pd = 13;
        LAS int* tab = (LAS int*)(lds + LDS_MISC + 256);
        if (IN(pg) || IN(pd)) {
            __syncthreads();
            if (tid == 0) { int acc = 0; for (int e = 0; e < 8; ++e) { const int c = (int)__hip_atomic_load(ctl + CW_CNT + 64 * e, __ATOMIC_RELAXED, __HIP_MEMORY_SCOPE_AGENT); tab[e] = acc; tab[16 + e] = c; acc += (c + 255) >> 8; } tab[8] = acc; }
            __syncthreads();
        }
        const int ntile = (IN(pg) || IN(pd)) ? __builtin_amdgcn_readfirstlane(tab[8]) : 0;
        const int tile0 = 64 * pass, nt_pass = min(64, ntile - tile0);
        if (IN(pg) && nt_pass > 0) {
            MoeGuSched S; S.o.init(nt_pass, 2 * FE / 256, G, bx); S.A = (const char*)HA; S.W = (const char*)(ws + WS_WMOE_GU); S.list = (const int*)(ws + WS_ROUTE + RT_LIST); S.tab = tab; S.tile0 = tile0;
            EpiSwiglu E{(bf16_t*)(ws + WS_MACT), FE, nullptr, (const float*)(ws + WS_ROUTE + RT_LRSTD)};
            pg8::gemm_phase<EpiSwiglu, MoeGuSched, true>(lds, D, S, E);
        }
        SEAM(pg);
        if (IN(pd) && nt_pass > 0) {
            MoeDownSched S; S.o.init(nt_pass, D / 256, G, bx); S.A = (const char*)(ws + WS_MACT); S.W = (const char*)(ws + WS_WMOE_D); S.tab = tab; S.tile0 = tile0;
            EpiSlot E{(bf16_t*)(ws + WS_YSLOT)};
            pg8::gemm_phase<EpiSlot, MoeDownSched, true>(lds, FE, S, E);
        }
        if (IN(pd) && (pass + 1 < args.pass_hi || IN(14))) xcd_barrier(bar);
    }
    }

    if (IN(14)) {
        LAS int* tab = (LAS int*)(lds + LDS_MISC + 256);
        __syncthreads();
        if (tid == 0) { int acc = 0; for (int e = 0; e < 8; ++e) { const int c = (int)__hip_atomic_load(ctl + CW_CNT + 64 * e, __ATOMIC_RELAXED, __HIP_MEMORY_SCOPE_AGENT); tab[e] = acc; acc += (c + 255) >> 8; } }
        __syncthreads();
        const int* toke = (const int*)(ws + WS_ROUTE + RT_TOKE); const int* tokr = (const int*)(ws + WS_ROUTE + RT_TOKR); const float* tokw = (const float*)(ws + WS_ROUTE + RT_TOKW);
        const bf16_t* Y = (const bf16_t*)(ws + WS_YSLOT);
        for (int r = gw; r < T; r += NGW) {
            const int e0 = toke[2 * r], e1 = toke[2 * r + 1]; const float w0 = tokw[2 * r], w1 = tokw[2 * r + 1];
            const size_t s0 = (size_t)tab[e0] * 256 + tokr[2 * r], s1 = (size_t)tab[e1] * 256 + tokr[2 * r + 1];
            const f32x4* xr = (const f32x4*)(X + (size_t)r * D) + lane; const u32x2* y0 = (const u32x2*)(Y + s0 * D) + lane; const u32x2* y1 = (const u32x2*)(Y + s1 * D) + lane;
            f32x4 v[4]; float s = 0.f;
#pragma unroll
            for (int j = 0; j < 4; ++j) { v[j] = xr[64 * j]; const u32x2 a = y0[64 * j], b = y1[64 * j];
                v[j][0] += w0 * bflo(a.x) + w1 * bflo(b.x); v[j][1] += w0 * bfhi(a.x) + w1 * bfhi(b.x); v[j][2] += w0 * bflo(a.y) + w1 * bflo(b.y); v[j][3] += w0 * bfhi(a.y) + w1 * bfhi(b.y);
                s += (v[j][0] * v[j][0] + v[j][1] * v[j][1]) + (v[j][2] * v[j][2] + v[j][3] * v[j][3]); }
            float rs = rstd_of(wave_sum(s));
#ifdef DBG_RWKV
            { const float sd = __hip_atomic_load((float*)(ctl + 16384), __ATOMIC_RELAXED, __HIP_MEMORY_SCOPE_AGENT), sr = __hip_atomic_load((float*)(ctl + 16385), __ATOMIC_RELAXED, __HIP_MEMORY_SCOPE_AGENT);
              const float e = sqrtf(sd / sr); float dl = 0.1f * log10f(e * 1000.f); if (!(e == e)) dl = 0.7f; dl = fminf(fmaxf(dl, 0.f), 0.8f);
              const unsigned bad = __hip_atomic_load(ctl + 16386, __ATOMIC_RELAXED, __HIP_MEMORY_SCOPE_AGENT);
              if (bad) { int code = 0; for (int bit = 6; bit >= 0; --bit) if (bad & (1u << bit)) code = bit + 1; dl = 0.1f * code; }
              const unsigned bad2 = __hip_atomic_load(ctl + 16387, __ATOMIC_RELAXED, __HIP_MEMORY_SCOPE_AGENT);
              if (bad2 & ~DBG_SKIPMASK) { int code = 0; for (int bit = 21; bit >= 0; --bit) if ((bad2 & ~DBG_SKIPMASK) & (1u << bit)) code = bit + 1; dl = 0.03f * code; }
#ifdef DBG_MAXWORD
              { const float mx = __uint_as_float(__hip_atomic_load(ctl + 16387 + DBG_MAXWORD, __ATOMIC_RELAXED, __HIP_MEMORY_SCOPE_AGENT)); float lg = log2f(fmaxf(mx, 1e-9f)); lg = fminf(fmaxf(lg, -30.f), 130.f); dl = 0.005f * (lg + 30.f); }
#endif
              rs *= (1.f + dl); }
#endif
            const f32x4* gr = (const f32x4*)(args.in[I_NORM_FINAL]) + lane; f32x4* o = (f32x4*)(X + (size_t)r * D) + lane;
#pragma unroll
            for (int j = 0; j < 4; ++j) { const f32x4 g = gr[64 * j]; o[64 * j] = v[j] * rs * g; }
        }
    }
#undef IN
#undef SEAM
#undef lane
#undef tid
}

#ifdef DBG_RWKV
__global__ void __launch_bounds__(NTHR, 2) dbg_naive(Args args) {
    extern __shared__ __attribute__((aligned(16))) unsigned char lds_raw[];
    LAS unsigned char* lds = (LAS unsigned char*)lds_raw; unsigned char* ws = args.ws;
    const int wave = __builtin_amdgcn_readfirstlane(threadIdx.x >> 6);
    rwkv_naive(args, lds, (const bf16_t*)(ws + WS_P1), (const bf16_t*)(ws + 432 * MiB), (const bf16_t*)(ws + 480 * MiB), (const bf16_t*)(ws + 128 * MiB), (const bf16_t*)(ws + 2 * MiB), (bf16_t*)(ws + WS_CAT), blockIdx.x, gridDim.x, wave, lane_now());
}
#endif

#ifndef N_LAUNCH_MODE
#define N_LAUNCH_MODE 1
#endif
extern "C" void kernel_launch(void* const* d_in, const int* in_sizes, int n_in, void* d_out, int out_size, void* d_ws, size_t ws_size, hipStream_t stream) {
    static int grid = 0;
    if (grid == 0) {
        if (n_in != N_IN || in_sizes[0] != T * D || out_size != T * D || ws_size < WS_NEED) {
            fprintf(stderr, "kernel_launch: unexpected shapes/workspace: n_in %d in0 %d out %d ws %zu (need %zu)\n", n_in, n_in > 0 ? in_sizes[0] : -1, out_size, ws_size, (size_t)WS_NEED); grid = -1; return; }
        int dev = 0, cus = 0;
        if (hipGetDevice(&dev) != hipSuccess || hipDeviceGetAttribute(&cus, hipDeviceAttributeMultiprocessorCount, dev) != hipSuccess) { grid = -1; return; }
        bool ok = true;
#define SETATTR(K) ok = ok && (hipFuncSetAttribute((const void*)K, hipFuncAttributeMaxDynamicSharedMemorySize, LDS_BYTES) == hipSuccess)
#if N_LAUNCH_MODE == 1
        SETATTR((fwd<0, N_PHASES>));
#else
        SETATTR((fwd<0, 1>)); SETATTR((fwd<1, 2>)); SETATTR((fwd<2, 3>)); SETATTR((fwd<3, 4>)); SETATTR((fwd<4, 5>)); SETATTR((fwd<5, 6>)); SETATTR((fwd<6, 7>)); SETATTR((fwd<7, 8>));
        SETATTR((fwd<8, 9>)); SETATTR((fwd<9, 10>)); SETATTR((fwd<10, 11>)); SETATTR((fwd<11, 12>)); SETATTR((fwd<12, 13>)); SETATTR((fwd<13, 14>)); SETATTR((fwd<14, 15>));
#endif
        if (!ok) { fprintf(stderr, "kernel_launch: hipFuncSetAttribute failed\n"); grid = -1; return; }
        (void)hipGetLastError();
        grid = cus;
    }
    if (grid < 0) return;
    if (hipMemsetAsync((char*)d_ws + WS_CTL, 0, CTL_BYTES, stream) != hipSuccess) return;
    Args a{};
    for (int i = 0; i < N_IN; ++i) a.in[i] = (const float*)d_in[i];
    a.out = (float*)d_out; a.ws = (unsigned char*)d_ws;
#if N_LAUNCH_MODE == 1
    a.ph_lo = 0; a.ph_hi = N_PHASES; a.pass_lo = 0; a.pass_hi = 5;
    hipLaunchKernelGGL((fwd<0, N_PHASES>), dim3(grid), dim3(NTHR), LDS_BYTES, stream, a);
#else
#define LAUNCH1(P) do { a.ph_lo = (P); a.ph_hi = (P) + 1; hipLaunchKernelGGL((fwd<(P), (P) + 1>), dim3(grid), dim3(NTHR), LDS_BYTES, stream, a); } while (0)
    LAUNCH1(0); LAUNCH1(1); LAUNCH1(2); LAUNCH1(3); LAUNCH1(4); LAUNCH1(5); LAUNCH1(6); LAUNCH1(7);
#ifdef DBG_RWKV
    hipLaunchKernelGGL(dbg_naive, dim3(grid), dim3(NTHR), 4096, stream, a); LAUNCH1(8);
#else
    LAUNCH1(8);
#endif
    LAUNCH1(9); LAUNCH1(10); LAUNCH1(11);
    for (int pass = 0; pass < 5; ++pass) { a.pass_lo = pass; a.pass_hi = pass + 1; LAUNCH1(12); LAUNCH1(13); }
    LAUNCH1(14);
#endif
}
```

```cpp
#include <hip/hip_runtime.h>
#include <cstdio>
#include <cstdint>

#define LAS __attribute__((address_space(3)))
#define GAS __attribute__((address_space(1)))
typedef unsigned short bf16_t;
typedef short bf16x8 __attribute__((ext_vector_type(8)));
typedef short bf16x4 __attribute__((ext_vector_type(4)));
typedef float f32x4 __attribute__((ext_vector_type(4)));
typedef float f32x2 __attribute__((ext_vector_type(2)));
typedef unsigned u32x4 __attribute__((ext_vector_type(4)));
typedef unsigned u32x2 __attribute__((ext_vector_type(2)));

constexpr int NB = 8, SEQ = 4096, T = NB * SEQ, D = 1024, MEML = 256, MROWS = NB * MEML;
constexpr int CS = 768, CM = 256, NH_MEM = 4;
constexpr int S5G = 48, S5J = 16, S5P = 64;
constexpr int RH = 12, RN = 64, SHIFTC = 2560, INB = 2816;
constexpr int FD = 2816, NE = 8, FE = 3584;
constexpr float RMS_EPS = 1e-6f, LNX_EPS = 64e-5f;
constexpr int NWAVES = 8, NTHR = 512;

enum { I_X = 0, I_MEM, I_NORM_MIX, I_NORM_MEM, I_WKV, I_WOUT, I_NORM_FFN, I_NORM_FINAL, I_WINA, I_LAM_RE, I_LAM_IM, I_LOG_DT, I_B_RE, I_B_IM, I_C_RE, I_C_IM,
       I_S5D, I_WGLU, I_BGLU, I_FGATE, I_FUP, I_FDOWN, I_WINB, I_MU, I_W0, I_W2, I_A0, I_A2, I_G2, I_KK, I_KA, I_RK, I_LNXW, I_LNXB, I_WR, I_BR, I_MGATE, I_MUP, I_MDOWN, N_IN };

constexpr size_t MiB = 1u << 20;
constexpr size_t WS_CTL = 0, CTL_BYTES = 2 * MiB;
constexpr size_t WS_HA = 2 * MiB;
constexpr size_t WS_ROUTE = 66 * MiB;
constexpr size_t WS_WOUT1 = 70 * MiB;
constexpr size_t WS_KV = 72 * MiB;
constexpr size_t WS_LORA = 76 * MiB;
constexpr size_t WS_W2T = WS_LORA, WS_A2T = WS_LORA + 96 * 1024, WS_G2T = WS_LORA + 192 * 1024;
constexpr size_t WS_WINA = 78 * MiB, WS_WOUT0 = 80 * MiB, WS_WKV = 82 * MiB  , WS_WGU0 = 84 * MiB  , WS_WD0 = 95 * MiB  ,
                 WS_WINB = 101 * MiB  , WS_MEMN = 107 * MiB  , WS_S5TAB = 115 * MiB  ;
constexpr size_t WS_P0U = 128 * MiB;
constexpr size_t WS_P0Q = 176 * MiB;
constexpr size_t WS_CAT = 192 * MiB;
constexpr size_t WS_ACT0 = 256 * MiB;
constexpr size_t WS_P1 = 256 * MiB;
constexpr size_t WS_RPP = 2 * MiB, WS_RWL = 50 * MiB  , WS_RQP = 128 * MiB, WS_RRP = 432 * MiB, WS_RGA = 480 * MiB, WS_RGB = 78 * MiB, WS_RXL = 52 * MiB  , WS_X3 = 340 * MiB  ;
constexpr size_t WS_WMOE_GU = 256 * MiB;
constexpr size_t WS_WMOE_D = 312 * MiB;
constexpr size_t WS_HA2 = 468 * MiB;
constexpr size_t WS_ROUTE2 = 2 * MiB;
constexpr size_t WS_MACT = 6 * MiB;
constexpr size_t WS_YSLOT = 118 * MiB;
constexpr size_t WS_TAILP = 424 * MiB;
constexpr size_t WS_END = 532 * MiB, WS_NEED = 532 * MiB;
constexpr int CW_BAR = 4096;
constexpr int CW_CNT = 8192;
constexpr size_t CTL_ROWSS = 1 * MiB;
constexpr size_t RT_LIST = 0, RT_LRSTD = 1 * MiB, RT_TOKE = 2 * MiB  , RT_TOKR = 2 * MiB + 256 * 1024, RT_TOKW = 2 * MiB + 512 * 1024;

constexpr int LDS_STAGE = 131072, LDS_BYTES = 147456, LDS_MISC = LDS_BYTES - 1024;

typedef __bf16 bf16v2_t __attribute__((ext_vector_type(2)));
__device__ __forceinline__ unsigned cvt_pk_bf16(float lo, float hi) { const f32x2 v = {lo, hi}; const bf16v2_t b = __builtin_convertvector(v, bf16v2_t); return __builtin_bit_cast(unsigned, b); }
__device__ __forceinline__ float bf2f(unsigned short b) { return __uint_as_float(((unsigned)b) << 16); }
__device__ __forceinline__ float bflo(unsigned w) { return __uint_as_float(w << 16); }
__device__ __forceinline__ float bfhi(unsigned w) { return __uint_as_float(w & 0xffff0000u); }
__device__ __forceinline__ bf16_t f2bf(float f) { return (bf16_t)(cvt_pk_bf16(f, 0.f) & 0xffffu); }
__device__ __forceinline__ float wave_sum(float v) {
#pragma unroll
    for (int o = 1; o < 64; o <<= 1) v += __shfl_xor(v, o);
    return v;
}
__device__ __forceinline__ float wave_sum_fast(float v) {
    v += __builtin_bit_cast(float, __builtin_amdgcn_update_dpp(0, __builtin_bit_cast(int, v), 0xB1, 0xf, 0xf, false));
    v += __builtin_bit_cast(float, __builtin_amdgcn_update_dpp(0, __builtin_bit_cast(int, v), 0x4E, 0xf, 0xf, false));
    v += __builtin_bit_cast(float, __builtin_amdgcn_update_dpp(0, __builtin_bit_cast(int, v), 0x141, 0xf, 0xf, false));
    v += __builtin_bit_cast(float, __builtin_amdgcn_update_dpp(0, __builtin_bit_cast(int, v), 0x140, 0xf, 0xf, false));
    const int vi = __builtin_bit_cast(int, v);
    return (__builtin_bit_cast(float, __builtin_amdgcn_readlane(vi, 0)) + __builtin_bit_cast(float, __builtin_amdgcn_readlane(vi, 16))) + (__builtin_bit_cast(float, __builtin_amdgcn_readlane(vi, 32)) + __builtin_bit_cast(float, __builtin_amdgcn_readlane(vi, 48)));
}
__device__ __forceinline__ float row_sum16(float v) {
    v += __builtin_bit_cast(float, __builtin_amdgcn_update_dpp(0, __builtin_bit_cast(int, v), 0xB1, 0xf, 0xf, false));
    v += __builtin_bit_cast(float, __builtin_amdgcn_update_dpp(0, __builtin_bit_cast(int, v), 0x4E, 0xf, 0xf, false));
    v += __builtin_bit_cast(float, __builtin_amdgcn_update_dpp(0, __builtin_bit_cast(int, v), 0x141, 0xf, 0xf, false));
    v += __builtin_bit_cast(float, __builtin_amdgcn_update_dpp(0, __builtin_bit_cast(int, v), 0x140, 0xf, 0xf, false));
    return v;
}
__device__ __forceinline__ void wave_sum8(float (&x)[8]) {
    float y[4];
#pragma unroll
    for (int k = 0; k < 4; ++k) { float a = x[2 * k], b = x[2 * k + 1];
        asm volatile("s_nop 1\n\tv_permlane32_swap_b32 %0, %1\n\ts_nop 1" : "+v"(a), "+v"(b));
        float v = a + b;
        v += __builtin_bit_cast(float, __builtin_amdgcn_update_dpp(0, __builtin_bit_cast(int, v), 0xB1, 0xf, 0xf, false));
        v += __builtin_bit_cast(float, __builtin_amdgcn_update_dpp(0, __builtin_bit_cast(int, v), 0x4E, 0xf, 0xf, false));
        v += __builtin_bit_cast(float, __builtin_amdgcn_update_dpp(0, __builtin_bit_cast(int, v), 0x141, 0xf, 0xf, false));
        v += __builtin_bit_cast(float, __builtin_amdgcn_update_dpp(0, __builtin_bit_cast(int, v), 0x140, 0xf, 0xf, false));
        y[k] = v; }
#pragma unroll
    for (int k = 0; k < 4; ++k) { const int vi = __builtin_bit_cast(int, y[k]);
        x[2 * k] = __builtin_bit_cast(float, __builtin_amdgcn_readlane(vi, 0)) + __builtin_bit_cast(float, __builtin_amdgcn_readlane(vi, 16));
        x[2 * k + 1] = __builtin_bit_cast(float, __builtin_amdgcn_readlane(vi, 32)) + __builtin_bit_cast(float, __builtin_amdgcn_readlane(vi, 48)); }
}
__device__ __forceinline__ float tanh_fast_(float x) { const float e = __expf(2.0f * x); return 1.0f - 2.0f * __builtin_amdgcn_rcpf(1.0f + e); }
__device__ __forceinline__ float sigmoidf_(float x) { return __builtin_amdgcn_rcpf(1.0f + __expf(-x)); }
__device__ __forceinline__ float silu_(float x) { return x * __builtin_amdgcn_rcpf(1.0f + __expf(-x)); }
__device__ __forceinline__ float gelu_tanh_(float x) { const float a = 0.7978845608028654f * (x + 0.044715f * x * x * x); return 0.5f * x * (1.0f + tanhf(a)); }
__device__ __forceinline__ u32x2 cvt8_fp8(const f32x4 a, const f32x4 b) {
    const float lim = 448.0f; int w0 = 0, w1 = 0;
    w0 = __builtin_amdgcn_cvt_pk_fp8_f32(__builtin_amdgcn_fmed3f(a[0], -lim, lim), __builtin_amdgcn_fmed3f(a[1], -lim, lim), w0, false);
    w0 = __builtin_amdgcn_cvt_pk_fp8_f32(__builtin_amdgcn_fmed3f(a[2], -lim, lim), __builtin_amdgcn_fmed3f(a[3], -lim, lim), w0, true);
    w1 = __builtin_amdgcn_cvt_pk_fp8_f32(__builtin_amdgcn_fmed3f(b[0], -lim, lim), __builtin_amdgcn_fmed3f(b[1], -lim, lim), w1, false);
    w1 = __builtin_amdgcn_cvt_pk_fp8_f32(__builtin_amdgcn_fmed3f(b[2], -lim, lim), __builtin_amdgcn_fmed3f(b[3], -lim, lim), w1, true);
    return (u32x2){(unsigned)w0, (unsigned)w1};
}
constexpr float F8_X = 16.f, F8_WGU = 256.f, F8_ACT = 16.f, F8_WD = 512.f;
__device__ __forceinline__ int lane_now() { int l; asm volatile("v_mbcnt_lo_u32_b32 %0, -1, 0\n\tv_mbcnt_hi_u32_b32 %0, -1, %0" : "=v"(l)); return l; }
#define LDS_WAIT() asm volatile("s_waitcnt lgkmcnt(0)" ::: "memory")
#define VM_WAIT() asm volatile("s_waitcnt vmcnt(0)" ::: "memory")

#define XB_TMO      128
#define XB_XCNT(j)  (256  + 64 * (j))
#define XB_XSUB(j)  (1280 + 64 * (j))
#define XB_XGEN(j)  (2304 + 64 * (j))
#define XB_TOP      3328
#define XB_TOPGEN   3392
#define XCD_BAR_WORDS 3456
#define XB_SPIN_CAP (1u << 18)
__device__ __forceinline__ unsigned xb_ld(unsigned* p)              { return __hip_atomic_load(p, __ATOMIC_RELAXED, __HIP_MEMORY_SCOPE_AGENT); }
__device__ __forceinline__ unsigned xb_add(unsigned* p, unsigned v) { return __hip_atomic_fetch_add(p, v, __ATOMIC_RELAXED, __HIP_MEMORY_SCOPE_AGENT); }
__device__ __forceinline__ unsigned xb_xcc_id() { return (unsigned)__builtin_amdgcn_s_getreg((3 << 11) | 20) & 0xFu; }
#define XB_SPIN(cond, bar) do { unsigned _sp = 0; while (cond) { __builtin_amdgcn_s_sleep(1); \
    if ((++_sp & 255u) == 0u) { if (xb_ld(&(bar)[XB_TMO])) break; if (_sp > XB_SPIN_CAP) { atomicAdd(&(bar)[XB_TMO], 1u); break; } } } } while (0)
struct XcdBarrier { unsigned* bar; unsigned x; volatile LAS unsigned* st; int wave; };
__device__ __forceinline__ XcdBarrier xcd_barrier_post(unsigned* bar, volatile LAS unsigned* st) {
    XcdBarrier b; b.bar = bar; b.x = xb_xcc_id(); b.st = st; b.wave = __builtin_amdgcn_readfirstlane(threadIdx.x >> 6);
    if (threadIdx.x == 0) (void)xb_add(&bar[XB_XCNT(b.x)], 1u);
    return b;
}
__device__ __forceinline__ void xcd_barrier_complete(unsigned* bar, unsigned x, unsigned& nloc, unsigned& nx) {
    const unsigned G = gridDim.x * gridDim.y * gridDim.z;
    unsigned sum, cnt, mine, sp = 0u;
    for (;;) {
        sum = 0u; cnt = 0u; mine = 0u;
#pragma unroll
        for (unsigned j = 0; j < 16; ++j) { const unsigned c = xb_ld(&bar[XB_XCNT(j)]); sum += c; cnt += (c > 0u) ? 1u : 0u; mine = (j == x) ? c : mine; }
        if (sum == G) break;
        __builtin_amdgcn_s_sleep(1);
        if ((++sp & 255u) == 0u) { if (xb_ld(&bar[XB_TMO])) break; if (sp > XB_SPIN_CAP) { atomicAdd(&bar[XB_TMO], 1u); break; } }
    }
    nloc = mine > 0u ? mine : 1u; nx = cnt > 0u ? cnt : 1u;
}
__device__ __forceinline__ void xcd_barrier(const XcdBarrier& b) {
    asm volatile("s_waitcnt vmcnt(0)" ::: "memory");
    __syncthreads();
    if (b.wave == 0 && lane_now() == 0) {
        unsigned* bar = b.bar;
        __builtin_amdgcn_s_waitcnt(0);
        unsigned nloc = b.st[0], nx = b.st[1];
        if (nloc == 0u) { xcd_barrier_complete(bar, b.x, nloc, nx); b.st[0] = nloc; b.st[1] = nx; }
        const unsigned old = xb_add(&bar[XB_XSUB(b.x)], 1u);
        const unsigned gen = old / nloc;
        if (old + 1u == (gen + 1u) * nloc) {
            __builtin_amdgcn_fence(__ATOMIC_RELEASE, "agent");
            asm volatile("s_waitcnt vmcnt(0)" ::: "memory");
            const unsigned og = xb_add(&bar[XB_TOP], 1u);
            const unsigned tg = og / nx;
            if (og + 1u == (tg + 1u) * nx) xb_add(&bar[XB_TOPGEN], 1u);
            else XB_SPIN(xb_ld(&bar[XB_TOPGEN]) == tg, bar);
            __builtin_amdgcn_fence(__ATOMIC_ACQUIRE, "agent");
            xb_add(&bar[XB_XGEN(b.x)], 1u);
            asm volatile("s_waitcnt vmcnt(0)" ::: "memory");
        } else {
            XB_SPIN(xb_ld(&bar[XB_XGEN(b.x)]) == gen, bar);
            __builtin_amdgcn_fence(__ATOMIC_ACQUIRE, "agent");
            asm volatile("s_waitcnt vmcnt(0)" ::: "memory");
        }
    }
    __syncthreads();
}

namespace pg8 {
constexpr int BM = 256, BK = 64, HALF = 128, HTB = HALF * BK * 2, STAGE_BYTES = 8 * HTB, NXCD = 8, WGM = 4;
__host__ __device__ __forceinline__ int lds_byte(int r, int c) { const int st = (r >> 4) * 2 + (c >> 5), rr = r & 15, cc = c & 31, ob = rr * 64 + cc * 2; return st * 1024 + (ob ^ (((ob >> 9) & 1) << 5)); }
__host__ __device__ __forceinline__ void stage_rc(int b, int& R, int& C) { const int st = b / 1024, sb = b % 1024, swz = sb ^ (((sb >> 9) & 1) << 5); R = (st >> 1) * 16 + swz / 64; C = (st & 1) * 32 + (swz % 64) / 2; }
__host__ __device__ __forceinline__ int perm32(int rho) { const int n = rho >> 4, i = rho & 15; return 8 * (i >> 2) + 4 * n + (i & 3); }

struct Unit { int pm, pn, e, rb; };

struct TileOrder {
    int nM, nN, nwg, G, c;
    __device__ void init(int nM_, int nN_, int G_, int c_) { nM = nM_; nN = nN_; nwg = nM * nN; G = G_; c = c_; }
    __device__ bool tile(int i, int& pm, int& pn) const {
        const long L = (long)i * G + c; if (L >= nwg) return false;
        int wgid = (int)L; { const int q = nwg / NXCD, r = nwg % NXCD, xcd = wgid % NXCD, off = wgid / NXCD; wgid = (xcd < r ? xcd * (q + 1) : r * (q + 1) + (xcd - r) * q) + off; }
        const int nig = WGM * nN, gid = wgid / nig, fm = gid * WGM, gsz = (nM - fm) < WGM ? (nM - fm) : WGM;
        pm = fm + ((wgid % nig) % gsz); pn = (wgid % nig) / gsz; return true;
    }
};
struct DenseSched {
    static constexpr bool GATHER = false;
    TileOrder o; const char* A; const char* Bt; int K;
    __device__ void init(const void* A_, const void* Bt_, int M, int N, int K_, int G, int c) { o.init(M / BM, N / BM, G, c); A = (const char*)A_; Bt = (const char*)Bt_; K = K_; }
    __device__ __forceinline__ bool next(int i, Unit& u) const { u.e = 0; u.rb = 0; return o.tile(i, u.pm, u.pn); }
    __device__ __forceinline__ const char* a_ptr() const { return A; }
    __device__ __forceinline__ const char* b_ptr() const { return Bt; }
    __device__ __forceinline__ unsigned a_base(const Unit& u) const { return (unsigned)u.pm * (unsigned)(BM * K * 2); }
    __device__ __forceinline__ unsigned b_base(const Unit& u) const { return (unsigned)u.pn * (unsigned)(BM * K * 2); }
    __device__ __forceinline__ void gather_ids(const Unit&, int, int, int (&)[4]) const {}
};

struct KvSched {
    static constexpr bool GATHER = false;
    TileOrder o; const char* A; const char* Bt;
    __device__ void init(const void* A_, const void* Bt_, int G, int c) { o.init(2 * MROWS / BM, 512 / BM, G, c); A = (const char*)A_; Bt = (const char*)Bt_; }
    __device__ __forceinline__ bool next(int i, Unit& u) const { u.e = 0; u.rb = 0; return o.tile(i, u.pm, u.pn); }
    __device__ __forceinline__ const char* a_ptr() const { return A; }
    __device__ __forceinline__ const char* b_ptr() const { return Bt; }
    __device__ __forceinline__ unsigned a_base(const Unit& u) const { return (unsigned)u.pm * (unsigned)(BM * D * 2); }
    __device__ __forceinline__ unsigned b_base(const Unit& u) const { return ((unsigned)(u.pm >= MROWS / BM ? 512 : 0) + (unsigned)u.pn * BM) * (unsigned)(D * 2); }
    __device__ __forceinline__ void gather_ids(const Unit&, int, int, int (&)[4]) const {}
};
typedef int i32x8v __attribute__((ext_vector_type(8)));
typedef int i32x4v __attribute__((ext_vector_type(4)));
template <class Epi, class Sched, bool ALIGN_EPI, bool FP8 = false, int VAR = 0>
__device__ __forceinline__ void gemm_phase(LAS unsigned char* lds, const int K, const Sched& S, const Epi& E, const int ldk_ = 0, const int wid_ = -1) {
    int widv_ = (wid_ >= 0) ? wid_ : __builtin_amdgcn_readfirstlane(threadIdx.x >> 6); asm volatile("" : "+s"(widv_));
    const int lane = lane_now(), wid = widv_, tid = wid * 64 + lane, wr = wid >> 2, wc = wid & 3, fr = lane & 15, fq = lane >> 4;
    const int nt = K / BK, LD = ldk_ ? ldk_ : K;
    unsigned voffA[2][2], voffB[2];
#pragma unroll
    for (int i = 0; i < 2; ++i) { int R, C; stage_rc(tid * 16 + i * 8192, R, C); const int Rb = (R & ~31) + perm32(R & 31);
        voffA[0][i] = (unsigned)(R * LD + C) * 2u; voffA[1][i] = (unsigned)((R + HALF) * LD + C) * 2u; voffB[i] = (unsigned)(Rb * LD + C) * 2u; }
    const unsigned kstep = (unsigned)(BK * 2);
    const unsigned hstep = (unsigned)(HALF * LD * 2);
    const __amdgpu_buffer_rsrc_t rsA = __builtin_amdgcn_make_buffer_rsrc((void*)S.a_ptr(), 0, 0x7ffffffc, 0x00020000), rsB = __builtin_amdgcn_make_buffer_rsrc((void*)S.b_ptr(), 0, 0x7ffffffc, 0x00020000);
    const unsigned ldsw = (unsigned)wid * 1024u;
    const int aoff = lds_byte(wr * 64 + fr, fq * 8), boff = lds_byte(wc * 32 + fr, fq * 8);
    LAS unsigned char* pA = lds + aoff; LAS unsigned char* pB = lds + 4 * HTB + boff;
#define PG8_SA(b, h) (((b) * 2 + (h)) * HTB)
#define PG8_SB(b, h) ((4 + (b) * 2 + (h)) * HTB)
#define PG8_SBR(b, h) (((b) * 2 + (h)) * HTB)
#define PG8_STAGE_R(rs, bufoff, gbase, voff) do { if constexpr (VAR != 3 && VAR != 4) _Pragma("unroll") for (int _i = 0; _i < 2; ++_i) \
        __builtin_amdgcn_raw_ptr_buffer_load_lds(rs, (LAS unsigned*)(lds + (bufoff) + ldsw + _i * 8192), 16, (voff)[_i], (gbase), 0, 0); } while (0)
#define PG8_STAGE(bufoff, gbase, voff) PG8_STAGE_R(rsB, bufoff, gbase, voff)
#define PG8_STAGE_A(bufoff, gbase, h) do { if constexpr (Sched::GATHER) { \
        __builtin_amdgcn_raw_ptr_buffer_load_lds(rsA, (LAS unsigned*)(lds + (bufoff) + ldsw), 16, (voffA[h][0] & 0xffffu) * (unsigned)(K * 2) + (cpk & 0xffffu), (gbase), 0, 0); \
        __builtin_amdgcn_raw_ptr_buffer_load_lds(rsA, (LAS unsigned*)(lds + (bufoff) + ldsw + 8192), 16, (voffA[h][0] >> 16) * (unsigned)(K * 2) + (cpk >> 16), (gbase), 0, 0); \
        } else { PG8_STAGE_R(rsA, bufoff, (gbase) + (h) * hstep, voffA[0]); } } while (0)
#define PG8_LD8(ptr_) __builtin_shufflevector(*(const LAS i32x4v*)(ptr_), *(const LAS i32x4v*)((ptr_) + 1024), 0, 1, 2, 3, 4, 5, 6, 7)
#define PG8_LDA(dst, b, h) do { if constexpr (VAR == 4 || VAR == 5) { _Pragma("unroll") for (int m = 0; m < 4; ++m) _Pragma("unroll") for (int k = 0; k < 2; ++k) asm volatile("" : "+v"(dst[m][k])); } else if constexpr (FP8) { _Pragma("unroll") for (int m = 0; m < 4; ++m) dst##8[m] = PG8_LD8(pA + PG8_SA(b, h) + m * 2048); } else { \
        _Pragma("unroll") for (int m = 0; m < 4; ++m) _Pragma("unroll") for (int k = 0; k < 2; ++k) dst[m][k] = *(const LAS bf16x8*)(pA + PG8_SA(b, h) + m * 2048 + k * 1024); } } while (0)
#define PG8_LDB(dst, b, h) do { if constexpr (VAR == 4 || VAR == 5) { _Pragma("unroll") for (int n = 0; n < 2; ++n) _Pragma("unroll") for (int k = 0; k < 2; ++k) asm volatile("" : "+v"(dst[n][k])); } else if constexpr (FP8) { _Pragma("unroll") for (int n = 0; n < 2; ++n) dst##8[n] = PG8_LD8(pB + PG8_SBR(b, h) + n * 2048); } else { \
        _Pragma("unroll") for (int n = 0; n < 2; ++n) _Pragma("unroll") for (int k = 0; k < 2; ++k) dst[n][k] = *(const LAS bf16x8*)(pB + PG8_SBR(b, h) + n * 2048 + k * 1024); } } while (0)
#define PG8_MMA(ai, bj, At, Bt) do { __builtin_amdgcn_s_setprio(1); if constexpr (VAR == 2) { _Pragma("unroll") for (int m = 0; m < 4; ++m) _Pragma("unroll") for (int k = 0; k < 2; ++k) asm volatile("" :: "v"(At[m][k])); _Pragma("unroll") for (int n = 0; n < 2; ++n) _Pragma("unroll") for (int k = 0; k < 2; ++k) asm volatile("" :: "v"(Bt[n][k])); } else if constexpr (FP8) { _Pragma("unroll") for (int m = 0; m < 4; ++m) _Pragma("unroll") for (int n = 0; n < 2; ++n) \
            acc[ai][bj][m][n] = __builtin_amdgcn_mfma_scale_f32_16x16x128_f8f6f4(Bt##8[n], At##8[m], acc[ai][bj][m][n], 0, 0, 0, 0x7f7f7f7f, 0, 0x7f7f7f7f); } else { \
        _Pragma("unroll") for (int m = 0; m < 4; ++m) _Pragma("unroll") for (int n = 0; n < 2; ++n) _Pragma("unroll") for (int k = 0; k < 2; ++k) \
        acc[ai][bj][m][n] = __builtin_amdgcn_mfma_f32_16x16x32_bf16(Bt[n][k], At[m][k], acc[ai][bj][m][n], 0, 0, 0); } __builtin_amdgcn_s_setprio(0); } while (0)
#define PG8_WAIT_V(n) asm volatile("s_waitcnt vmcnt(" #n ")" ::: "memory")
#define PG8_WAIT_L(n) asm volatile("s_waitcnt lgkmcnt(" #n ")" ::: "memory")
#define PG8_BAR __builtin_amdgcn_s_barrier()
#define PG8_SCHED __builtin_amdgcn_sched_barrier(0)
    Unit cur, nxt; int ui = 0;
    if (!S.next(0, cur)) return;
    float sv_ = 0.f; LAS float* const rsl_ = (LAS float*)(lds + STAGE_BYTES);
    unsigned cpk = 0u;
    if constexpr (Sched::GATHER) { int ids[4]; int R0, C0, R1, C1; stage_rc(tid * 16, R0, C0); stage_rc(tid * 16 + 8192, R1, C1); S.gather_ids(cur, R0, R1, ids);
        cpk = (unsigned)(C0 * 2) | ((unsigned)(C1 * 2) << 16);
#pragma unroll
        for (int h = 0; h < 2; ++h) voffA[h][0] = (unsigned)ids[h * 2 + 0] | ((unsigned)ids[h * 2 + 1] << 16); }
    f32x4 acc[2][2][4][2];
#pragma unroll
    for (int a = 0; a < 2; ++a)
#pragma unroll
        for (int b = 0; b < 2; ++b)
#pragma unroll
            for (int m = 0; m < 4; ++m)
#pragma unroll
                for (int n = 0; n < 2; ++n) acc[a][b][m][n] = (f32x4){0.f, 0.f, 0.f, 0.f};
    bf16x8 At[4][2], B0[2][2], B1[2][2]; i32x8v At8[4], B08[2], B18[2];
    if constexpr (VAR == 4 || VAR == 5) {
#pragma unroll
        for (int m = 0; m < 4; ++m)
#pragma unroll
            for (int k = 0; k < 2; ++k)
#pragma unroll
                for (int e = 0; e < 8; ++e) { const unsigned hsh = (unsigned)(lane * 8 + e + 64 * (m * 2 + k)) * 2654435761u; At[m][k][e] = (short)(0x3f00u | ((hsh >> 9) & 0xffu) | ((hsh >> 3) & 0x8000u));
                    if (m < 2) { B0[m][k][e] = (short)(0x3f00u | ((hsh >> 17) & 0xffu) | ((hsh >> 5) & 0x8000u)); B1[m][k][e] = (short)(0x3f00u | ((hsh >> 21) & 0xffu) | ((hsh >> 7) & 0x8000u)); } } }
    unsigned cA = S.a_base(cur), cB = S.b_base(cur);
    PG8_STAGE(PG8_SB(0, 0), cB, voffB); PG8_STAGE(PG8_SB(0, 1), cB + hstep, voffB); PG8_STAGE_A(PG8_SA(0, 0), cA, 0); PG8_STAGE_A(PG8_SA(0, 1), cA, 1);
    if (wr == 1) PG8_BAR;
    PG8_WAIT_V(2); PG8_BAR;
    PG8_STAGE(PG8_SB(1, 0), cB + kstep, voffB); PG8_STAGE_A(PG8_SA(1, 0), cA + kstep, 0); PG8_STAGE(PG8_SB(1, 1), cB + hstep + kstep, voffB);
    PG8_WAIT_V(6); PG8_BAR;
    for (;;) {
        const bool has_next = S.next(ui + 1, nxt);
        const unsigned nA = has_next ? S.a_base(nxt) : cA, nB = has_next ? S.b_base(nxt) : cB;
        unsigned voffN[2] = {0u, 0u};
#pragma unroll 1
        for (int t = 0; t < nt; t += 2) {
            asm volatile(".p2align 6" : "+v"(pA), "+v"(pB));
            if constexpr (Epi::STASH) { if (t == 2) { const int t2_ = wid * 64 + lane_now(); if (t2_ < 256) sv_ = E.stash_load(cur, t2_); }
                                        else if (t == 4) { const int t2_ = wid * 64 + lane_now(); if (t2_ < 256) rsl_[t2_] = sv_; } }
            const bool last = (t == nt - 2);
            const unsigned a1 = cA + (unsigned)(t + 1) * kstep;
            const unsigned a2 = last ? nA : cA + (unsigned)(t + 2) * kstep, b2 = last ? nB : cB + (unsigned)(t + 2) * kstep;
            const unsigned a3 = a2 + kstep, b3 = b2 + kstep;
            if constexpr (Sched::GATHER) { if (t == nt - 4 && has_next) { int ids[4]; int R0, C0, R1, C1; const int tid2 = wid * 64 + lane_now(); stage_rc(tid2 * 16, R0, C0); stage_rc(tid2 * 16 + 8192, R1, C1); S.gather_ids(nxt, R0, R1, ids);
#pragma unroll
                for (int h = 0; h < 2; ++h) voffN[h] = (unsigned)ids[h * 2 + 0] | ((unsigned)ids[h * 2 + 1] << 16); } }
            PG8_LDB(B0, 0, 0); PG8_LDB(B1, 0, 1); PG8_SCHED; PG8_LDA(At, 0, 0); PG8_STAGE_A(PG8_SA(1, 1), a1, 1);
            if constexpr (Sched::GATHER) { if (last && has_next) { voffA[0][0] = voffN[0]; voffA[1][0] = voffN[1]; } }
            PG8_WAIT_V(8); PG8_WAIT_L(0); PG8_BAR; PG8_MMA(0, 0, At, B0); PG8_MMA(0, 1, At, B1); PG8_BAR; PG8_SCHED;
            PG8_LDA(At, 0, 1); PG8_STAGE(PG8_SB(0, 0), b2, voffB); PG8_STAGE(PG8_SB(0, 1), b2 + hstep, voffB); PG8_STAGE_A(PG8_SA(0, 0), a2, 0);
            PG8_WAIT_V(8); PG8_WAIT_L(0); PG8_BAR; PG8_MMA(1, 0, At, B0); PG8_MMA(1, 1, At, B1); PG8_BAR; PG8_SCHED;
            PG8_LDB(B0, 1, 0); PG8_LDB(B1, 1, 1); PG8_SCHED; PG8_LDA(At, 1, 0); PG8_STAGE_A(PG8_SA(0, 1), a2, 1);
            PG8_WAIT_V(8); PG8_WAIT_L(0); PG8_BAR; PG8_MMA(0, 0, At, B0); PG8_MMA(0, 1, At, B1); PG8_BAR; PG8_SCHED;
            PG8_LDA(At, 1, 1); PG8_STAGE(PG8_SB(1, 0), b3, voffB); PG8_STAGE(PG8_SB(1, 1), b3 + hstep, voffB); PG8_STAGE_A(PG8_SA(1, 0), a3, 0);
            PG8_WAIT_V(8); PG8_WAIT_L(0); PG8_BAR; PG8_MMA(1, 0, At, B0); PG8_MMA(1, 1, At, B1); PG8_BAR; PG8_SCHED;
        }
        if constexpr (ALIGN_EPI) { if (wr == 0) PG8_BAR; }
        { const int le_ = lane_now(); E(acc, cur, wr, wc, le_ & 15, le_ >> 4, rsl_); }
        if (!has_next) break;
#pragma unroll
        for (int a = 0; a < 2; ++a)
#pragma unroll
            for (int b = 0; b < 2; ++b)
#pragma unroll
                for (int m = 0; m < 4; ++m)
#pragma unroll
                    for (int n = 0; n < 2; ++n) acc[a][b][m][n] = (f32x4){0.f, 0.f, 0.f, 0.f};
        cur = nxt; cA = nA; cB = nB; ++ui;
        if constexpr (ALIGN_EPI) { if (wr == 1) PG8_BAR; }
    }
    PG8_WAIT_V(0);
    if constexpr (!ALIGN_EPI) { if (wr == 0) PG8_BAR; }
    PG8_BAR;
#undef PG8_SA
#undef PG8_SB
#undef PG8_SBR
#undef PG8_STAGE
#undef PG8_STAGE_R
#undef PG8_STAGE_A
#undef PG8_LDA
#undef PG8_LD8
#undef PG8_LDB
#undef PG8_MMA
#undef PG8_WAIT_V
#undef PG8_WAIT_L
#undef PG8_BAR
#undef PG8_SCHED
}
}
using pg8::Unit;

__device__ __forceinline__ float rstd_of(float ss) { return 1.0f / sqrtf(ss * (1.0f / D) + RMS_EPS); }
typedef unsigned long long rss_t;
__device__ __forceinline__ float rstd_fx(rss_t s) { return rstd_of((float)((double)s * (1.0 / 16777216.0))); }
__device__ __forceinline__ rss_t rss_fx(float ss) { return (rss_t)__float2ull_rn(ss * 16777216.0f); }

struct EpiInA {
    static constexpr bool STASH = true;
    __device__ __forceinline__ float stash_load(const Unit& u, int lrow) const { return rstd_fx(rowss[u.pm * 256 + lrow]); }
    bf16_t* U; bf16_t* Q; const rss_t* rowss;
    __device__ __forceinline__ void operator()(const f32x4 (&acc)[2][2][4][2], const Unit& u, int wr, int wc, int fr, int fq, const LAS float* rsl) const {
        const int row0 = u.pm * 256 + wr * 64 + fr, col0 = u.pn * 256 + wc * 32 + 8 * fq;
        float rsq[8];
#pragma unroll
        for (int i = 0; i < 8; ++i) rsq[i] = rsl[wr * 64 + fr + (i >> 2) * 128 + (i & 3) * 16];
#pragma unroll
        for (int ai = 0; ai < 2; ++ai)
#pragma unroll
            for (int m = 0; m < 4; ++m) { const int row = row0 + ai * 128 + m * 16; const float rs = rsq[ai * 4 + m];
#pragma unroll
                for (int bj = 0; bj < 2; ++bj) { const int c = col0 + bj * 128; const f32x4 v0 = acc[ai][bj][m][0] * rs, v1 = acc[ai][bj][m][1] * rs;
                    u32x4 w; w.x = cvt_pk_bf16(v0[0], v0[1]); w.y = cvt_pk_bf16(v0[2], v0[3]); w.z = cvt_pk_bf16(v1[0], v1[1]); w.w = cvt_pk_bf16(v1[2], v1[3]);
                    if (c < CS) { const int g = c >> 4, hf = (c >> 3) & 1, b = row >> 12, t = row & 4095; *(u32x4*)(U + (((size_t)(b * S5G + g) * SEQ + t) * 16 + 8 * hf)) = w; }
                    else *(u32x4*)(Q + (size_t)row * CM + (c - CS)) = w; } }
    }
};
struct EpiBf16 {
    static constexpr bool STASH = true;
    __device__ __forceinline__ float stash_load(const Unit& u, int lrow) const { return rowss ? rstd_fx(rowss[u.pm * 256 + lrow]) : 1.0f; }
    bf16_t* O; int ldc; const rss_t* rowss; bf16_t* Q; int qcol0;
    __device__ __forceinline__ void operator()(const f32x4 (&acc)[2][2][4][2], const Unit& u, int wr, int wc, int fr, int fq, const LAS float* rsl) const {
        const int row0 = u.pm * 256 + wr * 64 + fr, col0 = u.pn * 256 + wc * 32 + 8 * fq;
        float rsv8[8];
#pragma unroll
        for (int i = 0; i < 8; ++i) rsv8[i] = rsl[wr * 64 + fr + (i >> 2) * 128 + (i & 3) * 16];
#pragma unroll
        for (int ai = 0; ai < 2; ++ai)
#pragma unroll
            for (int m = 0; m < 4; ++m) { const int row = row0 + ai * 128 + m * 16; const float rs = rsv8[ai * 4 + m];
#pragma unroll
                for (int bj = 0; bj < 2; ++bj) { const int c = col0 + bj * 128; const f32x4 v0 = acc[ai][bj][m][0] * rs, v1 = acc[ai][bj][m][1] * rs;
                    u32x4 w; w.x = cvt_pk_bf16(v0[0], v0[1]); w.y = cvt_pk_bf16(v0[2], v0[3]); w.z = cvt_pk_bf16(v1[0], v1[1]); w.w = cvt_pk_bf16(v1[2], v1[3]);
                    if (Q && c >= qcol0) *(u32x4*)(Q + (size_t)row * CM + (c - qcol0)) = w;
                    else *(u32x4*)(O + (size_t)row * ldc + c) = w; } }
    }
};
struct EpiRes {
    static constexpr bool STASH = false;
    const float* XinF; const bf16_t* XinB; bf16_t* H; rss_t* rowss; unsigned char* H8;
    __device__ __forceinline__ void operator()(const f32x4 (&acc)[2][2][4][2], const Unit& u, int wr, int wc, int fr, int fq, const LAS float* rsl) const {
        const int row0 = u.pm * 256 + wr * 64 + fr, col0 = u.pn * 256 + wc * 32 + 8 * fq;
#pragma unroll
        for (int ai = 0; ai < 2; ++ai) {
            f32x4 xv[4][2][2];
            if (XinF) {
#pragma unroll
                for (int m = 0; m < 4; ++m)
#pragma unroll
                    for (int bj = 0; bj < 2; ++bj) { const size_t o = (size_t)(row0 + ai * 128 + m * 16) * D + col0 + bj * 128; xv[m][bj][0] = *(const f32x4*)(XinF + o); xv[m][bj][1] = *(const f32x4*)(XinF + o + 4); }
            } else { u32x4 xb[4][2];
#pragma unroll
                for (int m = 0; m < 4; ++m)
#pragma unroll
                    for (int bj = 0; bj < 2; ++bj) xb[m][bj] = *(const u32x4*)(XinB + (size_t)(row0 + ai * 128 + m * 16) * D + col0 + bj * 128);
#pragma unroll
                for (int m = 0; m < 4; ++m)
#pragma unroll
                    for (int bj = 0; bj < 2; ++bj) { const u32x4 w = xb[m][bj]; xv[m][bj][0] = (f32x4){bflo(w.x), bfhi(w.x), bflo(w.y), bfhi(w.y)}; xv[m][bj][1] = (f32x4){bflo(w.z), bfhi(w.z), bflo(w.w), bfhi(w.w)}; } }
            __builtin_amdgcn_sched_barrier(0);
            float ss4[4];
#pragma unroll
            for (int m = 0; m < 4; ++m) { const int row = row0 + ai * 128 + m * 16; float ss = 0.f;
#pragma unroll
                for (int bj = 0; bj < 2; ++bj) { const size_t o = (size_t)row * D + col0 + bj * 128;
                    const f32x4 s0 = acc[ai][bj][m][0] + xv[m][bj][0], s1 = acc[ai][bj][m][1] + xv[m][bj][1];
                    u32x4 w; w.x = cvt_pk_bf16(s0[0], s0[1]); w.y = cvt_pk_bf16(s0[2], s0[3]); w.z = cvt_pk_bf16(s1[0], s1[1]); w.w = cvt_pk_bf16(s1[2], s1[3]);
                    *(u32x4*)(H + o) = w;
                    const f32x4 v0 = {bflo(w.x), bfhi(w.x), bflo(w.y), bfhi(w.y)}, v1 = {bflo(w.z), bfhi(w.z), bflo(w.w), bfhi(w.w)};
                    if (H8) *(u32x2*)(H8 + o) = cvt8_fp8(v0 * F8_X, v1 * F8_X);
                    ss += (v0[0] * v0[0] + v0[1] * v0[1]) + (v0[2] * v0[2] + v0[3] * v0[3]) + (v1[0] * v1[0] + v1[1] * v1[1]) + (v1[2] * v1[2] + v1[3] * v1[3]); }
                ss4[m] = ss; }
#pragma unroll
            for (int m = 0; m < 4; ++m) { float ss = ss4[m]; ss += __shfl_xor(ss, 16); ss += __shfl_xor(ss, 32);
                if (fq == 0) atomicAdd(rowss + row0 + ai * 128 + m * 16, rss_fx(ss)); }
            __builtin_amdgcn_sched_barrier(0); }
    }
};
struct EpiSwiglu {
    static constexpr bool STASH = true;
    __device__ __forceinline__ float stash_load(const Unit& u, int lrow) const { return rsv ? rsv[u.rb + lrow] : rstd_fx(rowss[u.pm * 256 + lrow]); }
    bf16_t* O; int ldo; const rss_t* rowss; const float* rsv; int skip;
    __device__ __forceinline__ void operator()(const f32x4 (&acc)[2][2][4][2], const Unit& u, int wr, int wc, int fr, int fq, const LAS float* rsl) const {
        if (skip) return;
        const int lrow0 = wr * 64 + fr, col0 = u.pn * 128 + wc * 32 + 8 * fq;
        float rs8[8];
#pragma unroll
        for (int i = 0; i < 8; ++i) { const int lrow = lrow0 + (i >> 2) * 128 + (i & 3) * 16; rs8[i] = (skip == 3) ? 1.0f : rsl[lrow]; }
#pragma unroll
        for (int ai = 0; ai < 2; ++ai)
#pragma unroll
            for (int m = 0; m < 4; ++m) { const int lrow = lrow0 + ai * 128 + m * 16;
                const float rs = rs8[ai * 4 + m]; const size_t orow = rsv ? ((size_t)u.e + lrow) : (size_t)(u.pm * 256 + lrow);
                const f32x4 g0 = acc[ai][0][m][0] * rs, g1 = acc[ai][0][m][1] * rs, u0 = acc[ai][1][m][0] * rs, u1 = acc[ai][1][m][1] * rs;
                u32x4 w; w.x = cvt_pk_bf16(silu_(g0[0]) * u0[0], silu_(g0[1]) * u0[1]); w.y = cvt_pk_bf16(silu_(g0[2]) * u0[2], silu_(g0[3]) * u0[3]);
                w.z = cvt_pk_bf16(silu_(g1[0]) * u1[0], silu_(g1[1]) * u1[1]); w.w = cvt_pk_bf16(silu_(g1[2]) * u1[2], silu_(g1[3]) * u1[3]);
                if (skip == 3) { w.x = cvt_pk_bf16(g0[0] * u0[0], g0[1] * u0[1]); w.y = cvt_pk_bf16(g0[2] * u0[2], g0[3] * u0[3]); w.z = cvt_pk_bf16(g1[0] * u1[0], g1[1] * u1[1]); w.w = cvt_pk_bf16(g1[2] * u1[2], g1[3] * u1[3]); }
                if (skip == 2) asm volatile("" :: "v"(w)); else if (skip == 4) *(u32x4*)(O + ((size_t)blockIdx.x * 256 + lrow) * 128 + (col0 & 127)) = w; else
                *(u32x4*)(O + orow * ldo + col0) = w; }
    }
};
struct EpiSwigluF8 {
    static constexpr bool STASH = true;
    __device__ __forceinline__ float stash_load(const Unit& u, int lrow) const { return rsv[u.rb + lrow] * (1.0f / (F8_X * F8_WGU)); }
    unsigned char* O8; int ldo; const float* rsv;
    __device__ __forceinline__ void operator()(const f32x4 (&acc)[2][2][4][2], const Unit& u, int wr, int wc, int fr, int fq, const LAS float* rsl) const {
        const int lrow0 = wr * 64 + fr, col0 = u.pn * 128 + wc * 32 + 8 * fq;
        float rs8[8];
#pragma unroll
        for (int i = 0; i < 8; ++i) rs8[i] = rsl[lrow0 + (i >> 2) * 128 + (i & 3) * 16];
#pragma unroll
        for (int ai = 0; ai < 2; ++ai)
#pragma unroll
            for (int m = 0; m < 4; ++m) { const int lrow = lrow0 + ai * 128 + m * 16; const float rs = rs8[ai * 4 + m];
                f32x4 a0, a1;
#pragma unroll
                for (int e = 0; e < 4; ++e) { a0[e] = silu_(acc[ai][0][m][0][e] * rs) * (acc[ai][1][m][0][e] * rs) * F8_ACT; a1[e] = silu_(acc[ai][0][m][1][e] * rs) * (acc[ai][1][m][1][e] * rs) * F8_ACT; }
                *(u32x2*)(O8 + ((size_t)u.e + lrow) * ldo + col0) = cvt8_fp8(a0, a1);
                asm volatile("" ::: "memory"); }
    }
};
struct EpiSlot {
    static constexpr bool STASH = false;
    bf16_t* O;
    __device__ __forceinline__ void operator()(const f32x4 (&acc)[2][2][4][2], const Unit& u, int wr, int wc, int fr, int fq, const LAS float* rsl) const {
        const int lrow0 = wr * 64 + fr, col0 = u.pn * 256 + wc * 32 + 8 * fq;
#pragma unroll
        for (int ai = 0; ai < 2; ++ai)
#pragma unroll
            for (int m = 0; m < 4; ++m) { const size_t orow = (size_t)u.e + lrow0 + ai * 128 + m * 16;
#pragma unroll
                for (int bj = 0; bj < 2; ++bj) { const float sc = 1.0f / (F8_ACT * F8_WD); const f32x4 v0 = acc[ai][bj][m][0] * sc, v1 = acc[ai][bj][m][1] * sc;
                    u32x4 w; w.x = cvt_pk_bf16(v0[0], v0[1]); w.y = cvt_pk_bf16(v0[2], v0[3]); w.z = cvt_pk_bf16(v1[0], v1[1]); w.w = cvt_pk_bf16(v1[2], v1[3]);
                    *(u32x4*)(O + orow * D + col0 + bj * 128) = w; } }
    }
};

struct MoeGuSched {
    static constexpr bool GATHER = true;
    pg8::TileOrder o; const char* A; const char* W; const int* list; const LAS int* tab; int tile0;
    __device__ __forceinline__ bool next(int i, Unit& u) const {
        if (!o.tile(i, u.pm, u.pn)) return false;
        const int gt = tile0 + u.pm; int e = 0;
#pragma unroll
        for (int k = 1; k < 8; ++k) e += (gt >= tab[k]) ? 1 : 0;
        e = __builtin_amdgcn_readfirstlane(e);
        u.rb = __builtin_amdgcn_readfirstlane(e * 32768 + (gt - tab[e]) * 256); u.e = u.pm * 256; return true;
    }
    __device__ __forceinline__ const char* a_ptr() const { return A; }
    __device__ __forceinline__ const char* b_ptr() const { return W; }
    __device__ __forceinline__ unsigned a_base(const Unit&) const { return 0u; }
    __device__ __forceinline__ unsigned b_base(const Unit& u) const { return ((unsigned)(u.rb >> 15) * (2 * FE) + (unsigned)u.pn * 256) * (unsigned)D; }
    __device__ __forceinline__ void gather_ids(const Unit& u, int R0, int R1, int (&ids)[4]) const {
        const int e = u.rb >> 15, rank0 = u.rb & 32767, cnt = __builtin_amdgcn_readfirstlane(tab[16 + e]);
#pragma unroll
        for (int h = 0; h < 2; ++h) { const int r0 = R0 + 128 * h, r1 = R1 + 128 * h;
            ids[h * 2 + 0] = (rank0 + r0 < cnt) ? list[u.rb + r0] : 0; ids[h * 2 + 1] = (rank0 + r1 < cnt) ? list[u.rb + r1] : 0; }
    }
};
struct MoeDownSched {
    static constexpr bool GATHER = false;
    pg8::TileOrder o; const char* A; const char* W; const LAS int* tab; int tile0;
    __device__ __forceinline__ bool next(int i, Unit& u) const {
        if (!o.tile(i, u.pm, u.pn)) return false;
        const int gt = tile0 + u.pm; int e = 0;
#pragma unroll
        for (int k = 1; k < 8; ++k) e += (gt >= tab[k]) ? 1 : 0;
        u.rb = __builtin_amdgcn_readfirstlane(e); u.e = gt * 256; return true;
    }
    __device__ __forceinline__ const char* a_ptr() const { return A; }
    __device__ __forceinline__ const char* b_ptr() const { return W; }
    __device__ __forceinline__ unsigned a_base(const Unit& u) const { return (unsigned)u.pm * (unsigned)(256 * FE); }
    __device__ __forceinline__ unsigned b_base(const Unit& u) const { return ((unsigned)u.rb * D + (unsigned)u.pn * 256) * (unsigned)FE; }
    __device__ __forceinline__ void gather_ids(const Unit&, int, int, int (&)[4]) const {}
};

constexpr int TAIL_SPLIT = 7, TAIL_K = FE / TAIL_SPLIT;
struct MoeDownTailSched {
    static constexpr bool GATHER = false;
    pg8::TileOrder o; const char* A; const char* W; const LAS int* tab; int tile0;
    __device__ __forceinline__ bool next(int i, Unit& u) const {
        int cn; if (!o.tile(i, u.pm, cn)) return false;
        const int gt = tile0 + u.pm; int e = 0;
#pragma unroll
        for (int k = 1; k < 8; ++k) e += (gt >= tab[k]) ? 1 : 0;
        u.pn = cn & 3; u.rb = __builtin_amdgcn_readfirstlane(e) * 8 + (cn >> 2); u.e = u.pm * 256; return true;
    }
    __device__ __forceinline__ const char* a_ptr() const { return A; }
    __device__ __forceinline__ const char* b_ptr() const { return W; }
    __device__ __forceinline__ unsigned a_base(const Unit& u) const { return (unsigned)u.pm * (unsigned)(256 * FE) + (unsigned)(u.rb & 7) * TAIL_K; }
    __device__ __forceinline__ unsigned b_base(const Unit& u) const { return ((unsigned)(u.rb >> 3) * D + (unsigned)u.pn * 256) * (unsigned)FE + (unsigned)(u.rb & 7) * TAIL_K; }
    __device__ __forceinline__ void gather_ids(const Unit&, int, int, int (&)[4]) const {}
};
struct EpiSlotPart {
    static constexpr bool STASH = false;
    bf16_t* P;
    __device__ __forceinline__ void operator()(const f32x4 (&acc)[2][2][4][2], const Unit& u, int wr, int wc, int fr, int fq, const LAS float* rsl) const {
        const int lrow0 = wr * 64 + fr, col0 = u.pn * 256 + wc * 32 + 8 * fq; bf16_t* base = P + (size_t)(u.rb & 7) * 2048 * D;
#pragma unroll
        for (int ai = 0; ai < 2; ++ai)
#pragma unroll
            for (int m = 0; m < 4; ++m) { const size_t orow = (size_t)u.e + lrow0 + ai * 128 + m * 16;
#pragma unroll
                for (int bj = 0; bj < 2; ++bj) { const float sc = 1.0f / (F8_ACT * F8_WD); const f32x4 v0 = acc[ai][bj][m][0] * sc, v1 = acc[ai][bj][m][1] * sc;
                    u32x4 w; w.x = cvt_pk_bf16(v0[0], v0[1]); w.y = cvt_pk_bf16(v0[2], v0[3]); w.z = cvt_pk_bf16(v1[0], v1[1]); w.w = cvt_pk_bf16(v1[2], v1[3]);
                    *(u32x4*)(base + orow * D + col0 + bj * 128) = w; } }
    }
};

__device__ __forceinline__ void tr_item(const float* W, int K, int N, bf16_t* WT, const float* gain, int mode, LAS float* scr, int item, int lane, float f8s = 0.f) {
    const int nblk = N / 32, kb = item / nblk, nb = item % nblk, k0 = 64 * kb, n0 = 32 * nb;
    {
        const int r8 = lane >> 3, c4 = (lane & 7) * 4; f32x4 v[8]; float gn[8];
#pragma unroll
        for (int i = 0; i < 8; ++i) { v[i] = *(const f32x4*)(W + (size_t)(k0 + 8 * i + r8) * N + n0 + c4); gn[i] = gain ? gain[k0 + 8 * i + r8] : 1.0f; }
#pragma unroll
        for (int i = 0; i < 8; ++i) { LAS float* d = scr + (8 * i + r8) * 33 + c4; d[0] = v[i][0] * gn[i]; d[1] = v[i][1] * gn[i]; d[2] = v[i][2] * gn[i]; d[3] = v[i][3] * gn[i]; } }
    LDS_WAIT(); asm volatile("" ::: "memory");
    const int c = lane & 7;
#pragma unroll
    for (int j = 0; j < 4; ++j) { const int n = (lane >> 3) + 8 * j; const LAS float* s = scr + (8 * c) * 33 + n;
        u32x4 o; o.x = cvt_pk_bf16(s[0 * 33], s[1 * 33]); o.y = cvt_pk_bf16(s[2 * 33], s[3 * 33]); o.z = cvt_pk_bf16(s[4 * 33], s[5 * 33]); o.w = cvt_pk_bf16(s[6 * 33], s[7 * 33]);
        const int nn = n0 + n; const int row = (mode == 0) ? nn : (((nn >> 7) << 8) + (nn & 127) + (mode == 2 ? 128 : 0));
        if (f8s != 0.f) { const f32x4 a = {s[0 * 33] * f8s, s[1 * 33] * f8s, s[2 * 33] * f8s, s[3 * 33] * f8s}, b = {s[4 * 33] * f8s, s[5 * 33] * f8s, s[6 * 33] * f8s, s[7 * 33] * f8s};
            *(u32x2*)((unsigned char*)WT + (size_t)row * K + k0 + 8 * c) = cvt8_fp8(a, b); }
        else *(u32x4*)(WT + (size_t)row * K + k0 + 8 * c) = o; }
    LDS_WAIT(); asm volatile("" ::: "memory");
}
struct TrJob { const float* W; bf16_t* WT; const float* gain; int K, N, mode, items; float f8s; };
struct TrRegs { f32x4 v[8]; float gn[8]; };
__device__ __forceinline__ void tr_load(const TrJob& jb, int item, int lane, TrRegs& R) {
    const int nblk = jb.N / 32, kb = item / nblk, nb = item % nblk, k0 = 64 * kb, n0 = 32 * nb, r8 = lane >> 3, c4 = (lane & 7) * 4;
#pragma unroll
    for (int i = 0; i < 8; ++i) { R.v[i] = *(const f32x4*)(jb.W + (size_t)(k0 + 8 * i + r8) * jb.N + n0 + c4); R.gn[i] = jb.gain ? jb.gain[k0 + 8 * i + r8] : 1.0f; }
}
__device__ __forceinline__ void tr_fin(const TrJob& jb, int item, LAS float* scr, int lane, const TrRegs& R) {
    const int nblk = jb.N / 32, kb = item / nblk, nb = item % nblk, k0 = 64 * kb, n0 = 32 * nb, r8 = lane >> 3, c4 = (lane & 7) * 4;
#pragma unroll
    for (int i = 0; i < 8; ++i) { LAS float* d = scr + (8 * i + r8) * 33 + c4; d[0] = R.v[i][0] * R.gn[i]; d[1] = R.v[i][1] * R.gn[i]; d[2] = R.v[i][2] * R.gn[i]; d[3] = R.v[i][3] * R.gn[i]; }
    LDS_WAIT(); asm volatile("" ::: "memory");
    const int c = lane & 7;
#pragma unroll
    for (int j = 0; j < 4; ++j) { const int n = (lane >> 3) + 8 * j; const LAS float* s = scr + (8 * c) * 33 + n;
        const int nn = n0 + n; const int row = (jb.mode == 0) ? nn : (((nn >> 7) << 8) + (nn & 127) + (jb.mode == 2 ? 128 : 0));
        const float f8s = jb.f8s; const f32x4 a = {s[0 * 33] * f8s, s[1 * 33] * f8s, s[2 * 33] * f8s, s[3 * 33] * f8s}, b = {s[4 * 33] * f8s, s[5 * 33] * f8s, s[6 * 33] * f8s, s[7 * 33] * f8s};
        *(u32x2*)((unsigned char*)jb.WT + (size_t)row * jb.K + k0 + 8 * c) = cvt8_fp8(a, b); }
    LDS_WAIT(); asm volatile("" ::: "memory");
}


struct Args { const float* in[N_IN]; float* out; unsigned char* ws; int ph_lo, ph_hi, pass_lo, pass_hi; };

__device__ __forceinline__ void attn_naive(LAS unsigned char* lds, const bf16_t* Q, const bf16_t* KV, bf16_t* CAT, int bx, int G, int tid) {
    LAS float* Ks = (LAS float*)lds; LAS float* Vs = Ks + 256 * 64;
    for (int item = bx; item < NB * NH_MEM * 8; item += G) {
        const int b = item >> 5, h = (item >> 3) & 3, qb = item & 7;
#pragma unroll 4
        for (int i = 0; i < 32; ++i) { const int idx = tid + 512 * i, m = idx >> 6, d = idx & 63;
            const bf16_t* kr = KV + (size_t)(b * MEML + m) * 512 + h * 64 + d;
            Ks[idx] = bf2f(kr[0]); Vs[idx] = bf2f(kr[256]); }
        __syncthreads();
        const int row = b * SEQ + qb * 512 + tid;
        float q[64], o[64];
        { const u32x4* qp = (const u32x4*)(Q + (size_t)row * CM + h * 64);
#pragma unroll
          for (int i = 0; i < 8; ++i) { const u32x4 w = qp[i];
              q[8 * i + 0] = bflo(w.x) * 0.125f; q[8 * i + 1] = bfhi(w.x) * 0.125f; q[8 * i + 2] = bflo(w.y) * 0.125f; q[8 * i + 3] = bfhi(w.y) * 0.125f;
              q[8 * i + 4] = bflo(w.z) * 0.125f; q[8 * i + 5] = bfhi(w.z) * 0.125f; q[8 * i + 6] = bflo(w.w) * 0.125f; q[8 * i + 7] = bfhi(w.w) * 0.125f; } }
#pragma unroll
        for (int d = 0; d < 64; ++d) o[d] = 0.f;
        float mx = -1e30f, l = 0.f;
#pragma unroll 1
        for (int key = 0; key < MEML; ++key) {
            const LAS f32x4* kr = (const LAS f32x4*)(Ks + key * 64); float sc = 0.f;
#pragma unroll
            for (int d4 = 0; d4 < 16; ++d4) { const f32x4 kv = kr[d4]; sc += q[4 * d4] * kv[0] + q[4 * d4 + 1] * kv[1] + q[4 * d4 + 2] * kv[2] + q[4 * d4 + 3] * kv[3]; }
            const float mn = fmaxf(mx, sc), alpha = __expf(mx - mn), p = __expf(sc - mn); mx = mn; l = l * alpha + p;
            const LAS f32x4* vr = (const LAS f32x4*)(Vs + key * 64);
#pragma unroll
            for (int d4 = 0; d4 < 16; ++d4) { const f32x4 vv = vr[d4]; o[4 * d4] = o[4 * d4] * alpha + p * vv[0]; o[4 * d4 + 1] = o[4 * d4 + 1] * alpha + p * vv[1]; o[4 * d4 + 2] = o[4 * d4 + 2] * alpha + p * vv[2]; o[4 * d4 + 3] = o[4 * d4 + 3] * alpha + p * vv[3]; }
        }
        const float il = 1.0f / l;
        u32x4* op = (u32x4*)(CAT + (size_t)row * D + CS + h * 64);
#pragma unroll
        for (int i = 0; i < 8; ++i) { u32x4 w; w.x = cvt_pk_bf16(o[8 * i] * il, o[8 * i + 1] * il); w.y = cvt_pk_bf16(o[8 * i + 2] * il, o[8 * i + 3] * il);
            w.z = cvt_pk_bf16(o[8 * i + 4] * il, o[8 * i + 5] * il); w.w = cvt_pk_bf16(o[8 * i + 6] * il, o[8 * i + 7] * il); op[i] = w; }
        __syncthreads();
    }
}

__device__ __forceinline__ void s5_naive(const Args& a, LAS unsigned char* lds, const bf16_t* U, bf16_t* CAT, int bx, int G, int wave, int lane) {
    LAS float* xs = (LAS float*)(lds + wave * 1024);
    for (int it = bx + G * wave; it < NB * S5G; it += G * NWAVES) {
        const int b = it / S5G, g = it % S5G, p = lane;
        const double dt = exp((double)a.in[I_LOG_DT][g]), lr = a.in[I_LAM_RE][g * S5P + p], li = a.in[I_LAM_IM][g * S5P + p];
        const double mag = exp(lr * dt), ang = li * dt, abr_d = mag * cos(ang), abi_d = mag * sin(ang);
        const double nre = abr_d - 1.0, nim = abi_d, den = lr * lr + li * li, zr = (nre * lr + nim * li) / den, zi = (nim * lr - nre * li) / den;
        const float abr = (float)abr_d, abi = (float)abi_d;
        float bbr[16], bbi[16], cre[16], cim[16], wg[16];
#pragma unroll
        for (int j = 0; j < 16; ++j) { const double br = a.in[I_B_RE][(size_t)(g * S5P + p) * 16 + j], bi = a.in[I_B_IM][(size_t)(g * S5P + p) * 16 + j]; bbr[j] = (float)(zr * br - zi * bi); bbi[j] = (float)(zr * bi + zi * br); }
        const int jj = lane & 15, pq = lane >> 4;
#pragma unroll
        for (int q = 0; q < 16; ++q) { cre[q] = a.in[I_C_RE][(size_t)(g * 16 + jj) * S5P + 16 * pq + q]; cim[q] = a.in[I_C_IM][(size_t)(g * 16 + jj) * S5P + 16 * pq + q]; }
#pragma unroll
        for (int j = 0; j < 16; ++j) wg[j] = a.in[I_WGLU][(size_t)(g * 16 + j) * 16 + jj];
        const float dj = a.in[I_S5D][g * 16 + jj], bg = a.in[I_BGLU][g * 16 + jj];
        const bf16_t* up = U + (size_t)(b * S5G + g) * SEQ * 16;
        float xr = 0.f, xi = 0.f;
#pragma unroll 1
        for (int t = 0; t < SEQ; ++t) {
            const u32x4 w0 = *(const u32x4*)(up + (size_t)t * 16), w1 = *(const u32x4*)(up + (size_t)t * 16 + 8);
            float uf[16];
            uf[0] = bflo(w0.x); uf[1] = bfhi(w0.x); uf[2] = bflo(w0.y); uf[3] = bfhi(w0.y); uf[4] = bflo(w0.z); uf[5] = bfhi(w0.z); uf[6] = bflo(w0.w); uf[7] = bfhi(w0.w);
            uf[8] = bflo(w1.x); uf[9] = bfhi(w1.x); uf[10] = bflo(w1.y); uf[11] = bfhi(w1.y); uf[12] = bflo(w1.z); uf[13] = bfhi(w1.z); uf[14] = bflo(w1.w); uf[15] = bfhi(w1.w);
            const float uj = bf2f(up[(size_t)t * 16 + jj]);
            float bur = 0.f, bui = 0.f;
#pragma unroll
            for (int j = 0; j < 16; ++j) { bur += bbr[j] * uf[j]; bui += bbi[j] * uf[j]; }
            const float nxr = abr * xr - abi * xi + bur, nxi = abr * xi + abi * xr + bui; xr = nxr; xi = nxi;
            xs[p] = xr; xs[64 + p] = xi;
            LDS_WAIT(); asm volatile("" ::: "memory");
            float s = 0.f;
#pragma unroll
            for (int q4 = 0; q4 < 4; ++q4) { const f32x4 vr = *(const LAS f32x4*)(xs + 16 * pq + 4 * q4), vi = *(const LAS f32x4*)(xs + 64 + 16 * pq + 4 * q4);
#pragma unroll
                for (int e = 0; e < 4; ++e) s += cre[4 * q4 + e] * vr[e] - cim[4 * q4 + e] * vi[e]; }
            LDS_WAIT(); asm volatile("" ::: "memory");
            s += __shfl_xor(s, 16); s += __shfl_xor(s, 32);
            const float yg = gelu_tanh_(s + dj * uj);
            float z = bg;
#pragma unroll
            for (int j = 0; j < 16; ++j) z += __shfl(yg, j) * wg[j];
            const float o = yg * sigmoidf_(z);
            if (lane < 16) CAT[(size_t)(b * SEQ + t) * D + g * 16 + lane] = f2bf(o);
        }
    }
}

__device__ __forceinline__ void rwkv_prep(const Args& a, LAS unsigned char* lds, const bf16_t* P1, bf16_t* RA, bf16_t* RKK, bf16_t* RLD, bf16_t* RG, int bx, int G, int tid) {
    LAS float* twT = (LAS float*)lds; LAS float* adT = twT + 64 * 16; LAS float* sgT = adT + 64 * 16;
    const float* mu = a.in[I_MU];
    for (int tile = bx; tile < T / 16; tile += G) {
        __syncthreads();
#pragma unroll
        for (int i = 0; i < 8; ++i) { const int idx = tid + 512 * i, tok = idx >> 8, c = idx & 255, row = tile * 16 + tok, t = row & (SEQ - 1);
            const float cur = bf2f(P1[(size_t)row * INB + 2304 + c]), prev = t > 0 ? bf2f(P1[(size_t)(row - 1) * INB + 2304 + c]) : 0.f;
            const float xsv = cur + (prev - cur) * mu[2304 + c];
            if (c < 64) twT[c * 16 + tok] = tanhf(xsv); else if (c < 128) adT[(c - 64) * 16 + tok] = xsv; else sgT[(c - 128) * 16 + tok] = sigmoidf_(xsv); }
        __syncthreads();
        if (tid < 384) {
#pragma unroll 1
            for (int cc = 0; cc < 2; ++cc) { const int c = tid + 384 * cc;
                float aw[16], aa[16], ag[16];
#pragma unroll
                for (int k = 0; k < 16; ++k) { aw[k] = 0.f; aa[k] = 0.f; ag[k] = 0.f; }
#pragma unroll 2
                for (int m = 0; m < 64; ++m) { const float w2v = a.in[I_W2][(size_t)m * CS + c], a2v = a.in[I_A2][(size_t)m * CS + c];
#pragma unroll
                    for (int k4 = 0; k4 < 4; ++k4) { const f32x4 tw = *(const LAS f32x4*)(twT + m * 16 + 4 * k4), ad = *(const LAS f32x4*)(adT + m * 16 + 4 * k4);
#pragma unroll
                        for (int e = 0; e < 4; ++e) { aw[4 * k4 + e] += tw[e] * w2v; aa[4 * k4 + e] += ad[e] * a2v; } } }
#pragma unroll 2
                for (int m = 0; m < 128; ++m) { const float g2v = a.in[I_G2][(size_t)m * CS + c];
#pragma unroll
                    for (int k4 = 0; k4 < 4; ++k4) { const f32x4 sg = *(const LAS f32x4*)(sgT + m * 16 + 4 * k4);
#pragma unroll
                        for (int e = 0; e < 4; ++e) ag[4 * k4 + e] += sg[e] * g2v; } }
                const float w0 = a.in[I_W0][c], a0 = a.in[I_A0][c], kkw = a.in[I_KK][c], muk = mu[CS + c];
#pragma unroll
                for (int k = 0; k < 16; ++k) { const int row = tile * 16 + k, t = row & (SEQ - 1);
                    const float z = -(w0 + aw[k]);
                    const float sp = z > 20.f ? z : log1pf(__expf(z));
                    const float ld = -__expf(-sp - 0.5f);
                    const float av = sigmoidf_(a0 + aa[k]);
                    const float cur = bf2f(P1[(size_t)row * INB + CS + c]), prev = t > 0 ? bf2f(P1[(size_t)(row - 1) * INB + CS + c]) : 0.f;
                    const float kx = (cur + (prev - cur) * muk) * kkw;
                    const float ss = wave_sum(kx * kx);
                    const float kkv = kx / fmaxf(sqrtf(ss), 1e-12f);
                    const size_t o = (size_t)row * CS + c;
                    RA[o] = f2bf(av); RKK[o] = f2bf(kkv); RLD[o] = f2bf(ld); RG[o] = f2bf(ag[k]); }
            }
        }
    }
}

__device__ __forceinline__ void rwkv_naive(const Args& a, LAS unsigned char* lds, const bf16_t* P1, const bf16_t* RA, const bf16_t* RKK, const bf16_t* RLD, const bf16_t* RG, bf16_t* CAT, int bx, int G, int wave, int lane) {
    if (wave != 4) return;
    LAS float* vec = (LAS float*)lds;
    for (int item = bx; item < NB * RH; item += G) {
        const int b = item / RH, h = item % RH, c = h * 64 + lane;
        const float mur = a.in[I_MU][c], muk = a.in[I_MU][CS + c], muv = a.in[I_MU][2 * CS + c], ka = a.in[I_KA][c], rkc = a.in[I_RK][c], lw = a.in[I_LNXW][c], lb = a.in[I_LNXB][c];
        float S[64];
#pragma unroll
        for (int j = 0; j < 64; ++j) S[j] = 0.f;
        float prr = 0.f, prk = 0.f, prv = 0.f;
        const size_t row0 = (size_t)b * SEQ;
        bf16_t n_r = P1[row0 * INB + c], n_k = P1[row0 * INB + CS + c], n_v = P1[row0 * INB + 2 * CS + c], n_a = RA[row0 * CS + c], n_kk = RKK[row0 * CS + c], n_ld = RLD[row0 * CS + c], n_g = RG[row0 * CS + c];
#pragma unroll 1
        for (int t = 0; t < SEQ; ++t) {
            const float pr = bf2f(n_r), pk = bf2f(n_k), pv = bf2f(n_v), av = bf2f(n_a), kkv = bf2f(n_kk), ld = bf2f(n_ld), gv = bf2f(n_g);
            if (t + 1 < SEQ) { const size_t rn = row0 + t + 1; n_r = P1[rn * INB + c]; n_k = P1[rn * INB + CS + c]; n_v = P1[rn * INB + 2 * CS + c]; n_a = RA[rn * CS + c]; n_kk = RKK[rn * CS + c]; n_ld = RLD[rn * CS + c]; n_g = RG[rn * CS + c]; }
            const float r = pr + (prr - pr) * mur, k = pk + (prk - pk) * muk, v = pv + (prv - pv) * muv;
            prr = pr; prk = pk; prv = pv;
            const float kp = k * (1.f + (av - 1.f) * ka), ap = -kkv, bb = kkv * av, w = __expf(ld);
            vec[lane] = r; vec[64 + lane] = w; vec[128 + lane] = kp; vec[192 + lane] = ap; vec[256 + lane] = bb;
            LDS_WAIT(); asm volatile("" ::: "memory");
            float sa = 0.f;
#pragma unroll
            for (int j4 = 0; j4 < 16; ++j4) { const f32x4 x = *(const LAS f32x4*)(vec + 192 + 4 * j4); sa += S[4 * j4] * x[0] + S[4 * j4 + 1] * x[1] + S[4 * j4 + 2] * x[2] + S[4 * j4 + 3] * x[3]; }
            float y = 0.f;
#pragma unroll
            for (int j4 = 0; j4 < 16; ++j4) { const f32x4 wv = *(const LAS f32x4*)(vec + 64 + 4 * j4), bv = *(const LAS f32x4*)(vec + 256 + 4 * j4), kv = *(const LAS f32x4*)(vec + 128 + 4 * j4), rv = *(const LAS f32x4*)(vec + 4 * j4);
#pragma unroll
                for (int e = 0; e < 4; ++e) { const float s = S[4 * j4 + e] * wv[e] + sa * bv[e] + v * kv[e]; S[4 * j4 + e] = s; y += s * rv[e]; } }
            LDS_WAIT(); asm volatile("" ::: "memory");
            const float rkv = wave_sum(r * kp * rkc), bonus = rkv * v;
            const float mean = wave_sum(y) * (1.f / 64.f), dlt = y - mean, var = wave_sum(dlt * dlt) * (1.f / 64.f);
            const float yn = dlt * (1.0f / sqrtf(var + LNX_EPS)) * lw + lb;
            CAT[(row0 + t) * D + c] = f2bf((yn + bonus) * gv);
        }
    }
}

__device__ __forceinline__ void moe_router(const Args& a, const bf16_t* XB, unsigned* ctl, unsigned char* ws, int gw, int NGW, int lane, LAS unsigned char* sm, int wave) {
    int* list = (int*)(ws + WS_ROUTE2 + RT_LIST); float* lrstd = (float*)(ws + WS_ROUTE2 + RT_LRSTD);
    int* toke = (int*)(ws + WS_ROUTE2 + RT_TOKE); int* tokr = (int*)(ws + WS_ROUTE2 + RT_TOKR); float* tokw = (float*)(ws + WS_ROUTE2 + RT_TOKW);
    float wg[16][8];
    {   const float* wr = a.in[I_WR]; const f32x4* gr = (const f32x4*)(a.in[I_NORM_FFN] + D) + lane;
#pragma unroll
        for (int j = 0; j < 4; ++j) { const f32x4 g = gr[64 * j];
#pragma unroll
            for (int i = 0; i < 4; ++i) { const int k = 4 * (lane + 64 * j) + i; const f32x4 w0 = *(const f32x4*)(wr + (size_t)k * 8), w1 = *(const f32x4*)(wr + (size_t)k * 8 + 4);
#pragma unroll
                for (int e = 0; e < 4; ++e) { wg[4 * j + i][e] = g[i] * w0[e]; wg[4 * j + i][4 + e] = g[i] * w1[e]; } } } }
    float br[8];
#pragma unroll
    for (int e = 0; e < 8; ++e) br[e] = a.in[I_BR][e];
    int m_bi = 0, m_si = 0; float m_rs = 0.f, m_w0 = 0.f;
    u32x2 va[4], vb[4];
#define RT_LOAD(v_, r_) do { const u32x2* xr_ = (const u32x2*)(XB + (size_t)(r_) * D) + lane; _Pragma("unroll") for (int j = 0; j < 4; ++j) v_[j] = xr_[64 * j]; } while (0)
#define RT_ROW(v_, i_) do { float lg[8]; float s = 0.f; \
        _Pragma("unroll") for (int e = 0; e < 8; ++e) lg[e] = 0.f; \
        _Pragma("unroll") for (int j = 0; j < 4; ++j) _Pragma("unroll") for (int i = 0; i < 4; ++i) { const unsigned pw_ = (i < 2) ? v_[j].x : v_[j].y; const float hv = (i & 1) ? bfhi(pw_) : bflo(pw_); s += hv * hv; \
            _Pragma("unroll") for (int e = 0; e < 8; ++e) lg[e] += hv * wg[4 * j + i][e]; } \
        wave_sum8(lg); const float rs = rstd_of(wave_sum_fast(s)); \
        _Pragma("unroll") for (int e = 0; e < 8; ++e) lg[e] = lg[e] * rs + br[e]; \
        float bv = lg[0]; int bi = 0; \
        _Pragma("unroll") for (int e = 1; e < 8; ++e) if (lg[e] > bv) { bv = lg[e]; bi = e; } \
        float sv = -3.0e38f; int si = 0; \
        _Pragma("unroll") for (int e = 0; e < 8; ++e) if (e != bi && lg[e] > sv) { sv = lg[e]; si = e; } \
        const float w0 = 1.0f / (1.0f + __expf(sv - bv)); \
        if (lane == (i_)) { m_bi = bi; m_si = si; m_rs = rs; m_w0 = w0; } } while (0)
    int nrow = 0;
    if (gw < T) RT_LOAD(va, gw);
    for (int r = gw; r < T; r += 2 * NGW) {
        const int r2 = r + NGW, r3 = r + 2 * NGW;
        if (r2 < T) RT_LOAD(vb, r2);
        __builtin_amdgcn_sched_barrier(0);
        RT_ROW(va, nrow); ++nrow;
        if (r3 < T) RT_LOAD(va, r3);
        __builtin_amdgcn_sched_barrier(0);
        if (r2 < T) { RT_ROW(vb, nrow); ++nrow; }
    }
#undef RT_LOAD
#undef RT_ROW
    {   LAS int* wcnt = (LAS int*)sm; LAS int* wbase = wcnt + 64;
        const bool act = lane < nrow; int myc = 0; unsigned long long mk[8];
#pragma unroll
        for (int e = 0; e < 8; ++e) { mk[e] = __ballot(act && (m_bi == e || m_si == e)); if (lane == e) myc = __popcll(mk[e]); }
        if (lane < 8) wcnt[wave * 8 + lane] = myc;
        __syncthreads();
        if (wave == 0 && lane < 8) { int tot = 0, pre[8];
#pragma unroll
            for (int w = 0; w < 8; ++w) { pre[w] = tot; tot += wcnt[w * 8 + lane]; }
            const int base = tot ? (int)atomicAdd(ctl + CW_CNT + 64 * lane, (unsigned)tot) : 0;
#pragma unroll
            for (int w = 0; w < 8; ++w) wbase[w * 8 + lane] = base + pre[w]; }
        __syncthreads();
        if (act) { const int r = gw + NGW * lane; const int bi = m_bi, si = m_si; const float rs = m_rs, w0 = m_w0, w1 = 1.0f - w0;
            const unsigned long long lt = (1ull << lane) - 1ull; int r0 = 0, r1 = 0;
#pragma unroll
            for (int e = 0; e < 8; ++e) { const int rk = wbase[wave * 8 + e] + __popcll(mk[e] & lt); if (bi == e) r0 = rk; if (si == e) r1 = rk; }
            list[bi * 32768 + r0] = r; lrstd[bi * 32768 + r0] = rs; list[si * 32768 + r1] = r; lrstd[si * 32768 + r1] = rs;
            toke[2 * r] = bi; toke[2 * r + 1] = si; tokr[2 * r] = r0; tokr[2 * r + 1] = r1; tokw[2 * r] = w0; tokw[2 * r + 1] = w1; } }
}

constexpr int RW_LS = 72;
constexpr int RW_SLOT = 64 * RW_LS * 2;
constexpr int RW_FS = 65;
__device__ __forceinline__ LAS unsigned char* rw_slot(LAS unsigned char* lds, int s) { return lds + s * RW_SLOT; }
__device__ __forceinline__ bf16x8 rw_frag(const LAS unsigned char* m, int row, int kq, int ks) { return *(const LAS bf16x8*)(m + row * (RW_LS * 2) + (32 * ks + 8 * kq) * 2); }
__device__ __forceinline__ f32x4 rw_mm(const LAS unsigned char* A, const LAS unsigned char* Bt, int mt, int nt, int l15, int kq, f32x4 acc) {
#pragma unroll
    for (int ks = 0; ks < 2; ++ks) acc = __builtin_amdgcn_mfma_f32_16x16x32_bf16(rw_frag(A, 16 * mt + l15, kq, ks), rw_frag(Bt, 16 * nt + l15, kq, ks), acc, 0, 0, 0);
    return acc;
}
__device__ __forceinline__ void rw_store_T(LAS unsigned char* m, int mt, int nt, int q, int n, f32x4 v) {
    u32x2 w; w.x = cvt_pk_bf16(v[0], v[1]); w.y = cvt_pk_bf16(v[2], v[3]);
    *(LAS u32x2*)(m + (16 * nt + n) * (RW_LS * 2) + (16 * mt + 4 * q) * 2) = w;
}
__device__ __forceinline__ void rw_store_D(LAS unsigned char* m, int mt, int nt, int q, int n, f32x4 v) {
#pragma unroll
    for (int r = 0; r < 4; ++r) *(LAS bf16_t*)(m + (16 * mt + 4 * q + r) * (RW_LS * 2) + (16 * nt + n) * 2) = f2bf(v[r]);
}
struct RwF2 { bf16x8 k[2]; };
__device__ __forceinline__ RwF2 rw_ld2(const LAS unsigned char* m, int row, int kq) { RwF2 f; f.k[0] = rw_frag(m, row, kq, 0); f.k[1] = rw_frag(m, row, kq, 1); return f; }
__device__ __forceinline__ f32x4 rw_mmf(const RwF2& a, const RwF2& b, f32x4 acc) {
    acc = __builtin_amdgcn_mfma_f32_16x16x32_bf16(a.k[0], b.k[0], acc, 0, 0, 0); return __builtin_amdgcn_mfma_f32_16x16x32_bf16(a.k[1], b.k[1], acc, 0, 0, 0); }
#define RW_LOADED() __builtin_amdgcn_sched_barrier(0)
__device__ __forceinline__ float rw_ld1(const LAS unsigned char* m, int row, int col) { return bf2f(*(const LAS bf16_t*)(m + row * (RW_LS * 2) + col * 2)); }

#ifdef DBG_RWKV
__device__ __forceinline__ void rw_dbg_scan(LAS unsigned char* lds, int slot, int bit, unsigned* word, int tid) {
    unsigned bad = 0u;
    for (int i = tid; i < 4096; i += NTHR) { const float v = rw_ld1(rw_slot(lds, slot), i >> 6, i & 63); if (!(v - v == 0.f)) bad = 1u; }
    if (bad) atomicOr(word, 1u << bit);
}
#define RW_DBG(slot, bit) rw_dbg_scan(lds, slot, bit, B.dbg, tid)
__device__ __forceinline__ void rw_dbg_max(LAS unsigned char* lds, int slot, unsigned* word, int tid) {
    float m = 0.f;
    for (int i = tid; i < 4096; i += NTHR) { const float v = fabsf(rw_ld1(rw_slot(lds, slot), i >> 6, i & 63)); if (v - v == 0.f) m = fmaxf(m, v); }
    atomicMax(word, __float_as_uint(m));
}
#else
#define RW_DBG(slot, bit)
#endif
struct RwBufs { unsigned* dbg;  bf16_t* XL; bf16_t* Pp; bf16_t* Qp; bf16_t* Rp; float* WL; bf16_t* GA; bf16_t* GB; bf16_t* CAT; const bf16_t* P1; const bf16_t* w2T; const bf16_t* a2T; const bf16_t* g2T; };

__device__ __forceinline__ void rwkv_xpre(const Args& a, const RwBufs& B, int bx, int G, int wave) {
    const int tid = wave * 64 + lane_now(), c8 = (tid & 31) * 8, seg = c8 >> 5, tr = tid >> 5;
    const float* mu = a.in[I_MU];
    const f32x4 m0 = *(const f32x4*)(mu + 2304 + c8), m1 = *(const f32x4*)(mu + 2304 + c8 + 4);
#pragma unroll 2
    for (int r = bx * 16 + tr; r < T; r += G * 16) {
        const bf16_t* cp = B.P1 + (size_t)r * INB + 2304 + c8;
        const u32x4 cw = *(const u32x4*)cp, pw = ((r & (SEQ - 1)) == 0) ? (u32x4){0u, 0u, 0u, 0u} : *(const u32x4*)(cp - INB);
        float x[8]; const unsigned cwa[4] = {cw.x, cw.y, cw.z, cw.w}, pwa[4] = {pw.x, pw.y, pw.z, pw.w};
#pragma unroll
        for (int e = 0; e < 4; ++e) { const float c0 = bflo(cwa[e]), c1 = bfhi(cwa[e]), p0 = bflo(pwa[e]), p1 = bfhi(pwa[e]);
            const float mm0 = (e < 2) ? m0[2 * e] : m1[2 * e - 4], mm1 = (e < 2) ? m0[2 * e + 1] : m1[2 * e - 3];
            x[2 * e] = c0 + (p0 - c0) * mm0; x[2 * e + 1] = c1 + (p1 - c1) * mm1; }
#pragma unroll
        for (int e = 0; e < 8; ++e) { const float sg = __builtin_amdgcn_rcpf(1.0f + __expf(seg < 2 ? -2.0f * x[e] : -x[e])); x[e] = (seg < 2) ? (2.0f * sg - 1.0f) : ((seg >= 4) ? sg : x[e]); }
        u32x4 o; o.x = cvt_pk_bf16(x[0], x[1]); o.y = cvt_pk_bf16(x[2], x[3]); o.z = cvt_pk_bf16(x[4], x[5]); o.w = cvt_pk_bf16(x[6], x[7]);
        *(u32x4*)(B.XL + (size_t)r * 256 + c8) = o; }
}

#ifndef RW_DUPS
#define RW_DUPS 0
#endif
#define RW_REP(bit) _Pragma("unroll 1") for (int rp_ = 0; rp_ < ((((RW_DUPS) >> (bit)) & 1) ? 4 : 1); ++rp_)
__device__ __forceinline__ void rwkv_r1(const Args& a, LAS unsigned char* lds, const RwBufs& B, int bx, int G, int wave, int nitems) {
    const int lane = lane_now(), l15 = lane & 15, kq = lane >> 4, q = kq, n = l15, tid = wave * 64 + lane;
    LAS float* Fw = (LAS float*)lds; LAS float* Fa = Fw + 64 * RW_FS; LAS float* Fg = Fa + 64 * RW_FS;
    LAS float* gsum = (LAS float*)(lds + 15 * RW_SLOT);
    const float* mu = a.in[I_MU];
    const int h = bx % RH, rk = bx / RH, nh = (G - h + RH - 1) / RH, nbc = nitems / RH;
    u32x4 pcw[4]; unsigned ldrk[9], ldv2[5];
#define RW_ISSUE(bc_) do { const int b_ = (bc_) >> 6, c_ = (bc_) & 63; const size_t r0_ = (size_t)b_ * SEQ + c_ * 64; \
        { const int tid_ = wave * 64 + lane_now(); const int t_ = tid_ >> 3, seg_ = tid_ & 7; const bf16_t* cp_ = B.XL + (r0_ + t_) * 256 + 32 * seg_; \
          _Pragma("unroll") for (int v8 = 0; v8 < 4; ++v8) pcw[v8] = *(const u32x4*)(cp_ + 8 * v8); } \
        { const bf16_t* pr0_ = B.P1 + (r0_ + 8 * wave) * INB + h * 64 + lane_now(); const bool z0_ = (c_ == 0 && wave == 0); \
          _Pragma("unroll") for (int u = 0; u < 9; ++u) { unsigned r_ = 0u, k_ = 0u, v_ = 0u; if (!(u == 0 && z0_)) { const bf16_t* pp_ = pr0_ + (ptrdiff_t)(u - 1) * INB; r_ = pp_[0]; k_ = pp_[CS]; v_ = pp_[2 * CS]; } \
              ldrk[u] = r_ | (k_ << 16); if (u & 1) ldv2[u >> 1] |= v_ << 16; else ldv2[u >> 1] = v_; } } } while (0)
    const int cgh = h * 64 + lane;
    const float hc_a0 = a.in[I_A0][cgh], hc_kk = a.in[I_KK][cgh], hc_ka = a.in[I_KA][cgh], hc_rk = a.in[I_RK][cgh], hc_lxw = a.in[I_LNXW][cgh], hc_lxb = a.in[I_LNXB][cgh];
    const float hc_mur = mu[cgh], hc_muk = mu[CS + cgh], hc_muv = mu[2 * CS + cgh], hc_w0n = a.in[I_W0][h * 64 + 16 * (wave & 3) + l15];
#define RW_WFR_LOAD \
        { const int ntw = wave & 3; const size_t rw = (size_t)(h * 64 + 16 * ntw + l15); \
    _Pragma("unroll") \
          for (int ks = 0; ks < 2; ++ks) { wfr[ks] = *(const bf16x8*)(B.w2T + rw * 64 + 32 * ks + 8 * kq); wfr[2 + ks] = *(const bf16x8*)(B.a2T + rw * 64 + 32 * ks + 8 * kq); } \
    _Pragma("unroll") \
          for (int ks = 0; ks < 4; ++ks) wfr[4 + ks] = *(const bf16x8*)(B.g2T + rw * 128 + 32 * ks + 8 * kq); } \

    bf16x8 wfr[8];
#if !RW_DUPS
    RW_WFR_LOAD
#endif
    if (rk < nbc) RW_ISSUE(rk);
#pragma unroll 1
    for (int bc = rk; bc < nbc; bc += nh) {
        const int b = bc >> 6, c = bc & 63, item = bc * RH + h;
        const size_t row0 = (size_t)b * SEQ + c * 64;
#if RW_DUPS
        RW_WFR_LOAD
#endif
        __syncthreads();
        { const int tid0 = wave * 64 + lane_now(), t = tid0 >> 3, seg = tid0 & 7;
          LAS unsigned char* dst = rw_slot(lds, 6 + (seg >> 1)) + t * (RW_LS * 2) + (32 * (seg & 1)) * 2;
#pragma unroll
          for (int v8 = 0; v8 < 4; ++v8) *(LAS u32x4*)(dst + 16 * v8) = pcw[v8]; }
        __syncthreads();
        RW_REP(1) {
#pragma unroll
        for (int i6 = 0; i6 < 6; ++i6) { const int ti = wave + 8 * i6, mat = i6 >> 1, mt = (ti >> 2) & 3, nt = wave & 3; f32x4 acc = {0.f, 0.f, 0.f, 0.f};
            if (mat < 2) { const LAS unsigned char* X = rw_slot(lds, 6 + mat);
#pragma unroll
                for (int ks = 0; ks < 2; ++ks) acc = __builtin_amdgcn_mfma_f32_16x16x32_bf16(rw_frag(X, 16 * mt + l15, kq, ks), wfr[2 * mat + ks], acc, 0, 0, 0);
            } else {
#pragma unroll
                for (int ks = 0; ks < 4; ++ks) acc = __builtin_amdgcn_mfma_f32_16x16x32_bf16(rw_frag(rw_slot(lds, 8 + (ks >> 1)), 16 * mt + l15, kq, ks & 1), wfr[4 + ks], acc, 0, 0, 0); }
            LAS float* F = (mat == 0) ? Fw : (mat == 1 ? Fa : Fg);
            if (mat == 0) {
                const float w0n = hc_w0n; float s4 = 0.f;
#pragma unroll
                for (int r = 0; r < 4; ++r) { const float z = -(w0n + acc[r]); acc[r] = -0.6065306597126334f * __builtin_amdgcn_rcpf(1.0f + __expf(z)); s4 += acc[r]; }
                s4 += __shfl_xor(s4, 16);
                if ((q & 1) == 0) gsum[(2 * mt + (q >> 1)) * 64 + 16 * nt + n] = s4; }
#pragma unroll
            for (int r = 0; r < 4; ++r) F[(16 * mt + 4 * q + r) * RW_FS + 16 * nt + n] = acc[r]; }
        __syncthreads();
        }
        RW_REP(2) {
        {   const int j = lane, cg = h * 64 + j, t0 = 8 * wave;
            const float a0 = hc_a0, kkw = hc_kk, kaw = hc_ka, rkw = hc_rk, lxw = hc_lxw, lxb = hc_lxb, mur = hc_mur, muk = hc_muk, muv = hc_muv;
            float ldv[8], av[8], rv[8], kv[8], vv[8], kkv[8];
            float pr_r = bflo(ldrk[0]), pr_k = bfhi(ldrk[0]), pr_v = bflo(ldv2[0]);
#pragma unroll
            for (int u = 0; u < 8; ++u) { const float cr = bflo(ldrk[u + 1]), ck = bfhi(ldrk[u + 1]), cv = ((u + 1) & 1) ? bfhi(ldv2[(u + 1) >> 1]) : bflo(ldv2[(u + 1) >> 1]);
                rv[u] = cr + (pr_r - cr) * mur; kv[u] = ck + (pr_k - ck) * muk; vv[u] = cv + (pr_v - cv) * muv; pr_r = cr; pr_k = ck; pr_v = cv;
                ldv[u] = Fw[(t0 + u) * RW_FS + j];
                av[u] = sigmoidf_(a0 + Fa[(t0 + u) * RW_FS + j]);
                const float kx = kv[u] * kkw; const float ss = wave_sum_fast(kx * kx); kkv[u] = kx * __builtin_amdgcn_rsqf(fmaxf(ss, 1e-24f)); }
            float lw[8]; lw[0] = ldv[0];
#pragma unroll
            for (int u = 1; u < 8; ++u) lw[u] = lw[u - 1] + ldv[u];
            float off = 0.f, tot = 0.f;
#pragma unroll
            for (int w8 = 0; w8 < 8; ++w8) { const float gs = gsum[w8 * 64 + j]; tot += gs; if (w8 < wave) off += gs; }
            if (wave == 0) B.WL[(size_t)item * 64 + lane_now()] = __expf(tot);
            unsigned pAt[4], pBh[4], pKh[4], pV[4], pga[4], pgb[4];
            const float WLt = __expf(tot); float Wprev = __expf(off);
#pragma unroll
            for (int u2 = 0; u2 < 4; ++u2) { float tAt[2], tBh[2], tKh[2], ga2[2], gb2[2];
#pragma unroll
                for (int uu = 0; uu < 2; ++uu) { const int u = 2 * u2 + uu; const float lwt = off + lw[u];
                    const float kp = kv[u] * (1.f + (av[u] - 1.f) * kaw), ap = -kkv[u], bb = kkv[u] * av[u];
                    const float Wt = __expf(lwt), Wm1 = Wprev, iW = __builtin_amdgcn_rcpf(Wt), WLr = WLt * iW; Wprev = Wt;
                    const float bonus = wave_sum_fast(rv[u] * kp * rkw);
                    const float gv = Fg[(t0 + u) * RW_FS + j];
                    ga2[uu] = lxw * gv; gb2[uu] = (lxb + bonus * vv[u]) * gv;
                    const int t = t0 + u;
                    *(LAS bf16_t*)(rw_slot(lds, 10) + t * (RW_LS * 2) + j * 2) = f2bf(ap * Wm1);
                    *(LAS bf16_t*)(rw_slot(lds, 11) + t * (RW_LS * 2) + j * 2) = f2bf(bb * iW);
                    *(LAS bf16_t*)(rw_slot(lds, 12) + t * (RW_LS * 2) + j * 2) = f2bf(kp * iW);
                    *(LAS bf16_t*)(rw_slot(lds, 13) + t * (RW_LS * 2) + j * 2) = f2bf(rv[u] * Wt);
                    tAt[uu] = ap * Wm1; tBh[uu] = bb * WLr; tKh[uu] = kp * WLr; }
                pAt[u2] = cvt_pk_bf16(tAt[0], tAt[1]); pBh[u2] = cvt_pk_bf16(tBh[0], tBh[1]); pKh[u2] = cvt_pk_bf16(tKh[0], tKh[1]); pV[u2] = cvt_pk_bf16(vv[2 * u2], vv[2 * u2 + 1]);
                pga[u2] = cvt_pk_bf16(ga2[0], ga2[1]); pgb[u2] = cvt_pk_bf16(gb2[0], gb2[1]); }
            *(LAS u32x4*)(rw_slot(lds, 14) + j * (RW_LS * 2) + t0 * 2) = (u32x4){pAt[0], pAt[1], pAt[2], pAt[3]};
            *(LAS u32x4*)(rw_slot(lds, 6) + j * (RW_LS * 2) + t0 * 2) = (u32x4){pBh[0], pBh[1], pBh[2], pBh[3]};
            *(LAS u32x4*)(rw_slot(lds, 7) + j * (RW_LS * 2) + t0 * 2) = (u32x4){pKh[0], pKh[1], pKh[2], pKh[3]};
            *(LAS u32x4*)(rw_slot(lds, 8) + j * (RW_LS * 2) + t0 * 2) = (u32x4){pV[0], pV[1], pV[2], pV[3]};
            { const int j2 = lane_now(); bf16_t* gap = B.GA + (size_t)item * 4096 + j2 * 64; bf16_t* gbp = B.GB + (size_t)item * 4096 + j2 * 64;
#pragma unroll
              for (int hh = 0; hh < 2; ++hh) { const int pos = (2 * (wave & 1) + hh) * 16 + (wave >> 1) * 4;
                  *(u32x2*)(gap + pos) = (u32x2){pga[2 * hh], pga[2 * hh + 1]}; *(u32x2*)(gbp + pos) = (u32x2){pgb[2 * hh], pgb[2 * hh + 1]}; } }
        }
        __syncthreads();
        }
        if (bc + nh < nbc) RW_ISSUE(bc + nh);
        RW_DBG(10, 0); RW_DBG(11, 1); RW_DBG(12, 2); RW_DBG(13, 3); RW_DBG(14, 4); RW_DBG(6, 5); RW_DBG(7, 6); RW_DBG(8, 7);
        RW_REP(3) {
        {   const int nt = wave & 3, mta = wave >> 2, mtb = mta + 2; const f32x4 z4 = {0.f, 0.f, 0.f, 0.f};
            const int da = 16 * (mta - nt) + 4 * q - n, db = 16 * (mtb - nt) + 4 * q - n;
#define RW_MASK(acc_, d_, MODE) do { _Pragma("unroll") for (int r = 0; r < 4; ++r) { const bool keep = (MODE == 0) ? ((d_) + r > 0) : ((MODE == 1) ? ((d_) + r < 0) : ((d_) + r <= 0)); acc_[r] = keep ? acc_[r] : 0.f; } } while (0)
            {   const RwF2 a10a = rw_ld2(rw_slot(lds, 10), 16 * mta + l15, kq), a10b = rw_ld2(rw_slot(lds, 10), 16 * mtb + l15, kq), b11 = rw_ld2(rw_slot(lds, 11), 16 * nt + l15, kq);
                const RwF2 a12a = rw_ld2(rw_slot(lds, 12), 16 * mta + l15, kq), a12b = rw_ld2(rw_slot(lds, 12), 16 * mtb + l15, kq), b10 = rw_ld2(rw_slot(lds, 10), 16 * nt + l15, kq);
                RW_LOADED();
                f32x4 c0 = rw_mmf(a10a, b11, z4), c1 = rw_mmf(a10b, b11, z4), c2 = rw_mmf(a12a, b10, z4), c3 = rw_mmf(a12b, b10, z4);
                RW_MASK(c0, da, 0); RW_MASK(c1, db, 0); RW_MASK(c2, da, 1); RW_MASK(c3, db, 1);
                rw_store_T(rw_slot(lds, 0), mta, nt, q, n, c0); rw_store_T(rw_slot(lds, 0), mtb, nt, q, n, c1); rw_store_T(rw_slot(lds, 1), mta, nt, q, n, c2); rw_store_T(rw_slot(lds, 1), mtb, nt, q, n, c3);
                RW_LOADED(); }
            {   const RwF2 a11a = rw_ld2(rw_slot(lds, 11), 16 * mta + l15, kq), a11b = rw_ld2(rw_slot(lds, 11), 16 * mtb + l15, kq), b13 = rw_ld2(rw_slot(lds, 13), 16 * nt + l15, kq);
                const RwF2 a12a = rw_ld2(rw_slot(lds, 12), 16 * mta + l15, kq), a12b = rw_ld2(rw_slot(lds, 12), 16 * mtb + l15, kq);
                RW_LOADED();
                f32x4 c0 = rw_mmf(a11a, b13, z4), c1 = rw_mmf(a11b, b13, z4), c2 = rw_mmf(a12a, b13, z4), c3 = rw_mmf(a12b, b13, z4);
                RW_MASK(c0, da, 2); RW_MASK(c1, db, 2); RW_MASK(c2, da, 2); RW_MASK(c3, db, 2);
                rw_store_T(rw_slot(lds, 2), mta, nt, q, n, c0); rw_store_T(rw_slot(lds, 2), mtb, nt, q, n, c1); rw_store_T(rw_slot(lds, 3), mta, nt, q, n, c2); rw_store_T(rw_slot(lds, 3), mtb, nt, q, n, c3);
                RW_LOADED(); } }
        for (int i = wave * 64 + lane_now(); i < 2 * RW_SLOT / 16; i += NTHR) *(LAS u32x4*)(rw_slot(lds, 4) + i * 16) = (u32x4){0u, 0u, 0u, 0u};
        __syncthreads();
        }
        RW_DBG(0, 8); RW_DBG(1, 9); RW_DBG(2, 10); RW_DBG(3, 11);
#ifdef DBG_RWKV
        rw_dbg_max(lds, DBG_MAXSLOT_A, B.dbg + 1, tid);
#endif
        RW_REP(4) {
        if (wave >= 4) {
            {   const int nt = wave & 3; const f32x4 z4 = {0.f, 0.f, 0.f, 0.f};
                const RwF2 a0 = rw_ld2(rw_slot(lds, 1), l15, kq), a1 = rw_ld2(rw_slot(lds, 1), 16 + l15, kq), a2 = rw_ld2(rw_slot(lds, 1), 32 + l15, kq), a3 = rw_ld2(rw_slot(lds, 1), 48 + l15, kq), b8 = rw_ld2(rw_slot(lds, 8), 16 * nt + l15, kq);
                RW_LOADED();
                const f32x4 c0 = rw_mmf(a0, b8, z4), c1 = rw_mmf(a1, b8, z4), c2 = rw_mmf(a2, b8, z4), c3 = rw_mmf(a3, b8, z4);
                rw_store_T(rw_slot(lds, 12), 0, nt, q, n, c0); rw_store_T(rw_slot(lds, 12), 1, nt, q, n, c1); rw_store_T(rw_slot(lds, 12), 2, nt, q, n, c2); rw_store_T(rw_slot(lds, 12), 3, nt, q, n, c3); } }
        if (wave < 4 && lane_now() < 16) { const int i0 = 16 * wave, cc = lane_now(); float Tc[16];
            const LAS unsigned char* AT = rw_slot(lds, 0);
#pragma unroll
            for (int t = 0; t < 16; ++t) { float s = (t == cc) ? 1.f : 0.f;
#pragma unroll
                for (int s2 = 0; s2 < t; ++s2) s += rw_ld1(AT, i0 + s2, i0 + t) * Tc[s2];
                Tc[t] = s; }
#pragma unroll
            for (int t = 0; t < 16; ++t) *(LAS bf16_t*)(rw_slot(lds, 4) + (i0 + t) * (RW_LS * 2) + (i0 + cc) * 2) = f2bf(Tc[t]);
            u32x4 o0, o1; o0.x = cvt_pk_bf16(Tc[0], Tc[1]); o0.y = cvt_pk_bf16(Tc[2], Tc[3]); o0.z = cvt_pk_bf16(Tc[4], Tc[5]); o0.w = cvt_pk_bf16(Tc[6], Tc[7]);
            o1.x = cvt_pk_bf16(Tc[8], Tc[9]); o1.y = cvt_pk_bf16(Tc[10], Tc[11]); o1.z = cvt_pk_bf16(Tc[12], Tc[13]); o1.w = cvt_pk_bf16(Tc[14], Tc[15]);
            *(LAS u32x4*)(rw_slot(lds, 5) + (i0 + cc) * (RW_LS * 2) + i0 * 2) = o0; *(LAS u32x4*)(rw_slot(lds, 5) + (i0 + cc) * (RW_LS * 2) + (i0 + 8) * 2) = o1;
        }
#if RW_DUPS
        __syncthreads();
#endif
        }
        if (wave < 4 && lane_now() < 16) { const int i0 = 16 * wave, cc = lane_now();
            LDS_WAIT();
            *(LAS u32x4*)(rw_slot(lds, 0) + (i0 + cc) * (RW_LS * 2) + i0 * 2) = (u32x4){0u, 0u, 0u, 0u}; *(LAS u32x4*)(rw_slot(lds, 0) + (i0 + cc) * (RW_LS * 2) + (i0 + 8) * 2) = (u32x4){0u, 0u, 0u, 0u};
        }
        __syncthreads();
        RW_DBG(4, 12); RW_DBG(5, 13);
#ifdef DBG_RWKV
        rw_dbg_max(lds, 4, B.dbg + 2, tid);
#endif
        RW_REP(5) {
        {   const int nt = wave & 3, mta = wave >> 2, mtb = mta + 2; const f32x4 z4 = {0.f, 0.f, 0.f, 0.f};
            const RwF2 a4a = rw_ld2(rw_slot(lds, 4), 16 * mta + l15, kq), a4b = rw_ld2(rw_slot(lds, 4), 16 * mtb + l15, kq), b0 = rw_ld2(rw_slot(lds, 0), 16 * nt + l15, kq);
            RW_LOADED();
            const f32x4 c0 = rw_mmf(a4a, b0, z4), c1 = rw_mmf(a4b, b0, z4);
            rw_store_T(rw_slot(lds, 11), mta, nt, q, n, c0); rw_store_D(rw_slot(lds, 9), mta, nt, q, n, c0); rw_store_T(rw_slot(lds, 11), mtb, nt, q, n, c1); rw_store_D(rw_slot(lds, 9), mtb, nt, q, n, c1); }
        __syncthreads();
        }
        RW_DBG(9, 14); RW_DBG(11, 15);
#ifdef DBG_RWKV
        rw_dbg_max(lds, 11, B.dbg + 3, tid);
#endif
        RW_REP(6) {
        {   const int nt = wave & 3, mta = wave >> 2, mtb = mta + 2; const f32x4 z4 = {0.f, 0.f, 0.f, 0.f};
            const RwF2 a11a = rw_ld2(rw_slot(lds, 11), 16 * mta + l15, kq), a11b = rw_ld2(rw_slot(lds, 11), 16 * mtb + l15, kq), b9 = rw_ld2(rw_slot(lds, 9), 16 * nt + l15, kq);
            const RwF2 a9a = rw_ld2(rw_slot(lds, 9), 16 * mta + l15, kq), a9b = rw_ld2(rw_slot(lds, 9), 16 * mtb + l15, kq), b5 = rw_ld2(rw_slot(lds, 5), 16 * nt + l15, kq);
            const u32x2 dga = *(const LAS u32x2*)(rw_slot(lds, 5) + (16 * nt + n) * (RW_LS * 2) + (16 * mta + 4 * q) * 2), dgb = *(const LAS u32x2*)(rw_slot(lds, 5) + (16 * nt + n) * (RW_LS * 2) + (16 * mtb + 4 * q) * 2);
            RW_LOADED();
            const f32x4 c0 = rw_mmf(a11a, b9, z4), c1 = rw_mmf(a11b, b9, z4);
            const f32x4 c2 = rw_mmf(a9a, b5, (f32x4){bflo(dga.x), bfhi(dga.x), bflo(dga.y), bfhi(dga.y)}), c3 = rw_mmf(a9b, b5, (f32x4){bflo(dgb.x), bfhi(dgb.x), bflo(dgb.y), bfhi(dgb.y)});
            rw_store_T(rw_slot(lds, 10), mta, nt, q, n, c0); rw_store_T(rw_slot(lds, 10), mtb, nt, q, n, c1);
            RW_LOADED();
            rw_store_T(rw_slot(lds, 0), mta, nt, q, n, c2); rw_store_T(rw_slot(lds, 0), mtb, nt, q, n, c3); }
        __syncthreads();
        }
        RW_DBG(10, 16); RW_DBG(0, 17);
        RW_REP(7) {
        {   const int nt = wave & 3, mta = wave >> 2, mtb = mta + 2;
            const RwF2 a0a = rw_ld2(rw_slot(lds, 0), 16 * mta + l15, kq), a0b = rw_ld2(rw_slot(lds, 0), 16 * mtb + l15, kq), b10 = rw_ld2(rw_slot(lds, 10), 16 * nt + l15, kq);
            f32x4 za, zb;
#pragma unroll
            for (int r = 0; r < 4; ++r) { za[r] = rw_ld1(rw_slot(lds, 0), 16 * mta + 4 * q + r, 16 * nt + n); zb[r] = rw_ld1(rw_slot(lds, 0), 16 * mtb + 4 * q + r, 16 * nt + n); }
            RW_LOADED();
            const f32x4 c0 = rw_mmf(a0a, b10, za), c1 = rw_mmf(a0b, b10, zb);
            rw_store_T(rw_slot(lds, 4), mta, nt, q, n, c0); rw_store_T(rw_slot(lds, 4), mtb, nt, q, n, c1); }
        __syncthreads();
        }
        RW_DBG(4, 18);
        RW_REP(8) {
        {   const int nt = wave & 3, mta = wave >> 2, mtb = mta + 2; const f32x4 z4 = {0.f, 0.f, 0.f, 0.f};
            const RwF2 a4a = rw_ld2(rw_slot(lds, 4), 16 * mta + l15, kq), a4b = rw_ld2(rw_slot(lds, 4), 16 * mtb + l15, kq), b14 = rw_ld2(rw_slot(lds, 14), 16 * nt + l15, kq), b12 = rw_ld2(rw_slot(lds, 12), 16 * nt + l15, kq);
            RW_LOADED();
            const f32x4 c0 = rw_mmf(a4a, b14, z4), c1 = rw_mmf(a4b, b14, z4), c2 = rw_mmf(a4a, b12, z4), c3 = rw_mmf(a4b, b12, z4);
            rw_store_T(rw_slot(lds, 5), mta, nt, q, n, c0); rw_store_T(rw_slot(lds, 5), mtb, nt, q, n, c1); rw_store_T(rw_slot(lds, 11), mta, nt, q, n, c2); rw_store_T(rw_slot(lds, 11), mtb, nt, q, n, c3); }
        __syncthreads();
        }
        RW_DBG(5, 19); RW_DBG(11, 21);
        RW_REP(10) {
        {   const int nt = wave & 3, mta = wave >> 2, mtb = mta + 2; const f32x4 z4 = {0.f, 0.f, 0.f, 0.f};
#define RW_PK(c_) ((u32x2){cvt_pk_bf16(c_[0], c_[1]), cvt_pk_bf16(c_[2], c_[3])})
            {
                const RwF2 a5a = rw_ld2(rw_slot(lds, 5), 16 * mta + l15, kq), a5b = rw_ld2(rw_slot(lds, 5), 16 * mtb + l15, kq), b6 = rw_ld2(rw_slot(lds, 6), 16 * nt + l15, kq), b2 = rw_ld2(rw_slot(lds, 2), 16 * nt + l15, kq);
                const u32x2 rta = *(const LAS u32x2*)(rw_slot(lds, 13) + (16 * nt + n) * (RW_LS * 2) + (16 * mta + 4 * q) * 2), rtb = *(const LAS u32x2*)(rw_slot(lds, 13) + (16 * nt + n) * (RW_LS * 2) + (16 * mtb + 4 * q) * 2);
                RW_LOADED();
                const f32x4 c0 = rw_mmf(a5a, b6, z4), c1 = rw_mmf(a5b, b6, z4);
                const f32x4 c2 = rw_mmf(a5a, b2, (f32x4){bflo(rta.x), bfhi(rta.x), bflo(rta.y), bfhi(rta.y)}), c3 = rw_mmf(a5b, b2, (f32x4){bflo(rtb.x), bfhi(rtb.x), bflo(rtb.y), bfhi(rtb.y)});
                *(u32x2*)(B.Pp + (size_t)item * 4096 + (size_t)((nt * 2 + (mta >> 1)) * 64 + n + 16 * q) * 8 + 4 * (mta & 1)) = RW_PK(c0);
                *(u32x2*)(B.Pp + (size_t)item * 4096 + (size_t)((nt * 2 + (mtb >> 1)) * 64 + n + 16 * q) * 8 + 4 * (mtb & 1)) = RW_PK(c1);
                *(u32x2*)(B.Rp + (size_t)item * 4096 + (size_t)((nt * 2 + (mta >> 1)) * 64 + n + 16 * q) * 8 + 4 * (mta & 1)) = RW_PK(c2);
                *(u32x2*)(B.Rp + (size_t)item * 4096 + (size_t)((nt * 2 + (mtb >> 1)) * 64 + n + 16 * q) * 8 + 4 * (mtb & 1)) = RW_PK(c3);
                RW_LOADED(); }
            {
                const RwF2 b11 = rw_ld2(rw_slot(lds, 11), 16 * nt + l15, kq), b8 = rw_ld2(rw_slot(lds, 8), 16 * nt + l15, kq);
                const RwF2 a6a = rw_ld2(rw_slot(lds, 6), 16 * mta + l15, kq), a6b = rw_ld2(rw_slot(lds, 6), 16 * mtb + l15, kq), a7a = rw_ld2(rw_slot(lds, 7), 16 * mta + l15, kq), a7b = rw_ld2(rw_slot(lds, 7), 16 * mtb + l15, kq);
                RW_LOADED();
                f32x4 c0 = rw_mmf(a6a, b11, z4), c1 = rw_mmf(a6b, b11, z4); c0 = rw_mmf(a7a, b8, c0); c1 = rw_mmf(a7b, b8, c1);
                *(u32x2*)(B.Qp + (size_t)item * 4096 + (size_t)((nt * 4 + mta) * 64 + lane_now()) * 4) = RW_PK(c0);
                *(u32x2*)(B.Qp + (size_t)item * 4096 + (size_t)((nt * 4 + mtb) * 64 + lane_now()) * 4) = RW_PK(c1);
                RW_LOADED();
                const RwF2 a2a = rw_ld2(rw_slot(lds, 2), 16 * mta + l15, kq), a2b = rw_ld2(rw_slot(lds, 2), 16 * mtb + l15, kq), a3a = rw_ld2(rw_slot(lds, 3), 16 * mta + l15, kq), a3b = rw_ld2(rw_slot(lds, 3), 16 * mtb + l15, kq);
                RW_LOADED();
                f32x4 c2 = rw_mmf(a2a, b11, z4), c3 = rw_mmf(a2b, b11, z4); c2 = rw_mmf(a3a, b8, c2); c3 = rw_mmf(a3b, b8, c3);
                *(u32x2*)(B.CAT + (row0 + 16 * nt + n) * D + h * 64 + q * 16 + mta * 4) = RW_PK(c2);
                *(u32x2*)(B.CAT + (row0 + 16 * nt + n) * D + h * 64 + q * 16 + mtb * 4) = RW_PK(c3); }
        }
#if RW_DUPS
        __syncthreads();
#endif
        }
    }
}

constexpr int R2_SLOT = 2 * 8192 + 256, R2_LA = 7;
#define R2_WAITV(n) asm volatile("s_waitcnt vmcnt(" #n ")" ::: "memory")
struct R2Own { u32x2 qv[4]; u32x4 y0, y1; };
__device__ __forceinline__ void rwkv_r2(LAS unsigned char* lds, const RwBufs& B, int bx, int G, int wave, int nbh, bool dry = false) {
    const int lane = lane_now(), q = lane >> 4, n = lane & 15, wv = wave & 3;
#pragma unroll 1
    for (int bh = bx; bh < nbh; bh += G) {
        const int b = bh / RH, h = bh % RH;
        __syncthreads();
#define R2_ISSUE(c_) do { const int cc_ = (c_); const size_t item_ = (size_t)(b * 64 + cc_) * RH + h; LAS unsigned char* sl_ = lds + (cc_ & 7) * R2_SLOT; \
            const bf16_t* src_ = (wv < 2 ? B.Pp : B.Rp) + item_ * 4096 + (size_t)(wv & 1) * 2048 + lane_now() * 8; \
            _Pragma("unroll") for (int f = 0; f < 4; ++f) __builtin_amdgcn_global_load_lds((const unsigned*)(src_ + f * 512), (LAS unsigned*)(sl_ + (wv >> 1) * 8192 + (wv & 1) * 4096 + f * 1024), 16, 0, 0); \
            if (wv == 3 && lane_now() < 16) __builtin_amdgcn_global_load_lds((const unsigned*)(B.WL + item_ * 64 + lane_now() * 4), (LAS unsigned*)(sl_ + 2 * 8192), 16, 0, 0); } while (0)
#define R2_LANDED(c1_) do { const int af_ = (((c1_) + R2_LA - 1 < 63) ? ((c1_) + R2_LA - 1) : 63) - (c1_); \
            if (wv < 3) { if (af_ >= 6) R2_WAITV(24); else if (af_ == 5) R2_WAITV(20); else if (af_ == 4) R2_WAITV(16); else if (af_ == 3) R2_WAITV(12); else if (af_ == 2) R2_WAITV(8); else if (af_ == 1) R2_WAITV(4); else R2_WAITV(0); } \
            else        { if (af_ >= 6) R2_WAITV(30); else if (af_ == 5) R2_WAITV(25); else if (af_ == 4) R2_WAITV(20); else if (af_ == 3) R2_WAITV(15); else if (af_ == 2) R2_WAITV(10); else if (af_ == 1) R2_WAITV(5); else R2_WAITV(0); } } while (0)
#define R2_OWN(O_, c_) do { const int cc_ = (c_); const size_t item_ = (size_t)(b * 64 + cc_) * RH + h; const size_t rw0_ = (size_t)b * SEQ + cc_ * 64; \
            _Pragma("unroll") for (int mt = 0; mt < 4; ++mt) O_.qv[mt] = *(const u32x2*)(B.Qp + item_ * 4096 + (size_t)((wv * 4 + mt) * 64 + lane) * 4); \
            const bf16_t* yp_ = B.CAT + (rw0_ + 16 * wv + n) * D + h * 64 + q * 16; O_.y0 = *(const u32x4*)yp_; O_.y1 = *(const u32x4*)(yp_ + 8); } while (0)
        f32x4 S[4];
#pragma unroll
        for (int mt = 0; mt < 4; ++mt) S[mt] = (f32x4){0.f, 0.f, 0.f, 0.f};
        R2Own Oa, Ob, Oc, Od;
        if (wave >= 4) { R2_ISSUE(0); R2_ISSUE(1); R2_ISSUE(2); R2_ISSUE(3); R2_ISSUE(4); R2_ISSUE(5); R2_ISSUE(6); R2_LANDED(0); }
        else { R2_OWN(Oa, 0); R2_OWN(Ob, 1); R2_OWN(Oc, 2); R2_OWN(Od, 3); }
        __syncthreads();
#define R2_STEP(O_, c_) do { const int c = (c_); \
            if (wave >= 4) { if (c + R2_LA < 64) R2_ISSUE(c + R2_LA); if (c + 1 < 64) R2_LANDED(c + 1); } \
            else { \
                const size_t row0 = (size_t)b * SEQ + c * 64; const LAS unsigned char* sl = lds + (c & 7) * R2_SLOT; \
                bf16x8 pf[8], rf[8]; \
                _Pragma("unroll") for (int f = 0; f < 8; ++f) { pf[f] = *(const LAS bf16x8*)(sl + f * 1024 + lane * 16); rf[f] = *(const LAS bf16x8*)(sl + 8192 + f * 1024 + lane * 16); } \
                f32x4 wl[4]; \
                _Pragma("unroll") for (int mt = 0; mt < 4; ++mt) wl[mt] = *(const LAS f32x4*)(sl + 2 * 8192 + (16 * mt + 4 * q) * 4); \
                bf16_t* yp = B.CAT + (row0 + 16 * wv + n) * D + h * 64 + q * 16; \
                  \
                bf16x8 sh[2], sl2[2]; \
                _Pragma("unroll") for (int ks = 0; ks < 2; ++ks) { unsigned hw[4], lw[4]; \
                    _Pragma("unroll") for (int hf = 0; hf < 2; ++hf) { const f32x4 s = S[2 * ks + hf]; \
                        const unsigned h01 = cvt_pk_bf16(s[0], s[1]), h23 = cvt_pk_bf16(s[2], s[3]); \
                        hw[2 * hf] = h01; hw[2 * hf + 1] = h23; \
                        lw[2 * hf] = cvt_pk_bf16(s[0] - bflo(h01), s[1] - bfhi(h01)); lw[2 * hf + 1] = cvt_pk_bf16(s[2] - bflo(h23), s[3] - bfhi(h23)); } \
                    u32x4 hv = {hw[0], hw[1], hw[2], hw[3]}, lv = {lw[0], lw[1], lw[2], lw[3]}; \
                    sh[ks] = __builtin_bit_cast(bf16x8, hv); sl2[ks] = __builtin_bit_cast(bf16x8, lv); } \
                  \
                f32x4 ya[4]; \
                { const unsigned yw[8] = {O_.y0.x, O_.y0.y, O_.y0.z, O_.y0.w, O_.y1.x, O_.y1.y, O_.y1.z, O_.y1.w}; \
                  _Pragma("unroll") for (int mt = 0; mt < 4; ++mt) ya[mt] = (f32x4){bflo(yw[2 * mt]), bfhi(yw[2 * mt]), bflo(yw[2 * mt + 1]), bfhi(yw[2 * mt + 1])}; } \
                _Pragma("unroll") for (int mt = 0; mt < 4; ++mt) _Pragma("unroll") for (int ks = 0; ks < 2; ++ks) { \
                    ya[mt] = __builtin_amdgcn_mfma_f32_16x16x32_bf16(rf[mt * 2 + ks], sh[ks], ya[mt], 0, 0, 0); ya[mt] = __builtin_amdgcn_mfma_f32_16x16x32_bf16(rf[mt * 2 + ks], sl2[ks], ya[mt], 0, 0, 0); } \
                { u32x4 o0, o1; o0.x = cvt_pk_bf16(ya[0][0], ya[0][1]); o0.y = cvt_pk_bf16(ya[0][2], ya[0][3]); o0.z = cvt_pk_bf16(ya[1][0], ya[1][1]); o0.w = cvt_pk_bf16(ya[1][2], ya[1][3]); \
                  o1.x = cvt_pk_bf16(ya[2][0], ya[2][1]); o1.y = cvt_pk_bf16(ya[2][2], ya[2][3]); o1.z = cvt_pk_bf16(ya[3][0], ya[3][1]); o1.w = cvt_pk_bf16(ya[3][2], ya[3][3]); \
                  if (!dry) { *(u32x4*)yp = o0; *(u32x4*)(yp + 8) = o1; } } \
                  \
                f32x4 sn[4]; \
                _Pragma("unroll") for (int mt = 0; mt < 4; ++mt) { sn[mt] = (f32x4){bflo(O_.qv[mt].x), bfhi(O_.qv[mt].x), bflo(O_.qv[mt].y), bfhi(O_.qv[mt].y)} + wl[mt] * S[mt]; } \
                _Pragma("unroll") for (int mt = 0; mt < 4; ++mt) _Pragma("unroll") for (int ks = 0; ks < 2; ++ks) { \
                    sn[mt] = __builtin_amdgcn_mfma_f32_16x16x32_bf16(pf[mt * 2 + ks], sh[ks], sn[mt], 0, 0, 0); sn[mt] = __builtin_amdgcn_mfma_f32_16x16x32_bf16(pf[mt * 2 + ks], sl2[ks], sn[mt], 0, 0, 0); } \
                _Pragma("unroll") for (int mt = 0; mt < 4; ++mt) S[mt] = sn[mt]; \
                if (c + 4 < 64) R2_OWN(O_, c + 4);        \
            } \
            __syncthreads(); } while (0)
#pragma unroll 1
        for (int c0 = 0; c0 < 64; c0 += 4) { R2_STEP(Oa, c0); R2_STEP(Ob, c0 + 1); R2_STEP(Oc, c0 + 2); R2_STEP(Od, c0 + 3); }
    }
}

__device__ __forceinline__ void rwkv_r3(const RwBufs& B, int gw, int NGW, int nitems) {
    const int lane = lane_now(), q = lane >> 4, n = lane & 15;
#pragma unroll 1
    for (int item = gw; item < nitems; item += NGW) {
        const int b = item / (64 * RH), c = (item / RH) & 63, h = item % RH; const size_t row0 = (size_t)b * SEQ + c * 64;
        unsigned yw[4][8];
        u32x4 ga[4][2], gb[4][2];
#pragma unroll
        for (int wv = 0; wv < 4; ++wv) { const bf16_t* yp = B.CAT + (row0 + 16 * wv + n) * D + h * 64 + q * 16; const u32x4 y0 = *(const u32x4*)yp, y1 = *(const u32x4*)(yp + 8);
            yw[wv][0] = y0.x; yw[wv][1] = y0.y; yw[wv][2] = y0.z; yw[wv][3] = y0.w; yw[wv][4] = y1.x; yw[wv][5] = y1.y; yw[wv][6] = y1.z; yw[wv][7] = y1.w;
#pragma unroll
            for (int hf = 0; hf < 2; ++hf) { const size_t go = (size_t)item * 4096 + (size_t)(16 * wv + n) * 64 + q * 16 + 8 * hf; ga[wv][hf] = *(const u32x4*)(B.GA + go); gb[wv][hf] = *(const u32x4*)(B.GB + go); } }
        asm volatile("s_waitcnt vmcnt(0)" ::: "memory");
#pragma unroll
        for (int hf = 0; hf < 2; ++hf) {
            float s1[8], s2[8];
#pragma unroll
            for (int e4 = 0; e4 < 8; ++e4) { s1[e4] = 0.f; s2[e4] = 0.f; }
#pragma unroll
            for (int wv = 0; wv < 4; ++wv)
#pragma unroll
                for (int e2 = 0; e2 < 4; ++e2) { const unsigned w = yw[wv][4 * hf + e2]; const float ylo = bflo(w), yhi = bfhi(w); s1[2 * e2] += ylo; s2[2 * e2] += ylo * ylo; s1[2 * e2 + 1] += yhi; s2[2 * e2 + 1] += yhi * yhi; }
#pragma unroll
            for (int e4 = 0; e4 < 8; ++e4) {
                const float t1 = row_sum16(s1[e4]), t2 = row_sum16(s2[e4]);
                const float mean = t1 * (1.f / 64.f), var = fmaxf(t2 * (1.f / 64.f) - mean * mean, 0.f); s1[e4] = mean; s2[e4] = __builtin_amdgcn_rsqf(var + LNX_EPS); }
#pragma unroll
            for (int wv = 0; wv < 4; ++wv) { const u32x4 a0 = ga[wv][hf], b0 = gb[wv][hf];
                const unsigned aw[4] = {a0.x, a0.y, a0.z, a0.w}, bw[4] = {b0.x, b0.y, b0.z, b0.w};
#pragma unroll
                for (int e4 = 0; e4 < 8; ++e4) { const int e = 8 * hf + e4; const unsigned ywd = yw[wv][e >> 1];
                    const float yv = (e & 1) ? bfhi(ywd) : bflo(ywd), gaf = (e & 1) ? bfhi(aw[e4 >> 1]) : bflo(aw[e4 >> 1]), gbf = (e & 1) ? bfhi(bw[e4 >> 1]) : bflo(bw[e4 >> 1]);
                    const float o = (yv - s1[e4]) * s2[e4] * gaf + gbf; const int t = 16 * (e >> 2) + 4 * q + (e & 3);
                    B.CAT[(row0 + t) * D + h * 64 + 16 * wv + n] = f2bf(o); } }
        }
    }
}

constexpr int S5_TAB_EL = 128 * 256 + 256 * 384;
constexpr int S5_US = 264, S5_ZS = 65, S5_XS = 136;
typedef short bf16x4s __attribute__((ext_vector_type(4)));

__device__ __forceinline__ void s5_tables(const Args& a, LAS unsigned char* lds, bf16_t* TAB, float* A16T, int g, int part, int tid) {
    constexpr int CST = 68;
    LAS float* pwr = (LAS float*)lds; LAS float* pwi = pwr + 17 * 64;
    LAS float* bbr = pwi + 17 * 64; LAS float* bbi = bbr + 64 * 16;
    LAS float* crs = bbi + 64 * 16; LAS float* cis = crs + 16 * CST;
    LAS float* Kt = cis + 16 * CST;
    LAS float* zrs = Kt + 4096; LAS float* zis = zrs + 64;
    __syncthreads();
    {   const float dt = expf(a.in[I_LOG_DT][g]);
        for (int idx = tid; idx < 25 * 64; idx += NTHR) { const int t = idx >> 6, p = idx & 63; const float lr = a.in[I_LAM_RE][g * S5P + p], li = a.in[I_LAM_IM][g * S5P + p];
            const float tt = (t <= 16) ? (float)t : 16.0f * (float)(t - 16), m = expf(lr * dt * tt); float sn, cs; sincosf(li * dt * tt, &sn, &cs); const float vr = m * cs, vi = m * sn;
            if (t <= 16) { pwr[t * 64 + p] = vr; pwi[t * 64 + p] = vi; } else if (part == 0) { A16T[(g * 8 + (t - 17)) * 128 + p] = vr; A16T[(g * 8 + (t - 17)) * 128 + 64 + p] = vi; } }
        if (tid < 64) { const int p = tid; const float lr = a.in[I_LAM_RE][g * S5P + p], li = a.in[I_LAM_IM][g * S5P + p];
            float sn, cs, sh, ch; sincosf(li * dt, &sn, &cs); sincosf(0.5f * li * dt, &sh, &ch); const float em1 = expm1f(lr * dt);
            const float nre = em1 * cs - 2.0f * sh * sh, nim = (em1 + 1.0f) * sn, den = lr * lr + li * li;
            zrs[p] = (nre * lr + nim * li) / den; zis[p] = (nim * lr - nre * li) / den; } }
    for (int i = tid; i < 1024; i += NTHR) { crs[(i >> 6) * CST + (i & 63)] = a.in[I_C_RE][(size_t)g * 1024 + i]; cis[(i >> 6) * CST + (i & 63)] = a.in[I_C_IM][(size_t)g * 1024 + i]; }
    __syncthreads();
    for (int i = tid; i < 1024; i += NTHR) { const int p = i >> 4; const float zr = zrs[p], zi = zis[p], br = a.in[I_B_RE][(size_t)g * S5P * 16 + i], bi = a.in[I_B_IM][(size_t)g * S5P * 16 + i];
        bbr[i] = zr * br - zi * bi; bbi[i] = zr * bi + zi * br; }
    __syncthreads();
    for (int w = tid; w < (4 * part + 4) * 64; w += NTHR) { const int t = w >> 6, j = (w >> 2) & 15, jq = w & 3; f32x4 s4 = {0.f, 0.f, 0.f, 0.f};
#pragma unroll 2
        for (int p4 = 0; p4 < 64; p4 += 4) { const f32x4 cr = *(const LAS f32x4*)(crs + j * CST + p4), ci = *(const LAS f32x4*)(cis + j * CST + p4), ar = *(const LAS f32x4*)(pwr + t * 64 + p4), ai = *(const LAS f32x4*)(pwi + t * 64 + p4);
#pragma unroll
            for (int e = 0; e < 4; ++e) { const float wr = cr[e] * ar[e] - ci[e] * ai[e], wi = cr[e] * ai[e] + ci[e] * ar[e];
                const f32x4 br = *(const LAS f32x4*)(bbr + (p4 + e) * 16 + 4 * jq), bi = *(const LAS f32x4*)(bbi + (p4 + e) * 16 + 4 * jq);
                s4 += wr * br - wi * bi; } }
        if (t == 0 && (j >> 2) == jq) s4[j & 3] += a.in[I_S5D][g * 16 + j];
        *(LAS f32x4*)(Kt + (t << 8) + (j << 4) + 4 * jq) = s4; }
    __syncthreads();
    bf16_t* Gt = TAB + (size_t)g * S5_TAB_EL; bf16_t* MH = Gt + 128 * 256;
    for (int idx = part * 32 * 256 + tid; idx < (part + 1) * 32 * 256; idx += NTHR) { const int pp = idx >> 8, k = idx & 255, s = k >> 4, jp = k & 15, p = pp & 63, t = 15 - s;
        const float ar = pwr[t * 64 + p], ai = pwi[t * 64 + p], br = bbr[p * 16 + jp], bi = bbi[p * 16 + jp];
        Gt[idx] = f2bf(pp < 64 ? (ar * br - ai * bi) : (ar * bi + ai * br)); }
    for (int rr = 0; rr < 64; ++rr) { const int row = part * 64 + rr, t = row >> 4, j = row & 15;
        if (tid < 384) { const int k = tid; float v;
            if (k < 256) { const int s = k >> 4, jp = k & 15; v = (s <= t) ? Kt[((t - s) << 8) + (j << 4) + jp] : 0.f; }
            else { const int pp = k - 256, p = pp & 63; const float cr = crs[j * CST + p], ci = cis[j * CST + p], ar = pwr[(t + 1) * 64 + p], ai = pwi[(t + 1) * 64 + p];
                v = pp < 64 ? (cr * ar - ci * ai) : -(cr * ai + ci * ar); }
            MH[(size_t)row * 384 + k] = f2bf(v); } }
}

__device__ __forceinline__ float gelu_fast_(float x) { const float a2 = 1.5957691216057308f * (x + 0.044715f * x * x * x); return x * __builtin_amdgcn_rcpf(1.0f + __expf(-a2)); }

__device__ __forceinline__ void s5_chunked(const Args& a, LAS unsigned char* lds, const bf16_t* U, const bf16_t* TAB, const float* A16T, bf16_t* CAT, int bx, int G, int wave) {
    const int lane = lane_now(), l15 = lane & 15, kq = lane >> 4, q = kq, n = l15, tid = wave * 64 + lane;
    LAS unsigned char* Us0 = lds; LAS float* Zs = (LAS float*)(lds + 64 * S5_US * 2); LAS unsigned char* Xp = lds + 64 * S5_US * 2 + 128 * S5_ZS * 4;
    LAS unsigned char* Us1 = Xp + 64 * S5_XS * 2 + 8 * 128 * 4;
#define S5_UDMA(buf_, nb_) do { const int ln_ = lane_now(); if (ln_ < 32) { const bf16_t* src_ = UT + (size_t)((nb_) * 64 + 8 * wave) * 256 + ln_ * 8; \
        _Pragma("unroll") for (int i = 0; i < 8; ++i) __builtin_amdgcn_global_load_lds((const unsigned*)(src_ + (size_t)i * 256), (LAS unsigned*)((buf_) + (8 * wave + i) * (S5_US * 2)), 16, 0, 0); } } while (0)
#pragma unroll 1
    for (int item = bx; item < NB * S5G; item += G) {
        const int b = item / S5G, g = item % S5G;
        const bf16_t* UT = U + (size_t)(b * S5G + g) * SEQ * 16;
        const bf16_t* Gt = TAB + (size_t)g * S5_TAB_EL; const bf16_t* MH = Gt + 128 * 256;
        bf16x8 ga[8], mh[2][12];
#pragma unroll
        for (int ks = 0; ks < 8; ++ks) ga[ks] = *(const bf16x8*)(Gt + (size_t)(16 * wave + l15) * 256 + 32 * ks + 8 * kq);
        const int tau0 = wave, tau1 = 15 - wave;
#pragma unroll
        for (int ks = 0; ks < 12; ++ks) { mh[0][ks] = *(const bf16x8*)(MH + (size_t)(16 * tau0 + l15) * 384 + 32 * ks + 8 * kq); mh[1][ks] = *(const bf16x8*)(MH + (size_t)(16 * tau1 + l15) * 384 + 32 * ks + 8 * kq); }
        bf16x4s wg; { unsigned short w4[4];
#pragma unroll
            for (int e = 0; e < 4; ++e) w4[e] = f2bf(a.in[I_WGLU][(size_t)(g * 16 + 4 * kq + e) * 16 + l15]);
            wg = (bf16x4s){(short)w4[0], (short)w4[1], (short)w4[2], (short)w4[3]}; }
        const f32x4 bq = *(const f32x4*)(a.in[I_BGLU] + g * 16 + 4 * q);
        float xr = 0.f, xi = 0.f;
        float apr[8], api[8];
#pragma unroll
        for (int k8 = 0; k8 < 8; ++k8) { apr[k8] = A16T[(g * 8 + k8) * 128 + lane]; api[k8] = A16T[(g * 8 + k8) * 128 + 64 + lane]; }
        LAS float* Ex = (LAS float*)(Xp + 64 * S5_XS * 2);
        __syncthreads();
        S5_UDMA(Us0, 0);
#pragma unroll 1
        for (int nb = 0; nb < 4; ++nb) {
            LAS unsigned char* Us = (nb & 1) ? Us1 : Us0;
            asm volatile("s_waitcnt vmcnt(0)" ::: "memory");
            __syncthreads();
            if (nb + 1 < 4) { if (nb & 1) S5_UDMA(Us0, nb + 1); else S5_UDMA(Us1, nb + 1); }
#pragma unroll
            for (int nt = 0; nt < 4; ++nt) { f32x4 acc = {0.f, 0.f, 0.f, 0.f};
#pragma unroll
                for (int ks = 0; ks < 8; ++ks) acc = __builtin_amdgcn_mfma_f32_16x16x32_bf16(ga[ks], *(const LAS bf16x8*)(Us + (16 * nt + l15) * (S5_US * 2) + (32 * ks + 8 * kq) * 2), acc, 0, 0, 0);
#pragma unroll
                for (int r = 0; r < 4; ++r) Zs[(16 * wave + 4 * q + r) * S5_ZS + 16 * nt + n] = acc[r]; }
            __syncthreads();
            {   float lr8[8], li8[8]; float sr = 0.f, si = 0.f;
#pragma unroll
                for (int i = 0; i < 8; ++i) { lr8[i] = sr; li8[i] = si; const int c = 8 * wave + i; const float zr = Zs[lane * S5_ZS + c], zi = Zs[(64 + lane) * S5_ZS + c];
                    const float nr = apr[0] * sr - api[0] * si + zr, ni = apr[0] * si + api[0] * sr + zi; sr = nr; si = ni; }
                Ex[wave * 128 + lane] = sr; Ex[wave * 128 + 64 + lane] = si;
                __syncthreads();
                float cr = xr, ci = xi, myr = xr, myi = xi;
#pragma unroll
                for (int v = 0; v < 8; ++v) { if (v == wave) { myr = cr; myi = ci; }
                    const float er = Ex[v * 128 + lane], ei = Ex[v * 128 + 64 + lane]; const float nr = apr[7] * cr - api[7] * ci + er, ni = apr[7] * ci + api[7] * cr + ei; cr = nr; ci = ni; }
                xr = cr; xi = ci;
#pragma unroll
                for (int i = 0; i < 8; ++i) { float pr = lr8[i], pi = li8[i];
                    if (i == 0) { pr += myr; pi += myi; } else { pr += apr[i - 1] * myr - api[i - 1] * myi; pi += apr[i - 1] * myi + api[i - 1] * myr; }
                    const int c = 8 * wave + i; *(LAS bf16_t*)(Xp + c * (S5_XS * 2) + lane * 2) = f2bf(pr); *(LAS bf16_t*)(Xp + c * (S5_XS * 2) + (64 + lane) * 2) = f2bf(pi); } }
            __syncthreads();
#pragma unroll
            for (int mi = 0; mi < 2; ++mi) { const int tau = mi ? tau1 : tau0, kmax = tau >> 1;
#pragma unroll 1
                for (int nt = 0; nt < 4; ++nt) { f32x4 acc = {0.f, 0.f, 0.f, 0.f};
                    const LAS unsigned char* ub = Us + (16 * nt + l15) * (S5_US * 2) + (8 * kq) * 2; const LAS unsigned char* xb = Xp + (16 * nt + l15) * (S5_XS * 2) + (8 * kq) * 2;
#pragma unroll
                    for (int ks = 0; ks < 8; ++ks) if (ks <= kmax) acc = __builtin_amdgcn_mfma_f32_16x16x32_bf16(mh[mi][ks], *(const LAS bf16x8*)(ub + 64 * ks), acc, 0, 0, 0);
#pragma unroll
                    for (int ks = 0; ks < 4; ++ks) acc = __builtin_amdgcn_mfma_f32_16x16x32_bf16(mh[mi][8 + ks], *(const LAS bf16x8*)(xb + 64 * ks), acc, 0, 0, 0);
                    f32x4 yg; yg[0] = gelu_fast_(acc[0]); yg[1] = gelu_fast_(acc[1]); yg[2] = gelu_fast_(acc[2]); yg[3] = gelu_fast_(acc[3]);
                    const unsigned p01 = cvt_pk_bf16(yg[0], yg[1]), p23 = cvt_pk_bf16(yg[2], yg[3]); const u32x2 pk = {p01, p23};
                    const f32x4 z = __builtin_amdgcn_mfma_f32_16x16x16bf16_1k(wg, __builtin_bit_cast(bf16x4s, pk), bq, 0, 0, 0);
                    const int t = (nb * 64 + 16 * nt + n) * 16 + tau;
                    u32x2 o; o.x = cvt_pk_bf16(yg[0] * sigmoidf_(z[0]), yg[1] * sigmoidf_(z[1])); o.y = cvt_pk_bf16(yg[2] * sigmoidf_(z[2]), yg[3] * sigmoidf_(z[3]));
                    *(u32x2*)(CAT + ((size_t)b * SEQ + t) * D + g * 16 + 4 * q) = o; } }
        }
    }
}

constexpr int AT_KS = 72, AT_VS = 264;
__device__ __forceinline__ void attn_mfma(LAS unsigned char* lds, const bf16_t* Q, const bf16_t* KV, bf16_t* CAT, int bx, int G, int wave) {
    const int lane = lane_now(), l15 = lane & 15, kq = lane >> 4, q = kq, n = l15, tid = wave * 64 + lane;
    LAS unsigned char* Ks = lds; LAS unsigned char* Vt = lds + 256 * AT_KS * 2;
#pragma unroll 1
    for (int item = bx; item < NB * NH_MEM * 16; item += G) {
        const int b = item >> 6, h = (item >> 4) & 3, qb = item & 15;
        __syncthreads();
#pragma unroll
        for (int i = 0; i < 4; ++i) { const int idx = tid + 512 * i, key = idx >> 3, seg = idx & 7;
            const bf16_t* src = KV + (size_t)(b * MEML + key) * 512 + h * 64 + seg * 8;
            *(LAS u32x4*)(Ks + key * (AT_KS * 2) + seg * 16) = *(const u32x4*)src;
            const u32x4 vw = *(const u32x4*)(src + 256); const unsigned vv[4] = {vw.x, vw.y, vw.z, vw.w};
#pragma unroll
            for (int e = 0; e < 4; ++e) { *(LAS bf16_t*)(Vt + (seg * 8 + 2 * e) * (AT_VS * 2) + key * 2) = (bf16_t)(vv[e] & 0xffffu); *(LAS bf16_t*)(Vt + (seg * 8 + 2 * e + 1) * (AT_VS * 2) + key * 2) = (bf16_t)(vv[e] >> 16); } }
        __syncthreads();
#pragma unroll 1
        for (int tile = 0; tile < 2; ++tile) {
            const size_t qrow = (size_t)b * SEQ + qb * 256 + wave * 32 + tile * 16;
            bf16x8 qf[2];
#pragma unroll
            for (int ks = 0; ks < 2; ++ks) qf[ks] = *(const bf16x8*)(Q + (qrow + l15) * CM + h * 64 + 32 * ks + 8 * kq);
            f32x4 s[16];
#pragma unroll
            for (int kt = 0; kt < 16; ++kt) { f32x4 acc = {0.f, 0.f, 0.f, 0.f};
#pragma unroll
                for (int ks = 0; ks < 2; ++ks) acc = __builtin_amdgcn_mfma_f32_16x16x32_bf16(*(const LAS bf16x8*)(Ks + (16 * kt + l15) * (AT_KS * 2) + (32 * ks + 8 * kq) * 2), qf[ks], acc, 0, 0, 0);
                s[kt] = acc; if (kt & 1) asm volatile("" ::: "memory"); }
            float m = -3.0e38f;
#pragma unroll
            for (int kt = 0; kt < 16; ++kt) m = fmaxf(m, fmaxf(fmaxf(s[kt][0], s[kt][1]), fmaxf(s[kt][2], s[kt][3])));
            m = fmaxf(m, __shfl_xor(m, 16)); m = fmaxf(m, __shfl_xor(m, 32));
            float sum = 0.f; const float c = 0.125f * 1.4426950408889634f;
#pragma unroll
            for (int kt = 0; kt < 16; ++kt)
#pragma unroll
                for (int r = 0; r < 4; ++r) { const float p = __builtin_amdgcn_exp2f((s[kt][r] - m) * c); s[kt][r] = p; sum += p; }
            sum += __shfl_xor(sum, 16); sum += __shfl_xor(sum, 32);
            const float inv = 1.0f / sum;
            bf16x8 pf[8];
#pragma unroll
            for (int k2 = 0; k2 < 8; ++k2) { const u32x4 w = {cvt_pk_bf16(s[2 * k2][0], s[2 * k2][1]), cvt_pk_bf16(s[2 * k2][2], s[2 * k2][3]), cvt_pk_bf16(s[2 * k2 + 1][0], s[2 * k2 + 1][1]), cvt_pk_bf16(s[2 * k2 + 1][2], s[2 * k2 + 1][3])};
                pf[k2] = __builtin_bit_cast(bf16x8, w); }
#pragma unroll 1
            for (int dt = 0; dt < 4; ++dt) { f32x4 acc = {0.f, 0.f, 0.f, 0.f};
#pragma unroll
                for (int k2 = 0; k2 < 8; ++k2) { const LAS unsigned char* vp = Vt + (16 * dt + l15) * (AT_VS * 2) + (32 * k2 + 4 * kq) * 2;
                    const u32x2 v0 = *(const LAS u32x2*)vp, v1 = *(const LAS u32x2*)(vp + 32); const u32x4 vw = {v0.x, v0.y, v1.x, v1.y};
                    acc = __builtin_amdgcn_mfma_f32_16x16x32_bf16(__builtin_bit_cast(bf16x8, vw), pf[k2], acc, 0, 0, 0); }
                u32x2 o; o.x = cvt_pk_bf16(acc[0] * inv, acc[1] * inv); o.y = cvt_pk_bf16(acc[2] * inv, acc[3] * inv);
                *(u32x2*)(CAT + (qrow + n) * D + CS + h * 64 + 16 * dt + 4 * q) = o; }
        }
    }
}
constexpr int N_PHASES = 15;

__device__ __forceinline__ TrJob small_job(const Args& a, int j) {
    unsigned char* ws = a.ws; TrJob r;
    switch (j) {
    case 0: r = TrJob{a.in[I_WINA], (bf16_t*)(ws + WS_WINA), a.in[I_NORM_MIX], D, D, 0, 0, 0.f}; break;
    case 1: r = TrJob{a.in[I_WOUT], (bf16_t*)(ws + WS_WOUT0), nullptr, D, D, 0, 0, 0.f}; break;
    case 2: r = TrJob{a.in[I_WOUT] + (size_t)D * D, (bf16_t*)(ws + WS_WOUT1), nullptr, D, D, 0, 0, 0.f}; break;
    case 3: r = TrJob{a.in[I_WKV], (bf16_t*)(ws + WS_WKV), nullptr, D, 512, 0, 0, 0.f}; break;
    case 4: r = TrJob{a.in[I_WKV] + (size_t)D * 512, (bf16_t*)(ws + WS_WKV) + (size_t)512 * D, nullptr, D, 512, 0, 0, 0.f}; break;
    case 5: r = TrJob{a.in[I_FGATE], (bf16_t*)(ws + WS_WGU0), a.in[I_NORM_FFN], D, FD, 1, 0, 0.f}; break;
    case 6: r = TrJob{a.in[I_FUP], (bf16_t*)(ws + WS_WGU0), a.in[I_NORM_FFN], D, FD, 2, 0, 0.f}; break;
    case 7: r = TrJob{a.in[I_FDOWN], (bf16_t*)(ws + WS_WD0), nullptr, FD, D, 0, 0, 0.f}; break;
    case 8: r = TrJob{a.in[I_WINB], (bf16_t*)(ws + WS_WINB), a.in[I_NORM_MIX] + D, D, INB, 0, 0, 0.f}; break;
    case 9: r = TrJob{a.in[I_W2], (bf16_t*)(ws + WS_W2T), nullptr, 64, CS, 0, 0, 0.f}; break;
    case 10: r = TrJob{a.in[I_A2], (bf16_t*)(ws + WS_A2T), nullptr, 64, CS, 0, 0, 0.f}; break;
    default: r = TrJob{a.in[I_G2], (bf16_t*)(ws + WS_G2T), nullptr, 128, CS, 0, 0, 0.f}; break;
    }
    r.items = (r.K / 64) * (r.N / 32); r.f8s = 0.f; return r;
}
__device__ __forceinline__ TrJob moe_job(const Args& a, int j) {
    unsigned char* ws = a.ws; const int kind = j >> 3, e = j & 7; TrJob r;
    if (kind == 0) r = TrJob{a.in[I_MGATE] + (size_t)e * D * FE, (bf16_t*)(ws + WS_WMOE_GU + (size_t)e * 2 * FE * D), a.in[I_NORM_FFN] + D, D, FE, 1, 0, F8_WGU};
    else if (kind == 1) r = TrJob{a.in[I_MUP] + (size_t)e * D * FE, (bf16_t*)(ws + WS_WMOE_GU + (size_t)e * 2 * FE * D), a.in[I_NORM_FFN] + D, D, FE, 2, 0, F8_WGU};
    else r = TrJob{a.in[I_MDOWN] + (size_t)e * FE * D, (bf16_t*)(ws + WS_WMOE_D + (size_t)e * D * FE), nullptr, FE, D, 0, 0, F8_WD};
    r.items = (r.K / 64) * (r.N / 32); return r;
}

__device__ __forceinline__ void moe_convert(const Args& args, LAS float* scr, int cw, int ncw, int lane) {
    constexpr int JI = (D / 64) * (FE / 32), NGI = 24 * JI; static_assert((FE / 64) * (D / 32) == JI, "moe jobs differ in size");
    TrRegs R0, R1; int g0 = cw, g1 = cw + ncw;
    if (g0 < NGI) tr_load(moe_job(args, g0 / JI), g0 % JI, lane, R0);
    if (g1 < NGI) tr_load(moe_job(args, g1 / JI), g1 % JI, lane, R1);
#pragma unroll 1
    for (; g0 < NGI; g0 += 2 * ncw, g1 += 2 * ncw) {
        __builtin_amdgcn_sched_barrier(0);
        tr_fin(moe_job(args, g0 / JI), g0 % JI, scr, lane, R0);
        if (g0 + 2 * ncw < NGI) tr_load(moe_job(args, (g0 + 2 * ncw) / JI), (g0 + 2 * ncw) % JI, lane, R0);
        __builtin_amdgcn_sched_barrier(0);
        if (g1 < NGI) { tr_fin(moe_job(args, g1 / JI), g1 % JI, scr, lane, R1);
            if (g1 + 2 * ncw < NGI) tr_load(moe_job(args, (g1 + 2 * ncw) / JI), (g1 + 2 * ncw) % JI, lane, R1); } }
}

__device__ __forceinline__ void p0_transposes(const Args& args, LAS unsigned char* lds, int wave, int gw, int NGW) {
    unsigned char* ws = args.ws;
    LAS float* scr = (LAS float*)(lds + wave * 16384);
    {
        int base = 0;
        for (int j = 0; j < 12; ++j) { const TrJob jb = small_job(args, j);
            for (int it = gw - base; it < jb.items; it += NGW) { if (it >= 0) tr_item(jb.W, jb.K, jb.N, jb.WT, jb.gain, jb.mode, scr, it, lane_now()); }
            base = (base + jb.items) % NGW; }
    }
}
__device__ __forceinline__ void p0_memn(const Args& args, int gw, int NGW) {
    unsigned char* ws = args.ws;
    for (int r = gw; r < 2 * MROWS; r += NGW) { const int li = r / MROWS, row = r % MROWS;
        const f32x4* xr = (const f32x4*)(args.in[I_MEM] + (size_t)row * D) + lane_now(); const f32x4* gr = (const f32x4*)(args.in[I_NORM_MEM] + li * D) + lane_now();
        f32x4 v[4]; float s = 0.f;
#pragma unroll
        for (int j = 0; j < 4; ++j) { v[j] = xr[64 * j]; s += (v[j][0] * v[j][0] + v[j][1] * v[j][1]) + (v[j][2] * v[j][2] + v[j][3] * v[j][3]); }
        const float rs = rstd_of(wave_sum_fast(s));
        u32x2* o = (u32x2*)((bf16_t*)(ws + WS_MEMN) + ((size_t)li * MROWS + row) * D) + lane_now();
#pragma unroll
        for (int j = 0; j < 4; ++j) { const f32x4 g = gr[64 * j]; u32x2 w; w.x = cvt_pk_bf16(v[j][0] * rs * g[0], v[j][1] * rs * g[1]); w.y = cvt_pk_bf16(v[j][2] * rs * g[2], v[j][3] * rs * g[3]); o[64 * j] = w; }
    }
}
__device__ __forceinline__ void p0_xconv(const Args& args, bf16_t* HA, rss_t* rowss, int gw, int NGW) {
    for (int r = gw; r < T; r += 2 * NGW) {
        const int r2 = r + NGW; const bool has2 = r2 < T;
        const f32x4* xr = (const f32x4*)(args.in[I_X] + (size_t)r * D) + lane_now(); const f32x4* xq = (const f32x4*)(args.in[I_X] + (size_t)(has2 ? r2 : r) * D) + lane_now();
        f32x4 v[4], w[4]; float s = 0.f, s2 = 0.f;
#pragma unroll
        for (int j = 0; j < 4; ++j) { v[j] = xr[64 * j]; w[j] = xq[64 * j]; }
#pragma unroll
        for (int j = 0; j < 4; ++j) { s += (v[j][0] * v[j][0] + v[j][1] * v[j][1]) + (v[j][2] * v[j][2] + v[j][3] * v[j][3]); s2 += (w[j][0] * w[j][0] + w[j][1] * w[j][1]) + (w[j][2] * w[j][2] + w[j][3] * w[j][3]); }
        s = wave_sum_fast(s); s2 = wave_sum_fast(s2);
        if (lane_now() == 0) { rowss[r] = rss_fx(s); if (has2) rowss[r2] = rss_fx(s2); }
        u32x2* o = (u32x2*)(HA + (size_t)r * D) + lane_now(); u32x2* o2 = (u32x2*)(HA + (size_t)r2 * D) + lane_now();
#pragma unroll
        for (int j = 0; j < 4; ++j) { u32x2 p; p.x = cvt_pk_bf16(v[j][0], v[j][1]); p.y = cvt_pk_bf16(v[j][2], v[j][3]); o[64 * j] = p;
            if (has2) { u32x2 p2; p2.x = cvt_pk_bf16(w[j][0], w[j][1]); p2.y = cvt_pk_bf16(w[j][2], w[j][3]); o2[64 * j] = p2; } }
    }
}

template <int LO, int HI> __global__ void __launch_bounds__(NTHR, 2) fwd(Args args) {
    extern __shared__ __attribute__((aligned(16))) unsigned char lds_raw[];
    LAS unsigned char* lds = (LAS unsigned char*)lds_raw;
    volatile LAS unsigned* MISC = (volatile LAS unsigned*)(lds + LDS_MISC);
    const int wave = __builtin_amdgcn_readfirstlane(threadIdx.x >> 6);
#define lane (lane_now())
#define tid (wave * 64 + lane_now())
    const int G = gridDim.x, bx = blockIdx.x;
    const int gw = bx * NWAVES + wave, NGW = G * NWAVES;
    typedef __attribute__((address_space(1))) unsigned char gbyte_t;
    gbyte_t* wsg = (gbyte_t*)args.ws;
#define ws ((unsigned char*)wsg)
    unsigned* ctl = (unsigned*)(ws + WS_CTL);
    rss_t* rowss = (rss_t*)(ws + WS_CTL + CTL_ROWSS);
    float* X = args.out;
    bf16_t* HA = (bf16_t*)(ws + WS_HA);
    const int lo = args.ph_lo, hi = args.ph_hi;
    for (int u = tid; u < (LDS_BYTES - LDS_MISC) / 4; u += NTHR) ((LAS unsigned*)(lds + LDS_MISC))[u] = 0u;
    __syncthreads();
    XcdBarrier bar; bar.bar = ctl + CW_BAR; bar.x = 0; bar.st = nullptr; bar.wave = wave;
    const bool multi = (hi - lo) > 1;
    if (multi) bar = xcd_barrier_post(ctl + CW_BAR, MISC + 8);
#define IN(k) (LO <= (k) && (k) < HI && lo <= (k) && (k) < hi)
#define WS_FENCE() asm volatile("" : "+s"(wsg))
#ifdef TS_PHASE
    int nst = 0; volatile LAS unsigned long long* TSL = (volatile LAS unsigned long long*)(lds + LDS_MISC + 512);
#define STAMP() do { if (bx == 0 && threadIdx.x == 0) TSL[nst] = __builtin_amdgcn_s_memrealtime(); ++nst; } while (0)
#else
#define STAMP() do {} while (0)
#endif
    STAMP();
#ifdef TS_DUP
#define TS_T0() do { if (lane_now() == 0) *(volatile LAS unsigned long long*)(lds + LDS_MISC + 512 + 8 * wave) = __builtin_amdgcn_s_memrealtime(); } while (0)
#define TS_IDLE(k) do { if (((TS_DUP) >> (k)) & 1) { const unsigned long long t1_ = __builtin_amdgcn_s_memrealtime(), t0_ = *(volatile LAS unsigned long long*)(lds + LDS_MISC + 512 + 8 * wave); \
        const unsigned long long tgt_ = t1_ + (t1_ - t0_); while (__builtin_amdgcn_s_memrealtime() < tgt_) __builtin_amdgcn_s_sleep(8); } } while (0)
#else
#define TS_T0() do {} while (0)
#define TS_IDLE(k) do {} while (0)
#endif
    TS_T0();
#define SEAM(k) do { if (IN(k)) TS_IDLE(k); if (IN(k) && IN((k) + 1)) xcd_barrier(bar); TS_T0(); STAMP(); WS_FENCE(); } while (0)

    if (IN(0)) {
        if (bx < 4 * S5G) { s5_tables(args, lds, (bf16_t*)(ws + WS_S5TAB), (float*)(ws + WS_S5TAB + 12 * MiB), bx >> 2, bx & 3, tid); __syncthreads(); }
        p0_transposes(args, lds, wave, gw, NGW);
        p0_memn(args, gw, NGW);
        {
            constexpr int NTAB = 4 * S5G, KSH = 2; const int vw = (G > NTAB) ? NTAB + (G - NTAB) * KSH : G;
            if (G <= NTAB || bx < NTAB) p0_xconv(args, HA, rowss, gw, vw * NWAVES);
            else for (int j = 0; j < KSH; ++j) p0_xconv(args, HA, rowss, (NTAB + (bx - NTAB) * KSH + j) * NWAVES + wave, vw * NWAVES); }
#ifdef DUP_P0
        xcd_barrier(bar);
#if DUP_P0 & 1
        if (bx < 4 * S5G) { s5_tables(args, lds, (bf16_t*)(ws + WS_S5TAB), (float*)(ws + WS_S5TAB + 12 * MiB), bx >> 2, bx & 3, tid); __syncthreads(); }
#endif
#if DUP_P0 & 2
        p0_transposes(args, lds, wave, gw, NGW);
#endif
#if DUP_P0 & 4
        p0_memn(args, gw, NGW);
#endif
#if DUP_P0 & 8
        p0_xconv(args, HA, rowss, gw, NGW);
#endif
#endif
    }
    SEAM(0);

    if (IN(1)) {
        { pg8::DenseSched S; S.init(HA, ws + WS_WINA, T, D, D, G, bx);
          EpiInA E{(bf16_t*)(ws + WS_P0U), (bf16_t*)(ws + WS_P0Q), rowss};
          pg8::gemm_phase<EpiInA, pg8::DenseSched, true>(lds, D, S, E, 0, wave); }
        __syncthreads();
        { pg8::KvSched S; S.init(ws + WS_MEMN, ws + WS_WKV, G, (bx + 64) % G);
          EpiBf16 E{(bf16_t*)(ws + WS_KV), 512, nullptr, nullptr, 0};
          pg8::gemm_phase<EpiBf16, pg8::KvSched, true>(lds, D, S, E, 0, wave); }
    }
    SEAM(1);

    if (IN(2)) {
        bf16_t* CAT = (bf16_t*)(ws + WS_CAT);
        {
            const int n2 = NB * S5G - G;
            if (n2 > 0 && n2 < G) { if (bx >= n2) attn_mfma(lds, (const bf16_t*)(ws + WS_P0Q), (const bf16_t*)(ws + WS_KV), CAT, bx - n2, G - n2, wave); }
            else attn_mfma(lds, (const bf16_t*)(ws + WS_P0Q), (const bf16_t*)(ws + WS_KV), CAT, bx, G, wave); }
        __syncthreads();
#ifdef S5_NAIVE
        s5_naive(args, lds, (const bf16_t*)(ws + WS_P0U), CAT, bx, G, wave, lane);
#else
        s5_chunked(args, lds, (const bf16_t*)(ws + WS_P0U), (const bf16_t*)(ws + WS_S5TAB), (const float*)(ws + WS_S5TAB + 12 * MiB), CAT, bx, G, wave);
#endif
#ifdef DUP_P2
        xcd_barrier(bar);
#if DUP_P2 & 1
        attn_mfma(lds, (const bf16_t*)(ws + WS_P0Q), (const bf16_t*)(ws + WS_KV), CAT, bx, G, wave);
        __syncthreads();
#endif
#if DUP_P2 & 2
        s5_chunked(args, lds, (const bf16_t*)(ws + WS_P0U), (const bf16_t*)(ws + WS_S5TAB), (const float*)(ws + WS_S5TAB + 12 * MiB), CAT, bx, G, wave);
#endif
#endif
    }
    SEAM(2);

    if (IN(3)) {
        pg8::DenseSched S; S.init(ws + WS_CAT, ws + WS_WOUT0, T, D, D, G, bx);
        EpiRes E{args.in[I_X], nullptr, HA, rowss + T, nullptr};
        pg8::gemm_phase<EpiRes, pg8::DenseSched, true>(lds, D, S, E, 0, wave);
    }
    SEAM(3);

#ifdef DUP_P4
#pragma unroll 1
    for (int rep = 0; rep < 2; ++rep) {
#endif
    if (IN(4)) {
        pg8::DenseSched S; S.init(HA, ws + WS_WGU0, T, 2 * FD, D, G, bx);
        #ifdef DUP_P4
        int sk_ = (rep == 0) ? DUP_SKIP : 0; asm volatile("" : "+s"(sk_));
        EpiSwiglu E{(bf16_t*)(ws + WS_ACT0), FD, rowss + T, nullptr, sk_};
#else
        EpiSwiglu E{(bf16_t*)(ws + WS_ACT0), FD, rowss + T, nullptr, 0};
#endif
#ifdef DUP_P4
        if (rep == 0) pg8::gemm_phase<EpiSwiglu, pg8::DenseSched, true, false, DUP_VAR>(lds, D, S, E, 0, wave); else
#endif
        pg8::gemm_phase<EpiSwiglu, pg8::DenseSched, true>(lds, D, S, E, 0, wave);
    }
#ifdef DUP_P4
    if (rep == 0) xcd_barrier(bar); }
#endif
    SEAM(4);

    if (IN(5)) {
        pg8::DenseSched S; S.init(ws + WS_ACT0, ws + WS_WD0, T, D, FD, G, bx);
        EpiRes E{nullptr, HA, HA, rowss + 2 * T, nullptr};
        pg8::gemm_phase<EpiRes, pg8::DenseSched, true>(lds, FD, S, E, 0, wave);
    }
    SEAM(5);

    if (IN(6)) {
        pg8::DenseSched S; S.init(HA, ws + WS_WINB, T, INB, D, G, bx);
        EpiBf16 E{(bf16_t*)(ws + WS_P1), INB, rowss + 2 * T, (bf16_t*)(ws + WS_P0Q), SHIFTC};
        pg8::gemm_phase<EpiBf16, pg8::DenseSched, true>(lds, D, S, E, 0, wave);
#ifdef DUP_P6
        xcd_barrier(bar); pg8::gemm_phase<EpiBf16, pg8::DenseSched, true>(lds, D, S, E, 0, wave);
#endif
    }
    SEAM(6);

    RwBufs RB; RB.dbg = ctl + 16387;
#ifdef DBG_RWKV
    RB.Pp = (bf16_t*)(ws + 78 * MiB); RB.Qp = (bf16_t*)(ws + 84 * MiB); RB.Rp = (bf16_t*)(ws + 90 * MiB); RB.GA = (bf16_t*)(ws + 96 * MiB); RB.GB = (bf16_t*)(ws + 102 * MiB); RB.WL = (float*)(ws + 108 * MiB);
    RB.CAT = (bf16_t*)(ws + 110 * MiB);
    constexpr int RW_ITEMS = 64 * RH, RW_BH = RH;
#else
    { unsigned char* ob = (unsigned char*)args.out; RB.Pp = (bf16_t*)ob; RB.WL = (float*)(ob + 48 * MiB); RB.XL = (bf16_t*)(ob + 50 * MiB); }
    RB.Qp = (bf16_t*)(ws + WS_RQP); RB.Rp = (bf16_t*)(ws + WS_RRP); RB.GA = (bf16_t*)(ws + WS_RGA); RB.GB = (bf16_t*)(ws + WS_RGB);
    RB.CAT = (bf16_t*)(ws + WS_CAT);
    constexpr int RW_ITEMS = NB * 64 * RH, RW_BH = NB * RH;
#endif
#ifdef DBG_RWKV
    RB.XL = (bf16_t*)(ws + WS_RXL);
#endif
    RB.P1 = (const bf16_t*)(ws + WS_P1); RB.w2T = (const bf16_t*)(ws + WS_W2T); RB.a2T = (const bf16_t*)(ws + WS_A2T); RB.g2T = (const bf16_t*)(ws + WS_G2T);
    if (IN(7)) {
        rwkv_xpre(args, RB, bx, G, wave);
        xcd_barrier(bar);
#ifdef DBG_RWKV
        rwkv_prep(args, lds, (const bf16_t*)(ws + WS_P1), (bf16_t*)(ws + 432 * MiB), (bf16_t*)(ws + 480 * MiB), (bf16_t*)(ws + 128 * MiB), (bf16_t*)(ws + 2 * MiB), bx, G, tid);
        __syncthreads();
#endif
        rwkv_r1(args, lds, RB, bx, G, wave, RW_ITEMS);
#ifdef DUP_R1
        xcd_barrier(bar); rwkv_r1(args, lds, RB, bx, G, wave, RW_ITEMS);
#endif
    }
    SEAM(7);
    if (IN(8)) {
#ifdef DUP_R2
        rwkv_r2(lds, RB, bx, G, wave, RW_BH, true); xcd_barrier(bar);
#endif
        rwkv_r2(lds, RB, bx, G, wave, RW_BH);
        { const int nr2 = (RW_BH < G) ? RW_BH : G;
          if (nr2 < G) { if (bx >= nr2) { attn_mfma(lds, (const bf16_t*)(ws + WS_P0Q), (const bf16_t*)(ws + WS_KV) + (size_t)MROWS * 512, (bf16_t*)(ws + WS_CAT), bx - nr2, G - nr2, wave);
              __syncthreads(); moe_convert(args, (LAS float*)(lds + wave * 16384), (bx - nr2) * NWAVES + wave, (G - nr2) * NWAVES, lane);
          } }
          else { __syncthreads(); attn_mfma(lds, (const bf16_t*)(ws + WS_P0Q), (const bf16_t*)(ws + WS_KV) + (size_t)MROWS * 512, (bf16_t*)(ws + WS_CAT), bx, G, wave);
                 __syncthreads(); moe_convert(args, (LAS float*)(lds + wave * 16384), gw, NGW, lane); } }
    }
    SEAM(8);
    if (IN(9)) { rwkv_r3(RB, gw, NGW, RW_ITEMS);
    }
    SEAM(9);

    if (IN(10)) {
#ifdef DBG_RWKV
        {   const bf16_t* ref = (const bf16_t*)(ws + WS_CAT); const bf16_t* tst = (const bf16_t*)(ws + 110 * MiB); float sd = 0.f, sr = 0.f;
            for (int r = gw; r < SEQ; r += NGW) {
#pragma unroll
                for (int i = 0; i < 12; ++i) { const float a = bf2f(ref[(size_t)r * D + lane + 64 * i]), b = bf2f(tst[(size_t)r * D + lane + 64 * i]); sd += (a - b) * (a - b); sr += a * a; } }
            sd = wave_sum(sd); sr = wave_sum(sr);
            if (lane == 0) { atomicAdd((float*)(ctl + 16384), sd); atomicAdd((float*)(ctl + 16385), sr); }
            unsigned bad = 0u;
            for (int i = gw * 64 + lane; i < 768 * 64; i += NGW * 64) { const float v = RB.WL[i]; if (!(v - v == 0.f)) bad |= 1u; }
            for (int i = gw * 64 + lane; i < 768 * 4096; i += NGW * 64) { float v = bf2f(RB.GA[i]); if (!(v - v == 0.f)) bad |= 2u; v = bf2f(RB.GB[i]); if (!(v - v == 0.f)) bad |= 4u;
                v = bf2f(RB.Pp[i]); if (!(v - v == 0.f)) bad |= 8u; v = bf2f(RB.Qp[i]); if (!(v - v == 0.f)) bad |= 16u; v = bf2f(RB.Rp[i]); if (!(v - v == 0.f)) bad |= 32u; }
            for (int r = gw; r < SEQ; r += NGW) for (int i = 0; i < 12; ++i) { const float v = bf2f(tst[(size_t)r * D + lane + 64 * i]); if (!(v - v == 0.f)) bad |= 64u; }
            if (bad) atomicOr(ctl + 16386, bad); }
#endif
        pg8::DenseSched S; S.init(ws + WS_CAT, ws + WS_WOUT1, T, D, D, G, bx);
        EpiRes E{nullptr, HA, (bf16_t*)(ws + WS_X3), rowss + 3 * T, (unsigned char*)(ws + WS_HA2)};
        pg8::gemm_phase<EpiRes, pg8::DenseSched, true>(lds, D, S, E, 0, wave);
    }
    SEAM(10);

    if (IN(11)) {
        __syncthreads();
        moe_router(args, (const bf16_t*)(ws + WS_X3), ctl, ws, gw, NGW, lane, lds, wave);
    }
    SEAM(11);

    if constexpr (HI > 12 && LO < 14) {
#pragma unroll 1
    for (int pass = args.pass_lo; pass < args.pass_hi; ++pass) {
        constexpr int pg = 12, pd = 13;
        LAS int* tab = (LAS int*)(lds + LDS_MISC + 256);
        if (IN(pg) || IN(pd)) {
            __syncthreads();
            if (tid == 0) { int acc = 0;
#pragma unroll 1
                for (int e = 0; e < 8; ++e) { const int c = (int)__hip_atomic_load(ctl + CW_CNT + 64 * e, __ATOMIC_RELAXED, __HIP_MEMORY_SCOPE_AGENT); tab[e] = acc; tab[16 + e] = c; acc += (c + 255) >> 8; } tab[8] = acc; }
            __syncthreads();
        }
        const int ntile = (IN(pg) || IN(pd)) ? __builtin_amdgcn_readfirstlane(tab[8]) : 0;
        const int tile0 = 128 * pass, nt_pass = min(128, ntile - tile0);
        if (IN(pg) && nt_pass > 0) {
            MoeGuSched S; S.o.init(nt_pass, 2 * FE / 256, G, bx); S.A = (const char*)(ws + WS_HA2); S.W = (const char*)(ws + WS_WMOE_GU); S.list = (const int*)(ws + WS_ROUTE2 + RT_LIST); S.tab = tab; S.tile0 = tile0;
            EpiSwigluF8 E{(unsigned char*)(ws + WS_MACT), FE, (const float*)(ws + WS_ROUTE2 + RT_LRSTD)};
            pg8::gemm_phase<EpiSwigluF8, MoeGuSched, true, true>(lds, D / 2, S, E, 0, wave);
#ifdef DUP_GU
            if (pass == 0) { xcd_barrier(bar); pg8::gemm_phase<EpiSwigluF8, MoeGuSched, true, true>(lds, D / 2, S, E, 0, wave); }
#endif
        }
        SEAM(pg);
        if (IN(pd) && nt_pass > 0 && pass == 2) {
            MoeDownTailSched S; S.o.init(nt_pass, 4 * TAIL_SPLIT, G, bx); S.A = (const char*)(ws + WS_MACT); S.W = (const char*)(ws + WS_WMOE_D); S.tab = tab; S.tile0 = tile0;
            EpiSlotPart E{(bf16_t*)(ws + WS_TAILP)};
            pg8::gemm_phase<EpiSlotPart, MoeDownTailSched, true, true>(lds, TAIL_K / 2, S, E, FE / 2, wave);
        } else if (IN(pd) && nt_pass > 0) {
            MoeDownSched S; S.o.init(nt_pass, D / 256, G, bx); S.A = (const char*)(ws + WS_MACT); S.W = (const char*)(ws + WS_WMOE_D); S.tab = tab; S.tile0 = tile0;
            EpiSlot E{(bf16_t*)(ws + WS_YSLOT)};
            pg8::gemm_phase<EpiSlot, MoeDownSched, true, true>(lds, FE / 2, S, E, 0, wave);
#ifdef DUP_DN
            if (pass == 0) { xcd_barrier(bar); pg8::gemm_phase<EpiSlot, MoeDownSched, true, true>(lds, FE / 2, S, E, 0, wave); }
#endif
        }
        if (IN(pd)) TS_IDLE(pd);
        if (IN(pd) && (pass + 1 < args.pass_hi || IN(14))) xcd_barrier(bar);
        TS_T0(); STAMP(); WS_FENCE();
    }
    }

    if (IN(14)) {
        LAS int* tab = (LAS int*)(lds + LDS_MISC + 256);
        __syncthreads();
        if (tid == 0) { int acc = 0;
#pragma unroll 1
            for (int e = 0; e < 8; ++e) { const int c = (int)__hip_atomic_load(ctl + CW_CNT + 64 * e, __ATOMIC_RELAXED, __HIP_MEMORY_SCOPE_AGENT); tab[e] = acc; acc += (c + 255) >> 8; } }
        __syncthreads();
        const int* toke = (const int*)(ws + WS_ROUTE2 + RT_TOKE); const int* tokr = (const int*)(ws + WS_ROUTE2 + RT_TOKR); const float* tokw = (const float*)(ws + WS_ROUTE2 + RT_TOKW);
        const bf16_t* Y = (const bf16_t*)(ws + WS_YSLOT); const bf16_t* X3 = (const bf16_t*)(ws + WS_X3); const bf16_t* TP = (const bf16_t*)(ws + WS_TAILP);
        int ms0 = 0, ms1 = 0; float mw0 = 0.f, mw1 = 0.f;
        { const int r = gw + NGW * lane; if (r < T) { const int e0 = toke[2 * r], e1 = toke[2 * r + 1]; mw0 = tokw[2 * r]; mw1 = tokw[2 * r + 1]; ms0 = tab[e0] * 256 + tokr[2 * r]; ms1 = tab[e1] * 256 + tokr[2 * r + 1]; } }
        const int nrow = (gw < T) ? (T - 1 - gw) / NGW + 1 : 0;
        f32x4 gn[4];
#pragma unroll
        for (int j = 0; j < 4; ++j) gn[j] = ((const f32x4*)(args.in[I_NORM_FINAL]) + lane)[64 * j];
        struct FinIn { u32x2 x[4], y0[4], y1[4]; };
#define FIN_LOAD(I_, i_) do { const int r_ = gw + NGW * (i_); const int s0_ = __builtin_amdgcn_readlane(ms0, (i_)), s1_ = __builtin_amdgcn_readlane(ms1, (i_)); \
            const u32x2* xr_ = (const u32x2*)(X3 + (size_t)r_ * D) + lane; \
            const u32x2* y0_ = (const u32x2*)((s0_ < 65536) ? Y + (size_t)s0_ * D : TP + (size_t)(s0_ - 65536) * D) + lane; \
            const u32x2* y1_ = (const u32x2*)((s1_ < 65536) ? Y + (size_t)s1_ * D : TP + (size_t)(s1_ - 65536) * D) + lane; \
            _Pragma("unroll") for (int j = 0; j < 4; ++j) { I_.x[j] = xr_[64 * j]; I_.y0[j] = y0_[64 * j]; I_.y1[j] = y1_[64 * j]; } } while (0)
#define FIN_ROW(I_, i_) do { const int r_ = gw + NGW * (i_); const int s0_ = __builtin_amdgcn_readlane(ms0, (i_)), s1_ = __builtin_amdgcn_readlane(ms1, (i_)); \
            const float w0_ = __builtin_bit_cast(float, __builtin_amdgcn_readlane(__builtin_bit_cast(int, mw0), (i_))), w1_ = __builtin_bit_cast(float, __builtin_amdgcn_readlane(__builtin_bit_cast(int, mw1), (i_))); \
            f32x4 v[4]; float s = 0.f; \
            _Pragma("unroll") for (int j = 0; j < 4; ++j) { const u32x2 a = I_.x[j], b0 = I_.y0[j], b1 = I_.y1[j]; \
                v[j] = (f32x4){bflo(a.x) + w0_ * bflo(b0.x) + w1_ * bflo(b1.x), bfhi(a.x) + w0_ * bfhi(b0.x) + w1_ * bfhi(b1.x), bflo(a.y) + w0_ * bflo(b0.y) + w1_ * bflo(b1.y), bfhi(a.y) + w0_ * bfhi(b0.y) + w1_ * bfhi(b1.y)}; } \
            _Pragma("unroll 1") for (int kk = 0; kk < 2; ++kk) { const int sl = kk ? s1_ : s0_; const float wk = kk ? w1_ : w0_; \
                if (sl >= 65536) { _Pragma("unroll 1") for (int sp = 1; sp < TAIL_SPLIT; ++sp) { const u32x2* yp = (const u32x2*)(TP + ((size_t)sp * 2048 + (sl - 65536)) * D) + lane; \
                    _Pragma("unroll") for (int j = 0; j < 4; ++j) { const u32x2 a = yp[64 * j]; v[j][0] += wk * bflo(a.x); v[j][1] += wk * bfhi(a.x); v[j][2] += wk * bflo(a.y); v[j][3] += wk * bfhi(a.y); } } } } \
            _Pragma("unroll") for (int j = 0; j < 4; ++j) s += (v[j][0] * v[j][0] + v[j][1] * v[j][1]) + (v[j][2] * v[j][2] + v[j][3] * v[j][3]); \
            const float rs = rstd_of(wave_sum_fast(s)); f32x4* o = (f32x4*)(X + (size_t)r_ * D) + lane; \
            _Pragma("unroll") for (int j = 0; j < 4; ++j) o[64 * j] = v[j] * rs * gn[j]; } while (0)
        FinIn Fa, Fb;
        if (nrow > 0) FIN_LOAD(Fa, 0);
#pragma unroll 1
        for (int i = 0; i < nrow; i += 2) {
            if (i + 1 < nrow) FIN_LOAD(Fb, i + 1);
            __builtin_amdgcn_sched_barrier(0);
            FIN_ROW(Fa, i);
            if (i + 2 < nrow) FIN_LOAD(Fa, i + 2);
            __builtin_amdgcn_sched_barrier(0);
            if (i + 1 < nrow) FIN_ROW(Fb, i + 1);
        }
#undef FIN_LOAD
#undef FIN_ROW
        TS_IDLE(14);
    }
#undef IN
#undef SEAM
#undef lane
#undef tid
#undef ws
}

#ifdef DBG_RWKV
__global__ void __launch_bounds__(NTHR, 2) dbg_naive(Args args) {
    extern __shared__ __attribute__((aligned(16))) unsigned char lds_raw[];
    LAS unsigned char* lds = (LAS unsigned char*)lds_raw; unsigned char* ws = args.ws;
    const int wave = __builtin_amdgcn_readfirstlane(threadIdx.x >> 6);
    rwkv_naive(args, lds, (const bf16_t*)(ws + WS_P1), (const bf16_t*)(ws + 432 * MiB), (const bf16_t*)(ws + 480 * MiB), (const bf16_t*)(ws + 128 * MiB), (const bf16_t*)(ws + 2 * MiB), (bf16_t*)(ws + WS_CAT), blockIdx.x, gridDim.x, wave, lane_now());
}
#endif

#ifndef N_LAUNCH_MODE
#define N_LAUNCH_MODE 1
#endif
extern "C" void kernel_launch(void* const* d_in, const int* in_sizes, int n_in, void* d_out, int out_size, void* d_ws, size_t ws_size, hipStream_t stream) {
    static int grid = 0;
    if (grid == 0) {
        if (n_in != N_IN || in_sizes[0] != T * D || out_size != T * D || ws_size < WS_NEED) {
            fprintf(stderr, "kernel_launch: unexpected shapes/workspace: n_in %d in0 %d out %d ws %zu (need %zu)\n", n_in, n_in > 0 ? in_sizes[0] : -1, out_size, ws_size, (size_t)WS_NEED); grid = -1; return; }
        int dev = 0, cus = 0;
        if (hipGetDevice(&dev) != hipSuccess || hipDeviceGetAttribute(&cus, hipDeviceAttributeMultiprocessorCount, dev) != hipSuccess) { grid = -1; return; }
        bool ok = true;
#define SETATTR(K) ok = ok && (hipFuncSetAttribute((const void*)K, hipFuncAttributeMaxDynamicSharedMemorySize, LDS_BYTES) == hipSuccess)
#if N_LAUNCH_MODE == 1
        SETATTR((fwd<0, N_PHASES>));
#else
        SETATTR((fwd<0, 1>)); SETATTR((fwd<1, 2>)); SETATTR((fwd<2, 3>)); SETATTR((fwd<3, 4>)); SETATTR((fwd<4, 5>)); SETATTR((fwd<5, 6>)); SETATTR((fwd<6, 7>)); SETATTR((fwd<7, 8>));
        SETATTR((fwd<8, 9>)); SETATTR((fwd<9, 10>)); SETATTR((fwd<10, 11>)); SETATTR((fwd<11, 12>)); SETATTR((fwd<12, 13>)); SETATTR((fwd<13, 14>)); SETATTR((fwd<14, 15>));
#endif
        if (!ok) { fprintf(stderr, "kernel_launch: hipFuncSetAttribute failed\n"); grid = -1; return; }
        (void)hipGetLastError();
        grid = cus;
    }
    if (grid < 0) return;
    if (hipMemsetAsync((char*)d_ws + WS_CTL, 0, CTL_BYTES, stream) != hipSuccess) return;
    Args a{};
    for (int i = 0; i < N_IN; ++i) a.in[i] = (const float*)d_in[i];
    a.out = (float*)d_out; a.ws = (unsigned char*)d_ws;
#if N_LAUNCH_MODE == 1
    a.ph_lo = 0; a.ph_hi = N_PHASES; a.pass_lo = 0; a.pass_hi = 3;
    hipLaunchKernelGGL((fwd<0, N_PHASES>), dim3(grid), dim3(NTHR), LDS_BYTES, stream, a);
#else
#define LAUNCH1(P) do { a.ph_lo = (P); a.ph_hi = (P) + 1; hipLaunchKernelGGL((fwd<(P), (P) + 1>), dim3(grid), dim3(NTHR), LDS_BYTES, stream, a); } while (0)
    LAUNCH1(0); LAUNCH1(1); LAUNCH1(2); LAUNCH1(3); LAUNCH1(4); LAUNCH1(5); LAUNCH1(6); LAUNCH1(7);
#ifdef DBG_RWKV
    hipLaunchKernelGGL(dbg_naive, dim3(grid), dim3(NTHR), 4096, stream, a); LAUNCH1(8);
#else
    LAUNCH1(8);
#endif
    LAUNCH1(9); LAUNCH1(10); LAUNCH1(11);
    for (int pass = 0; pass < 5; ++pass) { a.pass_lo = pass; a.pass_hi = pass + 1; LAUNCH1(12); LAUNCH1(13); }
    LAUNCH1(14);
#endif
}
```

```cpp
#include <hip/hip_runtime.h>
#include <cstdio>
#include <cstdint>

#define LAS __attribute__((address_space(3)))
#define GAS __attribute__((address_space(1)))
typedef unsigned short bf16_t;
typedef short bf16x8 __attribute__((ext_vector_type(8)));
typedef short bf16x4 __attribute__((ext_vector_type(4)));
typedef float f32x4 __attribute__((ext_vector_type(4)));
typedef float f32x2 __attribute__((ext_vector_type(2)));
typedef unsigned u32x4 __attribute__((ext_vector_type(4)));
typedef unsigned u32x2 __attribute__((ext_vector_type(2)));

constexpr int NB = 8, SEQ = 4096, T = NB * SEQ, D = 1024, MEML = 256, MROWS = NB * MEML;
constexpr int CS = 768, CM = 256, NH_MEM = 4;
constexpr int S5G = 48, S5J = 16, S5P = 64;
constexpr int RH = 12, RN = 64, SHIFTC = 2560, INB = 2816;
constexpr int FD = 2816, NE = 8, FE = 3584;
constexpr float RMS_EPS = 1e-6f, LNX_EPS = 64e-5f;
constexpr int NWAVES = 8, NTHR = 512;

enum { I_X = 0, I_MEM, I_NORM_MIX, I_NORM_MEM, I_WKV, I_WOUT, I_NORM_FFN, I_NORM_FINAL, I_WINA, I_LAM_RE, I_LAM_IM, I_LOG_DT, I_B_RE, I_B_IM, I_C_RE, I_C_IM,
       I_S5D, I_WGLU, I_BGLU, I_FGATE, I_FUP, I_FDOWN, I_WINB, I_MU, I_W0, I_W2, I_A0, I_A2, I_G2, I_KK, I_KA, I_RK, I_LNXW, I_LNXB, I_WR, I_BR, I_MGATE, I_MUP, I_MDOWN, N_IN };

constexpr size_t MiB = 1u << 20;
constexpr size_t WS_CTL = 0, CTL_BYTES = 2 * MiB;
constexpr size_t WS_HA = 2 * MiB;
constexpr size_t WS_ROUTE = 66 * MiB;
constexpr size_t WS_WOUT1 = 70 * MiB;
constexpr size_t WS_KV = 72 * MiB;
constexpr size_t WS_LORA = 76 * MiB;
constexpr size_t WS_W2T = WS_LORA, WS_A2T = WS_LORA + 96 * 1024, WS_G2T = WS_LORA + 192 * 1024;
constexpr size_t WS_WINA = 78 * MiB, WS_WOUT0 = 80 * MiB, WS_WKV = 82 * MiB  , WS_WGU0 = 84 * MiB  , WS_WD0 = 95 * MiB  ,
                 WS_WINB = 101 * MiB  , WS_MEMN = 107 * MiB  , WS_S5TAB = 115 * MiB  ;
constexpr size_t WS_P0U = 128 * MiB;
constexpr size_t WS_P0Q = 176 * MiB;
constexpr size_t WS_CAT = 192 * MiB;
constexpr size_t WS_ACT0 = 256 * MiB;
constexpr size_t WS_P1 = 256 * MiB;
constexpr size_t WS_RPP = 2 * MiB, WS_RWL = 50 * MiB  , WS_RQP = 128 * MiB, WS_RRP = 432 * MiB, WS_RGA = 480 * MiB, WS_RGB = 78 * MiB, WS_RXL = 52 * MiB  , WS_X3 = 340 * MiB  ;
constexpr size_t WS_WMOE_GU = 256 * MiB;
constexpr size_t WS_WMOE_D = 312 * MiB;
constexpr size_t WS_HA2 = 468 * MiB;
constexpr size_t WS_ROUTE2 = 2 * MiB;
constexpr size_t WS_MACT = 6 * MiB;
constexpr size_t WS_YSLOT = 118 * MiB;
constexpr size_t WS_TAILP = 424 * MiB;
constexpr size_t WS_END = 532 * MiB, WS_NEED = 532 * MiB;
constexpr int CW_BAR = 4096;
constexpr int CW_CNT = 8192;
constexpr size_t CTL_ROWSS = 1 * MiB;
constexpr size_t RT_LIST = 0, RT_LRSTD = 1 * MiB, RT_TOKE = 2 * MiB  , RT_TOKR = 2 * MiB + 256 * 1024, RT_TOKW = 2 * MiB + 512 * 1024;

constexpr int LDS_STAGE = 131072, LDS_BYTES = 147456, LDS_MISC = LDS_BYTES - 1024;

typedef __bf16 bf16v2_t __attribute__((ext_vector_type(2)));
__device__ __forceinline__ unsigned cvt_pk_bf16(float lo, float hi) { const f32x2 v = {lo, hi}; const bf16v2_t b = __builtin_convertvector(v, bf16v2_t); return __builtin_bit_cast(unsigned, b); }
__device__ __forceinline__ float bf2f(unsigned short b) { return __uint_as_float(((unsigned)b) << 16); }
__device__ __forceinline__ float bflo(unsigned w) { return __uint_as_float(w << 16); }
__device__ __forceinline__ float bfhi(unsigned w) { return __uint_as_float(w & 0xffff0000u); }
__device__ __forceinline__ bf16_t f2bf(float f) { return (bf16_t)(cvt_pk_bf16(f, 0.f) & 0xffffu); }
__device__ __forceinline__ float wave_sum(float v) {
#pragma unroll
    for (int o = 1; o < 64; o <<= 1) v += __shfl_xor(v, o);
    return v;
}
__device__ __forceinline__ float wave_sum_fast(float v) {
    v += __builtin_bit_cast(float, __builtin_amdgcn_update_dpp(0, __builtin_bit_cast(int, v), 0xB1, 0xf, 0xf, false));
    v += __builtin_bit_cast(float, __builtin_amdgcn_update_dpp(0, __builtin_bit_cast(int, v), 0x4E, 0xf, 0xf, false));
    v += __builtin_bit_cast(float, __builtin_amdgcn_update_dpp(0, __builtin_bit_cast(int, v), 0x141, 0xf, 0xf, false));
    v += __builtin_bit_cast(float, __builtin_amdgcn_update_dpp(0, __builtin_bit_cast(int, v), 0x140, 0xf, 0xf, false));
    const int vi = __builtin_bit_cast(int, v);
    return (__builtin_bit_cast(float, __builtin_amdgcn_readlane(vi, 0)) + __builtin_bit_cast(float, __builtin_amdgcn_readlane(vi, 16))) + (__builtin_bit_cast(float, __builtin_amdgcn_readlane(vi, 32)) + __builtin_bit_cast(float, __builtin_amdgcn_readlane(vi, 48)));
}
__device__ __forceinline__ void wave_sum8(float (&x)[8]) {
    float y[4];
#pragma unroll
    for (int k = 0; k < 4; ++k) { float a = x[2 * k], b = x[2 * k + 1];
        asm volatile("s_nop 1\n\tv_permlane32_swap_b32 %0, %1\n\ts_nop 1" : "+v"(a), "+v"(b));
        float v = a + b;
        v += __builtin_bit_cast(float, __builtin_amdgcn_update_dpp(0, __builtin_bit_cast(int, v), 0xB1, 0xf, 0xf, false));
        v += __builtin_bit_cast(float, __builtin_amdgcn_update_dpp(0, __builtin_bit_cast(int, v), 0x4E, 0xf, 0xf, false));
        v += __builtin_bit_cast(float, __builtin_amdgcn_update_dpp(0, __builtin_bit_cast(int, v), 0x141, 0xf, 0xf, false));
        v += __builtin_bit_cast(float, __builtin_amdgcn_update_dpp(0, __builtin_bit_cast(int, v), 0x140, 0xf, 0xf, false));
        y[k] = v; }
#pragma unroll
    for (int k = 0; k < 4; ++k) { const int vi = __builtin_bit_cast(int, y[k]);
        x[2 * k] = __builtin_bit_cast(float, __builtin_amdgcn_readlane(vi, 0)) + __builtin_bit_cast(float, __builtin_amdgcn_readlane(vi, 16));
        x[2 * k + 1] = __builtin_bit_cast(float, __builtin_amdgcn_readlane(vi, 32)) + __builtin_bit_cast(float, __builtin_amdgcn_readlane(vi, 48)); }
}
__device__ __forceinline__ float tanh_fast_(float x) { const float e = __expf(2.0f * x); return 1.0f - 2.0f * __builtin_amdgcn_rcpf(1.0f + e); }
__device__ __forceinline__ float sigmoidf_(float x) { return __builtin_amdgcn_rcpf(1.0f + __expf(-x)); }
__device__ __forceinline__ float silu_(float x) { return x * __builtin_amdgcn_rcpf(1.0f + __expf(-x)); }
__device__ __forceinline__ float gelu_tanh_(float x) { const float a = 0.7978845608028654f * (x + 0.044715f * x * x * x); return 0.5f * x * (1.0f + tanhf(a)); }
__device__ __forceinline__ u32x2 cvt8_fp8(const f32x4 a, const f32x4 b) {
    const float lim = 448.0f; int w0 = 0, w1 = 0;
    w0 = __builtin_amdgcn_cvt_pk_fp8_f32(__builtin_amdgcn_fmed3f(a[0], -lim, lim), __builtin_amdgcn_fmed3f(a[1], -lim, lim), w0, false);
    w0 = __builtin_amdgcn_cvt_pk_fp8_f32(__builtin_amdgcn_fmed3f(a[2], -lim, lim), __builtin_amdgcn_fmed3f(a[3], -lim, lim), w0, true);
    w1 = __builtin_amdgcn_cvt_pk_fp8_f32(__builtin_amdgcn_fmed3f(b[0], -lim, lim), __builtin_amdgcn_fmed3f(b[1], -lim, lim), w1, false);
    w1 = __builtin_amdgcn_cvt_pk_fp8_f32(__builtin_amdgcn_fmed3f(b[2], -lim, lim), __builtin_amdgcn_fmed3f(b[3], -lim, lim), w1, true);
    return (u32x2){(unsigned)w0, (unsigned)w1};
}
constexpr float F8_X = 16.f, F8_WGU = 256.f, F8_ACT = 16.f, F8_WD = 512.f;
__device__ __forceinline__ int lane_now() { int l; asm volatile("v_mbcnt_lo_u32_b32 %0, -1, 0\n\tv_mbcnt_hi_u32_b32 %0, -1, %0" : "=v"(l)); return l; }
#define LDS_WAIT() asm volatile("s_waitcnt lgkmcnt(0)" ::: "memory")
#define VM_WAIT() asm volatile("s_waitcnt vmcnt(0)" ::: "memory")

#define XB_TMO      128
#define XB_XCNT(j)  (256  + 64 * (j))
#define XB_XSUB(j)  (1280 + 64 * (j))
#define XB_XGEN(j)  (2304 + 64 * (j))
#define XB_TOP      3328
#define XB_TOPGEN   3392
#define XCD_BAR_WORDS 3456
#define XB_SPIN_CAP (1u << 18)
__device__ __forceinline__ unsigned xb_ld(unsigned* p)              { return __hip_atomic_load(p, __ATOMIC_RELAXED, __HIP_MEMORY_SCOPE_AGENT); }
__device__ __forceinline__ unsigned xb_add(unsigned* p, unsigned v) { return __hip_atomic_fetch_add(p, v, __ATOMIC_RELAXED, __HIP_MEMORY_SCOPE_AGENT); }
__device__ __forceinline__ unsigned xb_xcc_id() { return (unsigned)__builtin_amdgcn_s_getreg((3 << 11) | 20) & 0xFu; }
#define XB_SPIN(cond, bar) do { unsigned _sp = 0; while (cond) { __builtin_amdgcn_s_sleep(1); \
    if ((++_sp & 255u) == 0u) { if (xb_ld(&(bar)[XB_TMO])) break; if (_sp > XB_SPIN_CAP) { atomicAdd(&(bar)[XB_TMO], 1u); break; } } } } while (0)
struct XcdBarrier { unsigned* bar; unsigned x; volatile LAS unsigned* st; int wave; };
__device__ __forceinline__ XcdBarrier xcd_barrier_post(unsigned* bar, volatile LAS unsigned* st) {
    XcdBarrier b; b.bar = bar; b.x = xb_xcc_id(); b.st = st; b.wave = __builtin_amdgcn_readfirstlane(threadIdx.x >> 6);
    if (threadIdx.x == 0) (void)xb_add(&bar[XB_XCNT(b.x)], 1u);
    return b;
}
__device__ __forceinline__ void xcd_barrier_complete(unsigned* bar, unsigned x, unsigned& nloc, unsigned& nx) {
    const unsigned G = gridDim.x * gridDim.y * gridDim.z;
    unsigned sum, cnt, mine, sp = 0u;
    for (;;) {
        sum = 0u; cnt = 0u; mine = 0u;
#pragma unroll
        for (unsigned j = 0; j < 16; ++j) { const unsigned c = xb_ld(&bar[XB_XCNT(j)]); sum += c; cnt += (c > 0u) ? 1u : 0u; mine = (j == x) ? c : mine; }
        if (sum == G) break;
        __builtin_amdgcn_s_sleep(1);
        if ((++sp & 255u) == 0u) { if (xb_ld(&bar[XB_TMO])) break; if (sp > XB_SPIN_CAP) { atomicAdd(&bar[XB_TMO], 1u); break; } }
    }
    nloc = mine > 0u ? mine : 1u; nx = cnt > 0u ? cnt : 1u;
}
__device__ __forceinline__ void xcd_barrier(const XcdBarrier& b) {
    asm volatile("s_waitcnt vmcnt(0)" ::: "memory");
    __syncthreads();
    if (b.wave == 0 && lane_now() == 0) {
        unsigned* bar = b.bar;
        __builtin_amdgcn_s_waitcnt(0);
        unsigned nloc = b.st[0], nx = b.st[1];
        if (nloc == 0u) { xcd_barrier_complete(bar, b.x, nloc, nx); b.st[0] = nloc; b.st[1] = nx; }
        const unsigned old = xb_add(&bar[XB_XSUB(b.x)], 1u);
        const unsigned gen = old / nloc;
        if (old + 1u == (gen + 1u) * nloc) {
            __builtin_amdgcn_fence(__ATOMIC_RELEASE, "agent");
            asm volatile("s_waitcnt vmcnt(0)" ::: "memory");
            const unsigned og = xb_add(&bar[XB_TOP], 1u);
            const unsigned tg = og / nx;
            if (og + 1u == (tg + 1u) * nx) xb_add(&bar[XB_TOPGEN], 1u);
            else XB_SPIN(xb_ld(&bar[XB_TOPGEN]) == tg, bar);
            __builtin_amdgcn_fence(__ATOMIC_ACQUIRE, "agent");
            xb_add(&bar[XB_XGEN(b.x)], 1u);
            asm volatile("s_waitcnt vmcnt(0)" ::: "memory");
        } else {
            XB_SPIN(xb_ld(&bar[XB_XGEN(b.x)]) == gen, bar);
            __builtin_amdgcn_fence(__ATOMIC_ACQUIRE, "agent");
            asm volatile("s_waitcnt vmcnt(0)" ::: "memory");
        }
    }
    __syncthreads();
}

namespace pg8 {
constexpr int BM = 256, BK = 64, HALF = 128, HTB = HALF * BK * 2, STAGE_BYTES = 8 * HTB, NXCD = 8, WGM = 4;
__host__ __device__ __forceinline__ int lds_byte(int r, int c) { const int st = (r >> 4) * 2 + (c >> 5), rr = r & 15, cc = c & 31, ob = rr * 64 + cc * 2; return st * 1024 + (ob ^ (((ob >> 9) & 1) << 5)); }
__host__ __device__ __forceinline__ void stage_rc(int b, int& R, int& C) { const int st = b / 1024, sb = b % 1024, swz = sb ^ (((sb >> 9) & 1) << 5); R = (st >> 1) * 16 + swz / 64; C = (st & 1) * 32 + (swz % 64) / 2; }
__host__ __device__ __forceinline__ int perm32(int rho) { const int n = rho >> 4, i = rho & 15; return 8 * (i >> 2) + 4 * n + (i & 3); }

struct Unit { int pm, pn, e, rb; };

struct TileOrder {
    int nM, nN, nwg, G, c;
    __device__ void init(int nM_, int nN_, int G_, int c_) { nM = nM_; nN = nN_; nwg = nM * nN; G = G_; c = c_; }
    __device__ bool tile(int i, int& pm, int& pn) const {
        const long L = (long)i * G + c; if (L >= nwg) return false;
        int wgid = (int)L; { const int q = nwg / NXCD, r = nwg % NXCD, xcd = wgid % NXCD, off = wgid / NXCD; wgid = (xcd < r ? xcd * (q + 1) : r * (q + 1) + (xcd - r) * q) + off; }
        const int nig = WGM * nN, gid = wgid / nig, fm = gid * WGM, gsz = (nM - fm) < WGM ? (nM - fm) : WGM;
        pm = fm + ((wgid % nig) % gsz); pn = (wgid % nig) / gsz; return true;
    }
};
struct DenseSched {
    static constexpr bool GATHER = false;
    TileOrder o; const char* A; const char* Bt; int K;
    __device__ void init(const void* A_, const void* Bt_, int M, int N, int K_, int G, int c) { o.init(M / BM, N / BM, G, c); A = (const char*)A_; Bt = (const char*)Bt_; K = K_; }
    __device__ __forceinline__ bool next(int i, Unit& u) const { u.e = 0; u.rb = 0; return o.tile(i, u.pm, u.pn); }
    __device__ __forceinline__ const char* a_ptr() const { return A; }
    __device__ __forceinline__ const char* b_ptr() const { return Bt; }
    __device__ __forceinline__ unsigned a_base(const Unit& u) const { return (unsigned)u.pm * (unsigned)(BM * K * 2); }
    __device__ __forceinline__ unsigned b_base(const Unit& u) const { return (unsigned)u.pn * (unsigned)(BM * K * 2); }
    __device__ __forceinline__ void gather_ids(const Unit&, int, int, int (&)[4]) const {}
};

struct KvSched {
    static constexpr bool GATHER = false;
    TileOrder o; const char* A; const char* Bt;
    __device__ void init(const void* A_, const void* Bt_, int G, int c) { o.init(2 * MROWS / BM, 512 / BM, G, c); A = (const char*)A_; Bt = (const char*)Bt_; }
    __device__ __forceinline__ bool next(int i, Unit& u) const { u.e = 0; u.rb = 0; return o.tile(i, u.pm, u.pn); }
    __device__ __forceinline__ const char* a_ptr() const { return A; }
    __device__ __forceinline__ const char* b_ptr() const { return Bt; }
    __device__ __forceinline__ unsigned a_base(const Unit& u) const { return (unsigned)u.pm * (unsigned)(BM * D * 2); }
    __device__ __forceinline__ unsigned b_base(const Unit& u) const { return ((unsigned)(u.pm >= MROWS / BM ? 512 : 0) + (unsigned)u.pn * BM) * (unsigned)(D * 2); }
    __device__ __forceinline__ void gather_ids(const Unit&, int, int, int (&)[4]) const {}
};
typedef int i32x8v __attribute__((ext_vector_type(8)));
typedef int i32x4v __attribute__((ext_vector_type(4)));
template <class Epi, class Sched, bool ALIGN_EPI, bool FP8 = false, int VAR = 0>
__device__ __forceinline__ void gemm_phase(LAS unsigned char* lds, const int K, const Sched& S, const Epi& E, const int ldk_ = 0, const int wid_ = -1) {
    int widv_ = (wid_ >= 0) ? wid_ : __builtin_amdgcn_readfirstlane(threadIdx.x >> 6); asm volatile("" : "+s"(widv_));
    const int lane = lane_now(), wid = widv_, tid = wid * 64 + lane, wr = wid >> 2, wc = wid & 3, fr = lane & 15, fq = lane >> 4;
    const int nt = K / BK, LD = ldk_ ? ldk_ : K;
    unsigned voffA[2][2], voffB[2];
#pragma unroll
    for (int i = 0; i < 2; ++i) { int R, C; stage_rc(tid * 16 + i * 8192, R, C); const int Rb = (R & ~31) + perm32(R & 31);
        voffA[0][i] = (unsigned)(R * LD + C) * 2u; voffA[1][i] = (unsigned)((R + HALF) * LD + C) * 2u; voffB[i] = (unsigned)(Rb * LD + C) * 2u; }
    const unsigned kstep = (unsigned)(BK * 2);
    const unsigned hstep = (unsigned)(HALF * LD * 2);
    const __amdgpu_buffer_rsrc_t rsA = __builtin_amdgcn_make_buffer_rsrc((void*)S.a_ptr(), 0, 0x7ffffffc, 0x00020000), rsB = __builtin_amdgcn_make_buffer_rsrc((void*)S.b_ptr(), 0, 0x7ffffffc, 0x00020000);
    const unsigned ldsw = (unsigned)wid * 1024u;
    const int aoff = lds_byte(wr * 64 + fr, fq * 8), boff = lds_byte(wc * 32 + fr, fq * 8);
    LAS unsigned char* pA = lds + aoff; LAS unsigned char* pB = lds + 4 * HTB + boff;
#define PG8_SA(b, h) (((b) * 2 + (h)) * HTB)
#define PG8_SB(b, h) ((4 + (b) * 2 + (h)) * HTB)
#define PG8_SBR(b, h) (((b) * 2 + (h)) * HTB)
#define PG8_STAGE_R(rs, bufoff, gbase, voff) do { if constexpr (VAR != 3 && VAR != 4) _Pragma("unroll") for (int _i = 0; _i < 2; ++_i) \
        __builtin_amdgcn_raw_ptr_buffer_load_lds(rs, (LAS unsigned*)(lds + (bufoff) + ldsw + _i * 8192), 16, (voff)[_i], (gbase), 0, 0); } while (0)
#define PG8_STAGE(bufoff, gbase, voff) PG8_STAGE_R(rsB, bufoff, gbase, voff)
#define PG8_STAGE_A(bufoff, gbase, h) do { if constexpr (Sched::GATHER) { \
        __builtin_amdgcn_raw_ptr_buffer_load_lds(rsA, (LAS unsigned*)(lds + (bufoff) + ldsw), 16, (voffA[h][0] & 0xffffu) * (unsigned)(K * 2) + (cpk & 0xffffu), (gbase), 0, 0); \
        __builtin_amdgcn_raw_ptr_buffer_load_lds(rsA, (LAS unsigned*)(lds + (bufoff) + ldsw + 8192), 16, (voffA[h][0] >> 16) * (unsigned)(K * 2) + (cpk >> 16), (gbase), 0, 0); \
        } else { PG8_STAGE_R(rsA, bufoff, (gbase) + (h) * hstep, voffA[0]); } } while (0)
#define PG8_LD8(ptr_) __builtin_shufflevector(*(const LAS i32x4v*)(ptr_), *(const LAS i32x4v*)((ptr_) + 1024), 0, 1, 2, 3, 4, 5, 6, 7)
#define PG8_LDA(dst, b, h) do { if constexpr (VAR == 4 || VAR == 5) { _Pragma("unroll") for (int m = 0; m < 4; ++m) _Pragma("unroll") for (int k = 0; k < 2; ++k) asm volatile("" : "+v"(dst[m][k])); } else if constexpr (FP8) { _Pragma("unroll") for (int m = 0; m < 4; ++m) dst##8[m] = PG8_LD8(pA + PG8_SA(b, h) + m * 2048); } else { \
        _Pragma("unroll") for (int m = 0; m < 4; ++m) _Pragma("unroll") for (int k = 0; k < 2; ++k) dst[m][k] = *(const LAS bf16x8*)(pA + PG8_SA(b, h) + m * 2048 + k * 1024); } } while (0)
#define PG8_LDB(dst, b, h) do { if constexpr (VAR == 4 || VAR == 5) { _Pragma("unroll") for (int n = 0; n < 2; ++n) _Pragma("unroll") for (int k = 0; k < 2; ++k) asm volatile("" : "+v"(dst[n][k])); } else if constexpr (FP8) { _Pragma("unroll") for (int n = 0; n < 2; ++n) dst##8[n] = PG8_LD8(pB + PG8_SBR(b, h) + n * 2048); } else { \
        _Pragma("unroll") for (int n = 0; n < 2; ++n) _Pragma("unroll") for (int k = 0; k < 2; ++k) dst[n][k] = *(const LAS bf16x8*)(pB + PG8_SBR(b, h) + n * 2048 + k * 1024); } } while (0)
#define PG8_MMA(ai, bj, At, Bt) do { __builtin_amdgcn_s_setprio(1); if constexpr (VAR == 2) { _Pragma("unroll") for (int m = 0; m < 4; ++m) _Pragma("unroll") for (int k = 0; k < 2; ++k) asm volatile("" :: "v"(At[m][k])); _Pragma("unroll") for (int n = 0; n < 2; ++n) _Pragma("unroll") for (int k = 0; k < 2; ++k) asm volatile("" :: "v"(Bt[n][k])); } else if constexpr (FP8) { _Pragma("unroll") for (int m = 0; m < 4; ++m) _Pragma("unroll") for (int n = 0; n < 2; ++n) \
            acc[ai][bj][m][n] = __builtin_amdgcn_mfma_scale_f32_16x16x128_f8f6f4(Bt##8[n], At##8[m], acc[ai][bj][m][n], 0, 0, 0, 0x7f7f7f7f, 0, 0x7f7f7f7f); } else { \
        _Pragma("unroll") for (int m = 0; m < 4; ++m) _Pragma("unroll") for (int n = 0; n < 2; ++n) _Pragma("unroll") for (int k = 0; k < 2; ++k) \
        acc[ai][bj][m][n] = __builtin_amdgcn_mfma_f32_16x16x32_bf16(Bt[n][k], At[m][k], acc[ai][bj][m][n], 0, 0, 0); } __builtin_amdgcn_s_setprio(0); } while (0)
#define PG8_WAIT_V(n) asm volatile("s_waitcnt vmcnt(" #n ")" ::: "memory")
#define PG8_WAIT_L(n) asm volatile("s_waitcnt lgkmcnt(" #n ")" ::: "memory")
#define PG8_BAR __builtin_amdgcn_s_barrier()
#define PG8_SCHED __builtin_amdgcn_sched_barrier(0)
    Unit cur, nxt; int ui = 0;
    if (!S.next(0, cur)) return;
    float sv_ = 0.f; LAS float* const rsl_ = (LAS float*)(lds + STAGE_BYTES);
    unsigned cpk = 0u;
    if constexpr (Sched::GATHER) { int ids[4]; int R0, C0, R1, C1; stage_rc(tid * 16, R0, C0); stage_rc(tid * 16 + 8192, R1, C1); S.gather_ids(cur, R0, R1, ids);
        cpk = (unsigned)(C0 * 2) | ((unsigned)(C1 * 2) << 16);
#pragma unroll
        for (int h = 0; h < 2; ++h) voffA[h][0] = (unsigned)ids[h * 2 + 0] | ((unsigned)ids[h * 2 + 1] << 16); }
    f32x4 acc[2][2][4][2];
#pragma unroll
    for (int a = 0; a < 2; ++a)
#pragma unroll
        for (int b = 0; b < 2; ++b)
#pragma unroll
            for (int m = 0; m < 4; ++m)
#pragma unroll
                for (int n = 0; n < 2; ++n) acc[a][b][m][n] = (f32x4){0.f, 0.f, 0.f, 0.f};
    bf16x8 At[4][2], B0[2][2], B1[2][2]; i32x8v At8[4], B08[2], B18[2];
    if constexpr (VAR == 4 || VAR == 5) {
#pragma unroll
        for (int m = 0; m < 4; ++m)
#pragma unroll
            for (int k = 0; k < 2; ++k)
#pragma unroll
                for (int e = 0; e < 8; ++e) { const unsigned hsh = (unsigned)(lane * 8 + e + 64 * (m * 2 + k)) * 2654435761u; At[m][k][e] = (short)(0x3f00u | ((hsh >> 9) & 0xffu) | ((hsh >> 3) & 0x8000u));
                    if (m < 2) { B0[m][k][e] = (short)(0x3f00u | ((hsh >> 17) & 0xffu) | ((hsh >> 5) & 0x8000u)); B1[m][k][e] = (short)(0x3f00u | ((hsh >> 21) & 0xffu) | ((hsh >> 7) & 0x8000u)); } } }
    unsigned cA = S.a_base(cur), cB = S.b_base(cur);
    PG8_STAGE(PG8_SB(0, 0), cB, voffB); PG8_STAGE(PG8_SB(0, 1), cB + hstep, voffB); PG8_STAGE_A(PG8_SA(0, 0), cA, 0); PG8_STAGE_A(PG8_SA(0, 1), cA, 1);
    if (wr == 1) PG8_BAR;
    PG8_WAIT_V(2); PG8_BAR;
    PG8_STAGE(PG8_SB(1, 0), cB + kstep, voffB); PG8_STAGE_A(PG8_SA(1, 0), cA + kstep, 0); PG8_STAGE(PG8_SB(1, 1), cB + hstep + kstep, voffB);
    PG8_WAIT_V(6); PG8_BAR;
    for (;;) {
        const bool has_next = S.next(ui + 1, nxt);
        const unsigned nA = has_next ? S.a_base(nxt) : cA, nB = has_next ? S.b_base(nxt) : cB;
        unsigned voffN[2] = {0u, 0u};
#pragma unroll 1
        for (int t = 0; t < nt; t += 2) {
            asm volatile(".p2align 6" : "+v"(pA), "+v"(pB));
            if constexpr (Epi::STASH) { if (t == 2) { const int t2_ = wid * 64 + lane_now(); if (t2_ < 256) sv_ = E.stash_load(cur, t2_); }
                                        else if (t == 4) { const int t2_ = wid * 64 + lane_now(); if (t2_ < 256) rsl_[t2_] = sv_; } }
            const bool last = (t == nt - 2);
            const unsigned a1 = cA + (unsigned)(t + 1) * kstep;
            const unsigned a2 = last ? nA : cA + (unsigned)(t + 2) * kstep, b2 = last ? nB : cB + (unsigned)(t + 2) * kstep;
            const unsigned a3 = a2 + kstep, b3 = b2 + kstep;
            if constexpr (Sched::GATHER) { if (t == nt - 4 && has_next) { int ids[4]; int R0, C0, R1, C1; const int tid2 = wid * 64 + lane_now(); stage_rc(tid2 * 16, R0, C0); stage_rc(tid2 * 16 + 8192, R1, C1); S.gather_ids(nxt, R0, R1, ids);
#pragma unroll
                for (int h = 0; h < 2; ++h) voffN[h] = (unsigned)ids[h * 2 + 0] | ((unsigned)ids[h * 2 + 1] << 16); } }
            PG8_LDB(B0, 0, 0); PG8_LDB(B1, 0, 1); PG8_SCHED; PG8_LDA(At, 0, 0); PG8_STAGE_A(PG8_SA(1, 1), a1, 1);
            if constexpr (Sched::GATHER) { if (last && has_next) { voffA[0][0] = voffN[0]; voffA[1][0] = voffN[1]; } }
            PG8_WAIT_V(8); PG8_WAIT_L(0); PG8_BAR; PG8_MMA(0, 0, At, B0); PG8_MMA(0, 1, At, B1); PG8_BAR; PG8_SCHED;
            PG8_LDA(At, 0, 1); PG8_STAGE(PG8_SB(0, 0), b2, voffB); PG8_STAGE(PG8_SB(0, 1), b2 + hstep, voffB); PG8_STAGE_A(PG8_SA(0, 0), a2, 0);
            PG8_WAIT_V(8); PG8_WAIT_L(0); PG8_BAR; PG8_MMA(1, 0, At, B0); PG8_MMA(1, 1, At, B1); PG8_BAR; PG8_SCHED;
            PG8_LDB(B0, 1, 0); PG8_LDB(B1, 1, 1); PG8_SCHED; PG8_LDA(At, 1, 0); PG8_STAGE_A(PG8_SA(0, 1), a2, 1);
            PG8_WAIT_V(8); PG8_WAIT_L(0); PG8_BAR; PG8_MMA(0, 0, At, B0); PG8_MMA(0, 1, At, B1); PG8_BAR; PG8_SCHED;
            PG8_LDA(At, 1, 1); PG8_STAGE(PG8_SB(1, 0), b3, voffB); PG8_STAGE(PG8_SB(1, 1), b3 + hstep, voffB); PG8_STAGE_A(PG8_SA(1, 0), a3, 0);
            PG8_WAIT_V(8); PG8_WAIT_L(0); PG8_BAR; PG8_MMA(1, 0, At, B0); PG8_MMA(1, 1, At, B1); PG8_BAR; PG8_SCHED;
        }
        if constexpr (ALIGN_EPI) { if (wr == 0) PG8_BAR; }
        { const int le_ = lane_now(); E(acc, cur, wr, wc, le_ & 15, le_ >> 4, rsl_); }
        if (!has_next) break;
#pragma unroll
        for (int a = 0; a < 2; ++a)
#pragma unroll
            for (int b = 0; b < 2; ++b)
#pragma unroll
                for (int m = 0; m < 4; ++m)
#pragma unroll
                    for (int n = 0; n < 2; ++n) acc[a][b][m][n] = (f32x4){0.f, 0.f, 0.f, 0.f};
        cur = nxt; cA = nA; cB = nB; ++ui;
        if constexpr (ALIGN_EPI) { if (wr == 1) PG8_BAR; }
    }
    PG8_WAIT_V(0);
    if constexpr (!ALIGN_EPI) { if (wr == 0) PG8_BAR; }
    PG8_BAR;
#undef PG8_SA
#undef PG8_SB
#undef PG8_SBR
#undef PG8_STAGE
#undef PG8_STAGE_R
#undef PG8_STAGE_A
#undef PG8_LDA
#undef PG8_LD8
#undef PG8_LDB
#undef PG8_MMA
#undef PG8_WAIT_V
#undef PG8_WAIT_L
#undef PG8_BAR
#undef PG8_SCHED
}
}
using pg8::Unit;

__device__ __forceinline__ float rstd_of(float ss) { return 1.0f / sqrtf(ss * (1.0f / D) + RMS_EPS); }
typedef unsigned long long rss_t;
__device__ __forceinline__ float rstd_fx(rss_t s) { return rstd_of((float)((double)s * (1.0 / 16777216.0))); }
__device__ __forceinline__ rss_t rss_fx(float ss) { return (rss_t)__float2ull_rn(ss * 16777216.0f); }

struct EpiInA {
    static constexpr bool STASH = true;
    __device__ __forceinline__ float stash_load(const Unit& u, int lrow) const { return rstd_fx(rowss[u.pm * 256 + lrow]); }
    bf16_t* U; bf16_t* Q; const rss_t* rowss;
    __device__ __forceinline__ void operator()(const f32x4 (&acc)[2][2][4][2], const Unit& u, int wr, int wc, int fr, int fq, const LAS float* rsl) const {
        const int row0 = u.pm * 256 + wr * 64 + fr, col0 = u.pn * 256 + wc * 32 + 8 * fq;
        float rsq[8];
#pragma unroll
        for (int i = 0; i < 8; ++i) rsq[i] = rsl[wr * 64 + fr + (i >> 2) * 128 + (i & 3) * 16];
#pragma unroll
        for (int ai = 0; ai < 2; ++ai)
#pragma unroll
            for (int m = 0; m < 4; ++m) { const int row = row0 + ai * 128 + m * 16; const float rs = rsq[ai * 4 + m];
#pragma unroll
                for (int bj = 0; bj < 2; ++bj) { const int c = col0 + bj * 128; const f32x4 v0 = acc[ai][bj][m][0] * rs, v1 = acc[ai][bj][m][1] * rs;
                    u32x4 w; w.x = cvt_pk_bf16(v0[0], v0[1]); w.y = cvt_pk_bf16(v0[2], v0[3]); w.z = cvt_pk_bf16(v1[0], v1[1]); w.w = cvt_pk_bf16(v1[2], v1[3]);
                    if (c < CS) { const int g = c >> 4, hf = (c >> 3) & 1, b = row >> 12, t = row & 4095; *(u32x4*)(U + (((size_t)(b * S5G + g) * SEQ + t) * 16 + 8 * hf)) = w; }
                    else *(u32x4*)(Q + (size_t)row * CM + (c - CS)) = w; } }
    }
};
struct EpiBf16 {
    static constexpr bool STASH = true;
    __device__ __forceinline__ float stash_load(const Unit& u, int lrow) const { return rowss ? rstd_fx(rowss[u.pm * 256 + lrow]) : 1.0f; }
    bf16_t* O; int ldc; const rss_t* rowss; bf16_t* Q; int qcol0;
    __device__ __forceinline__ void operator()(const f32x4 (&acc)[2][2][4][2], const Unit& u, int wr, int wc, int fr, int fq, const LAS float* rsl) const {
        const int row0 = u.pm * 256 + wr * 64 + fr, col0 = u.pn * 256 + wc * 32 + 8 * fq;
        float rsv8[8];
#pragma unroll
        for (int i = 0; i < 8; ++i) rsv8[i] = rsl[wr * 64 + fr + (i >> 2) * 128 + (i & 3) * 16];
#pragma unroll
        for (int ai = 0; ai < 2; ++ai)
#pragma unroll
            for (int m = 0; m < 4; ++m) { const int row = row0 + ai * 128 + m * 16; const float rs = rsv8[ai * 4 + m];
#pragma unroll
                for (int bj = 0; bj < 2; ++bj) { const int c = col0 + bj * 128; const f32x4 v0 = acc[ai][bj][m][0] * rs, v1 = acc[ai][bj][m][1] * rs;
                    u32x4 w; w.x = cvt_pk_bf16(v0[0], v0[1]); w.y = cvt_pk_bf16(v0[2], v0[3]); w.z = cvt_pk_bf16(v1[0], v1[1]); w.w = cvt_pk_bf16(v1[2], v1[3]);
                    if (Q && c >= qcol0) *(u32x4*)(Q + (size_t)row * CM + (c - qcol0)) = w;
                    else *(u32x4*)(O + (size_t)row * ldc + c) = w; } }
    }
};
struct EpiRes {
    static constexpr bool STASH = false;
    const float* XinF; const bf16_t* XinB; bf16_t* H; rss_t* rowss; unsigned char* H8;
    __device__ __forceinline__ void operator()(const f32x4 (&acc)[2][2][4][2], const Unit& u, int wr, int wc, int fr, int fq, const LAS float* rsl) const {
        const int row0 = u.pm * 256 + wr * 64 + fr, col0 = u.pn * 256 + wc * 32 + 8 * fq;
#pragma unroll
        for (int ai = 0; ai < 2; ++ai) {
            f32x4 xv[4][2][2];
            if (XinF) {
#pragma unroll
                for (int m = 0; m < 4; ++m)
#pragma unroll
                    for (int bj = 0; bj < 2; ++bj) { const size_t o = (size_t)(row0 + ai * 128 + m * 16) * D + col0 + bj * 128; xv[m][bj][0] = *(const f32x4*)(XinF + o); xv[m][bj][1] = *(const f32x4*)(XinF + o + 4); }
            } else { u32x4 xb[4][2];
#pragma unroll
                for (int m = 0; m < 4; ++m)
#pragma unroll
                    for (int bj = 0; bj < 2; ++bj) xb[m][bj] = *(const u32x4*)(XinB + (size_t)(row0 + ai * 128 + m * 16) * D + col0 + bj * 128);
#pragma unroll
                for (int m = 0; m < 4; ++m)
#pragma unroll
                    for (int bj = 0; bj < 2; ++bj) { const u32x4 w = xb[m][bj]; xv[m][bj][0] = (f32x4){bflo(w.x), bfhi(w.x), bflo(w.y), bfhi(w.y)}; xv[m][bj][1] = (f32x4){bflo(w.z), bfhi(w.z), bflo(w.w), bfhi(w.w)}; } }
            __builtin_amdgcn_sched_barrier(0);
            float ss4[4];
#pragma unroll
            for (int m = 0; m < 4; ++m) { const int row = row0 + ai * 128 + m * 16; float ss = 0.f;
#pragma unroll
                for (int bj = 0; bj < 2; ++bj) { const size_t o = (size_t)row * D + col0 + bj * 128;
                    const f32x4 s0 = acc[ai][bj][m][0] + xv[m][bj][0], s1 = acc[ai][bj][m][1] + xv[m][bj][1];
                    u32x4 w; w.x = cvt_pk_bf16(s0[0], s0[1]); w.y = cvt_pk_bf16(s0[2], s0[3]); w.z = cvt_pk_bf16(s1[0], s1[1]); w.w = cvt_pk_bf16(s1[2], s1[3]);
                    *(u32x4*)(H + o) = w;
                    const f32x4 v0 = {bflo(w.x), bfhi(w.x), bflo(w.y), bfhi(w.y)}, v1 = {bflo(w.z), bfhi(w.z), bflo(w.w), bfhi(w.w)};
                    if (H8) *(u32x2*)(H8 + o) = cvt8_fp8(v0 * F8_X, v1 * F8_X);
                    ss += (v0[0] * v0[0] + v0[1] * v0[1]) + (v0[2] * v0[2] + v0[3] * v0[3]) + (v1[0] * v1[0] + v1[1] * v1[1]) + (v1[2] * v1[2] + v1[3] * v1[3]); }
                ss4[m] = ss; }
#pragma unroll
            for (int m = 0; m < 4; ++m) { float ss = ss4[m]; ss += __shfl_xor(ss, 16); ss += __shfl_xor(ss, 32);
                if (fq == 0) atomicAdd(rowss + row0 + ai * 128 + m * 16, rss_fx(ss)); }
            __builtin_amdgcn_sched_barrier(0); }
    }
};
struct EpiSwiglu {
    static constexpr bool STASH = true;
    __device__ __forceinline__ float stash_load(const Unit& u, int lrow) const { return rsv ? rsv[u.rb + lrow] : rstd_fx(rowss[u.pm * 256 + lrow]); }
    bf16_t* O; int ldo; const rss_t* rowss; const float* rsv; int skip;
    __device__ __forceinline__ void operator()(const f32x4 (&acc)[2][2][4][2], const Unit& u, int wr, int wc, int fr, int fq, const LAS float* rsl) const {
        if (skip) return;
        const int lrow0 = wr * 64 + fr, col0 = u.pn * 128 + wc * 32 + 8 * fq;
        float rs8[8];
#pragma unroll
        for (int i = 0; i < 8; ++i) { const int lrow = lrow0 + (i >> 2) * 128 + (i & 3) * 16; rs8[i] = (skip == 3) ? 1.0f : rsl[lrow]; }
#pragma unroll
        for (int ai = 0; ai < 2; ++ai)
#pragma unroll
            for (int m = 0; m < 4; ++m) { const int lrow = lrow0 + ai * 128 + m * 16;
                const float rs = rs8[ai * 4 + m]; const size_t orow = rsv ? ((size_t)u.e + lrow) : (size_t)(u.pm * 256 + lrow);
                const f32x4 g0 = acc[ai][0][m][0] * rs, g1 = acc[ai][0][m][1] * rs, u0 = acc[ai][1][m][0] * rs, u1 = acc[ai][1][m][1] * rs;
                u32x4 w; w.x = cvt_pk_bf16(silu_(g0[0]) * u0[0], silu_(g0[1]) * u0[1]); w.y = cvt_pk_bf16(silu_(g0[2]) * u0[2], silu_(g0[3]) * u0[3]);
                w.z = cvt_pk_bf16(silu_(g1[0]) * u1[0], silu_(g1[1]) * u1[1]); w.w = cvt_pk_bf16(silu_(g1[2]) * u1[2], silu_(g1[3]) * u1[3]);
                if (skip == 3) { w.x = cvt_pk_bf16(g0[0] * u0[0], g0[1] * u0[1]); w.y = cvt_pk_bf16(g0[2] * u0[2], g0[3] * u0[3]); w.z = cvt_pk_bf16(g1[0] * u1[0], g1[1] * u1[1]); w.w = cvt_pk_bf16(g1[2] * u1[2], g1[3] * u1[3]); }
                if (skip == 2) asm volatile("" :: "v"(w)); else if (skip == 4) *(u32x4*)(O + ((size_t)blockIdx.x * 256 + lrow) * 128 + (col0 & 127)) = w; else
                *(u32x4*)(O + orow * ldo + col0) = w; }
    }
};
struct EpiSwigluF8 {
    static constexpr bool STASH = true;
    __device__ __forceinline__ float stash_load(const Unit& u, int lrow) const { return rsv[u.rb + lrow] * (1.0f / (F8_X * F8_WGU)); }
    unsigned char* O8; int ldo; const float* rsv;
    __device__ __forceinline__ void operator()(const f32x4 (&acc)[2][2][4][2], const Unit& u, int wr, int wc, int fr, int fq, const LAS float* rsl) const {
        const int lrow0 = wr * 64 + fr, col0 = u.pn * 128 + wc * 32 + 8 * fq;
        float rs8[8];
#pragma unroll
        for (int i = 0; i < 8; ++i) rs8[i] = rsl[lrow0 + (i >> 2) * 128 + (i & 3) * 16];
#pragma unroll
        for (int ai = 0; ai < 2; ++ai)
#pragma unroll
            for (int m = 0; m < 4; ++m) { const int lrow = lrow0 + ai * 128 + m * 16; const float rs = rs8[ai * 4 + m];
                f32x4 a0, a1;
#pragma unroll
                for (int e = 0; e < 4; ++e) { a0[e] = silu_(acc[ai][0][m][0][e] * rs) * (acc[ai][1][m][0][e] * rs) * F8_ACT; a1[e] = silu_(acc[ai][0][m][1][e] * rs) * (acc[ai][1][m][1][e] * rs) * F8_ACT; }
                *(u32x2*)(O8 + ((size_t)u.e + lrow) * ldo + col0) = cvt8_fp8(a0, a1);
                asm volatile("" ::: "memory"); }
    }
};
struct EpiSlot {
    static constexpr bool STASH = false;
    bf16_t* O;
    __device__ __forceinline__ void operator()(const f32x4 (&acc)[2][2][4][2], const Unit& u, int wr, int wc, int fr, int fq, const LAS float* rsl) const {
        const int lrow0 = wr * 64 + fr, col0 = u.pn * 256 + wc * 32 + 8 * fq;
#pragma unroll
        for (int ai = 0; ai < 2; ++ai)
#pragma unroll
            for (int m = 0; m < 4; ++m) { const size_t orow = (size_t)u.e + lrow0 + ai * 128 + m * 16;
#pragma unroll
                for (int bj = 0; bj < 2; ++bj) { const float sc = 1.0f / (F8_ACT * F8_WD); const f32x4 v0 = acc[ai][bj][m][0] * sc, v1 = acc[ai][bj][m][1] * sc;
                    u32x4 w; w.x = cvt_pk_bf16(v0[0], v0[1]); w.y = cvt_pk_bf16(v0[2], v0[3]); w.z = cvt_pk_bf16(v1[0], v1[1]); w.w = cvt_pk_bf16(v1[2], v1[3]);
                    *(u32x4*)(O + orow * D + col0 + bj * 128) = w; } }
    }
};

struct MoeGuSched {
    static constexpr bool GATHER = true;
    pg8::TileOrder o; const char* A; const char* W; const int* list; const LAS int* tab; int tile0;
    __device__ __forceinline__ bool next(int i, Unit& u) const {
        if (!o.tile(i, u.pm, u.pn)) return false;
        const int gt = tile0 + u.pm; int e = 0;
#pragma unroll
        for (int k = 1; k < 8; ++k) e += (gt >= tab[k]) ? 1 : 0;
        e = __builtin_amdgcn_readfirstlane(e);
        u.rb = __builtin_amdgcn_readfirstlane(e * 32768 + (gt - tab[e]) * 256); u.e = u.pm * 256; return true;
    }
    __device__ __forceinline__ const char* a_ptr() const { return A; }
    __device__ __forceinline__ const char* b_ptr() const { return W; }
    __device__ __forceinline__ unsigned a_base(const Unit&) const { return 0u; }
    __device__ __forceinline__ unsigned b_base(const Unit& u) const { return ((unsigned)(u.rb >> 15) * (2 * FE) + (unsigned)u.pn * 256) * (unsigned)D; }
    __device__ __forceinline__ void gather_ids(const Unit& u, int R0, int R1, int (&ids)[4]) const {
        const int e = u.rb >> 15, rank0 = u.rb & 32767, cnt = __builtin_amdgcn_readfirstlane(tab[16 + e]);
#pragma unroll
        for (int h = 0; h < 2; ++h) { const int r0 = R0 + 128 * h, r1 = R1 + 128 * h;
            ids[h * 2 + 0] = (rank0 + r0 < cnt) ? list[u.rb + r0] : 0; ids[h * 2 + 1] = (rank0 + r1 < cnt) ? list[u.rb + r1] : 0; }
    }
};
struct MoeDownSched {
    static constexpr bool GATHER = false;
    pg8::TileOrder o; const char* A; const char* W; const LAS int* tab; int tile0;
    __device__ __forceinline__ bool next(int i, Unit& u) const {
        if (!o.tile(i, u.pm, u.pn)) return false;
        const int gt = tile0 + u.pm; int e = 0;
#pragma unroll
        for (int k = 1; k < 8; ++k) e += (gt >= tab[k]) ? 1 : 0;
        u.rb = __builtin_amdgcn_readfirstlane(e); u.e = gt * 256; return true;
    }
    __device__ __forceinline__ const char* a_ptr() const { return A; }
    __device__ __forceinline__ const char* b_ptr() const { return W; }
    __device__ __forceinline__ unsigned a_base(const Unit& u) const { return (unsigned)u.pm * (unsigned)(256 * FE); }
    __device__ __forceinline__ unsigned b_base(const Unit& u) const { return ((unsigned)u.rb * D + (unsigned)u.pn * 256) * (unsigned)FE; }
    __device__ __forceinline__ void gather_ids(const Unit&, int, int, int (&)[4]) const {}
};

constexpr int TAIL_SPLIT = 7, TAIL_K = FE / TAIL_SPLIT;
struct MoeDownTailSched {
    static constexpr bool GATHER = false;
    pg8::TileOrder o; const char* A; const char* W; const LAS int* tab; int tile0;
    __device__ __forceinline__ bool next(int i, Unit& u) const {
        int cn; if (!o.tile(i, u.pm, cn)) return false;
        const int gt = tile0 + u.pm; int e = 0;
#pragma unroll
        for (int k = 1; k < 8; ++k) e += (gt >= tab[k]) ? 1 : 0;
        u.pn = cn & 3; u.rb = __builtin_amdgcn_readfirstlane(e) * 8 + (cn >> 2); u.e = u.pm * 256; return true;
    }
    __device__ __forceinline__ const char* a_ptr() const { return A; }
    __device__ __forceinline__ const char* b_ptr() const { return W; }
    __device__ __forceinline__ unsigned a_base(const Unit& u) const { return (unsigned)u.pm * (unsigned)(256 * FE) + (unsigned)(u.rb & 7) * TAIL_K; }
    __device__ __forceinline__ unsigned b_base(const Unit& u) const { return ((unsigned)(u.rb >> 3) * D + (unsigned)u.pn * 256) * (unsigned)FE + (unsigned)(u.rb & 7) * TAIL_K; }
    __device__ __forceinline__ void gather_ids(const Unit&, int, int, int (&)[4]) const {}
};
struct EpiSlotPart {
    static constexpr bool STASH = false;
    bf16_t* P;
    __device__ __forceinline__ void operator()(const f32x4 (&acc)[2][2][4][2], const Unit& u, int wr, int wc, int fr, int fq, const LAS float* rsl) const {
        const int lrow0 = wr * 64 + fr, col0 = u.pn * 256 + wc * 32 + 8 * fq; bf16_t* base = P + (size_t)(u.rb & 7) * 2048 * D;
#pragma unroll
        for (int ai = 0; ai < 2; ++ai)
#pragma unroll
            for (int m = 0; m < 4; ++m) { const size_t orow = (size_t)u.e + lrow0 + ai * 128 + m * 16;
#pragma unroll
                for (int bj = 0; bj < 2; ++bj) { const float sc = 1.0f / (F8_ACT * F8_WD); const f32x4 v0 = acc[ai][bj][m][0] * sc, v1 = acc[ai][bj][m][1] * sc;
                    u32x4 w; w.x = cvt_pk_bf16(v0[0], v0[1]); w.y = cvt_pk_bf16(v0[2], v0[3]); w.z = cvt_pk_bf16(v1[0], v1[1]); w.w = cvt_pk_bf16(v1[2], v1[3]);
                    *(u32x4*)(base + orow * D + col0 + bj * 128) = w; } }
    }
};

__device__ __forceinline__ void tr_item(const float* W, int K, int N, bf16_t* WT, const float* gain, int mode, LAS float* scr, int item, int lane, float f8s = 0.f) {
    const int nblk = N / 32, kb = item / nblk, nb = item % nblk, k0 = 64 * kb, n0 = 32 * nb;
    {
        const int r8 = lane >> 3, c4 = (lane & 7) * 4; f32x4 v[8]; float gn[8];
#pragma unroll
        for (int i = 0; i < 8; ++i) { v[i] = *(const f32x4*)(W + (size_t)(k0 + 8 * i + r8) * N + n0 + c4); gn[i] = gain ? gain[k0 + 8 * i + r8] : 1.0f; }
#pragma unroll
        for (int i = 0; i < 8; ++i) { LAS float* d = scr + (8 * i + r8) * 33 + c4; d[0] = v[i][0] * gn[i]; d[1] = v[i][1] * gn[i]; d[2] = v[i][2] * gn[i]; d[3] = v[i][3] * gn[i]; } }
    LDS_WAIT(); asm volatile("" ::: "memory");
    const int c = lane & 7;
#pragma unroll
    for (int j = 0; j < 4; ++j) { const int n = (lane >> 3) + 8 * j; const LAS float* s = scr + (8 * c) * 33 + n;
        u32x4 o; o.x = cvt_pk_bf16(s[0 * 33], s[1 * 33]); o.y = cvt_pk_bf16(s[2 * 33], s[3 * 33]); o.z = cvt_pk_bf16(s[4 * 33], s[5 * 33]); o.w = cvt_pk_bf16(s[6 * 33], s[7 * 33]);
        const int nn = n0 + n; const int row = (mode == 0) ? nn : (((nn >> 7) << 8) + (nn & 127) + (mode == 2 ? 128 : 0));
        if (f8s != 0.f) { const f32x4 a = {s[0 * 33] * f8s, s[1 * 33] * f8s, s[2 * 33] * f8s, s[3 * 33] * f8s}, b = {s[4 * 33] * f8s, s[5 * 33] * f8s, s[6 * 33] * f8s, s[7 * 33] * f8s};
            *(u32x2*)((unsigned char*)WT + (size_t)row * K + k0 + 8 * c) = cvt8_fp8(a, b); }
        else *(u32x4*)(WT + (size_t)row * K + k0 + 8 * c) = o; }
    LDS_WAIT(); asm volatile("" ::: "memory");
}
struct TrJob { const float* W; bf16_t* WT; const float* gain; int K, N, mode, items; float f8s; };
struct TrRegs { f32x4 v[8]; float gn[8]; };
__device__ __forceinline__ void tr_load(const TrJob& jb, int item, int lane, TrRegs& R) {
    const int nblk = jb.N / 32, kb = item / nblk, nb = item % nblk, k0 = 64 * kb, n0 = 32 * nb, r8 = lane >> 3, c4 = (lane & 7) * 4;
#pragma unroll
    for (int i = 0; i < 8; ++i) { R.v[i] = *(const f32x4*)(jb.W + (size_t)(k0 + 8 * i + r8) * jb.N + n0 + c4); R.gn[i] = jb.gain ? jb.gain[k0 + 8 * i + r8] : 1.0f; }
}
__device__ __forceinline__ void tr_fin(const TrJob& jb, int item, LAS float* scr, int lane, const TrRegs& R) {
    const int nblk = jb.N / 32, kb = item / nblk, nb = item % nblk, k0 = 64 * kb, n0 = 32 * nb, r8 = lane >> 3, c4 = (lane & 7) * 4;
#pragma unroll
    for (int i = 0; i < 8; ++i) { LAS float* d = scr + (8 * i + r8) * 33 + c4; d[0] = R.v[i][0] * R.gn[i]; d[1] = R.v[i][1] * R.gn[i]; d[2] = R.v[i][2] * R.gn[i]; d[3] = R.v[i][3] * R.gn[i]; }
    LDS_WAIT(); asm volatile("" ::: "memory");
    const int c = lane & 7;
#pragma unroll
    for (int j = 0; j < 4; ++j) { const int n = (lane >> 3) + 8 * j; const LAS float* s = scr + (8 * c) * 33 + n;
        const int nn = n0 + n; const int row = (jb.mode == 0) ? nn : (((nn >> 7) << 8) + (nn & 127) + (jb.mode == 2 ? 128 : 0));
        const float f8s = jb.f8s; const f32x4 a = {s[0 * 33] * f8s, s[1 * 33] * f8s, s[2 * 33] * f8s, s[3 * 33] * f8s}, b = {s[4 * 33] * f8s, s[5 * 33] * f8s, s[6 * 33] * f8s, s[7 * 33] * f8s};
        *(u32x2*)((unsigned char*)jb.WT + (size_t)row * jb.K + k0 + 8 * c) = cvt8_fp8(a, b); }
    LDS_WAIT(); asm volatile("" ::: "memory");
}


struct Args { const float* in[N_IN]; float* out; unsigned char* ws; int ph_lo, ph_hi, pass_lo, pass_hi; };

__device__ __forceinline__ void attn_naive(LAS unsigned char* lds, const bf16_t* Q, const bf16_t* KV, bf16_t* CAT, int bx, int G, int tid) {
    LAS float* Ks = (LAS float*)lds; LAS float* Vs = Ks + 256 * 64;
    for (int item = bx; item < NB * NH_MEM * 8; item += G) {
        const int b = item >> 5, h = (item >> 3) & 3, qb = item & 7;
#pragma unroll 4
        for (int i = 0; i < 32; ++i) { const int idx = tid + 512 * i, m = idx >> 6, d = idx & 63;
            const bf16_t* kr = KV + (size_t)(b * MEML + m) * 512 + h * 64 + d;
            Ks[idx] = bf2f(kr[0]); Vs[idx] = bf2f(kr[256]); }
        __syncthreads();
        const int row = b * SEQ + qb * 512 + tid;
        float q[64], o[64];
        { const u32x4* qp = (const u32x4*)(Q + (size_t)row * CM + h * 64);
#pragma unroll
          for (int i = 0; i < 8; ++i) { const u32x4 w = qp[i];
              q[8 * i + 0] = bflo(w.x) * 0.125f; q[8 * i + 1] = bfhi(w.x) * 0.125f; q[8 * i + 2] = bflo(w.y) * 0.125f; q[8 * i + 3] = bfhi(w.y) * 0.125f;
              q[8 * i + 4] = bflo(w.z) * 0.125f; q[8 * i + 5] = bfhi(w.z) * 0.125f; q[8 * i + 6] = bflo(w.w) * 0.125f; q[8 * i + 7] = bfhi(w.w) * 0.125f; } }
#pragma unroll
        for (int d = 0; d < 64; ++d) o[d] = 0.f;
        float mx = -1e30f, l = 0.f;
#pragma unroll 1
        for (int key = 0; key < MEML; ++key) {
            const LAS f32x4* kr = (const LAS f32x4*)(Ks + key * 64); float sc = 0.f;
#pragma unroll
            for (int d4 = 0; d4 < 16; ++d4) { const f32x4 kv = kr[d4]; sc += q[4 * d4] * kv[0] + q[4 * d4 + 1] * kv[1] + q[4 * d4 + 2] * kv[2] + q[4 * d4 + 3] * kv[3]; }
            const float mn = fmaxf(mx, sc), alpha = __expf(mx - mn), p = __expf(sc - mn); mx = mn; l = l * alpha + p;
            const LAS f32x4* vr = (const LAS f32x4*)(Vs + key * 64);
#pragma unroll
            for (int d4 = 0; d4 < 16; ++d4) { const f32x4 vv = vr[d4]; o[4 * d4] = o[4 * d4] * alpha + p * vv[0]; o[4 * d4 + 1] = o[4 * d4 + 1] * alpha + p * vv[1]; o[4 * d4 + 2] = o[4 * d4 + 2] * alpha + p * vv[2]; o[4 * d4 + 3] = o[4 * d4 + 3] * alpha + p * vv[3]; }
        }
        const float il = 1.0f / l;
        u32x4* op = (u32x4*)(CAT + (size_t)row * D + CS + h * 64);
#pragma unroll
        for (int i = 0; i < 8; ++i) { u32x4 w; w.x = cvt_pk_bf16(o[8 * i] * il, o[8 * i + 1] * il); w.y = cvt_pk_bf16(o[8 * i + 2] * il, o[8 * i + 3] * il);
            w.z = cvt_pk_bf16(o[8 * i + 4] * il, o[8 * i + 5] * il); w.w = cvt_pk_bf16(o[8 * i + 6] * il, o[8 * i + 7] * il); op[i] = w; }
        __syncthreads();
    }
}

__device__ __forceinline__ void s5_naive(const Args& a, LAS unsigned char* lds, const bf16_t* U, bf16_t* CAT, int bx, int G, int wave, int lane) {
    LAS float* xs = (LAS float*)(lds + wave * 1024);
    for (int it = bx + G * wave; it < NB * S5G; it += G * NWAVES) {
        const int b = it / S5G, g = it % S5G, p = lane;
        const double dt = exp((double)a.in[I_LOG_DT][g]), lr = a.in[I_LAM_RE][g * S5P + p], li = a.in[I_LAM_IM][g * S5P + p];
        const double mag = exp(lr * dt), ang = li * dt, abr_d = mag * cos(ang), abi_d = mag * sin(ang);
        const double nre = abr_d - 1.0, nim = abi_d, den = lr * lr + li * li, zr = (nre * lr + nim * li) / den, zi = (nim * lr - nre * li) / den;
        const float abr = (float)abr_d, abi = (float)abi_d;
        float bbr[16], bbi[16], cre[16], cim[16], wg[16];
#pragma unroll
        for (int j = 0; j < 16; ++j) { const double br = a.in[I_B_RE][(size_t)(g * S5P + p) * 16 + j], bi = a.in[I_B_IM][(size_t)(g * S5P + p) * 16 + j]; bbr[j] = (float)(zr * br - zi * bi); bbi[j] = (float)(zr * bi + zi * br); }
        const int jj = lane & 15, pq = lane >> 4;
#pragma unroll
        for (int q = 0; q < 16; ++q) { cre[q] = a.in[I_C_RE][(size_t)(g * 16 + jj) * S5P + 16 * pq + q]; cim[q] = a.in[I_C_IM][(size_t)(g * 16 + jj) * S5P + 16 * pq + q]; }
#pragma unroll
        for (int j = 0; j < 16; ++j) wg[j] = a.in[I_WGLU][(size_t)(g * 16 + j) * 16 + jj];
        const float dj = a.in[I_S5D][g * 16 + jj], bg = a.in[I_BGLU][g * 16 + jj];
        const bf16_t* up = U + (size_t)(b * S5G + g) * SEQ * 16;
        float xr = 0.f, xi = 0.f;
#pragma unroll 1
        for (int t = 0; t < SEQ; ++t) {
            const u32x4 w0 = *(const u32x4*)(up + (size_t)t * 16), w1 = *(const u32x4*)(up + (size_t)t * 16 + 8);
            float uf[16];
            uf[0] = bflo(w0.x); uf[1] = bfhi(w0.x); uf[2] = bflo(w0.y); uf[3] = bfhi(w0.y); uf[4] = bflo(w0.z); uf[5] = bfhi(w0.z); uf[6] = bflo(w0.w); uf[7] = bfhi(w0.w);
            uf[8] = bflo(w1.x); uf[9] = bfhi(w1.x); uf[10] = bflo(w1.y); uf[11] = bfhi(w1.y); uf[12] = bflo(w1.z); uf[13] = bfhi(w1.z); uf[14] = bflo(w1.w); uf[15] = bfhi(w1.w);
            const float uj = bf2f(up[(size_t)t * 16 + jj]);
            float bur = 0.f, bui = 0.f;
#pragma unroll
            for (int j = 0; j < 16; ++j) { bur += bbr[j] * uf[j]; bui += bbi[j] * uf[j]; }
            const float nxr = abr * xr - abi * xi + bur, nxi = abr * xi + abi * xr + bui; xr = nxr; xi = nxi;
            xs[p] = xr; xs[64 + p] = xi;
            LDS_WAIT(); asm volatile("" ::: "memory");
            float s = 0.f;
#pragma unroll
            for (int q4 = 0; q4 < 4; ++q4) { const f32x4 vr = *(const LAS f32x4*)(xs + 16 * pq + 4 * q4), vi = *(const LAS f32x4*)(xs + 64 + 16 * pq + 4 * q4);
#pragma unroll
                for (int e = 0; e < 4; ++e) s += cre[4 * q4 + e] * vr[e] - cim[4 * q4 + e] * vi[e]; }
            LDS_WAIT(); asm volatile("" ::: "memory");
            s += __shfl_xor(s, 16); s += __shfl_xor(s, 32);
            const float yg = gelu_tanh_(s + dj * uj);
            float z = bg;
#pragma unroll
            for (int j = 0; j < 16; ++j) z += __shfl(yg, j) * wg[j];
            const float o = yg * sigmoidf_(z);
            if (lane < 16) CAT[(size_t)(b * SEQ + t) * D + g * 16 + lane] = f2bf(o);
        }
    }
}

__device__ __forceinline__ void rwkv_prep(const Args& a, LAS unsigned char* lds, const bf16_t* P1, bf16_t* RA, bf16_t* RKK, bf16_t* RLD, bf16_t* RG, int bx, int G, int tid) {
    LAS float* twT = (LAS float*)lds; LAS float* adT = twT + 64 * 16; LAS float* sgT = adT + 64 * 16;
    const float* mu = a.in[I_MU];
    for (int tile = bx; tile < T / 16; tile += G) {
        __syncthreads();
#pragma unroll
        for (int i = 0; i < 8; ++i) { const int idx = tid + 512 * i, tok = idx >> 8, c = idx & 255, row = tile * 16 + tok, t = row & (SEQ - 1);
            const float cur = bf2f(P1[(size_t)row * INB + 2304 + c]), prev = t > 0 ? bf2f(P1[(size_t)(row - 1) * INB + 2304 + c]) : 0.f;
            const float xsv = cur + (prev - cur) * mu[2304 + c];
            if (c < 64) twT[c * 16 + tok] = tanhf(xsv); else if (c < 128) adT[(c - 64) * 16 + tok] = xsv; else sgT[(c - 128) * 16 + tok] = sigmoidf_(xsv); }
        __syncthreads();
        if (tid < 384) {
#pragma unroll 1
            for (int cc = 0; cc < 2; ++cc) { const int c = tid + 384 * cc;
                float aw[16], aa[16], ag[16];
#pragma unroll
                for (int k = 0; k < 16; ++k) { aw[k] = 0.f; aa[k] = 0.f; ag[k] = 0.f; }
#pragma unroll 2
                for (int m = 0; m < 64; ++m) { const float w2v = a.in[I_W2][(size_t)m * CS + c], a2v = a.in[I_A2][(size_t)m * CS + c];
#pragma unroll
                    for (int k4 = 0; k4 < 4; ++k4) { const f32x4 tw = *(const LAS f32x4*)(twT + m * 16 + 4 * k4), ad = *(const LAS f32x4*)(adT + m * 16 + 4 * k4);
#pragma unroll
                        for (int e = 0; e < 4; ++e) { aw[4 * k4 + e] += tw[e] * w2v; aa[4 * k4 + e] += ad[e] * a2v; } } }
#pragma unroll 2
                for (int m = 0; m < 128; ++m) { const float g2v = a.in[I_G2][(size_t)m * CS + c];
#pragma unroll
                    for (int k4 = 0; k4 < 4; ++k4) { const f32x4 sg = *(const LAS f32x4*)(sgT + m * 16 + 4 * k4);
#pragma unroll
                        for (int e = 0; e < 4; ++e) ag[4 * k4 + e] += sg[e] * g2v; } }
                const float w0 = a.in[I_W0][c], a0 = a.in[I_A0][c], kkw = a.in[I_KK][c], muk = mu[CS + c];
#pragma unroll
                for (int k = 0; k < 16; ++k) { const int row = tile * 16 + k, t = row & (SEQ - 1);
                    const float z = -(w0 + aw[k]);
                    const float sp = z > 20.f ? z : log1pf(__expf(z));
                    const float ld = -__expf(-sp - 0.5f);
                    const float av = sigmoidf_(a0 + aa[k]);
                    const float cur = bf2f(P1[(size_t)row * INB + CS + c]), prev = t > 0 ? bf2f(P1[(size_t)(row - 1) * INB + CS + c]) : 0.f;
                    const float kx = (cur + (prev - cur) * muk) * kkw;
                    const float ss = wave_sum(kx * kx);
                    const float kkv = kx / fmaxf(sqrtf(ss), 1e-12f);
                    const size_t o = (size_t)row * CS + c;
                    RA[o] = f2bf(av); RKK[o] = f2bf(kkv); RLD[o] = f2bf(ld); RG[o] = f2bf(ag[k]); }
            }
        }
    }
}

__device__ __forceinline__ void rwkv_naive(const Args& a, LAS unsigned char* lds, const bf16_t* P1, const bf16_t* RA, const bf16_t* RKK, const bf16_t* RLD, const bf16_t* RG, bf16_t* CAT, int bx, int G, int wave, int lane) {
    if (wave != 4) return;
    LAS float* vec = (LAS float*)lds;
    for (int item = bx; item < NB * RH; item += G) {
        const int b = item / RH, h = item % RH, c = h * 64 + lane;
        const float mur = a.in[I_MU][c], muk = a.in[I_MU][CS + c], muv = a.in[I_MU][2 * CS + c], ka = a.in[I_KA][c], rkc = a.in[I_RK][c], lw = a.in[I_LNXW][c], lb = a.in[I_LNXB][c];
        float S[64];
#pragma unroll
        for (int j = 0; j < 64; ++j) S[j] = 0.f;
        float prr = 0.f, prk = 0.f, prv = 0.f;
        const size_t row0 = (size_t)b * SEQ;
        bf16_t n_r = P1[row0 * INB + c], n_k = P1[row0 * INB + CS + c], n_v = P1[row0 * INB + 2 * CS + c], n_a = RA[row0 * CS + c], n_kk = RKK[row0 * CS + c], n_ld = RLD[row0 * CS + c], n_g = RG[row0 * CS + c];
#pragma unroll 1
        for (int t = 0; t < SEQ; ++t) {
            const float pr = bf2f(n_r), pk = bf2f(n_k), pv = bf2f(n_v), av = bf2f(n_a), kkv = bf2f(n_kk), ld = bf2f(n_ld), gv = bf2f(n_g);
            if (t + 1 < SEQ) { const size_t rn = row0 + t + 1; n_r = P1[rn * INB + c]; n_k = P1[rn * INB + CS + c]; n_v = P1[rn * INB + 2 * CS + c]; n_a = RA[rn * CS + c]; n_kk = RKK[rn * CS + c]; n_ld = RLD[rn * CS + c]; n_g = RG[rn * CS + c]; }
            const float r = pr + (prr - pr) * mur, k = pk + (prk - pk) * muk, v = pv + (prv - pv) * muv;
            prr = pr; prk = pk; prv = pv;
            const float kp = k * (1.f + (av - 1.f) * ka), ap = -kkv, bb = kkv * av, w = __expf(ld);
            vec[lane] = r; vec[64 + lane] = w; vec[128 + lane] = kp; vec[192 + lane] = ap; vec[256 + lane] = bb;
            LDS_WAIT(); asm volatile("" ::: "memory");
            float sa = 0.f;
#pragma unroll
            for (int j4 = 0; j4 < 16; ++j4) { const f32x4 x = *(const LAS f32x4*)(vec + 192 + 4 * j4); sa += S[4 * j4] * x[0] + S[4 * j4 + 1] * x[1] + S[4 * j4 + 2] * x[2] + S[4 * j4 + 3] * x[3]; }
            float y = 0.f;
#pragma unroll
            for (int j4 = 0; j4 < 16; ++j4) { const f32x4 wv = *(const LAS f32x4*)(vec + 64 + 4 * j4), bv = *(const LAS f32x4*)(vec + 256 + 4 * j4), kv = *(const LAS f32x4*)(vec + 128 + 4 * j4), rv = *(const LAS f32x4*)(vec + 4 * j4);
#pragma unroll
                for (int e = 0; e < 4; ++e) { const float s = S[4 * j4 + e] * wv[e] + sa * bv[e] + v * kv[e]; S[4 * j4 + e] = s; y += s * rv[e]; } }
            LDS_WAIT(); asm volatile("" ::: "memory");
            const float rkv = wave_sum(r * kp * rkc), bonus = rkv * v;
            const float mean = wave_sum(y) * (1.f / 64.f), dlt = y - mean, var = wave_sum(dlt * dlt) * (1.f / 64.f);
            const float yn = dlt * (1.0f / sqrtf(var + LNX_EPS)) * lw + lb;
            CAT[(row0 + t) * D + c] = f2bf((yn + bonus) * gv);
        }
    }
}

__device__ __forceinline__ void moe_router(const Args& a, const bf16_t* XB, unsigned* ctl, unsigned char* ws, int gw, int NGW, int lane, LAS unsigned char* sm, int wave) {
    int* list = (int*)(ws + WS_ROUTE2 + RT_LIST); float* lrstd = (float*)(ws + WS_ROUTE2 + RT_LRSTD);
    int* toke = (int*)(ws + WS_ROUTE2 + RT_TOKE); int* tokr = (int*)(ws + WS_ROUTE2 + RT_TOKR); float* tokw = (float*)(ws + WS_ROUTE2 + RT_TOKW);
    float wg[16][8];
    {   const float* wr = a.in[I_WR]; const f32x4* gr = (const f32x4*)(a.in[I_NORM_FFN] + D) + lane;
#pragma unroll
        for (int j = 0; j < 4; ++j) { const f32x4 g = gr[64 * j];
#pragma unroll
            for (int i = 0; i < 4; ++i) { const int k = 4 * (lane + 64 * j) + i; const f32x4 w0 = *(const f32x4*)(wr + (size_t)k * 8), w1 = *(const f32x4*)(wr + (size_t)k * 8 + 4);
#pragma unroll
                for (int e = 0; e < 4; ++e) { wg[4 * j + i][e] = g[i] * w0[e]; wg[4 * j + i][4 + e] = g[i] * w1[e]; } } } }
    float br[8];
#pragma unroll
    for (int e = 0; e < 8; ++e) br[e] = a.in[I_BR][e];
    int m_bi = 0, m_si = 0; float m_rs = 0.f, m_w0 = 0.f;
    u32x2 va[4], vb[4];
#define RT_LOAD(v_, r_) do { const u32x2* xr_ = (const u32x2*)(XB + (size_t)(r_) * D) + lane; _Pragma("unroll") for (int j = 0; j < 4; ++j) v_[j] = xr_[64 * j]; } while (0)
#define RT_ROW(v_, i_) do { float lg[8]; float s = 0.f; \
        _Pragma("unroll") for (int e = 0; e < 8; ++e) lg[e] = 0.f; \
        _Pragma("unroll") for (int j = 0; j < 4; ++j) _Pragma("unroll") for (int i = 0; i < 4; ++i) { const unsigned pw_ = (i < 2) ? v_[j].x : v_[j].y; const float hv = (i & 1) ? bfhi(pw_) : bflo(pw_); s += hv * hv; \
            _Pragma("unroll") for (int e = 0; e < 8; ++e) lg[e] += hv * wg[4 * j + i][e]; } \
        wave_sum8(lg); const float rs = rstd_of(wave_sum_fast(s)); \
        _Pragma("unroll") for (int e = 0; e < 8; ++e) lg[e] = lg[e] * rs + br[e]; \
        float bv = lg[0]; int bi = 0; \
        _Pragma("unroll") for (int e = 1; e < 8; ++e) if (lg[e] > bv) { bv = lg[e]; bi = e; } \
        float sv = -3.0e38f; int si = 0; \
        _Pragma("unroll") for (int e = 0; e < 8; ++e) if (e != bi && lg[e] > sv) { sv = lg[e]; si = e; } \
        const float w0 = 1.0f / (1.0f + __expf(sv - bv)); \
        if (lane == (i_)) { m_bi = bi; m_si = si; m_rs = rs; m_w0 = w0; } } while (0)
    int nrow = 0;
    if (gw < T) RT_LOAD(va, gw);
    for (int r = gw; r < T; r += 2 * NGW) {
        const int r2 = r + NGW, r3 = r + 2 * NGW;
        if (r2 < T) RT_LOAD(vb, r2);
        __builtin_amdgcn_sched_barrier(0);
        RT_ROW(va, nrow); ++nrow;
        if (r3 < T) RT_LOAD(va, r3);
        __builtin_amdgcn_sched_barrier(0);
        if (r2 < T) { RT_ROW(vb, nrow); ++nrow; }
    }
#undef RT_LOAD
#undef RT_ROW
    {   LAS int* wcnt = (LAS int*)sm; LAS int* wbase = wcnt + 64;
        const bool act = lane < nrow; int myc = 0; unsigned long long mk[8];
#pragma unroll
        for (int e = 0; e < 8; ++e) { mk[e] = __ballot(act && (m_bi == e || m_si == e)); if (lane == e) myc = __popcll(mk[e]); }
        if (lane < 8) wcnt[wave * 8 + lane] = myc;
        __syncthreads();
        if (wave == 0 && lane < 8) { int tot = 0, pre[8];
#pragma unroll
            for (int w = 0; w < 8; ++w) { pre[w] = tot; tot += wcnt[w * 8 + lane]; }
            const int base = tot ? (int)atomicAdd(ctl + CW_CNT + 64 * lane, (unsigned)tot) : 0;
#pragma unroll
            for (int w = 0; w < 8; ++w) wbase[w * 8 + lane] = base + pre[w]; }
        __syncthreads();
        if (act) { const int r = gw + NGW * lane; const int bi = m_bi, si = m_si; const float rs = m_rs, w0 = m_w0, w1 = 1.0f - w0;
            const unsigned long long lt = (1ull << lane) - 1ull; int r0 = 0, r1 = 0;
#pragma unroll
            for (int e = 0; e < 8; ++e) { const int rk = wbase[wave * 8 + e] + __popcll(mk[e] & lt); if (bi == e) r0 = rk; if (si == e) r1 = rk; }
            list[bi * 32768 + r0] = r; lrstd[bi * 32768 + r0] = rs; list[si * 32768 + r1] = r; lrstd[si * 32768 + r1] = rs;
            toke[2 * r] = bi; toke[2 * r + 1] = si; tokr[2 * r] = r0; tokr[2 * r + 1] = r1; tokw[2 * r] = w0; tokw[2 * r + 1] = w1; } }
}

constexpr int RW_LS = 72;
constexpr int RW_SLOT = 64 * RW_LS * 2;
constexpr int RW_FS = 65;
__device__ __forceinline__ LAS unsigned char* rw_slot(LAS unsigned char* lds, int s) { return lds + s * RW_SLOT; }
__device__ __forceinline__ bf16x8 rw_frag(const LAS unsigned char* m, int row, int kq, int ks) { return *(const LAS bf16x8*)(m + row * (RW_LS * 2) + (32 * ks + 8 * kq) * 2); }
__device__ __forceinline__ f32x4 rw_mm(const LAS unsigned char* A, const LAS unsigned char* Bt, int mt, int nt, int l15, int kq, f32x4 acc) {
#pragma unroll
    for (int ks = 0; ks < 2; ++ks) acc = __builtin_amdgcn_mfma_f32_16x16x32_bf16(rw_frag(A, 16 * mt + l15, kq, ks), rw_frag(Bt, 16 * nt + l15, kq, ks), acc, 0, 0, 0);
    return acc;
}
__device__ __forceinline__ void rw_store_T(LAS unsigned char* m, int mt, int nt, int q, int n, f32x4 v) {
    u32x2 w; w.x = cvt_pk_bf16(v[0], v[1]); w.y = cvt_pk_bf16(v[2], v[3]);
    *(LAS u32x2*)(m + (16 * nt + n) * (RW_LS * 2) + (16 * mt + 4 * q) * 2) = w;
}
__device__ __forceinline__ void rw_store_D(LAS unsigned char* m, int mt, int nt, int q, int n, f32x4 v) {
#pragma unroll
    for (int r = 0; r < 4; ++r) *(LAS bf16_t*)(m + (16 * mt + 4 * q + r) * (RW_LS * 2) + (16 * nt + n) * 2) = f2bf(v[r]);
}
struct RwF2 { bf16x8 k[2]; };
__device__ __forceinline__ RwF2 rw_ld2(const LAS unsigned char* m, int row, int kq) { RwF2 f; f.k[0] = rw_frag(m, row, kq, 0); f.k[1] = rw_frag(m, row, kq, 1); return f; }
__device__ __forceinline__ f32x4 rw_mmf(const RwF2& a, const RwF2& b, f32x4 acc) {
    acc = __builtin_amdgcn_mfma_f32_16x16x32_bf16(a.k[0], b.k[0], acc, 0, 0, 0); return __builtin_amdgcn_mfma_f32_16x16x32_bf16(a.k[1], b.k[1], acc, 0, 0, 0); }
#define RW_LOADED() __builtin_amdgcn_sched_barrier(0)
__device__ __forceinline__ float rw_ld1(const LAS unsigned char* m, int row, int col) { return bf2f(*(const LAS bf16_t*)(m + row * (RW_LS * 2) + col * 2)); }

#ifdef DBG_RWKV
__device__ __forceinline__ void rw_dbg_scan(LAS unsigned char* lds, int slot, int bit, unsigned* word, int tid) {
    unsigned bad = 0u;
    for (int i = tid; i < 4096; i += NTHR) { const float v = rw_ld1(rw_slot(lds, slot), i >> 6, i & 63); if (!(v - v == 0.f)) bad = 1u; }
    if (bad) atomicOr(word, 1u << bit);
}
#define RW_DBG(slot, bit) rw_dbg_scan(lds, slot, bit, B.dbg, tid)
__device__ __forceinline__ void rw_dbg_max(LAS unsigned char* lds, int slot, unsigned* word, int tid) {
    float m = 0.f;
    for (int i = tid; i < 4096; i += NTHR) { const float v = fabsf(rw_ld1(rw_slot(lds, slot), i >> 6, i & 63)); if (v - v == 0.f) m = fmaxf(m, v); }
    atomicMax(word, __float_as_uint(m));
}
#else
#define RW_DBG(slot, bit)
#endif
struct RwBufs { unsigned* dbg;  bf16_t* XL; bf16_t* Pp; bf16_t* Qp; bf16_t* Rp; float* WL; bf16_t* GA; bf16_t* GB; bf16_t* CAT; const bf16_t* P1; const bf16_t* w2T; const bf16_t* a2T; const bf16_t* g2T; };

__device__ __forceinline__ void rwkv_xpre(const Args& a, const RwBufs& B, int bx, int G, int wave) {
    const int tid = wave * 64 + lane_now(), c8 = (tid & 31) * 8, seg = c8 >> 5, tr = tid >> 5;
    const float* mu = a.in[I_MU];
    const f32x4 m0 = *(const f32x4*)(mu + 2304 + c8), m1 = *(const f32x4*)(mu + 2304 + c8 + 4);
#pragma unroll 2
    for (int r = bx * 16 + tr; r < T; r += G * 16) {
        const bf16_t* cp = B.P1 + (size_t)r * INB + 2304 + c8;
        const u32x4 cw = *(const u32x4*)cp, pw = ((r & (SEQ - 1)) == 0) ? (u32x4){0u, 0u, 0u, 0u} : *(const u32x4*)(cp - INB);
        float x[8]; const unsigned cwa[4] = {cw.x, cw.y, cw.z, cw.w}, pwa[4] = {pw.x, pw.y, pw.z, pw.w};
#pragma unroll
        for (int e = 0; e < 4; ++e) { const float c0 = bflo(cwa[e]), c1 = bfhi(cwa[e]), p0 = bflo(pwa[e]), p1 = bfhi(pwa[e]);
            const float mm0 = (e < 2) ? m0[2 * e] : m1[2 * e - 4], mm1 = (e < 2) ? m0[2 * e + 1] : m1[2 * e - 3];
            x[2 * e] = c0 + (p0 - c0) * mm0; x[2 * e + 1] = c1 + (p1 - c1) * mm1; }
#pragma unroll
        for (int e = 0; e < 8; ++e) { const float sg = __builtin_amdgcn_rcpf(1.0f + __expf(seg < 2 ? -2.0f * x[e] : -x[e])); x[e] = (seg < 2) ? (2.0f * sg - 1.0f) : ((seg >= 4) ? sg : x[e]); }
        u32x4 o; o.x = cvt_pk_bf16(x[0], x[1]); o.y = cvt_pk_bf16(x[2], x[3]); o.z = cvt_pk_bf16(x[4], x[5]); o.w = cvt_pk_bf16(x[6], x[7]);
        *(u32x4*)(B.XL + (size_t)r * 256 + c8) = o; }
}

#ifndef RW_DUPS
#define RW_DUPS 0
#endif
#define RW_REP(bit) _Pragma("unroll 1") for (int rp_ = 0; rp_ < ((((RW_DUPS) >> (bit)) & 1) ? 4 : 1); ++rp_)
__device__ __forceinline__ void rwkv_r1(const Args& a, LAS unsigned char* lds, const RwBufs& B, int bx, int G, int wave, int nitems) {
    const int lane = lane_now(), l15 = lane & 15, kq = lane >> 4, q = kq, n = l15, tid = wave * 64 + lane;
    LAS float* Fw = (LAS float*)lds; LAS float* Fa = Fw + 64 * RW_FS; LAS float* Fg = Fa + 64 * RW_FS;
    LAS float* gsum = (LAS float*)(lds + 15 * RW_SLOT);
    const float* mu = a.in[I_MU];
    const int h = bx % RH, rk = bx / RH, nh = (G - h + RH - 1) / RH, nbc = nitems / RH;
    u32x4 pcw[4]; unsigned ldrk[9], ldv2[5];
#define RW_ISSUE(bc_) do { const int b_ = (bc_) >> 6, c_ = (bc_) & 63; const size_t r0_ = (size_t)b_ * SEQ + c_ * 64; \
        { const int tid_ = wave * 64 + lane_now(); const int t_ = tid_ >> 3, seg_ = tid_ & 7; const bf16_t* cp_ = B.XL + (r0_ + t_) * 256 + 32 * seg_; \
          _Pragma("unroll") for (int v8 = 0; v8 < 4; ++v8) pcw[v8] = *(const u32x4*)(cp_ + 8 * v8); } \
        { const bf16_t* pr0_ = B.P1 + (r0_ + 8 * wave) * INB + h * 64 + lane_now(); const bool z0_ = (c_ == 0 && wave == 0); \
          _Pragma("unroll") for (int u = 0; u < 9; ++u) { unsigned r_ = 0u, k_ = 0u, v_ = 0u; if (!(u == 0 && z0_)) { const bf16_t* pp_ = pr0_ + (ptrdiff_t)(u - 1) * INB; r_ = pp_[0]; k_ = pp_[CS]; v_ = pp_[2 * CS]; } \
              ldrk[u] = r_ | (k_ << 16); if (u & 1) ldv2[u >> 1] |= v_ << 16; else ldv2[u >> 1] = v_; } } } while (0)
    const int cgh = h * 64 + lane;
    const float hc_a0 = a.in[I_A0][cgh], hc_kk = a.in[I_KK][cgh], hc_ka = a.in[I_KA][cgh], hc_rk = a.in[I_RK][cgh], hc_lxw = a.in[I_LNXW][cgh], hc_lxb = a.in[I_LNXB][cgh];
    const float hc_mur = mu[cgh], hc_muk = mu[CS + cgh], hc_muv = mu[2 * CS + cgh], hc_w0n = a.in[I_W0][h * 64 + 16 * (wave & 3) + l15];
#define RW_WFR_LOAD \
        { const int ntw = wave & 3; const size_t rw = (size_t)(h * 64 + 16 * ntw + l15); \
    _Pragma("unroll") \
          for (int ks = 0; ks < 2; ++ks) { wfr[ks] = *(const bf16x8*)(B.w2T + rw * 64 + 32 * ks + 8 * kq); wfr[2 + ks] = *(const bf16x8*)(B.a2T + rw * 64 + 32 * ks + 8 * kq); } \
    _Pragma("unroll") \
          for (int ks = 0; ks < 4; ++ks) wfr[4 + ks] = *(const bf16x8*)(B.g2T + rw * 128 + 32 * ks + 8 * kq); } \

    bf16x8 wfr[8];
#if !RW_DUPS
    RW_WFR_LOAD
#endif
    if (rk < nbc) RW_ISSUE(rk);
#pragma unroll 1
    for (int bc = rk; bc < nbc; bc += nh) {
        const int b = bc >> 6, c = bc & 63, item = bc * RH + h;
        const size_t row0 = (size_t)b * SEQ + c * 64;
#if RW_DUPS
        RW_WFR_LOAD
#endif
        __syncthreads();
        { const int tid0 = wave * 64 + lane_now(), t = tid0 >> 3, seg = tid0 & 7;
          LAS unsigned char* dst = rw_slot(lds, 6 + (seg >> 1)) + t * (RW_LS * 2) + (32 * (seg & 1)) * 2;
#pragma unroll
          for (int v8 = 0; v8 < 4; ++v8) *(LAS u32x4*)(dst + 16 * v8) = pcw[v8]; }
        __syncthreads();
        RW_REP(1) {
#pragma unroll
        for (int i6 = 0; i6 < 6; ++i6) { const int ti = wave + 8 * i6, mat = i6 >> 1, mt = (ti >> 2) & 3, nt = wave & 3; f32x4 acc = {0.f, 0.f, 0.f, 0.f};
            if (mat < 2) { const LAS unsigned char* X = rw_slot(lds, 6 + mat);
#pragma unroll
                for (int ks = 0; ks < 2; ++ks) acc = __builtin_amdgcn_mfma_f32_16x16x32_bf16(rw_frag(X, 16 * mt + l15, kq, ks), wfr[2 * mat + ks], acc, 0, 0, 0);
            } else {
#pragma unroll
                for (int ks = 0; ks < 4; ++ks) acc = __builtin_amdgcn_mfma_f32_16x16x32_bf16(rw_frag(rw_slot(lds, 8 + (ks >> 1)), 16 * mt + l15, kq, ks & 1), wfr[4 + ks], acc, 0, 0, 0); }
            LAS float* F = (mat == 0) ? Fw : (mat == 1 ? Fa : Fg);
            if (mat == 0) {
                const float w0n = hc_w0n; float s4 = 0.f;
#pragma unroll
                for (int r = 0; r < 4; ++r) { const float z = -(w0n + acc[r]); acc[r] = -0.6065306597126334f * __builtin_amdgcn_rcpf(1.0f + __expf(z)); s4 += acc[r]; }
                s4 += __shfl_xor(s4, 16);
                if ((q & 1) == 0) gsum[(2 * mt + (q >> 1)) * 64 + 16 * nt + n] = s4; }
#pragma unroll
            for (int r = 0; r < 4; ++r) F[(16 * mt + 4 * q + r) * RW_FS + 16 * nt + n] = acc[r]; }
        __syncthreads();
        }
        RW_REP(2) {
        {   const int j = lane, cg = h * 64 + j, t0 = 8 * wave;
            const float a0 = hc_a0, kkw = hc_kk, kaw = hc_ka, rkw = hc_rk, lxw = hc_lxw, lxb = hc_lxb, mur = hc_mur, muk = hc_muk, muv = hc_muv;
            float ldv[8], av[8], rv[8], kv[8], vv[8], kkv[8];
            float pr_r = bflo(ldrk[0]), pr_k = bfhi(ldrk[0]), pr_v = bflo(ldv2[0]);
#pragma unroll
            for (int u = 0; u < 8; ++u) { const float cr = bflo(ldrk[u + 1]), ck = bfhi(ldrk[u + 1]), cv = ((u + 1) & 1) ? bfhi(ldv2[(u + 1) >> 1]) : bflo(ldv2[(u + 1) >> 1]);
                rv[u] = cr + (pr_r - cr) * mur; kv[u] = ck + (pr_k - ck) * muk; vv[u] = cv + (pr_v - cv) * muv; pr_r = cr; pr_k = ck; pr_v = cv;
                ldv[u] = Fw[(t0 + u) * RW_FS + j];
                av[u] = sigmoidf_(a0 + Fa[(t0 + u) * RW_FS + j]);
                const float kx = kv[u] * kkw; const float ss = wave_sum_fast(kx * kx); kkv[u] = kx * __builtin_amdgcn_rsqf(fmaxf(ss, 1e-24f)); }
            float lw[8]; lw[0] = ldv[0];
#pragma unroll
            for (int u = 1; u < 8; ++u) lw[u] = lw[u - 1] + ldv[u];
            float off = 0.f, tot = 0.f;
#pragma unroll
            for (int w8 = 0; w8 < 8; ++w8) { const float gs = gsum[w8 * 64 + j]; tot += gs; if (w8 < wave) off += gs; }
            if (wave == 0) B.WL[(size_t)item * 64 + lane_now()] = __expf(tot);
            unsigned pAt[4], pBh[4], pKh[4], pV[4], pga[4], pgb[4];
            const float WLt = __expf(tot); float Wprev = __expf(off);
#pragma unroll
            for (int u2 = 0; u2 < 4; ++u2) { float tAt[2], tBh[2], tKh[2], ga2[2], gb2[2];
#pragma unroll
                for (int uu = 0; uu < 2; ++uu) { const int u = 2 * u2 + uu; const float lwt = off + lw[u];
                    const float kp = kv[u] * (1.f + (av[u] - 1.f) * kaw), ap = -kkv[u], bb = kkv[u] * av[u];
                    const float Wt = __expf(lwt), Wm1 = Wprev, iW = __builtin_amdgcn_rcpf(Wt), WLr = WLt * iW; Wprev = Wt;
                    const float bonus = wave_sum_fast(rv[u] * kp * rkw);
                    const float gv = Fg[(t0 + u) * RW_FS + j];
                    ga2[uu] = lxw * gv; gb2[uu] = (lxb + bonus * vv[u]) * gv;
                    const int t = t0 + u;
                    *(LAS bf16_t*)(rw_slot(lds, 10) + t * (RW_LS * 2) + j * 2) = f2bf(ap * Wm1);
                    *(LAS bf16_t*)(rw_slot(lds, 11) + t * (RW_LS * 2) + j * 2) = f2bf(bb * iW);
                    *(LAS bf16_t*)(rw_slot(lds, 12) + t * (RW_LS * 2) + j * 2) = f2bf(kp * iW);
                    *(LAS bf16_t*)(rw_slot(lds, 13) + t * (RW_LS * 2) + j * 2) = f2bf(rv[u] * Wt);
                    tAt[uu] = ap * Wm1; tBh[uu] = bb * WLr; tKh[uu] = kp * WLr; }
                pAt[u2] = cvt_pk_bf16(tAt[0], tAt[1]); pBh[u2] = cvt_pk_bf16(tBh[0], tBh[1]); pKh[u2] = cvt_pk_bf16(tKh[0], tKh[1]); pV[u2] = cvt_pk_bf16(vv[2 * u2], vv[2 * u2 + 1]);
                pga[u2] = cvt_pk_bf16(ga2[0], ga2[1]); pgb[u2] = cvt_pk_bf16(gb2[0], gb2[1]); }
            *(LAS u32x4*)(rw_slot(lds, 14) + j * (RW_LS * 2) + t0 * 2) = (u32x4){pAt[0], pAt[1], pAt[2], pAt[3]};
            *(LAS u32x4*)(rw_slot(lds, 6) + j * (RW_LS * 2) + t0 * 2) = (u32x4){pBh[0], pBh[1], pBh[2], pBh[3]};
            *(LAS u32x4*)(rw_slot(lds, 7) + j * (RW_LS * 2) + t0 * 2) = (u32x4){pKh[0], pKh[1], pKh[2], pKh[3]};
            *(LAS u32x4*)(rw_slot(lds, 8) + j * (RW_LS * 2) + t0 * 2) = (u32x4){pV[0], pV[1], pV[2], pV[3]};
            { const int j2 = lane_now(); bf16_t* gap = B.GA + (size_t)item * 4096 + j2 * 64; bf16_t* gbp = B.GB + (size_t)item * 4096 + j2 * 64;
#pragma unroll
              for (int hh = 0; hh < 2; ++hh) { const int pos = (2 * (wave & 1) + hh) * 16 + (wave >> 1) * 4;
                  *(u32x2*)(gap + pos) = (u32x2){pga[2 * hh], pga[2 * hh + 1]}; *(u32x2*)(gbp + pos) = (u32x2){pgb[2 * hh], pgb[2 * hh + 1]}; } }
        }
        __syncthreads();
        }
        if (bc + nh < nbc) RW_ISSUE(bc + nh);
        RW_DBG(10, 0); RW_DBG(11, 1); RW_DBG(12, 2); RW_DBG(13, 3); RW_DBG(14, 4); RW_DBG(6, 5); RW_DBG(7, 6); RW_DBG(8, 7);
        RW_REP(3) {
        {   const int nt = wave & 3, mta = wave >> 2, mtb = mta + 2; const f32x4 z4 = {0.f, 0.f, 0.f, 0.f};
            const int da = 16 * (mta - nt) + 4 * q - n, db = 16 * (mtb - nt) + 4 * q - n;
#define RW_MASK(acc_, d_, MODE) do { _Pragma("unroll") for (int r = 0; r < 4; ++r) { const bool keep = (MODE == 0) ? ((d_) + r > 0) : ((MODE == 1) ? ((d_) + r < 0) : ((d_) + r <= 0)); acc_[r] = keep ? acc_[r] : 0.f; } } while (0)
            {   const RwF2 a10a = rw_ld2(rw_slot(lds, 10), 16 * mta + l15, kq), a10b = rw_ld2(rw_slot(lds, 10), 16 * mtb + l15, kq), b11 = rw_ld2(rw_slot(lds, 11), 16 * nt + l15, kq);
                const RwF2 a12a = rw_ld2(rw_slot(lds, 12), 16 * mta + l15, kq), a12b = rw_ld2(rw_slot(lds, 12), 16 * mtb + l15, kq), b10 = rw_ld2(rw_slot(lds, 10), 16 * nt + l15, kq);
                RW_LOADED();
                f32x4 c0 = rw_mmf(a10a, b11, z4), c1 = rw_mmf(a10b, b11, z4), c2 = rw_mmf(a12a, b10, z4), c3 = rw_mmf(a12b, b10, z4);
                RW_MASK(c0, da, 0); RW_MASK(c1, db, 0); RW_MASK(c2, da, 1); RW_MASK(c3, db, 1);
                rw_store_T(rw_slot(lds, 0), mta, nt, q, n, c0); rw_store_T(rw_slot(lds, 0), mtb, nt, q, n, c1); rw_store_T(rw_slot(lds, 1), mta, nt, q, n, c2); rw_store_T(rw_slot(lds, 1), mtb, nt, q, n, c3);
                RW_LOADED(); }
            {   const RwF2 a11a = rw_ld2(rw_slot(lds, 11), 16 * mta + l15, kq), a11b = rw_ld2(rw_slot(lds, 11), 16 * mtb + l15, kq), b13 = rw_ld2(rw_slot(lds, 13), 16 * nt + l15, kq);
                const RwF2 a12a = rw_ld2(rw_slot(lds, 12), 16 * mta + l15, kq), a12b = rw_ld2(rw_slot(lds, 12), 16 * mtb + l15, kq);
                RW_LOADED();
                f32x4 c0 = rw_mmf(a11a, b13, z4), c1 = rw_mmf(a11b, b13, z4), c2 = rw_mmf(a12a, b13, z4), c3 = rw_mmf(a12b, b13, z4);
                RW_MASK(c0, da, 2); RW_MASK(c1, db, 2); RW_MASK(c2, da, 2); RW_MASK(c3, db, 2);
                rw_store_T(rw_slot(lds, 2), mta, nt, q, n, c0); rw_store_T(rw_slot(lds, 2), mtb, nt, q, n, c1); rw_store_T(rw_slot(lds, 3), mta, nt, q, n, c2); rw_store_T(rw_slot(lds, 3), mtb, nt, q, n, c3);
                RW_LOADED(); } }
        for (int i = wave * 64 + lane_now(); i < 2 * RW_SLOT / 16; i += NTHR) *(LAS u32x4*)(rw_slot(lds, 4) + i * 16) = (u32x4){0u, 0u, 0u, 0u};
        __syncthreads();
        }
        RW_DBG(0, 8); RW_DBG(1, 9); RW_DBG(2, 10); RW_DBG(3, 11);
#ifdef DBG_RWKV
        rw_dbg_max(lds, DBG_MAXSLOT_A, B.dbg + 1, tid);
#endif
        RW_REP(4) {
        if (wave >= 4) {
            {   const int nt = wave & 3; const f32x4 z4 = {0.f, 0.f, 0.f, 0.f};
                const RwF2 a0 = rw_ld2(rw_slot(lds, 1), l15, kq), a1 = rw_ld2(rw_slot(lds, 1), 16 + l15, kq), a2 = rw_ld2(rw_slot(lds, 1), 32 + l15, kq), a3 = rw_ld2(rw_slot(lds, 1), 48 + l15, kq), b8 = rw_ld2(rw_slot(lds, 8), 16 * nt + l15, kq);
                RW_LOADED();
                const f32x4 c0 = rw_mmf(a0, b8, z4), c1 = rw_mmf(a1, b8, z4), c2 = rw_mmf(a2, b8, z4), c3 = rw_mmf(a3, b8, z4);
                rw_store_T(rw_slot(lds, 12), 0, nt, q, n, c0); rw_store_T(rw_slot(lds, 12), 1, nt, q, n, c1); rw_store_T(rw_slot(lds, 12), 2, nt, q, n, c2); rw_store_T(rw_slot(lds, 12), 3, nt, q, n, c3); } }
        if (wave < 4 && lane_now() < 16) { const int i0 = 16 * wave, cc = lane_now(); float Tc[16];
            const LAS unsigned char* AT = rw_slot(lds, 0);
#pragma unroll
            for (int t = 0; t < 16; ++t) { float s = (t == cc) ? 1.f : 0.f;
#pragma unroll
                for (int s2 = 0; s2 < t; ++s2) s += rw_ld1(AT, i0 + s2, i0 + t) * Tc[s2];
                Tc[t] = s; }
#pragma unroll
            for (int t = 0; t < 16; ++t) *(LAS bf16_t*)(rw_slot(lds, 4) + (i0 + t) * (RW_LS * 2) + (i0 + cc) * 2) = f2bf(Tc[t]);
            u32x4 o0, o1; o0.x = cvt_pk_bf16(Tc[0], Tc[1]); o0.y = cvt_pk_bf16(Tc[2], Tc[3]); o0.z = cvt_pk_bf16(Tc[4], Tc[5]); o0.w = cvt_pk_bf16(Tc[6], Tc[7]);
            o1.x = cvt_pk_bf16(Tc[8], Tc[9]); o1.y = cvt_pk_bf16(Tc[10], Tc[11]); o1.z = cvt_pk_bf16(Tc[12], Tc[13]); o1.w = cvt_pk_bf16(Tc[14], Tc[15]);
            *(LAS u32x4*)(rw_slot(lds, 5) + (i0 + cc) * (RW_LS * 2) + i0 * 2) = o0; *(LAS u32x4*)(rw_slot(lds, 5) + (i0 + cc) * (RW_LS * 2) + (i0 + 8) * 2) = o1;
        }
#if RW_DUPS
        __syncthreads();
#endif
        }
        if (wave < 4 && lane_now() < 16) { const int i0 = 16 * wave, cc = lane_now();
            LDS_WAIT();
            *(LAS u32x4*)(rw_slot(lds, 0) + (i0 + cc) * (RW_LS * 2) + i0 * 2) = (u32x4){0u, 0u, 0u, 0u}; *(LAS u32x4*)(rw_slot(lds, 0) + (i0 + cc) * (RW_LS * 2) + (i0 + 8) * 2) = (u32x4){0u, 0u, 0u, 0u};
        }
        __syncthreads();
        RW_DBG(4, 12); RW_DBG(5, 13);
#ifdef DBG_RWKV
        rw_dbg_max(lds, 4, B.dbg + 2, tid);
#endif
        RW_REP(5) {
        {   const int nt = wave & 3, mta = wave >> 2, mtb = mta + 2; const f32x4 z4 = {0.f, 0.f, 0.f, 0.f};
            const RwF2 a4a = rw_ld2(rw_slot(lds, 4), 16 * mta + l15, kq), a4b = rw_ld2(rw_slot(lds, 4), 16 * mtb + l15, kq), b0 = rw_ld2(rw_slot(lds, 0), 16 * nt + l15, kq);
            RW_LOADED();
            const f32x4 c0 = rw_mmf(a4a, b0, z4), c1 = rw_mmf(a4b, b0, z4);
            rw_store_T(rw_slot(lds, 11), mta, nt, q, n, c0); rw_store_D(rw_slot(lds, 9), mta, nt, q, n, c0); rw_store_T(rw_slot(lds, 11), mtb, nt, q, n, c1); rw_store_D(rw_slot(lds, 9), mtb, nt, q, n, c1); }
        __syncthreads();
        }
        RW_DBG(9, 14); RW_DBG(11, 15);
#ifdef DBG_RWKV
        rw_dbg_max(lds, 11, B.dbg + 3, tid);
#endif
        RW_REP(6) {
        {   const int nt = wave & 3, mta = wave >> 2, mtb = mta + 2; const f32x4 z4 = {0.f, 0.f, 0.f, 0.f};
            const RwF2 a11a = rw_ld2(rw_slot(lds, 11), 16 * mta + l15, kq), a11b = rw_ld2(rw_slot(lds, 11), 16 * mtb + l15, kq), b9 = rw_ld2(rw_slot(lds, 9), 16 * nt + l15, kq);
            const RwF2 a9a = rw_ld2(rw_slot(lds, 9), 16 * mta + l15, kq), a9b = rw_ld2(rw_slot(lds, 9), 16 * mtb + l15, kq), b5 = rw_ld2(rw_slot(lds, 5), 16 * nt + l15, kq);
            const u32x2 dga = *(const LAS u32x2*)(rw_slot(lds, 5) + (16 * nt + n) * (RW_LS * 2) + (16 * mta + 4 * q) * 2), dgb = *(const LAS u32x2*)(rw_slot(lds, 5) + (16 * nt + n) * (RW_LS * 2) + (16 * mtb + 4 * q) * 2);
            RW_LOADED();
            const f32x4 c0 = rw_mmf(a11a, b9, z4), c1 = rw_mmf(a11b, b9, z4);
            const f32x4 c2 = rw_mmf(a9a, b5, (f32x4){bflo(dga.x), bfhi(dga.x), bflo(dga.y), bfhi(dga.y)}), c3 = rw_mmf(a9b, b5, (f32x4){bflo(dgb.x), bfhi(dgb.x), bflo(dgb.y), bfhi(dgb.y)});
            rw_store_T(rw_slot(lds, 10), mta, nt, q, n, c0); rw_store_T(rw_slot(lds, 10), mtb, nt, q, n, c1);
            RW_LOADED();
            rw_store_T(rw_slot(lds, 0), mta, nt, q, n, c2); rw_store_T(rw_slot(lds, 0), mtb, nt, q, n, c3); }
        __syncthreads();
        }
        RW_DBG(10, 16); RW_DBG(0, 17);
        RW_REP(7) {
        {   const int nt = wave & 3, mta = wave >> 2, mtb = mta + 2;
            const RwF2 a0a = rw_ld2(rw_slot(lds, 0), 16 * mta + l15, kq), a0b = rw_ld2(rw_slot(lds, 0), 16 * mtb + l15, kq), b10 = rw_ld2(rw_slot(lds, 10), 16 * nt + l15, kq);
            f32x4 za, zb;
#pragma unroll
            for (int r = 0; r < 4; ++r) { za[r] = rw_ld1(rw_slot(lds, 0), 16 * mta + 4 * q + r, 16 * nt + n); zb[r] = rw_ld1(rw_slot(lds, 0), 16 * mtb + 4 * q + r, 16 * nt + n); }
            RW_LOADED();
            const f32x4 c0 = rw_mmf(a0a, b10, za), c1 = rw_mmf(a0b, b10, zb);
            rw_store_T(rw_slot(lds, 4), mta, nt, q, n, c0); rw_store_T(rw_slot(lds, 4), mtb, nt, q, n, c1); }
        __syncthreads();
        }
        RW_DBG(4, 18);
        RW_REP(8) {
        {   const int nt = wave & 3, mta = wave >> 2, mtb = mta + 2; const f32x4 z4 = {0.f, 0.f, 0.f, 0.f};
            const RwF2 a4a = rw_ld2(rw_slot(lds, 4), 16 * mta + l15, kq), a4b = rw_ld2(rw_slot(lds, 4), 16 * mtb + l15, kq), b14 = rw_ld2(rw_slot(lds, 14), 16 * nt + l15, kq), b12 = rw_ld2(rw_slot(lds, 12), 16 * nt + l15, kq);
            RW_LOADED();
            const f32x4 c0 = rw_mmf(a4a, b14, z4), c1 = rw_mmf(a4b, b14, z4), c2 = rw_mmf(a4a, b12, z4), c3 = rw_mmf(a4b, b12, z4);
            rw_store_T(rw_slot(lds, 5), mta, nt, q, n, c0); rw_store_T(rw_slot(lds, 5), mtb, nt, q, n, c1); rw_store_T(rw_slot(lds, 11), mta, nt, q, n, c2); rw_store_T(rw_slot(lds, 11), mtb, nt, q, n, c3); }
        __syncthreads();
        }
        RW_DBG(5, 19); RW_DBG(11, 21);
        RW_REP(10) {
        {   const int nt = wave & 3, mta = wave >> 2, mtb = mta + 2; const f32x4 z4 = {0.f, 0.f, 0.f, 0.f};
#define RW_PK(c_) ((u32x2){cvt_pk_bf16(c_[0], c_[1]), cvt_pk_bf16(c_[2], c_[3])})
            {
                const RwF2 a5a = rw_ld2(rw_slot(lds, 5), 16 * mta + l15, kq), a5b = rw_ld2(rw_slot(lds, 5), 16 * mtb + l15, kq), b6 = rw_ld2(rw_slot(lds, 6), 16 * nt + l15, kq), b2 = rw_ld2(rw_slot(lds, 2), 16 * nt + l15, kq);
                const u32x2 rta = *(const LAS u32x2*)(rw_slot(lds, 13) + (16 * nt + n) * (RW_LS * 2) + (16 * mta + 4 * q) * 2), rtb = *(const LAS u32x2*)(rw_slot(lds, 13) + (16 * nt + n) * (RW_LS * 2) + (16 * mtb + 4 * q) * 2);
                RW_LOADED();
                const f32x4 c0 = rw_mmf(a5a, b6, z4), c1 = rw_mmf(a5b, b6, z4);
                const f32x4 c2 = rw_mmf(a5a, b2, (f32x4){bflo(rta.x), bfhi(rta.x), bflo(rta.y), bfhi(rta.y)}), c3 = rw_mmf(a5b, b2, (f32x4){bflo(rtb.x), bfhi(rtb.x), bflo(rtb.y), bfhi(rtb.y)});
                *(u32x2*)(B.Pp + (size_t)item * 4096 + (size_t)((nt * 2 + (mta >> 1)) * 64 + n + 16 * q) * 8 + 4 * (mta & 1)) = RW_PK(c0);
                *(u32x2*)(B.Pp + (size_t)item * 4096 + (size_t)((nt * 2 + (mtb >> 1)) * 64 + n + 16 * q) * 8 + 4 * (mtb & 1)) = RW_PK(c1);
                *(u32x2*)(B.Rp + (size_t)item * 4096 + (size_t)((nt * 2 + (mta >> 1)) * 64 + n + 16 * q) * 8 + 4 * (mta & 1)) = RW_PK(c2);
                *(u32x2*)(B.Rp + (size_t)item * 4096 + (size_t)((nt * 2 + (mtb >> 1)) * 64 + n + 16 * q) * 8 + 4 * (mtb & 1)) = RW_PK(c3);
                RW_LOADED(); }
            {
                const RwF2 b11 = rw_ld2(rw_slot(lds, 11), 16 * nt + l15, kq), b8 = rw_ld2(rw_slot(lds, 8), 16 * nt + l15, kq);
                const RwF2 a6a = rw_ld2(rw_slot(lds, 6), 16 * mta + l15, kq), a6b = rw_ld2(rw_slot(lds, 6), 16 * mtb + l15, kq), a7a = rw_ld2(rw_slot(lds, 7), 16 * mta + l15, kq), a7b = rw_ld2(rw_slot(lds, 7), 16 * mtb + l15, kq);
                RW_LOADED();
                f32x4 c0 = rw_mmf(a6a, b11, z4), c1 = rw_mmf(a6b, b11, z4); c0 = rw_mmf(a7a, b8, c0); c1 = rw_mmf(a7b, b8, c1);
                *(u32x2*)(B.Qp + (size_t)item * 4096 + (size_t)((nt * 4 + mta) * 64 + lane_now()) * 4) = RW_PK(c0);
                *(u32x2*)(B.Qp + (size_t)item * 4096 + (size_t)((nt * 4 + mtb) * 64 + lane_now()) * 4) = RW_PK(c1);
                RW_LOADED();
                const RwF2 a2a = rw_ld2(rw_slot(lds, 2), 16 * mta + l15, kq), a2b = rw_ld2(rw_slot(lds, 2), 16 * mtb + l15, kq), a3a = rw_ld2(rw_slot(lds, 3), 16 * mta + l15, kq), a3b = rw_ld2(rw_slot(lds, 3), 16 * mtb + l15, kq);
                RW_LOADED();
                f32x4 c2 = rw_mmf(a2a, b11, z4), c3 = rw_mmf(a2b, b11, z4); c2 = rw_mmf(a3a, b8, c2); c3 = rw_mmf(a3b, b8, c3);
                *(u32x2*)(B.CAT + (row0 + 16 * nt + n) * D + h * 64 + q * 16 + mta * 4) = RW_PK(c2);
                *(u32x2*)(B.CAT + (row0 + 16 * nt + n) * D + h * 64 + q * 16 + mtb * 4) = RW_PK(c3); }
        }
#if RW_DUPS
        __syncthreads();
#endif
        }
    }
}

constexpr int R2_SLOT = 2 * 8192 + 256, R2_LA = 7;
#define R2_WAITV(n) asm volatile("s_waitcnt vmcnt(" #n ")" ::: "memory")
struct R2Own { u32x2 qv[4]; u32x4 y0, y1; };
__device__ __forceinline__ void rwkv_r2(LAS unsigned char* lds, const RwBufs& B, int bx, int G, int wave, int nbh, bool dry = false) {
    const int lane = lane_now(), q = lane >> 4, n = lane & 15, wv = wave & 3;
#pragma unroll 1
    for (int bh = bx; bh < nbh; bh += G) {
        const int b = bh / RH, h = bh % RH;
        __syncthreads();
#define R2_ISSUE(c_) do { const int cc_ = (c_); const size_t item_ = (size_t)(b * 64 + cc_) * RH + h; LAS unsigned char* sl_ = lds + (cc_ & 7) * R2_SLOT; \
            const bf16_t* src_ = (wv < 2 ? B.Pp : B.Rp) + item_ * 4096 + (size_t)(wv & 1) * 2048 + lane_now() * 8; \
            _Pragma("unroll") for (int f = 0; f < 4; ++f) __builtin_amdgcn_global_load_lds((const unsigned*)(src_ + f * 512), (LAS unsigned*)(sl_ + (wv >> 1) * 8192 + (wv & 1) * 4096 + f * 1024), 16, 0, 0); \
            if (wv == 3 && lane_now() < 16) __builtin_amdgcn_global_load_lds((const unsigned*)(B.WL + item_ * 64 + lane_now() * 4), (LAS unsigned*)(sl_ + 2 * 8192), 16, 0, 0); } while (0)
#define R2_LANDED(c1_) do { const int af_ = (((c1_) + R2_LA - 1 < 63) ? ((c1_) + R2_LA - 1) : 63) - (c1_); \
            if (wv < 3) { if (af_ >= 6) R2_WAITV(24); else if (af_ == 5) R2_WAITV(20); else if (af_ == 4) R2_WAITV(16); else if (af_ == 3) R2_WAITV(12); else if (af_ == 2) R2_WAITV(8); else if (af_ == 1) R2_WAITV(4); else R2_WAITV(0); } \
            else        { if (af_ >= 6) R2_WAITV(30); else if (af_ == 5) R2_WAITV(25); else if (af_ == 4) R2_WAITV(20); else if (af_ == 3) R2_WAITV(15); else if (af_ == 2) R2_WAITV(10); else if (af_ == 1) R2_WAITV(5); else R2_WAITV(0); } } while (0)
#define R2_OWN(O_, c_) do { const int cc_ = (c_); const size_t item_ = (size_t)(b * 64 + cc_) * RH + h; const size_t rw0_ = (size_t)b * SEQ + cc_ * 64; \
            _Pragma("unroll") for (int mt = 0; mt < 4; ++mt) O_.qv[mt] = *(const u32x2*)(B.Qp + item_ * 4096 + (size_t)((wv * 4 + mt) * 64 + lane) * 4); \
            const bf16_t* yp_ = B.CAT + (rw0_ + 16 * wv + n) * D + h * 64 + q * 16; O_.y0 = *(const u32x4*)yp_; O_.y1 = *(const u32x4*)(yp_ + 8); } while (0)
        f32x4 S[4];
#pragma unroll
        for (int mt = 0; mt < 4; ++mt) S[mt] = (f32x4){0.f, 0.f, 0.f, 0.f};
        R2Own Oa, Ob, Oc, Od;
        if (wave >= 4) { R2_ISSUE(0); R2_ISSUE(1); R2_ISSUE(2); R2_ISSUE(3); R2_ISSUE(4); R2_ISSUE(5); R2_ISSUE(6); R2_LANDED(0); }
        else { R2_OWN(Oa, 0); R2_OWN(Ob, 1); R2_OWN(Oc, 2); R2_OWN(Od, 3); }
        __syncthreads();
#define R2_STEP(O_, c_) do { const int c = (c_); \
            if (wave >= 4) { if (c + R2_LA < 64) R2_ISSUE(c + R2_LA); if (c + 1 < 64) R2_LANDED(c + 1); } \
            else { \
                const size_t row0 = (size_t)b * SEQ + c * 64; const LAS unsigned char* sl = lds + (c & 7) * R2_SLOT; \
                bf16x8 pf[8], rf[8]; \
                _Pragma("unroll") for (int f = 0; f < 8; ++f) { pf[f] = *(const LAS bf16x8*)(sl + f * 1024 + lane * 16); rf[f] = *(const LAS bf16x8*)(sl + 8192 + f * 1024 + lane * 16); } \
                f32x4 wl[4]; \
                _Pragma("unroll") for (int mt = 0; mt < 4; ++mt) wl[mt] = *(const LAS f32x4*)(sl + 2 * 8192 + (16 * mt + 4 * q) * 4); \
                bf16_t* yp = B.CAT + (row0 + 16 * wv + n) * D + h * 64 + q * 16; \
                  \
                bf16x8 sh[2], sl2[2]; \
                _Pragma("unroll") for (int ks = 0; ks < 2; ++ks) { unsigned hw[4], lw[4]; \
                    _Pragma("unroll") for (int hf = 0; hf < 2; ++hf) { const f32x4 s = S[2 * ks + hf]; \
                        const unsigned h01 = cvt_pk_bf16(s[0], s[1]), h23 = cvt_pk_bf16(s[2], s[3]); \
                        hw[2 * hf] = h01; hw[2 * hf + 1] = h23; \
                        lw[2 * hf] = cvt_pk_bf16(s[0] - bflo(h01), s[1] - bfhi(h01)); lw[2 * hf + 1] = cvt_pk_bf16(s[2] - bflo(h23), s[3] - bfhi(h23)); } \
                    u32x4 hv = {hw[0], hw[1], hw[2], hw[3]}, lv = {lw[0], lw[1], lw[2], lw[3]}; \
                    sh[ks] = __builtin_bit_cast(bf16x8, hv); sl2[ks] = __builtin_bit_cast(bf16x8, lv); } \
                  \
                f32x4 ya[4]; \
                { const unsigned yw[8] = {O_.y0.x, O_.y0.y, O_.y0.z, O_.y0.w, O_.y1.x, O_.y1.y, O_.y1.z, O_.y1.w}; \
                  _Pragma("unroll") for (int mt = 0; mt < 4; ++mt) ya[mt] = (f32x4){bflo(yw[2 * mt]), bfhi(yw[2 * mt]), bflo(yw[2 * mt + 1]), bfhi(yw[2 * mt + 1])}; } \
                _Pragma("unroll") for (int mt = 0; mt < 4; ++mt) _Pragma("unroll") for (int ks = 0; ks < 2; ++ks) { \
                    ya[mt] = __builtin_amdgcn_mfma_f32_16x16x32_bf16(rf[mt * 2 + ks], sh[ks], ya[mt], 0, 0, 0); ya[mt] = __builtin_amdgcn_mfma_f32_16x16x32_bf16(rf[mt * 2 + ks], sl2[ks], ya[mt], 0, 0, 0); } \
                { u32x4 o0, o1; o0.x = cvt_pk_bf16(ya[0][0], ya[0][1]); o0.y = cvt_pk_bf16(ya[0][2], ya[0][3]); o0.z = cvt_pk_bf16(ya[1][0], ya[1][1]); o0.w = cvt_pk_bf16(ya[1][2], ya[1][3]); \
                  o1.x = cvt_pk_bf16(ya[2][0], ya[2][1]); o1.y = cvt_pk_bf16(ya[2][2], ya[2][3]); o1.z = cvt_pk_bf16(ya[3][0], ya[3][1]); o1.w = cvt_pk_bf16(ya[3][2], ya[3][3]); \
                  if (!dry) { *(u32x4*)yp = o0; *(u32x4*)(yp + 8) = o1; } } \
                  \
                f32x4 sn[4]; \
                _Pragma("unroll") for (int mt = 0; mt < 4; ++mt) { sn[mt] = (f32x4){bflo(O_.qv[mt].x), bfhi(O_.qv[mt].x), bflo(O_.qv[mt].y), bfhi(O_.qv[mt].y)} + wl[mt] * S[mt]; } \
                _Pragma("unroll") for (int mt = 0; mt < 4; ++mt) _Pragma("unroll") for (int ks = 0; ks < 2; ++ks) { \
                    sn[mt] = __builtin_amdgcn_mfma_f32_16x16x32_bf16(pf[mt * 2 + ks], sh[ks], sn[mt], 0, 0, 0); sn[mt] = __builtin_amdgcn_mfma_f32_16x16x32_bf16(pf[mt * 2 + ks], sl2[ks], sn[mt], 0, 0, 0); } \
                _Pragma("unroll") for (int mt = 0; mt < 4; ++mt) S[mt] = sn[mt]; \
                if (c + 4 < 64) R2_OWN(O_, c + 4);        \
            } \
            __syncthreads(); } while (0)
#pragma unroll 1
        for (int c0 = 0; c0 < 64; c0 += 4) { R2_STEP(Oa, c0); R2_STEP(Ob, c0 + 1); R2_STEP(Oc, c0 + 2); R2_STEP(Od, c0 + 3); }
    }
}

__device__ __forceinline__ void rwkv_r3(const RwBufs& B, int gw, int NGW, int nitems, LAS unsigned char* lds, int wave) {
    const int lane = lane_now(), q = lane >> 4, n = lane & 15;
    constexpr int R3P = 144;
    LAS unsigned char* ot = lds + wave * (64 * R3P);
#pragma unroll 1
    for (int item = gw; item < nitems; item += NGW) {
        const int b = item / (64 * RH), c = (item / RH) & 63, h = item % RH; const size_t row0 = (size_t)b * SEQ + c * 64;
        unsigned yw[4][8];
        u32x4 ga[4][2], gb[4][2];
#pragma unroll
        for (int wv = 0; wv < 4; ++wv) { const bf16_t* yp = B.CAT + (row0 + 16 * wv + n) * D + h * 64 + q * 16; const u32x4 y0 = *(const u32x4*)yp, y1 = *(const u32x4*)(yp + 8);
            yw[wv][0] = y0.x; yw[wv][1] = y0.y; yw[wv][2] = y0.z; yw[wv][3] = y0.w; yw[wv][4] = y1.x; yw[wv][5] = y1.y; yw[wv][6] = y1.z; yw[wv][7] = y1.w;
#pragma unroll
            for (int hf = 0; hf < 2; ++hf) { const size_t go = (size_t)item * 4096 + (size_t)(16 * wv + n) * 64 + q * 16 + 8 * hf; ga[wv][hf] = *(const u32x4*)(B.GA + go); gb[wv][hf] = *(const u32x4*)(B.GB + go); } }
        asm volatile("s_waitcnt vmcnt(0)" ::: "memory");
#pragma unroll
        for (int hf = 0; hf < 2; ++hf) {
            float s1[8], s2[8];
#pragma unroll
            for (int e4 = 0; e4 < 8; ++e4) { s1[e4] = 0.f; s2[e4] = 0.f; }
#pragma unroll
            for (int wv = 0; wv < 4; ++wv)
#pragma unroll
                for (int e2 = 0; e2 < 4; ++e2) { const unsigned w = yw[wv][4 * hf + e2]; const float ylo = bflo(w), yhi = bfhi(w); s1[2 * e2] += ylo; s2[2 * e2] += ylo * ylo; s1[2 * e2 + 1] += yhi; s2[2 * e2 + 1] += yhi * yhi; }
#pragma unroll
            for (int e4 = 0; e4 < 8; ++e4) {
#pragma unroll
                for (int o = 1; o < 16; o <<= 1) { s1[e4] += __shfl_xor(s1[e4], o); s2[e4] += __shfl_xor(s2[e4], o); }
                const float mean = s1[e4] * (1.f / 64.f), var = fmaxf(s2[e4] * (1.f / 64.f) - mean * mean, 0.f); s1[e4] = mean; s2[e4] = 1.0f / sqrtf(var + LNX_EPS); }
#pragma unroll
            for (int wv = 0; wv < 4; ++wv) { const u32x4 a0 = ga[wv][hf], b0 = gb[wv][hf];
                const unsigned aw[4] = {a0.x, a0.y, a0.z, a0.w}, bw[4] = {b0.x, b0.y, b0.z, b0.w};
#pragma unroll
                for (int e4 = 0; e4 < 8; ++e4) { const int e = 8 * hf + e4; const unsigned ywd = yw[wv][e >> 1];
                    const float yv = (e & 1) ? bfhi(ywd) : bflo(ywd), gaf = (e & 1) ? bfhi(aw[e4 >> 1]) : bflo(aw[e4 >> 1]), gbf = (e & 1) ? bfhi(bw[e4 >> 1]) : bflo(bw[e4 >> 1]);
                    const float o = (yv - s1[e4]) * s2[e4] * gaf + gbf; const int t = 16 * (e >> 2) + 4 * q + (e & 3);
                    *(LAS bf16_t*)(ot + t * R3P + (16 * wv + n) * 2) = f2bf(o); } }
        }
        LDS_WAIT();
#pragma unroll
        for (int k = 0; k < 8; ++k) { const int t = (lane >> 3) + 8 * k, c8 = lane & 7;
            *(u32x4*)(B.CAT + (row0 + t) * D + h * 64 + c8 * 8) = *(const LAS u32x4*)(ot + t * R3P + c8 * 16); }
        LDS_WAIT();
    }
}

constexpr int S5_TAB_EL = 128 * 256 + 256 * 384;
constexpr int S5_US = 264, S5_ZS = 65, S5_XS = 136;
typedef short bf16x4s __attribute__((ext_vector_type(4)));

__device__ __forceinline__ void s5_tables(const Args& a, LAS unsigned char* lds, bf16_t* TAB, float* A16T, int g, int part, int tid) {
    constexpr int CST = 68;
    LAS float* pwr = (LAS float*)lds; LAS float* pwi = pwr + 17 * 64;
    LAS float* bbr = pwi + 17 * 64; LAS float* bbi = bbr + 64 * 16;
    LAS float* crs = bbi + 64 * 16; LAS float* cis = crs + 16 * CST;
    LAS float* Kt = cis + 16 * CST;
    LAS float* zrs = Kt + 4096; LAS float* zis = zrs + 64;
    __syncthreads();
    {   const float dt = expf(a.in[I_LOG_DT][g]);
        for (int idx = tid; idx < 25 * 64; idx += NTHR) { const int t = idx >> 6, p = idx & 63; const float lr = a.in[I_LAM_RE][g * S5P + p], li = a.in[I_LAM_IM][g * S5P + p];
            const float tt = (t <= 16) ? (float)t : 16.0f * (float)(t - 16), m = expf(lr * dt * tt); float sn, cs; sincosf(li * dt * tt, &sn, &cs); const float vr = m * cs, vi = m * sn;
            if (t <= 16) { pwr[t * 64 + p] = vr; pwi[t * 64 + p] = vi; } else if (part == 0) { A16T[(g * 8 + (t - 17)) * 128 + p] = vr; A16T[(g * 8 + (t - 17)) * 128 + 64 + p] = vi; } }
        if (tid < 64) { const int p = tid; const float lr = a.in[I_LAM_RE][g * S5P + p], li = a.in[I_LAM_IM][g * S5P + p];
            float sn, cs, sh, ch; sincosf(li * dt, &sn, &cs); sincosf(0.5f * li * dt, &sh, &ch); const float em1 = expm1f(lr * dt);
            const float nre = em1 * cs - 2.0f * sh * sh, nim = (em1 + 1.0f) * sn, den = lr * lr + li * li;
            zrs[p] = (nre * lr + nim * li) / den; zis[p] = (nim * lr - nre * li) / den; } }
    for (int i = tid; i < 1024; i += NTHR) { crs[(i >> 6) * CST + (i & 63)] = a.in[I_C_RE][(size_t)g * 1024 + i]; cis[(i >> 6) * CST + (i & 63)] = a.in[I_C_IM][(size_t)g * 1024 + i]; }
    __syncthreads();
    for (int i = tid; i < 1024; i += NTHR) { const int p = i >> 4; const float zr = zrs[p], zi = zis[p], br = a.in[I_B_RE][(size_t)g * S5P * 16 + i], bi = a.in[I_B_IM][(size_t)g * S5P * 16 + i];
        bbr[i] = zr * br - zi * bi; bbi[i] = zr * bi + zi * br; }
    __syncthreads();
    for (int w = tid; w < (4 * part + 4) * 64; w += NTHR) { const int t = w >> 6, j = (w >> 2) & 15, jq = w & 3; f32x4 s4 = {0.f, 0.f, 0.f, 0.f};
#pragma unroll 2
        for (int p4 = 0; p4 < 64; p4 += 4) { const f32x4 cr = *(const LAS f32x4*)(crs + j * CST + p4), ci = *(const LAS f32x4*)(cis + j * CST + p4), ar = *(const LAS f32x4*)(pwr + t * 64 + p4), ai = *(const LAS f32x4*)(pwi + t * 64 + p4);
#pragma unroll
            for (int e = 0; e < 4; ++e) { const float wr = cr[e] * ar[e] - ci[e] * ai[e], wi = cr[e] * ai[e] + ci[e] * ar[e];
                const f32x4 br = *(const LAS f32x4*)(bbr + (p4 + e) * 16 + 4 * jq), bi = *(const LAS f32x4*)(bbi + (p4 + e) * 16 + 4 * jq);
                s4 += wr * br - wi * bi; } }
        if (t == 0 && (j >> 2) == jq) s4[j & 3] += a.in[I_S5D][g * 16 + j];
        *(LAS f32x4*)(Kt + (t << 8) + (j << 4) + 4 * jq) = s4; }
    __syncthreads();
    bf16_t* Gt = TAB + (size_t)g * S5_TAB_EL; bf16_t* MH = Gt + 128 * 256;
    for (int idx = part * 32 * 256 + tid; idx < (part + 1) * 32 * 256; idx += NTHR) { const int pp = idx >> 8, k = idx & 255, s = k >> 4, jp = k & 15, p = pp & 63, t = 15 - s;
        const float ar = pwr[t * 64 + p], ai = pwi[t * 64 + p], br = bbr[p * 16 + jp], bi = bbi[p * 16 + jp];
        Gt[idx] = f2bf(pp < 64 ? (ar * br - ai * bi) : (ar * bi + ai * br)); }
    for (int rr = 0; rr < 64; ++rr) { const int row = part * 64 + rr, t = row >> 4, j = row & 15;
        if (tid < 384) { const int k = tid; float v;
            if (k < 256) { const int s = k >> 4, jp = k & 15; v = (s <= t) ? Kt[((t - s) << 8) + (j << 4) + jp] : 0.f; }
            else { const int pp = k - 256, p = pp & 63; const float cr = crs[j * CST + p], ci = cis[j * CST + p], ar = pwr[(t + 1) * 64 + p], ai = pwi[(t + 1) * 64 + p];
                v = pp < 64 ? (cr * ar - ci * ai) : -(cr * ai + ci * ar); }
            MH[(size_t)row * 384 + k] = f2bf(v); } }
}

__device__ __forceinline__ float gelu_fast_(float x) { const float a2 = 1.5957691216057308f * (x + 0.044715f * x * x * x); return x * __builtin_amdgcn_rcpf(1.0f + __expf(-a2)); }

__device__ __forceinline__ void s5_chunked(const Args& a, LAS unsigned char* lds, const bf16_t* U, const bf16_t* TAB, const float* A16T, bf16_t* CAT, int bx, int G, int wave) {
    const int lane = lane_now(), l15 = lane & 15, kq = lane >> 4, q = kq, n = l15, tid = wave * 64 + lane;
    LAS unsigned char* Us0 = lds; LAS float* Zs = (LAS float*)(lds + 64 * S5_US * 2); LAS unsigned char* Xp = lds + 64 * S5_US * 2 + 128 * S5_ZS * 4;
    LAS unsigned char* Us1 = Xp + 64 * S5_XS * 2 + 8 * 128 * 4;
#define S5_UDMA(buf_, nb_) do { const int ln_ = lane_now(); if (ln_ < 32) { const bf16_t* src_ = UT + (size_t)((nb_) * 64 + 8 * wave) * 256 + ln_ * 8; \
        _Pragma("unroll") for (int i = 0; i < 8; ++i) __builtin_amdgcn_global_load_lds((const unsigned*)(src_ + (size_t)i * 256), (LAS unsigned*)((buf_) + (8 * wave + i) * (S5_US * 2)), 16, 0, 0); } } while (0)
#pragma unroll 1
    for (int item = bx; item < NB * S5G; item += G) {
        const int b = item / S5G, g = item % S5G;
        const bf16_t* UT = U + (size_t)(b * S5G + g) * SEQ * 16;
        const bf16_t* Gt = TAB + (size_t)g * S5_TAB_EL; const bf16_t* MH = Gt + 128 * 256;
        bf16x8 ga[8], mh[2][12];
#pragma unroll
        for (int ks = 0; ks < 8; ++ks) ga[ks] = *(const bf16x8*)(Gt + (size_t)(16 * wave + l15) * 256 + 32 * ks + 8 * kq);
        const int tau0 = wave, tau1 = 15 - wave;
#pragma unroll
        for (int ks = 0; ks < 12; ++ks) { mh[0][ks] = *(const bf16x8*)(MH + (size_t)(16 * tau0 + l15) * 384 + 32 * ks + 8 * kq); mh[1][ks] = *(const bf16x8*)(MH + (size_t)(16 * tau1 + l15) * 384 + 32 * ks + 8 * kq); }
        bf16x4s wg; { unsigned short w4[4];
#pragma unroll
            for (int e = 0; e < 4; ++e) w4[e] = f2bf(a.in[I_WGLU][(size_t)(g * 16 + 4 * kq + e) * 16 + l15]);
            wg = (bf16x4s){(short)w4[0], (short)w4[1], (short)w4[2], (short)w4[3]}; }
        const f32x4 bq = *(const f32x4*)(a.in[I_BGLU] + g * 16 + 4 * q);
        float xr = 0.f, xi = 0.f;
        float apr[8], api[8];
#pragma unroll
        for (int k8 = 0; k8 < 8; ++k8) { apr[k8] = A16T[(g * 8 + k8) * 128 + lane]; api[k8] = A16T[(g * 8 + k8) * 128 + 64 + lane]; }
        LAS float* Ex = (LAS float*)(Xp + 64 * S5_XS * 2);
        __syncthreads();
        S5_UDMA(Us0, 0);
#pragma unroll 1
        for (int nb = 0; nb < 4; ++nb) {
            LAS unsigned char* Us = (nb & 1) ? Us1 : Us0;
            asm volatile("s_waitcnt vmcnt(0)" ::: "memory");
            __syncthreads();
            if (nb + 1 < 4) { if (nb & 1) S5_UDMA(Us0, nb + 1); else S5_UDMA(Us1, nb + 1); }
#pragma unroll
            for (int nt = 0; nt < 4; ++nt) { f32x4 acc = {0.f, 0.f, 0.f, 0.f};
#pragma unroll
                for (int ks = 0; ks < 8; ++ks) acc = __builtin_amdgcn_mfma_f32_16x16x32_bf16(ga[ks], *(const LAS bf16x8*)(Us + (16 * nt + l15) * (S5_US * 2) + (32 * ks + 8 * kq) * 2), acc, 0, 0, 0);
#pragma unroll
                for (int r = 0; r < 4; ++r) Zs[(16 * wave + 4 * q + r) * S5_ZS + 16 * nt + n] = acc[r]; }
            __syncthreads();
            {   float lr8[8], li8[8]; float sr = 0.f, si = 0.f;
#pragma unroll
                for (int i = 0; i < 8; ++i) { lr8[i] = sr; li8[i] = si; const int c = 8 * wave + i; const float zr = Zs[lane * S5_ZS + c], zi = Zs[(64 + lane) * S5_ZS + c];
                    const float nr = apr[0] * sr - api[0] * si + zr, ni = apr[0] * si + api[0] * sr + zi; sr = nr; si = ni; }
                Ex[wave * 128 + lane] = sr; Ex[wave * 128 + 64 + lane] = si;
                __syncthreads();
                float cr = xr, ci = xi, myr = xr, myi = xi;
#pragma unroll
                for (int v = 0; v < 8; ++v) { if (v == wave) { myr = cr; myi = ci; }
                    const float er = Ex[v * 128 + lane], ei = Ex[v * 128 + 64 + lane]; const float nr = apr[7] * cr - api[7] * ci + er, ni = apr[7] * ci + api[7] * cr + ei; cr = nr; ci = ni; }
                xr = cr; xi = ci;
#pragma unroll
                for (int i = 0; i < 8; ++i) { float pr = lr8[i], pi = li8[i];
                    if (i == 0) { pr += myr; pi += myi; } else { pr += apr[i - 1] * myr - api[i - 1] * myi; pi += apr[i - 1] * myi + api[i - 1] * myr; }
                    const int c = 8 * wave + i; *(LAS bf16_t*)(Xp + c * (S5_XS * 2) + lane * 2) = f2bf(pr); *(LAS bf16_t*)(Xp + c * (S5_XS * 2) + (64 + lane) * 2) = f2bf(pi); } }
            __syncthreads();
#pragma unroll
            for (int mi = 0; mi < 2; ++mi) { const int tau = mi ? tau1 : tau0, kmax = tau >> 1;
#pragma unroll 1
                for (int nt = 0; nt < 4; ++nt) { f32x4 acc = {0.f, 0.f, 0.f, 0.f};
                    const LAS unsigned char* ub = Us + (16 * nt + l15) * (S5_US * 2) + (8 * kq) * 2; const LAS unsigned char* xb = Xp + (16 * nt + l15) * (S5_XS * 2) + (8 * kq) * 2;
#pragma unroll
                    for (int ks = 0; ks < 8; ++ks) if (ks <= kmax) acc = __builtin_amdgcn_mfma_f32_16x16x32_bf16(mh[mi][ks], *(const LAS bf16x8*)(ub + 64 * ks), acc, 0, 0, 0);
#pragma unroll
                    for (int ks = 0; ks < 4; ++ks) acc = __builtin_amdgcn_mfma_f32_16x16x32_bf16(mh[mi][8 + ks], *(const LAS bf16x8*)(xb + 64 * ks), acc, 0, 0, 0);
                    f32x4 yg; yg[0] = gelu_fast_(acc[0]); yg[1] = gelu_fast_(acc[1]); yg[2] = gelu_fast_(acc[2]); yg[3] = gelu_fast_(acc[3]);
                    const unsigned p01 = cvt_pk_bf16(yg[0], yg[1]), p23 = cvt_pk_bf16(yg[2], yg[3]); const u32x2 pk = {p01, p23};
                    const f32x4 z = __builtin_amdgcn_mfma_f32_16x16x16bf16_1k(wg, __builtin_bit_cast(bf16x4s, pk), bq, 0, 0, 0);
                    const int t = (nb * 64 + 16 * nt + n) * 16 + tau;
                    u32x2 o; o.x = cvt_pk_bf16(yg[0] * sigmoidf_(z[0]), yg[1] * sigmoidf_(z[1])); o.y = cvt_pk_bf16(yg[2] * sigmoidf_(z[2]), yg[3] * sigmoidf_(z[3]));
                    *(u32x2*)(CAT + ((size_t)b * SEQ + t) * D + g * 16 + 4 * q) = o; } }
        }
    }
}

constexpr int AT_KS = 72, AT_VS = 264;
__device__ __forceinline__ void attn_mfma(LAS unsigned char* lds, const bf16_t* Q, const bf16_t* KV, bf16_t* CAT, int bx, int G, int wave) {
    const int lane = lane_now(), l15 = lane & 15, kq = lane >> 4, q = kq, n = l15, tid = wave * 64 + lane;
    LAS unsigned char* Ks = lds; LAS unsigned char* Vt = lds + 256 * AT_KS * 2;
#pragma unroll 1
    for (int item = bx; item < NB * NH_MEM * 16; item += G) {
        const int b = item >> 6, h = (item >> 4) & 3, qb = item & 15;
        __syncthreads();
#pragma unroll
        for (int i = 0; i < 4; ++i) { const int idx = tid + 512 * i, key = idx >> 3, seg = idx & 7;
            const bf16_t* src = KV + (size_t)(b * MEML + key) * 512 + h * 64 + seg * 8;
            *(LAS u32x4*)(Ks + key * (AT_KS * 2) + seg * 16) = *(const u32x4*)src;
            const u32x4 vw = *(const u32x4*)(src + 256); const unsigned vv[4] = {vw.x, vw.y, vw.z, vw.w};
#pragma unroll
            for (int e = 0; e < 4; ++e) { *(LAS bf16_t*)(Vt + (seg * 8 + 2 * e) * (AT_VS * 2) + key * 2) = (bf16_t)(vv[e] & 0xffffu); *(LAS bf16_t*)(Vt + (seg * 8 + 2 * e + 1) * (AT_VS * 2) + key * 2) = (bf16_t)(vv[e] >> 16); } }
        __syncthreads();
#pragma unroll 1
        for (int tile = 0; tile < 2; ++tile) {
            const size_t qrow = (size_t)b * SEQ + qb * 256 + wave * 32 + tile * 16;
            bf16x8 qf[2];
#pragma unroll
            for (int ks = 0; ks < 2; ++ks) qf[ks] = *(const bf16x8*)(Q + (qrow + l15) * CM + h * 64 + 32 * ks + 8 * kq);
            f32x4 s[16];
#pragma unroll
            for (int kt = 0; kt < 16; ++kt) { f32x4 acc = {0.f, 0.f, 0.f, 0.f};
#pragma unroll
                for (int ks = 0; ks < 2; ++ks) acc = __builtin_amdgcn_mfma_f32_16x16x32_bf16(*(const LAS bf16x8*)(Ks + (16 * kt + l15) * (AT_KS * 2) + (32 * ks + 8 * kq) * 2), qf[ks], acc, 0, 0, 0);
                s[kt] = acc; if (kt & 1) asm volatile("" ::: "memory"); }
            float m = -3.0e38f;
#pragma unroll
            for (int kt = 0; kt < 16; ++kt) m = fmaxf(m, fmaxf(fmaxf(s[kt][0], s[kt][1]), fmaxf(s[kt][2], s[kt][3])));
            m = fmaxf(m, __shfl_xor(m, 16)); m = fmaxf(m, __shfl_xor(m, 32));
            float sum = 0.f; const float c = 0.125f * 1.4426950408889634f;
#pragma unroll
            for (int kt = 0; kt < 16; ++kt)
#pragma unroll
                for (int r = 0; r < 4; ++r) { const float p = __builtin_amdgcn_exp2f((s[kt][r] - m) * c); s[kt][r] = p; sum += p; }
            sum += __shfl_xor(sum, 16); sum += __shfl_xor(sum, 32);
            const float inv = 1.0f / sum;
            bf16x8 pf[8];
#pragma unroll
            for (int k2 = 0; k2 < 8; ++k2) { const u32x4 w = {cvt_pk_bf16(s[2 * k2][0], s[2 * k2][1]), cvt_pk_bf16(s[2 * k2][2], s[2 * k2][3]), cvt_pk_bf16(s[2 * k2 + 1][0], s[2 * k2 + 1][1]), cvt_pk_bf16(s[2 * k2 + 1][2], s[2 * k2 + 1][3])};
                pf[k2] = __builtin_bit_cast(bf16x8, w); }
#pragma unroll 1
            for (int dt = 0; dt < 4; ++dt) { f32x4 acc = {0.f, 0.f, 0.f, 0.f};
#pragma unroll
                for (int k2 = 0; k2 < 8; ++k2) { const LAS unsigned char* vp = Vt + (16 * dt + l15) * (AT_VS * 2) + (32 * k2 + 4 * kq) * 2;
                    const u32x2 v0 = *(const LAS u32x2*)vp, v1 = *(const LAS u32x2*)(vp + 32); const u32x4 vw = {v0.x, v0.y, v1.x, v1.y};
                    acc = __builtin_amdgcn_mfma_f32_16x16x32_bf16(__builtin_bit_cast(bf16x8, vw), pf[k2], acc, 0, 0, 0); }
                u32x2 o; o.x = cvt_pk_bf16(acc[0] * inv, acc[1] * inv); o.y = cvt_pk_bf16(acc[2] * inv, acc[3] * inv);
                *(u32x2*)(CAT + (qrow + n) * D + CS + h * 64 + 16 * dt + 4 * q) = o; }
        }
    }
}
constexpr int N_PHASES = 15;

__device__ __forceinline__ TrJob small_job(const Args& a, int j) {
    unsigned char* ws = a.ws; TrJob r;
    switch (j) {
    case 0: r = TrJob{a.in[I_WINA], (bf16_t*)(ws + WS_WINA), a.in[I_NORM_MIX], D, D, 0, 0, 0.f}; break;
    case 1: r = TrJob{a.in[I_WOUT], (bf16_t*)(ws + WS_WOUT0), nullptr, D, D, 0, 0, 0.f}; break;
    case 2: r = TrJob{a.in[I_WOUT] + (size_t)D * D, (bf16_t*)(ws + WS_WOUT1), nullptr, D, D, 0, 0, 0.f}; break;
    case 3: r = TrJob{a.in[I_WKV], (bf16_t*)(ws + WS_WKV), nullptr, D, 512, 0, 0, 0.f}; break;
    case 4: r = TrJob{a.in[I_WKV] + (size_t)D * 512, (bf16_t*)(ws + WS_WKV) + (size_t)512 * D, nullptr, D, 512, 0, 0, 0.f}; break;
    case 5: r = TrJob{a.in[I_FGATE], (bf16_t*)(ws + WS_WGU0), a.in[I_NORM_FFN], D, FD, 1, 0, 0.f}; break;
    case 6: r = TrJob{a.in[I_FUP], (bf16_t*)(ws + WS_WGU0), a.in[I_NORM_FFN], D, FD, 2, 0, 0.f}; break;
    case 7: r = TrJob{a.in[I_FDOWN], (bf16_t*)(ws + WS_WD0), nullptr, FD, D, 0, 0, 0.f}; break;
    case 8: r = TrJob{a.in[I_WINB], (bf16_t*)(ws + WS_WINB), a.in[I_NORM_MIX] + D, D, INB, 0, 0, 0.f}; break;
    case 9: r = TrJob{a.in[I_W2], (bf16_t*)(ws + WS_W2T), nullptr, 64, CS, 0, 0, 0.f}; break;
    case 10: r = TrJob{a.in[I_A2], (bf16_t*)(ws + WS_A2T), nullptr, 64, CS, 0, 0, 0.f}; break;
    default: r = TrJob{a.in[I_G2], (bf16_t*)(ws + WS_G2T), nullptr, 128, CS, 0, 0, 0.f}; break;
    }
    r.items = (r.K / 64) * (r.N / 32); r.f8s = 0.f; return r;
}
__device__ __forceinline__ TrJob moe_job(const Args& a, int j) {
    unsigned char* ws = a.ws; const int kind = j >> 3, e = j & 7; TrJob r;
    if (kind == 0) r = TrJob{a.in[I_MGATE] + (size_t)e * D * FE, (bf16_t*)(ws + WS_WMOE_GU + (size_t)e * 2 * FE * D), a.in[I_NORM_FFN] + D, D, FE, 1, 0, F8_WGU};
    else if (kind == 1) r = TrJob{a.in[I_MUP] + (size_t)e * D * FE, (bf16_t*)(ws + WS_WMOE_GU + (size_t)e * 2 * FE * D), a.in[I_NORM_FFN] + D, D, FE, 2, 0, F8_WGU};
    else r = TrJob{a.in[I_MDOWN] + (size_t)e * FE * D, (bf16_t*)(ws + WS_WMOE_D + (size_t)e * D * FE), nullptr, FE, D, 0, 0, F8_WD};
    r.items = (r.K / 64) * (r.N / 32); return r;
}

__device__ __forceinline__ void moe_convert(const Args& args, LAS float* scr, int cw, int ncw, int lane) {
    constexpr int JI = (D / 64) * (FE / 32), NGI = 24 * JI; static_assert((FE / 64) * (D / 32) == JI, "moe jobs differ in size");
    TrRegs R0, R1; int g0 = cw, g1 = cw + ncw;
    if (g0 < NGI) tr_load(moe_job(args, g0 / JI), g0 % JI, lane, R0);
    if (g1 < NGI) tr_load(moe_job(args, g1 / JI), g1 % JI, lane, R1);
#pragma unroll 1
    for (; g0 < NGI; g0 += 2 * ncw, g1 += 2 * ncw) {
        __builtin_amdgcn_sched_barrier(0);
        tr_fin(moe_job(args, g0 / JI), g0 % JI, scr, lane, R0);
        if (g0 + 2 * ncw < NGI) tr_load(moe_job(args, (g0 + 2 * ncw) / JI), (g0 + 2 * ncw) % JI, lane, R0);
        __builtin_amdgcn_sched_barrier(0);
        if (g1 < NGI) { tr_fin(moe_job(args, g1 / JI), g1 % JI, scr, lane, R1);
            if (g1 + 2 * ncw < NGI) tr_load(moe_job(args, (g1 + 2 * ncw) / JI), (g1 + 2 * ncw) % JI, lane, R1); } }
}

__device__ __forceinline__ void p0_transposes(const Args& args, LAS unsigned char* lds, int wave, int gw, int NGW) {
    unsigned char* ws = args.ws;
    LAS float* scr = (LAS float*)(lds + wave * 16384);
    {
        int base = 0;
        for (int j = 0; j < 12; ++j) { const TrJob jb = small_job(args, j);
            for (int it = gw - base; it < jb.items; it += NGW) { if (it >= 0) tr_item(jb.W, jb.K, jb.N, jb.WT, jb.gain, jb.mode, scr, it, lane_now()); }
            base = (base + jb.items) % NGW; }
    }
}
__device__ __forceinline__ void p0_memn(const Args& args, int gw, int NGW) {
    unsigned char* ws = args.ws;
    for (int r = gw; r < 2 * MROWS; r += NGW) { const int li = r / MROWS, row = r % MROWS;
        const f32x4* xr = (const f32x4*)(args.in[I_MEM] + (size_t)row * D) + lane_now(); const f32x4* gr = (const f32x4*)(args.in[I_NORM_MEM] + li * D) + lane_now();
        f32x4 v[4]; float s = 0.f;
#pragma unroll
        for (int j = 0; j < 4; ++j) { v[j] = xr[64 * j]; s += (v[j][0] * v[j][0] + v[j][1] * v[j][1]) + (v[j][2] * v[j][2] + v[j][3] * v[j][3]); }
        const float rs = rstd_of(wave_sum_fast(s));
        u32x2* o = (u32x2*)((bf16_t*)(ws + WS_MEMN) + ((size_t)li * MROWS + row) * D) + lane_now();
#pragma unroll
        for (int j = 0; j < 4; ++j) { const f32x4 g = gr[64 * j]; u32x2 w; w.x = cvt_pk_bf16(v[j][0] * rs * g[0], v[j][1] * rs * g[1]); w.y = cvt_pk_bf16(v[j][2] * rs * g[2], v[j][3] * rs * g[3]); o[64 * j] = w; }
    }
}
__device__ __forceinline__ void p0_xconv(const Args& args, bf16_t* HA, rss_t* rowss, int gw, int NGW) {
    for (int r = gw; r < T; r += 2 * NGW) {
        const int r2 = r + NGW; const bool has2 = r2 < T;
        const f32x4* xr = (const f32x4*)(args.in[I_X] + (size_t)r * D) + lane_now(); const f32x4* xq = (const f32x4*)(args.in[I_X] + (size_t)(has2 ? r2 : r) * D) + lane_now();
        f32x4 v[4], w[4]; float s = 0.f, s2 = 0.f;
#pragma unroll
        for (int j = 0; j < 4; ++j) { v[j] = xr[64 * j]; w[j] = xq[64 * j]; }
#pragma unroll
        for (int j = 0; j < 4; ++j) { s += (v[j][0] * v[j][0] + v[j][1] * v[j][1]) + (v[j][2] * v[j][2] + v[j][3] * v[j][3]); s2 += (w[j][0] * w[j][0] + w[j][1] * w[j][1]) + (w[j][2] * w[j][2] + w[j][3] * w[j][3]); }
        s = wave_sum_fast(s); s2 = wave_sum_fast(s2);
        if (lane_now() == 0) { rowss[r] = rss_fx(s); if (has2) rowss[r2] = rss_fx(s2); }
        u32x2* o = (u32x2*)(HA + (size_t)r * D) + lane_now(); u32x2* o2 = (u32x2*)(HA + (size_t)r2 * D) + lane_now();
#pragma unroll
        for (int j = 0; j < 4; ++j) { u32x2 p; p.x = cvt_pk_bf16(v[j][0], v[j][1]); p.y = cvt_pk_bf16(v[j][2], v[j][3]); o[64 * j] = p;
            if (has2) { u32x2 p2; p2.x = cvt_pk_bf16(w[j][0], w[j][1]); p2.y = cvt_pk_bf16(w[j][2], w[j][3]); o2[64 * j] = p2; } }
    }
}

template <int LO, int HI> __global__ void __launch_bounds__(NTHR, 2) fwd(Args args) {
    extern __shared__ __attribute__((aligned(16))) unsigned char lds_raw[];
    LAS unsigned char* lds = (LAS unsigned char*)lds_raw;
    volatile LAS unsigned* MISC = (volatile LAS unsigned*)(lds + LDS_MISC);
    const int wave = __builtin_amdgcn_readfirstlane(threadIdx.x >> 6);
#define lane (lane_now())
#define tid (wave * 64 + lane_now())
    const int G = gridDim.x, bx = blockIdx.x;
    const int gw = bx * NWAVES + wave, NGW = G * NWAVES;
    typedef __attribute__((address_space(1))) unsigned char gbyte_t;
    gbyte_t* wsg = (gbyte_t*)args.ws;
#define ws ((unsigned char*)wsg)
    unsigned* ctl = (unsigned*)(ws + WS_CTL);
    rss_t* rowss = (rss_t*)(ws + WS_CTL + CTL_ROWSS);
    float* X = args.out;
    bf16_t* HA = (bf16_t*)(ws + WS_HA);
    const int lo = args.ph_lo, hi = args.ph_hi;
    for (int u = tid; u < (LDS_BYTES - LDS_MISC) / 4; u += NTHR) ((LAS unsigned*)(lds + LDS_MISC))[u] = 0u;
    __syncthreads();
    XcdBarrier bar; bar.bar = ctl + CW_BAR; bar.x = 0; bar.st = nullptr; bar.wave = wave;
    const bool multi = (hi - lo) > 1;
    if (multi) bar = xcd_barrier_post(ctl + CW_BAR, MISC + 8);
#define IN(k) (LO <= (k) && (k) < HI && lo <= (k) && (k) < hi)
#define WS_FENCE() asm volatile("" : "+s"(wsg))
#ifdef TS_PHASE
    int nst = 0; volatile LAS unsigned long long* TSL = (volatile LAS unsigned long long*)(lds + LDS_MISC + 512);
#define STAMP() do { if (bx == 0 && threadIdx.x == 0) TSL[nst] = __builtin_amdgcn_s_memrealtime(); ++nst; } while (0)
#else
#define STAMP() do {} while (0)
#endif
    STAMP();
#ifdef TS_DUP
#define TS_T0() do { if (lane_now() == 0) *(volatile LAS unsigned long long*)(lds + LDS_MISC + 512 + 8 * wave) = __builtin_amdgcn_s_memrealtime(); } while (0)
#define TS_IDLE(k) do { if (((TS_DUP) >> (k)) & 1) { const unsigned long long t1_ = __builtin_amdgcn_s_memrealtime(), t0_ = *(volatile LAS unsigned long long*)(lds + LDS_MISC + 512 + 8 * wave); \
        const unsigned long long tgt_ = t1_ + (t1_ - t0_); while (__builtin_amdgcn_s_memrealtime() < tgt_) __builtin_amdgcn_s_sleep(8); } } while (0)
#else
#define TS_T0() do {} while (0)
#define TS_IDLE(k) do {} while (0)
#endif
    TS_T0();
#define SEAM(k) do { if (IN(k)) TS_IDLE(k); if (IN(k) && IN((k) + 1)) xcd_barrier(bar); TS_T0(); STAMP(); WS_FENCE(); } while (0)

    if (IN(0)) {
        if (bx < 4 * S5G) { s5_tables(args, lds, (bf16_t*)(ws + WS_S5TAB), (float*)(ws + WS_S5TAB + 12 * MiB), bx >> 2, bx & 3, tid); __syncthreads(); }
        p0_transposes(args, lds, wave, gw, NGW);
        p0_memn(args, gw, NGW);
        {
            constexpr int NTAB = 4 * S5G, KSH = 2; const int vw = (G > NTAB) ? NTAB + (G - NTAB) * KSH : G;
            if (G <= NTAB || bx < NTAB) p0_xconv(args, HA, rowss, gw, vw * NWAVES);
            else for (int j = 0; j < KSH; ++j) p0_xconv(args, HA, rowss, (NTAB + (bx - NTAB) * KSH + j) * NWAVES + wave, vw * NWAVES); }
#ifdef DUP_P0
        xcd_barrier(bar);
#if DUP_P0 & 1
        if (bx < 4 * S5G) { s5_tables(args, lds, (bf16_t*)(ws + WS_S5TAB), (float*)(ws + WS_S5TAB + 12 * MiB), bx >> 2, bx & 3, tid); __syncthreads(); }
#endif
#if DUP_P0 & 2
        p0_transposes(args, lds, wave, gw, NGW);
#endif
#if DUP_P0 & 4
        p0_memn(args, gw, NGW);
#endif
#if DUP_P0 & 8
        p0_xconv(args, HA, rowss, gw, NGW);
#endif
#endif
    }
    SEAM(0);

    if (IN(1)) {
        { pg8::DenseSched S; S.init(HA, ws + WS_WINA, T, D, D, G, bx);
          EpiInA E{(bf16_t*)(ws + WS_P0U), (bf16_t*)(ws + WS_P0Q), rowss};
          pg8::gemm_phase<EpiInA, pg8::DenseSched, true>(lds, D, S, E, 0, wave); }
        __syncthreads();
        { pg8::KvSched S; S.init(ws + WS_MEMN, ws + WS_WKV, G, (bx + 64) % G);
          EpiBf16 E{(bf16_t*)(ws + WS_KV), 512, nullptr, nullptr, 0};
          pg8::gemm_phase<EpiBf16, pg8::KvSched, true>(lds, D, S, E, 0, wave); }
    }
    SEAM(1);

    if (IN(2)) {
        bf16_t* CAT = (bf16_t*)(ws + WS_CAT);
        {
            const int n2 = NB * S5G - G;
            if (n2 > 0 && n2 < G) { if (bx >= n2) attn_mfma(lds, (const bf16_t*)(ws + WS_P0Q), (const bf16_t*)(ws + WS_KV), CAT, bx - n2, G - n2, wave); }
            else attn_mfma(lds, (const bf16_t*)(ws + WS_P0Q), (const bf16_t*)(ws + WS_KV), CAT, bx, G, wave); }
        __syncthreads();
#ifdef S5_NAIVE
        s5_naive(args, lds, (const bf16_t*)(ws + WS_P0U), CAT, bx, G, wave, lane);
#else
        s5_chunked(args, lds, (const bf16_t*)(ws + WS_P0U), (const bf16_t*)(ws + WS_S5TAB), (const float*)(ws + WS_S5TAB + 12 * MiB), CAT, bx, G, wave);
#endif
#ifdef DUP_P2
        xcd_barrier(bar);
#if DUP_P2 & 1
        attn_mfma(lds, (const bf16_t*)(ws + WS_P0Q), (const bf16_t*)(ws + WS_KV), CAT, bx, G, wave);
        __syncthreads();
#endif
#if DUP_P2 & 2
        s5_chunked(args, lds, (const bf16_t*)(ws + WS_P0U), (const bf16_t*)(ws + WS_S5TAB), (const float*)(ws + WS_S5TAB + 12 * MiB), CAT, bx, G, wave);
#endif
#endif
    }
    SEAM(2);

    if (IN(3)) {
        pg8::DenseSched S; S.init(ws + WS_CAT, ws + WS_WOUT0, T, D, D, G, bx);
        EpiRes E{args.in[I_X], nullptr, HA, rowss + T, nullptr};
        pg8::gemm_phase<EpiRes, pg8::DenseSched, true>(lds, D, S, E, 0, wave);
    }
    SEAM(3);

#ifdef DUP_P4
#pragma unroll 1
    for (int rep = 0; rep < 2; ++rep) {
#endif
    if (IN(4)) {
        pg8::DenseSched S; S.init(HA, ws + WS_WGU0, T, 2 * FD, D, G, bx);
        #ifdef DUP_P4
        int sk_ = (rep == 0) ? DUP_SKIP : 0; asm volatile("" : "+s"(sk_));
        EpiSwiglu E{(bf16_t*)(ws + WS_ACT0), FD, rowss + T, nullptr, sk_};
#else
        EpiSwiglu E{(bf16_t*)(ws + WS_ACT0), FD, rowss + T, nullptr, 0};
#endif
#ifdef DUP_P4
        if (rep == 0) pg8::gemm_phase<EpiSwiglu, pg8::DenseSched, true, false, DUP_VAR>(lds, D, S, E, 0, wave); else
#endif
        pg8::gemm_phase<EpiSwiglu, pg8::DenseSched, true>(lds, D, S, E, 0, wave);
    }
#ifdef DUP_P4
    if (rep == 0) xcd_barrier(bar); }
#endif
    SEAM(4);

    if (IN(5)) {
        pg8::DenseSched S; S.init(ws + WS_ACT0, ws + WS_WD0, T, D, FD, G, bx);
        EpiRes E{nullptr, HA, HA, rowss + 2 * T, nullptr};
        pg8::gemm_phase<EpiRes, pg8::DenseSched, true>(lds, FD, S, E, 0, wave);
    }
    SEAM(5);

    if (IN(6)) {
        pg8::DenseSched S; S.init(HA, ws + WS_WINB, T, INB, D, G, bx);
        EpiBf16 E{(bf16_t*)(ws + WS_P1), INB, rowss + 2 * T, (bf16_t*)(ws + WS_P0Q), SHIFTC};
        pg8::gemm_phase<EpiBf16, pg8::DenseSched, true>(lds, D, S, E, 0, wave);
#ifdef DUP_P6
        xcd_barrier(bar); pg8::gemm_phase<EpiBf16, pg8::DenseSched, true>(lds, D, S, E, 0, wave);
#endif
    }
    SEAM(6);

    RwBufs RB; RB.dbg = ctl + 16387;
#ifdef DBG_RWKV
    RB.Pp = (bf16_t*)(ws + 78 * MiB); RB.Qp = (bf16_t*)(ws + 84 * MiB); RB.Rp = (bf16_t*)(ws + 90 * MiB); RB.GA = (bf16_t*)(ws + 96 * MiB); RB.GB = (bf16_t*)(ws + 102 * MiB); RB.WL = (float*)(ws + 108 * MiB);
    RB.CAT = (bf16_t*)(ws + 110 * MiB);
    constexpr int RW_ITEMS = 64 * RH, RW_BH = RH;
#else
    { unsigned char* ob = (unsigned char*)args.out; RB.Pp = (bf16_t*)ob; RB.WL = (float*)(ob + 48 * MiB); RB.XL = (bf16_t*)(ob + 50 * MiB); }
    RB.Qp = (bf16_t*)(ws + WS_RQP); RB.Rp = (bf16_t*)(ws + WS_RRP); RB.GA = (bf16_t*)(ws + WS_RGA); RB.GB = (bf16_t*)(ws + WS_RGB);
    RB.CAT = (bf16_t*)(ws + WS_CAT);
    constexpr int RW_ITEMS = NB * 64 * RH, RW_BH = NB * RH;
#endif
#ifdef DBG_RWKV
    RB.XL = (bf16_t*)(ws + WS_RXL);
#endif
    RB.P1 = (const bf16_t*)(ws + WS_P1); RB.w2T = (const bf16_t*)(ws + WS_W2T); RB.a2T = (const bf16_t*)(ws + WS_A2T); RB.g2T = (const bf16_t*)(ws + WS_G2T);
    if (IN(7)) {
        rwkv_xpre(args, RB, bx, G, wave);
        xcd_barrier(bar);
#ifdef DBG_RWKV
        rwkv_prep(args, lds, (const bf16_t*)(ws + WS_P1), (bf16_t*)(ws + 432 * MiB), (bf16_t*)(ws + 480 * MiB), (bf16_t*)(ws + 128 * MiB), (bf16_t*)(ws + 2 * MiB), bx, G, tid);
        __syncthreads();
#endif
        rwkv_r1(args, lds, RB, bx, G, wave, RW_ITEMS);
#ifdef DUP_R1
        xcd_barrier(bar); rwkv_r1(args, lds, RB, bx, G, wave, RW_ITEMS);
#endif
    }
    SEAM(7);
    if (IN(8)) {
#ifdef DUP_R2
        rwkv_r2(lds, RB, bx, G, wave, RW_BH, true); xcd_barrier(bar);
#endif
        rwkv_r2(lds, RB, bx, G, wave, RW_BH);
        { const int nr2 = (RW_BH < G) ? RW_BH : G;
          if (nr2 < G) { if (bx >= nr2) { attn_mfma(lds, (const bf16_t*)(ws + WS_P0Q), (const bf16_t*)(ws + WS_KV) + (size_t)MROWS * 512, (bf16_t*)(ws + WS_CAT), bx - nr2, G - nr2, wave);
              __syncthreads(); moe_convert(args, (LAS float*)(lds + wave * 16384), (bx - nr2) * NWAVES + wave, (G - nr2) * NWAVES, lane);
          } }
          else { __syncthreads(); attn_mfma(lds, (const bf16_t*)(ws + WS_P0Q), (const bf16_t*)(ws + WS_KV) + (size_t)MROWS * 512, (bf16_t*)(ws + WS_CAT), bx, G, wave);
                 __syncthreads(); moe_convert(args, (LAS float*)(lds + wave * 16384), gw, NGW, lane); } }
    }
    SEAM(8);
    if (IN(9)) { rwkv_r3(RB, gw, NGW, RW_ITEMS, lds, wave);
    }
    SEAM(9);

    if (IN(10)) {
#ifdef DBG_RWKV
        {   const bf16_t* ref = (const bf16_t*)(ws + WS_CAT); const bf16_t* tst = (const bf16_t*)(ws + 110 * MiB); float sd = 0.f, sr = 0.f;
            for (int r = gw; r < SEQ; r += NGW) {
#pragma unroll
                for (int i = 0; i < 12; ++i) { const float a = bf2f(ref[(size_t)r * D + lane + 64 * i]), b = bf2f(tst[(size_t)r * D + lane + 64 * i]); sd += (a - b) * (a - b); sr += a * a; } }
            sd = wave_sum(sd); sr = wave_sum(sr);
            if (lane == 0) { atomicAdd((float*)(ctl + 16384), sd); atomicAdd((float*)(ctl + 16385), sr); }
            unsigned bad = 0u;
            for (int i = gw * 64 + lane; i < 768 * 64; i += NGW * 64) { const float v = RB.WL[i]; if (!(v - v == 0.f)) bad |= 1u; }
            for (int i = gw * 64 + lane; i < 768 * 4096; i += NGW * 64) { float v = bf2f(RB.GA[i]); if (!(v - v == 0.f)) bad |= 2u; v = bf2f(RB.GB[i]); if (!(v - v == 0.f)) bad |= 4u;
                v = bf2f(RB.Pp[i]); if (!(v - v == 0.f)) bad |= 8u; v = bf2f(RB.Qp[i]); if (!(v - v == 0.f)) bad |= 16u; v = bf2f(RB.Rp[i]); if (!(v - v == 0.f)) bad |= 32u; }
            for (int r = gw; r < SEQ; r += NGW) for (int i = 0; i < 12; ++i) { const float v = bf2f(tst[(size_t)r * D + lane + 64 * i]); if (!(v - v == 0.f)) bad |= 64u; }
            if (bad) atomicOr(ctl + 16386, bad); }
#endif
        pg8::DenseSched S; S.init(ws + WS_CAT, ws + WS_WOUT1, T, D, D, G, bx);
        EpiRes E{nullptr, HA, (bf16_t*)(ws + WS_X3), rowss + 3 * T, (unsigned char*)(ws + WS_HA2)};
        pg8::gemm_phase<EpiRes, pg8::DenseSched, true>(lds, D, S, E, 0, wave);
    }
    SEAM(10);

    if (IN(11)) {
        __syncthreads();
        moe_router(args, (const bf16_t*)(ws + WS_X3), ctl, ws, gw, NGW, lane, lds, wave);
    }
    SEAM(11);

    if constexpr (HI > 12 && LO < 14) {
#pragma unroll 1
    for (int pass = args.pass_lo; pass < args.pass_hi; ++pass) {
        constexpr int pg = 12, pd = 13;
        LAS int* tab = (LAS int*)(lds + LDS_MISC + 256);
        if (IN(pg) || IN(pd)) {
            __syncthreads();
            if (tid == 0) { int acc = 0;
#pragma unroll 1
                for (int e = 0; e < 8; ++e) { const int c = (int)__hip_atomic_load(ctl + CW_CNT + 64 * e, __ATOMIC_RELAXED, __HIP_MEMORY_SCOPE_AGENT); tab[e] = acc; tab[16 + e] = c; acc += (c + 255) >> 8; } tab[8] = acc; }
            __syncthreads();
        }
        const int ntile = (IN(pg) || IN(pd)) ? __builtin_amdgcn_readfirstlane(tab[8]) : 0;
        const int tile0 = 128 * pass, nt_pass = min(128, ntile - tile0);
        if (IN(pg) && nt_pass > 0) {
            MoeGuSched S; S.o.init(nt_pass, 2 * FE / 256, G, bx); S.A = (const char*)(ws + WS_HA2); S.W = (const char*)(ws + WS_WMOE_GU); S.list = (const int*)(ws + WS_ROUTE2 + RT_LIST); S.tab = tab; S.tile0 = tile0;
            EpiSwigluF8 E{(unsigned char*)(ws + WS_MACT), FE, (const float*)(ws + WS_ROUTE2 + RT_LRSTD)};
            pg8::gemm_phase<EpiSwigluF8, MoeGuSched, true, true>(lds, D / 2, S, E, 0, wave);
#ifdef DUP_GU
            if (pass == 0) { xcd_barrier(bar); pg8::gemm_phase<EpiSwigluF8, MoeGuSched, true, true>(lds, D / 2, S, E, 0, wave); }
#endif
        }
        SEAM(pg);
        if (IN(pd) && nt_pass > 0 && pass == 2) {
            MoeDownTailSched S; S.o.init(nt_pass, 4 * TAIL_SPLIT, G, bx); S.A = (const char*)(ws + WS_MACT); S.W = (const char*)(ws + WS_WMOE_D); S.tab = tab; S.tile0 = tile0;
            EpiSlotPart E{(bf16_t*)(ws + WS_TAILP)};
            pg8::gemm_phase<EpiSlotPart, MoeDownTailSched, true, true>(lds, TAIL_K / 2, S, E, FE / 2, wave);
        } else if (IN(pd) && nt_pass > 0) {
            MoeDownSched S; S.o.init(nt_pass, D / 256, G, bx); S.A = (const char*)(ws + WS_MACT); S.W = (const char*)(ws + WS_WMOE_D); S.tab = tab; S.tile0 = tile0;
            EpiSlot E{(bf16_t*)(ws + WS_YSLOT)};
            pg8::gemm_phase<EpiSlot, MoeDownSched, true, true>(lds, FE / 2, S, E, 0, wave);
#ifdef DUP_DN
            if (pass == 0) { xcd_barrier(bar); pg8::gemm_phase<EpiSlot, MoeDownSched, true, true>(lds, FE / 2, S, E, 0, wave); }
#endif
        }
        if (IN(pd)) TS_IDLE(pd);
        if (IN(pd) && (pass + 1 < args.pass_hi || IN(14))) xcd_barrier(bar);
        TS_T0(); STAMP(); WS_FENCE();
    }
    }

    if (IN(14)) {
        LAS int* tab = (LAS int*)(lds + LDS_MISC + 256);
        __syncthreads();
        if (tid == 0) { int acc = 0;
#pragma unroll 1
            for (int e = 0; e < 8; ++e) { const int c = (int)__hip_atomic_load(ctl + CW_CNT + 64 * e, __ATOMIC_RELAXED, __HIP_MEMORY_SCOPE_AGENT); tab[e] = acc; acc += (c + 255) >> 8; } }
        __syncthreads();
        const int* toke = (const int*)(ws + WS_ROUTE2 + RT_TOKE); const int* tokr = (const int*)(ws + WS_ROUTE2 + RT_TOKR); const float* tokw = (const float*)(ws + WS_ROUTE2 + RT_TOKW);
        const bf16_t* Y = (const bf16_t*)(ws + WS_YSLOT); const bf16_t* X3 = (const bf16_t*)(ws + WS_X3); const bf16_t* TP = (const bf16_t*)(ws + WS_TAILP);
        int ms0 = 0, ms1 = 0; float mw0 = 0.f, mw1 = 0.f;
        { const int r = gw + NGW * lane; if (r < T) { const int e0 = toke[2 * r], e1 = toke[2 * r + 1]; mw0 = tokw[2 * r]; mw1 = tokw[2 * r + 1]; ms0 = tab[e0] * 256 + tokr[2 * r]; ms1 = tab[e1] * 256 + tokr[2 * r + 1]; } }
        const int nrow = (gw < T) ? (T - 1 - gw) / NGW + 1 : 0;
        f32x4 gn[4];
#pragma unroll
        for (int j = 0; j < 4; ++j) gn[j] = ((const f32x4*)(args.in[I_NORM_FINAL]) + lane)[64 * j];
        struct FinIn { u32x2 x[4], y0[4], y1[4]; };
#define FIN_LOAD(I_, i_) do { const int r_ = gw + NGW * (i_); const int s0_ = __builtin_amdgcn_readlane(ms0, (i_)), s1_ = __builtin_amdgcn_readlane(ms1, (i_)); \
            const u32x2* xr_ = (const u32x2*)(X3 + (size_t)r_ * D) + lane; \
            const u32x2* y0_ = (const u32x2*)((s0_ < 65536) ? Y + (size_t)s0_ * D : TP + (size_t)(s0_ - 65536) * D) + lane; \
            const u32x2* y1_ = (const u32x2*)((s1_ < 65536) ? Y + (size_t)s1_ * D : TP + (size_t)(s1_ - 65536) * D) + lane; \
            _Pragma("unroll") for (int j = 0; j < 4; ++j) { I_.x[j] = xr_[64 * j]; I_.y0[j] = y0_[64 * j]; I_.y1[j] = y1_[64 * j]; } } while (0)
#define FIN_ROW(I_, i_) do { const int r_ = gw + NGW * (i_); const int s0_ = __builtin_amdgcn_readlane(ms0, (i_)), s1_ = __builtin_amdgcn_readlane(ms1, (i_)); \
            const float w0_ = __builtin_bit_cast(float, __builtin_amdgcn_readlane(__builtin_bit_cast(int, mw0), (i_))), w1_ = __builtin_bit_cast(float, __builtin_amdgcn_readlane(__builtin_bit_cast(int, mw1), (i_))); \
            f32x4 v[4]; float s = 0.f; \
            _Pragma("unroll") for (int j = 0; j < 4; ++j) { const u32x2 a = I_.x[j], b0 = I_.y0[j], b1 = I_.y1[j]; \
                v[j] = (f32x4){bflo(a.x) + w0_ * bflo(b0.x) + w1_ * bflo(b1.x), bfhi(a.x) + w0_ * bfhi(b0.x) + w1_ * bfhi(b1.x), bflo(a.y) + w0_ * bflo(b0.y) + w1_ * bflo(b1.y), bfhi(a.y) + w0_ * bfhi(b0.y) + w1_ * bfhi(b1.y)}; } \
            _Pragma("unroll 1") for (int kk = 0; kk < 2; ++kk) { const int sl = kk ? s1_ : s0_; const float wk = kk ? w1_ : w0_; \
                if (sl >= 65536) { _Pragma("unroll 1") for (int sp = 1; sp < TAIL_SPLIT; ++sp) { const u32x2* yp = (const u32x2*)(TP + ((size_t)sp * 2048 + (sl - 65536)) * D) + lane; \
                    _Pragma("unroll") for (int j = 0; j < 4; ++j) { const u32x2 a = yp[64 * j]; v[j][0] += wk * bflo(a.x); v[j][1] += wk * bfhi(a.x); v[j][2] += wk * bflo(a.y); v[j][3] += wk * bfhi(a.y); } } } } \
            _Pragma("unroll") for (int j = 0; j < 4; ++j) s += (v[j][0] * v[j][0] + v[j][1] * v[j][1]) + (v[j][2] * v[j][2] + v[j][3] * v[j][3]); \
            const float rs = rstd_of(wave_sum_fast(s)); f32x4* o = (f32x4*)(X + (size_t)r_ * D) + lane; \
            _Pragma("unroll") for (int j = 0; j < 4; ++j) o[64 * j] = v[j] * rs * gn[j]; } while (0)
        FinIn Fa, Fb;
        if (nrow > 0) FIN_LOAD(Fa, 0);
#pragma unroll 1
        for (int i = 0; i < nrow; i += 2) {
            if (i + 1 < nrow) FIN_LOAD(Fb, i + 1);
            __builtin_amdgcn_sched_barrier(0);
            FIN_ROW(Fa, i);
            if (i + 2 < nrow) FIN_LOAD(Fa, i + 2);
            __builtin_amdgcn_sched_barrier(0);
            if (i + 1 < nrow) FIN_ROW(Fb, i + 1);
        }
#undef FIN_LOAD
#undef FIN_ROW
        TS_IDLE(14);
    }
#undef IN
#undef SEAM
#undef lane
#undef tid
#undef ws
}

#ifdef DBG_RWKV
__global__ void __launch_bounds__(NTHR, 2) dbg_naive(Args args) {
    extern __shared__ __attribute__((aligned(16))) unsigned char lds_raw[];
    LAS unsigned char* lds = (LAS unsigned char*)lds_raw; unsigned char* ws = args.ws;
    const int wave = __builtin_amdgcn_readfirstlane(threadIdx.x >> 6);
    rwkv_naive(args, lds, (const bf16_t*)(ws + WS_P1), (const bf16_t*)(ws + 432 * MiB), (const bf16_t*)(ws + 480 * MiB), (const bf16_t*)(ws + 128 * MiB), (const bf16_t*)(ws + 2 * MiB), (bf16_t*)(ws + WS_CAT), blockIdx.x, gridDim.x, wave, lane_now());
}
#endif

#ifndef N_LAUNCH_MODE
#define N_LAUNCH_MODE 1
#endif
extern "C" void kernel_launch(void* const* d_in, const int* in_sizes, int n_in, void* d_out, int out_size, void* d_ws, size_t ws_size, hipStream_t stream) {
    static int grid = 0;
    if (grid == 0) {
        if (n_in != N_IN || in_sizes[0] != T * D || out_size != T * D || ws_size < WS_NEED) {
            fprintf(stderr, "kernel_launch: unexpected shapes/workspace: n_in %d in0 %d out %d ws %zu (need %zu)\n", n_in, n_in > 0 ? in_sizes[0] : -1, out_size, ws_size, (size_t)WS_NEED); grid = -1; return; }
        int dev = 0, cus = 0;
        if (hipGetDevice(&dev) != hipSuccess || hipDeviceGetAttribute(&cus, hipDeviceAttributeMultiprocessorCount, dev) != hipSuccess) { grid = -1; return; }
        bool ok = true;
#define SETATTR(K) ok = ok && (hipFuncSetAttribute((const void*)K, hipFuncAttributeMaxDynamicSharedMemorySize, LDS_BYTES) == hipSuccess)
#if N_LAUNCH_MODE == 1
        SETATTR((fwd<0, N_PHASES>));
#else
        SETATTR((fwd<0, 1>)); SETATTR((fwd<1, 2>)); SETATTR((fwd<2, 3>)); SETATTR((fwd<3, 4>)); SETATTR((fwd<4, 5>)); SETATTR((fwd<5, 6>)); SETATTR((fwd<6, 7>)); SETATTR((fwd<7, 8>));
        SETATTR((fwd<8, 9>)); SETATTR((fwd<9, 10>)); SETATTR((fwd<10, 11>)); SETATTR((fwd<11, 12>)); SETATTR((fwd<12, 13>)); SETATTR((fwd<13, 14>)); SETATTR((fwd<14, 15>));
#endif
        if (!ok) { fprintf(stderr, "kernel_launch: hipFuncSetAttribute failed\n"); grid = -1; return; }
        (void)hipGetLastError();
        grid = cus;
    }
    if (grid < 0) return;
    if (hipMemsetAsync((char*)d_ws + WS_CTL, 0, CTL_BYTES, stream) != hipSuccess) return;
    Args a{};
    for (int i = 0; i < N_IN; ++i) a.in[i] = (const float*)d_in[i];
    a.out = (float*)d_out; a.ws = (unsigned char*)d_ws;
#if N_LAUNCH_MODE == 1
    a.ph_lo = 0; a.ph_hi = N_PHASES; a.pass_lo = 0; a.pass_hi = 3;
    hipLaunchKernelGGL((fwd<0, N_PHASES>), dim3(grid), dim3(NTHR), LDS_BYTES, stream, a);
#else
#define LAUNCH1(P) do { a.ph_lo = (P); a.ph_hi = (P) + 1; hipLaunchKernelGGL((fwd<(P), (P) + 1>), dim3(grid), dim3(NTHR), LDS_BYTES, stream, a); } while (0)
    LAUNCH1(0); LAUNCH1(1); LAUNCH1(2); LAUNCH1(3); LAUNCH1(4); LAUNCH1(5); LAUNCH1(6); LAUNCH1(7);
#ifdef DBG_RWKV
    hipLaunchKernelGGL(dbg_naive, dim3(grid), dim3(NTHR), 4096, stream, a); LAUNCH1(8);
#else
    LAUNCH1(8);
#endif
    LAUNCH1(9); LAUNCH1(10); LAUNCH1(11);
    for (int pass = 0; pass < 5; ++pass) { a.pass_lo = pass; a.pass_hi = pass + 1; LAUNCH1(12); LAUNCH1(13); }
    LAUNCH1(14);
#endif
}
```

```cpp
#include <hip/hip_runtime.h>
#include <cstdio>
#include <cstdint>

#define LAS __attribute__((address_space(3)))
#define GAS __attribute__((address_space(1)))
typedef unsigned short bf16_t;
typedef short bf16x8 __attribute__((ext_vector_type(8)));
typedef short bf16x4 __attribute__((ext_vector_type(4)));
typedef float f32x4 __attribute__((ext_vector_type(4)));
typedef float f32x2 __attribute__((ext_vector_type(2)));
typedef unsigned u32x4 __attribute__((ext_vector_type(4)));
typedef unsigned u32x2 __attribute__((ext_vector_type(2)));

constexpr int NB = 8, SEQ = 4096, T = NB * SEQ, D = 1024, MEML = 256, MROWS = NB * MEML;
constexpr int CS = 768, CM = 256, NH_MEM = 4;
constexpr int S5G = 48, S5J = 16, S5P = 64;
constexpr int RH = 12, RN = 64, SHIFTC = 2560, INB = 2816;
constexpr int FD = 2816, NE = 8, FE = 3584;
constexpr float RMS_EPS = 1e-6f, LNX_EPS = 64e-5f;
constexpr int NWAVES = 8, NTHR = 512;

enum { I_X = 0, I_MEM, I_NORM_MIX, I_NORM_MEM, I_WKV, I_WOUT, I_NORM_FFN, I_NORM_FINAL, I_WINA, I_LAM_RE, I_LAM_IM, I_LOG_DT, I_B_RE, I_B_IM, I_C_RE, I_C_IM,
       I_S5D, I_WGLU, I_BGLU, I_FGATE, I_FUP, I_FDOWN, I_WINB, I_MU, I_W0, I_W2, I_A0, I_A2, I_G2, I_KK, I_KA, I_RK, I_LNXW, I_LNXB, I_WR, I_BR, I_MGATE, I_MUP, I_MDOWN, N_IN };

constexpr size_t MiB = 1u << 20;
constexpr size_t WS_CTL = 0, CTL_BYTES = 2 * MiB;
constexpr size_t WS_HA = 2 * MiB;
constexpr size_t WS_ROUTE = 66 * MiB;
constexpr size_t WS_WOUT1 = 70 * MiB;
constexpr size_t WS_KV = 72 * MiB;
constexpr size_t WS_LORA = 76 * MiB;
constexpr size_t WS_W2T = WS_LORA, WS_A2T = WS_LORA + 96 * 1024, WS_G2T = WS_LORA + 192 * 1024;
constexpr size_t WS_WINA = 78 * MiB, WS_WOUT0 = 80 * MiB, WS_WKV = 82 * MiB  , WS_WGU0 = 84 * MiB  , WS_WD0 = 95 * MiB  ,
                 WS_WINB = 101 * MiB  , WS_MEMN = 107 * MiB  , WS_S5TAB = 115 * MiB  ;
constexpr size_t WS_P0U = 128 * MiB;
constexpr size_t WS_P0Q = 176 * MiB;
constexpr size_t WS_CAT = 192 * MiB;
constexpr size_t WS_ACT0 = 256 * MiB;
constexpr size_t WS_P1 = 256 * MiB;
constexpr size_t WS_RPP = 2 * MiB, WS_RWL = 50 * MiB  , WS_RQP = 128 * MiB, WS_RRP = 432 * MiB, WS_RGA = 480 * MiB, WS_RGB = 78 * MiB, WS_RXL = 52 * MiB  , WS_X3 = 340 * MiB  ;
constexpr size_t WS_WMOE_GU = 256 * MiB;
constexpr size_t WS_WMOE_D = 312 * MiB;
constexpr size_t WS_HA2 = 468 * MiB;
constexpr size_t WS_ROUTE2 = 2 * MiB;
constexpr size_t WS_MACT = 6 * MiB;
constexpr size_t WS_YSLOT = 118 * MiB;
constexpr size_t WS_TAILP = 424 * MiB;
constexpr size_t WS_END = 532 * MiB, WS_NEED = 532 * MiB;
constexpr int CW_BAR = 4096;
constexpr int CW_CNT = 8192;
constexpr size_t CTL_ROWSS = 1 * MiB;
constexpr size_t RT_LIST = 0, RT_LRSTD = 1 * MiB, RT_TOKE = 2 * MiB  , RT_TOKR = 2 * MiB + 256 * 1024, RT_TOKW = 2 * MiB + 512 * 1024;

constexpr int LDS_STAGE = 131072, LDS_BYTES = 147456, LDS_MISC = LDS_BYTES - 1024;

typedef __bf16 bf16v2_t __attribute__((ext_vector_type(2)));
__device__ __forceinline__ unsigned cvt_pk_bf16(float lo, float hi) { const f32x2 v = {lo, hi}; const bf16v2_t b = __builtin_convertvector(v, bf16v2_t); return __builtin_bit_cast(unsigned, b); }
__device__ __forceinline__ float bf2f(unsigned short b) { return __uint_as_float(((unsigned)b) << 16); }
__device__ __forceinline__ float bflo(unsigned w) { return __uint_as_float(w << 16); }
__device__ __forceinline__ float bfhi(unsigned w) { return __uint_as_float(w & 0xffff0000u); }
__device__ __forceinline__ bf16_t f2bf(float f) { return (bf16_t)(cvt_pk_bf16(f, 0.f) & 0xffffu); }
__device__ __forceinline__ float wave_sum(float v) {
#pragma unroll
    for (int o = 1; o < 64; o <<= 1) v += __shfl_xor(v, o);
    return v;
}
__device__ __forceinline__ float wave_sum_fast(float v) {
    v += __builtin_bit_cast(float, __builtin_amdgcn_update_dpp(0, __builtin_bit_cast(int, v), 0xB1, 0xf, 0xf, false));
    v += __builtin_bit_cast(float, __builtin_amdgcn_update_dpp(0, __builtin_bit_cast(int, v), 0x4E, 0xf, 0xf, false));
    v += __builtin_bit_cast(float, __builtin_amdgcn_update_dpp(0, __builtin_bit_cast(int, v), 0x141, 0xf, 0xf, false));
    v += __builtin_bit_cast(float, __builtin_amdgcn_update_dpp(0, __builtin_bit_cast(int, v), 0x140, 0xf, 0xf, false));
    const int vi = __builtin_bit_cast(int, v);
    return (__builtin_bit_cast(float, __builtin_amdgcn_readlane(vi, 0)) + __builtin_bit_cast(float, __builtin_amdgcn_readlane(vi, 16))) + (__builtin_bit_cast(float, __builtin_amdgcn_readlane(vi, 32)) + __builtin_bit_cast(float, __builtin_amdgcn_readlane(vi, 48)));
}
__device__ __forceinline__ void wave_sum8(float (&x)[8]) {
    float y[4];
#pragma unroll
    for (int k = 0; k < 4; ++k) { float a = x[2 * k], b = x[2 * k + 1];
        asm volatile("s_nop 1\n\tv_permlane32_swap_b32 %0, %1\n\ts_nop 1" : "+v"(a), "+v"(b));
        float v = a + b;
        v += __builtin_bit_cast(float, __builtin_amdgcn_update_dpp(0, __builtin_bit_cast(int, v), 0xB1, 0xf, 0xf, false));
        v += __builtin_bit_cast(float, __builtin_amdgcn_update_dpp(0, __builtin_bit_cast(int, v), 0x4E, 0xf, 0xf, false));
        v += __builtin_bit_cast(float, __builtin_amdgcn_update_dpp(0, __builtin_bit_cast(int, v), 0x141, 0xf, 0xf, false));
        v += __builtin_bit_cast(float, __builtin_amdgcn_update_dpp(0, __builtin_bit_cast(int, v), 0x140, 0xf, 0xf, false));
        y[k] = v; }
#pragma unroll
    for (int k = 0; k < 4; ++k) { const int vi = __builtin_bit_cast(int, y[k]);
        x[2 * k] = __builtin_bit_cast(float, __builtin_amdgcn_readlane(vi, 0)) + __builtin_bit_cast(float, __builtin_amdgcn_readlane(vi, 16));
        x[2 * k + 1] = __builtin_bit_cast(float, __builtin_amdgcn_readlane(vi, 32)) + __builtin_bit_cast(float, __builtin_amdgcn_readlane(vi, 48)); }
}
__device__ __forceinline__ float tanh_fast_(float x) { const float e = __expf(2.0f * x); return 1.0f - 2.0f * __builtin_amdgcn_rcpf(1.0f + e); }
__device__ __forceinline__ float sigmoidf_(float x) { return __builtin_amdgcn_rcpf(1.0f + __expf(-x)); }
__device__ __forceinline__ float silu_(float x) { return x * __builtin_amdgcn_rcpf(1.0f + __expf(-x)); }
__device__ __forceinline__ float swiglu_rs_(float g, float u, float c1, float c2) { return (g * u) * c2 * __builtin_amdgcn_rcpf(1.0f + __builtin_amdgcn_exp2f(g * c1)); }
__device__ __forceinline__ float gelu_tanh_(float x) { const float a = 0.7978845608028654f * (x + 0.044715f * x * x * x); return 0.5f * x * (1.0f + tanhf(a)); }
__device__ __forceinline__ u32x2 cvt8_fp8(const f32x4 a, const f32x4 b) {
    const float lim = 448.0f; int w0 = 0, w1 = 0;
    w0 = __builtin_amdgcn_cvt_pk_fp8_f32(__builtin_amdgcn_fmed3f(a[0], -lim, lim), __builtin_amdgcn_fmed3f(a[1], -lim, lim), w0, false);
    w0 = __builtin_amdgcn_cvt_pk_fp8_f32(__builtin_amdgcn_fmed3f(a[2], -lim, lim), __builtin_amdgcn_fmed3f(a[3], -lim, lim), w0, true);
    w1 = __builtin_amdgcn_cvt_pk_fp8_f32(__builtin_amdgcn_fmed3f(b[0], -lim, lim), __builtin_amdgcn_fmed3f(b[1], -lim, lim), w1, false);
    w1 = __builtin_amdgcn_cvt_pk_fp8_f32(__builtin_amdgcn_fmed3f(b[2], -lim, lim), __builtin_amdgcn_fmed3f(b[3], -lim, lim), w1, true);
    return (u32x2){(unsigned)w0, (unsigned)w1};
}
constexpr float F8_X = 16.f, F8_WGU = 256.f, F8_ACT = 16.f, F8_WD = 512.f;
__device__ __forceinline__ int lane_now() { int l; asm volatile("v_mbcnt_lo_u32_b32 %0, -1, 0\n\tv_mbcnt_hi_u32_b32 %0, -1, %0" : "=v"(l)); return l; }
#define LDS_WAIT() asm volatile("s_waitcnt lgkmcnt(0)" ::: "memory")
#define VM_WAIT() asm volatile("s_waitcnt vmcnt(0)" ::: "memory")

#define XB_TMO      128
#define XB_XCNT(j)  (256  + 64 * (j))
#define XB_XSUB(j)  (1280 + 64 * (j))
#define XB_XGEN(j)  (2304 + 64 * (j))
#define XB_TOP      3328
#define XB_TOPGEN   3392
#define XCD_BAR_WORDS 3456
#define XB_SPIN_CAP (1u << 18)
__device__ __forceinline__ unsigned xb_ld(unsigned* p)              { return __hip_atomic_load(p, __ATOMIC_RELAXED, __HIP_MEMORY_SCOPE_AGENT); }
__device__ __forceinline__ unsigned xb_add(unsigned* p, unsigned v) { return __hip_atomic_fetch_add(p, v, __ATOMIC_RELAXED, __HIP_MEMORY_SCOPE_AGENT); }
__device__ __forceinline__ unsigned xb_xcc_id() { return (unsigned)__builtin_amdgcn_s_getreg((3 << 11) | 20) & 0xFu; }
#define XB_SPIN(cond, bar) do { unsigned _sp = 0; while (cond) { __builtin_amdgcn_s_sleep(1); \
    if ((++_sp & 255u) == 0u) { if (xb_ld(&(bar)[XB_TMO])) break; if (_sp > XB_SPIN_CAP) { atomicAdd(&(bar)[XB_TMO], 1u); break; } } } } while (0)
struct XcdBarrier { unsigned* bar; unsigned x; volatile LAS unsigned* st; int wave; };
__device__ __forceinline__ XcdBarrier xcd_barrier_post(unsigned* bar, volatile LAS unsigned* st) {
    XcdBarrier b; b.bar = bar; b.x = xb_xcc_id(); b.st = st; b.wave = __builtin_amdgcn_readfirstlane(threadIdx.x >> 6);
    if (threadIdx.x == 0) (void)xb_add(&bar[XB_XCNT(b.x)], 1u);
    return b;
}
__device__ __forceinline__ void xcd_barrier_complete(unsigned* bar, unsigned x, unsigned& nloc, unsigned& nx) {
    const unsigned G = gridDim.x * gridDim.y * gridDim.z;
    unsigned sum, cnt, mine, sp = 0u;
    for (;;) {
        sum = 0u; cnt = 0u; mine = 0u;
#pragma unroll
        for (unsigned j = 0; j < 16; ++j) { const unsigned c = xb_ld(&bar[XB_XCNT(j)]); sum += c; cnt += (c > 0u) ? 1u : 0u; mine = (j == x) ? c : mine; }
        if (sum == G) break;
        __builtin_amdgcn_s_sleep(1);
        if ((++sp & 255u) == 0u) { if (xb_ld(&bar[XB_TMO])) break; if (sp > XB_SPIN_CAP) { atomicAdd(&bar[XB_TMO], 1u); break; } }
    }
    nloc = mine > 0u ? mine : 1u; nx = cnt > 0u ? cnt : 1u;
}
__device__ __forceinline__ void xcd_barrier(const XcdBarrier& b) {
    asm volatile("s_waitcnt vmcnt(0)" ::: "memory");
    __syncthreads();
    if (b.wave == 0 && lane_now() == 0) {
        unsigned* bar = b.bar;
        __builtin_amdgcn_s_waitcnt(0);
        unsigned nloc = b.st[0], nx = b.st[1];
        if (nloc == 0u) { xcd_barrier_complete(bar, b.x, nloc, nx); b.st[0] = nloc; b.st[1] = nx; }
        const unsigned old = xb_add(&bar[XB_XSUB(b.x)], 1u);
        const unsigned gen = old / nloc;
        if (old + 1u == (gen + 1u) * nloc) {
            __builtin_amdgcn_fence(__ATOMIC_RELEASE, "agent");
            asm volatile("s_waitcnt vmcnt(0)" ::: "memory");
            const unsigned og = xb_add(&bar[XB_TOP], 1u);
            const unsigned tg = og / nx;
            if (og + 1u == (tg + 1u) * nx) xb_add(&bar[XB_TOPGEN], 1u);
            else XB_SPIN(xb_ld(&bar[XB_TOPGEN]) == tg, bar);
            __builtin_amdgcn_fence(__ATOMIC_ACQUIRE, "agent");
            xb_add(&bar[XB_XGEN(b.x)], 1u);
            asm volatile("s_waitcnt vmcnt(0)" ::: "memory");
        } else {
            XB_SPIN(xb_ld(&bar[XB_XGEN(b.x)]) == gen, bar);
            __builtin_amdgcn_fence(__ATOMIC_ACQUIRE, "agent");
            asm volatile("s_waitcnt vmcnt(0)" ::: "memory");
        }
    }
    __syncthreads();
}

namespace pg8 {
constexpr int BM = 256, BK = 64, HALF = 128, HTB = HALF * BK * 2, STAGE_BYTES = 8 * HTB, NXCD = 8, WGM = 4;
__host__ __device__ __forceinline__ int lds_byte(int r, int c) { const int st = (r >> 4) * 2 + (c >> 5), rr = r & 15, cc = c & 31, ob = rr * 64 + cc * 2; return st * 1024 + (ob ^ (((ob >> 9) & 1) << 5)); }
__host__ __device__ __forceinline__ void stage_rc(int b, int& R, int& C) { const int st = b / 1024, sb = b % 1024, swz = sb ^ (((sb >> 9) & 1) << 5); R = (st >> 1) * 16 + swz / 64; C = (st & 1) * 32 + (swz % 64) / 2; }
__host__ __device__ __forceinline__ int perm32(int rho) { const int n = rho >> 4, i = rho & 15; return 8 * (i >> 2) + 4 * n + (i & 3); }

struct Unit { int pm, pn, e, rb; };

struct TileOrder {
    int nM, nN, nwg, G, c;
    __device__ void init(int nM_, int nN_, int G_, int c_) { nM = nM_; nN = nN_; nwg = nM * nN; G = G_; c = c_; }
    __device__ bool tile(int i, int& pm, int& pn) const {
        const long L = (long)i * G + c; if (L >= nwg) return false;
        int wgid = (int)L; { const int q = nwg / NXCD, r = nwg % NXCD, xcd = wgid % NXCD, off = wgid / NXCD; wgid = (xcd < r ? xcd * (q + 1) : r * (q + 1) + (xcd - r) * q) + off; }
        const int nig = WGM * nN, gid = wgid / nig, fm = gid * WGM, gsz = (nM - fm) < WGM ? (nM - fm) : WGM;
        pm = fm + ((wgid % nig) % gsz); pn = (wgid % nig) / gsz; return true;
    }
};
struct DenseSched {
    static constexpr bool GATHER = false;
    TileOrder o; const char* A; const char* Bt; int K;
    __device__ void init(const void* A_, const void* Bt_, int M, int N, int K_, int G, int c) { o.init(M / BM, N / BM, G, c); A = (const char*)A_; Bt = (const char*)Bt_; K = K_; }
    __device__ __forceinline__ bool next(int i, Unit& u) const { u.e = 0; u.rb = 0; return o.tile(i, u.pm, u.pn); }
    __device__ __forceinline__ const char* a_ptr() const { return A; }
    __device__ __forceinline__ const char* b_ptr() const { return Bt; }
    __device__ __forceinline__ unsigned a_base(const Unit& u) const { return (unsigned)u.pm * (unsigned)(BM * K * 2); }
    __device__ __forceinline__ unsigned b_base(const Unit& u) const { return (unsigned)u.pn * (unsigned)(BM * K * 2); }
    __device__ __forceinline__ void gather_ids(const Unit&, int, int, int (&)[4]) const {}
};

struct KvSched {
    static constexpr bool GATHER = false;
    TileOrder o; const char* A; const char* Bt;
    __device__ void init(const void* A_, const void* Bt_, int G, int c) { o.init(2 * MROWS / BM, 512 / BM, G, c); A = (const char*)A_; Bt = (const char*)Bt_; }
    __device__ __forceinline__ bool next(int i, Unit& u) const { u.e = 0; u.rb = 0; return o.tile(i, u.pm, u.pn); }
    __device__ __forceinline__ const char* a_ptr() const { return A; }
    __device__ __forceinline__ const char* b_ptr() const { return Bt; }
    __device__ __forceinline__ unsigned a_base(const Unit& u) const { return (unsigned)u.pm * (unsigned)(BM * D * 2); }
    __device__ __forceinline__ unsigned b_base(const Unit& u) const { return ((unsigned)(u.pm >= MROWS / BM ? 512 : 0) + (unsigned)u.pn * BM) * (unsigned)(D * 2); }
    __device__ __forceinline__ void gather_ids(const Unit&, int, int, int (&)[4]) const {}
};
typedef int i32x8v __attribute__((ext_vector_type(8)));
typedef int i32x4v __attribute__((ext_vector_type(4)));
template <class Epi, class Sched, bool ALIGN_EPI, bool FP8 = false, int VAR = 0>
__device__ __forceinline__ void gemm_phase(LAS unsigned char* lds, const int K, const Sched& S, const Epi& E, const int ldk_ = 0, const int wid_ = -1) {
    int widv_ = (wid_ >= 0) ? wid_ : __builtin_amdgcn_readfirstlane(threadIdx.x >> 6); asm volatile("" : "+s"(widv_));
    const int lane = lane_now(), wid = widv_, tid = wid * 64 + lane, wr = wid >> 2, wc = wid & 3, fr = lane & 15, fq = lane >> 4;
    const int nt = K / BK, LD = ldk_ ? ldk_ : K;
    unsigned voffA[2][2], voffB[2];
#pragma unroll
    for (int i = 0; i < 2; ++i) { int R, C; stage_rc(tid * 16 + i * 8192, R, C); const int Rb = (R & ~31) + perm32(R & 31);
        voffA[0][i] = (unsigned)(R * LD + C) * 2u; voffA[1][i] = (unsigned)((R + HALF) * LD + C) * 2u; voffB[i] = (unsigned)(Rb * LD + C) * 2u; }
    const unsigned kstep = (unsigned)(BK * 2);
    const unsigned hstep = (unsigned)(HALF * LD * 2);
    const __amdgpu_buffer_rsrc_t rsA = __builtin_amdgcn_make_buffer_rsrc((void*)S.a_ptr(), 0, 0x7ffffffc, 0x00020000), rsB = __builtin_amdgcn_make_buffer_rsrc((void*)S.b_ptr(), 0, 0x7ffffffc, 0x00020000);
    const unsigned ldsw = (unsigned)wid * 1024u;
    const int aoff = lds_byte(wr * 64 + fr, fq * 8), boff = lds_byte(wc * 32 + fr, fq * 8);
    LAS unsigned char* pA = lds + aoff; LAS unsigned char* pB = lds + 4 * HTB + boff;
#define PG8_SA(b, h) (((b) * 2 + (h)) * HTB)
#define PG8_SB(b, h) ((4 + (b) * 2 + (h)) * HTB)
#define PG8_SBR(b, h) (((b) * 2 + (h)) * HTB)
#define PG8_STAGE_R(rs, bufoff, gbase, voff) do { if constexpr (VAR != 3 && VAR != 4) _Pragma("unroll") for (int _i = 0; _i < 2; ++_i) \
        __builtin_amdgcn_raw_ptr_buffer_load_lds(rs, (LAS unsigned*)(lds + (bufoff) + ldsw + _i * 8192), 16, (voff)[_i], (gbase), 0, 0); } while (0)
#define PG8_STAGE(bufoff, gbase, voff) PG8_STAGE_R(rsB, bufoff, gbase, voff)
#define PG8_STAGE_A(bufoff, gbase, h) do { if constexpr (Sched::GATHER) { \
        __builtin_amdgcn_raw_ptr_buffer_load_lds(rsA, (LAS unsigned*)(lds + (bufoff) + ldsw), 16, (voffA[h][0] & 0xffffu) * (unsigned)(K * 2) + (cpk & 0xffffu), (gbase), 0, 0); \
        __builtin_amdgcn_raw_ptr_buffer_load_lds(rsA, (LAS unsigned*)(lds + (bufoff) + ldsw + 8192), 16, (voffA[h][0] >> 16) * (unsigned)(K * 2) + (cpk >> 16), (gbase), 0, 0); \
        } else { PG8_STAGE_R(rsA, bufoff, (gbase) + (h) * hstep, voffA[0]); } } while (0)
#define PG8_LD8(ptr_) __builtin_shufflevector(*(const LAS i32x4v*)(ptr_), *(const LAS i32x4v*)((ptr_) + 1024), 0, 1, 2, 3, 4, 5, 6, 7)
#define PG8_LDA(dst, b, h) do { if constexpr (VAR == 4 || VAR == 5) { _Pragma("unroll") for (int m = 0; m < 4; ++m) _Pragma("unroll") for (int k = 0; k < 2; ++k) asm volatile("" : "+v"(dst[m][k])); } else if constexpr (FP8) { _Pragma("unroll") for (int m = 0; m < 4; ++m) dst##8[m] = PG8_LD8(pA + PG8_SA(b, h) + m * 2048); } else { \
        _Pragma("unroll") for (int m = 0; m < 4; ++m) _Pragma("unroll") for (int k = 0; k < 2; ++k) dst[m][k] = *(const LAS bf16x8*)(pA + PG8_SA(b, h) + m * 2048 + k * 1024); } } while (0)
#define PG8_LDB(dst, b, h) do { if constexpr (VAR == 4 || VAR == 5) { _Pragma("unroll") for (int n = 0; n < 2; ++n) _Pragma("unroll") for (int k = 0; k < 2; ++k) asm volatile("" : "+v"(dst[n][k])); } else if constexpr (FP8) { _Pragma("unroll") for (int n = 0; n < 2; ++n) dst##8[n] = PG8_LD8(pB + PG8_SBR(b, h) + n * 2048); } else { \
        _Pragma("unroll") for (int n = 0; n < 2; ++n) _Pragma("unroll") for (int k = 0; k < 2; ++k) dst[n][k] = *(const LAS bf16x8*)(pB + PG8_SBR(b, h) + n * 2048 + k * 1024); } } while (0)
#define PG8_MMA(ai, bj, At, Bt) do { __builtin_amdgcn_s_setprio(1); if constexpr (VAR == 2) { _Pragma("unroll") for (int m = 0; m < 4; ++m) _Pragma("unroll") for (int k = 0; k < 2; ++k) asm volatile("" :: "v"(At[m][k])); _Pragma("unroll") for (int n = 0; n < 2; ++n) _Pragma("unroll") for (int k = 0; k < 2; ++k) asm volatile("" :: "v"(Bt[n][k])); } else if constexpr (FP8) { _Pragma("unroll") for (int m = 0; m < 4; ++m) _Pragma("unroll") for (int n = 0; n < 2; ++n) \
            acc[ai][bj][m][n] = __builtin_amdgcn_mfma_scale_f32_16x16x128_f8f6f4(Bt##8[n], At##8[m], acc[ai][bj][m][n], 0, 0, 0, 0x7f7f7f7f, 0, 0x7f7f7f7f); } else { \
        _Pragma("unroll") for (int m = 0; m < 4; ++m) _Pragma("unroll") for (int n = 0; n < 2; ++n) _Pragma("unroll") for (int k = 0; k < 2; ++k) \
        acc[ai][bj][m][n] = __builtin_amdgcn_mfma_f32_16x16x32_bf16(Bt[n][k], At[m][k], acc[ai][bj][m][n], 0, 0, 0); } __builtin_amdgcn_s_setprio(0); } while (0)
#define PG8_WAIT_V(n) asm volatile("s_waitcnt vmcnt(" #n ")" ::: "memory")
#define PG8_WAIT_L(n) asm volatile("s_waitcnt lgkmcnt(" #n ")" ::: "memory")
#define PG8_BAR __builtin_amdgcn_s_barrier()
#define PG8_SCHED __builtin_amdgcn_sched_barrier(0)
    Unit cur, nxt; int ui = 0;
    if (!S.next(0, cur)) return;
    float sv_ = 0.f; LAS float* const rsl_ = (LAS float*)(lds + STAGE_BYTES);
    unsigned cpk = 0u;
    if constexpr (Sched::GATHER) { int ids[4]; int R0, C0, R1, C1; stage_rc(tid * 16, R0, C0); stage_rc(tid * 16 + 8192, R1, C1); S.gather_ids(cur, R0, R1, ids);
        cpk = (unsigned)(C0 * 2) | ((unsigned)(C1 * 2) << 16);
#pragma unroll
        for (int h = 0; h < 2; ++h) voffA[h][0] = (unsigned)ids[h * 2 + 0] | ((unsigned)ids[h * 2 + 1] << 16); }
    f32x4 acc[2][2][4][2];
#pragma unroll
    for (int a = 0; a < 2; ++a)
#pragma unroll
        for (int b = 0; b < 2; ++b)
#pragma unroll
            for (int m = 0; m < 4; ++m)
#pragma unroll
                for (int n = 0; n < 2; ++n) acc[a][b][m][n] = (f32x4){0.f, 0.f, 0.f, 0.f};
    bf16x8 At[4][2], B0[2][2], B1[2][2]; i32x8v At8[4], B08[2], B18[2];
    if constexpr (VAR == 4 || VAR == 5) {
#pragma unroll
        for (int m = 0; m < 4; ++m)
#pragma unroll
            for (int k = 0; k < 2; ++k)
#pragma unroll
                for (int e = 0; e < 8; ++e) { const unsigned hsh = (unsigned)(lane * 8 + e + 64 * (m * 2 + k)) * 2654435761u; At[m][k][e] = (short)(0x3f00u | ((hsh >> 9) & 0xffu) | ((hsh >> 3) & 0x8000u));
                    if (m < 2) { B0[m][k][e] = (short)(0x3f00u | ((hsh >> 17) & 0xffu) | ((hsh >> 5) & 0x8000u)); B1[m][k][e] = (short)(0x3f00u | ((hsh >> 21) & 0xffu) | ((hsh >> 7) & 0x8000u)); } } }
    unsigned cA = S.a_base(cur), cB = S.b_base(cur);
    PG8_STAGE(PG8_SB(0, 0), cB, voffB); PG8_STAGE(PG8_SB(0, 1), cB + hstep, voffB); PG8_STAGE_A(PG8_SA(0, 0), cA, 0); PG8_STAGE_A(PG8_SA(0, 1), cA, 1);
    if (wr == 1) PG8_BAR;
    PG8_WAIT_V(2); PG8_BAR;
    PG8_STAGE(PG8_SB(1, 0), cB + kstep, voffB); PG8_STAGE_A(PG8_SA(1, 0), cA + kstep, 0); PG8_STAGE(PG8_SB(1, 1), cB + hstep + kstep, voffB);
    PG8_WAIT_V(6); PG8_BAR;
    for (;;) {
        const bool has_next = S.next(ui + 1, nxt);
        const unsigned nA = has_next ? S.a_base(nxt) : cA, nB = has_next ? S.b_base(nxt) : cB;
        unsigned voffN[2] = {0u, 0u};
#pragma unroll 1
        for (int t = 0; t < nt; t += 2) {
            asm volatile("" : "+v"(pA), "+v"(pB));
            if constexpr (Epi::STASH) { if (t == 2) { const int t2_ = wid * 64 + lane_now(); if (t2_ < 256) sv_ = E.stash_load(cur, t2_); }
                                        else if (t == 4) { const int t2_ = wid * 64 + lane_now(); if (t2_ < 256) E.stash_store(rsl_, t2_, sv_); } }
            const bool last = (t == nt - 2);
            const unsigned a1 = cA + (unsigned)(t + 1) * kstep;
            const unsigned a2 = last ? nA : cA + (unsigned)(t + 2) * kstep, b2 = last ? nB : cB + (unsigned)(t + 2) * kstep;
            const unsigned a3 = a2 + kstep, b3 = b2 + kstep;
            if constexpr (Sched::GATHER) { if (t == nt - 4 && has_next) { int ids[4]; int R0, C0, R1, C1; const int tid2 = wid * 64 + lane_now(); stage_rc(tid2 * 16, R0, C0); stage_rc(tid2 * 16 + 8192, R1, C1); S.gather_ids(nxt, R0, R1, ids);
#pragma unroll
                for (int h = 0; h < 2; ++h) voffN[h] = (unsigned)ids[h * 2 + 0] | ((unsigned)ids[h * 2 + 1] << 16); } }
            PG8_LDB(B0, 0, 0); PG8_LDB(B1, 0, 1); PG8_SCHED; PG8_LDA(At, 0, 0); PG8_STAGE_A(PG8_SA(1, 1), a1, 1);
            if constexpr (Sched::GATHER) { if (last && has_next) { voffA[0][0] = voffN[0]; voffA[1][0] = voffN[1]; } }
            PG8_WAIT_V(8); PG8_WAIT_L(0); PG8_BAR; PG8_MMA(0, 0, At, B0); PG8_MMA(0, 1, At, B1); PG8_BAR; PG8_SCHED;
            PG8_LDA(At, 0, 1); PG8_STAGE(PG8_SB(0, 0), b2, voffB); PG8_STAGE(PG8_SB(0, 1), b2 + hstep, voffB); PG8_STAGE_A(PG8_SA(0, 0), a2, 0);
            PG8_WAIT_V(8); PG8_WAIT_L(0); PG8_BAR; PG8_MMA(1, 0, At, B0); PG8_MMA(1, 1, At, B1); PG8_BAR; PG8_SCHED;
            PG8_LDB(B0, 1, 0); PG8_LDB(B1, 1, 1); PG8_SCHED; PG8_LDA(At, 1, 0); PG8_STAGE_A(PG8_SA(0, 1), a2, 1);
            PG8_WAIT_V(8); PG8_WAIT_L(0); PG8_BAR; PG8_MMA(0, 0, At, B0); PG8_MMA(0, 1, At, B1); PG8_BAR; PG8_SCHED;
            PG8_LDA(At, 1, 1); PG8_STAGE(PG8_SB(1, 0), b3, voffB); PG8_STAGE(PG8_SB(1, 1), b3 + hstep, voffB); PG8_STAGE_A(PG8_SA(1, 0), a3, 0);
            PG8_WAIT_V(8); PG8_WAIT_L(0); PG8_BAR; PG8_MMA(1, 0, At, B0); PG8_MMA(1, 1, At, B1); PG8_BAR; PG8_SCHED;
        }
        if constexpr (ALIGN_EPI) { if (wr == 0) PG8_BAR; }
        { const int le_ = lane_now(); E(acc, cur, wr, wc, le_ & 15, le_ >> 4, rsl_); }
        if (!has_next) break;
#pragma unroll
        for (int a = 0; a < 2; ++a)
#pragma unroll
            for (int b = 0; b < 2; ++b)
#pragma unroll
                for (int m = 0; m < 4; ++m)
#pragma unroll
                    for (int n = 0; n < 2; ++n) acc[a][b][m][n] = (f32x4){0.f, 0.f, 0.f, 0.f};
        cur = nxt; cA = nA; cB = nB; ++ui;
        if constexpr (ALIGN_EPI) { if (wr == 1) PG8_BAR; }
    }
    PG8_WAIT_V(0);
    if constexpr (!ALIGN_EPI) { if (wr == 0) PG8_BAR; }
    PG8_BAR;
#undef PG8_SA
#undef PG8_SB
#undef PG8_SBR
#undef PG8_STAGE
#undef PG8_STAGE_R
#undef PG8_STAGE_A
#undef PG8_LDA
#undef PG8_LD8
#undef PG8_LDB
#undef PG8_MMA
#undef PG8_WAIT_V
#undef PG8_WAIT_L
#undef PG8_BAR
#undef PG8_SCHED
}
}
using pg8::Unit;

__device__ __forceinline__ float rstd_of(float ss) { return 1.0f / sqrtf(ss * (1.0f / D) + RMS_EPS); }
typedef unsigned long long rss_t;
__device__ __forceinline__ float rstd_fx(rss_t s) { return rstd_of((float)((double)s * (1.0 / 16777216.0))); }
__device__ __forceinline__ rss_t rss_fx(float ss) { return (rss_t)__float2ull_rn(ss * 16777216.0f); }

struct EpiInA {
    static constexpr bool STASH = true;
    __device__ __forceinline__ void stash_store(LAS float* rsl, int lrow, float v) const { rsl[lrow] = v; }
    __device__ __forceinline__ float stash_load(const Unit& u, int lrow) const { return rstd_fx(rowss[u.pm * 256 + lrow]); }
    bf16_t* U; bf16_t* Q; const rss_t* rowss;
    __device__ __forceinline__ void operator()(const f32x4 (&acc)[2][2][4][2], const Unit& u, int wr, int wc, int fr, int fq, const LAS float* rsl) const {
        const int row0 = u.pm * 256 + wr * 64 + fr, col0 = u.pn * 256 + wc * 32 + 8 * fq;
        float rsq[8];
#pragma unroll
        for (int i = 0; i < 8; ++i) rsq[i] = rsl[wr * 64 + fr + (i >> 2) * 128 + (i & 3) * 16];
#pragma unroll
        for (int ai = 0; ai < 2; ++ai)
#pragma unroll
            for (int m = 0; m < 4; ++m) { const int row = row0 + ai * 128 + m * 16; const float rs = rsq[ai * 4 + m];
#pragma unroll
                for (int bj = 0; bj < 2; ++bj) { const int c = col0 + bj * 128; const f32x4 v0 = acc[ai][bj][m][0] * rs, v1 = acc[ai][bj][m][1] * rs;
                    u32x4 w; w.x = cvt_pk_bf16(v0[0], v0[1]); w.y = cvt_pk_bf16(v0[2], v0[3]); w.z = cvt_pk_bf16(v1[0], v1[1]); w.w = cvt_pk_bf16(v1[2], v1[3]);
                    if (c < CS) { const int g = c >> 4, hf = (c >> 3) & 1, b = row >> 12, t = row & 4095; *(u32x4*)(U + (((size_t)(b * S5G + g) * SEQ + t) * 16 + 8 * hf)) = w; }
                    else *(u32x4*)(Q + (size_t)row * CM + (c - CS)) = w; } }
    }
};
struct EpiBf16 {
    static constexpr bool STASH = true;
    __device__ __forceinline__ void stash_store(LAS float* rsl, int lrow, float v) const { rsl[lrow] = v; }
    __device__ __forceinline__ float stash_load(const Unit& u, int lrow) const { return rowss ? rstd_fx(rowss[u.pm * 256 + lrow]) : 1.0f; }
    bf16_t* O; int ldc; const rss_t* rowss; bf16_t* Q; int qcol0;
    __device__ __forceinline__ void operator()(const f32x4 (&acc)[2][2][4][2], const Unit& u, int wr, int wc, int fr, int fq, const LAS float* rsl) const {
        const int row0 = u.pm * 256 + wr * 64 + fr, col0 = u.pn * 256 + wc * 32 + 8 * fq;
        float rsv8[8];
#pragma unroll
        for (int i = 0; i < 8; ++i) rsv8[i] = rsl[wr * 64 + fr + (i >> 2) * 128 + (i & 3) * 16];
#pragma unroll
        for (int ai = 0; ai < 2; ++ai)
#pragma unroll
            for (int m = 0; m < 4; ++m) { const int row = row0 + ai * 128 + m * 16; const float rs = rsv8[ai * 4 + m];
#pragma unroll
                for (int bj = 0; bj < 2; ++bj) { const int c = col0 + bj * 128; const f32x4 v0 = acc[ai][bj][m][0] * rs, v1 = acc[ai][bj][m][1] * rs;
                    u32x4 w; w.x = cvt_pk_bf16(v0[0], v0[1]); w.y = cvt_pk_bf16(v0[2], v0[3]); w.z = cvt_pk_bf16(v1[0], v1[1]); w.w = cvt_pk_bf16(v1[2], v1[3]);
                    if (Q && c >= qcol0) *(u32x4*)(Q + (size_t)row * CM + (c - qcol0)) = w;
                    else *(u32x4*)(O + (size_t)row * ldc + c) = w; } }
    }
};
struct EpiRes {
    static constexpr bool STASH = false;
    const float* XinF; const bf16_t* XinB; bf16_t* H; rss_t* rowss; unsigned char* H8;
    __device__ __forceinline__ void operator()(const f32x4 (&acc)[2][2][4][2], const Unit& u, int wr, int wc, int fr, int fq, const LAS float* rsl) const {
        const int row0 = u.pm * 256 + wr * 64 + fr, col0 = u.pn * 256 + wc * 32 + 8 * fq;
#pragma unroll
        for (int ai = 0; ai < 2; ++ai) {
            f32x4 xv[4][2][2];
            if (XinF) {
#pragma unroll
                for (int m = 0; m < 4; ++m)
#pragma unroll
                    for (int bj = 0; bj < 2; ++bj) { const size_t o = (size_t)(row0 + ai * 128 + m * 16) * D + col0 + bj * 128; xv[m][bj][0] = *(const f32x4*)(XinF + o); xv[m][bj][1] = *(const f32x4*)(XinF + o + 4); }
            } else { u32x4 xb[4][2];
#pragma unroll
                for (int m = 0; m < 4; ++m)
#pragma unroll
                    for (int bj = 0; bj < 2; ++bj) xb[m][bj] = *(const u32x4*)(XinB + (size_t)(row0 + ai * 128 + m * 16) * D + col0 + bj * 128);
#pragma unroll
                for (int m = 0; m < 4; ++m)
#pragma unroll
                    for (int bj = 0; bj < 2; ++bj) { const u32x4 w = xb[m][bj]; xv[m][bj][0] = (f32x4){bflo(w.x), bfhi(w.x), bflo(w.y), bfhi(w.y)}; xv[m][bj][1] = (f32x4){bflo(w.z), bfhi(w.z), bflo(w.w), bfhi(w.w)}; } }
            __builtin_amdgcn_sched_barrier(0);
            float ss4[4];
#pragma unroll
            for (int m = 0; m < 4; ++m) { const int row = row0 + ai * 128 + m * 16; float ss = 0.f;
#pragma unroll
                for (int bj = 0; bj < 2; ++bj) { const size_t o = (size_t)row * D + col0 + bj * 128;
                    const f32x4 s0 = acc[ai][bj][m][0] + xv[m][bj][0], s1 = acc[ai][bj][m][1] + xv[m][bj][1];
                    u32x4 w; w.x = cvt_pk_bf16(s0[0], s0[1]); w.y = cvt_pk_bf16(s0[2], s0[3]); w.z = cvt_pk_bf16(s1[0], s1[1]); w.w = cvt_pk_bf16(s1[2], s1[3]);
                    *(u32x4*)(H + o) = w;
                    const f32x4 v0 = {bflo(w.x), bfhi(w.x), bflo(w.y), bfhi(w.y)}, v1 = {bflo(w.z), bfhi(w.z), bflo(w.w), bfhi(w.w)};
                    if (H8) *(u32x2*)(H8 + o) = cvt8_fp8(v0 * F8_X, v1 * F8_X);
                    ss += (v0[0] * v0[0] + v0[1] * v0[1]) + (v0[2] * v0[2] + v0[3] * v0[3]) + (v1[0] * v1[0] + v1[1] * v1[1]) + (v1[2] * v1[2] + v1[3] * v1[3]); }
                ss4[m] = ss; }
#pragma unroll
            for (int m = 0; m < 4; ++m) { float ss = ss4[m]; ss += __shfl_xor(ss, 16); ss += __shfl_xor(ss, 32);
                if (fq == 0) atomicAdd(rowss + row0 + ai * 128 + m * 16, rss_fx(ss)); }
            __builtin_amdgcn_sched_barrier(0); }
    }
};
struct EpiSwiglu {
    static constexpr bool STASH = true;
    __device__ __forceinline__ void stash_store(LAS float* rsl, int lrow, float v) const { rsl[lrow] = v * -1.4426950408889634f; rsl[256 + lrow] = v * v; }
    __device__ __forceinline__ float stash_load(const Unit& u, int lrow) const { return rsv ? rsv[u.rb + lrow] : rstd_fx(rowss[u.pm * 256 + lrow]); }
    bf16_t* O; int ldo; const rss_t* rowss; const float* rsv; int skip;
    __device__ __forceinline__ void operator()(const f32x4 (&acc)[2][2][4][2], const Unit& u, int wr, int wc, int fr, int fq, const LAS float* rsl) const {
        if (skip) return;
        const int lrow0 = wr * 64 + fr, col0 = u.pn * 128 + wc * 32 + 8 * fq;
        float c18[8], c28[8];
#pragma unroll
        for (int i = 0; i < 8; ++i) { const int lrow = lrow0 + (i >> 2) * 128 + (i & 3) * 16; c18[i] = rsl[lrow]; c28[i] = rsl[256 + lrow]; }
#pragma unroll
        for (int ai = 0; ai < 2; ++ai)
#pragma unroll
            for (int m = 0; m < 4; ++m) { const int lrow = lrow0 + ai * 128 + m * 16;
                const float c1 = c18[ai * 4 + m], c2 = c28[ai * 4 + m]; const size_t orow = rsv ? ((size_t)u.e + lrow) : (size_t)(u.pm * 256 + lrow);
                const f32x4 g0 = acc[ai][0][m][0], g1 = acc[ai][0][m][1], u0 = acc[ai][1][m][0], u1 = acc[ai][1][m][1];
                u32x4 w; w.x = cvt_pk_bf16(swiglu_rs_(g0[0], u0[0], c1, c2), swiglu_rs_(g0[1], u0[1], c1, c2)); w.y = cvt_pk_bf16(swiglu_rs_(g0[2], u0[2], c1, c2), swiglu_rs_(g0[3], u0[3], c1, c2));
                w.z = cvt_pk_bf16(swiglu_rs_(g1[0], u1[0], c1, c2), swiglu_rs_(g1[1], u1[1], c1, c2)); w.w = cvt_pk_bf16(swiglu_rs_(g1[2], u1[2], c1, c2), swiglu_rs_(g1[3], u1[3], c1, c2));
                if (skip == 3) { w.x = cvt_pk_bf16(g0[0] * u0[0], g0[1] * u0[1]); w.y = cvt_pk_bf16(g0[2] * u0[2], g0[3] * u0[3]); w.z = cvt_pk_bf16(g1[0] * u1[0], g1[1] * u1[1]); w.w = cvt_pk_bf16(g1[2] * u1[2], g1[3] * u1[3]); }
                if (skip == 2) asm volatile("" :: "v"(w)); else if (skip == 4) *(u32x4*)(O + ((size_t)blockIdx.x * 256 + lrow) * 128 + (col0 & 127)) = w; else
                *(u32x4*)(O + orow * ldo + col0) = w; }
    }
};
struct EpiSwigluF8 {
    static constexpr bool STASH = true;
    __device__ __forceinline__ void stash_store(LAS float* rsl, int lrow, float v) const { rsl[lrow] = v * -1.4426950408889634f; rsl[256 + lrow] = v * v * F8_ACT; }
    __device__ __forceinline__ float stash_load(const Unit& u, int lrow) const { return rsv[u.rb + lrow] * (1.0f / (F8_X * F8_WGU)); }
    unsigned char* O8; int ldo; const float* rsv;
    __device__ __forceinline__ void operator()(const f32x4 (&acc)[2][2][4][2], const Unit& u, int wr, int wc, int fr, int fq, const LAS float* rsl) const {
        const int lrow0 = wr * 64 + fr, col0 = u.pn * 128 + wc * 32 + 8 * fq;
        float c1n = rsl[lrow0], c2n = rsl[256 + lrow0];
#pragma unroll
        for (int ai = 0; ai < 2; ++ai)
#pragma unroll
            for (int m = 0; m < 4; ++m) { const int lrow = lrow0 + ai * 128 + m * 16; const float c1 = c1n, c2 = c2n;
                if (ai * 4 + m < 7) { const int ln_ = lrow0 + ((ai * 4 + m + 1) >> 2) * 128 + ((ai * 4 + m + 1) & 3) * 16; c1n = rsl[ln_]; c2n = rsl[256 + ln_]; }
                f32x4 a0, a1;
#pragma unroll
                for (int e = 0; e < 4; ++e) { a0[e] = swiglu_rs_(acc[ai][0][m][0][e], acc[ai][1][m][0][e], c1, c2); a1[e] = swiglu_rs_(acc[ai][0][m][1][e], acc[ai][1][m][1][e], c1, c2); }
                *(u32x2*)(O8 + ((size_t)u.e + lrow) * ldo + col0) = cvt8_fp8(a0, a1);
                asm volatile("" ::: "memory"); }
    }
};
struct EpiSlot {
    static constexpr bool STASH = false;
    bf16_t* O;
    __device__ __forceinline__ void operator()(const f32x4 (&acc)[2][2][4][2], const Unit& u, int wr, int wc, int fr, int fq, const LAS float* rsl) const {
        const int lrow0 = wr * 64 + fr, col0 = u.pn * 256 + wc * 32 + 8 * fq;
#pragma unroll
        for (int ai = 0; ai < 2; ++ai)
#pragma unroll
            for (int m = 0; m < 4; ++m) { const size_t orow = (size_t)u.e + lrow0 + ai * 128 + m * 16;
#pragma unroll
                for (int bj = 0; bj < 2; ++bj) { const float sc = 1.0f / (F8_ACT * F8_WD); const f32x4 v0 = acc[ai][bj][m][0] * sc, v1 = acc[ai][bj][m][1] * sc;
                    u32x4 w; w.x = cvt_pk_bf16(v0[0], v0[1]); w.y = cvt_pk_bf16(v0[2], v0[3]); w.z = cvt_pk_bf16(v1[0], v1[1]); w.w = cvt_pk_bf16(v1[2], v1[3]);
                    *(u32x4*)(O + orow * D + col0 + bj * 128) = w; } }
    }
};

struct MoeGuSched {
    static constexpr bool GATHER = true;
    pg8::TileOrder o; const char* A; const char* W; const int* list; const LAS int* tab; int tile0;
    __device__ __forceinline__ bool next(int i, Unit& u) const {
        if (!o.tile(i, u.pm, u.pn)) return false;
        const int gt = tile0 + u.pm; int e = 0;
#pragma unroll
        for (int k = 1; k < 8; ++k) e += (gt >= tab[k]) ? 1 : 0;
        e = __builtin_amdgcn_readfirstlane(e);
        u.rb = __builtin_amdgcn_readfirstlane(e * 32768 + (gt - tab[e]) * 256); u.e = u.pm * 256; return true;
    }
    __device__ __forceinline__ const char* a_ptr() const { return A; }
    __device__ __forceinline__ const char* b_ptr() const { return W; }
    __device__ __forceinline__ unsigned a_base(const Unit&) const { return 0u; }
    __device__ __forceinline__ unsigned b_base(const Unit& u) const { return ((unsigned)(u.rb >> 15) * (2 * FE) + (unsigned)u.pn * 256) * (unsigned)D; }
    __device__ __forceinline__ void gather_ids(const Unit& u, int R0, int R1, int (&ids)[4]) const {
        const int e = u.rb >> 15, rank0 = u.rb & 32767, cnt = __builtin_amdgcn_readfirstlane(tab[16 + e]);
#pragma unroll
        for (int h = 0; h < 2; ++h) { const int r0 = R0 + 128 * h, r1 = R1 + 128 * h;
            ids[h * 2 + 0] = (rank0 + r0 < cnt) ? list[u.rb + r0] : 0; ids[h * 2 + 1] = (rank0 + r1 < cnt) ? list[u.rb + r1] : 0; }
    }
};
struct MoeDownSched {
    static constexpr bool GATHER = false;
    pg8::TileOrder o; const char* A; const char* W; const LAS int* tab; int tile0;
    __device__ __forceinline__ bool next(int i, Unit& u) const {
        if (!o.tile(i, u.pm, u.pn)) return false;
        const int gt = tile0 + u.pm; int e = 0;
#pragma unroll
        for (int k = 1; k < 8; ++k) e += (gt >= tab[k]) ? 1 : 0;
        u.rb = __builtin_amdgcn_readfirstlane(e); u.e = gt * 256; return true;
    }
    __device__ __forceinline__ const char* a_ptr() const { return A; }
    __device__ __forceinline__ const char* b_ptr() const { return W; }
    __device__ __forceinline__ unsigned a_base(const Unit& u) const { return (unsigned)u.pm * (unsigned)(256 * FE); }
    __device__ __forceinline__ unsigned b_base(const Unit& u) const { return ((unsigned)u.rb * D + (unsigned)u.pn * 256) * (unsigned)FE; }
    __device__ __forceinline__ void gather_ids(const Unit&, int, int, int (&)[4]) const {}
};

constexpr int TAIL_SPLIT = 7, TAIL_K = FE / TAIL_SPLIT;
struct MoeDownTailSched {
    static constexpr bool GATHER = false;
    pg8::TileOrder o; const char* A; const char* W; const LAS int* tab; int tile0;
    __device__ __forceinline__ bool next(int i, Unit& u) const {
        int cn; if (!o.tile(i, u.pm, cn)) return false;
        const int gt = tile0 + u.pm; int e = 0;
#pragma unroll
        for (int k = 1; k < 8; ++k) e += (gt >= tab[k]) ? 1 : 0;
        u.pn = cn & 3; u.rb = __builtin_amdgcn_readfirstlane(e) * 8 + (cn >> 2); u.e = u.pm * 256; return true;
    }
    __device__ __forceinline__ const char* a_ptr() const { return A; }
    __device__ __forceinline__ const char* b_ptr() const { return W; }
    __device__ __forceinline__ unsigned a_base(const Unit& u) const { return (unsigned)u.pm * (unsigned)(256 * FE) + (unsigned)(u.rb & 7) * TAIL_K; }
    __device__ __forceinline__ unsigned b_base(const Unit& u) const { return ((unsigned)(u.rb >> 3) * D + (unsigned)u.pn * 256) * (unsigned)FE + (unsigned)(u.rb & 7) * TAIL_K; }
    __device__ __forceinline__ void gather_ids(const Unit&, int, int, int (&)[4]) const {}
};
struct EpiSlotPart {
    static constexpr bool STASH = false;
    bf16_t* P;
    __device__ __forceinline__ void operator()(const f32x4 (&acc)[2][2][4][2], const Unit& u, int wr, int wc, int fr, int fq, const LAS float* rsl) const {
        const int lrow0 = wr * 64 + fr, col0 = u.pn * 256 + wc * 32 + 8 * fq; bf16_t* base = P + (size_t)(u.rb & 7) * 2048 * D;
#pragma unroll
        for (int ai = 0; ai < 2; ++ai)
#pragma unroll
            for (int m = 0; m < 4; ++m) { const size_t orow = (size_t)u.e + lrow0 + ai * 128 + m * 16;
#pragma unroll
                for (int bj = 0; bj < 2; ++bj) { const float sc = 1.0f / (F8_ACT * F8_WD); const f32x4 v0 = acc[ai][bj][m][0] * sc, v1 = acc[ai][bj][m][1] * sc;
                    u32x4 w; w.x = cvt_pk_bf16(v0[0], v0[1]); w.y = cvt_pk_bf16(v0[2], v0[3]); w.z = cvt_pk_bf16(v1[0], v1[1]); w.w = cvt_pk_bf16(v1[2], v1[3]);
                    *(u32x4*)(base + orow * D + col0 + bj * 128) = w; } }
    }
};

__device__ __forceinline__ void tr_item(const float* W, int K, int N, bf16_t* WT, const float* gain, int mode, LAS float* scr, int item, int lane, float f8s = 0.f) {
    const int nblk = N / 32, kb = item / nblk, nb = item % nblk, k0 = 64 * kb, n0 = 32 * nb;
    {
        const int r8 = lane >> 3, c4 = (lane & 7) * 4; f32x4 v[8]; float gn[8];
#pragma unroll
        for (int i = 0; i < 8; ++i) { v[i] = *(const f32x4*)(W + (size_t)(k0 + 8 * i + r8) * N + n0 + c4); gn[i] = gain ? gain[k0 + 8 * i + r8] : 1.0f; }
#pragma unroll
        for (int i = 0; i < 8; ++i) { LAS float* d = scr + (8 * i + r8) * 33 + c4; d[0] = v[i][0] * gn[i]; d[1] = v[i][1] * gn[i]; d[2] = v[i][2] * gn[i]; d[3] = v[i][3] * gn[i]; } }
    LDS_WAIT(); asm volatile("" ::: "memory");
    const int c = lane & 7;
#pragma unroll
    for (int j = 0; j < 4; ++j) { const int n = (lane >> 3) + 8 * j; const LAS float* s = scr + (8 * c) * 33 + n;
        u32x4 o; o.x = cvt_pk_bf16(s[0 * 33], s[1 * 33]); o.y = cvt_pk_bf16(s[2 * 33], s[3 * 33]); o.z = cvt_pk_bf16(s[4 * 33], s[5 * 33]); o.w = cvt_pk_bf16(s[6 * 33], s[7 * 33]);
        const int nn = n0 + n; const int row = (mode == 0) ? nn : (((nn >> 7) << 8) + (nn & 127) + (mode == 2 ? 128 : 0));
        if (f8s != 0.f) { const f32x4 a = {s[0 * 33] * f8s, s[1 * 33] * f8s, s[2 * 33] * f8s, s[3 * 33] * f8s}, b = {s[4 * 33] * f8s, s[5 * 33] * f8s, s[6 * 33] * f8s, s[7 * 33] * f8s};
            *(u32x2*)((unsigned char*)WT + (size_t)row * K + k0 + 8 * c) = cvt8_fp8(a, b); }
        else *(u32x4*)(WT + (size_t)row * K + k0 + 8 * c) = o; }
    LDS_WAIT(); asm volatile("" ::: "memory");
}
struct TrJob { const float* W; bf16_t* WT; const float* gain; int K, N, mode, items; float f8s; };
struct TrRegs { f32x4 v[8]; float gn[8]; };
__device__ __forceinline__ void tr_load(const TrJob& jb, int item, int lane, TrRegs& R) {
    const int nblk = jb.N / 32, kb = item / nblk, nb = item % nblk, k0 = 64 * kb, n0 = 32 * nb, r8 = lane >> 3, c4 = (lane & 7) * 4;
#pragma unroll
    for (int i = 0; i < 8; ++i) { R.v[i] = *(const f32x4*)(jb.W + (size_t)(k0 + 8 * i + r8) * jb.N + n0 + c4); R.gn[i] = jb.gain ? jb.gain[k0 + 8 * i + r8] : 1.0f; }
}
__device__ __forceinline__ void tr_fin(const TrJob& jb, int item, LAS float* scr, int lane, const TrRegs& R) {
    const int nblk = jb.N / 32, kb = item / nblk, nb = item % nblk, k0 = 64 * kb, n0 = 32 * nb, r8 = lane >> 3, c4 = (lane & 7) * 4;
#pragma unroll
    for (int i = 0; i < 8; ++i) { LAS float* d = scr + (8 * i + r8) * 33 + c4; d[0] = R.v[i][0] * R.gn[i]; d[1] = R.v[i][1] * R.gn[i]; d[2] = R.v[i][2] * R.gn[i]; d[3] = R.v[i][3] * R.gn[i]; }
    LDS_WAIT(); asm volatile("" ::: "memory");
    const int c = lane & 7;
#pragma unroll
    for (int j = 0; j < 4; ++j) { const int n = (lane >> 3) + 8 * j; const LAS float* s = scr + (8 * c) * 33 + n;
        const int nn = n0 + n; const int row = (jb.mode == 0) ? nn : (((nn >> 7) << 8) + (nn & 127) + (jb.mode == 2 ? 128 : 0));
        const float f8s = jb.f8s; const f32x4 a = {s[0 * 33] * f8s, s[1 * 33] * f8s, s[2 * 33] * f8s, s[3 * 33] * f8s}, b = {s[4 * 33] * f8s, s[5 * 33] * f8s, s[6 * 33] * f8s, s[7 * 33] * f8s};
        *(u32x2*)((unsigned char*)jb.WT + (size_t)row * jb.K + k0 + 8 * c) = cvt8_fp8(a, b); }
    LDS_WAIT(); asm volatile("" ::: "memory");
}


struct Args { const float* in[N_IN]; float* out; unsigned char* ws; int ph_lo, ph_hi, pass_lo, pass_hi; };

__device__ __forceinline__ void attn_naive(LAS unsigned char* lds, const bf16_t* Q, const bf16_t* KV, bf16_t* CAT, int bx, int G, int tid) {
    LAS float* Ks = (LAS float*)lds; LAS float* Vs = Ks + 256 * 64;
    for (int item = bx; item < NB * NH_MEM * 8; item += G) {
        const int b = item >> 5, h = (item >> 3) & 3, qb = item & 7;
#pragma unroll 4
        for (int i = 0; i < 32; ++i) { const int idx = tid + 512 * i, m = idx >> 6, d = idx & 63;
            const bf16_t* kr = KV + (size_t)(b * MEML + m) * 512 + h * 64 + d;
            Ks[idx] = bf2f(kr[0]); Vs[idx] = bf2f(kr[256]); }
        __syncthreads();
        const int row = b * SEQ + qb * 512 + tid;
        float q[64], o[64];
        { const u32x4* qp = (const u32x4*)(Q + (size_t)row * CM + h * 64);
#pragma unroll
          for (int i = 0; i < 8; ++i) { const u32x4 w = qp[i];
              q[8 * i + 0] = bflo(w.x) * 0.125f; q[8 * i + 1] = bfhi(w.x) * 0.125f; q[8 * i + 2] = bflo(w.y) * 0.125f; q[8 * i + 3] = bfhi(w.y) * 0.125f;
              q[8 * i + 4] = bflo(w.z) * 0.125f; q[8 * i + 5] = bfhi(w.z) * 0.125f; q[8 * i + 6] = bflo(w.w) * 0.125f; q[8 * i + 7] = bfhi(w.w) * 0.125f; } }
#pragma unroll
        for (int d = 0; d < 64; ++d) o[d] = 0.f;
        float mx = -1e30f, l = 0.f;
#pragma unroll 1
        for (int key = 0; key < MEML; ++key) {
            const LAS f32x4* kr = (const LAS f32x4*)(Ks + key * 64); float sc = 0.f;
#pragma unroll
            for (int d4 = 0; d4 < 16; ++d4) { const f32x4 kv = kr[d4]; sc += q[4 * d4] * kv[0] + q[4 * d4 + 1] * kv[1] + q[4 * d4 + 2] * kv[2] + q[4 * d4 + 3] * kv[3]; }
            const float mn = fmaxf(mx, sc), alpha = __expf(mx - mn), p = __expf(sc - mn); mx = mn; l = l * alpha + p;
            const LAS f32x4* vr = (const LAS f32x4*)(Vs + key * 64);
#pragma unroll
            for (int d4 = 0; d4 < 16; ++d4) { const f32x4 vv = vr[d4]; o[4 * d4] = o[4 * d4] * alpha + p * vv[0]; o[4 * d4 + 1] = o[4 * d4 + 1] * alpha + p * vv[1]; o[4 * d4 + 2] = o[4 * d4 + 2] * alpha + p * vv[2]; o[4 * d4 + 3] = o[4 * d4 + 3] * alpha + p * vv[3]; }
        }
        const float il = 1.0f / l;
        u32x4* op = (u32x4*)(CAT + (size_t)row * D + CS + h * 64);
#pragma unroll
        for (int i = 0; i < 8; ++i) { u32x4 w; w.x = cvt_pk_bf16(o[8 * i] * il, o[8 * i + 1] * il); w.y = cvt_pk_bf16(o[8 * i + 2] * il, o[8 * i + 3] * il);
            w.z = cvt_pk_bf16(o[8 * i + 4] * il, o[8 * i + 5] * il); w.w = cvt_pk_bf16(o[8 * i + 6] * il, o[8 * i + 7] * il); op[i] = w; }
        __syncthreads();
    }
}

__device__ __forceinline__ void s5_naive(const Args& a, LAS unsigned char* lds, const bf16_t* U, bf16_t* CAT, int bx, int G, int wave, int lane) {
    LAS float* xs = (LAS float*)(lds + wave * 1024);
    for (int it = bx + G * wave; it < NB * S5G; it += G * NWAVES) {
        const int b = it / S5G, g = it % S5G, p = lane;
        const double dt = exp((double)a.in[I_LOG_DT][g]), lr = a.in[I_LAM_RE][g * S5P + p], li = a.in[I_LAM_IM][g * S5P + p];
        const double mag = exp(lr * dt), ang = li * dt, abr_d = mag * cos(ang), abi_d = mag * sin(ang);
        const double nre = abr_d - 1.0, nim = abi_d, den = lr * lr + li * li, zr = (nre * lr + nim * li) / den, zi = (nim * lr - nre * li) / den;
        const float abr = (float)abr_d, abi = (float)abi_d;
        float bbr[16], bbi[16], cre[16], cim[16], wg[16];
#pragma unroll
        for (int j = 0; j < 16; ++j) { const double br = a.in[I_B_RE][(size_t)(g * S5P + p) * 16 + j], bi = a.in[I_B_IM][(size_t)(g * S5P + p) * 16 + j]; bbr[j] = (float)(zr * br - zi * bi); bbi[j] = (float)(zr * bi + zi * br); }
        const int jj = lane & 15, pq = lane >> 4;
#pragma unroll
        for (int q = 0; q < 16; ++q) { cre[q] = a.in[I_C_RE][(size_t)(g * 16 + jj) * S5P + 16 * pq + q]; cim[q] = a.in[I_C_IM][(size_t)(g * 16 + jj) * S5P + 16 * pq + q]; }
#pragma unroll
        for (int j = 0; j < 16; ++j) wg[j] = a.in[I_WGLU][(size_t)(g * 16 + j) * 16 + jj];
        const float dj = a.in[I_S5D][g * 16 + jj], bg = a.in[I_BGLU][g * 16 + jj];
        const bf16_t* up = U + (size_t)(b * S5G + g) * SEQ * 16;
        float xr = 0.f, xi = 0.f;
#pragma unroll 1
        for (int t = 0; t < SEQ; ++t) {
            const u32x4 w0 = *(const u32x4*)(up + (size_t)t * 16), w1 = *(const u32x4*)(up + (size_t)t * 16 + 8);
            float uf[16];
            uf[0] = bflo(w0.x); uf[1] = bfhi(w0.x); uf[2] = bflo(w0.y); uf[3] = bfhi(w0.y); uf[4] = bflo(w0.z); uf[5] = bfhi(w0.z); uf[6] = bflo(w0.w); uf[7] = bfhi(w0.w);
            uf[8] = bflo(w1.x); uf[9] = bfhi(w1.x); uf[10] = bflo(w1.y); uf[11] = bfhi(w1.y); uf[12] = bflo(w1.z); uf[13] = bfhi(w1.z); uf[14] = bflo(w1.w); uf[15] = bfhi(w1.w);
            const float uj = bf2f(up[(size_t)t * 16 + jj]);
            float bur = 0.f, bui = 0.f;
#pragma unroll
            for (int j = 0; j < 16; ++j) { bur += bbr[j] * uf[j]; bui += bbi[j] * uf[j]; }
            const float nxr = abr * xr - abi * xi + bur, nxi = abr * xi + abi * xr + bui; xr = nxr; xi = nxi;
            xs[p] = xr; xs[64 + p] = xi;
            LDS_WAIT(); asm volatile("" ::: "memory");
            float s = 0.f;
#pragma unroll
            for (int q4 = 0; q4 < 4; ++q4) { const f32x4 vr = *(const LAS f32x4*)(xs + 16 * pq + 4 * q4), vi = *(const LAS f32x4*)(xs + 64 + 16 * pq + 4 * q4);
#pragma unroll
                for (int e = 0; e < 4; ++e) s += cre[4 * q4 + e] * vr[e] - cim[4 * q4 + e] * vi[e]; }
            LDS_WAIT(); asm volatile("" ::: "memory");
            s += __shfl_xor(s, 16); s += __shfl_xor(s, 32);
            const float yg = gelu_tanh_(s + dj * uj);
            float z = bg;
#pragma unroll
            for (int j = 0; j < 16; ++j) z += __shfl(yg, j) * wg[j];
            const float o = yg * sigmoidf_(z);
            if (lane < 16) CAT[(size_t)(b * SEQ + t) * D + g * 16 + lane] = f2bf(o);
        }
    }
}

__device__ __forceinline__ void rwkv_prep(const Args& a, LAS unsigned char* lds, const bf16_t* P1, bf16_t* RA, bf16_t* RKK, bf16_t* RLD, bf16_t* RG, int bx, int G, int tid) {
    LAS float* twT = (LAS float*)lds; LAS float* adT = twT + 64 * 16; LAS float* sgT = adT + 64 * 16;
    const float* mu = a.in[I_MU];
    for (int tile = bx; tile < T / 16; tile += G) {
        __syncthreads();
#pragma unroll
        for (int i = 0; i < 8; ++i) { const int idx = tid + 512 * i, tok = idx >> 8, c = idx & 255, row = tile * 16 + tok, t = row & (SEQ - 1);
            const float cur = bf2f(P1[(size_t)row * INB + 2304 + c]), prev = t > 0 ? bf2f(P1[(size_t)(row - 1) * INB + 2304 + c]) : 0.f;
            const float xsv = cur + (prev - cur) * mu[2304 + c];
            if (c < 64) twT[c * 16 + tok] = tanhf(xsv); else if (c < 128) adT[(c - 64) * 16 + tok] = xsv; else sgT[(c - 128) * 16 + tok] = sigmoidf_(xsv); }
        __syncthreads();
        if (tid < 384) {
#pragma unroll 1
            for (int cc = 0; cc < 2; ++cc) { const int c = tid + 384 * cc;
                float aw[16], aa[16], ag[16];
#pragma unroll
                for (int k = 0; k < 16; ++k) { aw[k] = 0.f; aa[k] = 0.f; ag[k] = 0.f; }
#pragma unroll 2
                for (int m = 0; m < 64; ++m) { const float w2v = a.in[I_W2][(size_t)m * CS + c], a2v = a.in[I_A2][(size_t)m * CS + c];
#pragma unroll
                    for (int k4 = 0; k4 < 4; ++k4) { const f32x4 tw = *(const LAS f32x4*)(twT + m * 16 + 4 * k4), ad = *(const LAS f32x4*)(adT + m * 16 + 4 * k4);
#pragma unroll
                        for (int e = 0; e < 4; ++e) { aw[4 * k4 + e] += tw[e] * w2v; aa[4 * k4 + e] += ad[e] * a2v; } } }
#pragma unroll 2
                for (int m = 0; m < 128; ++m) { const float g2v = a.in[I_G2][(size_t)m * CS + c];
#pragma unroll
                    for (int k4 = 0; k4 < 4; ++k4) { const f32x4 sg = *(const LAS f32x4*)(sgT + m * 16 + 4 * k4);
#pragma unroll
                        for (int e = 0; e < 4; ++e) ag[4 * k4 + e] += sg[e] * g2v; } }
                const float w0 = a.in[I_W0][c], a0 = a.in[I_A0][c], kkw = a.in[I_KK][c], muk = mu[CS + c];
#pragma unroll
                for (int k = 0; k < 16; ++k) { const int row = tile * 16 + k, t = row & (SEQ - 1);
                    const float z = -(w0 + aw[k]);
                    const float sp = z > 20.f ? z : log1pf(__expf(z));
                    const float ld = -__expf(-sp - 0.5f);
                    const float av = sigmoidf_(a0 + aa[k]);
                    const float cur = bf2f(P1[(size_t)row * INB + CS + c]), prev = t > 0 ? bf2f(P1[(size_t)(row - 1) * INB + CS + c]) : 0.f;
                    const float kx = (cur + (prev - cur) * muk) * kkw;
                    const float ss = wave_sum(kx * kx);
                    const float kkv = kx / fmaxf(sqrtf(ss), 1e-12f);
                    const size_t o = (size_t)row * CS + c;
                    RA[o] = f2bf(av); RKK[o] = f2bf(kkv); RLD[o] = f2bf(ld); RG[o] = f2bf(ag[k]); }
            }
        }
    }
}

__device__ __forceinline__ void rwkv_naive(const Args& a, LAS unsigned char* lds, const bf16_t* P1, const bf16_t* RA, const bf16_t* RKK, const bf16_t* RLD, const bf16_t* RG, bf16_t* CAT, int bx, int G, int wave, int lane) {
    if (wave != 4) return;
    LAS float* vec = (LAS float*)lds;
    for (int item = bx; item < NB * RH; item += G) {
        const int b = item / RH, h = item % RH, c = h * 64 + lane;
        const float mur = a.in[I_MU][c], muk = a.in[I_MU][CS + c], muv = a.in[I_MU][2 * CS + c], ka = a.in[I_KA][c], rkc = a.in[I_RK][c], lw = a.in[I_LNXW][c], lb = a.in[I_LNXB][c];
        float S[64];
#pragma unroll
        for (int j = 0; j < 64; ++j) S[j] = 0.f;
        float prr = 0.f, prk = 0.f, prv = 0.f;
        const size_t row0 = (size_t)b * SEQ;
        bf16_t n_r = P1[row0 * INB + c], n_k = P1[row0 * INB + CS + c], n_v = P1[row0 * INB + 2 * CS + c], n_a = RA[row0 * CS + c], n_kk = RKK[row0 * CS + c], n_ld = RLD[row0 * CS + c], n_g = RG[row0 * CS + c];
#pragma unroll 1
        for (int t = 0; t < SEQ; ++t) {
            const float pr = bf2f(n_r), pk = bf2f(n_k), pv = bf2f(n_v), av = bf2f(n_a), kkv = bf2f(n_kk), ld = bf2f(n_ld), gv = bf2f(n_g);
            if (t + 1 < SEQ) { const size_t rn = row0 + t + 1; n_r = P1[rn * INB + c]; n_k = P1[rn * INB + CS + c]; n_v = P1[rn * INB + 2 * CS + c]; n_a = RA[rn * CS + c]; n_kk = RKK[rn * CS + c]; n_ld = RLD[rn * CS + c]; n_g = RG[rn * CS + c]; }
            const float r = pr + (prr - pr) * mur, k = pk + (prk - pk) * muk, v = pv + (prv - pv) * muv;
            prr = pr; prk = pk; prv = pv;
            const float kp = k * (1.f + (av - 1.f) * ka), ap = -kkv, bb = kkv * av, w = __expf(ld);
            vec[lane] = r; vec[64 + lane] = w; vec[128 + lane] = kp; vec[192 + lane] = ap; vec[256 + lane] = bb;
            LDS_WAIT(); asm volatile("" ::: "memory");
            float sa = 0.f;
#pragma unroll
            for (int j4 = 0; j4 < 16; ++j4) { const f32x4 x = *(const LAS f32x4*)(vec + 192 + 4 * j4); sa += S[4 * j4] * x[0] + S[4 * j4 + 1] * x[1] + S[4 * j4 + 2] * x[2] + S[4 * j4 + 3] * x[3]; }
            float y = 0.f;
#pragma unroll
            for (int j4 = 0; j4 < 16; ++j4) { const f32x4 wv = *(const LAS f32x4*)(vec + 64 + 4 * j4), bv = *(const LAS f32x4*)(vec + 256 + 4 * j4), kv = *(const LAS f32x4*)(vec + 128 + 4 * j4), rv = *(const LAS f32x4*)(vec + 4 * j4);
#pragma unroll
                for (int e = 0; e < 4; ++e) { const float s = S[4 * j4 + e] * wv[e] + sa * bv[e] + v * kv[e]; S[4 * j4 + e] = s; y += s * rv[e]; } }
            LDS_WAIT(); asm volatile("" ::: "memory");
            const float rkv = wave_sum(r * kp * rkc), bonus = rkv * v;
            const float mean = wave_sum(y) * (1.f / 64.f), dlt = y - mean, var = wave_sum(dlt * dlt) * (1.f / 64.f);
            const float yn = dlt * (1.0f / sqrtf(var + LNX_EPS)) * lw + lb;
            CAT[(row0 + t) * D + c] = f2bf((yn + bonus) * gv);
        }
    }
}

__device__ __forceinline__ void moe_router(const Args& a, const bf16_t* XB, unsigned* ctl, unsigned char* ws, int gw, int NGW, int lane, LAS unsigned char* sm, int wave) {
    int* list = (int*)(ws + WS_ROUTE2 + RT_LIST); float* lrstd = (float*)(ws + WS_ROUTE2 + RT_LRSTD);
    int* toke = (int*)(ws + WS_ROUTE2 + RT_TOKE); int* tokr = (int*)(ws + WS_ROUTE2 + RT_TOKR); float* tokw = (float*)(ws + WS_ROUTE2 + RT_TOKW);
    float wg[16][8];
    {   const float* wr = a.in[I_WR]; const f32x4* gr = (const f32x4*)(a.in[I_NORM_FFN] + D) + lane;
#pragma unroll
        for (int j = 0; j < 4; ++j) { const f32x4 g = gr[64 * j];
#pragma unroll
            for (int i = 0; i < 4; ++i) { const int k = 4 * (lane + 64 * j) + i; const f32x4 w0 = *(const f32x4*)(wr + (size_t)k * 8), w1 = *(const f32x4*)(wr + (size_t)k * 8 + 4);
#pragma unroll
                for (int e = 0; e < 4; ++e) { wg[4 * j + i][e] = g[i] * w0[e]; wg[4 * j + i][4 + e] = g[i] * w1[e]; } } } }
    float br[8];
#pragma unroll
    for (int e = 0; e < 8; ++e) br[e] = a.in[I_BR][e];
    int m_bi = 0, m_si = 0; float m_rs = 0.f, m_w0 = 0.f;
    u32x2 va[4], vb[4];
#define RT_LOAD(v_, r_) do { const u32x2* xr_ = (const u32x2*)(XB + (size_t)(r_) * D) + lane; _Pragma("unroll") for (int j = 0; j < 4; ++j) v_[j] = xr_[64 * j]; } while (0)
#define RT_ROW(v_, i_) do { float lg[8]; float s = 0.f; \
        _Pragma("unroll") for (int e = 0; e < 8; ++e) lg[e] = 0.f; \
        _Pragma("unroll") for (int j = 0; j < 4; ++j) _Pragma("unroll") for (int i = 0; i < 4; ++i) { const unsigned pw_ = (i < 2) ? v_[j].x : v_[j].y; const float hv = (i & 1) ? bfhi(pw_) : bflo(pw_); s += hv * hv; \
            _Pragma("unroll") for (int e = 0; e < 8; ++e) lg[e] += hv * wg[4 * j + i][e]; } \
        wave_sum8(lg); const float rs = rstd_of(wave_sum_fast(s)); \
        _Pragma("unroll") for (int e = 0; e < 8; ++e) lg[e] = lg[e] * rs + br[e]; \
        float bv = lg[0]; int bi = 0; \
        _Pragma("unroll") for (int e = 1; e < 8; ++e) if (lg[e] > bv) { bv = lg[e]; bi = e; } \
        float sv = -3.0e38f; int si = 0; \
        _Pragma("unroll") for (int e = 0; e < 8; ++e) if (e != bi && lg[e] > sv) { sv = lg[e]; si = e; } \
        const float w0 = 1.0f / (1.0f + __expf(sv - bv)); \
        if (lane == (i_)) { m_bi = bi; m_si = si; m_rs = rs; m_w0 = w0; } } while (0)
    int nrow = 0;
    if (gw < T) RT_LOAD(va, gw);
    for (int r = gw; r < T; r += 2 * NGW) {
        const int r2 = r + NGW, r3 = r + 2 * NGW;
        if (r2 < T) RT_LOAD(vb, r2);
        __builtin_amdgcn_sched_barrier(0);
        RT_ROW(va, nrow); ++nrow;
        if (r3 < T) RT_LOAD(va, r3);
        __builtin_amdgcn_sched_barrier(0);
        if (r2 < T) { RT_ROW(vb, nrow); ++nrow; }
    }
#undef RT_LOAD
#undef RT_ROW
    {   LAS int* wcnt = (LAS int*)sm; LAS int* wbase = wcnt + 64;
        const bool act = lane < nrow; int myc = 0; unsigned long long mk[8];
#pragma unroll
        for (int e = 0; e < 8; ++e) { mk[e] = __ballot(act && (m_bi == e || m_si == e)); if (lane == e) myc = __popcll(mk[e]); }
        if (lane < 8) wcnt[wave * 8 + lane] = myc;
        __syncthreads();
        if (wave == 0 && lane < 8) { int tot = 0, pre[8];
#pragma unroll
            for (int w = 0; w < 8; ++w) { pre[w] = tot; tot += wcnt[w * 8 + lane]; }
            const int base = tot ? (int)atomicAdd(ctl + CW_CNT + 64 * lane, (unsigned)tot) : 0;
#pragma unroll
            for (int w = 0; w < 8; ++w) wbase[w * 8 + lane] = base + pre[w]; }
        __syncthreads();
        if (act) { const int r = gw + NGW * lane; const int bi = m_bi, si = m_si; const float rs = m_rs, w0 = m_w0, w1 = 1.0f - w0;
            const unsigned long long lt = (1ull << lane) - 1ull; int r0 = 0, r1 = 0;
#pragma unroll
            for (int e = 0; e < 8; ++e) { const int rk = wbase[wave * 8 + e] + __popcll(mk[e] & lt); if (bi == e) r0 = rk; if (si == e) r1 = rk; }
            list[bi * 32768 + r0] = r; lrstd[bi * 32768 + r0] = rs; list[si * 32768 + r1] = r; lrstd[si * 32768 + r1] = rs;
            toke[2 * r] = bi; toke[2 * r + 1] = si; tokr[2 * r] = r0; tokr[2 * r + 1] = r1; tokw[2 * r] = w0; tokw[2 * r + 1] = w1; } }
}

constexpr int RW_LS = 72;
constexpr int RW_SLOT = 64 * RW_LS * 2;
constexpr int RW_FS = 65;
__device__ __forceinline__ LAS unsigned char* rw_slot(LAS unsigned char* lds, int s) { return lds + s * RW_SLOT; }
__device__ __forceinline__ bf16x8 rw_frag(const LAS unsigned char* m, int row, int kq, int ks) { return *(const LAS bf16x8*)(m + row * (RW_LS * 2) + (32 * ks + 8 * kq) * 2); }
__device__ __forceinline__ f32x4 rw_mm(const LAS unsigned char* A, const LAS unsigned char* Bt, int mt, int nt, int l15, int kq, f32x4 acc) {
#pragma unroll
    for (int ks = 0; ks < 2; ++ks) acc = __builtin_amdgcn_mfma_f32_16x16x32_bf16(rw_frag(A, 16 * mt + l15, kq, ks), rw_frag(Bt, 16 * nt + l15, kq, ks), acc, 0, 0, 0);
    return acc;
}
__device__ __forceinline__ void rw_store_T(LAS unsigned char* m, int mt, int nt, int q, int n, f32x4 v) {
    u32x2 w; w.x = cvt_pk_bf16(v[0], v[1]); w.y = cvt_pk_bf16(v[2], v[3]);
    *(LAS u32x2*)(m + (16 * nt + n) * (RW_LS * 2) + (16 * mt + 4 * q) * 2) = w;
}
__device__ __forceinline__ void rw_store_D(LAS unsigned char* m, int mt, int nt, int q, int n, f32x4 v) {
#pragma unroll
    for (int r = 0; r < 4; ++r) *(LAS bf16_t*)(m + (16 * mt + 4 * q + r) * (RW_LS * 2) + (16 * nt + n) * 2) = f2bf(v[r]);
}
struct RwF2 { bf16x8 k[2]; };
__device__ __forceinline__ RwF2 rw_ld2(const LAS unsigned char* m, int row, int kq) { RwF2 f; f.k[0] = rw_frag(m, row, kq, 0); f.k[1] = rw_frag(m, row, kq, 1); return f; }
__device__ __forceinline__ f32x4 rw_mmf(const RwF2& a, const RwF2& b, f32x4 acc) {
    acc = __builtin_amdgcn_mfma_f32_16x16x32_bf16(a.k[0], b.k[0], acc, 0, 0, 0); return __builtin_amdgcn_mfma_f32_16x16x32_bf16(a.k[1], b.k[1], acc, 0, 0, 0); }
#define RW_LOADED() __builtin_amdgcn_sched_barrier(0)
__device__ __forceinline__ float rw_ld1(const LAS unsigned char* m, int row, int col) { return bf2f(*(const LAS bf16_t*)(m + row * (RW_LS * 2) + col * 2)); }

#ifdef DBG_RWKV
__device__ __forceinline__ void rw_dbg_scan(LAS unsigned char* lds, int slot, int bit, unsigned* word, int tid) {
    unsigned bad = 0u;
    for (int i = tid; i < 4096; i += NTHR) { const float v = rw_ld1(rw_slot(lds, slot), i >> 6, i & 63); if (!(v - v == 0.f)) bad = 1u; }
    if (bad) atomicOr(word, 1u << bit);
}
#define RW_DBG(slot, bit) rw_dbg_scan(lds, slot, bit, B.dbg, tid)
__device__ __forceinline__ void rw_dbg_max(LAS unsigned char* lds, int slot, unsigned* word, int tid) {
    float m = 0.f;
    for (int i = tid; i < 4096; i += NTHR) { const float v = fabsf(rw_ld1(rw_slot(lds, slot), i >> 6, i & 63)); if (v - v == 0.f) m = fmaxf(m, v); }
    atomicMax(word, __float_as_uint(m));
}
#else
#define RW_DBG(slot, bit)
#endif
struct RwBufs { unsigned* dbg;  bf16_t* XL; bf16_t* Pp; bf16_t* Qp; bf16_t* Rp; float* WL; bf16_t* GA; bf16_t* GB; bf16_t* CAT; const bf16_t* P1; const bf16_t* w2T; const bf16_t* a2T; const bf16_t* g2T; };

__device__ __forceinline__ void rwkv_xpre(const Args& a, const RwBufs& B, int bx, int G, int wave) {
    const int tid = wave * 64 + lane_now(), c8 = (tid & 31) * 8, seg = c8 >> 5, tr = tid >> 5;
    const float* mu = a.in[I_MU];
    const f32x4 m0 = *(const f32x4*)(mu + 2304 + c8), m1 = *(const f32x4*)(mu + 2304 + c8 + 4);
#pragma unroll 2
    for (int r = bx * 16 + tr; r < T; r += G * 16) {
        const bf16_t* cp = B.P1 + (size_t)r * INB + 2304 + c8;
        const u32x4 cw = *(const u32x4*)cp, pw = ((r & (SEQ - 1)) == 0) ? (u32x4){0u, 0u, 0u, 0u} : *(const u32x4*)(cp - INB);
        float x[8]; const unsigned cwa[4] = {cw.x, cw.y, cw.z, cw.w}, pwa[4] = {pw.x, pw.y, pw.z, pw.w};
#pragma unroll
        for (int e = 0; e < 4; ++e) { const float c0 = bflo(cwa[e]), c1 = bfhi(cwa[e]), p0 = bflo(pwa[e]), p1 = bfhi(pwa[e]);
            const float mm0 = (e < 2) ? m0[2 * e] : m1[2 * e - 4], mm1 = (e < 2) ? m0[2 * e + 1] : m1[2 * e - 3];
            x[2 * e] = c0 + (p0 - c0) * mm0; x[2 * e + 1] = c1 + (p1 - c1) * mm1; }
#pragma unroll
        for (int e = 0; e < 8; ++e) { const float sg = __builtin_amdgcn_rcpf(1.0f + __expf(seg < 2 ? -2.0f * x[e] : -x[e])); x[e] = (seg < 2) ? (2.0f * sg - 1.0f) : ((seg >= 4) ? sg : x[e]); }
        u32x4 o; o.x = cvt_pk_bf16(x[0], x[1]); o.y = cvt_pk_bf16(x[2], x[3]); o.z = cvt_pk_bf16(x[4], x[5]); o.w = cvt_pk_bf16(x[6], x[7]);
        *(u32x4*)(B.XL + (size_t)r * 256 + c8) = o; }
}

#ifndef RW_DUPS
#define RW_DUPS 0
#endif
#define RW_REP(bit) _Pragma("unroll 1") for (int rp_ = 0; rp_ < ((((RW_DUPS) >> (bit)) & 1) ? 4 : 1); ++rp_)
__device__ __forceinline__ void rwkv_r1(const Args& a, LAS unsigned char* lds, const RwBufs& B, int bx, int G, int wave, int nitems) {
    const int lane = lane_now(), l15 = lane & 15, kq = lane >> 4, q = kq, n = l15, tid = wave * 64 + lane;
    LAS float* Fw = (LAS float*)lds; LAS float* Fa = Fw + 64 * RW_FS; LAS float* Fg = Fa + 64 * RW_FS;
    LAS float* gsum = (LAS float*)(lds + 15 * RW_SLOT);
    const float* mu = a.in[I_MU];
    const int h = bx % RH, rk = bx / RH, nh = (G - h + RH - 1) / RH, nbc = nitems / RH;
    u32x4 pcw[4]; unsigned ldrk[9], ldv2[5];
#define RW_ISSUE(bc_) do { const int b_ = (bc_) >> 6, c_ = (bc_) & 63; const size_t r0_ = (size_t)b_ * SEQ + c_ * 64; \
        { const int tid_ = wave * 64 + lane_now(); const int t_ = tid_ >> 3, seg_ = tid_ & 7; const bf16_t* cp_ = B.XL + (r0_ + t_) * 256 + 32 * seg_; \
          _Pragma("unroll") for (int v8 = 0; v8 < 4; ++v8) pcw[v8] = *(const u32x4*)(cp_ + 8 * v8); } \
        { const bf16_t* pr0_ = B.P1 + (r0_ + 8 * wave) * INB + h * 64 + lane_now(); const bool z0_ = (c_ == 0 && wave == 0); \
          _Pragma("unroll") for (int u = 0; u < 9; ++u) { unsigned r_ = 0u, k_ = 0u, v_ = 0u; if (!(u == 0 && z0_)) { const bf16_t* pp_ = pr0_ + (ptrdiff_t)(u - 1) * INB; r_ = pp_[0]; k_ = pp_[CS]; v_ = pp_[2 * CS]; } \
              ldrk[u] = r_ | (k_ << 16); if (u & 1) ldv2[u >> 1] |= v_ << 16; else ldv2[u >> 1] = v_; } } } while (0)
    const int cgh = h * 64 + lane;
    const float hc_a0 = a.in[I_A0][cgh], hc_kk = a.in[I_KK][cgh], hc_ka = a.in[I_KA][cgh], hc_rk = a.in[I_RK][cgh], hc_lxw = a.in[I_LNXW][cgh], hc_lxb = a.in[I_LNXB][cgh];
    const float hc_mur = mu[cgh], hc_muk = mu[CS + cgh], hc_muv = mu[2 * CS + cgh], hc_w0n = a.in[I_W0][h * 64 + 16 * (wave & 3) + l15];
#define RW_WFR_LOAD \
        { const int ntw = wave & 3; const size_t rw = (size_t)(h * 64 + 16 * ntw + l15); \
    _Pragma("unroll") \
          for (int ks = 0; ks < 2; ++ks) { wfr[ks] = *(const bf16x8*)(B.w2T + rw * 64 + 32 * ks + 8 * kq); wfr[2 + ks] = *(const bf16x8*)(B.a2T + rw * 64 + 32 * ks + 8 * kq); } \
    _Pragma("unroll") \
          for (int ks = 0; ks < 4; ++ks) wfr[4 + ks] = *(const bf16x8*)(B.g2T + rw * 128 + 32 * ks + 8 * kq); } \

    bf16x8 wfr[8];
#if !RW_DUPS
    RW_WFR_LOAD
#endif
    if (rk < nbc) RW_ISSUE(rk);
#pragma unroll 1
    for (int bc = rk; bc < nbc; bc += nh) {
        const int b = bc >> 6, c = bc & 63, item = bc * RH + h;
        const size_t row0 = (size_t)b * SEQ + c * 64;
#if RW_DUPS
        RW_WFR_LOAD
#endif
        __syncthreads();
        { const int tid0 = wave * 64 + lane_now(), t = tid0 >> 3, seg = tid0 & 7;
          LAS unsigned char* dst = rw_slot(lds, 6 + (seg >> 1)) + t * (RW_LS * 2) + (32 * (seg & 1)) * 2;
#pragma unroll
          for (int v8 = 0; v8 < 4; ++v8) *(LAS u32x4*)(dst + 16 * v8) = pcw[v8]; }
        __syncthreads();
        RW_REP(1) {
#pragma unroll
        for (int i6 = 0; i6 < 6; ++i6) { const int ti = wave + 8 * i6, mat = i6 >> 1, mt = (ti >> 2) & 3, nt = wave & 3; f32x4 acc = {0.f, 0.f, 0.f, 0.f};
            if (mat < 2) { const LAS unsigned char* X = rw_slot(lds, 6 + mat);
#pragma unroll
                for (int ks = 0; ks < 2; ++ks) acc = __builtin_amdgcn_mfma_f32_16x16x32_bf16(rw_frag(X, 16 * mt + l15, kq, ks), wfr[2 * mat + ks], acc, 0, 0, 0);
            } else {
#pragma unroll
                for (int ks = 0; ks < 4; ++ks) acc = __builtin_amdgcn_mfma_f32_16x16x32_bf16(rw_frag(rw_slot(lds, 8 + (ks >> 1)), 16 * mt + l15, kq, ks & 1), wfr[4 + ks], acc, 0, 0, 0); }
            LAS float* F = (mat == 0) ? Fw : (mat == 1 ? Fa : Fg);
            if (mat == 0) {
                const float w0n = hc_w0n; float s4 = 0.f;
#pragma unroll
                for (int r = 0; r < 4; ++r) { const float z = -(w0n + acc[r]); acc[r] = -0.6065306597126334f * __builtin_amdgcn_rcpf(1.0f + __expf(z)); s4 += acc[r]; }
                s4 += __shfl_xor(s4, 16);
                if ((q & 1) == 0) gsum[(2 * mt + (q >> 1)) * 64 + 16 * nt + n] = s4; }
#pragma unroll
            for (int r = 0; r < 4; ++r) F[(16 * mt + 4 * q + r) * RW_FS + 16 * nt + n] = acc[r]; }
        __syncthreads();
        }
        RW_REP(2) {
        {   const int j = lane, cg = h * 64 + j, t0 = 8 * wave;
            const float a0 = hc_a0, kkw = hc_kk, kaw = hc_ka, rkw = hc_rk, lxw = hc_lxw, lxb = hc_lxb, mur = hc_mur, muk = hc_muk, muv = hc_muv;
            float ldv[8], av[8], rv[8], kv[8], vv[8], kkv[8];
            float pr_r = bflo(ldrk[0]), pr_k = bfhi(ldrk[0]), pr_v = bflo(ldv2[0]);
#pragma unroll
            for (int u = 0; u < 8; ++u) { const float cr = bflo(ldrk[u + 1]), ck = bfhi(ldrk[u + 1]), cv = ((u + 1) & 1) ? bfhi(ldv2[(u + 1) >> 1]) : bflo(ldv2[(u + 1) >> 1]);
                rv[u] = cr + (pr_r - cr) * mur; kv[u] = ck + (pr_k - ck) * muk; vv[u] = cv + (pr_v - cv) * muv; pr_r = cr; pr_k = ck; pr_v = cv;
                ldv[u] = Fw[(t0 + u) * RW_FS + j];
                av[u] = sigmoidf_(a0 + Fa[(t0 + u) * RW_FS + j]);
                const float kx = kv[u] * kkw; const float ss = wave_sum_fast(kx * kx); kkv[u] = kx * __builtin_amdgcn_rsqf(fmaxf(ss, 1e-24f)); }
            float lw[8]; lw[0] = ldv[0];
#pragma unroll
            for (int u = 1; u < 8; ++u) lw[u] = lw[u - 1] + ldv[u];
            float off = 0.f, tot = 0.f;
#pragma unroll
            for (int w8 = 0; w8 < 8; ++w8) { const float gs = gsum[w8 * 64 + j]; tot += gs; if (w8 < wave) off += gs; }
            if (wave == 0) B.WL[(size_t)item * 64 + lane_now()] = __expf(tot);
            unsigned pAt[4], pBh[4], pKh[4], pV[4], pga[4], pgb[4];
            const float WLt = __expf(tot); float Wprev = __expf(off);
#pragma unroll
            for (int u2 = 0; u2 < 4; ++u2) { float tAt[2], tBh[2], tKh[2], ga2[2], gb2[2];
#pragma unroll
                for (int uu = 0; uu < 2; ++uu) { const int u = 2 * u2 + uu; const float lwt = off + lw[u];
                    const float kp = kv[u] * (1.f + (av[u] - 1.f) * kaw), ap = -kkv[u], bb = kkv[u] * av[u];
                    const float Wt = __expf(lwt), Wm1 = Wprev, iW = __builtin_amdgcn_rcpf(Wt), WLr = WLt * iW; Wprev = Wt;
                    const float bonus = wave_sum_fast(rv[u] * kp * rkw);
                    const float gv = Fg[(t0 + u) * RW_FS + j];
                    ga2[uu] = lxw * gv; gb2[uu] = (lxb + bonus * vv[u]) * gv;
                    const int t = t0 + u;
                    *(LAS bf16_t*)(rw_slot(lds, 10) + t * (RW_LS * 2) + j * 2) = f2bf(ap * Wm1);
                    *(LAS bf16_t*)(rw_slot(lds, 11) + t * (RW_LS * 2) + j * 2) = f2bf(bb * iW);
                    *(LAS bf16_t*)(rw_slot(lds, 12) + t * (RW_LS * 2) + j * 2) = f2bf(kp * iW);
                    *(LAS bf16_t*)(rw_slot(lds, 13) + t * (RW_LS * 2) + j * 2) = f2bf(rv[u] * Wt);
                    tAt[uu] = ap * Wm1; tBh[uu] = bb * WLr; tKh[uu] = kp * WLr; }
                pAt[u2] = cvt_pk_bf16(tAt[0], tAt[1]); pBh[u2] = cvt_pk_bf16(tBh[0], tBh[1]); pKh[u2] = cvt_pk_bf16(tKh[0], tKh[1]); pV[u2] = cvt_pk_bf16(vv[2 * u2], vv[2 * u2 + 1]);
                pga[u2] = cvt_pk_bf16(ga2[0], ga2[1]); pgb[u2] = cvt_pk_bf16(gb2[0], gb2[1]); }
            *(LAS u32x4*)(rw_slot(lds, 14) + j * (RW_LS * 2) + t0 * 2) = (u32x4){pAt[0], pAt[1], pAt[2], pAt[3]};
            *(LAS u32x4*)(rw_slot(lds, 6) + j * (RW_LS * 2) + t0 * 2) = (u32x4){pBh[0], pBh[1], pBh[2], pBh[3]};
            *(LAS u32x4*)(rw_slot(lds, 7) + j * (RW_LS * 2) + t0 * 2) = (u32x4){pKh[0], pKh[1], pKh[2], pKh[3]};
            *(LAS u32x4*)(rw_slot(lds, 8) + j * (RW_LS * 2) + t0 * 2) = (u32x4){pV[0], pV[1], pV[2], pV[3]};
            { const int j2 = lane_now(); bf16_t* gap = B.GA + (size_t)item * 4096 + j2 * 64; bf16_t* gbp = B.GB + (size_t)item * 4096 + j2 * 64;
#pragma unroll
              for (int hh = 0; hh < 2; ++hh) { const int pos = (2 * (wave & 1) + hh) * 16 + (wave >> 1) * 4;
                  *(u32x2*)(gap + pos) = (u32x2){pga[2 * hh], pga[2 * hh + 1]}; *(u32x2*)(gbp + pos) = (u32x2){pgb[2 * hh], pgb[2 * hh + 1]}; } }
        }
        __syncthreads();
        }
        if (bc + nh < nbc) RW_ISSUE(bc + nh);
        RW_DBG(10, 0); RW_DBG(11, 1); RW_DBG(12, 2); RW_DBG(13, 3); RW_DBG(14, 4); RW_DBG(6, 5); RW_DBG(7, 6); RW_DBG(8, 7);
        RW_REP(3) {
        {   const int nt = wave & 3, mta = wave >> 2, mtb = mta + 2; const f32x4 z4 = {0.f, 0.f, 0.f, 0.f};
            const int da = 16 * (mta - nt) + 4 * q - n, db = 16 * (mtb - nt) + 4 * q - n;
#define RW_MASK(acc_, d_, MODE) do { _Pragma("unroll") for (int r = 0; r < 4; ++r) { const bool keep = (MODE == 0) ? ((d_) + r > 0) : ((MODE == 1) ? ((d_) + r < 0) : ((d_) + r <= 0)); acc_[r] = keep ? acc_[r] : 0.f; } } while (0)
            {   const RwF2 a10a = rw_ld2(rw_slot(lds, 10), 16 * mta + l15, kq), a10b = rw_ld2(rw_slot(lds, 10), 16 * mtb + l15, kq), b11 = rw_ld2(rw_slot(lds, 11), 16 * nt + l15, kq);
                const RwF2 a12a = rw_ld2(rw_slot(lds, 12), 16 * mta + l15, kq), a12b = rw_ld2(rw_slot(lds, 12), 16 * mtb + l15, kq), b10 = rw_ld2(rw_slot(lds, 10), 16 * nt + l15, kq);
                RW_LOADED();
                f32x4 c0 = rw_mmf(a10a, b11, z4), c1 = rw_mmf(a10b, b11, z4), c2 = rw_mmf(a12a, b10, z4), c3 = rw_mmf(a12b, b10, z4);
                RW_MASK(c0, da, 0); RW_MASK(c1, db, 0); RW_MASK(c2, da, 1); RW_MASK(c3, db, 1);
                rw_store_T(rw_slot(lds, 0), mta, nt, q, n, c0); rw_store_T(rw_slot(lds, 0), mtb, nt, q, n, c1); rw_store_T(rw_slot(lds, 1), mta, nt, q, n, c2); rw_store_T(rw_slot(lds, 1), mtb, nt, q, n, c3);
                RW_LOADED(); }
            {   const RwF2 a11a = rw_ld2(rw_slot(lds, 11), 16 * mta + l15, kq), a11b = rw_ld2(rw_slot(lds, 11), 16 * mtb + l15, kq), b13 = rw_ld2(rw_slot(lds, 13), 16 * nt + l15, kq);
                const RwF2 a12a = rw_ld2(rw_slot(lds, 12), 16 * mta + l15, kq), a12b = rw_ld2(rw_slot(lds, 12), 16 * mtb + l15, kq);
                RW_LOADED();
                f32x4 c0 = rw_mmf(a11a, b13, z4), c1 = rw_mmf(a11b, b13, z4), c2 = rw_mmf(a12a, b13, z4), c3 = rw_mmf(a12b, b13, z4);
                RW_MASK(c0, da, 2); RW_MASK(c1, db, 2); RW_MASK(c2, da, 2); RW_MASK(c3, db, 2);
                rw_store_T(rw_slot(lds, 2), mta, nt, q, n, c0); rw_store_T(rw_slot(lds, 2), mtb, nt, q, n, c1); rw_store_T(rw_slot(lds, 3), mta, nt, q, n, c2); rw_store_T(rw_slot(lds, 3), mtb, nt, q, n, c3);
                RW_LOADED(); } }
        for (int i = wave * 64 + lane_now(); i < 2 * RW_SLOT / 16; i += NTHR) *(LAS u32x4*)(rw_slot(lds, 4) + i * 16) = (u32x4){0u, 0u, 0u, 0u};
        __syncthreads();
        }
        RW_DBG(0, 8); RW_DBG(1, 9); RW_DBG(2, 10); RW_DBG(3, 11);
#ifdef DBG_RWKV
        rw_dbg_max(lds, DBG_MAXSLOT_A, B.dbg + 1, tid);
#endif
        RW_REP(4) {
        if (wave >= 4) {
            {   const int nt = wave & 3; const f32x4 z4 = {0.f, 0.f, 0.f, 0.f};
                const RwF2 a0 = rw_ld2(rw_slot(lds, 1), l15, kq), a1 = rw_ld2(rw_slot(lds, 1), 16 + l15, kq), a2 = rw_ld2(rw_slot(lds, 1), 32 + l15, kq), a3 = rw_ld2(rw_slot(lds, 1), 48 + l15, kq), b8 = rw_ld2(rw_slot(lds, 8), 16 * nt + l15, kq);
                RW_LOADED();
                const f32x4 c0 = rw_mmf(a0, b8, z4), c1 = rw_mmf(a1, b8, z4), c2 = rw_mmf(a2, b8, z4), c3 = rw_mmf(a3, b8, z4);
                rw_store_T(rw_slot(lds, 12), 0, nt, q, n, c0); rw_store_T(rw_slot(lds, 12), 1, nt, q, n, c1); rw_store_T(rw_slot(lds, 12), 2, nt, q, n, c2); rw_store_T(rw_slot(lds, 12), 3, nt, q, n, c3); } }
        if (wave < 4 && lane_now() < 16) { const int i0 = 16 * wave, cc = lane_now(); float Tc[16];
            const LAS unsigned char* AT = rw_slot(lds, 0);
#pragma unroll
            for (int t = 0; t < 16; ++t) { float s = (t == cc) ? 1.f : 0.f;
#pragma unroll
                for (int s2 = 0; s2 < t; ++s2) s += rw_ld1(AT, i0 + s2, i0 + t) * Tc[s2];
                Tc[t] = s; }
#pragma unroll
            for (int t = 0; t < 16; ++t) *(LAS bf16_t*)(rw_slot(lds, 4) + (i0 + t) * (RW_LS * 2) + (i0 + cc) * 2) = f2bf(Tc[t]);
            u32x4 o0, o1; o0.x = cvt_pk_bf16(Tc[0], Tc[1]); o0.y = cvt_pk_bf16(Tc[2], Tc[3]); o0.z = cvt_pk_bf16(Tc[4], Tc[5]); o0.w = cvt_pk_bf16(Tc[6], Tc[7]);
            o1.x = cvt_pk_bf16(Tc[8], Tc[9]); o1.y = cvt_pk_bf16(Tc[10], Tc[11]); o1.z = cvt_pk_bf16(Tc[12], Tc[13]); o1.w = cvt_pk_bf16(Tc[14], Tc[15]);
            *(LAS u32x4*)(rw_slot(lds, 5) + (i0 + cc) * (RW_LS * 2) + i0 * 2) = o0; *(LAS u32x4*)(rw_slot(lds, 5) + (i0 + cc) * (RW_LS * 2) + (i0 + 8) * 2) = o1;
        }
#if RW_DUPS
        __syncthreads();
#endif
        }
        if (wave < 4 && lane_now() < 16) { const int i0 = 16 * wave, cc = lane_now();
            LDS_WAIT();
            *(LAS u32x4*)(rw_slot(lds, 0) + (i0 + cc) * (RW_LS * 2) + i0 * 2) = (u32x4){0u, 0u, 0u, 0u}; *(LAS u32x4*)(rw_slot(lds, 0) + (i0 + cc) * (RW_LS * 2) + (i0 + 8) * 2) = (u32x4){0u, 0u, 0u, 0u};
        }
        __syncthreads();
        RW_DBG(4, 12); RW_DBG(5, 13);
#ifdef DBG_RWKV
        rw_dbg_max(lds, 4, B.dbg + 2, tid);
#endif
        RW_REP(5) {
        {   const int nt = wave & 3, mta = wave >> 2, mtb = mta + 2; const f32x4 z4 = {0.f, 0.f, 0.f, 0.f};
            const RwF2 a4a = rw_ld2(rw_slot(lds, 4), 16 * mta + l15, kq), a4b = rw_ld2(rw_slot(lds, 4), 16 * mtb + l15, kq), b0 = rw_ld2(rw_slot(lds, 0), 16 * nt + l15, kq);
            RW_LOADED();
            const f32x4 c0 = rw_mmf(a4a, b0, z4), c1 = rw_mmf(a4b, b0, z4);
            rw_store_T(rw_slot(lds, 11), mta, nt, q, n, c0); rw_store_D(rw_slot(lds, 9), mta, nt, q, n, c0); rw_store_T(rw_slot(lds, 11), mtb, nt, q, n, c1); rw_store_D(rw_slot(lds, 9), mtb, nt, q, n, c1); }
        __syncthreads();
        }
        RW_DBG(9, 14); RW_DBG(11, 15);
#ifdef DBG_RWKV
        rw_dbg_max(lds, 11, B.dbg + 3, tid);
#endif
        RW_REP(6) {
        {   const int nt = wave & 3, mta = wave >> 2, mtb = mta + 2; const f32x4 z4 = {0.f, 0.f, 0.f, 0.f};
            const RwF2 a11a = rw_ld2(rw_slot(lds, 11), 16 * mta + l15, kq), a11b = rw_ld2(rw_slot(lds, 11), 16 * mtb + l15, kq), b9 = rw_ld2(rw_slot(lds, 9), 16 * nt + l15, kq);
            const RwF2 a9a = rw_ld2(rw_slot(lds, 9), 16 * mta + l15, kq), a9b = rw_ld2(rw_slot(lds, 9), 16 * mtb + l15, kq), b5 = rw_ld2(rw_slot(lds, 5), 16 * nt + l15, kq);
            const u32x2 dga = *(const LAS u32x2*)(rw_slot(lds, 5) + (16 * nt + n) * (RW_LS * 2) + (16 * mta + 4 * q) * 2), dgb = *(const LAS u32x2*)(rw_slot(lds, 5) + (16 * nt + n) * (RW_LS * 2) + (16 * mtb + 4 * q) * 2);
            RW_LOADED();
            const f32x4 c0 = rw_mmf(a11a, b9, z4), c1 = rw_mmf(a11b, b9, z4);
            const f32x4 c2 = rw_mmf(a9a, b5, (f32x4){bflo(dga.x), bfhi(dga.x), bflo(dga.y), bfhi(dga.y)}), c3 = rw_mmf(a9b, b5, (f32x4){bflo(dgb.x), bfhi(dgb.x), bflo(dgb.y), bfhi(dgb.y)});
            rw_store_T(rw_slot(lds, 10), mta, nt, q, n, c0); rw_store_T(rw_slot(lds, 10), mtb, nt, q, n, c1);
            RW_LOADED();
            rw_store_T(rw_slot(lds, 0), mta, nt, q, n, c2); rw_store_T(rw_slot(lds, 0), mtb, nt, q, n, c3); }
        __syncthreads();
        }
        RW_DBG(10, 16); RW_DBG(0, 17);
        RW_REP(7) {
        {   const int nt = wave & 3, mta = wave >> 2, mtb = mta + 2;
            const RwF2 a0a = rw_ld2(rw_slot(lds, 0), 16 * mta + l15, kq), a0b = rw_ld2(rw_slot(lds, 0), 16 * mtb + l15, kq), b10 = rw_ld2(rw_slot(lds, 10), 16 * nt + l15, kq);
            f32x4 za, zb;
#pragma unroll
            for (int r = 0; r < 4; ++r) { za[r] = rw_ld1(rw_slot(lds, 0), 16 * mta + 4 * q + r, 16 * nt + n); zb[r] = rw_ld1(rw_slot(lds, 0), 16 * mtb + 4 * q + r, 16 * nt + n); }
            RW_LOADED();
            const f32x4 c0 = rw_mmf(a0a, b10, za), c1 = rw_mmf(a0b, b10, zb);
            rw_store_T(rw_slot(lds, 4), mta, nt, q, n, c0); rw_store_T(rw_slot(lds, 4), mtb, nt, q, n, c1); }
        __syncthreads();
        }
        RW_DBG(4, 18);
        RW_REP(8) {
        {   const int nt = wave & 3, mta = wave >> 2, mtb = mta + 2; const f32x4 z4 = {0.f, 0.f, 0.f, 0.f};
            const RwF2 a4a = rw_ld2(rw_slot(lds, 4), 16 * mta + l15, kq), a4b = rw_ld2(rw_slot(lds, 4), 16 * mtb + l15, kq), b14 = rw_ld2(rw_slot(lds, 14), 16 * nt + l15, kq), b12 = rw_ld2(rw_slot(lds, 12), 16 * nt + l15, kq);
            RW_LOADED();
            const f32x4 c0 = rw_mmf(a4a, b14, z4), c1 = rw_mmf(a4b, b14, z4), c2 = rw_mmf(a4a, b12, z4), c3 = rw_mmf(a4b, b12, z4);
            rw_store_T(rw_slot(lds, 5), mta, nt, q, n, c0); rw_store_T(rw_slot(lds, 5), mtb, nt, q, n, c1); rw_store_T(rw_slot(lds, 11), mta, nt, q, n, c2); rw_store_T(rw_slot(lds, 11), mtb, nt, q, n, c3); }
        __syncthreads();
        }
        RW_DBG(5, 19); RW_DBG(11, 21);
        RW_REP(10) {
        {   const int nt = wave & 3, mta = wave >> 2, mtb = mta + 2; const f32x4 z4 = {0.f, 0.f, 0.f, 0.f};
#define RW_PK(c_) ((u32x2){cvt_pk_bf16(c_[0], c_[1]), cvt_pk_bf16(c_[2], c_[3])})
            {
                const RwF2 a5a = rw_ld2(rw_slot(lds, 5), 16 * mta + l15, kq), a5b = rw_ld2(rw_slot(lds, 5), 16 * mtb + l15, kq), b6 = rw_ld2(rw_slot(lds, 6), 16 * nt + l15, kq), b2 = rw_ld2(rw_slot(lds, 2), 16 * nt + l15, kq);
                const u32x2 rta = *(const LAS u32x2*)(rw_slot(lds, 13) + (16 * nt + n) * (RW_LS * 2) + (16 * mta + 4 * q) * 2), rtb = *(const LAS u32x2*)(rw_slot(lds, 13) + (16 * nt + n) * (RW_LS * 2) + (16 * mtb + 4 * q) * 2);
                RW_LOADED();
                const f32x4 c0 = rw_mmf(a5a, b6, z4), c1 = rw_mmf(a5b, b6, z4);
                const f32x4 c2 = rw_mmf(a5a, b2, (f32x4){bflo(rta.x), bfhi(rta.x), bflo(rta.y), bfhi(rta.y)}), c3 = rw_mmf(a5b, b2, (f32x4){bflo(rtb.x), bfhi(rtb.x), bflo(rtb.y), bfhi(rtb.y)});
                *(u32x2*)(B.Pp + (size_t)item * 4096 + (size_t)((nt * 2 + (mta >> 1)) * 64 + n + 16 * q) * 8 + 4 * (mta & 1)) = RW_PK(c0);
                *(u32x2*)(B.Pp + (size_t)item * 4096 + (size_t)((nt * 2 + (mtb >> 1)) * 64 + n + 16 * q) * 8 + 4 * (mtb & 1)) = RW_PK(c1);
                *(u32x2*)(B.Rp + (size_t)item * 4096 + (size_t)((nt * 2 + (mta >> 1)) * 64 + n + 16 * q) * 8 + 4 * (mta & 1)) = RW_PK(c2);
                *(u32x2*)(B.Rp + (size_t)item * 4096 + (size_t)((nt * 2 + (mtb >> 1)) * 64 + n + 16 * q) * 8 + 4 * (mtb & 1)) = RW_PK(c3);
                RW_LOADED(); }
            {
                const RwF2 b11 = rw_ld2(rw_slot(lds, 11), 16 * nt + l15, kq), b8 = rw_ld2(rw_slot(lds, 8), 16 * nt + l15, kq);
                const RwF2 a6a = rw_ld2(rw_slot(lds, 6), 16 * mta + l15, kq), a6b = rw_ld2(rw_slot(lds, 6), 16 * mtb + l15, kq), a7a = rw_ld2(rw_slot(lds, 7), 16 * mta + l15, kq), a7b = rw_ld2(rw_slot(lds, 7), 16 * mtb + l15, kq);
                RW_LOADED();
                f32x4 c0 = rw_mmf(a6a, b11, z4), c1 = rw_mmf(a6b, b11, z4); c0 = rw_mmf(a7a, b8, c0); c1 = rw_mmf(a7b, b8, c1);
                *(u32x2*)(B.Qp + (size_t)item * 4096 + (size_t)((nt * 4 + mta) * 64 + lane_now()) * 4) = RW_PK(c0);
                *(u32x2*)(B.Qp + (size_t)item * 4096 + (size_t)((nt * 4 + mtb) * 64 + lane_now()) * 4) = RW_PK(c1);
                RW_LOADED();
                const RwF2 a2a = rw_ld2(rw_slot(lds, 2), 16 * mta + l15, kq), a2b = rw_ld2(rw_slot(lds, 2), 16 * mtb + l15, kq), a3a = rw_ld2(rw_slot(lds, 3), 16 * mta + l15, kq), a3b = rw_ld2(rw_slot(lds, 3), 16 * mtb + l15, kq);
                RW_LOADED();
                f32x4 c2 = rw_mmf(a2a, b11, z4), c3 = rw_mmf(a2b, b11, z4); c2 = rw_mmf(a3a, b8, c2); c3 = rw_mmf(a3b, b8, c3);
                *(u32x2*)(B.CAT + (row0 + 16 * nt + n) * D + h * 64 + q * 16 + mta * 4) = RW_PK(c2);
                *(u32x2*)(B.CAT + (row0 + 16 * nt + n) * D + h * 64 + q * 16 + mtb * 4) = RW_PK(c3); }
        }
#if RW_DUPS
        __syncthreads();
#endif
        }
    }
}

constexpr int R2_SLOT = 2 * 8192 + 256, R2_LA = 7;
#define R2_WAITV(n) asm volatile("s_waitcnt vmcnt(" #n ")" ::: "memory")
struct R2Own { u32x2 qv[4]; u32x4 y0, y1; };
__device__ __forceinline__ void rwkv_r2(LAS unsigned char* lds, const RwBufs& B, int bx, int G, int wave, int nbh, bool dry = false) {
    const int lane = lane_now(), q = lane >> 4, n = lane & 15, wv = wave & 3;
#pragma unroll 1
    for (int bh = bx; bh < nbh; bh += G) {
        const int b = bh / RH, h = bh % RH;
        __syncthreads();
#define R2_ISSUE(c_) do { const int cc_ = (c_); const size_t item_ = (size_t)(b * 64 + cc_) * RH + h; LAS unsigned char* sl_ = lds + (cc_ & 7) * R2_SLOT; \
            const bf16_t* src_ = (wv < 2 ? B.Pp : B.Rp) + item_ * 4096 + (size_t)(wv & 1) * 2048 + lane_now() * 8; \
            _Pragma("unroll") for (int f = 0; f < 4; ++f) __builtin_amdgcn_global_load_lds((const unsigned*)(src_ + f * 512), (LAS unsigned*)(sl_ + (wv >> 1) * 8192 + (wv & 1) * 4096 + f * 1024), 16, 0, 0); \
            if (wv == 3 && lane_now() < 16) __builtin_amdgcn_global_load_lds((const unsigned*)(B.WL + item_ * 64 + lane_now() * 4), (LAS unsigned*)(sl_ + 2 * 8192), 16, 0, 0); } while (0)
#define R2_LANDED(c1_) do { const int af_ = (((c1_) + R2_LA - 1 < 63) ? ((c1_) + R2_LA - 1) : 63) - (c1_); \
            if (wv < 3) { if (af_ >= 6) R2_WAITV(24); else if (af_ == 5) R2_WAITV(20); else if (af_ == 4) R2_WAITV(16); else if (af_ == 3) R2_WAITV(12); else if (af_ == 2) R2_WAITV(8); else if (af_ == 1) R2_WAITV(4); else R2_WAITV(0); } \
            else        { if (af_ >= 6) R2_WAITV(30); else if (af_ == 5) R2_WAITV(25); else if (af_ == 4) R2_WAITV(20); else if (af_ == 3) R2_WAITV(15); else if (af_ == 2) R2_WAITV(10); else if (af_ == 1) R2_WAITV(5); else R2_WAITV(0); } } while (0)
#define R2_OWN(O_, c_) do { const int cc_ = (c_); const size_t item_ = (size_t)(b * 64 + cc_) * RH + h; const size_t rw0_ = (size_t)b * SEQ + cc_ * 64; \
            _Pragma("unroll") for (int mt = 0; mt < 4; ++mt) O_.qv[mt] = *(const u32x2*)(B.Qp + item_ * 4096 + (size_t)((wv * 4 + mt) * 64 + lane) * 4); \
            const bf16_t* yp_ = B.CAT + (rw0_ + 16 * wv + n) * D + h * 64 + q * 16; O_.y0 = *(const u32x4*)yp_; O_.y1 = *(const u32x4*)(yp_ + 8); } while (0)
        f32x4 S[4];
#pragma unroll
        for (int mt = 0; mt < 4; ++mt) S[mt] = (f32x4){0.f, 0.f, 0.f, 0.f};
        R2Own Oa, Ob, Oc, Od;
        if (wave >= 4) { R2_ISSUE(0); R2_ISSUE(1); R2_ISSUE(2); R2_ISSUE(3); R2_ISSUE(4); R2_ISSUE(5); R2_ISSUE(6); R2_LANDED(0); }
        else { R2_OWN(Oa, 0); R2_OWN(Ob, 1); R2_OWN(Oc, 2); R2_OWN(Od, 3); }
        __syncthreads();
#define R2_STEP(O_, c_) do { const int c = (c_); \
            if (wave >= 4) { if (c + R2_LA < 64) R2_ISSUE(c + R2_LA); if (c + 1 < 64) R2_LANDED(c + 1); } \
            else { \
                const size_t row0 = (size_t)b * SEQ + c * 64; const LAS unsigned char* sl = lds + (c & 7) * R2_SLOT; \
                bf16x8 pf[8], rf[8]; \
                _Pragma("unroll") for (int f = 0; f < 8; ++f) { pf[f] = *(const LAS bf16x8*)(sl + f * 1024 + lane * 16); rf[f] = *(const LAS bf16x8*)(sl + 8192 + f * 1024 + lane * 16); } \
                f32x4 wl[4]; \
                _Pragma("unroll") for (int mt = 0; mt < 4; ++mt) wl[mt] = *(const LAS f32x4*)(sl + 2 * 8192 + (16 * mt + 4 * q) * 4); \
                bf16_t* yp = B.CAT + (row0 + 16 * wv + n) * D + h * 64 + q * 16; \
                  \
                bf16x8 sh[2], sl2[2]; \
                _Pragma("unroll") for (int ks = 0; ks < 2; ++ks) { unsigned hw[4], lw[4]; \
                    _Pragma("unroll") for (int hf = 0; hf < 2; ++hf) { const f32x4 s = S[2 * ks + hf]; \
                        const unsigned h01 = cvt_pk_bf16(s[0], s[1]), h23 = cvt_pk_bf16(s[2], s[3]); \
                        hw[2 * hf] = h01; hw[2 * hf + 1] = h23; \
                        lw[2 * hf] = cvt_pk_bf16(s[0] - bflo(h01), s[1] - bfhi(h01)); lw[2 * hf + 1] = cvt_pk_bf16(s[2] - bflo(h23), s[3] - bfhi(h23)); } \
                    u32x4 hv = {hw[0], hw[1], hw[2], hw[3]}, lv = {lw[0], lw[1], lw[2], lw[3]}; \
                    sh[ks] = __builtin_bit_cast(bf16x8, hv); sl2[ks] = __builtin_bit_cast(bf16x8, lv); } \
                  \
                f32x4 ya[4]; \
                { const unsigned yw[8] = {O_.y0.x, O_.y0.y, O_.y0.z, O_.y0.w, O_.y1.x, O_.y1.y, O_.y1.z, O_.y1.w}; \
                  _Pragma("unroll") for (int mt = 0; mt < 4; ++mt) ya[mt] = (f32x4){bflo(yw[2 * mt]), bfhi(yw[2 * mt]), bflo(yw[2 * mt + 1]), bfhi(yw[2 * mt + 1])}; } \
                _Pragma("unroll") for (int mt = 0; mt < 4; ++mt) _Pragma("unroll") for (int ks = 0; ks < 2; ++ks) { \
                    ya[mt] = __builtin_amdgcn_mfma_f32_16x16x32_bf16(rf[mt * 2 + ks], sh[ks], ya[mt], 0, 0, 0); ya[mt] = __builtin_amdgcn_mfma_f32_16x16x32_bf16(rf[mt * 2 + ks], sl2[ks], ya[mt], 0, 0, 0); } \
                { u32x4 o0, o1; o0.x = cvt_pk_bf16(ya[0][0], ya[0][1]); o0.y = cvt_pk_bf16(ya[0][2], ya[0][3]); o0.z = cvt_pk_bf16(ya[1][0], ya[1][1]); o0.w = cvt_pk_bf16(ya[1][2], ya[1][3]); \
                  o1.x = cvt_pk_bf16(ya[2][0], ya[2][1]); o1.y = cvt_pk_bf16(ya[2][2], ya[2][3]); o1.z = cvt_pk_bf16(ya[3][0], ya[3][1]); o1.w = cvt_pk_bf16(ya[3][2], ya[3][3]); \
                  if (!dry) { *(u32x4*)yp = o0; *(u32x4*)(yp + 8) = o1; } } \
                  \
                f32x4 sn[4]; \
                _Pragma("unroll") for (int mt = 0; mt < 4; ++mt) { sn[mt] = (f32x4){bflo(O_.qv[mt].x), bfhi(O_.qv[mt].x), bflo(O_.qv[mt].y), bfhi(O_.qv[mt].y)} + wl[mt] * S[mt]; } \
                _Pragma("unroll") for (int mt = 0; mt < 4; ++mt) _Pragma("unroll") for (int ks = 0; ks < 2; ++ks) { \
                    sn[mt] = __builtin_amdgcn_mfma_f32_16x16x32_bf16(pf[mt * 2 + ks], sh[ks], sn[mt], 0, 0, 0); sn[mt] = __builtin_amdgcn_mfma_f32_16x16x32_bf16(pf[mt * 2 + ks], sl2[ks], sn[mt], 0, 0, 0); } \
                _Pragma("unroll") for (int mt = 0; mt < 4; ++mt) S[mt] = sn[mt]; \
                if (c + 4 < 64) R2_OWN(O_, c + 4);        \
            } \
            __syncthreads(); } while (0)
#pragma unroll 1
        for (int c0 = 0; c0 < 64; c0 += 4) { R2_STEP(Oa, c0); R2_STEP(Ob, c0 + 1); R2_STEP(Oc, c0 + 2); R2_STEP(Od, c0 + 3); }
    }
}

__device__ __forceinline__ void rwkv_r3(const RwBufs& B, int gw, int NGW, int nitems) {
    const int lane = lane_now(), q = lane >> 4, n = lane & 15;
#pragma unroll 1
    for (int item = gw; item < nitems; item += NGW) {
        const int b = item / (64 * RH), c = (item / RH) & 63, h = item % RH; const size_t row0 = (size_t)b * SEQ + c * 64;
        unsigned yw[4][8];
        u32x4 ga[4][2], gb[4][2];
#pragma unroll
        for (int wv = 0; wv < 4; ++wv) { const bf16_t* yp = B.CAT + (row0 + 16 * wv + n) * D + h * 64 + q * 16; const u32x4 y0 = *(const u32x4*)yp, y1 = *(const u32x4*)(yp + 8);
            yw[wv][0] = y0.x; yw[wv][1] = y0.y; yw[wv][2] = y0.z; yw[wv][3] = y0.w; yw[wv][4] = y1.x; yw[wv][5] = y1.y; yw[wv][6] = y1.z; yw[wv][7] = y1.w;
#pragma unroll
            for (int hf = 0; hf < 2; ++hf) { const size_t go = (size_t)item * 4096 + (size_t)(16 * wv + n) * 64 + q * 16 + 8 * hf; ga[wv][hf] = *(const u32x4*)(B.GA + go); gb[wv][hf] = *(const u32x4*)(B.GB + go); } }
        asm volatile("s_waitcnt vmcnt(0)" ::: "memory");
#pragma unroll
        for (int hf = 0; hf < 2; ++hf) {
            float s1[8], s2[8];
#pragma unroll
            for (int e4 = 0; e4 < 8; ++e4) { s1[e4] = 0.f; s2[e4] = 0.f; }
#pragma unroll
            for (int wv = 0; wv < 4; ++wv)
#pragma unroll
                for (int e2 = 0; e2 < 4; ++e2) { const unsigned w = yw[wv][4 * hf + e2]; const float ylo = bflo(w), yhi = bfhi(w); s1[2 * e2] += ylo; s2[2 * e2] += ylo * ylo; s1[2 * e2 + 1] += yhi; s2[2 * e2 + 1] += yhi * yhi; }
#pragma unroll
            for (int e4 = 0; e4 < 8; ++e4) {
#pragma unroll
                for (int o = 1; o < 16; o <<= 1) { s1[e4] += __shfl_xor(s1[e4], o); s2[e4] += __shfl_xor(s2[e4], o); }
                const float mean = s1[e4] * (1.f / 64.f), var = fmaxf(s2[e4] * (1.f / 64.f) - mean * mean, 0.f); s1[e4] = mean; s2[e4] = 1.0f / sqrtf(var + LNX_EPS); }
#pragma unroll
            for (int wv = 0; wv < 4; ++wv) { const u32x4 a0 = ga[wv][hf], b0 = gb[wv][hf];
                const unsigned aw[4] = {a0.x, a0.y, a0.z, a0.w}, bw[4] = {b0.x, b0.y, b0.z, b0.w};
#pragma unroll
                for (int e4 = 0; e4 < 8; ++e4) { const int e = 8 * hf + e4; const unsigned ywd = yw[wv][e >> 1];
                    const float yv = (e & 1) ? bfhi(ywd) : bflo(ywd), gaf = (e & 1) ? bfhi(aw[e4 >> 1]) : bflo(aw[e4 >> 1]), gbf = (e & 1) ? bfhi(bw[e4 >> 1]) : bflo(bw[e4 >> 1]);
                    const float o = (yv - s1[e4]) * s2[e4] * gaf + gbf; const int t = 16 * (e >> 2) + 4 * q + (e & 3);
                    B.CAT[(row0 + t) * D + h * 64 + 16 * wv + n] = f2bf(o); } }
        }
    }
}

constexpr int S5_TAB_EL = 128 * 256 + 256 * 384;
constexpr int S5_US = 264, S5_ZS = 65, S5_XS = 136;
typedef short bf16x4s __attribute__((ext_vector_type(4)));

__device__ __forceinline__ void s5_tables(const Args& a, LAS unsigned char* lds, bf16_t* TAB, float* A16T, int g, int part, int tid) {
    constexpr int CST = 68;
    LAS float* pwr = (LAS float*)lds; LAS float* pwi = pwr + 17 * 64;
    LAS float* bbr = pwi + 17 * 64; LAS float* bbi = bbr + 64 * 16;
    LAS float* crs = bbi + 64 * 16; LAS float* cis = crs + 16 * CST;
    LAS float* Kt = cis + 16 * CST;
    LAS float* zrs = Kt + 4096; LAS float* zis = zrs + 64;
    __syncthreads();
    {   const float dt = expf(a.in[I_LOG_DT][g]);
        for (int idx = tid; idx < 25 * 64; idx += NTHR) { const int t = idx >> 6, p = idx & 63; const float lr = a.in[I_LAM_RE][g * S5P + p], li = a.in[I_LAM_IM][g * S5P + p];
            const float tt = (t <= 16) ? (float)t : 16.0f * (float)(t - 16), m = expf(lr * dt * tt); float sn, cs; sincosf(li * dt * tt, &sn, &cs); const float vr = m * cs, vi = m * sn;
            if (t <= 16) { pwr[t * 64 + p] = vr; pwi[t * 64 + p] = vi; } else if (part == 0) { A16T[(g * 8 + (t - 17)) * 128 + p] = vr; A16T[(g * 8 + (t - 17)) * 128 + 64 + p] = vi; } }
        if (tid < 64) { const int p = tid; const float lr = a.in[I_LAM_RE][g * S5P + p], li = a.in[I_LAM_IM][g * S5P + p];
            float sn, cs, sh, ch; sincosf(li * dt, &sn, &cs); sincosf(0.5f * li * dt, &sh, &ch); const float em1 = expm1f(lr * dt);
            const float nre = em1 * cs - 2.0f * sh * sh, nim = (em1 + 1.0f) * sn, den = lr * lr + li * li;
            zrs[p] = (nre * lr + nim * li) / den; zis[p] = (nim * lr - nre * li) / den; } }
    for (int i = tid; i < 1024; i += NTHR) { crs[(i >> 6) * CST + (i & 63)] = a.in[I_C_RE][(size_t)g * 1024 + i]; cis[(i >> 6) * CST + (i & 63)] = a.in[I_C_IM][(size_t)g * 1024 + i]; }
    __syncthreads();
    for (int i = tid; i < 1024; i += NTHR) { const int p = i >> 4; const float zr = zrs[p], zi = zis[p], br = a.in[I_B_RE][(size_t)g * S5P * 16 + i], bi = a.in[I_B_IM][(size_t)g * S5P * 16 + i];
        bbr[i] = zr * br - zi * bi; bbi[i] = zr * bi + zi * br; }
    __syncthreads();
    for (int w = tid; w < (4 * part + 4) * 64; w += NTHR) { const int t = w >> 6, j = (w >> 2) & 15, jq = w & 3; f32x4 s4 = {0.f, 0.f, 0.f, 0.f};
#pragma unroll 2
        for (int p4 = 0; p4 < 64; p4 += 4) { const f32x4 cr = *(const LAS f32x4*)(crs + j * CST + p4), ci = *(const LAS f32x4*)(cis + j * CST + p4), ar = *(const LAS f32x4*)(pwr + t * 64 + p4), ai = *(const LAS f32x4*)(pwi + t * 64 + p4);
#pragma unroll
            for (int e = 0; e < 4; ++e) { const float wr = cr[e] * ar[e] - ci[e] * ai[e], wi = cr[e] * ai[e] + ci[e] * ar[e];
                const f32x4 br = *(const LAS f32x4*)(bbr + (p4 + e) * 16 + 4 * jq), bi = *(const LAS f32x4*)(bbi + (p4 + e) * 16 + 4 * jq);
                s4 += wr * br - wi * bi; } }
        if (t == 0 && (j >> 2) == jq) s4[j & 3] += a.in[I_S5D][g * 16 + j];
        *(LAS f32x4*)(Kt + (t << 8) + (j << 4) + 4 * jq) = s4; }
    __syncthreads();
    bf16_t* Gt = TAB + (size_t)g * S5_TAB_EL; bf16_t* MH = Gt + 128 * 256;
    for (int idx = part * 32 * 256 + tid; idx < (part + 1) * 32 * 256; idx += NTHR) { const int pp = idx >> 8, k = idx & 255, s = k >> 4, jp = k & 15, p = pp & 63, t = 15 - s;
        const float ar = pwr[t * 64 + p], ai = pwi[t * 64 + p], br = bbr[p * 16 + jp], bi = bbi[p * 16 + jp];
        Gt[idx] = f2bf(pp < 64 ? (ar * br - ai * bi) : (ar * bi + ai * br)); }
    for (int rr = 0; rr < 64; ++rr) { const int row = part * 64 + rr, t = row >> 4, j = row & 15;
        if (tid < 384) { const int k = tid; float v;
            if (k < 256) { const int s = k >> 4, jp = k & 15; v = (s <= t) ? Kt[((t - s) << 8) + (j << 4) + jp] : 0.f; }
            else { const int pp = k - 256, p = pp & 63; const float cr = crs[j * CST + p], ci = cis[j * CST + p], ar = pwr[(t + 1) * 64 + p], ai = pwi[(t + 1) * 64 + p];
                v = pp < 64 ? (cr * ar - ci * ai) : -(cr * ai + ci * ar); }
            MH[(size_t)row * 384 + k] = f2bf(v); } }
}

__device__ __forceinline__ float gelu_fast_(float x) { const float a2 = 1.5957691216057308f * (x + 0.044715f * x * x * x); return x * __builtin_amdgcn_rcpf(1.0f + __expf(-a2)); }

__device__ __forceinline__ void s5_chunked(const Args& a, LAS unsigned char* lds, const bf16_t* U, const bf16_t* TAB, const float* A16T, bf16_t* CAT, int bx, int G, int wave) {
    const int lane = lane_now(), l15 = lane & 15, kq = lane >> 4, q = kq, n = l15, tid = wave * 64 + lane;
    LAS unsigned char* Us0 = lds; LAS float* Zs = (LAS float*)(lds + 64 * S5_US * 2); LAS unsigned char* Xp = lds + 64 * S5_US * 2 + 128 * S5_ZS * 4;
    LAS unsigned char* Us1 = Xp + 64 * S5_XS * 2 + 8 * 128 * 4;
#define S5_UDMA(buf_, nb_) do { const int ln_ = lane_now(); if (ln_ < 32) { const bf16_t* src_ = UT + (size_t)((nb_) * 64 + 8 * wave) * 256 + ln_ * 8; \
        _Pragma("unroll") for (int i = 0; i < 8; ++i) __builtin_amdgcn_global_load_lds((const unsigned*)(src_ + (size_t)i * 256), (LAS unsigned*)((buf_) + (8 * wave + i) * (S5_US * 2)), 16, 0, 0); } } while (0)
#pragma unroll 1
    for (int item = bx; item < NB * S5G; item += G) {
        const int b = item / S5G, g = item % S5G;
        const bf16_t* UT = U + (size_t)(b * S5G + g) * SEQ * 16;
        const bf16_t* Gt = TAB + (size_t)g * S5_TAB_EL; const bf16_t* MH = Gt + 128 * 256;
        bf16x8 ga[8], mh[2][12];
#pragma unroll
        for (int ks = 0; ks < 8; ++ks) ga[ks] = *(const bf16x8*)(Gt + (size_t)(16 * wave + l15) * 256 + 32 * ks + 8 * kq);
        const int tau0 = wave, tau1 = 15 - wave;
#pragma unroll
        for (int ks = 0; ks < 12; ++ks) { mh[0][ks] = *(const bf16x8*)(MH + (size_t)(16 * tau0 + l15) * 384 + 32 * ks + 8 * kq); mh[1][ks] = *(const bf16x8*)(MH + (size_t)(16 * tau1 + l15) * 384 + 32 * ks + 8 * kq); }
        bf16x4s wg; { unsigned short w4[4];
#pragma unroll
            for (int e = 0; e < 4; ++e) w4[e] = f2bf(a.in[I_WGLU][(size_t)(g * 16 + 4 * kq + e) * 16 + l15]);
            wg = (bf16x4s){(short)w4[0], (short)w4[1], (short)w4[2], (short)w4[3]}; }
        const f32x4 bq = *(const f32x4*)(a.in[I_BGLU] + g * 16 + 4 * q);
        float xr = 0.f, xi = 0.f;
        float apr[8], api[8];
#pragma unroll
        for (int k8 = 0; k8 < 8; ++k8) { apr[k8] = A16T[(g * 8 + k8) * 128 + lane]; api[k8] = A16T[(g * 8 + k8) * 128 + 64 + lane]; }
        LAS float* Ex = (LAS float*)(Xp + 64 * S5_XS * 2);
        __syncthreads();
        S5_UDMA(Us0, 0);
#pragma unroll 1
        for (int nb = 0; nb < 4; ++nb) {
            LAS unsigned char* Us = (nb & 1) ? Us1 : Us0;
            asm volatile("s_waitcnt vmcnt(0)" ::: "memory");
            __syncthreads();
            if (nb + 1 < 4) { if (nb & 1) S5_UDMA(Us0, nb + 1); else S5_UDMA(Us1, nb + 1); }
#pragma unroll
            for (int nt = 0; nt < 4; ++nt) { f32x4 acc = {0.f, 0.f, 0.f, 0.f};
#pragma unroll
                for (int ks = 0; ks < 8; ++ks) acc = __builtin_amdgcn_mfma_f32_16x16x32_bf16(ga[ks], *(const LAS bf16x8*)(Us + (16 * nt + l15) * (S5_US * 2) + (32 * ks + 8 * kq) * 2), acc, 0, 0, 0);
#pragma unroll
                for (int r = 0; r < 4; ++r) Zs[(16 * wave + 4 * q + r) * S5_ZS + 16 * nt + n] = acc[r]; }
            __syncthreads();
            {   float lr8[8], li8[8]; float sr = 0.f, si = 0.f;
#pragma unroll
                for (int i = 0; i < 8; ++i) { lr8[i] = sr; li8[i] = si; const int c = 8 * wave + i; const float zr = Zs[lane * S5_ZS + c], zi = Zs[(64 + lane) * S5_ZS + c];
                    const float nr = apr[0] * sr - api[0] * si + zr, ni = apr[0] * si + api[0] * sr + zi; sr = nr; si = ni; }
                Ex[wave * 128 + lane] = sr; Ex[wave * 128 + 64 + lane] = si;
                __syncthreads();
                float cr = xr, ci = xi, myr = xr, myi = xi;
#pragma unroll
                for (int v = 0; v < 8; ++v) { if (v == wave) { myr = cr; myi = ci; }
                    const float er = Ex[v * 128 + lane], ei = Ex[v * 128 + 64 + lane]; const float nr = apr[7] * cr - api[7] * ci + er, ni = apr[7] * ci + api[7] * cr + ei; cr = nr; ci = ni; }
                xr = cr; xi = ci;
#pragma unroll
                for (int i = 0; i < 8; ++i) { float pr = lr8[i], pi = li8[i];
                    if (i == 0) { pr += myr; pi += myi; } else { pr += apr[i - 1] * myr - api[i - 1] * myi; pi += apr[i - 1] * myi + api[i - 1] * myr; }
                    const int c = 8 * wave + i; *(LAS bf16_t*)(Xp + c * (S5_XS * 2) + lane * 2) = f2bf(pr); *(LAS bf16_t*)(Xp + c * (S5_XS * 2) + (64 + lane) * 2) = f2bf(pi); } }
            __syncthreads();
#pragma unroll
            for (int mi = 0; mi < 2; ++mi) { const int tau = mi ? tau1 : tau0, kmax = tau >> 1;
#pragma unroll 1
                for (int nt = 0; nt < 4; ++nt) { f32x4 acc = {0.f, 0.f, 0.f, 0.f};
                    const LAS unsigned char* ub = Us + (16 * nt + l15) * (S5_US * 2) + (8 * kq) * 2; const LAS unsigned char* xb = Xp + (16 * nt + l15) * (S5_XS * 2) + (8 * kq) * 2;
#pragma unroll
                    for (int ks = 0; ks < 8; ++ks) if (ks <= kmax) acc = __builtin_amdgcn_mfma_f32_16x16x32_bf16(mh[mi][ks], *(const LAS bf16x8*)(ub + 64 * ks), acc, 0, 0, 0);
#pragma unroll
                    for (int ks = 0; ks < 4; ++ks) acc = __builtin_amdgcn_mfma_f32_16x16x32_bf16(mh[mi][8 + ks], *(const LAS bf16x8*)(xb + 64 * ks), acc, 0, 0, 0);
                    f32x4 yg; yg[0] = gelu_fast_(acc[0]); yg[1] = gelu_fast_(acc[1]); yg[2] = gelu_fast_(acc[2]); yg[3] = gelu_fast_(acc[3]);
                    const unsigned p01 = cvt_pk_bf16(yg[0], yg[1]), p23 = cvt_pk_bf16(yg[2], yg[3]); const u32x2 pk = {p01, p23};
                    const f32x4 z = __builtin_amdgcn_mfma_f32_16x16x16bf16_1k(wg, __builtin_bit_cast(bf16x4s, pk), bq, 0, 0, 0);
                    const int t = (nb * 64 + 16 * nt + n) * 16 + tau;
                    u32x2 o; o.x = cvt_pk_bf16(yg[0] * sigmoidf_(z[0]), yg[1] * sigmoidf_(z[1])); o.y = cvt_pk_bf16(yg[2] * sigmoidf_(z[2]), yg[3] * sigmoidf_(z[3]));
                    *(u32x2*)(CAT + ((size_t)b * SEQ + t) * D + g * 16 + 4 * q) = o; } }
        }
    }
}

constexpr int AT_KS = 72, AT_VS = 264;
__device__ __forceinline__ void attn_mfma(LAS unsigned char* lds, const bf16_t* Q, const bf16_t* KV, bf16_t* CAT, int bx, int G, int wave) {
    const int lane = lane_now(), l15 = lane & 15, kq = lane >> 4, q = kq, n = l15, tid = wave * 64 + lane;
    LAS unsigned char* Ks = lds; LAS unsigned char* Vt = lds + 256 * AT_KS * 2;
#pragma unroll 1
    for (int item = bx; item < NB * NH_MEM * 16; item += G) {
        const int b = item >> 6, h = (item >> 4) & 3, qb = item & 15;
        __syncthreads();
#pragma unroll
        for (int i = 0; i < 4; ++i) { const int idx = tid + 512 * i, key = idx >> 3, seg = idx & 7;
            const bf16_t* src = KV + (size_t)(b * MEML + key) * 512 + h * 64 + seg * 8;
            *(LAS u32x4*)(Ks + key * (AT_KS * 2) + seg * 16) = *(const u32x4*)src;
            const u32x4 vw = *(const u32x4*)(src + 256); const unsigned vv[4] = {vw.x, vw.y, vw.z, vw.w};
#pragma unroll
            for (int e = 0; e < 4; ++e) { *(LAS bf16_t*)(Vt + (seg * 8 + 2 * e) * (AT_VS * 2) + key * 2) = (bf16_t)(vv[e] & 0xffffu); *(LAS bf16_t*)(Vt + (seg * 8 + 2 * e + 1) * (AT_VS * 2) + key * 2) = (bf16_t)(vv[e] >> 16); } }
        __syncthreads();
#pragma unroll 1
        for (int tile = 0; tile < 2; ++tile) {
            const size_t qrow = (size_t)b * SEQ + qb * 256 + wave * 32 + tile * 16;
            bf16x8 qf[2];
#pragma unroll
            for (int ks = 0; ks < 2; ++ks) qf[ks] = *(const bf16x8*)(Q + (qrow + l15) * CM + h * 64 + 32 * ks + 8 * kq);
            f32x4 s[16];
#pragma unroll
            for (int kt = 0; kt < 16; ++kt) { f32x4 acc = {0.f, 0.f, 0.f, 0.f};
#pragma unroll
                for (int ks = 0; ks < 2; ++ks) acc = __builtin_amdgcn_mfma_f32_16x16x32_bf16(*(const LAS bf16x8*)(Ks + (16 * kt + l15) * (AT_KS * 2) + (32 * ks + 8 * kq) * 2), qf[ks], acc, 0, 0, 0);
                s[kt] = acc; if (kt & 1) asm volatile("" ::: "memory"); }
            float m = -3.0e38f;
#pragma unroll
            for (int kt = 0; kt < 16; ++kt) m = fmaxf(m, fmaxf(fmaxf(s[kt][0], s[kt][1]), fmaxf(s[kt][2], s[kt][3])));
            m = fmaxf(m, __shfl_xor(m, 16)); m = fmaxf(m, __shfl_xor(m, 32));
            float sum = 0.f; const float c = 0.125f * 1.4426950408889634f;
#pragma unroll
            for (int kt = 0; kt < 16; ++kt)
#pragma unroll
                for (int r = 0; r < 4; ++r) { const float p = __builtin_amdgcn_exp2f((s[kt][r] - m) * c); s[kt][r] = p; sum += p; }
            sum += __shfl_xor(sum, 16); sum += __shfl_xor(sum, 32);
            const float inv = 1.0f / sum;
            bf16x8 pf[8];
#pragma unroll
            for (int k2 = 0; k2 < 8; ++k2) { const u32x4 w = {cvt_pk_bf16(s[2 * k2][0], s[2 * k2][1]), cvt_pk_bf16(s[2 * k2][2], s[2 * k2][3]), cvt_pk_bf16(s[2 * k2 + 1][0], s[2 * k2 + 1][1]), cvt_pk_bf16(s[2 * k2 + 1][2], s[2 * k2 + 1][3])};
                pf[k2] = __builtin_bit_cast(bf16x8, w); }
#pragma unroll 1
            for (int dt = 0; dt < 4; ++dt) { f32x4 acc = {0.f, 0.f, 0.f, 0.f};
#pragma unroll
                for (int k2 = 0; k2 < 8; ++k2) { const LAS unsigned char* vp = Vt + (16 * dt + l15) * (AT_VS * 2) + (32 * k2 + 4 * kq) * 2;
                    const u32x2 v0 = *(const LAS u32x2*)vp, v1 = *(const LAS u32x2*)(vp + 32); const u32x4 vw = {v0.x, v0.y, v1.x, v1.y};
                    acc = __builtin_amdgcn_mfma_f32_16x16x32_bf16(__builtin_bit_cast(bf16x8, vw), pf[k2], acc, 0, 0, 0); }
                u32x2 o; o.x = cvt_pk_bf16(acc[0] * inv, acc[1] * inv); o.y = cvt_pk_bf16(acc[2] * inv, acc[3] * inv);
                *(u32x2*)(CAT + (qrow + n) * D + CS + h * 64 + 16 * dt + 4 * q) = o; }
        }
    }
}
constexpr int N_PHASES = 15;

__device__ __forceinline__ TrJob small_job(const Args& a, int j) {
    unsigned char* ws = a.ws; TrJob r;
    switch (j) {
    case 0: r = TrJob{a.in[I_WINA], (bf16_t*)(ws + WS_WINA), a.in[I_NORM_MIX], D, D, 0, 0, 0.f}; break;
    case 1: r = TrJob{a.in[I_WOUT], (bf16_t*)(ws + WS_WOUT0), nullptr, D, D, 0, 0, 0.f}; break;
    case 2: r = TrJob{a.in[I_WOUT] + (size_t)D * D, (bf16_t*)(ws + WS_WOUT1), nullptr, D, D, 0, 0, 0.f}; break;
    case 3: r = TrJob{a.in[I_WKV], (bf16_t*)(ws + WS_WKV), nullptr, D, 512, 0, 0, 0.f}; break;
    case 4: r = TrJob{a.in[I_WKV] + (size_t)D * 512, (bf16_t*)(ws + WS_WKV) + (size_t)512 * D, nullptr, D, 512, 0, 0, 0.f}; break;
    case 5: r = TrJob{a.in[I_FGATE], (bf16_t*)(ws + WS_WGU0), a.in[I_NORM_FFN], D, FD, 1, 0, 0.f}; break;
    case 6: r = TrJob{a.in[I_FUP], (bf16_t*)(ws + WS_WGU0), a.in[I_NORM_FFN], D, FD, 2, 0, 0.f}; break;
    case 7: r = TrJob{a.in[I_FDOWN], (bf16_t*)(ws + WS_WD0), nullptr, FD, D, 0, 0, 0.f}; break;
    case 8: r = TrJob{a.in[I_WINB], (bf16_t*)(ws + WS_WINB), a.in[I_NORM_MIX] + D, D, INB, 0, 0, 0.f}; break;
    case 9: r = TrJob{a.in[I_W2], (bf16_t*)(ws + WS_W2T), nullptr, 64, CS, 0, 0, 0.f}; break;
    case 10: r = TrJob{a.in[I_A2], (bf16_t*)(ws + WS_A2T), nullptr, 64, CS, 0, 0, 0.f}; break;
    default: r = TrJob{a.in[I_G2], (bf16_t*)(ws + WS_G2T), nullptr, 128, CS, 0, 0, 0.f}; break;
    }
    r.items = (r.K / 64) * (r.N / 32); r.f8s = 0.f; return r;
}
__device__ __forceinline__ TrJob moe_job(const Args& a, int j) {
    unsigned char* ws = a.ws; const int kind = j >> 3, e = j & 7; TrJob r;
    if (kind == 0) r = TrJob{a.in[I_MGATE] + (size_t)e * D * FE, (bf16_t*)(ws + WS_WMOE_GU + (size_t)e * 2 * FE * D), a.in[I_NORM_FFN] + D, D, FE, 1, 0, F8_WGU};
    else if (kind == 1) r = TrJob{a.in[I_MUP] + (size_t)e * D * FE, (bf16_t*)(ws + WS_WMOE_GU + (size_t)e * 2 * FE * D), a.in[I_NORM_FFN] + D, D, FE, 2, 0, F8_WGU};
    else r = TrJob{a.in[I_MDOWN] + (size_t)e * FE * D, (bf16_t*)(ws + WS_WMOE_D + (size_t)e * D * FE), nullptr, FE, D, 0, 0, F8_WD};
    r.items = (r.K / 64) * (r.N / 32); return r;
}

__device__ __forceinline__ void moe_convert(const Args& args, LAS float* scr, int cw, int ncw, int lane) {
    constexpr int JI = (D / 64) * (FE / 32), NGI = 24 * JI; static_assert((FE / 64) * (D / 32) == JI, "moe jobs differ in size");
    TrRegs R0, R1; int g0 = cw, g1 = cw + ncw;
    if (g0 < NGI) tr_load(moe_job(args, g0 / JI), g0 % JI, lane, R0);
    if (g1 < NGI) tr_load(moe_job(args, g1 / JI), g1 % JI, lane, R1);
#pragma unroll 1
    for (; g0 < NGI; g0 += 2 * ncw, g1 += 2 * ncw) {
        __builtin_amdgcn_sched_barrier(0);
        tr_fin(moe_job(args, g0 / JI), g0 % JI, scr, lane, R0);
        if (g0 + 2 * ncw < NGI) tr_load(moe_job(args, (g0 + 2 * ncw) / JI), (g0 + 2 * ncw) % JI, lane, R0);
        __builtin_amdgcn_sched_barrier(0);
        if (g1 < NGI) { tr_fin(moe_job(args, g1 / JI), g1 % JI, scr, lane, R1);
            if (g1 + 2 * ncw < NGI) tr_load(moe_job(args, (g1 + 2 * ncw) / JI), (g1 + 2 * ncw) % JI, lane, R1); } }
}

__device__ __forceinline__ void p0_transposes(const Args& args, LAS unsigned char* lds, int wave, int gw, int NGW) {
    unsigned char* ws = args.ws;
    LAS float* scr = (LAS float*)(lds + wave * 16384);
    {
        int base = 0;
        for (int j = 0; j < 12; ++j) { const TrJob jb = small_job(args, j);
            for (int it = gw - base; it < jb.items; it += NGW) { if (it >= 0) tr_item(jb.W, jb.K, jb.N, jb.WT, jb.gain, jb.mode, scr, it, lane_now()); }
            base = (base + jb.items) % NGW; }
    }
}
__device__ __forceinline__ void p0_memn(const Args& args, int gw, int NGW) {
    unsigned char* ws = args.ws;
    for (int r = gw; r < 2 * MROWS; r += NGW) { const int li = r / MROWS, row = r % MROWS;
        const f32x4* xr = (const f32x4*)(args.in[I_MEM] + (size_t)row * D) + lane_now(); const f32x4* gr = (const f32x4*)(args.in[I_NORM_MEM] + li * D) + lane_now();
        f32x4 v[4]; float s = 0.f;
#pragma unroll
        for (int j = 0; j < 4; ++j) { v[j] = xr[64 * j]; s += (v[j][0] * v[j][0] + v[j][1] * v[j][1]) + (v[j][2] * v[j][2] + v[j][3] * v[j][3]); }
        const float rs = rstd_of(wave_sum_fast(s));
        u32x2* o = (u32x2*)((bf16_t*)(ws + WS_MEMN) + ((size_t)li * MROWS + row) * D) + lane_now();
#pragma unroll
        for (int j = 0; j < 4; ++j) { const f32x4 g = gr[64 * j]; u32x2 w; w.x = cvt_pk_bf16(v[j][0] * rs * g[0], v[j][1] * rs * g[1]); w.y = cvt_pk_bf16(v[j][2] * rs * g[2], v[j][3] * rs * g[3]); o[64 * j] = w; }
    }
}
__device__ __forceinline__ void p0_xconv(const Args& args, bf16_t* HA, rss_t* rowss, int gw, int NGW) {
    for (int r = gw; r < T; r += 2 * NGW) {
        const int r2 = r + NGW; const bool has2 = r2 < T;
        const f32x4* xr = (const f32x4*)(args.in[I_X] + (size_t)r * D) + lane_now(); const f32x4* xq = (const f32x4*)(args.in[I_X] + (size_t)(has2 ? r2 : r) * D) + lane_now();
        f32x4 v[4], w[4]; float s = 0.f, s2 = 0.f;
#pragma unroll
        for (int j = 0; j < 4; ++j) { v[j] = xr[64 * j]; w[j] = xq[64 * j]; }
#pragma unroll
        for (int j = 0; j < 4; ++j) { s += (v[j][0] * v[j][0] + v[j][1] * v[j][1]) + (v[j][2] * v[j][2] + v[j][3] * v[j][3]); s2 += (w[j][0] * w[j][0] + w[j][1] * w[j][1]) + (w[j][2] * w[j][2] + w[j][3] * w[j][3]); }
        s = wave_sum_fast(s); s2 = wave_sum_fast(s2);
        if (lane_now() == 0) { rowss[r] = rss_fx(s); if (has2) rowss[r2] = rss_fx(s2); }
        u32x2* o = (u32x2*)(HA + (size_t)r * D) + lane_now(); u32x2* o2 = (u32x2*)(HA + (size_t)r2 * D) + lane_now();
#pragma unroll
        for (int j = 0; j < 4; ++j) { u32x2 p; p.x = cvt_pk_bf16(v[j][0], v[j][1]); p.y = cvt_pk_bf16(v[j][2], v[j][3]); o[64 * j] = p;
            if (has2) { u32x2 p2; p2.x = cvt_pk_bf16(w[j][0], w[j][1]); p2.y = cvt_pk_bf16(w[j][2], w[j][3]); o2[64 * j] = p2; } }
    }
}

template <int LO, int HI> __global__ void __launch_bounds__(NTHR, 2) fwd(Args args) {
    extern __shared__ __attribute__((aligned(16))) unsigned char lds_raw[];
    LAS unsigned char* lds = (LAS unsigned char*)lds_raw;
    volatile LAS unsigned* MISC = (volatile LAS unsigned*)(lds + LDS_MISC);
    const int wave = __builtin_amdgcn_readfirstlane(threadIdx.x >> 6);
#define lane (lane_now())
#define tid (wave * 64 + lane_now())
    const int G = gridDim.x, bx = blockIdx.x;
    const int gw = bx * NWAVES + wave, NGW = G * NWAVES;
    typedef __attribute__((address_space(1))) unsigned char gbyte_t;
    gbyte_t* wsg = (gbyte_t*)args.ws;
#define ws ((unsigned char*)wsg)
    unsigned* ctl = (unsigned*)(ws + WS_CTL);
    rss_t* rowss = (rss_t*)(ws + WS_CTL + CTL_ROWSS);
    float* X = args.out;
    bf16_t* HA = (bf16_t*)(ws + WS_HA);
    const int lo = args.ph_lo, hi = args.ph_hi;
    for (int u = tid; u < (LDS_BYTES - LDS_MISC) / 4; u += NTHR) ((LAS unsigned*)(lds + LDS_MISC))[u] = 0u;
    __syncthreads();
    XcdBarrier bar; bar.bar = ctl + CW_BAR; bar.x = 0; bar.st = nullptr; bar.wave = wave;
    const bool multi = (hi - lo) > 1;
    if (multi) bar = xcd_barrier_post(ctl + CW_BAR, MISC + 8);
#define IN(k) (LO <= (k) && (k) < HI && lo <= (k) && (k) < hi)
#define WS_FENCE() asm volatile("" : "+s"(wsg))
#ifdef TS_PHASE
    int nst = 0; volatile LAS unsigned long long* TSL = (volatile LAS unsigned long long*)(lds + LDS_MISC + 512);
#define STAMP() do { if (bx == 0 && threadIdx.x == 0) TSL[nst] = __builtin_amdgcn_s_memrealtime(); ++nst; } while (0)
#else
#define STAMP() do {} while (0)
#endif
    STAMP();
#ifdef TS_DUP
#define TS_T0() do { if (lane_now() == 0) *(volatile LAS unsigned long long*)(lds + LDS_MISC + 512 + 8 * wave) = __builtin_amdgcn_s_memrealtime(); } while (0)
#define TS_IDLE(k) do { if (((TS_DUP) >> (k)) & 1) { const unsigned long long t1_ = __builtin_amdgcn_s_memrealtime(), t0_ = *(volatile LAS unsigned long long*)(lds + LDS_MISC + 512 + 8 * wave); \
        const unsigned long long tgt_ = t1_ + (t1_ - t0_); while (__builtin_amdgcn_s_memrealtime() < tgt_) __builtin_amdgcn_s_sleep(8); } } while (0)
#else
#define TS_T0() do {} while (0)
#define TS_IDLE(k) do {} while (0)
#endif
    TS_T0();
#define SEAM(k) do { if (IN(k)) TS_IDLE(k); if (IN(k) && IN((k) + 1)) xcd_barrier(bar); TS_T0(); STAMP(); WS_FENCE(); } while (0)

    if (IN(0)) {
        if (bx < 4 * S5G) { s5_tables(args, lds, (bf16_t*)(ws + WS_S5TAB), (float*)(ws + WS_S5TAB + 12 * MiB), bx >> 2, bx & 3, tid); __syncthreads(); }
        p0_transposes(args, lds, wave, gw, NGW);
        p0_memn(args, gw, NGW);
        {
            constexpr int NTAB = 4 * S5G, KSH = 2; const int vw = (G > NTAB) ? NTAB + (G - NTAB) * KSH : G;
            if (G <= NTAB || bx < NTAB) p0_xconv(args, HA, rowss, gw, vw * NWAVES);
            else for (int j = 0; j < KSH; ++j) p0_xconv(args, HA, rowss, (NTAB + (bx - NTAB) * KSH + j) * NWAVES + wave, vw * NWAVES); }
#ifdef DUP_P0
        xcd_barrier(bar);
#if DUP_P0 & 1
        if (bx < 4 * S5G) { s5_tables(args, lds, (bf16_t*)(ws + WS_S5TAB), (float*)(ws + WS_S5TAB + 12 * MiB), bx >> 2, bx & 3, tid); __syncthreads(); }
#endif
#if DUP_P0 & 2
        p0_transposes(args, lds, wave, gw, NGW);
#endif
#if DUP_P0 & 4
        p0_memn(args, gw, NGW);
#endif
#if DUP_P0 & 8
        p0_xconv(args, HA, rowss, gw, NGW);
#endif
#endif
    }
    SEAM(0);

    if (IN(1)) {
        { pg8::DenseSched S; S.init(HA, ws + WS_WINA, T, D, D, G, bx);
          EpiInA E{(bf16_t*)(ws + WS_P0U), (bf16_t*)(ws + WS_P0Q), rowss};
          pg8::gemm_phase<EpiInA, pg8::DenseSched, true>(lds, D, S, E, 0, wave); }
        __syncthreads();
        { pg8::KvSched S; S.init(ws + WS_MEMN, ws + WS_WKV, G, (bx + 64) % G);
          EpiBf16 E{(bf16_t*)(ws + WS_KV), 512, nullptr, nullptr, 0};
          pg8::gemm_phase<EpiBf16, pg8::KvSched, true>(lds, D, S, E, 0, wave); }
    }
    SEAM(1);

    if (IN(2)) {
        bf16_t* CAT = (bf16_t*)(ws + WS_CAT);
        {
            const int n2 = NB * S5G - G;
            if (n2 > 0 && n2 < G) { if (bx >= n2) attn_mfma(lds, (const bf16_t*)(ws + WS_P0Q), (const bf16_t*)(ws + WS_KV), CAT, bx - n2, G - n2, wave); }
            else attn_mfma(lds, (const bf16_t*)(ws + WS_P0Q), (const bf16_t*)(ws + WS_KV), CAT, bx, G, wave); }
        __syncthreads();
#ifdef S5_NAIVE
        s5_naive(args, lds, (const bf16_t*)(ws + WS_P0U), CAT, bx, G, wave, lane);
#else
        s5_chunked(args, lds, (const bf16_t*)(ws + WS_P0U), (const bf16_t*)(ws + WS_S5TAB), (const float*)(ws + WS_S5TAB + 12 * MiB), CAT, bx, G, wave);
#endif
#ifdef DUP_P2
        xcd_barrier(bar);
#if DUP_P2 & 1
        attn_mfma(lds, (const bf16_t*)(ws + WS_P0Q), (const bf16_t*)(ws + WS_KV), CAT, bx, G, wave);
        __syncthreads();
#endif
#if DUP_P2 & 2
        s5_chunked(args, lds, (const bf16_t*)(ws + WS_P0U), (const bf16_t*)(ws + WS_S5TAB), (const float*)(ws + WS_S5TAB + 12 * MiB), CAT, bx, G, wave);
#endif
#endif
    }
    SEAM(2);

    if (IN(3)) {
        pg8::DenseSched S; S.init(ws + WS_CAT, ws + WS_WOUT0, T, D, D, G, bx);
        EpiRes E{args.in[I_X], nullptr, HA, rowss + T, nullptr};
        pg8::gemm_phase<EpiRes, pg8::DenseSched, true>(lds, D, S, E, 0, wave);
    }
    SEAM(3);

#ifdef DUP_P4
#pragma unroll 1
    for (int rep = 0; rep < 2; ++rep) {
#endif
    if (IN(4)) {
        pg8::DenseSched S; S.init(HA, ws + WS_WGU0, T, 2 * FD, D, G, bx);
        #ifdef DUP_P4
        int sk_ = (rep == 0) ? DUP_SKIP : 0; asm volatile("" : "+s"(sk_));
        EpiSwiglu E{(bf16_t*)(ws + WS_ACT0), FD, rowss + T, nullptr, sk_};
#else
        EpiSwiglu E{(bf16_t*)(ws + WS_ACT0), FD, rowss + T, nullptr, 0};
#endif
#ifdef DUP_P4
        if (rep == 0) pg8::gemm_phase<EpiSwiglu, pg8::DenseSched, true, false, DUP_VAR>(lds, D, S, E, 0, wave); else
#endif
        pg8::gemm_phase<EpiSwiglu, pg8::DenseSched, true>(lds, D, S, E, 0, wave);
    }
#ifdef DUP_P4
    if (rep == 0) xcd_barrier(bar); }
#endif
    SEAM(4);

    if (IN(5)) {
        pg8::DenseSched S; S.init(ws + WS_ACT0, ws + WS_WD0, T, D, FD, G, bx);
        EpiRes E{nullptr, HA, HA, rowss + 2 * T, nullptr};
        pg8::gemm_phase<EpiRes, pg8::DenseSched, true>(lds, FD, S, E, 0, wave);
    }
    SEAM(5);

    if (IN(6)) {
        pg8::DenseSched S; S.init(HA, ws + WS_WINB, T, INB, D, G, bx);
        EpiBf16 E{(bf16_t*)(ws + WS_P1), INB, rowss + 2 * T, (bf16_t*)(ws + WS_P0Q), SHIFTC};
        pg8::gemm_phase<EpiBf16, pg8::DenseSched, true>(lds, D, S, E, 0, wave);
#ifdef DUP_P6
        xcd_barrier(bar); pg8::gemm_phase<EpiBf16, pg8::DenseSched, true>(lds, D, S, E, 0, wave);
#endif
    }
    SEAM(6);

    RwBufs RB; RB.dbg = ctl + 16387;
#ifdef DBG_RWKV
    RB.Pp = (bf16_t*)(ws + 78 * MiB); RB.Qp = (bf16_t*)(ws + 84 * MiB); RB.Rp = (bf16_t*)(ws + 90 * MiB); RB.GA = (bf16_t*)(ws + 96 * MiB); RB.GB = (bf16_t*)(ws + 102 * MiB); RB.WL = (float*)(ws + 108 * MiB);
    RB.CAT = (bf16_t*)(ws + 110 * MiB);
    constexpr int RW_ITEMS = 64 * RH, RW_BH = RH;
#else
    { unsigned char* ob = (unsigned char*)args.out; RB.Pp = (bf16_t*)ob; RB.WL = (float*)(ob + 48 * MiB); RB.XL = (bf16_t*)(ob + 50 * MiB); }
    RB.Qp = (bf16_t*)(ws + WS_RQP); RB.Rp = (bf16_t*)(ws + WS_RRP); RB.GA = (bf16_t*)(ws + WS_RGA); RB.GB = (bf16_t*)(ws + WS_RGB);
    RB.CAT = (bf16_t*)(ws + WS_CAT);
    constexpr int RW_ITEMS = NB * 64 * RH, RW_BH = NB * RH;
#endif
#ifdef DBG_RWKV
    RB.XL = (bf16_t*)(ws + WS_RXL);
#endif
    RB.P1 = (const bf16_t*)(ws + WS_P1); RB.w2T = (const bf16_t*)(ws + WS_W2T); RB.a2T = (const bf16_t*)(ws + WS_A2T); RB.g2T = (const bf16_t*)(ws + WS_G2T);
    if (IN(7)) {
        rwkv_xpre(args, RB, bx, G, wave);
        xcd_barrier(bar);
#ifdef DBG_RWKV
        rwkv_prep(args, lds, (const bf16_t*)(ws + WS_P1), (bf16_t*)(ws + 432 * MiB), (bf16_t*)(ws + 480 * MiB), (bf16_t*)(ws + 128 * MiB), (bf16_t*)(ws + 2 * MiB), bx, G, tid);
        __syncthreads();
#endif
        rwkv_r1(args, lds, RB, bx, G, wave, RW_ITEMS);
#ifdef DUP_R1
        xcd_barrier(bar); rwkv_r1(args, lds, RB, bx, G, wave, RW_ITEMS);
#endif
    }
    SEAM(7);
    if (IN(8)) {
#ifdef DUP_R2
        rwkv_r2(lds, RB, bx, G, wave, RW_BH, true); xcd_barrier(bar);
#endif
        rwkv_r2(lds, RB, bx, G, wave, RW_BH);
        { const int nr2 = (RW_BH < G) ? RW_BH : G;
          if (nr2 < G) { if (bx >= nr2) { attn_mfma(lds, (const bf16_t*)(ws + WS_P0Q), (const bf16_t*)(ws + WS_KV) + (size_t)MROWS * 512, (bf16_t*)(ws + WS_CAT), bx - nr2, G - nr2, wave);
              __syncthreads(); moe_convert(args, (LAS float*)(lds + wave * 16384), (bx - nr2) * NWAVES + wave, (G - nr2) * NWAVES, lane);
          } }
          else { __syncthreads(); attn_mfma(lds, (const bf16_t*)(ws + WS_P0Q), (const bf16_t*)(ws + WS_KV) + (size_t)MROWS * 512, (bf16_t*)(ws + WS_CAT), bx, G, wave);
                 __syncthreads(); moe_convert(args, (LAS float*)(lds + wave * 16384), gw, NGW, lane); } }
    }
    SEAM(8);
    if (IN(9)) { rwkv_r3(RB, gw, NGW, RW_ITEMS);
    }
    SEAM(9);

    if (IN(10)) {
#ifdef DBG_RWKV
        {   const bf16_t* ref = (const bf16_t*)(ws + WS_CAT); const bf16_t* tst = (const bf16_t*)(ws + 110 * MiB); float sd = 0.f, sr = 0.f;
            for (int r = gw; r < SEQ; r += NGW) {
#pragma unroll
                for (int i = 0; i < 12; ++i) { const float a = bf2f(ref[(size_t)r * D + lane + 64 * i]), b = bf2f(tst[(size_t)r * D + lane + 64 * i]); sd += (a - b) * (a - b); sr += a * a; } }
            sd = wave_sum(sd); sr = wave_sum(sr);
            if (lane == 0) { atomicAdd((float*)(ctl + 16384), sd); atomicAdd((float*)(ctl + 16385), sr); }
            unsigned bad = 0u;
            for (int i = gw * 64 + lane; i < 768 * 64; i += NGW * 64) { const float v = RB.WL[i]; if (!(v - v == 0.f)) bad |= 1u; }
            for (int i = gw * 64 + lane; i < 768 * 4096; i += NGW * 64) { float v = bf2f(RB.GA[i]); if (!(v - v == 0.f)) bad |= 2u; v = bf2f(RB.GB[i]); if (!(v - v == 0.f)) bad |= 4u;
                v = bf2f(RB.Pp[i]); if (!(v - v == 0.f)) bad |= 8u; v = bf2f(RB.Qp[i]); if (!(v - v == 0.f)) bad |= 16u; v = bf2f(RB.Rp[i]); if (!(v - v == 0.f)) bad |= 32u; }
            for (int r = gw; r < SEQ; r += NGW) for (int i = 0; i < 12; ++i) { const float v = bf2f(tst[(size_t)r * D + lane + 64 * i]); if (!(v - v == 0.f)) bad |= 64u; }
            if (bad) atomicOr(ctl + 16386, bad); }
#endif
        pg8::DenseSched S; S.init(ws + WS_CAT, ws + WS_WOUT1, T, D, D, G, bx);
        EpiRes E{nullptr, HA, (bf16_t*)(ws + WS_X3), rowss + 3 * T, (unsigned char*)(ws + WS_HA2)};
        pg8::gemm_phase<EpiRes, pg8::DenseSched, true>(lds, D, S, E, 0, wave);
    }
    SEAM(10);

    if (IN(11)) {
        __syncthreads();
        moe_router(args, (const bf16_t*)(ws + WS_X3), ctl, ws, gw, NGW, lane, lds, wave);
    }
    SEAM(11);

    if constexpr (HI > 12 && LO < 14) {
#pragma unroll 1
    for (int pass = args.pass_lo; pass < args.pass_hi; ++pass) {
        constexpr int pg = 12, pd = 13;
        LAS int* tab = (LAS int*)(lds + LDS_MISC + 256);
        if (IN(pg) || IN(pd)) {
            __syncthreads();
            if (tid == 0) { int acc = 0;
#pragma unroll 1
                for (int e = 0; e < 8; ++e) { const int c = (int)__hip_atomic_load(ctl + CW_CNT + 64 * e, __ATOMIC_RELAXED, __HIP_MEMORY_SCOPE_AGENT); tab[e] = acc; tab[16 + e] = c; acc += (c + 255) >> 8; } tab[8] = acc; }
            __syncthreads();
        }
        const int ntile = (IN(pg) || IN(pd)) ? __builtin_amdgcn_readfirstlane(tab[8]) : 0;
        const int tile0 = 128 * pass, nt_pass = min(128, ntile - tile0);
        if (IN(pg) && nt_pass > 0) {
            MoeGuSched S; S.o.init(nt_pass, 2 * FE / 256, G, bx); S.A = (const char*)(ws + WS_HA2); S.W = (const char*)(ws + WS_WMOE_GU); S.list = (const int*)(ws + WS_ROUTE2 + RT_LIST); S.tab = tab; S.tile0 = tile0;
            EpiSwigluF8 E{(unsigned char*)(ws + WS_MACT), FE, (const float*)(ws + WS_ROUTE2 + RT_LRSTD)};
            pg8::gemm_phase<EpiSwigluF8, MoeGuSched, true, true>(lds, D / 2, S, E, 0, wave);
#ifdef DUP_GU
            if (pass == 0) { xcd_barrier(bar); pg8::gemm_phase<EpiSwigluF8, MoeGuSched, true, true>(lds, D / 2, S, E, 0, wave); }
#endif
        }
        SEAM(pg);
        if (IN(pd) && nt_pass > 0 && pass == 2) {
            MoeDownTailSched S; S.o.init(nt_pass, 4 * TAIL_SPLIT, G, bx); S.A = (const char*)(ws + WS_MACT); S.W = (const char*)(ws + WS_WMOE_D); S.tab = tab; S.tile0 = tile0;
            EpiSlotPart E{(bf16_t*)(ws + WS_TAILP)};
            pg8::gemm_phase<EpiSlotPart, MoeDownTailSched, true, true>(lds, TAIL_K / 2, S, E, FE / 2, wave);
        } else if (IN(pd) && nt_pass > 0) {
            MoeDownSched S; S.o.init(nt_pass, D / 256, G, bx); S.A = (const char*)(ws + WS_MACT); S.W = (const char*)(ws + WS_WMOE_D); S.tab = tab; S.tile0 = tile0;
            EpiSlot E{(bf16_t*)(ws + WS_YSLOT)};
            pg8::gemm_phase<EpiSlot, MoeDownSched, true, true>(lds, FE / 2, S, E, 0, wave);
#ifdef DUP_DN
            if (pass == 0) { xcd_barrier(bar); pg8::gemm_phase<EpiSlot, MoeDownSched, true, true>(lds, FE / 2, S, E, 0, wave); }
#endif
        }
        if (IN(pd)) TS_IDLE(pd);
        if (IN(pd) && (pass + 1 < args.pass_hi || IN(14))) xcd_barrier(bar);
        TS_T0(); STAMP(); WS_FENCE();
    }
    }

    if (IN(14)) {
        LAS int* tab = (LAS int*)(lds + LDS_MISC + 256);
        __syncthreads();
        if (tid == 0) { int acc = 0;
#pragma unroll 1
            for (int e = 0; e < 8; ++e) { const int c = (int)__hip_atomic_load(ctl + CW_CNT + 64 * e, __ATOMIC_RELAXED, __HIP_MEMORY_SCOPE_AGENT); tab[e] = acc; acc += (c + 255) >> 8; } }
        __syncthreads();
        const int* toke = (const int*)(ws + WS_ROUTE2 + RT_TOKE); const int* tokr = (const int*)(ws + WS_ROUTE2 + RT_TOKR); const float* tokw = (const float*)(ws + WS_ROUTE2 + RT_TOKW);
        const bf16_t* Y = (const bf16_t*)(ws + WS_YSLOT); const bf16_t* X3 = (const bf16_t*)(ws + WS_X3); const bf16_t* TP = (const bf16_t*)(ws + WS_TAILP);
        int ms0 = 0, ms1 = 0; float mw0 = 0.f, mw1 = 0.f;
        { const int r = gw + NGW * lane; if (r < T) { const int e0 = toke[2 * r], e1 = toke[2 * r + 1]; mw0 = tokw[2 * r]; mw1 = tokw[2 * r + 1]; ms0 = tab[e0] * 256 + tokr[2 * r]; ms1 = tab[e1] * 256 + tokr[2 * r + 1]; } }
        const int nrow = (gw < T) ? (T - 1 - gw) / NGW + 1 : 0;
        f32x4 gn[4];
#pragma unroll
        for (int j = 0; j < 4; ++j) gn[j] = ((const f32x4*)(args.in[I_NORM_FINAL]) + lane)[64 * j];
        struct FinIn { u32x2 x[4], y0[4], y1[4]; };
#define FIN_LOAD(I_, i_) do { const int r_ = gw + NGW * (i_); const int s0_ = __builtin_amdgcn_readlane(ms0, (i_)), s1_ = __builtin_amdgcn_readlane(ms1, (i_)); \
            const u32x2* xr_ = (const u32x2*)(X3 + (size_t)r_ * D) + lane; \
            const u32x2* y0_ = (const u32x2*)((s0_ < 65536) ? Y + (size_t)s0_ * D : TP + (size_t)(s0_ - 65536) * D) + lane; \
            const u32x2* y1_ = (const u32x2*)((s1_ < 65536) ? Y + (size_t)s1_ * D : TP + (size_t)(s1_ - 65536) * D) + lane; \
            _Pragma("unroll") for (int j = 0; j < 4; ++j) { I_.x[j] = xr_[64 * j]; I_.y0[j] = y0_[64 * j]; I_.y1[j] = y1_[64 * j]; } } while (0)
#define FIN_ROW(I_, i_) do { const int r_ = gw + NGW * (i_); const int s0_ = __builtin_amdgcn_readlane(ms0, (i_)), s1_ = __builtin_amdgcn_readlane(ms1, (i_)); \
            const float w0_ = __builtin_bit_cast(float, __builtin_amdgcn_readlane(__builtin_bit_cast(int, mw0), (i_))), w1_ = __builtin_bit_cast(float, __builtin_amdgcn_readlane(__builtin_bit_cast(int, mw1), (i_))); \
            f32x4 v[4]; float s = 0.f; \
            _Pragma("unroll") for (int j = 0; j < 4; ++j) { const u32x2 a = I_.x[j], b0 = I_.y0[j], b1 = I_.y1[j]; \
                v[j] = (f32x4){bflo(a.x) + w0_ * bflo(b0.x) + w1_ * bflo(b1.x), bfhi(a.x) + w0_ * bfhi(b0.x) + w1_ * bfhi(b1.x), bflo(a.y) + w0_ * bflo(b0.y) + w1_ * bflo(b1.y), bfhi(a.y) + w0_ * bfhi(b0.y) + w1_ * bfhi(b1.y)}; } \
            _Pragma("unroll 1") for (int kk = 0; kk < 2; ++kk) { const int sl = kk ? s1_ : s0_; const float wk = kk ? w1_ : w0_; \
                if (sl >= 65536) { _Pragma("unroll 1") for (int sp = 1; sp < TAIL_SPLIT; ++sp) { const u32x2* yp = (const u32x2*)(TP + ((size_t)sp * 2048 + (sl - 65536)) * D) + lane; \
                    _Pragma("unroll") for (int j = 0; j < 4; ++j) { const u32x2 a = yp[64 * j]; v[j][0] += wk * bflo(a.x); v[j][1] += wk * bfhi(a.x); v[j][2] += wk * bflo(a.y); v[j][3] += wk * bfhi(a.y); } } } } \
            _Pragma("unroll") for (int j = 0; j < 4; ++j) s += (v[j][0] * v[j][0] + v[j][1] * v[j][1]) + (v[j][2] * v[j][2] + v[j][3] * v[j][3]); \
            const float rs = rstd_of(wave_sum_fast(s)); f32x4* o = (f32x4*)(X + (size_t)r_ * D) + lane; \
            _Pragma("unroll") for (int j = 0; j < 4; ++j) o[64 * j] = v[j] * rs * gn[j]; } while (0)
        FinIn Fa, Fb;
        if (nrow > 0) FIN_LOAD(Fa, 0);
#pragma unroll 1
        for (int i = 0; i < nrow; i += 2) {
            if (i + 1 < nrow) FIN_LOAD(Fb, i + 1);
            __builtin_amdgcn_sched_barrier(0);
            FIN_ROW(Fa, i);
            if (i + 2 < nrow) FIN_LOAD(Fa, i + 2);
            __builtin_amdgcn_sched_barrier(0);
            if (i + 1 < nrow) FIN_ROW(Fb, i + 1);
        }
#undef FIN_LOAD
#undef FIN_ROW
        TS_IDLE(14);
    }
#undef IN
#undef SEAM
#undef lane
#undef tid
#undef ws
}

#ifdef DBG_RWKV
__global__ void __launch_bounds__(NTHR, 2) dbg_naive(Args args) {
    extern __shared__ __attribute__((aligned(16))) unsigned char lds_raw[];
    LAS unsigned char* lds = (LAS unsigned char*)lds_raw; unsigned char* ws = args.ws;
    const int wave = __builtin_amdgcn_readfirstlane(threadIdx.x >> 6);
    rwkv_naive(args, lds, (const bf16_t*)(ws + WS_P1), (const bf16_t*)(ws + 432 * MiB), (const bf16_t*)(ws + 480 * MiB), (const bf16_t*)(ws + 128 * MiB), (const bf16_t*)(ws + 2 * MiB), (bf16_t*)(ws + WS_CAT), blockIdx.x, gridDim.x, wave, lane_now());
}
#endif

#ifndef N_LAUNCH_MODE
#define N_LAUNCH_MODE 1
#endif
extern "C" void kernel_launch(void* const* d_in, const int* in_sizes, int n_in, void* d_out, int out_size, void* d_ws, size_t ws_size, hipStream_t stream) {
    static int grid = 0;
    if (grid == 0) {
        if (n_in != N_IN || in_sizes[0] != T * D || out_size != T * D || ws_size < WS_NEED) {
            fprintf(stderr, "kernel_launch: unexpected shapes/workspace: n_in %d in0 %d out %d ws %zu (need %zu)\n", n_in, n_in > 0 ? in_sizes[0] : -1, out_size, ws_size, (size_t)WS_NEED); grid = -1; return; }
        int dev = 0, cus = 0;
        if (hipGetDevice(&dev) != hipSuccess || hipDeviceGetAttribute(&cus, hipDeviceAttributeMultiprocessorCount, dev) != hipSuccess) { grid = -1; return; }
        bool ok = true;
#define SETATTR(K) ok = ok && (hipFuncSetAttribute((const void*)K, hipFuncAttributeMaxDynamicSharedMemorySize, LDS_BYTES) == hipSuccess)
#if N_LAUNCH_MODE == 1
        SETATTR((fwd<0, N_PHASES>));
#else
        SETATTR((fwd<0, 1>)); SETATTR((fwd<1, 2>)); SETATTR((fwd<2, 3>)); SETATTR((fwd<3, 4>)); SETATTR((fwd<4, 5>)); SETATTR((fwd<5, 6>)); SETATTR((fwd<6, 7>)); SETATTR((fwd<7, 8>));
        SETATTR((fwd<8, 9>)); SETATTR((fwd<9, 10>)); SETATTR((fwd<10, 11>)); SETATTR((fwd<11, 12>)); SETATTR((fwd<12, 13>)); SETATTR((fwd<13, 14>)); SETATTR((fwd<14, 15>));
#endif
        if (!ok) { fprintf(stderr, "kernel_launch: hipFuncSetAttribute failed\n"); grid = -1; return; }
        (void)hipGetLastError();
        grid = cus;
    }
    if (grid < 0) return;
    if (hipMemsetAsync((char*)d_ws + WS_CTL, 0, CTL_BYTES, stream) != hipSuccess) return;
    Args a{};
    for (int i = 0; i < N_IN; ++i) a.in[i] = (const float*)d_in[i];
    a.out = (float*)d_out; a.ws = (unsigned char*)d_ws;
#if N_LAUNCH_MODE == 1
    a.ph_lo = 0; a.ph_hi = N_PHASES; a.pass_lo = 0; a.pass_hi = 3;
    hipLaunchKernelGGL((fwd<0, N_PHASES>), dim3(grid), dim3(NTHR), LDS_BYTES, stream, a);
#else
#define LAUNCH1(P) do { a.ph_lo = (P); a.ph_hi = (P) + 1; hipLaunchKernelGGL((fwd<(P), (P) + 1>), dim3(grid), dim3(NTHR), LDS_BYTES, stream, a); } while (0)
    LAUNCH1(0); LAUNCH1(1); LAUNCH1(2); LAUNCH1(3); LAUNCH1(4); LAUNCH1(5); LAUNCH1(6); LAUNCH1(7);
#ifdef DBG_RWKV
    hipLaunchKernelGGL(dbg_naive, dim3(grid), dim3(NTHR), 4096, stream, a); LAUNCH1(8);
#else
    LAUNCH1(8);
#endif
    LAUNCH1(9); LAUNCH1(10); LAUNCH1(11);
    for (int pass = 0; pass < 5; ++pass) { a.pass_lo = pass; a.pass_hi = pass + 1; LAUNCH1(12); LAUNCH1(13); }
    LAUNCH1(14);
#endif
}
```

```cpp
#include <hip/hip_runtime.h>
#include <cstdio>
#include <cstdint>

#define LAS __attribute__((address_space(3)))
#define GAS __attribute__((address_space(1)))
typedef unsigned short bf16_t;
typedef short bf16x8 __attribute__((ext_vector_type(8)));
typedef short bf16x4 __attribute__((ext_vector_type(4)));
typedef float f32x4 __attribute__((ext_vector_type(4)));
typedef float f32x2 __attribute__((ext_vector_type(2)));
typedef unsigned u32x4 __attribute__((ext_vector_type(4)));
typedef unsigned u32x2 __attribute__((ext_vector_type(2)));

constexpr int NB = 8, SEQ = 4096, T = NB * SEQ, D = 1024, MEML = 256, MROWS = NB * MEML;
constexpr int CS = 768, CM = 256, NH_MEM = 4;
constexpr int S5G = 48, S5J = 16, S5P = 64;
constexpr int RH = 12, RN = 64, SHIFTC = 2560, INB = 2816;
constexpr int FD = 2816, NE = 8, FE = 3584;
constexpr float RMS_EPS = 1e-6f, LNX_EPS = 64e-5f;
constexpr int NWAVES = 8, NTHR = 512;

enum { I_X = 0, I_MEM, I_NORM_MIX, I_NORM_MEM, I_WKV, I_WOUT, I_NORM_FFN, I_NORM_FINAL, I_WINA, I_LAM_RE, I_LAM_IM, I_LOG_DT, I_B_RE, I_B_IM, I_C_RE, I_C_IM,
       I_S5D, I_WGLU, I_BGLU, I_FGATE, I_FUP, I_FDOWN, I_WINB, I_MU, I_W0, I_W2, I_A0, I_A2, I_G2, I_KK, I_KA, I_RK, I_LNXW, I_LNXB, I_WR, I_BR, I_MGATE, I_MUP, I_MDOWN, N_IN };

constexpr size_t MiB = 1u << 20;
constexpr size_t WS_CTL = 0, CTL_BYTES = 2 * MiB;
constexpr size_t WS_HA = 2 * MiB;
constexpr size_t WS_ROUTE = 66 * MiB;
constexpr size_t WS_WOUT1 = 70 * MiB;
constexpr size_t WS_KV = 72 * MiB;
constexpr size_t WS_LORA = 76 * MiB;
constexpr size_t WS_W2T = WS_LORA, WS_A2T = WS_LORA + 96 * 1024, WS_G2T = WS_LORA + 192 * 1024;
constexpr size_t WS_WINA = 78 * MiB, WS_WOUT0 = 80 * MiB, WS_WKV = 82 * MiB  , WS_WGU0 = 84 * MiB  , WS_WD0 = 95 * MiB  ,
                 WS_WINB = 101 * MiB  , WS_MEMN = 107 * MiB  , WS_S5TAB = 115 * MiB  ;
constexpr size_t WS_P0U = 128 * MiB;
constexpr size_t WS_P0Q = 176 * MiB;
constexpr size_t WS_CAT = 192 * MiB;
constexpr size_t WS_ACT0 = 256 * MiB;
constexpr size_t WS_P1 = 256 * MiB;
constexpr size_t WS_RPP = 2 * MiB, WS_RWL = 50 * MiB  , WS_RQP = 128 * MiB, WS_RRP = 432 * MiB, WS_RGA = 480 * MiB, WS_RGB = 78 * MiB, WS_RXL = 52 * MiB  , WS_X3 = 340 * MiB  ;
constexpr size_t WS_WMOE_GU = 256 * MiB;
constexpr size_t WS_WMOE_D = 312 * MiB;
constexpr size_t WS_HA2 = 468 * MiB;
constexpr size_t WS_ROUTE2 = 2 * MiB;
constexpr size_t WS_MACT = 6 * MiB;
constexpr size_t WS_YSLOT = 118 * MiB;
constexpr size_t WS_TAILP = 424 * MiB;
constexpr size_t WS_END = 532 * MiB, WS_NEED = 532 * MiB;
constexpr int CW_BAR = 4096;
constexpr int CW_CNT = 8192;
constexpr size_t CTL_ROWSS = 1 * MiB;
constexpr size_t RT_LIST = 0, RT_LRSTD = 1 * MiB, RT_TOKE = 2 * MiB  , RT_TOKR = 2 * MiB + 256 * 1024, RT_TOKW = 2 * MiB + 512 * 1024;

constexpr int LDS_STAGE = 131072, LDS_BYTES = 147456, LDS_MISC = LDS_BYTES - 1024;

typedef __bf16 bf16v2_t __attribute__((ext_vector_type(2)));
__device__ __forceinline__ unsigned cvt_pk_bf16(float lo, float hi) { const f32x2 v = {lo, hi}; const bf16v2_t b = __builtin_convertvector(v, bf16v2_t); return __builtin_bit_cast(unsigned, b); }
__device__ __forceinline__ float bf2f(unsigned short b) { return __uint_as_float(((unsigned)b) << 16); }
__device__ __forceinline__ float bflo(unsigned w) { return __uint_as_float(w << 16); }
__device__ __forceinline__ float bfhi(unsigned w) { return __uint_as_float(w & 0xffff0000u); }
__device__ __forceinline__ bf16_t f2bf(float f) { return (bf16_t)(cvt_pk_bf16(f, 0.f) & 0xffffu); }
__device__ __forceinline__ float wave_sum(float v) {
#pragma unroll
    for (int o = 1; o < 64; o <<= 1) v += __shfl_xor(v, o);
    return v;
}
__device__ __forceinline__ float wave_sum_fast(float v) {
    v += __builtin_bit_cast(float, __builtin_amdgcn_update_dpp(0, __builtin_bit_cast(int, v), 0xB1, 0xf, 0xf, false));
    v += __builtin_bit_cast(float, __builtin_amdgcn_update_dpp(0, __builtin_bit_cast(int, v), 0x4E, 0xf, 0xf, false));
    v += __builtin_bit_cast(float, __builtin_amdgcn_update_dpp(0, __builtin_bit_cast(int, v), 0x141, 0xf, 0xf, false));
    v += __builtin_bit_cast(float, __builtin_amdgcn_update_dpp(0, __builtin_bit_cast(int, v), 0x140, 0xf, 0xf, false));
    const int vi = __builtin_bit_cast(int, v);
    return (__builtin_bit_cast(float, __builtin_amdgcn_readlane(vi, 0)) + __builtin_bit_cast(float, __builtin_amdgcn_readlane(vi, 16))) + (__builtin_bit_cast(float, __builtin_amdgcn_readlane(vi, 32)) + __builtin_bit_cast(float, __builtin_amdgcn_readlane(vi, 48)));
}
__device__ __forceinline__ void wave_sum8(float (&x)[8]) {
    float y[4];
#pragma unroll
    for (int k = 0; k < 4; ++k) { float a = x[2 * k], b = x[2 * k + 1];
        asm volatile("s_nop 1\n\tv_permlane32_swap_b32 %0, %1\n\ts_nop 1" : "+v"(a), "+v"(b));
        float v = a + b;
        v += __builtin_bit_cast(float, __builtin_amdgcn_update_dpp(0, __builtin_bit_cast(int, v), 0xB1, 0xf, 0xf, false));
        v += __builtin_bit_cast(float, __builtin_amdgcn_update_dpp(0, __builtin_bit_cast(int, v), 0x4E, 0xf, 0xf, false));
        v += __builtin_bit_cast(float, __builtin_amdgcn_update_dpp(0, __builtin_bit_cast(int, v), 0x141, 0xf, 0xf, false));
        v += __builtin_bit_cast(float, __builtin_amdgcn_update_dpp(0, __builtin_bit_cast(int, v), 0x140, 0xf, 0xf, false));
        y[k] = v; }
#pragma unroll
    for (int k = 0; k < 4; ++k) { const int vi = __builtin_bit_cast(int, y[k]);
        x[2 * k] = __builtin_bit_cast(float, __builtin_amdgcn_readlane(vi, 0)) + __builtin_bit_cast(float, __builtin_amdgcn_readlane(vi, 16));
        x[2 * k + 1] = __builtin_bit_cast(float, __builtin_amdgcn_readlane(vi, 32)) + __builtin_bit_cast(float, __builtin_amdgcn_readlane(vi, 48)); }
}
__device__ __forceinline__ float tanh_fast_(float x) { const float e = __expf(2.0f * x); return 1.0f - 2.0f * __builtin_amdgcn_rcpf(1.0f + e); }
__device__ __forceinline__ float sigmoidf_(float x) { return __builtin_amdgcn_rcpf(1.0f + __expf(-x)); }
__device__ __forceinline__ float silu_(float x) { return x * __builtin_amdgcn_rcpf(1.0f + __expf(-x)); }
__device__ __forceinline__ float swiglu_rs_(float g, float u, float c1, float c2) { return (g * u) * c2 * __builtin_amdgcn_rcpf(1.0f + __builtin_amdgcn_exp2f(g * c1)); }
__device__ __forceinline__ float gelu_tanh_(float x) { const float a = 0.7978845608028654f * (x + 0.044715f * x * x * x); return 0.5f * x * (1.0f + tanhf(a)); }
__device__ __forceinline__ u32x2 cvt8_fp8(const f32x4 a, const f32x4 b) {
    const float lim = 448.0f; int w0 = 0, w1 = 0;
    w0 = __builtin_amdgcn_cvt_pk_fp8_f32(__builtin_amdgcn_fmed3f(a[0], -lim, lim), __builtin_amdgcn_fmed3f(a[1], -lim, lim), w0, false);
    w0 = __builtin_amdgcn_cvt_pk_fp8_f32(__builtin_amdgcn_fmed3f(a[2], -lim, lim), __builtin_amdgcn_fmed3f(a[3], -lim, lim), w0, true);
    w1 = __builtin_amdgcn_cvt_pk_fp8_f32(__builtin_amdgcn_fmed3f(b[0], -lim, lim), __builtin_amdgcn_fmed3f(b[1], -lim, lim), w1, false);
    w1 = __builtin_amdgcn_cvt_pk_fp8_f32(__builtin_amdgcn_fmed3f(b[2], -lim, lim), __builtin_amdgcn_fmed3f(b[3], -lim, lim), w1, true);
    return (u32x2){(unsigned)w0, (unsigned)w1};
}
constexpr float F8_X = 16.f, F8_WGU = 256.f, F8_ACT = 16.f, F8_WD = 512.f;
__device__ __forceinline__ int lane_now() { int l; asm volatile("v_mbcnt_lo_u32_b32 %0, -1, 0\n\tv_mbcnt_hi_u32_b32 %0, -1, %0" : "=v"(l)); return l; }
#define LDS_WAIT() asm volatile("s_waitcnt lgkmcnt(0)" ::: "memory")
#define VM_WAIT() asm volatile("s_waitcnt vmcnt(0)" ::: "memory")

#define XB_TMO      128
#define XB_XCNT(j)  (256  + 64 * (j))
#define XB_XSUB(j)  (1280 + 64 * (j))
#define XB_XGEN(j)  (2304 + 64 * (j))
#define XB_TOP      3328
#define XB_TOPGEN   3392
#define XCD_BAR_WORDS 3456
#define XB_SPIN_CAP (1u << 18)
__device__ __forceinline__ unsigned xb_ld(unsigned* p)              { return __hip_atomic_load(p, __ATOMIC_RELAXED, __HIP_MEMORY_SCOPE_AGENT); }
__device__ __forceinline__ unsigned xb_add(unsigned* p, unsigned v) { return __hip_atomic_fetch_add(p, v, __ATOMIC_RELAXED, __HIP_MEMORY_SCOPE_AGENT); }
__device__ __forceinline__ unsigned xb_xcc_id() { return (unsigned)__builtin_amdgcn_s_getreg((3 << 11) | 20) & 0xFu; }
#define XB_SPIN(cond, bar) do { unsigned _sp = 0; while (cond) { __builtin_amdgcn_s_sleep(1); \
    if ((++_sp & 255u) == 0u) { if (xb_ld(&(bar)[XB_TMO])) break; if (_sp > XB_SPIN_CAP) { atomicAdd(&(bar)[XB_TMO], 1u); break; } } } } while (0)
struct XcdBarrier { unsigned* bar; unsigned x; volatile LAS unsigned* st; int wave; };
__device__ __forceinline__ XcdBarrier xcd_barrier_post(unsigned* bar, volatile LAS unsigned* st) {
    XcdBarrier b; b.bar = bar; b.x = xb_xcc_id(); b.st = st; b.wave = __builtin_amdgcn_readfirstlane(threadIdx.x >> 6);
    if (threadIdx.x == 0) (void)xb_add(&bar[XB_XCNT(b.x)], 1u);
    return b;
}
__device__ __forceinline__ void xcd_barrier_complete(unsigned* bar, unsigned x, unsigned& nloc, unsigned& nx) {
    const unsigned G = gridDim.x * gridDim.y * gridDim.z;
    unsigned sum, cnt, mine, sp = 0u;
    for (;;) {
        sum = 0u; cnt = 0u; mine = 0u;
#pragma unroll
        for (unsigned j = 0; j < 16; ++j) { const unsigned c = xb_ld(&bar[XB_XCNT(j)]); sum += c; cnt += (c > 0u) ? 1u : 0u; mine = (j == x) ? c : mine; }
        if (sum == G) break;
        __builtin_amdgcn_s_sleep(1);
        if ((++sp & 255u) == 0u) { if (xb_ld(&bar[XB_TMO])) break; if (sp > XB_SPIN_CAP) { atomicAdd(&bar[XB_TMO], 1u); break; } }
    }
    nloc = mine > 0u ? mine : 1u; nx = cnt > 0u ? cnt : 1u;
}
__device__ __forceinline__ void xcd_barrier(const XcdBarrier& b) {
    asm volatile("s_waitcnt vmcnt(0)" ::: "memory");
    __syncthreads();
    if (b.wave == 0 && lane_now() == 0) {
        unsigned* bar = b.bar;
        __builtin_amdgcn_s_waitcnt(0);
        unsigned nloc = b.st[0], nx = b.st[1];
        if (nloc == 0u) { xcd_barrier_complete(bar, b.x, nloc, nx); b.st[0] = nloc; b.st[1] = nx; }
        const unsigned old = xb_add(&bar[XB_XSUB(b.x)], 1u);
        const unsigned gen = old / nloc;
        if (old + 1u == (gen + 1u) * nloc) {
            __builtin_amdgcn_fence(__ATOMIC_RELEASE, "agent");
            asm volatile("s_waitcnt vmcnt(0)" ::: "memory");
            const unsigned og = xb_add(&bar[XB_TOP], 1u);
            const unsigned tg = og / nx;
            if (og + 1u == (tg + 1u) * nx) xb_add(&bar[XB_TOPGEN], 1u);
            else XB_SPIN(xb_ld(&bar[XB_TOPGEN]) == tg, bar);
            __builtin_amdgcn_fence(__ATOMIC_ACQUIRE, "agent");
            xb_add(&bar[XB_XGEN(b.x)], 1u);
            asm volatile("s_waitcnt vmcnt(0)" ::: "memory");
        } else {
            XB_SPIN(xb_ld(&bar[XB_XGEN(b.x)]) == gen, bar);
            __builtin_amdgcn_fence(__ATOMIC_ACQUIRE, "agent");
            asm volatile("s_waitcnt vmcnt(0)" ::: "memory");
        }
    }
    __syncthreads();
}

namespace pg8 {
constexpr int BM = 256, BK = 64, HALF = 128, HTB = HALF * BK * 2, STAGE_BYTES = 8 * HTB, NXCD = 8, WGM = 4;
__host__ __device__ __forceinline__ int lds_byte(int r, int c) { const int st = (r >> 4) * 2 + (c >> 5), rr = r & 15, cc = c & 31, ob = rr * 64 + cc * 2; return st * 1024 + (ob ^ (((ob >> 9) & 1) << 5)); }
__host__ __device__ __forceinline__ void stage_rc(int b, int& R, int& C) { const int st = b / 1024, sb = b % 1024, swz = sb ^ (((sb >> 9) & 1) << 5); R = (st >> 1) * 16 + swz / 64; C = (st & 1) * 32 + (swz % 64) / 2; }
__host__ __device__ __forceinline__ int perm32(int rho) { const int n = rho >> 4, i = rho & 15; return 8 * (i >> 2) + 4 * n + (i & 3); }

struct Unit { int pm, pn, e, rb; };

struct TileOrder {
    int nM, nN, nwg, G, c;
    __device__ void init(int nM_, int nN_, int G_, int c_) { nM = nM_; nN = nN_; nwg = nM * nN; G = G_; c = c_; }
    __device__ bool tile(int i, int& pm, int& pn) const {
        const long L = (long)i * G + c; if (L >= nwg) return false;
        int wgid = (int)L; { const int q = nwg / NXCD, r = nwg % NXCD, xcd = wgid % NXCD, off = wgid / NXCD; wgid = (xcd < r ? xcd * (q + 1) : r * (q + 1) + (xcd - r) * q) + off; }
        const int nig = WGM * nN, gid = wgid / nig, fm = gid * WGM, gsz = (nM - fm) < WGM ? (nM - fm) : WGM;
        pm = fm + ((wgid % nig) % gsz); pn = (wgid % nig) / gsz; return true;
    }
};
struct DenseSched {
    static constexpr bool GATHER = false;
    TileOrder o; const char* A; const char* Bt; int K;
    __device__ void init(const void* A_, const void* Bt_, int M, int N, int K_, int G, int c) { o.init(M / BM, N / BM, G, c); A = (const char*)A_; Bt = (const char*)Bt_; K = K_; }
    __device__ __forceinline__ bool next(int i, Unit& u) const { u.e = 0; u.rb = 0; return o.tile(i, u.pm, u.pn); }
    __device__ __forceinline__ const char* a_ptr() const { return A; }
    __device__ __forceinline__ const char* b_ptr() const { return Bt; }
    __device__ __forceinline__ unsigned a_base(const Unit& u) const { return (unsigned)u.pm * (unsigned)(BM * K * 2); }
    __device__ __forceinline__ unsigned b_base(const Unit& u) const { return (unsigned)u.pn * (unsigned)(BM * K * 2); }
    __device__ __forceinline__ void gather_ids(const Unit&, int, int, int (&)[4]) const {}
};

struct KvSched {
    static constexpr bool GATHER = false;
    TileOrder o; const char* A; const char* Bt;
    __device__ void init(const void* A_, const void* Bt_, int G, int c) { o.init(2 * MROWS / BM, 512 / BM, G, c); A = (const char*)A_; Bt = (const char*)Bt_; }
    __device__ __forceinline__ bool next(int i, Unit& u) const { u.e = 0; u.rb = 0; return o.tile(i, u.pm, u.pn); }
    __device__ __forceinline__ const char* a_ptr() const { return A; }
    __device__ __forceinline__ const char* b_ptr() const { return Bt; }
    __device__ __forceinline__ unsigned a_base(const Unit& u) const { return (unsigned)u.pm * (unsigned)(BM * D * 2); }
    __device__ __forceinline__ unsigned b_base(const Unit& u) const { return ((unsigned)(u.pm >= MROWS / BM ? 512 : 0) + (unsigned)u.pn * BM) * (unsigned)(D * 2); }
    __device__ __forceinline__ void gather_ids(const Unit&, int, int, int (&)[4]) const {}
};
typedef int i32x8v __attribute__((ext_vector_type(8)));
typedef int i32x4v __attribute__((ext_vector_type(4)));
template <class Epi, class Sched, bool ALIGN_EPI, bool FP8 = false, int VAR = 0>
__device__ __forceinline__ void gemm_phase(LAS unsigned char* lds, const int K, const Sched& S, const Epi& E, const int ldk_ = 0, const int wid_ = -1) {
    int widv_ = (wid_ >= 0) ? wid_ : __builtin_amdgcn_readfirstlane(threadIdx.x >> 6); asm volatile("" : "+s"(widv_));
    const int lane = lane_now(), wid = widv_, tid = wid * 64 + lane, wr = wid >> 2, wc = wid & 3, fr = lane & 15, fq = lane >> 4;
    const int nt = K / BK, LD = ldk_ ? ldk_ : K;
    unsigned voffA[2][2], voffB[2];
#pragma unroll
    for (int i = 0; i < 2; ++i) { int R, C; stage_rc(tid * 16 + i * 8192, R, C); const int Rb = (R & ~31) + perm32(R & 31);
        voffA[0][i] = (unsigned)(R * LD + C) * 2u; voffA[1][i] = (unsigned)((R + HALF) * LD + C) * 2u; voffB[i] = (unsigned)(Rb * LD + C) * 2u; }
    const unsigned kstep = (unsigned)(BK * 2);
    const unsigned hstep = (unsigned)(HALF * LD * 2);
    const __amdgpu_buffer_rsrc_t rsA = __builtin_amdgcn_make_buffer_rsrc((void*)S.a_ptr(), 0, 0x7ffffffc, 0x00020000), rsB = __builtin_amdgcn_make_buffer_rsrc((void*)S.b_ptr(), 0, 0x7ffffffc, 0x00020000);
    const unsigned ldsw = (unsigned)wid * 1024u;
    const int aoff = lds_byte(wr * 64 + fr, fq * 8), boff = lds_byte(wc * 32 + fr, fq * 8);
    LAS unsigned char* pA = lds + aoff; LAS unsigned char* pB = lds + 4 * HTB + boff;
#define PG8_SA(b, h) (((b) * 2 + (h)) * HTB)
#define PG8_SB(b, h) ((4 + (b) * 2 + (h)) * HTB)
#define PG8_SBR(b, h) (((b) * 2 + (h)) * HTB)
#define PG8_STAGE_R(rs, bufoff, gbase, voff) do { if constexpr (VAR != 3 && VAR != 4) _Pragma("unroll") for (int _i = 0; _i < 2; ++_i) \
        __builtin_amdgcn_raw_ptr_buffer_load_lds(rs, (LAS unsigned*)(lds + (bufoff) + ldsw + _i * 8192), 16, (voff)[_i], (gbase), 0, 0); } while (0)
#define PG8_STAGE(bufoff, gbase, voff) PG8_STAGE_R(rsB, bufoff, gbase, voff)
#define PG8_STAGE_A(bufoff, gbase, h) do { if constexpr (Sched::GATHER) { \
        __builtin_amdgcn_raw_ptr_buffer_load_lds(rsA, (LAS unsigned*)(lds + (bufoff) + ldsw), 16, (voffA[h][0] & 0xffffu) * (unsigned)(K * 2) + (cpk & 0xffffu), (gbase), 0, 0); \
        __builtin_amdgcn_raw_ptr_buffer_load_lds(rsA, (LAS unsigned*)(lds + (bufoff) + ldsw + 8192), 16, (voffA[h][0] >> 16) * (unsigned)(K * 2) + (cpk >> 16), (gbase), 0, 0); \
        } else { PG8_STAGE_R(rsA, bufoff, (gbase) + (h) * hstep, voffA[0]); } } while (0)
#define PG8_LD8(ptr_) __builtin_shufflevector(*(const LAS i32x4v*)(ptr_), *(const LAS i32x4v*)((ptr_) + 1024), 0, 1, 2, 3, 4, 5, 6, 7)
#define PG8_LDA(dst, b, h) do { if constexpr (VAR == 4 || VAR == 5) { _Pragma("unroll") for (int m = 0; m < 4; ++m) _Pragma("unroll") for (int k = 0; k < 2; ++k) asm volatile("" : "+v"(dst[m][k])); } else if constexpr (FP8) { _Pragma("unroll") for (int m = 0; m < 4; ++m) dst##8[m] = PG8_LD8(pA + PG8_SA(b, h) + m * 2048); } else { \
        _Pragma("unroll") for (int m = 0; m < 4; ++m) _Pragma("unroll") for (int k = 0; k < 2; ++k) dst[m][k] = *(const LAS bf16x8*)(pA + PG8_SA(b, h) + m * 2048 + k * 1024); } } while (0)
#define PG8_LDB(dst, b, h) do { if constexpr (VAR == 4 || VAR == 5) { _Pragma("unroll") for (int n = 0; n < 2; ++n) _Pragma("unroll") for (int k = 0; k < 2; ++k) asm volatile("" : "+v"(dst[n][k])); } else if constexpr (FP8) { _Pragma("unroll") for (int n = 0; n < 2; ++n) dst##8[n] = PG8_LD8(pB + PG8_SBR(b, h) + n * 2048); } else { \
        _Pragma("unroll") for (int n = 0; n < 2; ++n) _Pragma("unroll") for (int k = 0; k < 2; ++k) dst[n][k] = *(const LAS bf16x8*)(pB + PG8_SBR(b, h) + n * 2048 + k * 1024); } } while (0)
#define PG8_MMA(ai, bj, At, Bt) do { __builtin_amdgcn_s_setprio(1); if constexpr (VAR == 2) { _Pragma("unroll") for (int m = 0; m < 4; ++m) _Pragma("unroll") for (int k = 0; k < 2; ++k) asm volatile("" :: "v"(At[m][k])); _Pragma("unroll") for (int n = 0; n < 2; ++n) _Pragma("unroll") for (int k = 0; k < 2; ++k) asm volatile("" :: "v"(Bt[n][k])); } else if constexpr (FP8) { _Pragma("unroll") for (int m = 0; m < 4; ++m) _Pragma("unroll") for (int n = 0; n < 2; ++n) \
            acc[ai][bj][m][n] = __builtin_amdgcn_mfma_scale_f32_16x16x128_f8f6f4(Bt##8[n], At##8[m], acc[ai][bj][m][n], 0, 0, 0, 0x7f7f7f7f, 0, 0x7f7f7f7f); } else { \
        _Pragma("unroll") for (int m = 0; m < 4; ++m) _Pragma("unroll") for (int n = 0; n < 2; ++n) _Pragma("unroll") for (int k = 0; k < 2; ++k) \
        acc[ai][bj][m][n] = __builtin_amdgcn_mfma_f32_16x16x32_bf16(Bt[n][k], At[m][k], acc[ai][bj][m][n], 0, 0, 0); } __builtin_amdgcn_s_setprio(0); } while (0)
#define PG8_WAIT_V(n) asm volatile("s_waitcnt vmcnt(" #n ")" ::: "memory")
#define PG8_WAIT_L(n) asm volatile("s_waitcnt lgkmcnt(" #n ")" ::: "memory")
#define PG8_BAR __builtin_amdgcn_s_barrier()
#define PG8_SCHED __builtin_amdgcn_sched_barrier(0)
    Unit cur, nxt; int ui = 0;
    if (!S.next(0, cur)) return;
    typename Epi::StashT sv_ = 0; LAS float* const rsl_ = (LAS float*)(lds + STAGE_BYTES);
    unsigned cpk = 0u;
    if constexpr (Sched::GATHER) { int ids[4]; int R0, C0, R1, C1; stage_rc(tid * 16, R0, C0); stage_rc(tid * 16 + 8192, R1, C1); S.gather_ids(cur, R0, R1, ids);
        cpk = (unsigned)(C0 * 2) | ((unsigned)(C1 * 2) << 16);
#pragma unroll
        for (int h = 0; h < 2; ++h) voffA[h][0] = (unsigned)ids[h * 2 + 0] | ((unsigned)ids[h * 2 + 1] << 16); }
    f32x4 acc[2][2][4][2];
#pragma unroll
    for (int a = 0; a < 2; ++a)
#pragma unroll
        for (int b = 0; b < 2; ++b)
#pragma unroll
            for (int m = 0; m < 4; ++m)
#pragma unroll
                for (int n = 0; n < 2; ++n) acc[a][b][m][n] = (f32x4){0.f, 0.f, 0.f, 0.f};
    bf16x8 At[4][2], B0[2][2], B1[2][2]; i32x8v At8[4], B08[2], B18[2];
    if constexpr (VAR == 4 || VAR == 5) {
#pragma unroll
        for (int m = 0; m < 4; ++m)
#pragma unroll
            for (int k = 0; k < 2; ++k)
#pragma unroll
                for (int e = 0; e < 8; ++e) { const unsigned hsh = (unsigned)(lane * 8 + e + 64 * (m * 2 + k)) * 2654435761u; At[m][k][e] = (short)(0x3f00u | ((hsh >> 9) & 0xffu) | ((hsh >> 3) & 0x8000u));
                    if (m < 2) { B0[m][k][e] = (short)(0x3f00u | ((hsh >> 17) & 0xffu) | ((hsh >> 5) & 0x8000u)); B1[m][k][e] = (short)(0x3f00u | ((hsh >> 21) & 0xffu) | ((hsh >> 7) & 0x8000u)); } } }
    unsigned cA = S.a_base(cur), cB = S.b_base(cur);
    PG8_STAGE(PG8_SB(0, 0), cB, voffB); PG8_STAGE(PG8_SB(0, 1), cB + hstep, voffB); PG8_STAGE_A(PG8_SA(0, 0), cA, 0); PG8_STAGE_A(PG8_SA(0, 1), cA, 1);
    if (wr == 1) PG8_BAR;
    PG8_WAIT_V(2); PG8_BAR;
    PG8_STAGE(PG8_SB(1, 0), cB + kstep, voffB); PG8_STAGE_A(PG8_SA(1, 0), cA + kstep, 0); PG8_STAGE(PG8_SB(1, 1), cB + hstep + kstep, voffB);
    PG8_WAIT_V(6); PG8_BAR;
    for (;;) {
        const bool has_next = S.next(ui + 1, nxt);
        const unsigned nA = has_next ? S.a_base(nxt) : cA, nB = has_next ? S.b_base(nxt) : cB;
        int idsN[4] = {0, 0, 0, 0};
#pragma unroll 1
        for (int t = 0; t < nt; t += 2) {
            asm volatile("" : "+v"(pA), "+v"(pB));
            if constexpr (Epi::STASH) { if (t == 2) { const int t2_ = wid * 64 + lane_now(); if (t2_ < 256) sv_ = E.stash_load(cur, t2_); }
                                        else if (t == 4) { const int t2_ = wid * 64 + lane_now(); if (t2_ < 256) E.stash_store(rsl_, t2_, sv_); } }
            const bool last = (t == nt - 2);
            const unsigned a1 = cA + (unsigned)(t + 1) * kstep;
            const unsigned a2 = last ? nA : cA + (unsigned)(t + 2) * kstep, b2 = last ? nB : cB + (unsigned)(t + 2) * kstep;
            const unsigned a3 = a2 + kstep, b3 = b2 + kstep;
            if constexpr (Sched::GATHER) { if (t == nt - 4 && has_next) { int ids[4]; int R0, C0, R1, C1; const int tid2 = wid * 64 + lane_now(); stage_rc(tid2 * 16, R0, C0); stage_rc(tid2 * 16 + 8192, R1, C1); S.gather_ids(nxt, R0, R1, ids);
#pragma unroll
                for (int h = 0; h < 4; ++h) idsN[h] = ids[h]; } }
            PG8_LDB(B0, 0, 0); PG8_LDB(B1, 0, 1); PG8_SCHED; PG8_LDA(At, 0, 0); PG8_STAGE_A(PG8_SA(1, 1), a1, 1);
            if constexpr (Sched::GATHER) { if (last && has_next) { voffA[0][0] = (unsigned)idsN[0] | ((unsigned)idsN[1] << 16); voffA[1][0] = (unsigned)idsN[2] | ((unsigned)idsN[3] << 16); } }
            PG8_WAIT_V(8); PG8_WAIT_L(0); PG8_BAR; PG8_MMA(0, 0, At, B0); PG8_MMA(0, 1, At, B1); PG8_BAR; PG8_SCHED;
            PG8_LDA(At, 0, 1); PG8_STAGE(PG8_SB(0, 0), b2, voffB); PG8_STAGE(PG8_SB(0, 1), b2 + hstep, voffB); PG8_STAGE_A(PG8_SA(0, 0), a2, 0);
            PG8_WAIT_V(8); PG8_WAIT_L(0); PG8_BAR; PG8_MMA(1, 0, At, B0); PG8_MMA(1, 1, At, B1); PG8_BAR; PG8_SCHED;
            PG8_LDB(B0, 1, 0); PG8_LDB(B1, 1, 1); PG8_SCHED; PG8_LDA(At, 1, 0); PG8_STAGE_A(PG8_SA(0, 1), a2, 1);
            PG8_WAIT_V(8); PG8_WAIT_L(0); PG8_BAR; PG8_MMA(0, 0, At, B0); PG8_MMA(0, 1, At, B1); PG8_BAR; PG8_SCHED;
            PG8_LDA(At, 1, 1); PG8_STAGE(PG8_SB(1, 0), b3, voffB); PG8_STAGE(PG8_SB(1, 1), b3 + hstep, voffB); PG8_STAGE_A(PG8_SA(1, 0), a3, 0);
            PG8_WAIT_V(8); PG8_WAIT_L(0); PG8_BAR; PG8_MMA(1, 0, At, B0); PG8_MMA(1, 1, At, B1); PG8_BAR; PG8_SCHED;
        }
        if constexpr (ALIGN_EPI) { if (wr == 0) PG8_BAR; }
        { const int le_ = lane_now(); E(acc, cur, wr, wc, le_ & 15, le_ >> 4, rsl_); }
        if (!has_next) break;
#pragma unroll
        for (int a = 0; a < 2; ++a)
#pragma unroll
            for (int b = 0; b < 2; ++b)
#pragma unroll
                for (int m = 0; m < 4; ++m)
#pragma unroll
                    for (int n = 0; n < 2; ++n) acc[a][b][m][n] = (f32x4){0.f, 0.f, 0.f, 0.f};
        cur = nxt; cA = nA; cB = nB; ++ui;
        if constexpr (ALIGN_EPI) { if (wr == 1) PG8_BAR; }
    }
    PG8_WAIT_V(0);
    if constexpr (!ALIGN_EPI) { if (wr == 0) PG8_BAR; }
    PG8_BAR;
#undef PG8_SA
#undef PG8_SB
#undef PG8_SBR
#undef PG8_STAGE
#undef PG8_STAGE_R
#undef PG8_STAGE_A
#undef PG8_LDA
#undef PG8_LD8
#undef PG8_LDB
#undef PG8_MMA
#undef PG8_WAIT_V
#undef PG8_WAIT_L
#undef PG8_BAR
#undef PG8_SCHED
}
}
using pg8::Unit;

__device__ __forceinline__ float rstd_of(float ss) { return 1.0f / sqrtf(ss * (1.0f / D) + RMS_EPS); }
typedef unsigned long long rss_t;
__device__ __forceinline__ float rstd_fx(rss_t s) { return rstd_of((float)((double)s * (1.0 / 16777216.0))); }
__device__ __forceinline__ rss_t rss_fx(float ss) { return (rss_t)__float2ull_rn(ss * 16777216.0f); }

struct EpiInA {
    static constexpr bool STASH = true;
    typedef rss_t StashT;
    __device__ __forceinline__ void stash_store(LAS float* rsl, int lrow, rss_t v) const { rsl[lrow] = rstd_fx(v); }
    __device__ __forceinline__ rss_t stash_load(const Unit& u, int lrow) const { return rowss[u.pm * 256 + lrow]; }
    bf16_t* U; bf16_t* Q; const rss_t* rowss;
    __device__ __forceinline__ void operator()(const f32x4 (&acc)[2][2][4][2], const Unit& u, int wr, int wc, int fr, int fq, const LAS float* rsl) const {
        const int row0 = u.pm * 256 + wr * 64 + fr, col0 = u.pn * 256 + wc * 32 + 8 * fq;
        float rsq[8];
#pragma unroll
        for (int i = 0; i < 8; ++i) rsq[i] = rsl[wr * 64 + fr + (i >> 2) * 128 + (i & 3) * 16];
#pragma unroll
        for (int ai = 0; ai < 2; ++ai)
#pragma unroll
            for (int m = 0; m < 4; ++m) { const int row = row0 + ai * 128 + m * 16; const float rs = rsq[ai * 4 + m];
#pragma unroll
                for (int bj = 0; bj < 2; ++bj) { const int c = col0 + bj * 128; const f32x4 v0 = acc[ai][bj][m][0] * rs, v1 = acc[ai][bj][m][1] * rs;
                    u32x4 w; w.x = cvt_pk_bf16(v0[0], v0[1]); w.y = cvt_pk_bf16(v0[2], v0[3]); w.z = cvt_pk_bf16(v1[0], v1[1]); w.w = cvt_pk_bf16(v1[2], v1[3]);
                    if (c < CS) { const int g = c >> 4, hf = (c >> 3) & 1, b = row >> 12, t = row & 4095; *(u32x4*)(U + (((size_t)(b * S5G + g) * SEQ + t) * 16 + 8 * hf)) = w; }
                    else *(u32x4*)(Q + (size_t)row * CM + (c - CS)) = w; } }
    }
};
struct EpiBf16 {
    static constexpr bool STASH = true;
    typedef rss_t StashT;
    __device__ __forceinline__ void stash_store(LAS float* rsl, int lrow, rss_t v) const { rsl[lrow] = rowss ? rstd_fx(v) : 1.0f; }
    __device__ __forceinline__ rss_t stash_load(const Unit& u, int lrow) const { return rowss ? rowss[u.pm * 256 + lrow] : (rss_t)0; }
    bf16_t* O; int ldc; const rss_t* rowss; bf16_t* Q; int qcol0;
    __device__ __forceinline__ void operator()(const f32x4 (&acc)[2][2][4][2], const Unit& u, int wr, int wc, int fr, int fq, const LAS float* rsl) const {
        const int row0 = u.pm * 256 + wr * 64 + fr, col0 = u.pn * 256 + wc * 32 + 8 * fq;
        float rsv8[8];
#pragma unroll
        for (int i = 0; i < 8; ++i) rsv8[i] = rsl[wr * 64 + fr + (i >> 2) * 128 + (i & 3) * 16];
#pragma unroll
        for (int ai = 0; ai < 2; ++ai)
#pragma unroll
            for (int m = 0; m < 4; ++m) { const int row = row0 + ai * 128 + m * 16; const float rs = rsv8[ai * 4 + m];
#pragma unroll
                for (int bj = 0; bj < 2; ++bj) { const int c = col0 + bj * 128; const f32x4 v0 = acc[ai][bj][m][0] * rs, v1 = acc[ai][bj][m][1] * rs;
                    u32x4 w; w.x = cvt_pk_bf16(v0[0], v0[1]); w.y = cvt_pk_bf16(v0[2], v0[3]); w.z = cvt_pk_bf16(v1[0], v1[1]); w.w = cvt_pk_bf16(v1[2], v1[3]);
                    if (Q && c >= qcol0) *(u32x4*)(Q + (size_t)row * CM + (c - qcol0)) = w;
                    else *(u32x4*)(O + (size_t)row * ldc + c) = w; } }
    }
};
struct EpiRes {
    static constexpr bool STASH = false; typedef float StashT;
    const float* XinF; const bf16_t* XinB; bf16_t* H; rss_t* rowss; unsigned char* H8;
    __device__ __forceinline__ void operator()(const f32x4 (&acc)[2][2][4][2], const Unit& u, int wr, int wc, int fr, int fq, const LAS float* rsl) const {
        const int row0 = u.pm * 256 + wr * 64 + fr, col0 = u.pn * 256 + wc * 32 + 8 * fq;
#pragma unroll
        for (int ai = 0; ai < 2; ++ai) {
            f32x4 xv[4][2][2];
            if (XinF) {
#pragma unroll
                for (int m = 0; m < 4; ++m)
#pragma unroll
                    for (int bj = 0; bj < 2; ++bj) { const size_t o = (size_t)(row0 + ai * 128 + m * 16) * D + col0 + bj * 128; xv[m][bj][0] = *(const f32x4*)(XinF + o); xv[m][bj][1] = *(const f32x4*)(XinF + o + 4); }
            } else { u32x4 xb[4][2];
#pragma unroll
                for (int m = 0; m < 4; ++m)
#pragma unroll
                    for (int bj = 0; bj < 2; ++bj) xb[m][bj] = *(const u32x4*)(XinB + (size_t)(row0 + ai * 128 + m * 16) * D + col0 + bj * 128);
#pragma unroll
                for (int m = 0; m < 4; ++m)
#pragma unroll
                    for (int bj = 0; bj < 2; ++bj) { const u32x4 w = xb[m][bj]; xv[m][bj][0] = (f32x4){bflo(w.x), bfhi(w.x), bflo(w.y), bfhi(w.y)}; xv[m][bj][1] = (f32x4){bflo(w.z), bfhi(w.z), bflo(w.w), bfhi(w.w)}; } }
            __builtin_amdgcn_sched_barrier(0);
            float ss4[4];
#pragma unroll
            for (int m = 0; m < 4; ++m) { const int row = row0 + ai * 128 + m * 16; float ss = 0.f;
#pragma unroll
                for (int bj = 0; bj < 2; ++bj) { const size_t o = (size_t)row * D + col0 + bj * 128;
                    const f32x4 s0 = acc[ai][bj][m][0] + xv[m][bj][0], s1 = acc[ai][bj][m][1] + xv[m][bj][1];
                    u32x4 w; w.x = cvt_pk_bf16(s0[0], s0[1]); w.y = cvt_pk_bf16(s0[2], s0[3]); w.z = cvt_pk_bf16(s1[0], s1[1]); w.w = cvt_pk_bf16(s1[2], s1[3]);
                    *(u32x4*)(H + o) = w;
                    const f32x4 v0 = {bflo(w.x), bfhi(w.x), bflo(w.y), bfhi(w.y)}, v1 = {bflo(w.z), bfhi(w.z), bflo(w.w), bfhi(w.w)};
                    if (H8) *(u32x2*)(H8 + o) = cvt8_fp8(v0 * F8_X, v1 * F8_X);
                    ss += (v0[0] * v0[0] + v0[1] * v0[1]) + (v0[2] * v0[2] + v0[3] * v0[3]) + (v1[0] * v1[0] + v1[1] * v1[1]) + (v1[2] * v1[2] + v1[3] * v1[3]); }
                ss4[m] = ss; }
#pragma unroll
            for (int m = 0; m < 4; ++m) { float ss = ss4[m]; ss += __shfl_xor(ss, 16); ss += __shfl_xor(ss, 32);
                if (fq == 0) atomicAdd(rowss + row0 + ai * 128 + m * 16, rss_fx(ss)); }
            __builtin_amdgcn_sched_barrier(0); }
    }
};
struct EpiSwiglu {
    static constexpr bool STASH = true;
    typedef rss_t StashT;
    __device__ __forceinline__ void stash_store(LAS float* rsl, int lrow, rss_t raw) const { const float v = rsv ? __uint_as_float((unsigned)raw) : rstd_fx(raw); rsl[lrow] = v * -1.4426950408889634f; rsl[256 + lrow] = v * v; }
    __device__ __forceinline__ rss_t stash_load(const Unit& u, int lrow) const { return rsv ? (rss_t)__float_as_uint(rsv[u.rb + lrow]) : rowss[u.pm * 256 + lrow]; }
    bf16_t* O; int ldo; const rss_t* rowss; const float* rsv; int skip;
    __device__ __forceinline__ void operator()(const f32x4 (&acc)[2][2][4][2], const Unit& u, int wr, int wc, int fr, int fq, const LAS float* rsl) const {
        if (skip) return;
        const int lrow0 = wr * 64 + fr, col0 = u.pn * 128 + wc * 32 + 8 * fq;
        float c18[8], c28[8];
#pragma unroll
        for (int i = 0; i < 8; ++i) { const int lrow = lrow0 + (i >> 2) * 128 + (i & 3) * 16; c18[i] = rsl[lrow]; c28[i] = rsl[256 + lrow]; }
#pragma unroll
        for (int ai = 0; ai < 2; ++ai)
#pragma unroll
            for (int m = 0; m < 4; ++m) { const int lrow = lrow0 + ai * 128 + m * 16;
                const float c1 = c18[ai * 4 + m], c2 = c28[ai * 4 + m]; const size_t orow = rsv ? ((size_t)u.e + lrow) : (size_t)(u.pm * 256 + lrow);
                const f32x4 g0 = acc[ai][0][m][0], g1 = acc[ai][0][m][1], u0 = acc[ai][1][m][0], u1 = acc[ai][1][m][1];
                u32x4 w; w.x = cvt_pk_bf16(swiglu_rs_(g0[0], u0[0], c1, c2), swiglu_rs_(g0[1], u0[1], c1, c2)); w.y = cvt_pk_bf16(swiglu_rs_(g0[2], u0[2], c1, c2), swiglu_rs_(g0[3], u0[3], c1, c2));
                w.z = cvt_pk_bf16(swiglu_rs_(g1[0], u1[0], c1, c2), swiglu_rs_(g1[1], u1[1], c1, c2)); w.w = cvt_pk_bf16(swiglu_rs_(g1[2], u1[2], c1, c2), swiglu_rs_(g1[3], u1[3], c1, c2));
                if (skip == 3) { w.x = cvt_pk_bf16(g0[0] * u0[0], g0[1] * u0[1]); w.y = cvt_pk_bf16(g0[2] * u0[2], g0[3] * u0[3]); w.z = cvt_pk_bf16(g1[0] * u1[0], g1[1] * u1[1]); w.w = cvt_pk_bf16(g1[2] * u1[2], g1[3] * u1[3]); }
                if (skip == 2) asm volatile("" :: "v"(w)); else if (skip == 4) *(u32x4*)(O + ((size_t)blockIdx.x * 256 + lrow) * 128 + (col0 & 127)) = w; else
                *(u32x4*)(O + orow * ldo + col0) = w; }
    }
};
struct EpiSwigluF8 {
    static constexpr bool STASH = true;
    typedef float StashT;
    __device__ __forceinline__ void stash_store(LAS float* rsl, int lrow, float raw) const { const float v = raw * (1.0f / (F8_X * F8_WGU)); rsl[lrow] = v * -1.4426950408889634f; rsl[256 + lrow] = v * v * F8_ACT; }
    __device__ __forceinline__ float stash_load(const Unit& u, int lrow) const { return rsv[u.rb + lrow]; }
    unsigned char* O8; int ldo; const float* rsv;
    __device__ __forceinline__ void operator()(const f32x4 (&acc)[2][2][4][2], const Unit& u, int wr, int wc, int fr, int fq, const LAS float* rsl) const {
        const int lrow0 = wr * 64 + fr, col0 = u.pn * 128 + wc * 32 + 8 * fq;
        float c1n = rsl[lrow0], c2n = rsl[256 + lrow0];
#pragma unroll
        for (int ai = 0; ai < 2; ++ai)
#pragma unroll
            for (int m = 0; m < 4; ++m) { const int lrow = lrow0 + ai * 128 + m * 16; const float c1 = c1n, c2 = c2n;
                if (ai * 4 + m < 7) { const int ln_ = lrow0 + ((ai * 4 + m + 1) >> 2) * 128 + ((ai * 4 + m + 1) & 3) * 16; c1n = rsl[ln_]; c2n = rsl[256 + ln_]; }
                f32x4 a0, a1;
#pragma unroll
                for (int e = 0; e < 4; ++e) { a0[e] = swiglu_rs_(acc[ai][0][m][0][e], acc[ai][1][m][0][e], c1, c2); a1[e] = swiglu_rs_(acc[ai][0][m][1][e], acc[ai][1][m][1][e], c1, c2); }
                *(u32x2*)(O8 + ((size_t)u.e + lrow) * ldo + col0) = cvt8_fp8(a0, a1);
                asm volatile("" ::: "memory"); }
    }
};
struct EpiSlot {
    static constexpr bool STASH = false; typedef float StashT;
    bf16_t* O;
    __device__ __forceinline__ void operator()(const f32x4 (&acc)[2][2][4][2], const Unit& u, int wr, int wc, int fr, int fq, const LAS float* rsl) const {
        const int lrow0 = wr * 64 + fr, col0 = u.pn * 256 + wc * 32 + 8 * fq;
#pragma unroll
        for (int ai = 0; ai < 2; ++ai)
#pragma unroll
            for (int m = 0; m < 4; ++m) { const size_t orow = (size_t)u.e + lrow0 + ai * 128 + m * 16;
#pragma unroll
                for (int bj = 0; bj < 2; ++bj) { const float sc = 1.0f / (F8_ACT * F8_WD); const f32x4 v0 = acc[ai][bj][m][0] * sc, v1 = acc[ai][bj][m][1] * sc;
                    u32x4 w; w.x = cvt_pk_bf16(v0[0], v0[1]); w.y = cvt_pk_bf16(v0[2], v0[3]); w.z = cvt_pk_bf16(v1[0], v1[1]); w.w = cvt_pk_bf16(v1[2], v1[3]);
                    *(u32x4*)(O + orow * D + col0 + bj * 128) = w; } }
    }
};

struct MoeGuSched {
    static constexpr bool GATHER = true;
    pg8::TileOrder o; const char* A; const char* W; const int* list; const LAS int* tab; int tile0;
    __device__ __forceinline__ bool next(int i, Unit& u) const {
        if (!o.tile(i, u.pm, u.pn)) return false;
        const int gt = tile0 + u.pm; int e = 0;
#pragma unroll
        for (int k = 1; k < 8; ++k) e += (gt >= tab[k]) ? 1 : 0;
        e = __builtin_amdgcn_readfirstlane(e);
        u.rb = __builtin_amdgcn_readfirstlane(e * 32768 + (gt - tab[e]) * 256); u.e = u.pm * 256; return true;
    }
    __device__ __forceinline__ const char* a_ptr() const { return A; }
    __device__ __forceinline__ const char* b_ptr() const { return W; }
    __device__ __forceinline__ unsigned a_base(const Unit&) const { return 0u; }
    __device__ __forceinline__ unsigned b_base(const Unit& u) const { return ((unsigned)(u.rb >> 15) * (2 * FE) + (unsigned)u.pn * 256) * (unsigned)D; }
    __device__ __forceinline__ void gather_ids(const Unit& u, int R0, int R1, int (&ids)[4]) const {
        const int e = u.rb >> 15, rank0 = u.rb & 32767, cnt = __builtin_amdgcn_readfirstlane(tab[16 + e]);
        const int lim = cnt - 1 - rank0;
#pragma unroll
        for (int h = 0; h < 2; ++h) { const int r0 = R0 + 128 * h, r1 = R1 + 128 * h;
            ids[h * 2 + 0] = list[u.rb + (r0 < lim ? r0 : lim)]; ids[h * 2 + 1] = list[u.rb + (r1 < lim ? r1 : lim)]; }
    }
};
struct MoeDownSched {
    static constexpr bool GATHER = false;
    pg8::TileOrder o; const char* A; const char* W; const LAS int* tab; int tile0;
    __device__ __forceinline__ bool next(int i, Unit& u) const {
        if (!o.tile(i, u.pm, u.pn)) return false;
        const int gt = tile0 + u.pm; int e = 0;
#pragma unroll
        for (int k = 1; k < 8; ++k) e += (gt >= tab[k]) ? 1 : 0;
        u.rb = __builtin_amdgcn_readfirstlane(e); u.e = gt * 256; return true;
    }
    __device__ __forceinline__ const char* a_ptr() const { return A; }
    __device__ __forceinline__ const char* b_ptr() const { return W; }
    __device__ __forceinline__ unsigned a_base(const Unit& u) const { return (unsigned)u.pm * (unsigned)(256 * FE); }
    __device__ __forceinline__ unsigned b_base(const Unit& u) const { return ((unsigned)u.rb * D + (unsigned)u.pn * 256) * (unsigned)FE; }
    __device__ __forceinline__ void gather_ids(const Unit&, int, int, int (&)[4]) const {}
};

constexpr int TAIL_SPLIT = 7, TAIL_K = FE / TAIL_SPLIT;
struct MoeDownTailSched {
    static constexpr bool GATHER = false;
    pg8::TileOrder o; const char* A; const char* W; const LAS int* tab; int tile0;
    __device__ __forceinline__ bool next(int i, Unit& u) const {
        int cn; if (!o.tile(i, u.pm, cn)) return false;
        const int gt = tile0 + u.pm; int e = 0;
#pragma unroll
        for (int k = 1; k < 8; ++k) e += (gt >= tab[k]) ? 1 : 0;
        u.pn = cn & 3; u.rb = __builtin_amdgcn_readfirstlane(e) * 8 + (cn >> 2); u.e = u.pm * 256; return true;
    }
    __device__ __forceinline__ const char* a_ptr() const { return A; }
    __device__ __forceinline__ const char* b_ptr() const { return W; }
    __device__ __forceinline__ unsigned a_base(const Unit& u) const { return (unsigned)u.pm * (unsigned)(256 * FE) + (unsigned)(u.rb & 7) * TAIL_K; }
    __device__ __forceinline__ unsigned b_base(const Unit& u) const { return ((unsigned)(u.rb >> 3) * D + (unsigned)u.pn * 256) * (unsigned)FE + (unsigned)(u.rb & 7) * TAIL_K; }
    __device__ __forceinline__ void gather_ids(const Unit&, int, int, int (&)[4]) const {}
};
struct EpiSlotPart {
    static constexpr bool STASH = false; typedef float StashT;
    bf16_t* P;
    __device__ __forceinline__ void operator()(const f32x4 (&acc)[2][2][4][2], const Unit& u, int wr, int wc, int fr, int fq, const LAS float* rsl) const {
        const int lrow0 = wr * 64 + fr, col0 = u.pn * 256 + wc * 32 + 8 * fq; bf16_t* base = P + (size_t)(u.rb & 7) * 2048 * D;
#pragma unroll
        for (int ai = 0; ai < 2; ++ai)
#pragma unroll
            for (int m = 0; m < 4; ++m) { const size_t orow = (size_t)u.e + lrow0 + ai * 128 + m * 16;
#pragma unroll
                for (int bj = 0; bj < 2; ++bj) { const float sc = 1.0f / (F8_ACT * F8_WD); const f32x4 v0 = acc[ai][bj][m][0] * sc, v1 = acc[ai][bj][m][1] * sc;
                    u32x4 w; w.x = cvt_pk_bf16(v0[0], v0[1]); w.y = cvt_pk_bf16(v0[2], v0[3]); w.z = cvt_pk_bf16(v1[0], v1[1]); w.w = cvt_pk_bf16(v1[2], v1[3]);
                    *(u32x4*)(base + orow * D + col0 + bj * 128) = w; } }
    }
};

__device__ __forceinline__ void tr_item(const float* W, int K, int N, bf16_t* WT, const float* gain, int mode, LAS float* scr, int item, int lane, float f8s = 0.f) {
    const int nblk = N / 32, kb = item / nblk, nb = item % nblk, k0 = 64 * kb, n0 = 32 * nb;
    {
        const int r8 = lane >> 3, c4 = (lane & 7) * 4; f32x4 v[8]; float gn[8];
#pragma unroll
        for (int i = 0; i < 8; ++i) { v[i] = *(const f32x4*)(W + (size_t)(k0 + 8 * i + r8) * N + n0 + c4); gn[i] = gain ? gain[k0 + 8 * i + r8] : 1.0f; }
#pragma unroll
        for (int i = 0; i < 8; ++i) { LAS float* d = scr + (8 * i + r8) * 33 + c4; d[0] = v[i][0] * gn[i]; d[1] = v[i][1] * gn[i]; d[2] = v[i][2] * gn[i]; d[3] = v[i][3] * gn[i]; } }
    LDS_WAIT(); asm volatile("" ::: "memory");
    const int c = lane & 7;
#pragma unroll
    for (int j = 0; j < 4; ++j) { const int n = (lane >> 3) + 8 * j; const LAS float* s = scr + (8 * c) * 33 + n;
        u32x4 o; o.x = cvt_pk_bf16(s[0 * 33], s[1 * 33]); o.y = cvt_pk_bf16(s[2 * 33], s[3 * 33]); o.z = cvt_pk_bf16(s[4 * 33], s[5 * 33]); o.w = cvt_pk_bf16(s[6 * 33], s[7 * 33]);
        const int nn = n0 + n; const int row = (mode == 0) ? nn : (((nn >> 7) << 8) + (nn & 127) + (mode == 2 ? 128 : 0));
        if (f8s != 0.f) { const f32x4 a = {s[0 * 33] * f8s, s[1 * 33] * f8s, s[2 * 33] * f8s, s[3 * 33] * f8s}, b = {s[4 * 33] * f8s, s[5 * 33] * f8s, s[6 * 33] * f8s, s[7 * 33] * f8s};
            *(u32x2*)((unsigned char*)WT + (size_t)row * K + k0 + 8 * c) = cvt8_fp8(a, b); }
        else *(u32x4*)(WT + (size_t)row * K + k0 + 8 * c) = o; }
    LDS_WAIT(); asm volatile("" ::: "memory");
}
struct TrJob { const float* W; bf16_t* WT; const float* gain; int K, N, mode, items; float f8s; };
struct TrRegs { f32x4 v[8]; float gn[8]; };
__device__ __forceinline__ void tr_load(const TrJob& jb, int item, int lane, TrRegs& R) {
    const int nblk = jb.N / 32, kb = item / nblk, nb = item % nblk, k0 = 64 * kb, n0 = 32 * nb, r8 = lane >> 3, c4 = (lane & 7) * 4;
#pragma unroll
    for (int i = 0; i < 8; ++i) { R.v[i] = *(const f32x4*)(jb.W + (size_t)(k0 + 8 * i + r8) * jb.N + n0 + c4); R.gn[i] = jb.gain ? jb.gain[k0 + 8 * i + r8] : 1.0f; }
}
__device__ __forceinline__ void tr_fin(const TrJob& jb, int item, LAS float* scr, int lane, const TrRegs& R) {
    const int nblk = jb.N / 32, kb = item / nblk, nb = item % nblk, k0 = 64 * kb, n0 = 32 * nb, r8 = lane >> 3, c4 = (lane & 7) * 4;
#pragma unroll
    for (int i = 0; i < 8; ++i) { LAS float* d = scr + (8 * i + r8) * 33 + c4; d[0] = R.v[i][0] * R.gn[i]; d[1] = R.v[i][1] * R.gn[i]; d[2] = R.v[i][2] * R.gn[i]; d[3] = R.v[i][3] * R.gn[i]; }
    LDS_WAIT(); asm volatile("" ::: "memory");
    const int c = lane & 7;
#pragma unroll
    for (int j = 0; j < 4; ++j) { const int n = (lane >> 3) + 8 * j; const LAS float* s = scr + (8 * c) * 33 + n;
        const int nn = n0 + n; const int row = (jb.mode == 0) ? nn : (((nn >> 7) << 8) + (nn & 127) + (jb.mode == 2 ? 128 : 0));
        const float f8s = jb.f8s; const f32x4 a = {s[0 * 33] * f8s, s[1 * 33] * f8s, s[2 * 33] * f8s, s[3 * 33] * f8s}, b = {s[4 * 33] * f8s, s[5 * 33] * f8s, s[6 * 33] * f8s, s[7 * 33] * f8s};
        *(u32x2*)((unsigned char*)jb.WT + (size_t)row * jb.K + k0 + 8 * c) = cvt8_fp8(a, b); }
    LDS_WAIT(); asm volatile("" ::: "memory");
}


struct Args { const float* in[N_IN]; float* out; unsigned char* ws; int ph_lo, ph_hi, pass_lo, pass_hi; };

__device__ __forceinline__ void attn_naive(LAS unsigned char* lds, const bf16_t* Q, const bf16_t* KV, bf16_t* CAT, int bx, int G, int tid) {
    LAS float* Ks = (LAS float*)lds; LAS float* Vs = Ks + 256 * 64;
    for (int item = bx; item < NB * NH_MEM * 8; item += G) {
        const int b = item >> 5, h = (item >> 3) & 3, qb = item & 7;
#pragma unroll 4
        for (int i = 0; i < 32; ++i) { const int idx = tid + 512 * i, m = idx >> 6, d = idx & 63;
            const bf16_t* kr = KV + (size_t)(b * MEML + m) * 512 + h * 64 + d;
            Ks[idx] = bf2f(kr[0]); Vs[idx] = bf2f(kr[256]); }
        __syncthreads();
        const int row = b * SEQ + qb * 512 + tid;
        float q[64], o[64];
        { const u32x4* qp = (const u32x4*)(Q + (size_t)row * CM + h * 64);
#pragma unroll
          for (int i = 0; i < 8; ++i) { const u32x4 w = qp[i];
              q[8 * i + 0] = bflo(w.x) * 0.125f; q[8 * i + 1] = bfhi(w.x) * 0.125f; q[8 * i + 2] = bflo(w.y) * 0.125f; q[8 * i + 3] = bfhi(w.y) * 0.125f;
              q[8 * i + 4] = bflo(w.z) * 0.125f; q[8 * i + 5] = bfhi(w.z) * 0.125f; q[8 * i + 6] = bflo(w.w) * 0.125f; q[8 * i + 7] = bfhi(w.w) * 0.125f; } }
#pragma unroll
        for (int d = 0; d < 64; ++d) o[d] = 0.f;
        float mx = -1e30f, l = 0.f;
#pragma unroll 1
        for (int key = 0; key < MEML; ++key) {
            const LAS f32x4* kr = (const LAS f32x4*)(Ks + key * 64); float sc = 0.f;
#pragma unroll
            for (int d4 = 0; d4 < 16; ++d4) { const f32x4 kv = kr[d4]; sc += q[4 * d4] * kv[0] + q[4 * d4 + 1] * kv[1] + q[4 * d4 + 2] * kv[2] + q[4 * d4 + 3] * kv[3]; }
            const float mn = fmaxf(mx, sc), alpha = __expf(mx - mn), p = __expf(sc - mn); mx = mn; l = l * alpha + p;
            const LAS f32x4* vr = (const LAS f32x4*)(Vs + key * 64);
#pragma unroll
            for (int d4 = 0; d4 < 16; ++d4) { const f32x4 vv = vr[d4]; o[4 * d4] = o[4 * d4] * alpha + p * vv[0]; o[4 * d4 + 1] = o[4 * d4 + 1] * alpha + p * vv[1]; o[4 * d4 + 2] = o[4 * d4 + 2] * alpha + p * vv[2]; o[4 * d4 + 3] = o[4 * d4 + 3] * alpha + p * vv[3]; }
        }
        const float il = 1.0f / l;
        u32x4* op = (u32x4*)(CAT + (size_t)row * D + CS + h * 64);
#pragma unroll
        for (int i = 0; i < 8; ++i) { u32x4 w; w.x = cvt_pk_bf16(o[8 * i] * il, o[8 * i + 1] * il); w.y = cvt_pk_bf16(o[8 * i + 2] * il, o[8 * i + 3] * il);
            w.z = cvt_pk_bf16(o[8 * i + 4] * il, o[8 * i + 5] * il); w.w = cvt_pk_bf16(o[8 * i + 6] * il, o[8 * i + 7] * il); op[i] = w; }
        __syncthreads();
    }
}

__device__ __forceinline__ void s5_naive(const Args& a, LAS unsigned char* lds, const bf16_t* U, bf16_t* CAT, int bx, int G, int wave, int lane) {
    LAS float* xs = (LAS float*)(lds + wave * 1024);
    for (int it = bx + G * wave; it < NB * S5G; it += G * NWAVES) {
        const int b = it / S5G, g = it % S5G, p = lane;
        const double dt = exp((double)a.in[I_LOG_DT][g]), lr = a.in[I_LAM_RE][g * S5P + p], li = a.in[I_LAM_IM][g * S5P + p];
        const double mag = exp(lr * dt), ang = li * dt, abr_d = mag * cos(ang), abi_d = mag * sin(ang);
        const double nre = abr_d - 1.0, nim = abi_d, den = lr * lr + li * li, zr = (nre * lr + nim * li) / den, zi = (nim * lr - nre * li) / den;
        const float abr = (float)abr_d, abi = (float)abi_d;
        float bbr[16], bbi[16], cre[16], cim[16], wg[16];
#pragma unroll
        for (int j = 0; j < 16; ++j) { const double br = a.in[I_B_RE][(size_t)(g * S5P + p) * 16 + j], bi = a.in[I_B_IM][(size_t)(g * S5P + p) * 16 + j]; bbr[j] = (float)(zr * br - zi * bi); bbi[j] = (float)(zr * bi + zi * br); }
        const int jj = lane & 15, pq = lane >> 4;
#pragma unroll
        for (int q = 0; q < 16; ++q) { cre[q] = a.in[I_C_RE][(size_t)(g * 16 + jj) * S5P + 16 * pq + q]; cim[q] = a.in[I_C_IM][(size_t)(g * 16 + jj) * S5P + 16 * pq + q]; }
#pragma unroll
        for (int j = 0; j < 16; ++j) wg[j] = a.in[I_WGLU][(size_t)(g * 16 + j) * 16 + jj];
        const float dj = a.in[I_S5D][g * 16 + jj], bg = a.in[I_BGLU][g * 16 + jj];
        const bf16_t* up = U + (size_t)(b * S5G + g) * SEQ * 16;
        float xr = 0.f, xi = 0.f;
#pragma unroll 1
        for (int t = 0; t < SEQ; ++t) {
            const u32x4 w0 = *(const u32x4*)(up + (size_t)t * 16), w1 = *(const u32x4*)(up + (size_t)t * 16 + 8);
            float uf[16];
            uf[0] = bflo(w0.x); uf[1] = bfhi(w0.x); uf[2] = bflo(w0.y); uf[3] = bfhi(w0.y); uf[4] = bflo(w0.z); uf[5] = bfhi(w0.z); uf[6] = bflo(w0.w); uf[7] = bfhi(w0.w);
            uf[8] = bflo(w1.x); uf[9] = bfhi(w1.x); uf[10] = bflo(w1.y); uf[11] = bfhi(w1.y); uf[12] = bflo(w1.z); uf[13] = bfhi(w1.z); uf[14] = bflo(w1.w); uf[15] = bfhi(w1.w);
            const float uj = bf2f(up[(size_t)t * 16 + jj]);
            float bur = 0.f, bui = 0.f;
#pragma unroll
            for (int j = 0; j < 16; ++j) { bur += bbr[j] * uf[j]; bui += bbi[j] * uf[j]; }
            const float nxr = abr * xr - abi * xi + bur, nxi = abr * xi + abi * xr + bui; xr = nxr; xi = nxi;
            xs[p] = xr; xs[64 + p] = xi;
            LDS_WAIT(); asm volatile("" ::: "memory");
            float s = 0.f;
#pragma unroll
            for (int q4 = 0; q4 < 4; ++q4) { const f32x4 vr = *(const LAS f32x4*)(xs + 16 * pq + 4 * q4), vi = *(const LAS f32x4*)(xs + 64 + 16 * pq + 4 * q4);
#pragma unroll
                for (int e = 0; e < 4; ++e) s += cre[4 * q4 + e] * vr[e] - cim[4 * q4 + e] * vi[e]; }
            LDS_WAIT(); asm volatile("" ::: "memory");
            s += __shfl_xor(s, 16); s += __shfl_xor(s, 32);
            const float yg = gelu_tanh_(s + dj * uj);
            float z = bg;
#pragma unroll
            for (int j = 0; j < 16; ++j) z += __shfl(yg, j) * wg[j];
            const float o = yg * sigmoidf_(z);
            if (lane < 16) CAT[(size_t)(b * SEQ + t) * D + g * 16 + lane] = f2bf(o);
        }
    }
}

__device__ __forceinline__ void rwkv_prep(const Args& a, LAS unsigned char* lds, const bf16_t* P1, bf16_t* RA, bf16_t* RKK, bf16_t* RLD, bf16_t* RG, int bx, int G, int tid) {
    LAS float* twT = (LAS float*)lds; LAS float* adT = twT + 64 * 16; LAS float* sgT = adT + 64 * 16;
    const float* mu = a.in[I_MU];
    for (int tile = bx; tile < T / 16; tile += G) {
        __syncthreads();
#pragma unroll
        for (int i = 0; i < 8; ++i) { const int idx = tid + 512 * i, tok = idx >> 8, c = idx & 255, row = tile * 16 + tok, t = row & (SEQ - 1);
            const float cur = bf2f(P1[(size_t)row * INB + 2304 + c]), prev = t > 0 ? bf2f(P1[(size_t)(row - 1) * INB + 2304 + c]) : 0.f;
            const float xsv = cur + (prev - cur) * mu[2304 + c];
            if (c < 64) twT[c * 16 + tok] = tanhf(xsv); else if (c < 128) adT[(c - 64) * 16 + tok] = xsv; else sgT[(c - 128) * 16 + tok] = sigmoidf_(xsv); }
        __syncthreads();
        if (tid < 384) {
#pragma unroll 1
            for (int cc = 0; cc < 2; ++cc) { const int c = tid + 384 * cc;
                float aw[16], aa[16], ag[16];
#pragma unroll
                for (int k = 0; k < 16; ++k) { aw[k] = 0.f; aa[k] = 0.f; ag[k] = 0.f; }
#pragma unroll 2
                for (int m = 0; m < 64; ++m) { const float w2v = a.in[I_W2][(size_t)m * CS + c], a2v = a.in[I_A2][(size_t)m * CS + c];
#pragma unroll
                    for (int k4 = 0; k4 < 4; ++k4) { const f32x4 tw = *(const LAS f32x4*)(twT + m * 16 + 4 * k4), ad = *(const LAS f32x4*)(adT + m * 16 + 4 * k4);
#pragma unroll
                        for (int e = 0; e < 4; ++e) { aw[4 * k4 + e] += tw[e] * w2v; aa[4 * k4 + e] += ad[e] * a2v; } } }
#pragma unroll 2
                for (int m = 0; m < 128; ++m) { const float g2v = a.in[I_G2][(size_t)m * CS + c];
#pragma unroll
                    for (int k4 = 0; k4 < 4; ++k4) { const f32x4 sg = *(const LAS f32x4*)(sgT + m * 16 + 4 * k4);
#pragma unroll
                        for (int e = 0; e < 4; ++e) ag[4 * k4 + e] += sg[e] * g2v; } }
                const float w0 = a.in[I_W0][c], a0 = a.in[I_A0][c], kkw = a.in[I_KK][c], muk = mu[CS + c];
#pragma unroll
                for (int k = 0; k < 16; ++k) { const int row = tile * 16 + k, t = row & (SEQ - 1);
                    const float z = -(w0 + aw[k]);
                    const float sp = z > 20.f ? z : log1pf(__expf(z));
                    const float ld = -__expf(-sp - 0.5f);
                    const float av = sigmoidf_(a0 + aa[k]);
                    const float cur = bf2f(P1[(size_t)row * INB + CS + c]), prev = t > 0 ? bf2f(P1[(size_t)(row - 1) * INB + CS + c]) : 0.f;
                    const float kx = (cur + (prev - cur) * muk) * kkw;
                    const float ss = wave_sum(kx * kx);
                    const float kkv = kx / fmaxf(sqrtf(ss), 1e-12f);
                    const size_t o = (size_t)row * CS + c;
                    RA[o] = f2bf(av); RKK[o] = f2bf(kkv); RLD[o] = f2bf(ld); RG[o] = f2bf(ag[k]); }
            }
        }
    }
}

__device__ __forceinline__ void rwkv_naive(const Args& a, LAS unsigned char* lds, const bf16_t* P1, const bf16_t* RA, const bf16_t* RKK, const bf16_t* RLD, const bf16_t* RG, bf16_t* CAT, int bx, int G, int wave, int lane) {
    if (wave != 4) return;
    LAS float* vec = (LAS float*)lds;
    for (int item = bx; item < NB * RH; item += G) {
        const int b = item / RH, h = item % RH, c = h * 64 + lane;
        const float mur = a.in[I_MU][c], muk = a.in[I_MU][CS + c], muv = a.in[I_MU][2 * CS + c], ka = a.in[I_KA][c], rkc = a.in[I_RK][c], lw = a.in[I_LNXW][c], lb = a.in[I_LNXB][c];
        float S[64];
#pragma unroll
        for (int j = 0; j < 64; ++j) S[j] = 0.f;
        float prr = 0.f, prk = 0.f, prv = 0.f;
        const size_t row0 = (size_t)b * SEQ;
        bf16_t n_r = P1[row0 * INB + c], n_k = P1[row0 * INB + CS + c], n_v = P1[row0 * INB + 2 * CS + c], n_a = RA[row0 * CS + c], n_kk = RKK[row0 * CS + c], n_ld = RLD[row0 * CS + c], n_g = RG[row0 * CS + c];
#pragma unroll 1
        for (int t = 0; t < SEQ; ++t) {
            const float pr = bf2f(n_r), pk = bf2f(n_k), pv = bf2f(n_v), av = bf2f(n_a), kkv = bf2f(n_kk), ld = bf2f(n_ld), gv = bf2f(n_g);
            if (t + 1 < SEQ) { const size_t rn = row0 + t + 1; n_r = P1[rn * INB + c]; n_k = P1[rn * INB + CS + c]; n_v = P1[rn * INB + 2 * CS + c]; n_a = RA[rn * CS + c]; n_kk = RKK[rn * CS + c]; n_ld = RLD[rn * CS + c]; n_g = RG[rn * CS + c]; }
            const float r = pr + (prr - pr) * mur, k = pk + (prk - pk) * muk, v = pv + (prv - pv) * muv;
            prr = pr; prk = pk; prv = pv;
            const float kp = k * (1.f + (av - 1.f) * ka), ap = -kkv, bb = kkv * av, w = __expf(ld);
            vec[lane] = r; vec[64 + lane] = w; vec[128 + lane] = kp; vec[192 + lane] = ap; vec[256 + lane] = bb;
            LDS_WAIT(); asm volatile("" ::: "memory");
            float sa = 0.f;
#pragma unroll
            for (int j4 = 0; j4 < 16; ++j4) { const f32x4 x = *(const LAS f32x4*)(vec + 192 + 4 * j4); sa += S[4 * j4] * x[0] + S[4 * j4 + 1] * x[1] + S[4 * j4 + 2] * x[2] + S[4 * j4 + 3] * x[3]; }
            float y = 0.f;
#pragma unroll
            for (int j4 = 0; j4 < 16; ++j4) { const f32x4 wv = *(const LAS f32x4*)(vec + 64 + 4 * j4), bv = *(const LAS f32x4*)(vec + 256 + 4 * j4), kv = *(const LAS f32x4*)(vec + 128 + 4 * j4), rv = *(const LAS f32x4*)(vec + 4 * j4);
#pragma unroll
                for (int e = 0; e < 4; ++e) { const float s = S[4 * j4 + e] * wv[e] + sa * bv[e] + v * kv[e]; S[4 * j4 + e] = s; y += s * rv[e]; } }
            LDS_WAIT(); asm volatile("" ::: "memory");
            const float rkv = wave_sum(r * kp * rkc), bonus = rkv * v;
            const float mean = wave_sum(y) * (1.f / 64.f), dlt = y - mean, var = wave_sum(dlt * dlt) * (1.f / 64.f);
            const float yn = dlt * (1.0f / sqrtf(var + LNX_EPS)) * lw + lb;
            CAT[(row0 + t) * D + c] = f2bf((yn + bonus) * gv);
        }
    }
}

__device__ __forceinline__ void moe_router(const Args& a, const bf16_t* XB, unsigned* ctl, unsigned char* ws, int gw, int NGW, int lane, LAS unsigned char* sm, int wave) {
    int* list = (int*)(ws + WS_ROUTE2 + RT_LIST); float* lrstd = (float*)(ws + WS_ROUTE2 + RT_LRSTD);
    int* toke = (int*)(ws + WS_ROUTE2 + RT_TOKE); int* tokr = (int*)(ws + WS_ROUTE2 + RT_TOKR); float* tokw = (float*)(ws + WS_ROUTE2 + RT_TOKW);
    float wg[16][8];
    {   const float* wr = a.in[I_WR]; const f32x4* gr = (const f32x4*)(a.in[I_NORM_FFN] + D) + lane;
#pragma unroll
        for (int j = 0; j < 4; ++j) { const f32x4 g = gr[64 * j];
#pragma unroll
            for (int i = 0; i < 4; ++i) { const int k = 4 * (lane + 64 * j) + i; const f32x4 w0 = *(const f32x4*)(wr + (size_t)k * 8), w1 = *(const f32x4*)(wr + (size_t)k * 8 + 4);
#pragma unroll
                for (int e = 0; e < 4; ++e) { wg[4 * j + i][e] = g[i] * w0[e]; wg[4 * j + i][4 + e] = g[i] * w1[e]; } } } }
    float br[8];
#pragma unroll
    for (int e = 0; e < 8; ++e) br[e] = a.in[I_BR][e];
    int m_bi = 0, m_si = 0; float m_rs = 0.f, m_w0 = 0.f;
    u32x2 va[4], vb[4];
#define RT_LOAD(v_, r_) do { const u32x2* xr_ = (const u32x2*)(XB + (size_t)(r_) * D) + lane; _Pragma("unroll") for (int j = 0; j < 4; ++j) v_[j] = xr_[64 * j]; } while (0)
#define RT_ROW(v_, i_) do { float lg[8]; float s = 0.f; \
        _Pragma("unroll") for (int e = 0; e < 8; ++e) lg[e] = 0.f; \
        _Pragma("unroll") for (int j = 0; j < 4; ++j) _Pragma("unroll") for (int i = 0; i < 4; ++i) { const unsigned pw_ = (i < 2) ? v_[j].x : v_[j].y; const float hv = (i & 1) ? bfhi(pw_) : bflo(pw_); s += hv * hv; \
            _Pragma("unroll") for (int e = 0; e < 8; ++e) lg[e] += hv * wg[4 * j + i][e]; } \
        wave_sum8(lg); const float rs = rstd_of(wave_sum_fast(s)); \
        _Pragma("unroll") for (int e = 0; e < 8; ++e) lg[e] = lg[e] * rs + br[e]; \
        float bv = lg[0]; int bi = 0; \
        _Pragma("unroll") for (int e = 1; e < 8; ++e) if (lg[e] > bv) { bv = lg[e]; bi = e; } \
        float sv = -3.0e38f; int si = 0; \
        _Pragma("unroll") for (int e = 0; e < 8; ++e) if (e != bi && lg[e] > sv) { sv = lg[e]; si = e; } \
        const float w0 = 1.0f / (1.0f + __expf(sv - bv)); \
        if (lane == (i_)) { m_bi = bi; m_si = si; m_rs = rs; m_w0 = w0; } } while (0)
    int nrow = 0;
    if (gw < T) RT_LOAD(va, gw);
    for (int r = gw; r < T; r += 2 * NGW) {
        const int r2 = r + NGW, r3 = r + 2 * NGW;
        if (r2 < T) RT_LOAD(vb, r2);
        __builtin_amdgcn_sched_barrier(0);
        RT_ROW(va, nrow); ++nrow;
        if (r3 < T) RT_LOAD(va, r3);
        __builtin_amdgcn_sched_barrier(0);
        if (r2 < T) { RT_ROW(vb, nrow); ++nrow; }
    }
#undef RT_LOAD
#undef RT_ROW
    {   LAS int* wcnt = (LAS int*)sm; LAS int* wbase = wcnt + 64;
        const bool act = lane < nrow; int myc = 0; unsigned long long mk[8];
#pragma unroll
        for (int e = 0; e < 8; ++e) { mk[e] = __ballot(act && (m_bi == e || m_si == e)); if (lane == e) myc = __popcll(mk[e]); }
        if (lane < 8) wcnt[wave * 8 + lane] = myc;
        __syncthreads();
        if (wave == 0 && lane < 8) { int tot = 0, pre[8];
#pragma unroll
            for (int w = 0; w < 8; ++w) { pre[w] = tot; tot += wcnt[w * 8 + lane]; }
            const int base = tot ? (int)atomicAdd(ctl + CW_CNT + 64 * lane, (unsigned)tot) : 0;
#pragma unroll
            for (int w = 0; w < 8; ++w) wbase[w * 8 + lane] = base + pre[w]; }
        __syncthreads();
        if (act) { const int r = gw + NGW * lane; const int bi = m_bi, si = m_si; const float rs = m_rs, w0 = m_w0, w1 = 1.0f - w0;
            const unsigned long long lt = (1ull << lane) - 1ull; int r0 = 0, r1 = 0;
#pragma unroll
            for (int e = 0; e < 8; ++e) { const int rk = wbase[wave * 8 + e] + __popcll(mk[e] & lt); if (bi == e) r0 = rk; if (si == e) r1 = rk; }
            list[bi * 32768 + r0] = r; lrstd[bi * 32768 + r0] = rs; list[si * 32768 + r1] = r; lrstd[si * 32768 + r1] = rs;
            toke[2 * r] = bi; toke[2 * r + 1] = si; tokr[2 * r] = r0; tokr[2 * r + 1] = r1; tokw[2 * r] = w0; tokw[2 * r + 1] = w1; } }
}

constexpr int RW_LS = 72;
constexpr int RW_SLOT = 64 * RW_LS * 2;
constexpr int RW_FS = 65;
__device__ __forceinline__ LAS unsigned char* rw_slot(LAS unsigned char* lds, int s) { return lds + s * RW_SLOT; }
__device__ __forceinline__ bf16x8 rw_frag(const LAS unsigned char* m, int row, int kq, int ks) { return *(const LAS bf16x8*)(m + row * (RW_LS * 2) + (32 * ks + 8 * kq) * 2); }
__device__ __forceinline__ f32x4 rw_mm(const LAS unsigned char* A, const LAS unsigned char* Bt, int mt, int nt, int l15, int kq, f32x4 acc) {
#pragma unroll
    for (int ks = 0; ks < 2; ++ks) acc = __builtin_amdgcn_mfma_f32_16x16x32_bf16(rw_frag(A, 16 * mt + l15, kq, ks), rw_frag(Bt, 16 * nt + l15, kq, ks), acc, 0, 0, 0);
    return acc;
}
__device__ __forceinline__ void rw_store_T(LAS unsigned char* m, int mt, int nt, int q, int n, f32x4 v) {
    u32x2 w; w.x = cvt_pk_bf16(v[0], v[1]); w.y = cvt_pk_bf16(v[2], v[3]);
    *(LAS u32x2*)(m + (16 * nt + n) * (RW_LS * 2) + (16 * mt + 4 * q) * 2) = w;
}
__device__ __forceinline__ void rw_store_D(LAS unsigned char* m, int mt, int nt, int q, int n, f32x4 v) {
#pragma unroll
    for (int r = 0; r < 4; ++r) *(LAS bf16_t*)(m + (16 * mt + 4 * q + r) * (RW_LS * 2) + (16 * nt + n) * 2) = f2bf(v[r]);
}
struct RwF2 { bf16x8 k[2]; };
__device__ __forceinline__ RwF2 rw_ld2(const LAS unsigned char* m, int row, int kq) { RwF2 f; f.k[0] = rw_frag(m, row, kq, 0); f.k[1] = rw_frag(m, row, kq, 1); return f; }
__device__ __forceinline__ f32x4 rw_mmf(const RwF2& a, const RwF2& b, f32x4 acc) {
    acc = __builtin_amdgcn_mfma_f32_16x16x32_bf16(a.k[0], b.k[0], acc, 0, 0, 0); return __builtin_amdgcn_mfma_f32_16x16x32_bf16(a.k[1], b.k[1], acc, 0, 0, 0); }
#define RW_LOADED() __builtin_amdgcn_sched_barrier(0)
__device__ __forceinline__ float rw_ld1(const LAS unsigned char* m, int row, int col) { return bf2f(*(const LAS bf16_t*)(m + row * (RW_LS * 2) + col * 2)); }

#ifdef DBG_RWKV
__device__ __forceinline__ void rw_dbg_scan(LAS unsigned char* lds, int slot, int bit, unsigned* word, int tid) {
    unsigned bad = 0u;
    for (int i = tid; i < 4096; i += NTHR) { const float v = rw_ld1(rw_slot(lds, slot), i >> 6, i & 63); if (!(v - v == 0.f)) bad = 1u; }
    if (bad) atomicOr(word, 1u << bit);
}
#define RW_DBG(slot, bit) rw_dbg_scan(lds, slot, bit, B.dbg, tid)
__device__ __forceinline__ void rw_dbg_max(LAS unsigned char* lds, int slot, unsigned* word, int tid) {
    float m = 0.f;
    for (int i = tid; i < 4096; i += NTHR) { const float v = fabsf(rw_ld1(rw_slot(lds, slot), i >> 6, i & 63)); if (v - v == 0.f) m = fmaxf(m, v); }
    atomicMax(word, __float_as_uint(m));
}
#else
#define RW_DBG(slot, bit)
#endif
struct RwBufs { unsigned* dbg;  bf16_t* XL; bf16_t* Pp; bf16_t* Qp; bf16_t* Rp; float* WL; bf16_t* GA; bf16_t* GB; bf16_t* CAT; const bf16_t* P1; const bf16_t* w2T; const bf16_t* a2T; const bf16_t* g2T; };

__device__ __forceinline__ void rwkv_xpre(const Args& a, const RwBufs& B, int bx, int G, int wave) {
    const int tid = wave * 64 + lane_now(), c8 = (tid & 31) * 8, seg = c8 >> 5, tr = tid >> 5;
    const float* mu = a.in[I_MU];
    const f32x4 m0 = *(const f32x4*)(mu + 2304 + c8), m1 = *(const f32x4*)(mu + 2304 + c8 + 4);
#pragma unroll 2
    for (int r = bx * 16 + tr; r < T; r += G * 16) {
        const bf16_t* cp = B.P1 + (size_t)r * INB + 2304 + c8;
        const u32x4 cw = *(const u32x4*)cp, pw = ((r & (SEQ - 1)) == 0) ? (u32x4){0u, 0u, 0u, 0u} : *(const u32x4*)(cp - INB);
        float x[8]; const unsigned cwa[4] = {cw.x, cw.y, cw.z, cw.w}, pwa[4] = {pw.x, pw.y, pw.z, pw.w};
#pragma unroll
        for (int e = 0; e < 4; ++e) { const float c0 = bflo(cwa[e]), c1 = bfhi(cwa[e]), p0 = bflo(pwa[e]), p1 = bfhi(pwa[e]);
            const float mm0 = (e < 2) ? m0[2 * e] : m1[2 * e - 4], mm1 = (e < 2) ? m0[2 * e + 1] : m1[2 * e - 3];
            x[2 * e] = c0 + (p0 - c0) * mm0; x[2 * e + 1] = c1 + (p1 - c1) * mm1; }
#pragma unroll
        for (int e = 0; e < 8; ++e) { const float sg = __builtin_amdgcn_rcpf(1.0f + __expf(seg < 2 ? -2.0f * x[e] : -x[e])); x[e] = (seg < 2) ? (2.0f * sg - 1.0f) : ((seg >= 4) ? sg : x[e]); }
        u32x4 o; o.x = cvt_pk_bf16(x[0], x[1]); o.y = cvt_pk_bf16(x[2], x[3]); o.z = cvt_pk_bf16(x[4], x[5]); o.w = cvt_pk_bf16(x[6], x[7]);
        *(u32x4*)(B.XL + (size_t)r * 256 + c8) = o; }
}

#ifndef RW_DUPS
#define RW_DUPS 0
#endif
#define RW_REP(bit) _Pragma("unroll 1") for (int rp_ = 0; rp_ < ((((RW_DUPS) >> (bit)) & 1) ? 4 : 1); ++rp_)
__device__ __forceinline__ void rwkv_r1(const Args& a, LAS unsigned char* lds, const RwBufs& B, int bx, int G, int wave, int nitems) {
    const int lane = lane_now(), l15 = lane & 15, kq = lane >> 4, q = kq, n = l15, tid = wave * 64 + lane;
    LAS float* Fw = (LAS float*)lds; LAS float* Fa = Fw + 64 * RW_FS; LAS float* Fg = Fa + 64 * RW_FS;
    LAS float* gsum = (LAS float*)(lds + 15 * RW_SLOT);
    const float* mu = a.in[I_MU];
    const int h = bx % RH, rk = bx / RH, nh = (G - h + RH - 1) / RH, nbc = nitems / RH;
    u32x4 pcw[4]; unsigned ldrk[9], ldv2[5];
#define RW_ISSUE(bc_) do { const int b_ = (bc_) >> 6, c_ = (bc_) & 63; const size_t r0_ = (size_t)b_ * SEQ + c_ * 64; \
        { const int tid_ = wave * 64 + lane_now(); const int t_ = tid_ >> 3, seg_ = tid_ & 7; const bf16_t* cp_ = B.XL + (r0_ + t_) * 256 + 32 * seg_; \
          _Pragma("unroll") for (int v8 = 0; v8 < 4; ++v8) pcw[v8] = *(const u32x4*)(cp_ + 8 * v8); } \
        { const bf16_t* pr0_ = B.P1 + (r0_ + 8 * wave) * INB + h * 64 + lane_now(); const bool z0_ = (c_ == 0 && wave == 0); \
          _Pragma("unroll") for (int u = 0; u < 9; ++u) { unsigned r_ = 0u, k_ = 0u, v_ = 0u; if (!(u == 0 && z0_)) { const bf16_t* pp_ = pr0_ + (ptrdiff_t)(u - 1) * INB; r_ = pp_[0]; k_ = pp_[CS]; v_ = pp_[2 * CS]; } \
              ldrk[u] = r_ | (k_ << 16); if (u & 1) ldv2[u >> 1] |= v_ << 16; else ldv2[u >> 1] = v_; } } } while (0)
    const int cgh = h * 64 + lane;
    const float hc_a0 = a.in[I_A0][cgh], hc_kk = a.in[I_KK][cgh], hc_ka = a.in[I_KA][cgh], hc_rk = a.in[I_RK][cgh], hc_lxw = a.in[I_LNXW][cgh], hc_lxb = a.in[I_LNXB][cgh];
    const float hc_mur = mu[cgh], hc_muk = mu[CS + cgh], hc_muv = mu[2 * CS + cgh], hc_w0n = a.in[I_W0][h * 64 + 16 * (wave & 3) + l15];
#define RW_WFR_LOAD \
        { const int ntw = wave & 3; const size_t rw = (size_t)(h * 64 + 16 * ntw + l15); \
    _Pragma("unroll") \
          for (int ks = 0; ks < 2; ++ks) { wfr[ks] = *(const bf16x8*)(B.w2T + rw * 64 + 32 * ks + 8 * kq); wfr[2 + ks] = *(const bf16x8*)(B.a2T + rw * 64 + 32 * ks + 8 * kq); } \
    _Pragma("unroll") \
          for (int ks = 0; ks < 4; ++ks) wfr[4 + ks] = *(const bf16x8*)(B.g2T + rw * 128 + 32 * ks + 8 * kq); } \

    bf16x8 wfr[8];
#if !RW_DUPS
    RW_WFR_LOAD
#endif
    if (rk < nbc) RW_ISSUE(rk);
#pragma unroll 1
    for (int bc = rk; bc < nbc; bc += nh) {
        const int b = bc >> 6, c = bc & 63, item = bc * RH + h;
        const size_t row0 = (size_t)b * SEQ + c * 64;
#if RW_DUPS
        RW_WFR_LOAD
#endif
        __syncthreads();
        { const int tid0 = wave * 64 + lane_now(), t = tid0 >> 3, seg = tid0 & 7;
          LAS unsigned char* dst = rw_slot(lds, 6 + (seg >> 1)) + t * (RW_LS * 2) + (32 * (seg & 1)) * 2;
#pragma unroll
          for (int v8 = 0; v8 < 4; ++v8) *(LAS u32x4*)(dst + 16 * v8) = pcw[v8]; }
        __syncthreads();
        RW_REP(1) {
#pragma unroll
        for (int i6 = 0; i6 < 6; ++i6) { const int ti = wave + 8 * i6, mat = i6 >> 1, mt = (ti >> 2) & 3, nt = wave & 3; f32x4 acc = {0.f, 0.f, 0.f, 0.f};
            if (mat < 2) { const LAS unsigned char* X = rw_slot(lds, 6 + mat);
#pragma unroll
                for (int ks = 0; ks < 2; ++ks) acc = __builtin_amdgcn_mfma_f32_16x16x32_bf16(rw_frag(X, 16 * mt + l15, kq, ks), wfr[2 * mat + ks], acc, 0, 0, 0);
            } else {
#pragma unroll
                for (int ks = 0; ks < 4; ++ks) acc = __builtin_amdgcn_mfma_f32_16x16x32_bf16(rw_frag(rw_slot(lds, 8 + (ks >> 1)), 16 * mt + l15, kq, ks & 1), wfr[4 + ks], acc, 0, 0, 0); }
            LAS float* F = (mat == 0) ? Fw : (mat == 1 ? Fa : Fg);
            if (mat == 0) {
                const float w0n = hc_w0n; float s4 = 0.f;
#pragma unroll
                for (int r = 0; r < 4; ++r) { const float z = -(w0n + acc[r]); acc[r] = -0.6065306597126334f * __builtin_amdgcn_rcpf(1.0f + __expf(z)); s4 += acc[r]; }
                s4 += __shfl_xor(s4, 16);
                if ((q & 1) == 0) gsum[(2 * mt + (q >> 1)) * 64 + 16 * nt + n] = s4; }
#pragma unroll
            for (int r = 0; r < 4; ++r) F[(16 * mt + 4 * q + r) * RW_FS + 16 * nt + n] = acc[r]; }
        __syncthreads();
        }
        RW_REP(2) {
        {   const int j = lane, cg = h * 64 + j, t0 = 8 * wave;
            const float a0 = hc_a0, kkw = hc_kk, kaw = hc_ka, rkw = hc_rk, lxw = hc_lxw, lxb = hc_lxb, mur = hc_mur, muk = hc_muk, muv = hc_muv;
            float ldv[8], av[8], rv[8], kv[8], vv[8], kkv[8];
            float pr_r = bflo(ldrk[0]), pr_k = bfhi(ldrk[0]), pr_v = bflo(ldv2[0]);
#pragma unroll
            for (int u = 0; u < 8; ++u) { const float cr = bflo(ldrk[u + 1]), ck = bfhi(ldrk[u + 1]), cv = ((u + 1) & 1) ? bfhi(ldv2[(u + 1) >> 1]) : bflo(ldv2[(u + 1) >> 1]);
                rv[u] = cr + (pr_r - cr) * mur; kv[u] = ck + (pr_k - ck) * muk; vv[u] = cv + (pr_v - cv) * muv; pr_r = cr; pr_k = ck; pr_v = cv;
                ldv[u] = Fw[(t0 + u) * RW_FS + j];
                av[u] = sigmoidf_(a0 + Fa[(t0 + u) * RW_FS + j]);
                const float kx = kv[u] * kkw; const float ss = wave_sum_fast(kx * kx); kkv[u] = kx * __builtin_amdgcn_rsqf(fmaxf(ss, 1e-24f)); }
            float lw[8]; lw[0] = ldv[0];
#pragma unroll
            for (int u = 1; u < 8; ++u) lw[u] = lw[u - 1] + ldv[u];
            float off = 0.f, tot = 0.f;
#pragma unroll
            for (int w8 = 0; w8 < 8; ++w8) { const float gs = gsum[w8 * 64 + j]; tot += gs; if (w8 < wave) off += gs; }
            if (wave == 0) B.WL[(size_t)item * 64 + lane_now()] = __expf(tot);
            unsigned pAt[4], pBh[4], pKh[4], pV[4], pga[4], pgb[4];
            const float WLt = __expf(tot); float Wprev = __expf(off);
#pragma unroll
            for (int u2 = 0; u2 < 4; ++u2) { float tAt[2], tBh[2], tKh[2], ga2[2], gb2[2];
#pragma unroll
                for (int uu = 0; uu < 2; ++uu) { const int u = 2 * u2 + uu; const float lwt = off + lw[u];
                    const float kp = kv[u] * (1.f + (av[u] - 1.f) * kaw), ap = -kkv[u], bb = kkv[u] * av[u];
                    const float Wt = __expf(lwt), Wm1 = Wprev, iW = __builtin_amdgcn_rcpf(Wt), WLr = WLt * iW; Wprev = Wt;
                    const float bonus = wave_sum_fast(rv[u] * kp * rkw);
                    const float gv = Fg[(t0 + u) * RW_FS + j];
                    ga2[uu] = lxw * gv; gb2[uu] = (lxb + bonus * vv[u]) * gv;
                    const int t = t0 + u;
                    *(LAS bf16_t*)(rw_slot(lds, 10) + t * (RW_LS * 2) + j * 2) = f2bf(ap * Wm1);
                    *(LAS bf16_t*)(rw_slot(lds, 11) + t * (RW_LS * 2) + j * 2) = f2bf(bb * iW);
                    *(LAS bf16_t*)(rw_slot(lds, 12) + t * (RW_LS * 2) + j * 2) = f2bf(kp * iW);
                    *(LAS bf16_t*)(rw_slot(lds, 13) + t * (RW_LS * 2) + j * 2) = f2bf(rv[u] * Wt);
                    tAt[uu] = ap * Wm1; tBh[uu] = bb * WLr; tKh[uu] = kp * WLr; }
                pAt[u2] = cvt_pk_bf16(tAt[0], tAt[1]); pBh[u2] = cvt_pk_bf16(tBh[0], tBh[1]); pKh[u2] = cvt_pk_bf16(tKh[0], tKh[1]); pV[u2] = cvt_pk_bf16(vv[2 * u2], vv[2 * u2 + 1]);
                pga[u2] = cvt_pk_bf16(ga2[0], ga2[1]); pgb[u2] = cvt_pk_bf16(gb2[0], gb2[1]); }
            *(LAS u32x4*)(rw_slot(lds, 14) + j * (RW_LS * 2) + t0 * 2) = (u32x4){pAt[0], pAt[1], pAt[2], pAt[3]};
            *(LAS u32x4*)(rw_slot(lds, 6) + j * (RW_LS * 2) + t0 * 2) = (u32x4){pBh[0], pBh[1], pBh[2], pBh[3]};
            *(LAS u32x4*)(rw_slot(lds, 7) + j * (RW_LS * 2) + t0 * 2) = (u32x4){pKh[0], pKh[1], pKh[2], pKh[3]};
            *(LAS u32x4*)(rw_slot(lds, 8) + j * (RW_LS * 2) + t0 * 2) = (u32x4){pV[0], pV[1], pV[2], pV[3]};
            { const int j2 = lane_now(); bf16_t* gap = B.GA + (size_t)item * 4096 + j2 * 64; bf16_t* gbp = B.GB + (size_t)item * 4096 + j2 * 64;
#pragma unroll
              for (int hh = 0; hh < 2; ++hh) { const int pos = (2 * (wave & 1) + hh) * 16 + (wave >> 1) * 4;
                  *(u32x2*)(gap + pos) = (u32x2){pga[2 * hh], pga[2 * hh + 1]}; *(u32x2*)(gbp + pos) = (u32x2){pgb[2 * hh], pgb[2 * hh + 1]}; } }
        }
        __syncthreads();
        }
        if (bc + nh < nbc) RW_ISSUE(bc + nh);
        RW_DBG(10, 0); RW_DBG(11, 1); RW_DBG(12, 2); RW_DBG(13, 3); RW_DBG(14, 4); RW_DBG(6, 5); RW_DBG(7, 6); RW_DBG(8, 7);
        RW_REP(3) {
        {   const int nt = wave & 3, mta = wave >> 2, mtb = mta + 2; const f32x4 z4 = {0.f, 0.f, 0.f, 0.f};
            const int da = 16 * (mta - nt) + 4 * q - n, db = 16 * (mtb - nt) + 4 * q - n;
#define RW_MASK(acc_, d_, MODE) do { _Pragma("unroll") for (int r = 0; r < 4; ++r) { const bool keep = (MODE == 0) ? ((d_) + r > 0) : ((MODE == 1) ? ((d_) + r < 0) : ((d_) + r <= 0)); acc_[r] = keep ? acc_[r] : 0.f; } } while (0)
            {   const RwF2 a10a = rw_ld2(rw_slot(lds, 10), 16 * mta + l15, kq), a10b = rw_ld2(rw_slot(lds, 10), 16 * mtb + l15, kq), b11 = rw_ld2(rw_slot(lds, 11), 16 * nt + l15, kq);
                const RwF2 a12a = rw_ld2(rw_slot(lds, 12), 16 * mta + l15, kq), a12b = rw_ld2(rw_slot(lds, 12), 16 * mtb + l15, kq), b10 = rw_ld2(rw_slot(lds, 10), 16 * nt + l15, kq);
                RW_LOADED();
                f32x4 c0 = rw_mmf(a10a, b11, z4), c1 = rw_mmf(a10b, b11, z4), c2 = rw_mmf(a12a, b10, z4), c3 = rw_mmf(a12b, b10, z4);
                RW_MASK(c0, da, 0); RW_MASK(c1, db, 0); RW_MASK(c2, da, 1); RW_MASK(c3, db, 1);
                rw_store_T(rw_slot(lds, 0), mta, nt, q, n, c0); rw_store_T(rw_slot(lds, 0), mtb, nt, q, n, c1); rw_store_T(rw_slot(lds, 1), mta, nt, q, n, c2); rw_store_T(rw_slot(lds, 1), mtb, nt, q, n, c3);
                RW_LOADED(); }
            {   const RwF2 a11a = rw_ld2(rw_slot(lds, 11), 16 * mta + l15, kq), a11b = rw_ld2(rw_slot(lds, 11), 16 * mtb + l15, kq), b13 = rw_ld2(rw_slot(lds, 13), 16 * nt + l15, kq);
                const RwF2 a12a = rw_ld2(rw_slot(lds, 12), 16 * mta + l15, kq), a12b = rw_ld2(rw_slot(lds, 12), 16 * mtb + l15, kq);
                RW_LOADED();
                f32x4 c0 = rw_mmf(a11a, b13, z4), c1 = rw_mmf(a11b, b13, z4), c2 = rw_mmf(a12a, b13, z4), c3 = rw_mmf(a12b, b13, z4);
                RW_MASK(c0, da, 2); RW_MASK(c1, db, 2); RW_MASK(c2, da, 2); RW_MASK(c3, db, 2);
                rw_store_T(rw_slot(lds, 2), mta, nt, q, n, c0); rw_store_T(rw_slot(lds, 2), mtb, nt, q, n, c1); rw_store_T(rw_slot(lds, 3), mta, nt, q, n, c2); rw_store_T(rw_slot(lds, 3), mtb, nt, q, n, c3);
                RW_LOADED(); } }
        for (int i = wave * 64 + lane_now(); i < 2 * RW_SLOT / 16; i += NTHR) *(LAS u32x4*)(rw_slot(lds, 4) + i * 16) = (u32x4){0u, 0u, 0u, 0u};
        __syncthreads();
        }
        RW_DBG(0, 8); RW_DBG(1, 9); RW_DBG(2, 10); RW_DBG(3, 11);
#ifdef DBG_RWKV
        rw_dbg_max(lds, DBG_MAXSLOT_A, B.dbg + 1, tid);
#endif
        RW_REP(4) {
        if (wave >= 4) {
            {   const int nt = wave & 3; const f32x4 z4 = {0.f, 0.f, 0.f, 0.f};
                const RwF2 a0 = rw_ld2(rw_slot(lds, 1), l15, kq), a1 = rw_ld2(rw_slot(lds, 1), 16 + l15, kq), a2 = rw_ld2(rw_slot(lds, 1), 32 + l15, kq), a3 = rw_ld2(rw_slot(lds, 1), 48 + l15, kq), b8 = rw_ld2(rw_slot(lds, 8), 16 * nt + l15, kq);
                RW_LOADED();
                const f32x4 c0 = rw_mmf(a0, b8, z4), c1 = rw_mmf(a1, b8, z4), c2 = rw_mmf(a2, b8, z4), c3 = rw_mmf(a3, b8, z4);
                rw_store_T(rw_slot(lds, 12), 0, nt, q, n, c0); rw_store_T(rw_slot(lds, 12), 1, nt, q, n, c1); rw_store_T(rw_slot(lds, 12), 2, nt, q, n, c2); rw_store_T(rw_slot(lds, 12), 3, nt, q, n, c3); } }
        if (wave < 4 && lane_now() < 16) { const int i0 = 16 * wave, cc = lane_now(); float Tc[16];
            const LAS unsigned char* AT = rw_slot(lds, 0);
#pragma unroll
            for (int t = 0; t < 16; ++t) { float s = (t == cc) ? 1.f : 0.f;
#pragma unroll
                for (int s2 = 0; s2 < t; ++s2) s += rw_ld1(AT, i0 + s2, i0 + t) * Tc[s2];
                Tc[t] = s; }
#pragma unroll
            for (int t = 0; t < 16; ++t) *(LAS bf16_t*)(rw_slot(lds, 4) + (i0 + t) * (RW_LS * 2) + (i0 + cc) * 2) = f2bf(Tc[t]);
            u32x4 o0, o1; o0.x = cvt_pk_bf16(Tc[0], Tc[1]); o0.y = cvt_pk_bf16(Tc[2], Tc[3]); o0.z = cvt_pk_bf16(Tc[4], Tc[5]); o0.w = cvt_pk_bf16(Tc[6], Tc[7]);
            o1.x = cvt_pk_bf16(Tc[8], Tc[9]); o1.y = cvt_pk_bf16(Tc[10], Tc[11]); o1.z = cvt_pk_bf16(Tc[12], Tc[13]); o1.w = cvt_pk_bf16(Tc[14], Tc[15]);
            *(LAS u32x4*)(rw_slot(lds, 5) + (i0 + cc) * (RW_LS * 2) + i0 * 2) = o0; *(LAS u32x4*)(rw_slot(lds, 5) + (i0 + cc) * (RW_LS * 2) + (i0 + 8) * 2) = o1;
        }
#if RW_DUPS
        __syncthreads();
#endif
        }
        if (wave < 4 && lane_now() < 16) { const int i0 = 16 * wave, cc = lane_now();
            LDS_WAIT();
            *(LAS u32x4*)(rw_slot(lds, 0) + (i0 + cc) * (RW_LS * 2) + i0 * 2) = (u32x4){0u, 0u, 0u, 0u}; *(LAS u32x4*)(rw_slot(lds, 0) + (i0 + cc) * (RW_LS * 2) + (i0 + 8) * 2) = (u32x4){0u, 0u, 0u, 0u};
        }
        __syncthreads();
        RW_DBG(4, 12); RW_DBG(5, 13);
#ifdef DBG_RWKV
        rw_dbg_max(lds, 4, B.dbg + 2, tid);
#endif
        RW_REP(5) {
        {   const int nt = wave & 3, mta = wave >> 2, mtb = mta + 2; const f32x4 z4 = {0.f, 0.f, 0.f, 0.f};
            const RwF2 a4a = rw_ld2(rw_slot(lds, 4), 16 * mta + l15, kq), a4b = rw_ld2(rw_slot(lds, 4), 16 * mtb + l15, kq), b0 = rw_ld2(rw_slot(lds, 0), 16 * nt + l15, kq);
            RW_LOADED();
            const f32x4 c0 = rw_mmf(a4a, b0, z4), c1 = rw_mmf(a4b, b0, z4);
            rw_store_T(rw_slot(lds, 11), mta, nt, q, n, c0); rw_store_D(rw_slot(lds, 9), mta, nt, q, n, c0); rw_store_T(rw_slot(lds, 11), mtb, nt, q, n, c1); rw_store_D(rw_slot(lds, 9), mtb, nt, q, n, c1); }
        __syncthreads();
        }
        RW_DBG(9, 14); RW_DBG(11, 15);
#ifdef DBG_RWKV
        rw_dbg_max(lds, 11, B.dbg + 3, tid);
#endif
        RW_REP(6) {
        {   const int nt = wave & 3, mta = wave >> 2, mtb = mta + 2; const f32x4 z4 = {0.f, 0.f, 0.f, 0.f};
            const RwF2 a11a = rw_ld2(rw_slot(lds, 11), 16 * mta + l15, kq), a11b = rw_ld2(rw_slot(lds, 11), 16 * mtb + l15, kq), b9 = rw_ld2(rw_slot(lds, 9), 16 * nt + l15, kq);
            const RwF2 a9a = rw_ld2(rw_slot(lds, 9), 16 * mta + l15, kq), a9b = rw_ld2(rw_slot(lds, 9), 16 * mtb + l15, kq), b5 = rw_ld2(rw_slot(lds, 5), 16 * nt + l15, kq);
            const u32x2 dga = *(const LAS u32x2*)(rw_slot(lds, 5) + (16 * nt + n) * (RW_LS * 2) + (16 * mta + 4 * q) * 2), dgb = *(const LAS u32x2*)(rw_slot(lds, 5) + (16 * nt + n) * (RW_LS * 2) + (16 * mtb + 4 * q) * 2);
            RW_LOADED();
            const f32x4 c0 = rw_mmf(a11a, b9, z4), c1 = rw_mmf(a11b, b9, z4);
            const f32x4 c2 = rw_mmf(a9a, b5, (f32x4){bflo(dga.x), bfhi(dga.x), bflo(dga.y), bfhi(dga.y)}), c3 = rw_mmf(a9b, b5, (f32x4){bflo(dgb.x), bfhi(dgb.x), bflo(dgb.y), bfhi(dgb.y)});
            rw_store_T(rw_slot(lds, 10), mta, nt, q, n, c0); rw_store_T(rw_slot(lds, 10), mtb, nt, q, n, c1);
            RW_LOADED();
            rw_store_T(rw_slot(lds, 0), mta, nt, q, n, c2); rw_store_T(rw_slot(lds, 0), mtb, nt, q, n, c3); }
        __syncthreads();
        }
        RW_DBG(10, 16); RW_DBG(0, 17);
        RW_REP(7) {
        {   const int nt = wave & 3, mta = wave >> 2, mtb = mta + 2;
            const RwF2 a0a = rw_ld2(rw_slot(lds, 0), 16 * mta + l15, kq), a0b = rw_ld2(rw_slot(lds, 0), 16 * mtb + l15, kq), b10 = rw_ld2(rw_slot(lds, 10), 16 * nt + l15, kq);
            f32x4 za, zb;
#pragma unroll
            for (int r = 0; r < 4; ++r) { za[r] = rw_ld1(rw_slot(lds, 0), 16 * mta + 4 * q + r, 16 * nt + n); zb[r] = rw_ld1(rw_slot(lds, 0), 16 * mtb + 4 * q + r, 16 * nt + n); }
            RW_LOADED();
            const f32x4 c0 = rw_mmf(a0a, b10, za), c1 = rw_mmf(a0b, b10, zb);
            rw_store_T(rw_slot(lds, 4), mta, nt, q, n, c0); rw_store_T(rw_slot(lds, 4), mtb, nt, q, n, c1); }
        __syncthreads();
        }
        RW_DBG(4, 18);
        RW_REP(8) {
        {   const int nt = wave & 3, mta = wave >> 2, mtb = mta + 2; const f32x4 z4 = {0.f, 0.f, 0.f, 0.f};
            const RwF2 a4a = rw_ld2(rw_slot(lds, 4), 16 * mta + l15, kq), a4b = rw_ld2(rw_slot(lds, 4), 16 * mtb + l15, kq), b14 = rw_ld2(rw_slot(lds, 14), 16 * nt + l15, kq), b12 = rw_ld2(rw_slot(lds, 12), 16 * nt + l15, kq);
            RW_LOADED();
            const f32x4 c0 = rw_mmf(a4a, b14, z4), c1 = rw_mmf(a4b, b14, z4), c2 = rw_mmf(a4a, b12, z4), c3 = rw_mmf(a4b, b12, z4);
            rw_store_T(rw_slot(lds, 5), mta, nt, q, n, c0); rw_store_T(rw_slot(lds, 5), mtb, nt, q, n, c1); rw_store_T(rw_slot(lds, 11), mta, nt, q, n, c2); rw_store_T(rw_slot(lds, 11), mtb, nt, q, n, c3); }
        __syncthreads();
        }
        RW_DBG(5, 19); RW_DBG(11, 21);
        RW_REP(10) {
        {   const int nt = wave & 3, mta = wave >> 2, mtb = mta + 2; const f32x4 z4 = {0.f, 0.f, 0.f, 0.f};
#define RW_PK(c_) ((u32x2){cvt_pk_bf16(c_[0], c_[1]), cvt_pk_bf16(c_[2], c_[3])})
            {
                const RwF2 a5a = rw_ld2(rw_slot(lds, 5), 16 * mta + l15, kq), a5b = rw_ld2(rw_slot(lds, 5), 16 * mtb + l15, kq), b6 = rw_ld2(rw_slot(lds, 6), 16 * nt + l15, kq), b2 = rw_ld2(rw_slot(lds, 2), 16 * nt + l15, kq);
                const u32x2 rta = *(const LAS u32x2*)(rw_slot(lds, 13) + (16 * nt + n) * (RW_LS * 2) + (16 * mta + 4 * q) * 2), rtb = *(const LAS u32x2*)(rw_slot(lds, 13) + (16 * nt + n) * (RW_LS * 2) + (16 * mtb + 4 * q) * 2);
                RW_LOADED();
                const f32x4 c0 = rw_mmf(a5a, b6, z4), c1 = rw_mmf(a5b, b6, z4);
                const f32x4 c2 = rw_mmf(a5a, b2, (f32x4){bflo(rta.x), bfhi(rta.x), bflo(rta.y), bfhi(rta.y)}), c3 = rw_mmf(a5b, b2, (f32x4){bflo(rtb.x), bfhi(rtb.x), bflo(rtb.y), bfhi(rtb.y)});
                *(u32x2*)(B.Pp + (size_t)item * 4096 + (size_t)((nt * 2 + (mta >> 1)) * 64 + n + 16 * q) * 8 + 4 * (mta & 1)) = RW_PK(c0);
                *(u32x2*)(B.Pp + (size_t)item * 4096 + (size_t)((nt * 2 + (mtb >> 1)) * 64 + n + 16 * q) * 8 + 4 * (mtb & 1)) = RW_PK(c1);
                *(u32x2*)(B.Rp + (size_t)item * 4096 + (size_t)((nt * 2 + (mta >> 1)) * 64 + n + 16 * q) * 8 + 4 * (mta & 1)) = RW_PK(c2);
                *(u32x2*)(B.Rp + (size_t)item * 4096 + (size_t)((nt * 2 + (mtb >> 1)) * 64 + n + 16 * q) * 8 + 4 * (mtb & 1)) = RW_PK(c3);
                RW_LOADED(); }
            {
                const RwF2 b11 = rw_ld2(rw_slot(lds, 11), 16 * nt + l15, kq), b8 = rw_ld2(rw_slot(lds, 8), 16 * nt + l15, kq);
                const RwF2 a6a = rw_ld2(rw_slot(lds, 6), 16 * mta + l15, kq), a6b = rw_ld2(rw_slot(lds, 6), 16 * mtb + l15, kq), a7a = rw_ld2(rw_slot(lds, 7), 16 * mta + l15, kq), a7b = rw_ld2(rw_slot(lds, 7), 16 * mtb + l15, kq);
                RW_LOADED();
                f32x4 c0 = rw_mmf(a6a, b11, z4), c1 = rw_mmf(a6b, b11, z4); c0 = rw_mmf(a7a, b8, c0); c1 = rw_mmf(a7b, b8, c1);
                *(u32x2*)(B.Qp + (size_t)item * 4096 + (size_t)((nt * 4 + mta) * 64 + lane_now()) * 4) = RW_PK(c0);
                *(u32x2*)(B.Qp + (size_t)item * 4096 + (size_t)((nt * 4 + mtb) * 64 + lane_now()) * 4) = RW_PK(c1);
                RW_LOADED();
                const RwF2 a2a = rw_ld2(rw_slot(lds, 2), 16 * mta + l15, kq), a2b = rw_ld2(rw_slot(lds, 2), 16 * mtb + l15, kq), a3a = rw_ld2(rw_slot(lds, 3), 16 * mta + l15, kq), a3b = rw_ld2(rw_slot(lds, 3), 16 * mtb + l15, kq);
                RW_LOADED();
                f32x4 c2 = rw_mmf(a2a, b11, z4), c3 = rw_mmf(a2b, b11, z4); c2 = rw_mmf(a3a, b8, c2); c3 = rw_mmf(a3b, b8, c3);
                *(u32x2*)(B.CAT + (row0 + 16 * nt + n) * D + h * 64 + q * 16 + mta * 4) = RW_PK(c2);
                *(u32x2*)(B.CAT + (row0 + 16 * nt + n) * D + h * 64 + q * 16 + mtb * 4) = RW_PK(c3); }
        }
#if RW_DUPS
        __syncthreads();
#endif
        }
    }
}

constexpr int R2_SLOT = 2 * 8192 + 256, R2_LA = 7;
#define R2_WAITV(n) asm volatile("s_waitcnt vmcnt(" #n ")" ::: "memory")
struct R2Own { u32x2 qv[4]; u32x4 y0, y1; };
__device__ __forceinline__ void rwkv_r2(LAS unsigned char* lds, const RwBufs& B, int bx, int G, int wave, int nbh, bool dry = false) {
    const int lane = lane_now(), q = lane >> 4, n = lane & 15, wv = wave & 3;
#pragma unroll 1
    for (int bh = bx; bh < nbh; bh += G) {
        const int b = bh / RH, h = bh % RH;
        __syncthreads();
#define R2_ISSUE(c_) do { const int cc_ = (c_); const size_t item_ = (size_t)(b * 64 + cc_) * RH + h; LAS unsigned char* sl_ = lds + (cc_ & 7) * R2_SLOT; \
            const bf16_t* src_ = (wv < 2 ? B.Pp : B.Rp) + item_ * 4096 + (size_t)(wv & 1) * 2048 + lane_now() * 8; \
            _Pragma("unroll") for (int f = 0; f < 4; ++f) __builtin_amdgcn_global_load_lds((const unsigned*)(src_ + f * 512), (LAS unsigned*)(sl_ + (wv >> 1) * 8192 + (wv & 1) * 4096 + f * 1024), 16, 0, 0); \
            if (wv == 3 && lane_now() < 16) __builtin_amdgcn_global_load_lds((const unsigned*)(B.WL + item_ * 64 + lane_now() * 4), (LAS unsigned*)(sl_ + 2 * 8192), 16, 0, 0); } while (0)
#define R2_LANDED(c1_) do { const int af_ = (((c1_) + R2_LA - 1 < 63) ? ((c1_) + R2_LA - 1) : 63) - (c1_); \
            if (wv < 3) { if (af_ >= 6) R2_WAITV(24); else if (af_ == 5) R2_WAITV(20); else if (af_ == 4) R2_WAITV(16); else if (af_ == 3) R2_WAITV(12); else if (af_ == 2) R2_WAITV(8); else if (af_ == 1) R2_WAITV(4); else R2_WAITV(0); } \
            else        { if (af_ >= 6) R2_WAITV(30); else if (af_ == 5) R2_WAITV(25); else if (af_ == 4) R2_WAITV(20); else if (af_ == 3) R2_WAITV(15); else if (af_ == 2) R2_WAITV(10); else if (af_ == 1) R2_WAITV(5); else R2_WAITV(0); } } while (0)
#define R2_OWN(O_, c_) do { const int cc_ = (c_); const size_t item_ = (size_t)(b * 64 + cc_) * RH + h; const size_t rw0_ = (size_t)b * SEQ + cc_ * 64; \
            _Pragma("unroll") for (int mt = 0; mt < 4; ++mt) O_.qv[mt] = *(const u32x2*)(B.Qp + item_ * 4096 + (size_t)((wv * 4 + mt) * 64 + lane) * 4); \
            const bf16_t* yp_ = B.CAT + (rw0_ + 16 * wv + n) * D + h * 64 + q * 16; O_.y0 = *(const u32x4*)yp_; O_.y1 = *(const u32x4*)(yp_ + 8); } while (0)
        f32x4 S[4];
#pragma unroll
        for (int mt = 0; mt < 4; ++mt) S[mt] = (f32x4){0.f, 0.f, 0.f, 0.f};
        R2Own Oa, Ob, Oc, Od;
        if (wave >= 4) { R2_ISSUE(0); R2_ISSUE(1); R2_ISSUE(2); R2_ISSUE(3); R2_ISSUE(4); R2_ISSUE(5); R2_ISSUE(6); R2_LANDED(0); }
        else { R2_OWN(Oa, 0); R2_OWN(Ob, 1); R2_OWN(Oc, 2); R2_OWN(Od, 3); }
        __syncthreads();
#define R2_STEP(O_, c_) do { const int c = (c_); \
            if (wave >= 4) { if (c + R2_LA < 64) R2_ISSUE(c + R2_LA); if (c + 1 < 64) R2_LANDED(c + 1); } \
            else { \
                const size_t row0 = (size_t)b * SEQ + c * 64; const LAS unsigned char* sl = lds + (c & 7) * R2_SLOT; \
                bf16x8 pf[8], rf[8]; \
                _Pragma("unroll") for (int f = 0; f < 8; ++f) { pf[f] = *(const LAS bf16x8*)(sl + f * 1024 + lane * 16); rf[f] = *(const LAS bf16x8*)(sl + 8192 + f * 1024 + lane * 16); } \
                f32x4 wl[4]; \
                _Pragma("unroll") for (int mt = 0; mt < 4; ++mt) wl[mt] = *(const LAS f32x4*)(sl + 2 * 8192 + (16 * mt + 4 * q) * 4); \
                bf16_t* yp = B.CAT + (row0 + 16 * wv + n) * D + h * 64 + q * 16; \
                  \
                bf16x8 sh[2], sl2[2]; \
                _Pragma("unroll") for (int ks = 0; ks < 2; ++ks) { unsigned hw[4], lw[4]; \
                    _Pragma("unroll") for (int hf = 0; hf < 2; ++hf) { const f32x4 s = S[2 * ks + hf]; \
                        const unsigned h01 = cvt_pk_bf16(s[0], s[1]), h23 = cvt_pk_bf16(s[2], s[3]); \
                        hw[2 * hf] = h01; hw[2 * hf + 1] = h23; \
                        lw[2 * hf] = cvt_pk_bf16(s[0] - bflo(h01), s[1] - bfhi(h01)); lw[2 * hf + 1] = cvt_pk_bf16(s[2] - bflo(h23), s[3] - bfhi(h23)); } \
                    u32x4 hv = {hw[0], hw[1], hw[2], hw[3]}, lv = {lw[0], lw[1], lw[2], lw[3]}; \
                    sh[ks] = __builtin_bit_cast(bf16x8, hv); sl2[ks] = __builtin_bit_cast(bf16x8, lv); } \
                  \
                f32x4 ya[4]; \
                { const unsigned yw[8] = {O_.y0.x, O_.y0.y, O_.y0.z, O_.y0.w, O_.y1.x, O_.y1.y, O_.y1.z, O_.y1.w}; \
                  _Pragma("unroll") for (int mt = 0; mt < 4; ++mt) ya[mt] = (f32x4){bflo(yw[2 * mt]), bfhi(yw[2 * mt]), bflo(yw[2 * mt + 1]), bfhi(yw[2 * mt + 1])}; } \
                _Pragma("unroll") for (int mt = 0; mt < 4; ++mt) _Pragma("unroll") for (int ks = 0; ks < 2; ++ks) { \
                    ya[mt] = __builtin_amdgcn_mfma_f32_16x16x32_bf16(rf[mt * 2 + ks], sh[ks], ya[mt], 0, 0, 0); ya[mt] = __builtin_amdgcn_mfma_f32_16x16x32_bf16(rf[mt * 2 + ks], sl2[ks], ya[mt], 0, 0, 0); } \
                { u32x4 o0, o1; o0.x = cvt_pk_bf16(ya[0][0], ya[0][1]); o0.y = cvt_pk_bf16(ya[0][2], ya[0][3]); o0.z = cvt_pk_bf16(ya[1][0], ya[1][1]); o0.w = cvt_pk_bf16(ya[1][2], ya[1][3]); \
                  o1.x = cvt_pk_bf16(ya[2][0], ya[2][1]); o1.y = cvt_pk_bf16(ya[2][2], ya[2][3]); o1.z = cvt_pk_bf16(ya[3][0], ya[3][1]); o1.w = cvt_pk_bf16(ya[3][2], ya[3][3]); \
                  if (!dry) { *(u32x4*)yp = o0; *(u32x4*)(yp + 8) = o1; } } \
                  \
                f32x4 sn[4]; \
                _Pragma("unroll") for (int mt = 0; mt < 4; ++mt) { sn[mt] = (f32x4){bflo(O_.qv[mt].x), bfhi(O_.qv[mt].x), bflo(O_.qv[mt].y), bfhi(O_.qv[mt].y)} + wl[mt] * S[mt]; } \
                _Pragma("unroll") for (int mt = 0; mt < 4; ++mt) _Pragma("unroll") for (int ks = 0; ks < 2; ++ks) { \
                    sn[mt] = __builtin_amdgcn_mfma_f32_16x16x32_bf16(pf[mt * 2 + ks], sh[ks], sn[mt], 0, 0, 0); sn[mt] = __builtin_amdgcn_mfma_f32_16x16x32_bf16(pf[mt * 2 + ks], sl2[ks], sn[mt], 0, 0, 0); } \
                _Pragma("unroll") for (int mt = 0; mt < 4; ++mt) S[mt] = sn[mt]; \
                if (c + 4 < 64) R2_OWN(O_, c + 4);        \
            } \
            __syncthreads(); } while (0)
#pragma unroll 1
        for (int c0 = 0; c0 < 64; c0 += 4) { R2_STEP(Oa, c0); R2_STEP(Ob, c0 + 1); R2_STEP(Oc, c0 + 2); R2_STEP(Od, c0 + 3); }
    }
}

__device__ __forceinline__ void rwkv_r3(const RwBufs& B, int gw, int NGW, int nitems) {
    const int lane = lane_now(), q = lane >> 4, n = lane & 15;
#pragma unroll 1
    for (int item = gw; item < nitems; item += NGW) {
        const int b = item / (64 * RH), c = (item / RH) & 63, h = item % RH; const size_t row0 = (size_t)b * SEQ + c * 64;
        unsigned yw[4][8];
        u32x4 ga[4][2], gb[4][2];
#pragma unroll
        for (int wv = 0; wv < 4; ++wv) { const bf16_t* yp = B.CAT + (row0 + 16 * wv + n) * D + h * 64 + q * 16; const u32x4 y0 = *(const u32x4*)yp, y1 = *(const u32x4*)(yp + 8);
            yw[wv][0] = y0.x; yw[wv][1] = y0.y; yw[wv][2] = y0.z; yw[wv][3] = y0.w; yw[wv][4] = y1.x; yw[wv][5] = y1.y; yw[wv][6] = y1.z; yw[wv][7] = y1.w;
#pragma unroll
            for (int hf = 0; hf < 2; ++hf) { const size_t go = (size_t)item * 4096 + (size_t)(16 * wv + n) * 64 + q * 16 + 8 * hf; ga[wv][hf] = *(const u32x4*)(B.GA + go); gb[wv][hf] = *(const u32x4*)(B.GB + go); } }
        asm volatile("s_waitcnt vmcnt(0)" ::: "memory");
#pragma unroll
        for (int hf = 0; hf < 2; ++hf) {
            float s1[8], s2[8];
#pragma unroll
            for (int e4 = 0; e4 < 8; ++e4) { s1[e4] = 0.f; s2[e4] = 0.f; }
#pragma unroll
            for (int wv = 0; wv < 4; ++wv)
#pragma unroll
                for (int e2 = 0; e2 < 4; ++e2) { const unsigned w = yw[wv][4 * hf + e2]; const float ylo = bflo(w), yhi = bfhi(w); s1[2 * e2] += ylo; s2[2 * e2] += ylo * ylo; s1[2 * e2 + 1] += yhi; s2[2 * e2 + 1] += yhi * yhi; }
#pragma unroll
            for (int e4 = 0; e4 < 8; ++e4) {
#pragma unroll
                for (int o = 1; o < 16; o <<= 1) { s1[e4] += __shfl_xor(s1[e4], o); s2[e4] += __shfl_xor(s2[e4], o); }
                const float mean = s1[e4] * (1.f / 64.f), var = fmaxf(s2[e4] * (1.f / 64.f) - mean * mean, 0.f); s1[e4] = mean; s2[e4] = 1.0f / sqrtf(var + LNX_EPS); }
#pragma unroll
            for (int wv = 0; wv < 4; ++wv) { const u32x4 a0 = ga[wv][hf], b0 = gb[wv][hf];
                const unsigned aw[4] = {a0.x, a0.y, a0.z, a0.w}, bw[4] = {b0.x, b0.y, b0.z, b0.w};
#pragma unroll
                for (int e4 = 0; e4 < 8; ++e4) { const int e = 8 * hf + e4; const unsigned ywd = yw[wv][e >> 1];
                    const float yv = (e & 1) ? bfhi(ywd) : bflo(ywd), gaf = (e & 1) ? bfhi(aw[e4 >> 1]) : bflo(aw[e4 >> 1]), gbf = (e & 1) ? bfhi(bw[e4 >> 1]) : bflo(bw[e4 >> 1]);
                    const float o = (yv - s1[e4]) * s2[e4] * gaf + gbf; const int t = 16 * (e >> 2) + 4 * q + (e & 3);
                    B.CAT[(row0 + t) * D + h * 64 + 16 * wv + n] = f2bf(o); } }
        }
    }
}

constexpr int S5_TAB_EL = 128 * 256 + 256 * 384;
constexpr int S5_US = 264, S5_ZS = 65, S5_XS = 136;
typedef short bf16x4s __attribute__((ext_vector_type(4)));

__device__ __forceinline__ void s5_tables(const Args& a, LAS unsigned char* lds, bf16_t* TAB, float* A16T, int g, int part, int tid) {
    constexpr int CST = 68;
    LAS float* pwr = (LAS float*)lds; LAS float* pwi = pwr + 17 * 64;
    LAS float* bbr = pwi + 17 * 64; LAS float* bbi = bbr + 64 * 16;
    LAS float* crs = bbi + 64 * 16; LAS float* cis = crs + 16 * CST;
    LAS float* Kt = cis + 16 * CST;
    LAS float* zrs = Kt + 4096; LAS float* zis = zrs + 64;
    __syncthreads();
    {   const float dt = expf(a.in[I_LOG_DT][g]);
        for (int idx = tid; idx < 25 * 64; idx += NTHR) { const int t = idx >> 6, p = idx & 63; const float lr = a.in[I_LAM_RE][g * S5P + p], li = a.in[I_LAM_IM][g * S5P + p];
            const float tt = (t <= 16) ? (float)t : 16.0f * (float)(t - 16), m = expf(lr * dt * tt); float sn, cs; sincosf(li * dt * tt, &sn, &cs); const float vr = m * cs, vi = m * sn;
            if (t <= 16) { pwr[t * 64 + p] = vr; pwi[t * 64 + p] = vi; } else if (part == 0) { A16T[(g * 8 + (t - 17)) * 128 + p] = vr; A16T[(g * 8 + (t - 17)) * 128 + 64 + p] = vi; } }
        if (tid < 64) { const int p = tid; const float lr = a.in[I_LAM_RE][g * S5P + p], li = a.in[I_LAM_IM][g * S5P + p];
            float sn, cs, sh, ch; sincosf(li * dt, &sn, &cs); sincosf(0.5f * li * dt, &sh, &ch); const float em1 = expm1f(lr * dt);
            const float nre = em1 * cs - 2.0f * sh * sh, nim = (em1 + 1.0f) * sn, den = lr * lr + li * li;
            zrs[p] = (nre * lr + nim * li) / den; zis[p] = (nim * lr - nre * li) / den; } }
    for (int i = tid; i < 1024; i += NTHR) { crs[(i >> 6) * CST + (i & 63)] = a.in[I_C_RE][(size_t)g * 1024 + i]; cis[(i >> 6) * CST + (i & 63)] = a.in[I_C_IM][(size_t)g * 1024 + i]; }
    __syncthreads();
    for (int i = tid; i < 1024; i += NTHR) { const int p = i >> 4; const float zr = zrs[p], zi = zis[p], br = a.in[I_B_RE][(size_t)g * S5P * 16 + i], bi = a.in[I_B_IM][(size_t)g * S5P * 16 + i];
        bbr[i] = zr * br - zi * bi; bbi[i] = zr * bi + zi * br; }
    __syncthreads();
    for (int w = tid; w < (4 * part + 4) * 64; w += NTHR) { const int t = w >> 6, j = (w >> 2) & 15, jq = w & 3; f32x4 s4 = {0.f, 0.f, 0.f, 0.f};
#pragma unroll 2
        for (int p4 = 0; p4 < 64; p4 += 4) { const f32x4 cr = *(const LAS f32x4*)(crs + j * CST + p4), ci = *(const LAS f32x4*)(cis + j * CST + p4), ar = *(const LAS f32x4*)(pwr + t * 64 + p4), ai = *(const LAS f32x4*)(pwi + t * 64 + p4);
#pragma unroll
            for (int e = 0; e < 4; ++e) { const float wr = cr[e] * ar[e] - ci[e] * ai[e], wi = cr[e] * ai[e] + ci[e] * ar[e];
                const f32x4 br = *(const LAS f32x4*)(bbr + (p4 + e) * 16 + 4 * jq), bi = *(const LAS f32x4*)(bbi + (p4 + e) * 16 + 4 * jq);
                s4 += wr * br - wi * bi; } }
        if (t == 0 && (j >> 2) == jq) s4[j & 3] += a.in[I_S5D][g * 16 + j];
        *(LAS f32x4*)(Kt + (t << 8) + (j << 4) + 4 * jq) = s4; }
    __syncthreads();
    bf16_t* Gt = TAB + (size_t)g * S5_TAB_EL; bf16_t* MH = Gt + 128 * 256;
    for (int idx = part * 32 * 256 + tid; idx < (part + 1) * 32 * 256; idx += NTHR) { const int pp = idx >> 8, k = idx & 255, s = k >> 4, jp = k & 15, p = pp & 63, t = 15 - s;
        const float ar = pwr[t * 64 + p], ai = pwi[t * 64 + p], br = bbr[p * 16 + jp], bi = bbi[p * 16 + jp];
        Gt[idx] = f2bf(pp < 64 ? (ar * br - ai * bi) : (ar * bi + ai * br)); }
    for (int rr = 0; rr < 64; ++rr) { const int row = part * 64 + rr, t = row >> 4, j = row & 15;
        if (tid < 384) { const int k = tid; float v;
            if (k < 256) { const int s = k >> 4, jp = k & 15; v = (s <= t) ? Kt[((t - s) << 8) + (j << 4) + jp] : 0.f; }
            else { const int pp = k - 256, p = pp & 63; const float cr = crs[j * CST + p], ci = cis[j * CST + p], ar = pwr[(t + 1) * 64 + p], ai = pwi[(t + 1) * 64 + p];
                v = pp < 64 ? (cr * ar - ci * ai) : -(cr * ai + ci * ar); }
            MH[(size_t)row * 384 + k] = f2bf(v); } }
}

__device__ __forceinline__ float gelu_fast_(float x) { const float a2 = 1.5957691216057308f * (x + 0.044715f * x * x * x); return x * __builtin_amdgcn_rcpf(1.0f + __expf(-a2)); }

__device__ __forceinline__ void s5_chunked(const Args& a, LAS unsigned char* lds, const bf16_t* U, const bf16_t* TAB, const float* A16T, bf16_t* CAT, int bx, int G, int wave) {
    const int lane = lane_now(), l15 = lane & 15, kq = lane >> 4, q = kq, n = l15, tid = wave * 64 + lane;
    LAS unsigned char* Us0 = lds; LAS float* Zs = (LAS float*)(lds + 64 * S5_US * 2); LAS unsigned char* Xp = lds + 64 * S5_US * 2 + 128 * S5_ZS * 4;
    LAS unsigned char* Us1 = Xp + 64 * S5_XS * 2 + 8 * 128 * 4;
#define S5_UDMA(buf_, nb_) do { const int ln_ = lane_now(); if (ln_ < 32) { const bf16_t* src_ = UT + (size_t)((nb_) * 64 + 8 * wave) * 256 + ln_ * 8; \
        _Pragma("unroll") for (int i = 0; i < 8; ++i) __builtin_amdgcn_global_load_lds((const unsigned*)(src_ + (size_t)i * 256), (LAS unsigned*)((buf_) + (8 * wave + i) * (S5_US * 2)), 16, 0, 0); } } while (0)
#pragma unroll 1
    for (int item = bx; item < NB * S5G; item += G) {
        const int b = item / S5G, g = item % S5G;
        const bf16_t* UT = U + (size_t)(b * S5G + g) * SEQ * 16;
        const bf16_t* Gt = TAB + (size_t)g * S5_TAB_EL; const bf16_t* MH = Gt + 128 * 256;
        bf16x8 ga[8], mh[2][12];
#pragma unroll
        for (int ks = 0; ks < 8; ++ks) ga[ks] = *(const bf16x8*)(Gt + (size_t)(16 * wave + l15) * 256 + 32 * ks + 8 * kq);
        const int tau0 = wave, tau1 = 15 - wave;
#pragma unroll
        for (int ks = 0; ks < 12; ++ks) { mh[0][ks] = *(const bf16x8*)(MH + (size_t)(16 * tau0 + l15) * 384 + 32 * ks + 8 * kq); mh[1][ks] = *(const bf16x8*)(MH + (size_t)(16 * tau1 + l15) * 384 + 32 * ks + 8 * kq); }
        bf16x4s wg; { unsigned short w4[4];
#pragma unroll
            for (int e = 0; e < 4; ++e) w4[e] = f2bf(a.in[I_WGLU][(size_t)(g * 16 + 4 * kq + e) * 16 + l15]);
            wg = (bf16x4s){(short)w4[0], (short)w4[1], (short)w4[2], (short)w4[3]}; }
        const f32x4 bq = *(const f32x4*)(a.in[I_BGLU] + g * 16 + 4 * q);
        float xr = 0.f, xi = 0.f;
        float apr[8], api[8];
#pragma unroll
        for (int k8 = 0; k8 < 8; ++k8) { apr[k8] = A16T[(g * 8 + k8) * 128 + lane]; api[k8] = A16T[(g * 8 + k8) * 128 + 64 + lane]; }
        LAS float* Ex = (LAS float*)(Xp + 64 * S5_XS * 2);
        __syncthreads();
        S5_UDMA(Us0, 0);
#pragma unroll 1
        for (int nb = 0; nb < 4; ++nb) {
            LAS unsigned char* Us = (nb & 1) ? Us1 : Us0;
            asm volatile("s_waitcnt vmcnt(0)" ::: "memory");
            __syncthreads();
            if (nb + 1 < 4) { if (nb & 1) S5_UDMA(Us0, nb + 1); else S5_UDMA(Us1, nb + 1); }
#pragma unroll
            for (int nt = 0; nt < 4; ++nt) { f32x4 acc = {0.f, 0.f, 0.f, 0.f};
#pragma unroll
                for (int ks = 0; ks < 8; ++ks) acc = __builtin_amdgcn_mfma_f32_16x16x32_bf16(ga[ks], *(const LAS bf16x8*)(Us + (16 * nt + l15) * (S5_US * 2) + (32 * ks + 8 * kq) * 2), acc, 0, 0, 0);
#pragma unroll
                for (int r = 0; r < 4; ++r) Zs[(16 * wave + 4 * q + r) * S5_ZS + 16 * nt + n] = acc[r]; }
            __syncthreads();
            {   float lr8[8], li8[8]; float sr = 0.f, si = 0.f;
#pragma unroll
                for (int i = 0; i < 8; ++i) { lr8[i] = sr; li8[i] = si; const int c = 8 * wave + i; const float zr = Zs[lane * S5_ZS + c], zi = Zs[(64 + lane) * S5_ZS + c];
                    const float nr = apr[0] * sr - api[0] * si + zr, ni = apr[0] * si + api[0] * sr + zi; sr = nr; si = ni; }
                Ex[wave * 128 + lane] = sr; Ex[wave * 128 + 64 + lane] = si;
                __syncthreads();
                float cr = xr, ci = xi, myr = xr, myi = xi;
#pragma unroll
                for (int v = 0; v < 8; ++v) { if (v == wave) { myr = cr; myi = ci; }
                    const float er = Ex[v * 128 + lane], ei = Ex[v * 128 + 64 + lane]; const float nr = apr[7] * cr - api[7] * ci + er, ni = apr[7] * ci + api[7] * cr + ei; cr = nr; ci = ni; }
                xr = cr; xi = ci;
#pragma unroll
                for (int i = 0; i < 8; ++i) { float pr = lr8[i], pi = li8[i];
                    if (i == 0) { pr += myr; pi += myi; } else { pr += apr[i - 1] * myr - api[i - 1] * myi; pi += apr[i - 1] * myi + api[i - 1] * myr; }
                    const int c = 8 * wave + i; *(LAS bf16_t*)(Xp + c * (S5_XS * 2) + lane * 2) = f2bf(pr); *(LAS bf16_t*)(Xp + c * (S5_XS * 2) + (64 + lane) * 2) = f2bf(pi); } }
            __syncthreads();
#pragma unroll
            for (int mi = 0; mi < 2; ++mi) { const int tau = mi ? tau1 : tau0, kmax = tau >> 1;
#pragma unroll 1
                for (int nt = 0; nt < 4; ++nt) { f32x4 acc = {0.f, 0.f, 0.f, 0.f};
                    const LAS unsigned char* ub = Us + (16 * nt + l15) * (S5_US * 2) + (8 * kq) * 2; const LAS unsigned char* xb = Xp + (16 * nt + l15) * (S5_XS * 2) + (8 * kq) * 2;
#pragma unroll
                    for (int ks = 0; ks < 8; ++ks) if (ks <= kmax) acc = __builtin_amdgcn_mfma_f32_16x16x32_bf16(mh[mi][ks], *(const LAS bf16x8*)(ub + 64 * ks), acc, 0, 0, 0);
#pragma unroll
                    for (int ks = 0; ks < 4; ++ks) acc = __builtin_amdgcn_mfma_f32_16x16x32_bf16(mh[mi][8 + ks], *(const LAS bf16x8*)(xb + 64 * ks), acc, 0, 0, 0);
                    f32x4 yg; yg[0] = gelu_fast_(acc[0]); yg[1] = gelu_fast_(acc[1]); yg[2] = gelu_fast_(acc[2]); yg[3] = gelu_fast_(acc[3]);
                    const unsigned p01 = cvt_pk_bf16(yg[0], yg[1]), p23 = cvt_pk_bf16(yg[2], yg[3]); const u32x2 pk = {p01, p23};
                    const f32x4 z = __builtin_amdgcn_mfma_f32_16x16x16bf16_1k(wg, __builtin_bit_cast(bf16x4s, pk), bq, 0, 0, 0);
                    const int t = (nb * 64 + 16 * nt + n) * 16 + tau;
                    u32x2 o; o.x = cvt_pk_bf16(yg[0] * sigmoidf_(z[0]), yg[1] * sigmoidf_(z[1])); o.y = cvt_pk_bf16(yg[2] * sigmoidf_(z[2]), yg[3] * sigmoidf_(z[3]));
                    *(u32x2*)(CAT + ((size_t)b * SEQ + t) * D + g * 16 + 4 * q) = o; } }
        }
    }
}

constexpr int AT_KS = 72, AT_VS = 264;
__device__ __forceinline__ void attn_mfma(LAS unsigned char* lds, const bf16_t* Q, const bf16_t* KV, bf16_t* CAT, int bx, int G, int wave) {
    const int lane = lane_now(), l15 = lane & 15, kq = lane >> 4, q = kq, n = l15, tid = wave * 64 + lane;
    LAS unsigned char* Ks = lds; LAS unsigned char* Vt = lds + 256 * AT_KS * 2;
#pragma unroll 1
    for (int item = bx; item < NB * NH_MEM * 16; item += G) {
        const int b = item >> 6, h = (item >> 4) & 3, qb = item & 15;
        __syncthreads();
#pragma unroll
        for (int i = 0; i < 4; ++i) { const int idx = tid + 512 * i, key = idx >> 3, seg = idx & 7;
            const bf16_t* src = KV + (size_t)(b * MEML + key) * 512 + h * 64 + seg * 8;
            *(LAS u32x4*)(Ks + key * (AT_KS * 2) + seg * 16) = *(const u32x4*)src;
            const u32x4 vw = *(const u32x4*)(src + 256); const unsigned vv[4] = {vw.x, vw.y, vw.z, vw.w};
#pragma unroll
            for (int e = 0; e < 4; ++e) { *(LAS bf16_t*)(Vt + (seg * 8 + 2 * e) * (AT_VS * 2) + key * 2) = (bf16_t)(vv[e] & 0xffffu); *(LAS bf16_t*)(Vt + (seg * 8 + 2 * e + 1) * (AT_VS * 2) + key * 2) = (bf16_t)(vv[e] >> 16); } }
        __syncthreads();
#pragma unroll 1
        for (int tile = 0; tile < 2; ++tile) {
            const size_t qrow = (size_t)b * SEQ + qb * 256 + wave * 32 + tile * 16;
            bf16x8 qf[2];
#pragma unroll
            for (int ks = 0; ks < 2; ++ks) qf[ks] = *(const bf16x8*)(Q + (qrow + l15) * CM + h * 64 + 32 * ks + 8 * kq);
            f32x4 s[16];
#pragma unroll
            for (int kt = 0; kt < 16; ++kt) { f32x4 acc = {0.f, 0.f, 0.f, 0.f};
#pragma unroll
                for (int ks = 0; ks < 2; ++ks) acc = __builtin_amdgcn_mfma_f32_16x16x32_bf16(*(const LAS bf16x8*)(Ks + (16 * kt + l15) * (AT_KS * 2) + (32 * ks + 8 * kq) * 2), qf[ks], acc, 0, 0, 0);
                s[kt] = acc; if (kt & 1) asm volatile("" ::: "memory"); }
            float m = -3.0e38f;
#pragma unroll
            for (int kt = 0; kt < 16; ++kt) m = fmaxf(m, fmaxf(fmaxf(s[kt][0], s[kt][1]), fmaxf(s[kt][2], s[kt][3])));
            m = fmaxf(m, __shfl_xor(m, 16)); m = fmaxf(m, __shfl_xor(m, 32));
            float sum = 0.f; const float c = 0.125f * 1.4426950408889634f;
#pragma unroll
            for (int kt = 0; kt < 16; ++kt)
#pragma unroll
                for (int r = 0; r < 4; ++r) { const float p = __builtin_amdgcn_exp2f((s[kt][r] - m) * c); s[kt][r] = p; sum += p; }
            sum += __shfl_xor(sum, 16); sum += __shfl_xor(sum, 32);
            const float inv = 1.0f / sum;
            bf16x8 pf[8];
#pragma unroll
            for (int k2 = 0; k2 < 8; ++k2) { const u32x4 w = {cvt_pk_bf16(s[2 * k2][0], s[2 * k2][1]), cvt_pk_bf16(s[2 * k2][2], s[2 * k2][3]), cvt_pk_bf16(s[2 * k2 + 1][0], s[2 * k2 + 1][1]), cvt_pk_bf16(s[2 * k2 + 1][2], s[2 * k2 + 1][3])};
                pf[k2] = __builtin_bit_cast(bf16x8, w); }
#pragma unroll 1
            for (int dt = 0; dt < 4; ++dt) { f32x4 acc = {0.f, 0.f, 0.f, 0.f};
#pragma unroll
                for (int k2 = 0; k2 < 8; ++k2) { const LAS unsigned char* vp = Vt + (16 * dt + l15) * (AT_VS * 2) + (32 * k2 + 4 * kq) * 2;
                    const u32x2 v0 = *(const LAS u32x2*)vp, v1 = *(const LAS u32x2*)(vp + 32); const u32x4 vw = {v0.x, v0.y, v1.x, v1.y};
                    acc = __builtin_amdgcn_mfma_f32_16x16x32_bf16(__builtin_bit_cast(bf16x8, vw), pf[k2], acc, 0, 0, 0); }
                u32x2 o; o.x = cvt_pk_bf16(acc[0] * inv, acc[1] * inv); o.y = cvt_pk_bf16(acc[2] * inv, acc[3] * inv);
                *(u32x2*)(CAT + (qrow + n) * D + CS + h * 64 + 16 * dt + 4 * q) = o; }
        }
    }
}
constexpr int N_PHASES = 15;

__device__ __forceinline__ TrJob small_job(const Args& a, int j) {
    unsigned char* ws = a.ws; TrJob r;
    switch (j) {
    case 0: r = TrJob{a.in[I_WINA], (bf16_t*)(ws + WS_WINA), a.in[I_NORM_MIX], D, D, 0, 0, 0.f}; break;
    case 1: r = TrJob{a.in[I_WOUT], (bf16_t*)(ws + WS_WOUT0), nullptr, D, D, 0, 0, 0.f}; break;
    case 2: r = TrJob{a.in[I_WOUT] + (size_t)D * D, (bf16_t*)(ws + WS_WOUT1), nullptr, D, D, 0, 0, 0.f}; break;
    case 3: r = TrJob{a.in[I_WKV], (bf16_t*)(ws + WS_WKV), nullptr, D, 512, 0, 0, 0.f}; break;
    case 4: r = TrJob{a.in[I_WKV] + (size_t)D * 512, (bf16_t*)(ws + WS_WKV) + (size_t)512 * D, nullptr, D, 512, 0, 0, 0.f}; break;
    case 5: r = TrJob{a.in[I_FGATE], (bf16_t*)(ws + WS_WGU0), a.in[I_NORM_FFN], D, FD, 1, 0, 0.f}; break;
    case 6: r = TrJob{a.in[I_FUP], (bf16_t*)(ws + WS_WGU0), a.in[I_NORM_FFN], D, FD, 2, 0, 0.f}; break;
    case 7: r = TrJob{a.in[I_FDOWN], (bf16_t*)(ws + WS_WD0), nullptr, FD, D, 0, 0, 0.f}; break;
    case 8: r = TrJob{a.in[I_WINB], (bf16_t*)(ws + WS_WINB), a.in[I_NORM_MIX] + D, D, INB, 0, 0, 0.f}; break;
    case 9: r = TrJob{a.in[I_W2], (bf16_t*)(ws + WS_W2T), nullptr, 64, CS, 0, 0, 0.f}; break;
    case 10: r = TrJob{a.in[I_A2], (bf16_t*)(ws + WS_A2T), nullptr, 64, CS, 0, 0, 0.f}; break;
    default: r = TrJob{a.in[I_G2], (bf16_t*)(ws + WS_G2T), nullptr, 128, CS, 0, 0, 0.f}; break;
    }
    r.items = (r.K / 64) * (r.N / 32); r.f8s = 0.f; return r;
}
__device__ __forceinline__ TrJob moe_job(const Args& a, int j) {
    unsigned char* ws = a.ws; const int kind = j >> 3, e = j & 7; TrJob r;
    if (kind == 0) r = TrJob{a.in[I_MGATE] + (size_t)e * D * FE, (bf16_t*)(ws + WS_WMOE_GU + (size_t)e * 2 * FE * D), a.in[I_NORM_FFN] + D, D, FE, 1, 0, F8_WGU};
    else if (kind == 1) r = TrJob{a.in[I_MUP] + (size_t)e * D * FE, (bf16_t*)(ws + WS_WMOE_GU + (size_t)e * 2 * FE * D), a.in[I_NORM_FFN] + D, D, FE, 2, 0, F8_WGU};
    else r = TrJob{a.in[I_MDOWN] + (size_t)e * FE * D, (bf16_t*)(ws + WS_WMOE_D + (size_t)e * D * FE), nullptr, FE, D, 0, 0, F8_WD};
    r.items = (r.K / 64) * (r.N / 32); return r;
}

__device__ __forceinline__ void moe_convert(const Args& args, LAS float* scr, int cw, int ncw, int lane) {
    constexpr int JI = (D / 64) * (FE / 32), NGI = 24 * JI; static_assert((FE / 64) * (D / 32) == JI, "moe jobs differ in size");
    TrRegs R0, R1; int g0 = cw, g1 = cw + ncw;
    if (g0 < NGI) tr_load(moe_job(args, g0 / JI), g0 % JI, lane, R0);
    if (g1 < NGI) tr_load(moe_job(args, g1 / JI), g1 % JI, lane, R1);
#pragma unroll 1
    for (; g0 < NGI; g0 += 2 * ncw, g1 += 2 * ncw) {
        __builtin_amdgcn_sched_barrier(0);
        tr_fin(moe_job(args, g0 / JI), g0 % JI, scr, lane, R0);
        if (g0 + 2 * ncw < NGI) tr_load(moe_job(args, (g0 + 2 * ncw) / JI), (g0 + 2 * ncw) % JI, lane, R0);
        __builtin_amdgcn_sched_barrier(0);
        if (g1 < NGI) { tr_fin(moe_job(args, g1 / JI), g1 % JI, scr, lane, R1);
            if (g1 + 2 * ncw < NGI) tr_load(moe_job(args, (g1 + 2 * ncw) / JI), (g1 + 2 * ncw) % JI, lane, R1); } }
}

__device__ __forceinline__ void p0_transposes(const Args& args, LAS unsigned char* lds, int wave, int gw, int NGW) {
    unsigned char* ws = args.ws;
    LAS float* scr = (LAS float*)(lds + wave * 16384);
    {
        int base = 0;
        for (int j = 0; j < 12; ++j) { const TrJob jb = small_job(args, j);
            for (int it = gw - base; it < jb.items; it += NGW) { if (it >= 0) tr_item(jb.W, jb.K, jb.N, jb.WT, jb.gain, jb.mode, scr, it, lane_now()); }
            base = (base + jb.items) % NGW; }
    }
}
__device__ __forceinline__ void p0_memn(const Args& args, int gw, int NGW) {
    unsigned char* ws = args.ws;
    for (int r = gw; r < 2 * MROWS; r += NGW) { const int li = r / MROWS, row = r % MROWS;
        const f32x4* xr = (const f32x4*)(args.in[I_MEM] + (size_t)row * D) + lane_now(); const f32x4* gr = (const f32x4*)(args.in[I_NORM_MEM] + li * D) + lane_now();
        f32x4 v[4]; float s = 0.f;
#pragma unroll
        for (int j = 0; j < 4; ++j) { v[j] = xr[64 * j]; s += (v[j][0] * v[j][0] + v[j][1] * v[j][1]) + (v[j][2] * v[j][2] + v[j][3] * v[j][3]); }
        const float rs = rstd_of(wave_sum_fast(s));
        u32x2* o = (u32x2*)((bf16_t*)(ws + WS_MEMN) + ((size_t)li * MROWS + row) * D) + lane_now();
#pragma unroll
        for (int j = 0; j < 4; ++j) { const f32x4 g = gr[64 * j]; u32x2 w; w.x = cvt_pk_bf16(v[j][0] * rs * g[0], v[j][1] * rs * g[1]); w.y = cvt_pk_bf16(v[j][2] * rs * g[2], v[j][3] * rs * g[3]); o[64 * j] = w; }
    }
}
__device__ __forceinline__ void p0_xconv(const Args& args, bf16_t* HA, rss_t* rowss, int gw, int NGW) {
    for (int r = gw; r < T; r += 2 * NGW) {
        const int r2 = r + NGW; const bool has2 = r2 < T;
        const f32x4* xr = (const f32x4*)(args.in[I_X] + (size_t)r * D) + lane_now(); const f32x4* xq = (const f32x4*)(args.in[I_X] + (size_t)(has2 ? r2 : r) * D) + lane_now();
        f32x4 v[4], w[4]; float s = 0.f, s2 = 0.f;
#pragma unroll
        for (int j = 0; j < 4; ++j) { v[j] = xr[64 * j]; w[j] = xq[64 * j]; }
#pragma unroll
        for (int j = 0; j < 4; ++j) { s += (v[j][0] * v[j][0] + v[j][1] * v[j][1]) + (v[j][2] * v[j][2] + v[j][3] * v[j][3]); s2 += (w[j][0] * w[j][0] + w[j][1] * w[j][1]) + (w[j][2] * w[j][2] + w[j][3] * w[j][3]); }
        s = wave_sum_fast(s); s2 = wave_sum_fast(s2);
        if (lane_now() == 0) { rowss[r] = rss_fx(s); if (has2) rowss[r2] = rss_fx(s2); }
        u32x2* o = (u32x2*)(HA + (size_t)r * D) + lane_now(); u32x2* o2 = (u32x2*)(HA + (size_t)r2 * D) + lane_now();
#pragma unroll
        for (int j = 0; j < 4; ++j) { u32x2 p; p.x = cvt_pk_bf16(v[j][0], v[j][1]); p.y = cvt_pk_bf16(v[j][2], v[j][3]); o[64 * j] = p;
            if (has2) { u32x2 p2; p2.x = cvt_pk_bf16(w[j][0], w[j][1]); p2.y = cvt_pk_bf16(w[j][2], w[j][3]); o2[64 * j] = p2; } }
    }
}

template <int LO, int HI> __global__ void __launch_bounds__(NTHR, 2) fwd(Args args) {
    extern __shared__ __attribute__((aligned(16))) unsigned char lds_raw[];
    LAS unsigned char* lds = (LAS unsigned char*)lds_raw;
    volatile LAS unsigned* MISC = (volatile LAS unsigned*)(lds + LDS_MISC);
    const int wave = __builtin_amdgcn_readfirstlane(threadIdx.x >> 6);
#define lane (lane_now())
#define tid (wave * 64 + lane_now())
    const int G = gridDim.x, bx = blockIdx.x;
    const int gw = bx * NWAVES + wave, NGW = G * NWAVES;
    typedef __attribute__((address_space(1))) unsigned char gbyte_t;
    gbyte_t* wsg = (gbyte_t*)args.ws;
#define ws ((unsigned char*)wsg)
    unsigned* ctl = (unsigned*)(ws + WS_CTL);
    rss_t* rowss = (rss_t*)(ws + WS_CTL + CTL_ROWSS);
    float* X = args.out;
    bf16_t* HA = (bf16_t*)(ws + WS_HA);
    const int lo = args.ph_lo, hi = args.ph_hi;
    for (int u = tid; u < (LDS_BYTES - LDS_MISC) / 4; u += NTHR) ((LAS unsigned*)(lds + LDS_MISC))[u] = 0u;
    __syncthreads();
    XcdBarrier bar; bar.bar = ctl + CW_BAR; bar.x = 0; bar.st = nullptr; bar.wave = wave;
    const bool multi = (hi - lo) > 1;
    if (multi) bar = xcd_barrier_post(ctl + CW_BAR, MISC + 8);
#define IN(k) (LO <= (k) && (k) < HI && lo <= (k) && (k) < hi)
#define WS_FENCE() asm volatile("" : "+s"(wsg))
#ifdef TS_PHASE
    int nst = 0; volatile LAS unsigned long long* TSL = (volatile LAS unsigned long long*)(lds + LDS_MISC + 512);
#define STAMP() do { if (bx == 0 && threadIdx.x == 0) TSL[nst] = __builtin_amdgcn_s_memrealtime(); ++nst; } while (0)
#else
#define STAMP() do {} while (0)
#endif
    STAMP();
#ifdef TS_DUP
#define TS_T0() do { if (lane_now() == 0) *(volatile LAS unsigned long long*)(lds + LDS_MISC + 512 + 8 * wave) = __builtin_amdgcn_s_memrealtime(); } while (0)
#define TS_IDLE(k) do { if (((TS_DUP) >> (k)) & 1) { const unsigned long long t1_ = __builtin_amdgcn_s_memrealtime(), t0_ = *(volatile LAS unsigned long long*)(lds + LDS_MISC + 512 + 8 * wave); \
        const unsigned long long tgt_ = t1_ + (t1_ - t0_); while (__builtin_amdgcn_s_memrealtime() < tgt_) __builtin_amdgcn_s_sleep(8); } } while (0)
#else
#define TS_T0() do {} while (0)
#define TS_IDLE(k) do {} while (0)
#endif
    TS_T0();
#define SEAM(k) do { if (IN(k)) TS_IDLE(k); if (IN(k) && IN((k) + 1)) xcd_barrier(bar); TS_T0(); STAMP(); WS_FENCE(); } while (0)

    if (IN(0)) {
        if (bx < 4 * S5G) { s5_tables(args, lds, (bf16_t*)(ws + WS_S5TAB), (float*)(ws + WS_S5TAB + 12 * MiB), bx >> 2, bx & 3, tid); __syncthreads(); }
        p0_transposes(args, lds, wave, gw, NGW);
        p0_memn(args, gw, NGW);
        {
            constexpr int NTAB = 4 * S5G, KSH = 2; const int vw = (G > NTAB) ? NTAB + (G - NTAB) * KSH : G;
            if (G <= NTAB || bx < NTAB) p0_xconv(args, HA, rowss, gw, vw * NWAVES);
            else for (int j = 0; j < KSH; ++j) p0_xconv(args, HA, rowss, (NTAB + (bx - NTAB) * KSH + j) * NWAVES + wave, vw * NWAVES); }
#ifdef DUP_P0
        xcd_barrier(bar);
#if DUP_P0 & 1
        if (bx < 4 * S5G) { s5_tables(args, lds, (bf16_t*)(ws + WS_S5TAB), (float*)(ws + WS_S5TAB + 12 * MiB), bx >> 2, bx & 3, tid); __syncthreads(); }
#endif
#if DUP_P0 & 2
        p0_transposes(args, lds, wave, gw, NGW);
#endif
#if DUP_P0 & 4
        p0_memn(args, gw, NGW);
#endif
#if DUP_P0 & 8
        p0_xconv(args, HA, rowss, gw, NGW);
#endif
#endif
    }
    SEAM(0);

    if (IN(1)) {
        { pg8::DenseSched S; S.init(HA, ws + WS_WINA, T, D, D, G, bx);
          EpiInA E{(bf16_t*)(ws + WS_P0U), (bf16_t*)(ws + WS_P0Q), rowss};
          pg8::gemm_phase<EpiInA, pg8::DenseSched, true>(lds, D, S, E, 0, wave); }
        __syncthreads();
        { pg8::KvSched S; S.init(ws + WS_MEMN, ws + WS_WKV, G, (bx + 64) % G);
          EpiBf16 E{(bf16_t*)(ws + WS_KV), 512, nullptr, nullptr, 0};
          pg8::gemm_phase<EpiBf16, pg8::KvSched, true>(lds, D, S, E, 0, wave); }
    }
    SEAM(1);

    if (IN(2)) {
        bf16_t* CAT = (bf16_t*)(ws + WS_CAT);
        {
            const int n2 = NB * S5G - G;
            if (n2 > 0 && n2 < G) { if (bx >= n2) attn_mfma(lds, (const bf16_t*)(ws + WS_P0Q), (const bf16_t*)(ws + WS_KV), CAT, bx - n2, G - n2, wave); }
            else attn_mfma(lds, (const bf16_t*)(ws + WS_P0Q), (const bf16_t*)(ws + WS_KV), CAT, bx, G, wave); }
        __syncthreads();
#ifdef S5_NAIVE
        s5_naive(args, lds, (const bf16_t*)(ws + WS_P0U), CAT, bx, G, wave, lane);
#else
        s5_chunked(args, lds, (const bf16_t*)(ws + WS_P0U), (const bf16_t*)(ws + WS_S5TAB), (const float*)(ws + WS_S5TAB + 12 * MiB), CAT, bx, G, wave);
#endif
#ifdef DUP_P2
        xcd_barrier(bar);
#if DUP_P2 & 1
        attn_mfma(lds, (const bf16_t*)(ws + WS_P0Q), (const bf16_t*)(ws + WS_KV), CAT, bx, G, wave);
        __syncthreads();
#endif
#if DUP_P2 & 2
        s5_chunked(args, lds, (const bf16_t*)(ws + WS_P0U), (const bf16_t*)(ws + WS_S5TAB), (const float*)(ws + WS_S5TAB + 12 * MiB), CAT, bx, G, wave);
#endif
#endif
    }
    SEAM(2);

    if (IN(3)) {
        pg8::DenseSched S; S.init(ws + WS_CAT, ws + WS_WOUT0, T, D, D, G, bx);
        EpiRes E{args.in[I_X], nullptr, HA, rowss + T, nullptr};
        pg8::gemm_phase<EpiRes, pg8::DenseSched, true>(lds, D, S, E, 0, wave);
    }
    SEAM(3);

#ifdef DUP_P4
#pragma unroll 1
    for (int rep = 0; rep < 2; ++rep) {
#endif
    if (IN(4)) {
        pg8::DenseSched S; S.init(HA, ws + WS_WGU0, T, 2 * FD, D, G, bx);
        #ifdef DUP_P4
        int sk_ = (rep == 0) ? DUP_SKIP : 0; asm volatile("" : "+s"(sk_));
        EpiSwiglu E{(bf16_t*)(ws + WS_ACT0), FD, rowss + T, nullptr, sk_};
#else
        EpiSwiglu E{(bf16_t*)(ws + WS_ACT0), FD, rowss + T, nullptr, 0};
#endif
#ifdef DUP_P4
        if (rep == 0) pg8::gemm_phase<EpiSwiglu, pg8::DenseSched, true, false, DUP_VAR>(lds, D, S, E, 0, wave); else
#endif
        pg8::gemm_phase<EpiSwiglu, pg8::DenseSched, true>(lds, D, S, E, 0, wave);
    }
#ifdef DUP_P4
    if (rep == 0) xcd_barrier(bar); }
#endif
    SEAM(4);

    if (IN(5)) {
        pg8::DenseSched S; S.init(ws + WS_ACT0, ws + WS_WD0, T, D, FD, G, bx);
        EpiRes E{nullptr, HA, HA, rowss + 2 * T, nullptr};
        pg8::gemm_phase<EpiRes, pg8::DenseSched, true>(lds, FD, S, E, 0, wave);
    }
    SEAM(5);

    if (IN(6)) {
        pg8::DenseSched S; S.init(HA, ws + WS_WINB, T, INB, D, G, bx);
        EpiBf16 E{(bf16_t*)(ws + WS_P1), INB, rowss + 2 * T, (bf16_t*)(ws + WS_P0Q), SHIFTC};
        pg8::gemm_phase<EpiBf16, pg8::DenseSched, true>(lds, D, S, E, 0, wave);
#ifdef DUP_P6
        xcd_barrier(bar); pg8::gemm_phase<EpiBf16, pg8::DenseSched, true>(lds, D, S, E, 0, wave);
#endif
    }
    SEAM(6);

    RwBufs RB; RB.dbg = ctl + 16387;
#ifdef DBG_RWKV
    RB.Pp = (bf16_t*)(ws + 78 * MiB); RB.Qp = (bf16_t*)(ws + 84 * MiB); RB.Rp = (bf16_t*)(ws + 90 * MiB); RB.GA = (bf16_t*)(ws + 96 * MiB); RB.GB = (bf16_t*)(ws + 102 * MiB); RB.WL = (float*)(ws + 108 * MiB);
    RB.CAT = (bf16_t*)(ws + 110 * MiB);
    constexpr int RW_ITEMS = 64 * RH, RW_BH = RH;
#else
    { unsigned char* ob = (unsigned char*)args.out; RB.Pp = (bf16_t*)ob; RB.WL = (float*)(ob + 48 * MiB); RB.XL = (bf16_t*)(ob + 50 * MiB); }
    RB.Qp = (bf16_t*)(ws + WS_RQP); RB.Rp = (bf16_t*)(ws + WS_RRP); RB.GA = (bf16_t*)(ws + WS_RGA); RB.GB = (bf16_t*)(ws + WS_RGB);
    RB.CAT = (bf16_t*)(ws + WS_CAT);
    constexpr int RW_ITEMS = NB * 64 * RH, RW_BH = NB * RH;
#endif
#ifdef DBG_RWKV
    RB.XL = (bf16_t*)(ws + WS_RXL);
#endif
    RB.P1 = (const bf16_t*)(ws + WS_P1); RB.w2T = (const bf16_t*)(ws + WS_W2T); RB.a2T = (const bf16_t*)(ws + WS_A2T); RB.g2T = (const bf16_t*)(ws + WS_G2T);
    if (IN(7)) {
        rwkv_xpre(args, RB, bx, G, wave);
        xcd_barrier(bar);
#ifdef DBG_RWKV
        rwkv_prep(args, lds, (const bf16_t*)(ws + WS_P1), (bf16_t*)(ws + 432 * MiB), (bf16_t*)(ws + 480 * MiB), (bf16_t*)(ws + 128 * MiB), (bf16_t*)(ws + 2 * MiB), bx, G, tid);
        __syncthreads();
#endif
        rwkv_r1(args, lds, RB, bx, G, wave, RW_ITEMS);
#ifdef DUP_R1
        xcd_barrier(bar); rwkv_r1(args, lds, RB, bx, G, wave, RW_ITEMS);
#endif
    }
    SEAM(7);
    if (IN(8)) {
#ifdef DUP_R2
        rwkv_r2(lds, RB, bx, G, wave, RW_BH, true); xcd_barrier(bar);
#endif
        rwkv_r2(lds, RB, bx, G, wave, RW_BH);
        { const int nr2 = (RW_BH < G) ? RW_BH : G;
          if (nr2 < G) { if (bx >= nr2) { attn_mfma(lds, (const bf16_t*)(ws + WS_P0Q), (const bf16_t*)(ws + WS_KV) + (size_t)MROWS * 512, (bf16_t*)(ws + WS_CAT), bx - nr2, G - nr2, wave);
              __syncthreads(); moe_convert(args, (LAS float*)(lds + wave * 16384), (bx - nr2) * NWAVES + wave, (G - nr2) * NWAVES, lane);
          } }
          else { __syncthreads(); attn_mfma(lds, (const bf16_t*)(ws + WS_P0Q), (const bf16_t*)(ws + WS_KV) + (size_t)MROWS * 512, (bf16_t*)(ws + WS_CAT), bx, G, wave);
                 __syncthreads(); moe_convert(args, (LAS float*)(lds + wave * 16384), gw, NGW, lane); } }
    }
    SEAM(8);
    if (IN(9)) { rwkv_r3(RB, gw, NGW, RW_ITEMS);
    }
    SEAM(9);

    if (IN(10)) {
#ifdef DBG_RWKV
        {   const bf16_t* ref = (const bf16_t*)(ws + WS_CAT); const bf16_t* tst = (const bf16_t*)(ws + 110 * MiB); float sd = 0.f, sr = 0.f;
            for (int r = gw; r < SEQ; r += NGW) {
#pragma unroll
                for (int i = 0; i < 12; ++i) { const float a = bf2f(ref[(size_t)r * D + lane + 64 * i]), b = bf2f(tst[(size_t)r * D + lane + 64 * i]); sd += (a - b) * (a - b); sr += a * a; } }
            sd = wave_sum(sd); sr = wave_sum(sr);
            if (lane == 0) { atomicAdd((float*)(ctl + 16384), sd); atomicAdd((float*)(ctl + 16385), sr); }
            unsigned bad = 0u;
            for (int i = gw * 64 + lane; i < 768 * 64; i += NGW * 64) { const float v = RB.WL[i]; if (!(v - v == 0.f)) bad |= 1u; }
            for (int i = gw * 64 + lane; i < 768 * 4096; i += NGW * 64) { float v = bf2f(RB.GA[i]); if (!(v - v == 0.f)) bad |= 2u; v = bf2f(RB.GB[i]); if (!(v - v == 0.f)) bad |= 4u;
                v = bf2f(RB.Pp[i]); if (!(v - v == 0.f)) bad |= 8u; v = bf2f(RB.Qp[i]); if (!(v - v == 0.f)) bad |= 16u; v = bf2f(RB.Rp[i]); if (!(v - v == 0.f)) bad |= 32u; }
            for (int r = gw; r < SEQ; r += NGW) for (int i = 0; i < 12; ++i) { const float v = bf2f(tst[(size_t)r * D + lane + 64 * i]); if (!(v - v == 0.f)) bad |= 64u; }
            if (bad) atomicOr(ctl + 16386, bad); }
#endif
        pg8::DenseSched S; S.init(ws + WS_CAT, ws + WS_WOUT1, T, D, D, G, bx);
        EpiRes E{nullptr, HA, (bf16_t*)(ws + WS_X3), rowss + 3 * T, (unsigned char*)(ws + WS_HA2)};
        pg8::gemm_phase<EpiRes, pg8::DenseSched, true>(lds, D, S, E, 0, wave);
    }
    SEAM(10);

    if (IN(11)) {
        __syncthreads();
        moe_router(args, (const bf16_t*)(ws + WS_X3), ctl, ws, gw, NGW, lane, lds, wave);
    }
    SEAM(11);

    if constexpr (HI > 12 && LO < 14) {
#pragma unroll 1
    for (int pass = args.pass_lo; pass < args.pass_hi; ++pass) {
        constexpr int pg = 12, pd = 13;
        LAS int* tab = (LAS int*)(lds + LDS_MISC + 256);
        if (IN(pg) || IN(pd)) {
            __syncthreads();
            if (tid == 0) { int acc = 0;
#pragma unroll 1
                for (int e = 0; e < 8; ++e) { const int c = (int)__hip_atomic_load(ctl + CW_CNT + 64 * e, __ATOMIC_RELAXED, __HIP_MEMORY_SCOPE_AGENT); tab[e] = acc; tab[16 + e] = c; acc += (c + 255) >> 8; } tab[8] = acc; }
            __syncthreads();
        }
        const int ntile = (IN(pg) || IN(pd)) ? __builtin_amdgcn_readfirstlane(tab[8]) : 0;
        const int tile0 = 128 * pass, nt_pass = min(128, ntile - tile0);
        if (IN(pg) && nt_pass > 0) {
            MoeGuSched S; S.o.init(nt_pass, 2 * FE / 256, G, bx); S.A = (const char*)(ws + WS_HA2); S.W = (const char*)(ws + WS_WMOE_GU); S.list = (const int*)(ws + WS_ROUTE2 + RT_LIST); S.tab = tab; S.tile0 = tile0;
            EpiSwigluF8 E{(unsigned char*)(ws + WS_MACT), FE, (const float*)(ws + WS_ROUTE2 + RT_LRSTD)};
            pg8::gemm_phase<EpiSwigluF8, MoeGuSched, true, true>(lds, D / 2, S, E, 0, wave);
#ifdef DUP_GU
            if (pass == 0) { xcd_barrier(bar); pg8::gemm_phase<EpiSwigluF8, MoeGuSched, true, true>(lds, D / 2, S, E, 0, wave); }
#endif
        }
        SEAM(pg);
        if (IN(pd) && nt_pass > 0 && pass == 2) {
            MoeDownTailSched S; S.o.init(nt_pass, 4 * TAIL_SPLIT, G, bx); S.A = (const char*)(ws + WS_MACT); S.W = (const char*)(ws + WS_WMOE_D); S.tab = tab; S.tile0 = tile0;
            EpiSlotPart E{(bf16_t*)(ws + WS_TAILP)};
            pg8::gemm_phase<EpiSlotPart, MoeDownTailSched, true, true>(lds, TAIL_K / 2, S, E, FE / 2, wave);
        } else if (IN(pd) && nt_pass > 0) {
            MoeDownSched S; S.o.init(nt_pass, D / 256, G, bx); S.A = (const char*)(ws + WS_MACT); S.W = (const char*)(ws + WS_WMOE_D); S.tab = tab; S.tile0 = tile0;
            EpiSlot E{(bf16_t*)(ws + WS_YSLOT)};
            pg8::gemm_phase<EpiSlot, MoeDownSched, true, true>(lds, FE / 2, S, E, 0, wave);
#ifdef DUP_DN
            if (pass == 0) { xcd_barrier(bar); pg8::gemm_phase<EpiSlot, MoeDownSched, true, true>(lds, FE / 2, S, E, 0, wave); }
#endif
        }
        if (IN(pd)) TS_IDLE(pd);
        if (IN(pd) && (pass + 1 < args.pass_hi || IN(14))) xcd_barrier(bar);
        TS_T0(); STAMP(); WS_FENCE();
    }
    }

    if (IN(14)) {
        LAS int* tab = (LAS int*)(lds + LDS_MISC + 256);
        __syncthreads();
        if (tid == 0) { int acc = 0;
#pragma unroll 1
            for (int e = 0; e < 8; ++e) { const int c = (int)__hip_atomic_load(ctl + CW_CNT + 64 * e, __ATOMIC_RELAXED, __HIP_MEMORY_SCOPE_AGENT); tab[e] = acc; acc += (c + 255) >> 8; } }
        __syncthreads();
        const int* toke = (const int*)(ws + WS_ROUTE2 + RT_TOKE); const int* tokr = (const int*)(ws + WS_ROUTE2 + RT_TOKR); const float* tokw = (const float*)(ws + WS_ROUTE2 + RT_TOKW);
        const bf16_t* Y = (const bf16_t*)(ws + WS_YSLOT); const bf16_t* X3 = (const bf16_t*)(ws + WS_X3); const bf16_t* TP = (const bf16_t*)(ws + WS_TAILP);
        int ms0 = 0, ms1 = 0; float mw0 = 0.f, mw1 = 0.f;
        { const int r = gw + NGW * lane; if (r < T) { const int e0 = toke[2 * r], e1 = toke[2 * r + 1]; mw0 = tokw[2 * r]; mw1 = tokw[2 * r + 1]; ms0 = tab[e0] * 256 + tokr[2 * r]; ms1 = tab[e1] * 256 + tokr[2 * r + 1]; } }
        const int nrow = (gw < T) ? (T - 1 - gw) / NGW + 1 : 0;
        f32x4 gn[4];
#pragma unroll
        for (int j = 0; j < 4; ++j) gn[j] = ((const f32x4*)(args.in[I_NORM_FINAL]) + lane)[64 * j];
        struct FinIn { u32x2 x[4], y0[4], y1[4]; };
#define FIN_LOAD(I_, i_) do { const int r_ = gw + NGW * (i_); const int s0_ = __builtin_amdgcn_readlane(ms0, (i_)), s1_ = __builtin_amdgcn_readlane(ms1, (i_)); \
            const u32x2* xr_ = (const u32x2*)(X3 + (size_t)r_ * D) + lane; \
            const u32x2* y0_ = (const u32x2*)((s0_ < 65536) ? Y + (size_t)s0_ * D : TP + (size_t)(s0_ - 65536) * D) + lane; \
            const u32x2* y1_ = (const u32x2*)((s1_ < 65536) ? Y + (size_t)s1_ * D : TP + (size_t)(s1_ - 65536) * D) + lane; \
            _Pragma("unroll") for (int j = 0; j < 4; ++j) { I_.x[j] = xr_[64 * j]; I_.y0[j] = y0_[64 * j]; I_.y1[j] = y1_[64 * j]; } } while (0)
#define FIN_ROW(I_, i_) do { const int r_ = gw + NGW * (i_); const int s0_ = __builtin_amdgcn_readlane(ms0, (i_)), s1_ = __builtin_amdgcn_readlane(ms1, (i_)); \
            const float w0_ = __builtin_bit_cast(float, __builtin_amdgcn_readlane(__builtin_bit_cast(int, mw0), (i_))), w1_ = __builtin_bit_cast(float, __builtin_amdgcn_readlane(__builtin_bit_cast(int, mw1), (i_))); \
            f32x4 v[4]; float s = 0.f; \
            _Pragma("unroll") for (int j = 0; j < 4; ++j) { const u32x2 a = I_.x[j], b0 = I_.y0[j], b1 = I_.y1[j]; \
                v[j] = (f32x4){bflo(a.x) + w0_ * bflo(b0.x) + w1_ * bflo(b1.x), bfhi(a.x) + w0_ * bfhi(b0.x) + w1_ * bfhi(b1.x), bflo(a.y) + w0_ * bflo(b0.y) + w1_ * bflo(b1.y), bfhi(a.y) + w0_ * bfhi(b0.y) + w1_ * bfhi(b1.y)}; } \
            _Pragma("unroll 1") for (int kk = 0; kk < 2; ++kk) { const int sl = kk ? s1_ : s0_; const float wk = kk ? w1_ : w0_; \
                if (sl >= 65536) { _Pragma("unroll 1") for (int sp = 1; sp < TAIL_SPLIT; ++sp) { const u32x2* yp = (const u32x2*)(TP + ((size_t)sp * 2048 + (sl - 65536)) * D) + lane; \
                    _Pragma("unroll") for (int j = 0; j < 4; ++j) { const u32x2 a = yp[64 * j]; v[j][0] += wk * bflo(a.x); v[j][1] += wk * bfhi(a.x); v[j][2] += wk * bflo(a.y); v[j][3] += wk * bfhi(a.y); } } } } \
            _Pragma("unroll") for (int j = 0; j < 4; ++j) s += (v[j][0] * v[j][0] + v[j][1] * v[j][1]) + (v[j][2] * v[j][2] + v[j][3] * v[j][3]); \
            const float rs = rstd_of(wave_sum_fast(s)); f32x4* o = (f32x4*)(X + (size_t)r_ * D) + lane; \
            _Pragma("unroll") for (int j = 0; j < 4; ++j) o[64 * j] = v[j] * rs * gn[j]; } while (0)
        FinIn Fa, Fb;
        if (nrow > 0) FIN_LOAD(Fa, 0);
#pragma unroll 1
        for (int i = 0; i < nrow; i += 2) {
            if (i + 1 < nrow) FIN_LOAD(Fb, i + 1);
            __builtin_amdgcn_sched_barrier(0);
            FIN_ROW(Fa, i);
            if (i + 2 < nrow) FIN_LOAD(Fa, i + 2);
            __builtin_amdgcn_sched_barrier(0);
            if (i + 1 < nrow) FIN_ROW(Fb, i + 1);
        }
#undef FIN_LOAD
#undef FIN_ROW
        TS_IDLE(14);
    }
#undef IN
#undef SEAM
#undef lane
#undef tid
#undef ws
}

#ifdef DBG_RWKV
__global__ void __launch_bounds__(NTHR, 2) dbg_naive(Args args) {
    extern __shared__ __attribute__((aligned(16))) unsigned char lds_raw[];
    LAS unsigned char* lds = (LAS unsigned char*)lds_raw; unsigned char* ws = args.ws;
    const int wave = __builtin_amdgcn_readfirstlane(threadIdx.x >> 6);
    rwkv_naive(args, lds, (const bf16_t*)(ws + WS_P1), (const bf16_t*)(ws + 432 * MiB), (const bf16_t*)(ws + 480 * MiB), (const bf16_t*)(ws + 128 * MiB), (const bf16_t*)(ws + 2 * MiB), (bf16_t*)(ws + WS_CAT), blockIdx.x, gridDim.x, wave, lane_now());
}
#endif

#ifndef N_LAUNCH_MODE
#define N_LAUNCH_MODE 1
#endif
extern "C" void kernel_launch(void* const* d_in, const int* in_sizes, int n_in, void* d_out, int out_size, void* d_ws, size_t ws_size, hipStream_t stream) {
    static int grid = 0;
    if (grid == 0) {
        if (n_in != N_IN || in_sizes[0] != T * D || out_size != T * D || ws_size < WS_NEED) {
            fprintf(stderr, "kernel_launch: unexpected shapes/workspace: n_in %d in0 %d out %d ws %zu (need %zu)\n", n_in, n_in > 0 ? in_sizes[0] : -1, out_size, ws_size, (size_t)WS_NEED); grid = -1; return; }
        int dev = 0, cus = 0;
        if (hipGetDevice(&dev) != hipSuccess || hipDeviceGetAttribute(&cus, hipDeviceAttributeMultiprocessorCount, dev) != hipSuccess) { grid = -1; return; }
        bool ok = true;
#define SETATTR(K) ok = ok && (hipFuncSetAttribute((const void*)K, hipFuncAttributeMaxDynamicSharedMemorySize, LDS_BYTES) == hipSuccess)
#if N_LAUNCH_MODE == 1
        SETATTR((fwd<0, N_PHASES>));
#else
        SETATTR((fwd<0, 1>)); SETATTR((fwd<1, 2>)); SETATTR((fwd<2, 3>)); SETATTR((fwd<3, 4>)); SETATTR((fwd<4, 5>)); SETATTR((fwd<5, 6>)); SETATTR((fwd<6, 7>)); SETATTR((fwd<7, 8>));
        SETATTR((fwd<8, 9>)); SETATTR((fwd<9, 10>)); SETATTR((fwd<10, 11>)); SETATTR((fwd<11, 12>)); SETATTR((fwd<12, 13>)); SETATTR((fwd<13, 14>)); SETATTR((fwd<14, 15>));
#endif
        if (!ok) { fprintf(stderr, "kernel_launch: hipFuncSetAttribute failed\n"); grid = -1; return; }
        (void)hipGetLastError();
        grid = cus;
    }
    if (grid < 0) return;
    if (hipMemsetAsync((char*)d_ws + WS_CTL, 0, CTL_BYTES, stream) != hipSuccess) return;
    Args a{};
    for (int i = 0; i < N_IN; ++i) a.in[i] = (const float*)d_in[i];
    a.out = (float*)d_out; a.ws = (unsigned char*)d_ws;
#if N_LAUNCH_MODE == 1
    a.ph_lo = 0; a.ph_hi = N_PHASES; a.pass_lo = 0; a.pass_hi = 3;
    hipLaunchKernelGGL((fwd<0, N_PHASES>), dim3(grid), dim3(NTHR), LDS_BYTES, stream, a);
#else
#define LAUNCH1(P) do { a.ph_lo = (P); a.ph_hi = (P) + 1; hipLaunchKernelGGL((fwd<(P), (P) + 1>), dim3(grid), dim3(NTHR), LDS_BYTES, stream, a); } while (0)
    LAUNCH1(0); LAUNCH1(1); LAUNCH1(2); LAUNCH1(3); LAUNCH1(4); LAUNCH1(5); LAUNCH1(6); LAUNCH1(7);
#ifdef DBG_RWKV
    hipLaunchKernelGGL(dbg_naive, dim3(grid), dim3(NTHR), 4096, stream, a); LAUNCH1(8);
#else
    LAUNCH1(8);
#endif
    LAUNCH1(9); LAUNCH1(10); LAUNCH1(11);
    for (int pass = 0; pass < 5; ++pass) { a.pass_lo = pass; a.pass_hi = pass + 1; LAUNCH1(12); LAUNCH1(13); }
    LAUNCH1(14);
#endif
}
```

```cpp
#include <hip/hip_runtime.h>
#include <cstdio>
#include <cstdint>

#define LAS __attribute__((address_space(3)))
#define GAS __attribute__((address_space(1)))
typedef unsigned short bf16_t;
typedef short bf16x8 __attribute__((ext_vector_type(8)));
typedef short bf16x4 __attribute__((ext_vector_type(4)));
typedef float f32x4 __attribute__((ext_vector_type(4)));
typedef float f32x2 __attribute__((ext_vector_type(2)));
typedef unsigned u32x4 __attribute__((ext_vector_type(4)));
typedef unsigned u32x2 __attribute__((ext_vector_type(2)));

constexpr int NB = 8, SEQ = 4096, T = NB * SEQ, D = 1024, MEML = 256, MROWS = NB * MEML;
constexpr int CS = 768, CM = 256, NH_MEM = 4;
constexpr int S5G = 48, S5J = 16, S5P = 64;
constexpr int RH = 12, RN = 64, SHIFTC = 2560, INB = 2816;
constexpr int FD = 2816, NE = 8, FE = 3584;
constexpr float RMS_EPS = 1e-6f, LNX_EPS = 64e-5f;
constexpr int NWAVES = 8, NTHR = 512;

enum { I_X = 0, I_MEM, I_NORM_MIX, I_NORM_MEM, I_WKV, I_WOUT, I_NORM_FFN, I_NORM_FINAL, I_WINA, I_LAM_RE, I_LAM_IM, I_LOG_DT, I_B_RE, I_B_IM, I_C_RE, I_C_IM,
       I_S5D, I_WGLU, I_BGLU, I_FGATE, I_FUP, I_FDOWN, I_WINB, I_MU, I_W0, I_W2, I_A0, I_A2, I_G2, I_KK, I_KA, I_RK, I_LNXW, I_LNXB, I_WR, I_BR, I_MGATE, I_MUP, I_MDOWN, N_IN };

constexpr size_t MiB = 1u << 20;
constexpr size_t WS_CTL = 0, CTL_BYTES = 2 * MiB;
constexpr size_t WS_HA = 2 * MiB;
constexpr size_t WS_ROUTE = 66 * MiB;
constexpr size_t WS_WOUT1 = 70 * MiB;
constexpr size_t WS_KV = 72 * MiB;
constexpr size_t WS_LORA = 76 * MiB;
constexpr size_t WS_W2T = WS_LORA, WS_A2T = WS_LORA + 96 * 1024, WS_G2T = WS_LORA + 192 * 1024;
constexpr size_t WS_WINA = 78 * MiB, WS_WOUT0 = 80 * MiB, WS_WKV = 82 * MiB  , WS_WGU0 = 84 * MiB  , WS_WD0 = 95 * MiB  ,
                 WS_WINB = 101 * MiB  , WS_MEMN = 107 * MiB  , WS_S5TAB = 115 * MiB  ;
constexpr size_t WS_P0U = 128 * MiB;
constexpr size_t WS_P0Q = 176 * MiB;
constexpr size_t WS_CAT = 192 * MiB;
constexpr size_t WS_ACT0 = 256 * MiB;
constexpr size_t WS_P1 = 256 * MiB;
constexpr size_t WS_RPP = 2 * MiB, WS_RWL = 50 * MiB  , WS_RQP = 128 * MiB, WS_RRP = 432 * MiB, WS_RGA = 480 * MiB, WS_RGB = 78 * MiB, WS_RXL = 52 * MiB  , WS_X3 = 340 * MiB  ;
constexpr size_t WS_WMOE_GU = 256 * MiB;
constexpr size_t WS_WMOE_D = 312 * MiB;
constexpr size_t WS_HA2 = 468 * MiB;
constexpr size_t WS_ROUTE2 = 2 * MiB;
constexpr size_t WS_MACT = 6 * MiB;
constexpr size_t WS_YSLOT = 118 * MiB;
constexpr size_t WS_TAILP = 424 * MiB;
constexpr size_t WS_END = 532 * MiB, WS_NEED = 532 * MiB;
constexpr int CW_BAR = 4096;
constexpr int CW_CNT = 8192;
constexpr size_t CTL_ROWSS = 1 * MiB;
constexpr size_t RT_LIST = 0, RT_LRSTD = 1 * MiB, RT_TOKE = 2 * MiB  , RT_TOKR = 2 * MiB + 256 * 1024, RT_TOKW = 2 * MiB + 512 * 1024;

constexpr int LDS_STAGE = 131072, LDS_BYTES = 147456, LDS_MISC = LDS_BYTES - 1024;

typedef __bf16 bf16v2_t __attribute__((ext_vector_type(2)));
__device__ __forceinline__ unsigned cvt_pk_bf16(float lo, float hi) { const f32x2 v = {lo, hi}; const bf16v2_t b = __builtin_convertvector(v, bf16v2_t); return __builtin_bit_cast(unsigned, b); }
__device__ __forceinline__ float bf2f(unsigned short b) { return __uint_as_float(((unsigned)b) << 16); }
__device__ __forceinline__ float bflo(unsigned w) { return __uint_as_float(w << 16); }
__device__ __forceinline__ float bfhi(unsigned w) { return __uint_as_float(w & 0xffff0000u); }
__device__ __forceinline__ bf16_t f2bf(float f) { return (bf16_t)(cvt_pk_bf16(f, 0.f) & 0xffffu); }
__device__ __forceinline__ float wave_sum(float v) {
#pragma unroll
    for (int o = 1; o < 64; o <<= 1) v += __shfl_xor(v, o);
    return v;
}
__device__ __forceinline__ float wave_sum_fast(float v) {
    v += __builtin_bit_cast(float, __builtin_amdgcn_update_dpp(0, __builtin_bit_cast(int, v), 0xB1, 0xf, 0xf, false));
    v += __builtin_bit_cast(float, __builtin_amdgcn_update_dpp(0, __builtin_bit_cast(int, v), 0x4E, 0xf, 0xf, false));
    v += __builtin_bit_cast(float, __builtin_amdgcn_update_dpp(0, __builtin_bit_cast(int, v), 0x141, 0xf, 0xf, false));
    v += __builtin_bit_cast(float, __builtin_amdgcn_update_dpp(0, __builtin_bit_cast(int, v), 0x140, 0xf, 0xf, false));
    const int vi = __builtin_bit_cast(int, v);
    return (__builtin_bit_cast(float, __builtin_amdgcn_readlane(vi, 0)) + __builtin_bit_cast(float, __builtin_amdgcn_readlane(vi, 16))) + (__builtin_bit_cast(float, __builtin_amdgcn_readlane(vi, 32)) + __builtin_bit_cast(float, __builtin_amdgcn_readlane(vi, 48)));
}
__device__ __forceinline__ void wave_sum8(float (&x)[8]) {
    float y[4];
#pragma unroll
    for (int k = 0; k < 4; ++k) { float a = x[2 * k], b = x[2 * k + 1];
        asm volatile("s_nop 1\n\tv_permlane32_swap_b32 %0, %1\n\ts_nop 1" : "+v"(a), "+v"(b));
        float v = a + b;
        v += __builtin_bit_cast(float, __builtin_amdgcn_update_dpp(0, __builtin_bit_cast(int, v), 0xB1, 0xf, 0xf, false));
        v += __builtin_bit_cast(float, __builtin_amdgcn_update_dpp(0, __builtin_bit_cast(int, v), 0x4E, 0xf, 0xf, false));
        v += __builtin_bit_cast(float, __builtin_amdgcn_update_dpp(0, __builtin_bit_cast(int, v), 0x141, 0xf, 0xf, false));
        v += __builtin_bit_cast(float, __builtin_amdgcn_update_dpp(0, __builtin_bit_cast(int, v), 0x140, 0xf, 0xf, false));
        y[k] = v; }
#pragma unroll
    for (int k = 0; k < 4; ++k) { const int vi = __builtin_bit_cast(int, y[k]);
        x[2 * k] = __builtin_bit_cast(float, __builtin_amdgcn_readlane(vi, 0)) + __builtin_bit_cast(float, __builtin_amdgcn_readlane(vi, 16));
        x[2 * k + 1] = __builtin_bit_cast(float, __builtin_amdgcn_readlane(vi, 32)) + __builtin_bit_cast(float, __builtin_amdgcn_readlane(vi, 48)); }
}
__device__ __forceinline__ float tanh_fast_(float x) { const float e = __expf(2.0f * x); return 1.0f - 2.0f * __builtin_amdgcn_rcpf(1.0f + e); }
__device__ __forceinline__ float sigmoidf_(float x) { return __builtin_amdgcn_rcpf(1.0f + __expf(-x)); }
__device__ __forceinline__ float silu_(float x) { return x * __builtin_amdgcn_rcpf(1.0f + __expf(-x)); }
typedef float f32x2_t __attribute__((ext_vector_type(2)));
__device__ __forceinline__ f32x4 swiglu_rs4_(f32x4 g, f32x4 u, float c1, float c2) {
    const f32x2_t g0 = {g[0], g[1]}, g1 = {g[2], g[3]}, u0 = {u[0], u[1]}, u1 = {u[2], u[3]};
    const f32x2_t a0 = g0 * c1, a1 = g1 * c1; f32x2_t t0 = (g0 * u0) * c2, t1 = (g1 * u1) * c2;
    f32x2_t e0 = {__builtin_amdgcn_exp2f(a0[0]), __builtin_amdgcn_exp2f(a0[1])}, e1 = {__builtin_amdgcn_exp2f(a1[0]), __builtin_amdgcn_exp2f(a1[1])};
    e0 = e0 + 1.0f; e1 = e1 + 1.0f;
    const f32x2_t r0 = {__builtin_amdgcn_rcpf(e0[0]), __builtin_amdgcn_rcpf(e0[1])}, r1 = {__builtin_amdgcn_rcpf(e1[0]), __builtin_amdgcn_rcpf(e1[1])};
    t0 = t0 * r0; t1 = t1 * r1;
    return (f32x4){t0[0], t0[1], t1[0], t1[1]};
}
__device__ __forceinline__ float swiglu_rs_(float g, float u, float c1, float c2) { return (g * u) * c2 * __builtin_amdgcn_rcpf(1.0f + __builtin_amdgcn_exp2f(g * c1)); }
__device__ __forceinline__ float gelu_tanh_(float x) { const float a = 0.7978845608028654f * (x + 0.044715f * x * x * x); return 0.5f * x * (1.0f + tanhf(a)); }
__device__ __forceinline__ u32x2 cvt8_fp8(const f32x4 a, const f32x4 b) {
    const float lim = 448.0f; int w0 = 0, w1 = 0;
    w0 = __builtin_amdgcn_cvt_pk_fp8_f32(__builtin_amdgcn_fmed3f(a[0], -lim, lim), __builtin_amdgcn_fmed3f(a[1], -lim, lim), w0, false);
    w0 = __builtin_amdgcn_cvt_pk_fp8_f32(__builtin_amdgcn_fmed3f(a[2], -lim, lim), __builtin_amdgcn_fmed3f(a[3], -lim, lim), w0, true);
    w1 = __builtin_amdgcn_cvt_pk_fp8_f32(__builtin_amdgcn_fmed3f(b[0], -lim, lim), __builtin_amdgcn_fmed3f(b[1], -lim, lim), w1, false);
    w1 = __builtin_amdgcn_cvt_pk_fp8_f32(__builtin_amdgcn_fmed3f(b[2], -lim, lim), __builtin_amdgcn_fmed3f(b[3], -lim, lim), w1, true);
    return (u32x2){(unsigned)w0, (unsigned)w1};
}
constexpr float F8_X = 16.f, F8_WGU = 256.f, F8_ACT = 16.f, F8_WD = 512.f;
__device__ __forceinline__ int lane_now() { int l; asm volatile("v_mbcnt_lo_u32_b32 %0, -1, 0\n\tv_mbcnt_hi_u32_b32 %0, -1, %0" : "=v"(l)); return l; }
#define LDS_WAIT() asm volatile("s_waitcnt lgkmcnt(0)" ::: "memory")
#define VM_WAIT() asm volatile("s_waitcnt vmcnt(0)" ::: "memory")

#define XB_TMO      128
#define XB_XCNT(j)  (256  + 64 * (j))
#define XB_XSUB(j)  (1280 + 64 * (j))
#define XB_XGEN(j)  (2304 + 64 * (j))
#define XB_TOP      3328
#define XB_TOPGEN   3392
#define XCD_BAR_WORDS 3456
#define XB_SPIN_CAP (1u << 18)
__device__ __forceinline__ unsigned xb_ld(unsigned* p)              { return __hip_atomic_load(p, __ATOMIC_RELAXED, __HIP_MEMORY_SCOPE_AGENT); }
__device__ __forceinline__ unsigned xb_add(unsigned* p, unsigned v) { return __hip_atomic_fetch_add(p, v, __ATOMIC_RELAXED, __HIP_MEMORY_SCOPE_AGENT); }
__device__ __forceinline__ unsigned xb_xcc_id() { return (unsigned)__builtin_amdgcn_s_getreg((3 << 11) | 20) & 0xFu; }
#define XB_SPIN(cond, bar) do { unsigned _sp = 0; while (cond) { __builtin_amdgcn_s_sleep(1); \
    if ((++_sp & 255u) == 0u) { if (xb_ld(&(bar)[XB_TMO])) break; if (_sp > XB_SPIN_CAP) { atomicAdd(&(bar)[XB_TMO], 1u); break; } } } } while (0)
struct XcdBarrier { unsigned* bar; unsigned x; volatile LAS unsigned* st; int wave; };
__device__ __forceinline__ XcdBarrier xcd_barrier_post(unsigned* bar, volatile LAS unsigned* st) {
    XcdBarrier b; b.bar = bar; b.x = xb_xcc_id(); b.st = st; b.wave = __builtin_amdgcn_readfirstlane(threadIdx.x >> 6);
    if (threadIdx.x == 0) (void)xb_add(&bar[XB_XCNT(b.x)], 1u);
    return b;
}
__device__ __forceinline__ void xcd_barrier_complete(unsigned* bar, unsigned x, unsigned& nloc, unsigned& nx) {
    const unsigned G = gridDim.x * gridDim.y * gridDim.z;
    unsigned sum, cnt, mine, sp = 0u;
    for (;;) {
        sum = 0u; cnt = 0u; mine = 0u;
#pragma unroll
        for (unsigned j = 0; j < 16; ++j) { const unsigned c = xb_ld(&bar[XB_XCNT(j)]); sum += c; cnt += (c > 0u) ? 1u : 0u; mine = (j == x) ? c : mine; }
        if (sum == G) break;
        __builtin_amdgcn_s_sleep(1);
        if ((++sp & 255u) == 0u) { if (xb_ld(&bar[XB_TMO])) break; if (sp > XB_SPIN_CAP) { atomicAdd(&bar[XB_TMO], 1u); break; } }
    }
    nloc = mine > 0u ? mine : 1u; nx = cnt > 0u ? cnt : 1u;
}
__device__ __forceinline__ void xcd_barrier(const XcdBarrier& b) {
    asm volatile("s_waitcnt vmcnt(0)" ::: "memory");
    __syncthreads();
    if (b.wave == 0 && lane_now() == 0) {
        unsigned* bar = b.bar;
        __builtin_amdgcn_s_waitcnt(0);
        unsigned nloc = b.st[0], nx = b.st[1];
        if (nloc == 0u) { xcd_barrier_complete(bar, b.x, nloc, nx); b.st[0] = nloc; b.st[1] = nx; }
        const unsigned old = xb_add(&bar[XB_XSUB(b.x)], 1u);
        const unsigned gen = old / nloc;
        if (old + 1u == (gen + 1u) * nloc) {
            __builtin_amdgcn_fence(__ATOMIC_RELEASE, "agent");
            asm volatile("s_waitcnt vmcnt(0)" ::: "memory");
            const unsigned og = xb_add(&bar[XB_TOP], 1u);
            const unsigned tg = og / nx;
            if (og + 1u == (tg + 1u) * nx) xb_add(&bar[XB_TOPGEN], 1u);
            else XB_SPIN(xb_ld(&bar[XB_TOPGEN]) == tg, bar);
            __builtin_amdgcn_fence(__ATOMIC_ACQUIRE, "agent");
            xb_add(&bar[XB_XGEN(b.x)], 1u);
            asm volatile("s_waitcnt vmcnt(0)" ::: "memory");
        } else {
            XB_SPIN(xb_ld(&bar[XB_XGEN(b.x)]) == gen, bar);
            __builtin_amdgcn_fence(__ATOMIC_ACQUIRE, "agent");
            asm volatile("s_waitcnt vmcnt(0)" ::: "memory");
        }
    }
    __syncthreads();
}

namespace pg8 {
constexpr int BM = 256, BK = 64, HALF = 128, HTB = HALF * BK * 2, STAGE_BYTES = 8 * HTB, NXCD = 8, WGM = 4;
__host__ __device__ __forceinline__ int lds_byte(int r, int c) { const int st = (r >> 4) * 2 + (c >> 5), rr = r & 15, cc = c & 31, ob = rr * 64 + cc * 2; return st * 1024 + (ob ^ (((ob >> 9) & 1) << 5)); }
__host__ __device__ __forceinline__ void stage_rc(int b, int& R, int& C) { const int st = b / 1024, sb = b % 1024, swz = sb ^ (((sb >> 9) & 1) << 5); R = (st >> 1) * 16 + swz / 64; C = (st & 1) * 32 + (swz % 64) / 2; }
__host__ __device__ __forceinline__ int perm32(int rho) { const int n = rho >> 4, i = rho & 15; return 8 * (i >> 2) + 4 * n + (i & 3); }

struct Unit { int pm, pn, e, rb; };

struct TileOrder {
    int nM, nN, nwg, G, c;
    __device__ void init(int nM_, int nN_, int G_, int c_) { nM = nM_; nN = nN_; nwg = nM * nN; G = G_; c = c_; }
    __device__ bool tile(int i, int& pm, int& pn) const {
        const long L = (long)i * G + c; if (L >= nwg) return false;
        int wgid = (int)L; { const int q = nwg / NXCD, r = nwg % NXCD, xcd = wgid % NXCD, off = wgid / NXCD; wgid = (xcd < r ? xcd * (q + 1) : r * (q + 1) + (xcd - r) * q) + off; }
        const int nig = WGM * nN, gid = wgid / nig, fm = gid * WGM, gsz = (nM - fm) < WGM ? (nM - fm) : WGM;
        pm = fm + ((wgid % nig) % gsz); pn = (wgid % nig) / gsz; return true;
    }
};
struct DenseSched {
    static constexpr bool GATHER = false;
    TileOrder o; const char* A; const char* Bt; int K;
    __device__ void init(const void* A_, const void* Bt_, int M, int N, int K_, int G, int c) { o.init(M / BM, N / BM, G, c); A = (const char*)A_; Bt = (const char*)Bt_; K = K_; }
    __device__ __forceinline__ bool next(int i, Unit& u) const { u.e = 0; u.rb = 0; return o.tile(i, u.pm, u.pn); }
    __device__ __forceinline__ const char* a_ptr() const { return A; }
    __device__ __forceinline__ const char* b_ptr() const { return Bt; }
    __device__ __forceinline__ unsigned a_base(const Unit& u) const { return (unsigned)u.pm * (unsigned)(BM * K * 2); }
    __device__ __forceinline__ unsigned b_base(const Unit& u) const { return (unsigned)u.pn * (unsigned)(BM * K * 2); }
    __device__ __forceinline__ void gather_ids(const Unit&, int, int, int (&)[4]) const {}
};

struct KvSched {
    static constexpr bool GATHER = false;
    TileOrder o; const char* A; const char* Bt;
    __device__ void init(const void* A_, const void* Bt_, int G, int c) { o.init(2 * MROWS / BM, 512 / BM, G, c); A = (const char*)A_; Bt = (const char*)Bt_; }
    __device__ __forceinline__ bool next(int i, Unit& u) const { u.e = 0; u.rb = 0; return o.tile(i, u.pm, u.pn); }
    __device__ __forceinline__ const char* a_ptr() const { return A; }
    __device__ __forceinline__ const char* b_ptr() const { return Bt; }
    __device__ __forceinline__ unsigned a_base(const Unit& u) const { return (unsigned)u.pm * (unsigned)(BM * D * 2); }
    __device__ __forceinline__ unsigned b_base(const Unit& u) const { return ((unsigned)(u.pm >= MROWS / BM ? 512 : 0) + (unsigned)u.pn * BM) * (unsigned)(D * 2); }
    __device__ __forceinline__ void gather_ids(const Unit&, int, int, int (&)[4]) const {}
};
typedef int i32x8v __attribute__((ext_vector_type(8)));
typedef int i32x4v __attribute__((ext_vector_type(4)));
template <class Epi, class Sched, bool ALIGN_EPI, bool FP8 = false, int VAR = 0>
__device__ __forceinline__ void gemm_phase(LAS unsigned char* lds, const int K, const Sched& S, const Epi& E, const int ldk_ = 0, const int wid_ = -1) {
    int widv_ = (wid_ >= 0) ? wid_ : __builtin_amdgcn_readfirstlane(threadIdx.x >> 6); asm volatile("" : "+s"(widv_));
    const int lane = lane_now(), wid = widv_, tid = wid * 64 + lane, wr = wid >> 2, wc = wid & 3, fr = lane & 15, fq = lane >> 4;
    const int nt = K / BK, LD = ldk_ ? ldk_ : K;
    unsigned voffA[2][2], voffB[2];
#pragma unroll
    for (int i = 0; i < 2; ++i) { int R, C; stage_rc(tid * 16 + i * 8192, R, C); const int Rb = (R & ~31) + perm32(R & 31);
        voffA[0][i] = (unsigned)(R * LD + C) * 2u; voffA[1][i] = (unsigned)((R + HALF) * LD + C) * 2u; voffB[i] = (unsigned)(Rb * LD + C) * 2u; }
    const unsigned kstep = (unsigned)(BK * 2);
    const unsigned hstep = (unsigned)(HALF * LD * 2);
    const __amdgpu_buffer_rsrc_t rsA = __builtin_amdgcn_make_buffer_rsrc((void*)S.a_ptr(), 0, 0x7ffffffc, 0x00020000), rsB = __builtin_amdgcn_make_buffer_rsrc((void*)S.b_ptr(), 0, 0x7ffffffc, 0x00020000);
    const unsigned ldsw = (unsigned)wid * 1024u;
    const int aoff = lds_byte(wr * 64 + fr, fq * 8), boff = lds_byte(wc * 32 + fr, fq * 8);
    LAS unsigned char* pA = lds + aoff; LAS unsigned char* pB = lds + 4 * HTB + boff;
#define PG8_SA(b, h) (((b) * 2 + (h)) * HTB)
#define PG8_SB(b, h) ((4 + (b) * 2 + (h)) * HTB)
#define PG8_SBR(b, h) (((b) * 2 + (h)) * HTB)
#define PG8_STAGE_R(rs, bufoff, gbase, voff) do { if constexpr (VAR != 3 && VAR != 4) _Pragma("unroll") for (int _i = 0; _i < 2; ++_i) \
        __builtin_amdgcn_raw_ptr_buffer_load_lds(rs, (LAS unsigned*)(lds + (bufoff) + ldsw + _i * 8192), 16, (voff)[_i], (gbase), 0, 0); } while (0)
#define PG8_STAGE(bufoff, gbase, voff) PG8_STAGE_R(rsB, bufoff, gbase, voff)
#define PG8_STAGE_A(bufoff, gbase, h) do { if constexpr (Sched::GATHER) { \
        __builtin_amdgcn_raw_ptr_buffer_load_lds(rsA, (LAS unsigned*)(lds + (bufoff) + ldsw), 16, (voffA[h][0] & 0xffffu) * (unsigned)(K * 2) + (cpk & 0xffffu), (gbase), 0, 0); \
        __builtin_amdgcn_raw_ptr_buffer_load_lds(rsA, (LAS unsigned*)(lds + (bufoff) + ldsw + 8192), 16, (voffA[h][0] >> 16) * (unsigned)(K * 2) + (cpk >> 16), (gbase), 0, 0); \
        } else { PG8_STAGE_R(rsA, bufoff, (gbase) + (h) * hstep, voffA[0]); } } while (0)
#define PG8_LD8(ptr_) __builtin_shufflevector(*(const LAS i32x4v*)(ptr_), *(const LAS i32x4v*)((ptr_) + 1024), 0, 1, 2, 3, 4, 5, 6, 7)
#define PG8_LDA(dst, b, h) do { if constexpr (VAR == 4 || VAR == 5) { _Pragma("unroll") for (int m = 0; m < 4; ++m) _Pragma("unroll") for (int k = 0; k < 2; ++k) asm volatile("" : "+v"(dst[m][k])); } else if constexpr (FP8) { _Pragma("unroll") for (int m = 0; m < 4; ++m) dst##8[m] = PG8_LD8(pA + PG8_SA(b, h) + m * 2048); } else { \
        _Pragma("unroll") for (int m = 0; m < 4; ++m) _Pragma("unroll") for (int k = 0; k < 2; ++k) dst[m][k] = *(const LAS bf16x8*)(pA + PG8_SA(b, h) + m * 2048 + k * 1024); } } while (0)
#define PG8_LDB(dst, b, h) do { if constexpr (VAR == 4 || VAR == 5) { _Pragma("unroll") for (int n = 0; n < 2; ++n) _Pragma("unroll") for (int k = 0; k < 2; ++k) asm volatile("" : "+v"(dst[n][k])); } else if constexpr (FP8) { _Pragma("unroll") for (int n = 0; n < 2; ++n) dst##8[n] = PG8_LD8(pB + PG8_SBR(b, h) + n * 2048); } else { \
        _Pragma("unroll") for (int n = 0; n < 2; ++n) _Pragma("unroll") for (int k = 0; k < 2; ++k) dst[n][k] = *(const LAS bf16x8*)(pB + PG8_SBR(b, h) + n * 2048 + k * 1024); } } while (0)
#define PG8_MMA(ai, bj, At, Bt) do { __builtin_amdgcn_s_setprio(1); if constexpr (VAR == 2) { _Pragma("unroll") for (int m = 0; m < 4; ++m) _Pragma("unroll") for (int k = 0; k < 2; ++k) asm volatile("" :: "v"(At[m][k])); _Pragma("unroll") for (int n = 0; n < 2; ++n) _Pragma("unroll") for (int k = 0; k < 2; ++k) asm volatile("" :: "v"(Bt[n][k])); } else if constexpr (FP8) { _Pragma("unroll") for (int m = 0; m < 4; ++m) _Pragma("unroll") for (int n = 0; n < 2; ++n) \
            acc[ai][bj][m][n] = __builtin_amdgcn_mfma_scale_f32_16x16x128_f8f6f4(Bt##8[n], At##8[m], acc[ai][bj][m][n], 0, 0, 0, 0x7f7f7f7f, 0, 0x7f7f7f7f); } else { \
        _Pragma("unroll") for (int m = 0; m < 4; ++m) _Pragma("unroll") for (int n = 0; n < 2; ++n) _Pragma("unroll") for (int k = 0; k < 2; ++k) \
        acc[ai][bj][m][n] = __builtin_amdgcn_mfma_f32_16x16x32_bf16(Bt[n][k], At[m][k], acc[ai][bj][m][n], 0, 0, 0); } __builtin_amdgcn_s_setprio(0); } while (0)
#define PG8_WAIT_V(n) asm volatile("s_waitcnt vmcnt(" #n ")" ::: "memory")
#define PG8_WAIT_L(n) asm volatile("s_waitcnt lgkmcnt(" #n ")" ::: "memory")
#define PG8_BAR __builtin_amdgcn_s_barrier()
#define PG8_SCHED __builtin_amdgcn_sched_barrier(0)
    Unit cur, nxt; int ui = 0;
    if (!S.next(0, cur)) return;
    typename Epi::StashT sv_ = 0; LAS float* const rsl_ = (LAS float*)(lds + STAGE_BYTES);
    unsigned cpk = 0u;
    if constexpr (Sched::GATHER) { int ids[4]; int R0, C0, R1, C1; stage_rc(tid * 16, R0, C0); stage_rc(tid * 16 + 8192, R1, C1); S.gather_ids(cur, R0, R1, ids);
        cpk = (unsigned)(C0 * 2) | ((unsigned)(C1 * 2) << 16);
#pragma unroll
        for (int h = 0; h < 2; ++h) voffA[h][0] = (unsigned)ids[h * 2 + 0] | ((unsigned)ids[h * 2 + 1] << 16); }
    f32x4 acc[2][2][4][2];
#pragma unroll
    for (int a = 0; a < 2; ++a)
#pragma unroll
        for (int b = 0; b < 2; ++b)
#pragma unroll
            for (int m = 0; m < 4; ++m)
#pragma unroll
                for (int n = 0; n < 2; ++n) acc[a][b][m][n] = (f32x4){0.f, 0.f, 0.f, 0.f};
    bf16x8 At[4][2], B0[2][2], B1[2][2]; i32x8v At8[4], B08[2], B18[2];
    if constexpr (VAR == 4 || VAR == 5) {
#pragma unroll
        for (int m = 0; m < 4; ++m)
#pragma unroll
            for (int k = 0; k < 2; ++k)
#pragma unroll
                for (int e = 0; e < 8; ++e) { const unsigned hsh = (unsigned)(lane * 8 + e + 64 * (m * 2 + k)) * 2654435761u; At[m][k][e] = (short)(0x3f00u | ((hsh >> 9) & 0xffu) | ((hsh >> 3) & 0x8000u));
                    if (m < 2) { B0[m][k][e] = (short)(0x3f00u | ((hsh >> 17) & 0xffu) | ((hsh >> 5) & 0x8000u)); B1[m][k][e] = (short)(0x3f00u | ((hsh >> 21) & 0xffu) | ((hsh >> 7) & 0x8000u)); } } }
    unsigned cA = S.a_base(cur), cB = S.b_base(cur);
    PG8_STAGE(PG8_SB(0, 0), cB, voffB); PG8_STAGE(PG8_SB(0, 1), cB + hstep, voffB); PG8_STAGE_A(PG8_SA(0, 0), cA, 0); PG8_STAGE_A(PG8_SA(0, 1), cA, 1);
    if (wr == 1) PG8_BAR;
    PG8_WAIT_V(2); PG8_BAR;
    PG8_STAGE(PG8_SB(1, 0), cB + kstep, voffB); PG8_STAGE_A(PG8_SA(1, 0), cA + kstep, 0); PG8_STAGE(PG8_SB(1, 1), cB + hstep + kstep, voffB);
    PG8_WAIT_V(6); PG8_BAR;
    for (;;) {
        const bool has_next = S.next(ui + 1, nxt);
        const unsigned nA = has_next ? S.a_base(nxt) : cA, nB = has_next ? S.b_base(nxt) : cB;
        int idsN[4] = {0, 0, 0, 0};
#pragma unroll 1
        for (int t = 0; t < nt; t += 2) {
            asm volatile("" : "+v"(pA), "+v"(pB));
            if constexpr (Epi::STASH) { if (t == 2) { const int t2_ = wid * 64 + lane_now(); if (t2_ < 256) sv_ = E.stash_load(cur, t2_); }
                                        else if (t == 4) { const int t2_ = wid * 64 + lane_now(); if (t2_ < 256) E.stash_store(rsl_, t2_, sv_); } }
            const bool last = (t == nt - 2);
            const unsigned a1 = cA + (unsigned)(t + 1) * kstep;
            const unsigned a2 = last ? nA : cA + (unsigned)(t + 2) * kstep, b2 = last ? nB : cB + (unsigned)(t + 2) * kstep;
            const unsigned a3 = a2 + kstep, b3 = b2 + kstep;
            if constexpr (Sched::GATHER) { if (t == nt - 4 && has_next) { int ids[4]; int R0, C0, R1, C1; const int tid2 = wid * 64 + lane_now(); stage_rc(tid2 * 16, R0, C0); stage_rc(tid2 * 16 + 8192, R1, C1); S.gather_ids(nxt, R0, R1, ids);
#pragma unroll
                for (int h = 0; h < 4; ++h) idsN[h] = ids[h]; } }
            PG8_LDB(B0, 0, 0); PG8_LDB(B1, 0, 1); PG8_SCHED; PG8_LDA(At, 0, 0); PG8_STAGE_A(PG8_SA(1, 1), a1, 1);
            if constexpr (Sched::GATHER) { if (last && has_next) { voffA[0][0] = (unsigned)idsN[0] | ((unsigned)idsN[1] << 16); voffA[1][0] = (unsigned)idsN[2] | ((unsigned)idsN[3] << 16); } }
            PG8_WAIT_V(8); PG8_WAIT_L(0); PG8_BAR; PG8_MMA(0, 0, At, B0); PG8_MMA(0, 1, At, B1); PG8_BAR; PG8_SCHED;
            PG8_LDA(At, 0, 1); PG8_STAGE(PG8_SB(0, 0), b2, voffB); PG8_STAGE(PG8_SB(0, 1), b2 + hstep, voffB); PG8_STAGE_A(PG8_SA(0, 0), a2, 0);
            PG8_WAIT_V(8); PG8_WAIT_L(0); PG8_BAR; PG8_MMA(1, 0, At, B0); PG8_MMA(1, 1, At, B1); PG8_BAR; PG8_SCHED;
            PG8_LDB(B0, 1, 0); PG8_LDB(B1, 1, 1); PG8_SCHED; PG8_LDA(At, 1, 0); PG8_STAGE_A(PG8_SA(0, 1), a2, 1);
            PG8_WAIT_V(8); PG8_WAIT_L(0); PG8_BAR; PG8_MMA(0, 0, At, B0); PG8_MMA(0, 1, At, B1); PG8_BAR; PG8_SCHED;
            PG8_LDA(At, 1, 1); PG8_STAGE(PG8_SB(1, 0), b3, voffB); PG8_STAGE(PG8_SB(1, 1), b3 + hstep, voffB); PG8_STAGE_A(PG8_SA(1, 0), a3, 0);
            PG8_WAIT_V(8); PG8_WAIT_L(0); PG8_BAR; PG8_MMA(1, 0, At, B0); PG8_MMA(1, 1, At, B1); PG8_BAR; PG8_SCHED;
        }
        if constexpr (ALIGN_EPI) { if (wr == 0) PG8_BAR; }
        { const int le_ = lane_now(); E(acc, cur, wr, wc, le_ & 15, le_ >> 4, rsl_); }
        if (!has_next) break;
        {
            typedef _Float16 h4_t __attribute__((ext_vector_type(4))); h4_t zh = {(_Float16)0.f, (_Float16)0.f, (_Float16)0.f, (_Float16)0.f}; asm volatile("" : "+v"(zh));
#pragma unroll
            for (int a = 0; a < 2; ++a)
#pragma unroll
                for (int b = 0; b < 2; ++b)
#pragma unroll
                    for (int m = 0; m < 4; ++m)
#pragma unroll
                        for (int n = 0; n < 2; ++n) acc[a][b][m][n] = __builtin_amdgcn_mfma_f32_4x4x4f16(zh, zh, (f32x4){0.f, 0.f, 0.f, 0.f}, 0, 0, 0); }
        cur = nxt; cA = nA; cB = nB; ++ui;
        if constexpr (ALIGN_EPI) { if (wr == 1) PG8_BAR; }
    }
    PG8_WAIT_V(0);
    if constexpr (!ALIGN_EPI) { if (wr == 0) PG8_BAR; }
    PG8_BAR;
#undef PG8_SA
#undef PG8_SB
#undef PG8_SBR
#undef PG8_STAGE
#undef PG8_STAGE_R
#undef PG8_STAGE_A
#undef PG8_LDA
#undef PG8_LD8
#undef PG8_LDB
#undef PG8_MMA
#undef PG8_WAIT_V
#undef PG8_WAIT_L
#undef PG8_BAR
#undef PG8_SCHED
}
}
using pg8::Unit;

__device__ __forceinline__ float rstd_of(float ss) { return 1.0f / sqrtf(ss * (1.0f / D) + RMS_EPS); }
typedef unsigned long long rss_t;
__device__ __forceinline__ float rstd_fx(rss_t s) { return rstd_of((float)((double)s * (1.0 / 16777216.0))); }
__device__ __forceinline__ rss_t rss_fx(float ss) { return (rss_t)__float2ull_rn(ss * 16777216.0f); }

struct EpiInA {
    static constexpr bool STASH = true;
    typedef rss_t StashT;
    __device__ __forceinline__ void stash_store(LAS float* rsl, int lrow, rss_t v) const { rsl[lrow] = rstd_fx(v); }
    __device__ __forceinline__ rss_t stash_load(const Unit& u, int lrow) const { return rowss[u.pm * 256 + lrow]; }
    bf16_t* U; bf16_t* Q; const rss_t* rowss;
    __device__ __forceinline__ void operator()(const f32x4 (&acc)[2][2][4][2], const Unit& u, int wr, int wc, int fr, int fq, const LAS float* rsl) const {
        const int row0 = u.pm * 256 + wr * 64 + fr, col0 = u.pn * 256 + wc * 32 + 8 * fq;
        float rsq[8];
#pragma unroll
        for (int i = 0; i < 8; ++i) rsq[i] = rsl[wr * 64 + fr + (i >> 2) * 128 + (i & 3) * 16];
#pragma unroll
        for (int ai = 0; ai < 2; ++ai)
#pragma unroll
            for (int m = 0; m < 4; ++m) { const int row = row0 + ai * 128 + m * 16; const float rs = rsq[ai * 4 + m];
#pragma unroll
                for (int bj = 0; bj < 2; ++bj) { const int c = col0 + bj * 128; const f32x4 v0 = acc[ai][bj][m][0] * rs, v1 = acc[ai][bj][m][1] * rs;
                    u32x4 w; w.x = cvt_pk_bf16(v0[0], v0[1]); w.y = cvt_pk_bf16(v0[2], v0[3]); w.z = cvt_pk_bf16(v1[0], v1[1]); w.w = cvt_pk_bf16(v1[2], v1[3]);
                    if (c < CS) { const int g = c >> 4, hf = (c >> 3) & 1, b = row >> 12, t = row & 4095; *(u32x4*)(U + (((size_t)(b * S5G + g) * SEQ + t) * 16 + 8 * hf)) = w; }
                    else *(u32x4*)(Q + (size_t)row * CM + (c - CS)) = w; } }
    }
};
struct EpiBf16 {
    static constexpr bool STASH = true;
    typedef rss_t StashT;
    __device__ __forceinline__ void stash_store(LAS float* rsl, int lrow, rss_t v) const { rsl[lrow] = rowss ? rstd_fx(v) : 1.0f; }
    __device__ __forceinline__ rss_t stash_load(const Unit& u, int lrow) const { return rowss ? rowss[u.pm * 256 + lrow] : (rss_t)0; }
    bf16_t* O; int ldc; const rss_t* rowss; bf16_t* Q; int qcol0;
    __device__ __forceinline__ void operator()(const f32x4 (&acc)[2][2][4][2], const Unit& u, int wr, int wc, int fr, int fq, const LAS float* rsl) const {
        const int row0 = u.pm * 256 + wr * 64 + fr, col0 = u.pn * 256 + wc * 32 + 8 * fq;
        float rsv8[8];
#pragma unroll
        for (int i = 0; i < 8; ++i) rsv8[i] = rsl[wr * 64 + fr + (i >> 2) * 128 + (i & 3) * 16];
#pragma unroll
        for (int ai = 0; ai < 2; ++ai)
#pragma unroll
            for (int m = 0; m < 4; ++m) { const int row = row0 + ai * 128 + m * 16; const float rs = rsv8[ai * 4 + m];
#pragma unroll
                for (int bj = 0; bj < 2; ++bj) { const int c = col0 + bj * 128; const f32x4 v0 = acc[ai][bj][m][0] * rs, v1 = acc[ai][bj][m][1] * rs;
                    u32x4 w; w.x = cvt_pk_bf16(v0[0], v0[1]); w.y = cvt_pk_bf16(v0[2], v0[3]); w.z = cvt_pk_bf16(v1[0], v1[1]); w.w = cvt_pk_bf16(v1[2], v1[3]);
                    if (Q && c >= qcol0) *(u32x4*)(Q + (size_t)row * CM + (c - qcol0)) = w;
                    else *(u32x4*)(O + (size_t)row * ldc + c) = w; } }
    }
};
struct EpiRes {
    static constexpr bool STASH = false; typedef float StashT;
    const float* XinF; const bf16_t* XinB; bf16_t* H; rss_t* rowss; unsigned char* H8;
    __device__ __forceinline__ void operator()(const f32x4 (&acc)[2][2][4][2], const Unit& u, int wr, int wc, int fr, int fq, const LAS float* rsl) const {
        const int row0 = u.pm * 256 + wr * 64 + fr, col0 = u.pn * 256 + wc * 32 + 8 * fq;
#pragma unroll
        for (int ai = 0; ai < 2; ++ai) {
            f32x4 xv[4][2][2];
            if (XinF) {
#pragma unroll
                for (int m = 0; m < 4; ++m)
#pragma unroll
                    for (int bj = 0; bj < 2; ++bj) { const size_t o = (size_t)(row0 + ai * 128 + m * 16) * D + col0 + bj * 128; xv[m][bj][0] = *(const f32x4*)(XinF + o); xv[m][bj][1] = *(const f32x4*)(XinF + o + 4); }
            } else { u32x4 xb[4][2];
#pragma unroll
                for (int m = 0; m < 4; ++m)
#pragma unroll
                    for (int bj = 0; bj < 2; ++bj) xb[m][bj] = *(const u32x4*)(XinB + (size_t)(row0 + ai * 128 + m * 16) * D + col0 + bj * 128);
#pragma unroll
                for (int m = 0; m < 4; ++m)
#pragma unroll
                    for (int bj = 0; bj < 2; ++bj) { const u32x4 w = xb[m][bj]; xv[m][bj][0] = (f32x4){bflo(w.x), bfhi(w.x), bflo(w.y), bfhi(w.y)}; xv[m][bj][1] = (f32x4){bflo(w.z), bfhi(w.z), bflo(w.w), bfhi(w.w)}; } }
            __builtin_amdgcn_sched_barrier(0);
            float ss4[4];
#pragma unroll
            for (int m = 0; m < 4; ++m) { const int row = row0 + ai * 128 + m * 16; float ss = 0.f;
#pragma unroll
                for (int bj = 0; bj < 2; ++bj) { const size_t o = (size_t)row * D + col0 + bj * 128;
                    const f32x4 s0 = acc[ai][bj][m][0] + xv[m][bj][0], s1 = acc[ai][bj][m][1] + xv[m][bj][1];
                    u32x4 w; w.x = cvt_pk_bf16(s0[0], s0[1]); w.y = cvt_pk_bf16(s0[2], s0[3]); w.z = cvt_pk_bf16(s1[0], s1[1]); w.w = cvt_pk_bf16(s1[2], s1[3]);
                    *(u32x4*)(H + o) = w;
                    const f32x4 v0 = {bflo(w.x), bfhi(w.x), bflo(w.y), bfhi(w.y)}, v1 = {bflo(w.z), bfhi(w.z), bflo(w.w), bfhi(w.w)};
                    if (H8) *(u32x2*)(H8 + o) = cvt8_fp8(v0 * F8_X, v1 * F8_X);
                    ss += (v0[0] * v0[0] + v0[1] * v0[1]) + (v0[2] * v0[2] + v0[3] * v0[3]) + (v1[0] * v1[0] + v1[1] * v1[1]) + (v1[2] * v1[2] + v1[3] * v1[3]); }
                ss4[m] = ss; }
#pragma unroll
            for (int m = 0; m < 4; ++m) { float ss = ss4[m]; ss += __shfl_xor(ss, 16); ss += __shfl_xor(ss, 32);
                if (fq == 0) atomicAdd(rowss + row0 + ai * 128 + m * 16, rss_fx(ss)); }
            __builtin_amdgcn_sched_barrier(0); }
    }
};
struct EpiSwiglu {
    static constexpr bool STASH = true;
    typedef rss_t StashT;
    __device__ __forceinline__ void stash_store(LAS float* rsl, int lrow, rss_t raw) const { const float v = rsv ? __uint_as_float((unsigned)raw) : rstd_fx(raw); rsl[lrow] = v * -1.4426950408889634f; rsl[256 + lrow] = v * v; }
    __device__ __forceinline__ rss_t stash_load(const Unit& u, int lrow) const { return rsv ? (rss_t)__float_as_uint(rsv[u.rb + lrow]) : rowss[u.pm * 256 + lrow]; }
    bf16_t* O; int ldo; const rss_t* rowss; const float* rsv; int skip;
    __device__ __forceinline__ void operator()(const f32x4 (&acc)[2][2][4][2], const Unit& u, int wr, int wc, int fr, int fq, const LAS float* rsl) const {
        if (skip) return;
        const int lrow0 = wr * 64 + fr, col0 = u.pn * 128 + wc * 32 + 8 * fq;
        float c18[8], c28[8];
#pragma unroll
        for (int i = 0; i < 8; ++i) { const int lrow = lrow0 + (i >> 2) * 128 + (i & 3) * 16; c18[i] = rsl[lrow]; c28[i] = rsl[256 + lrow]; }
#pragma unroll
        for (int ai = 0; ai < 2; ++ai)
#pragma unroll
            for (int m = 0; m < 4; ++m) { const int lrow = lrow0 + ai * 128 + m * 16;
                const float c1 = c18[ai * 4 + m], c2 = c28[ai * 4 + m]; const size_t orow = rsv ? ((size_t)u.e + lrow) : (size_t)(u.pm * 256 + lrow);
                const f32x4 g0 = acc[ai][0][m][0], g1 = acc[ai][0][m][1], u0 = acc[ai][1][m][0], u1 = acc[ai][1][m][1];
                const f32x4 s0 = swiglu_rs4_(g0, u0, c1, c2), s1 = swiglu_rs4_(g1, u1, c1, c2);
                u32x4 w; w.x = cvt_pk_bf16(s0[0], s0[1]); w.y = cvt_pk_bf16(s0[2], s0[3]); w.z = cvt_pk_bf16(s1[0], s1[1]); w.w = cvt_pk_bf16(s1[2], s1[3]);
                if (skip == 3) { w.x = cvt_pk_bf16(g0[0] * u0[0], g0[1] * u0[1]); w.y = cvt_pk_bf16(g0[2] * u0[2], g0[3] * u0[3]); w.z = cvt_pk_bf16(g1[0] * u1[0], g1[1] * u1[1]); w.w = cvt_pk_bf16(g1[2] * u1[2], g1[3] * u1[3]); }
                if (skip == 2) asm volatile("" :: "v"(w)); else if (skip == 4) *(u32x4*)(O + ((size_t)blockIdx.x * 256 + lrow) * 128 + (col0 & 127)) = w; else
                *(u32x4*)(O + orow * ldo + col0) = w; }
    }
};
struct EpiSwigluF8 {
    static constexpr bool STASH = true;
    typedef float StashT;
    __device__ __forceinline__ void stash_store(LAS float* rsl, int lrow, float raw) const { const float v = raw * (1.0f / (F8_X * F8_WGU)); rsl[lrow] = v * -1.4426950408889634f; rsl[256 + lrow] = v * v * F8_ACT; }
    __device__ __forceinline__ float stash_load(const Unit& u, int lrow) const { return rsv[u.rb + lrow]; }
    unsigned char* O8; int ldo; const float* rsv;
    __device__ __forceinline__ void operator()(const f32x4 (&acc)[2][2][4][2], const Unit& u, int wr, int wc, int fr, int fq, const LAS float* rsl) const {
        const int lrow0 = wr * 64 + fr, col0 = u.pn * 128 + wc * 32 + 8 * fq;
        float c1n = rsl[lrow0], c2n = rsl[256 + lrow0];
#pragma unroll
        for (int ai = 0; ai < 2; ++ai)
#pragma unroll
            for (int m = 0; m < 4; ++m) { const int lrow = lrow0 + ai * 128 + m * 16; const float c1 = c1n, c2 = c2n;
                if (ai * 4 + m < 7) { const int ln_ = lrow0 + ((ai * 4 + m + 1) >> 2) * 128 + ((ai * 4 + m + 1) & 3) * 16; c1n = rsl[ln_]; c2n = rsl[256 + ln_]; }
                f32x4 a0, a1;
                a0 = swiglu_rs4_(acc[ai][0][m][0], acc[ai][1][m][0], c1, c2); a1 = swiglu_rs4_(acc[ai][0][m][1], acc[ai][1][m][1], c1, c2);
                *(u32x2*)(O8 + ((size_t)u.e + lrow) * ldo + col0) = cvt8_fp8(a0, a1);
                asm volatile("" ::: "memory"); }
    }
};
struct EpiSlot {
    static constexpr bool STASH = false; typedef float StashT;
    bf16_t* O;
    __device__ __forceinline__ void operator()(const f32x4 (&acc)[2][2][4][2], const Unit& u, int wr, int wc, int fr, int fq, const LAS float* rsl) const {
        const int lrow0 = wr * 64 + fr, col0 = u.pn * 256 + wc * 32 + 8 * fq;
#pragma unroll
        for (int ai = 0; ai < 2; ++ai)
#pragma unroll
            for (int m = 0; m < 4; ++m) { const size_t orow = (size_t)u.e + lrow0 + ai * 128 + m * 16;
#pragma unroll
                for (int bj = 0; bj < 2; ++bj) { const float sc = 1.0f / (F8_ACT * F8_WD); const f32x4 v0 = acc[ai][bj][m][0] * sc, v1 = acc[ai][bj][m][1] * sc;
                    u32x4 w; w.x = cvt_pk_bf16(v0[0], v0[1]); w.y = cvt_pk_bf16(v0[2], v0[3]); w.z = cvt_pk_bf16(v1[0], v1[1]); w.w = cvt_pk_bf16(v1[2], v1[3]);
                    *(u32x4*)(O + orow * D + col0 + bj * 128) = w; } }
    }
};

struct MoeGuSched {
    static constexpr bool GATHER = true;
    pg8::TileOrder o; const char* A; const char* W; const int* list; const LAS int* tab; int tile0;
    __device__ __forceinline__ bool next(int i, Unit& u) const {
        if (!o.tile(i, u.pm, u.pn)) return false;
        const int gt = tile0 + u.pm; int e = 0;
#pragma unroll
        for (int k = 1; k < 8; ++k) e += (gt >= tab[k]) ? 1 : 0;
        e = __builtin_amdgcn_readfirstlane(e);
        u.rb = __builtin_amdgcn_readfirstlane(e * 32768 + (gt - tab[e]) * 256); u.e = u.pm * 256; return true;
    }
    __device__ __forceinline__ const char* a_ptr() const { return A; }
    __device__ __forceinline__ const char* b_ptr() const { return W; }
    __device__ __forceinline__ unsigned a_base(const Unit&) const { return 0u; }
    __device__ __forceinline__ unsigned b_base(const Unit& u) const { return ((unsigned)(u.rb >> 15) * (2 * FE) + (unsigned)u.pn * 256) * (unsigned)D; }
    __device__ __forceinline__ void gather_ids(const Unit& u, int R0, int R1, int (&ids)[4]) const {
        const int e = u.rb >> 15, rank0 = u.rb & 32767, cnt = __builtin_amdgcn_readfirstlane(tab[16 + e]);
        const int lim = cnt - 1 - rank0;
#pragma unroll
        for (int h = 0; h < 2; ++h) { const int r0 = R0 + 128 * h, r1 = R1 + 128 * h;
            ids[h * 2 + 0] = list[u.rb + (r0 < lim ? r0 : lim)]; ids[h * 2 + 1] = list[u.rb + (r1 < lim ? r1 : lim)]; }
    }
};
struct MoeDownSched {
    static constexpr bool GATHER = false;
    pg8::TileOrder o; const char* A; const char* W; const LAS int* tab; int tile0;
    __device__ __forceinline__ bool next(int i, Unit& u) const {
        if (!o.tile(i, u.pm, u.pn)) return false;
        const int gt = tile0 + u.pm; int e = 0;
#pragma unroll
        for (int k = 1; k < 8; ++k) e += (gt >= tab[k]) ? 1 : 0;
        u.rb = __builtin_amdgcn_readfirstlane(e); u.e = gt * 256; return true;
    }
    __device__ __forceinline__ const char* a_ptr() const { return A; }
    __device__ __forceinline__ const char* b_ptr() const { return W; }
    __device__ __forceinline__ unsigned a_base(const Unit& u) const { return (unsigned)u.pm * (unsigned)(256 * FE); }
    __device__ __forceinline__ unsigned b_base(const Unit& u) const { return ((unsigned)u.rb * D + (unsigned)u.pn * 256) * (unsigned)FE; }
    __device__ __forceinline__ void gather_ids(const Unit&, int, int, int (&)[4]) const {}
};

constexpr int TAIL_SPLIT = 7, TAIL_K = FE / TAIL_SPLIT;
struct MoeDownTailSched {
    static constexpr bool GATHER = false;
    pg8::TileOrder o; const char* A; const char* W; const LAS int* tab; int tile0;
    __device__ __forceinline__ bool next(int i, Unit& u) const {
        int cn; if (!o.tile(i, u.pm, cn)) return false;
        const int gt = tile0 + u.pm; int e = 0;
#pragma unroll
        for (int k = 1; k < 8; ++k) e += (gt >= tab[k]) ? 1 : 0;
        u.pn = cn & 3; u.rb = __builtin_amdgcn_readfirstlane(e) * 8 + (cn >> 2); u.e = u.pm * 256; return true;
    }
    __device__ __forceinline__ const char* a_ptr() const { return A; }
    __device__ __forceinline__ const char* b_ptr() const { return W; }
    __device__ __forceinline__ unsigned a_base(const Unit& u) const { return (unsigned)u.pm * (unsigned)(256 * FE) + (unsigned)(u.rb & 7) * TAIL_K; }
    __device__ __forceinline__ unsigned b_base(const Unit& u) const { return ((unsigned)(u.rb >> 3) * D + (unsigned)u.pn * 256) * (unsigned)FE + (unsigned)(u.rb & 7) * TAIL_K; }
    __device__ __forceinline__ void gather_ids(const Unit&, int, int, int (&)[4]) const {}
};
struct EpiSlotPart {
    static constexpr bool STASH = false; typedef float StashT;
    bf16_t* P;
    __device__ __forceinline__ void operator()(const f32x4 (&acc)[2][2][4][2], const Unit& u, int wr, int wc, int fr, int fq, const LAS float* rsl) const {
        const int lrow0 = wr * 64 + fr, col0 = u.pn * 256 + wc * 32 + 8 * fq; bf16_t* base = P + (size_t)(u.rb & 7) * 2048 * D;
#pragma unroll
        for (int ai = 0; ai < 2; ++ai)
#pragma unroll
            for (int m = 0; m < 4; ++m) { const size_t orow = (size_t)u.e + lrow0 + ai * 128 + m * 16;
#pragma unroll
                for (int bj = 0; bj < 2; ++bj) { const float sc = 1.0f / (F8_ACT * F8_WD); const f32x4 v0 = acc[ai][bj][m][0] * sc, v1 = acc[ai][bj][m][1] * sc;
                    u32x4 w; w.x = cvt_pk_bf16(v0[0], v0[1]); w.y = cvt_pk_bf16(v0[2], v0[3]); w.z = cvt_pk_bf16(v1[0], v1[1]); w.w = cvt_pk_bf16(v1[2], v1[3]);
                    *(u32x4*)(base + orow * D + col0 + bj * 128) = w; } }
    }
};

__device__ __forceinline__ void tr_item(const float* W, int K, int N, bf16_t* WT, const float* gain, int mode, LAS float* scr, int item, int lane, float f8s = 0.f) {
    const int nblk = N / 32, kb = item / nblk, nb = item % nblk, k0 = 64 * kb, n0 = 32 * nb;
    {
        const int r8 = lane >> 3, c4 = (lane & 7) * 4; f32x4 v[8]; float gn[8];
#pragma unroll
        for (int i = 0; i < 8; ++i) { v[i] = *(const f32x4*)(W + (size_t)(k0 + 8 * i + r8) * N + n0 + c4); gn[i] = gain ? gain[k0 + 8 * i + r8] : 1.0f; }
#pragma unroll
        for (int i = 0; i < 8; ++i) { LAS float* d = scr + (8 * i + r8) * 33 + c4; d[0] = v[i][0] * gn[i]; d[1] = v[i][1] * gn[i]; d[2] = v[i][2] * gn[i]; d[3] = v[i][3] * gn[i]; } }
    LDS_WAIT(); asm volatile("" ::: "memory");
    const int c = lane & 7;
#pragma unroll
    for (int j = 0; j < 4; ++j) { const int n = (lane >> 3) + 8 * j; const LAS float* s = scr + (8 * c) * 33 + n;
        u32x4 o; o.x = cvt_pk_bf16(s[0 * 33], s[1 * 33]); o.y = cvt_pk_bf16(s[2 * 33], s[3 * 33]); o.z = cvt_pk_bf16(s[4 * 33], s[5 * 33]); o.w = cvt_pk_bf16(s[6 * 33], s[7 * 33]);
        const int nn = n0 + n; const int row = (mode == 0) ? nn : (((nn >> 7) << 8) + (nn & 127) + (mode == 2 ? 128 : 0));
        if (f8s != 0.f) { const f32x4 a = {s[0 * 33] * f8s, s[1 * 33] * f8s, s[2 * 33] * f8s, s[3 * 33] * f8s}, b = {s[4 * 33] * f8s, s[5 * 33] * f8s, s[6 * 33] * f8s, s[7 * 33] * f8s};
            *(u32x2*)((unsigned char*)WT + (size_t)row * K + k0 + 8 * c) = cvt8_fp8(a, b); }
        else *(u32x4*)(WT + (size_t)row * K + k0 + 8 * c) = o; }
    LDS_WAIT(); asm volatile("" ::: "memory");
}
struct TrJob { const float* W; bf16_t* WT; const float* gain; int K, N, mode, items; float f8s; };
struct TrRegs { f32x4 v[8]; float gn[8]; };
__device__ __forceinline__ void tr_load(const TrJob& jb, int item, int lane, TrRegs& R) {
    const int nblk = jb.N / 32, kb = item / nblk, nb = item % nblk, k0 = 64 * kb, n0 = 32 * nb, r8 = lane >> 3, c4 = (lane & 7) * 4;
#pragma unroll
    for (int i = 0; i < 8; ++i) { R.v[i] = *(const f32x4*)(jb.W + (size_t)(k0 + 8 * i + r8) * jb.N + n0 + c4); R.gn[i] = jb.gain ? jb.gain[k0 + 8 * i + r8] : 1.0f; }
}
__device__ __forceinline__ void tr_fin(const TrJob& jb, int item, LAS float* scr, int lane, const TrRegs& R) {
    const int nblk = jb.N / 32, kb = item / nblk, nb = item % nblk, k0 = 64 * kb, n0 = 32 * nb, r8 = lane >> 3, c4 = (lane & 7) * 4;
#pragma unroll
    for (int i = 0; i < 8; ++i) { LAS float* d = scr + (8 * i + r8) * 33 + c4; d[0] = R.v[i][0] * R.gn[i]; d[1] = R.v[i][1] * R.gn[i]; d[2] = R.v[i][2] * R.gn[i]; d[3] = R.v[i][3] * R.gn[i]; }
    LDS_WAIT(); asm volatile("" ::: "memory");
    const int c = lane & 7;
#pragma unroll
    for (int j = 0; j < 4; ++j) { const int n = (lane >> 3) + 8 * j; const LAS float* s = scr + (8 * c) * 33 + n;
        const int nn = n0 + n; const int row = (jb.mode == 0) ? nn : (((nn >> 7) << 8) + (nn & 127) + (jb.mode == 2 ? 128 : 0));
        const float f8s = jb.f8s; const f32x4 a = {s[0 * 33] * f8s, s[1 * 33] * f8s, s[2 * 33] * f8s, s[3 * 33] * f8s}, b = {s[4 * 33] * f8s, s[5 * 33] * f8s, s[6 * 33] * f8s, s[7 * 33] * f8s};
        *(u32x2*)((unsigned char*)jb.WT + (size_t)row * jb.K + k0 + 8 * c) = cvt8_fp8(a, b); }
    LDS_WAIT(); asm volatile("" ::: "memory");
}


struct Args { const float* in[N_IN]; float* out; unsigned char* ws; int ph_lo, ph_hi, pass_lo, pass_hi; };

__device__ __forceinline__ void attn_naive(LAS unsigned char* lds, const bf16_t* Q, const bf16_t* KV, bf16_t* CAT, int bx, int G, int tid) {
    LAS float* Ks = (LAS float*)lds; LAS float* Vs = Ks + 256 * 64;
    for (int item = bx; item < NB * NH_MEM * 8; item += G) {
        const int b = item >> 5, h = (item >> 3) & 3, qb = item & 7;
#pragma unroll 4
        for (int i = 0; i < 32; ++i) { const int idx = tid + 512 * i, m = idx >> 6, d = idx & 63;
            const bf16_t* kr = KV + (size_t)(b * MEML + m) * 512 + h * 64 + d;
            Ks[idx] = bf2f(kr[0]); Vs[idx] = bf2f(kr[256]); }
        __syncthreads();
        const int row = b * SEQ + qb * 512 + tid;
        float q[64], o[64];
        { const u32x4* qp = (const u32x4*)(Q + (size_t)row * CM + h * 64);
#pragma unroll
          for (int i = 0; i < 8; ++i) { const u32x4 w = qp[i];
              q[8 * i + 0] = bflo(w.x) * 0.125f; q[8 * i + 1] = bfhi(w.x) * 0.125f; q[8 * i + 2] = bflo(w.y) * 0.125f; q[8 * i + 3] = bfhi(w.y) * 0.125f;
              q[8 * i + 4] = bflo(w.z) * 0.125f; q[8 * i + 5] = bfhi(w.z) * 0.125f; q[8 * i + 6] = bflo(w.w) * 0.125f; q[8 * i + 7] = bfhi(w.w) * 0.125f; } }
#pragma unroll
        for (int d = 0; d < 64; ++d) o[d] = 0.f;
        float mx = -1e30f, l = 0.f;
#pragma unroll 1
        for (int key = 0; key < MEML; ++key) {
            const LAS f32x4* kr = (const LAS f32x4*)(Ks + key * 64); float sc = 0.f;
#pragma unroll
            for (int d4 = 0; d4 < 16; ++d4) { const f32x4 kv = kr[d4]; sc += q[4 * d4] * kv[0] + q[4 * d4 + 1] * kv[1] + q[4 * d4 + 2] * kv[2] + q[4 * d4 + 3] * kv[3]; }
            const float mn = fmaxf(mx, sc), alpha = __expf(mx - mn), p = __expf(sc - mn); mx = mn; l = l * alpha + p;
            const LAS f32x4* vr = (const LAS f32x4*)(Vs + key * 64);
#pragma unroll
            for (int d4 = 0; d4 < 16; ++d4) { const f32x4 vv = vr[d4]; o[4 * d4] = o[4 * d4] * alpha + p * vv[0]; o[4 * d4 + 1] = o[4 * d4 + 1] * alpha + p * vv[1]; o[4 * d4 + 2] = o[4 * d4 + 2] * alpha + p * vv[2]; o[4 * d4 + 3] = o[4 * d4 + 3] * alpha + p * vv[3]; }
        }
        const float il = 1.0f / l;
        u32x4* op = (u32x4*)(CAT + (size_t)row * D + CS + h * 64);
#pragma unroll
        for (int i = 0; i < 8; ++i) { u32x4 w; w.x = cvt_pk_bf16(o[8 * i] * il, o[8 * i + 1] * il); w.y = cvt_pk_bf16(o[8 * i + 2] * il, o[8 * i + 3] * il);
            w.z = cvt_pk_bf16(o[8 * i + 4] * il, o[8 * i + 5] * il); w.w = cvt_pk_bf16(o[8 * i + 6] * il, o[8 * i + 7] * il); op[i] = w; }
        __syncthreads();
    }
}

__device__ __forceinline__ void s5_naive(const Args& a, LAS unsigned char* lds, const bf16_t* U, bf16_t* CAT, int bx, int G, int wave, int lane) {
    LAS float* xs = (LAS float*)(lds + wave * 1024);
    for (int it = bx + G * wave; it < NB * S5G; it += G * NWAVES) {
        const int b = it / S5G, g = it % S5G, p = lane;
        const double dt = exp((double)a.in[I_LOG_DT][g]), lr = a.in[I_LAM_RE][g * S5P + p], li = a.in[I_LAM_IM][g * S5P + p];
        const double mag = exp(lr * dt), ang = li * dt, abr_d = mag * cos(ang), abi_d = mag * sin(ang);
        const double nre = abr_d - 1.0, nim = abi_d, den = lr * lr + li * li, zr = (nre * lr + nim * li) / den, zi = (nim * lr - nre * li) / den;
        const float abr = (float)abr_d, abi = (float)abi_d;
        float bbr[16], bbi[16], cre[16], cim[16], wg[16];
#pragma unroll
        for (int j = 0; j < 16; ++j) { const double br = a.in[I_B_RE][(size_t)(g * S5P + p) * 16 + j], bi = a.in[I_B_IM][(size_t)(g * S5P + p) * 16 + j]; bbr[j] = (float)(zr * br - zi * bi); bbi[j] = (float)(zr * bi + zi * br); }
        const int jj = lane & 15, pq = lane >> 4;
#pragma unroll
        for (int q = 0; q < 16; ++q) { cre[q] = a.in[I_C_RE][(size_t)(g * 16 + jj) * S5P + 16 * pq + q]; cim[q] = a.in[I_C_IM][(size_t)(g * 16 + jj) * S5P + 16 * pq + q]; }
#pragma unroll
        for (int j = 0; j < 16; ++j) wg[j] = a.in[I_WGLU][(size_t)(g * 16 + j) * 16 + jj];
        const float dj = a.in[I_S5D][g * 16 + jj], bg = a.in[I_BGLU][g * 16 + jj];
        const bf16_t* up = U + (size_t)(b * S5G + g) * SEQ * 16;
        float xr = 0.f, xi = 0.f;
#pragma unroll 1
        for (int t = 0; t < SEQ; ++t) {
            const u32x4 w0 = *(const u32x4*)(up + (size_t)t * 16), w1 = *(const u32x4*)(up + (size_t)t * 16 + 8);
            float uf[16];
            uf[0] = bflo(w0.x); uf[1] = bfhi(w0.x); uf[2] = bflo(w0.y); uf[3] = bfhi(w0.y); uf[4] = bflo(w0.z); uf[5] = bfhi(w0.z); uf[6] = bflo(w0.w); uf[7] = bfhi(w0.w);
            uf[8] = bflo(w1.x); uf[9] = bfhi(w1.x); uf[10] = bflo(w1.y); uf[11] = bfhi(w1.y); uf[12] = bflo(w1.z); uf[13] = bfhi(w1.z); uf[14] = bflo(w1.w); uf[15] = bfhi(w1.w);
            const float uj = bf2f(up[(size_t)t * 16 + jj]);
            float bur = 0.f, bui = 0.f;
#pragma unroll
            for (int j = 0; j < 16; ++j) { bur += bbr[j] * uf[j]; bui += bbi[j] * uf[j]; }
            const float nxr = abr * xr - abi * xi + bur, nxi = abr * xi + abi * xr + bui; xr = nxr; xi = nxi;
            xs[p] = xr; xs[64 + p] = xi;
            LDS_WAIT(); asm volatile("" ::: "memory");
            float s = 0.f;
#pragma unroll
            for (int q4 = 0; q4 < 4; ++q4) { const f32x4 vr = *(const LAS f32x4*)(xs + 16 * pq + 4 * q4), vi = *(const LAS f32x4*)(xs + 64 + 16 * pq + 4 * q4);
#pragma unroll
                for (int e = 0; e < 4; ++e) s += cre[4 * q4 + e] * vr[e] - cim[4 * q4 + e] * vi[e]; }
            LDS_WAIT(); asm volatile("" ::: "memory");
            s += __shfl_xor(s, 16); s += __shfl_xor(s, 32);
            const float yg = gelu_tanh_(s + dj * uj);
            float z = bg;
#pragma unroll
            for (int j = 0; j < 16; ++j) z += __shfl(yg, j) * wg[j];
            const float o = yg * sigmoidf_(z);
            if (lane < 16) CAT[(size_t)(b * SEQ + t) * D + g * 16 + lane] = f2bf(o);
        }
    }
}

__device__ __forceinline__ void rwkv_prep(const Args& a, LAS unsigned char* lds, const bf16_t* P1, bf16_t* RA, bf16_t* RKK, bf16_t* RLD, bf16_t* RG, int bx, int G, int tid) {
    LAS float* twT = (LAS float*)lds; LAS float* adT = twT + 64 * 16; LAS float* sgT = adT + 64 * 16;
    const float* mu = a.in[I_MU];
    for (int tile = bx; tile < T / 16; tile += G) {
        __syncthreads();
#pragma unroll
        for (int i = 0; i < 8; ++i) { const int idx = tid + 512 * i, tok = idx >> 8, c = idx & 255, row = tile * 16 + tok, t = row & (SEQ - 1);
            const float cur = bf2f(P1[(size_t)row * INB + 2304 + c]), prev = t > 0 ? bf2f(P1[(size_t)(row - 1) * INB + 2304 + c]) : 0.f;
            const float xsv = cur + (prev - cur) * mu[2304 + c];
            if (c < 64) twT[c * 16 + tok] = tanhf(xsv); else if (c < 128) adT[(c - 64) * 16 + tok] = xsv; else sgT[(c - 128) * 16 + tok] = sigmoidf_(xsv); }
        __syncthreads();
        if (tid < 384) {
#pragma unroll 1
            for (int cc = 0; cc < 2; ++cc) { const int c = tid + 384 * cc;
                float aw[16], aa[16], ag[16];
#pragma unroll
                for (int k = 0; k < 16; ++k) { aw[k] = 0.f; aa[k] = 0.f; ag[k] = 0.f; }
#pragma unroll 2
                for (int m = 0; m < 64; ++m) { const float w2v = a.in[I_W2][(size_t)m * CS + c], a2v = a.in[I_A2][(size_t)m * CS + c];
#pragma unroll
                    for (int k4 = 0; k4 < 4; ++k4) { const f32x4 tw = *(const LAS f32x4*)(twT + m * 16 + 4 * k4), ad = *(const LAS f32x4*)(adT + m * 16 + 4 * k4);
#pragma unroll
                        for (int e = 0; e < 4; ++e) { aw[4 * k4 + e] += tw[e] * w2v; aa[4 * k4 + e] += ad[e] * a2v; } } }
#pragma unroll 2
                for (int m = 0; m < 128; ++m) { const float g2v = a.in[I_G2][(size_t)m * CS + c];
#pragma unroll
                    for (int k4 = 0; k4 < 4; ++k4) { const f32x4 sg = *(const LAS f32x4*)(sgT + m * 16 + 4 * k4);
#pragma unroll
                        for (int e = 0; e < 4; ++e) ag[4 * k4 + e] += sg[e] * g2v; } }
                const float w0 = a.in[I_W0][c], a0 = a.in[I_A0][c], kkw = a.in[I_KK][c], muk = mu[CS + c];
#pragma unroll
                for (int k = 0; k < 16; ++k) { const int row = tile * 16 + k, t = row & (SEQ - 1);
                    const float z = -(w0 + aw[k]);
                    const float sp = z > 20.f ? z : log1pf(__expf(z));
                    const float ld = -__expf(-sp - 0.5f);
                    const float av = sigmoidf_(a0 + aa[k]);
                    const float cur = bf2f(P1[(size_t)row * INB + CS + c]), prev = t > 0 ? bf2f(P1[(size_t)(row - 1) * INB + CS + c]) : 0.f;
                    const float kx = (cur + (prev - cur) * muk) * kkw;
                    const float ss = wave_sum(kx * kx);
                    const float kkv = kx / fmaxf(sqrtf(ss), 1e-12f);
                    const size_t o = (size_t)row * CS + c;
                    RA[o] = f2bf(av); RKK[o] = f2bf(kkv); RLD[o] = f2bf(ld); RG[o] = f2bf(ag[k]); }
            }
        }
    }
}

__device__ __forceinline__ void rwkv_naive(const Args& a, LAS unsigned char* lds, const bf16_t* P1, const bf16_t* RA, const bf16_t* RKK, const bf16_t* RLD, const bf16_t* RG, bf16_t* CAT, int bx, int G, int wave, int lane) {
    if (wave != 4) return;
    LAS float* vec = (LAS float*)lds;
    for (int item = bx; item < NB * RH; item += G) {
        const int b = item / RH, h = item % RH, c = h * 64 + lane;
        const float mur = a.in[I_MU][c], muk = a.in[I_MU][CS + c], muv = a.in[I_MU][2 * CS + c], ka = a.in[I_KA][c], rkc = a.in[I_RK][c], lw = a.in[I_LNXW][c], lb = a.in[I_LNXB][c];
        float S[64];
#pragma unroll
        for (int j = 0; j < 64; ++j) S[j] = 0.f;
        float prr = 0.f, prk = 0.f, prv = 0.f;
        const size_t row0 = (size_t)b * SEQ;
        bf16_t n_r = P1[row0 * INB + c], n_k = P1[row0 * INB + CS + c], n_v = P1[row0 * INB + 2 * CS + c], n_a = RA[row0 * CS + c], n_kk = RKK[row0 * CS + c], n_ld = RLD[row0 * CS + c], n_g = RG[row0 * CS + c];
#pragma unroll 1
        for (int t = 0; t < SEQ; ++t) {
            const float pr = bf2f(n_r), pk = bf2f(n_k), pv = bf2f(n_v), av = bf2f(n_a), kkv = bf2f(n_kk), ld = bf2f(n_ld), gv = bf2f(n_g);
            if (t + 1 < SEQ) { const size_t rn = row0 + t + 1; n_r = P1[rn * INB + c]; n_k = P1[rn * INB + CS + c]; n_v = P1[rn * INB + 2 * CS + c]; n_a = RA[rn * CS + c]; n_kk = RKK[rn * CS + c]; n_ld = RLD[rn * CS + c]; n_g = RG[rn * CS + c]; }
            const float r = pr + (prr - pr) * mur, k = pk + (prk - pk) * muk, v = pv + (prv - pv) * muv;
            prr = pr; prk = pk; prv = pv;
            const float kp = k * (1.f + (av - 1.f) * ka), ap = -kkv, bb = kkv * av, w = __expf(ld);
            vec[lane] = r; vec[64 + lane] = w; vec[128 + lane] = kp; vec[192 + lane] = ap; vec[256 + lane] = bb;
            LDS_WAIT(); asm volatile("" ::: "memory");
            float sa = 0.f;
#pragma unroll
            for (int j4 = 0; j4 < 16; ++j4) { const f32x4 x = *(const LAS f32x4*)(vec + 192 + 4 * j4); sa += S[4 * j4] * x[0] + S[4 * j4 + 1] * x[1] + S[4 * j4 + 2] * x[2] + S[4 * j4 + 3] * x[3]; }
            float y = 0.f;
#pragma unroll
            for (int j4 = 0; j4 < 16; ++j4) { const f32x4 wv = *(const LAS f32x4*)(vec + 64 + 4 * j4), bv = *(const LAS f32x4*)(vec + 256 + 4 * j4), kv = *(const LAS f32x4*)(vec + 128 + 4 * j4), rv = *(const LAS f32x4*)(vec + 4 * j4);
#pragma unroll
                for (int e = 0; e < 4; ++e) { const float s = S[4 * j4 + e] * wv[e] + sa * bv[e] + v * kv[e]; S[4 * j4 + e] = s; y += s * rv[e]; } }
            LDS_WAIT(); asm volatile("" ::: "memory");
            const float rkv = wave_sum(r * kp * rkc), bonus = rkv * v;
            const float mean = wave_sum(y) * (1.f / 64.f), dlt = y - mean, var = wave_sum(dlt * dlt) * (1.f / 64.f);
            const float yn = dlt * (1.0f / sqrtf(var + LNX_EPS)) * lw + lb;
            CAT[(row0 + t) * D + c] = f2bf((yn + bonus) * gv);
        }
    }
}

__device__ __forceinline__ void moe_router(const Args& a, const bf16_t* XB, unsigned* ctl, unsigned char* ws, int gw, int NGW, int lane, LAS unsigned char* sm, int wave) {
    int* list = (int*)(ws + WS_ROUTE2 + RT_LIST); float* lrstd = (float*)(ws + WS_ROUTE2 + RT_LRSTD);
    int* toke = (int*)(ws + WS_ROUTE2 + RT_TOKE); int* tokr = (int*)(ws + WS_ROUTE2 + RT_TOKR); float* tokw = (float*)(ws + WS_ROUTE2 + RT_TOKW);
    f32x2_t wg[16][4];
    {   const float* wr = a.in[I_WR]; const f32x4* gr = (const f32x4*)(a.in[I_NORM_FFN] + D) + lane;
#pragma unroll
        for (int j = 0; j < 4; ++j) { const f32x4 g = gr[64 * j];
#pragma unroll
            for (int i = 0; i < 4; ++i) { const int k = 4 * (lane + 64 * j) + i; const f32x4 w0 = *(const f32x4*)(wr + (size_t)k * 8), w1 = *(const f32x4*)(wr + (size_t)k * 8 + 4);
#pragma unroll
                for (int e = 0; e < 4; ++e) { wg[4 * j + i][e >> 1][e & 1] = g[i] * w0[e]; wg[4 * j + i][2 + (e >> 1)][e & 1] = g[i] * w1[e]; } } } }
    float br[8];
#pragma unroll
    for (int e = 0; e < 8; ++e) br[e] = a.in[I_BR][e];
    int m_bi = 0, m_si = 0; float m_rs = 0.f, m_w0 = 0.f;
    u32x2 va[4], vb[4];
#define RT_LOAD(v_, r_) do { const u32x2* xr_ = (const u32x2*)(XB + (size_t)(r_) * D) + lane; _Pragma("unroll") for (int j = 0; j < 4; ++j) v_[j] = xr_[64 * j]; } while (0)
#define RT_ROW(v_, i_) do { float lg[8]; float s = 0.f; f32x2_t lq[4]; \
        _Pragma("unroll") for (int e = 0; e < 4; ++e) lq[e] = (f32x2_t){0.f, 0.f}; \
        _Pragma("unroll") for (int j = 0; j < 4; ++j) _Pragma("unroll") for (int i = 0; i < 4; ++i) { const unsigned pw_ = (i < 2) ? v_[j].x : v_[j].y; const float hv = (i & 1) ? bfhi(pw_) : bflo(pw_); s += hv * hv; \
            const f32x2_t h2_ = {hv, hv}; \
            _Pragma("unroll") for (int e = 0; e < 4; ++e) lq[e] = __builtin_elementwise_fma(h2_, wg[4 * j + i][e], lq[e]); } \
        _Pragma("unroll") for (int e = 0; e < 4; ++e) { lg[2 * e] = lq[e].x; lg[2 * e + 1] = lq[e].y; } \
        wave_sum8(lg); const float rs = rstd_of(wave_sum_fast(s)); \
        _Pragma("unroll") for (int e = 0; e < 8; ++e) lg[e] = lg[e] * rs + br[e]; \
        float bv = lg[0]; int bi = 0; \
        _Pragma("unroll") for (int e = 1; e < 8; ++e) if (lg[e] > bv) { bv = lg[e]; bi = e; } \
        float sv = -3.0e38f; int si = 0; \
        _Pragma("unroll") for (int e = 0; e < 8; ++e) if (e != bi && lg[e] > sv) { sv = lg[e]; si = e; } \
        const float w0 = 1.0f / (1.0f + __expf(sv - bv)); \
        if (lane == (i_)) { m_bi = bi; m_si = si; m_rs = rs; m_w0 = w0; } } while (0)
    int nrow = 0;
    if (gw < T) RT_LOAD(va, gw);
    for (int r = gw; r < T; r += 2 * NGW) {
        const int r2 = r + NGW, r3 = r + 2 * NGW;
        RT_LOAD(vb, (r2 < T) ? r2 : r);
        __builtin_amdgcn_sched_barrier(0);
        RT_ROW(va, nrow); ++nrow;
        RT_LOAD(va, (r3 < T) ? r3 : r);
        __builtin_amdgcn_sched_barrier(0);
        if (r2 < T) { RT_ROW(vb, nrow); ++nrow; }
    }
#undef RT_LOAD
#undef RT_ROW
    {   LAS int* wcnt = (LAS int*)sm; LAS int* wbase = wcnt + 64;
        const bool act = lane < nrow; int myc = 0; unsigned long long mk[8];
#pragma unroll
        for (int e = 0; e < 8; ++e) { mk[e] = __ballot(act && (m_bi == e || m_si == e)); if (lane == e) myc = __popcll(mk[e]); }
        if (lane < 8) wcnt[wave * 8 + lane] = myc;
        __syncthreads();
        if (wave == 0 && lane < 8) { int tot = 0, pre[8];
#pragma unroll
            for (int w = 0; w < 8; ++w) { pre[w] = tot; tot += wcnt[w * 8 + lane]; }
            const int base = tot ? (int)atomicAdd(ctl + CW_CNT + 64 * lane, (unsigned)tot) : 0;
#pragma unroll
            for (int w = 0; w < 8; ++w) wbase[w * 8 + lane] = base + pre[w]; }
        __syncthreads();
        if (act) { const int r = gw + NGW * lane; const int bi = m_bi, si = m_si; const float rs = m_rs, w0 = m_w0, w1 = 1.0f - w0;
            const unsigned long long lt = (1ull << lane) - 1ull; int r0 = 0, r1 = 0;
#pragma unroll
            for (int e = 0; e < 8; ++e) { const int rk = wbase[wave * 8 + e] + __popcll(mk[e] & lt); if (bi == e) r0 = rk; if (si == e) r1 = rk; }
            list[bi * 32768 + r0] = r; lrstd[bi * 32768 + r0] = rs; list[si * 32768 + r1] = r; lrstd[si * 32768 + r1] = rs;
            toke[2 * r] = bi; toke[2 * r + 1] = si; tokr[2 * r] = r0; tokr[2 * r + 1] = r1; tokw[2 * r] = w0; tokw[2 * r + 1] = w1; } }
}

constexpr int RW_LS = 72;
constexpr int RW_SLOT = 64 * RW_LS * 2;
constexpr int RW_FS = 65;
__device__ __forceinline__ LAS unsigned char* rw_slot(LAS unsigned char* lds, int s) { return lds + s * RW_SLOT; }
__device__ __forceinline__ bf16x8 rw_frag(const LAS unsigned char* m, int row, int kq, int ks) { return *(const LAS bf16x8*)(m + row * (RW_LS * 2) + (32 * ks + 8 * kq) * 2); }
__device__ __forceinline__ f32x4 rw_mm(const LAS unsigned char* A, const LAS unsigned char* Bt, int mt, int nt, int l15, int kq, f32x4 acc) {
#pragma unroll
    for (int ks = 0; ks < 2; ++ks) acc = __builtin_amdgcn_mfma_f32_16x16x32_bf16(rw_frag(A, 16 * mt + l15, kq, ks), rw_frag(Bt, 16 * nt + l15, kq, ks), acc, 0, 0, 0);
    return acc;
}
__device__ __forceinline__ void rw_store_T(LAS unsigned char* m, int mt, int nt, int q, int n, f32x4 v) {
    u32x2 w; w.x = cvt_pk_bf16(v[0], v[1]); w.y = cvt_pk_bf16(v[2], v[3]);
    *(LAS u32x2*)(m + (16 * nt + n) * (RW_LS * 2) + (16 * mt + 4 * q) * 2) = w;
}
__device__ __forceinline__ void rw_store_D(LAS unsigned char* m, int mt, int nt, int q, int n, f32x4 v) {
#pragma unroll
    for (int r = 0; r < 4; ++r) *(LAS bf16_t*)(m + (16 * mt + 4 * q + r) * (RW_LS * 2) + (16 * nt + n) * 2) = f2bf(v[r]);
}
struct RwF2 { bf16x8 k[2]; };
__device__ __forceinline__ RwF2 rw_ld2(const LAS unsigned char* m, int row, int kq) { RwF2 f; f.k[0] = rw_frag(m, row, kq, 0); f.k[1] = rw_frag(m, row, kq, 1); return f; }
__device__ __forceinline__ f32x4 rw_mmf(const RwF2& a, const RwF2& b, f32x4 acc) {
    acc = __builtin_amdgcn_mfma_f32_16x16x32_bf16(a.k[0], b.k[0], acc, 0, 0, 0); return __builtin_amdgcn_mfma_f32_16x16x32_bf16(a.k[1], b.k[1], acc, 0, 0, 0); }
#define RW_LOADED() __builtin_amdgcn_sched_barrier(0)
__device__ __forceinline__ float rw_ld1(const LAS unsigned char* m, int row, int col) { return bf2f(*(const LAS bf16_t*)(m + row * (RW_LS * 2) + col * 2)); }

#ifdef DBG_RWKV
__device__ __forceinline__ void rw_dbg_scan(LAS unsigned char* lds, int slot, int bit, unsigned* word, int tid) {
    unsigned bad = 0u;
    for (int i = tid; i < 4096; i += NTHR) { const float v = rw_ld1(rw_slot(lds, slot), i >> 6, i & 63); if (!(v - v == 0.f)) bad = 1u; }
    if (bad) atomicOr(word, 1u << bit);
}
#define RW_DBG(slot, bit) rw_dbg_scan(lds, slot, bit, B.dbg, tid)
__device__ __forceinline__ void rw_dbg_max(LAS unsigned char* lds, int slot, unsigned* word, int tid) {
    float m = 0.f;
    for (int i = tid; i < 4096; i += NTHR) { const float v = fabsf(rw_ld1(rw_slot(lds, slot), i >> 6, i & 63)); if (v - v == 0.f) m = fmaxf(m, v); }
    atomicMax(word, __float_as_uint(m));
}
#else
#define RW_DBG(slot, bit)
#endif
struct RwBufs { unsigned* dbg;  bf16_t* XL; bf16_t* Pp; bf16_t* Qp; bf16_t* Rp; float* WL; bf16_t* GA; bf16_t* GB; bf16_t* CAT; const bf16_t* P1; const bf16_t* w2T; const bf16_t* a2T; const bf16_t* g2T; };

__device__ __forceinline__ void rwkv_xpre(const Args& a, const RwBufs& B, int bx, int G, int wave) {
    const int tid = wave * 64 + lane_now(), c8 = (tid & 31) * 8, seg = c8 >> 5, tr = tid >> 5;
    const float* mu = a.in[I_MU];
    const f32x4 m0 = *(const f32x4*)(mu + 2304 + c8), m1 = *(const f32x4*)(mu + 2304 + c8 + 4);
#pragma unroll 2
    for (int r = bx * 16 + tr; r < T; r += G * 16) {
        const bf16_t* cp = B.P1 + (size_t)r * INB + 2304 + c8;
        const u32x4 cw = *(const u32x4*)cp, pw = ((r & (SEQ - 1)) == 0) ? (u32x4){0u, 0u, 0u, 0u} : *(const u32x4*)(cp - INB);
        float x[8]; const unsigned cwa[4] = {cw.x, cw.y, cw.z, cw.w}, pwa[4] = {pw.x, pw.y, pw.z, pw.w};
#pragma unroll
        for (int e = 0; e < 4; ++e) { const float c0 = bflo(cwa[e]), c1 = bfhi(cwa[e]), p0 = bflo(pwa[e]), p1 = bfhi(pwa[e]);
            const float mm0 = (e < 2) ? m0[2 * e] : m1[2 * e - 4], mm1 = (e < 2) ? m0[2 * e + 1] : m1[2 * e - 3];
            x[2 * e] = c0 + (p0 - c0) * mm0; x[2 * e + 1] = c1 + (p1 - c1) * mm1; }
#pragma unroll
        for (int e = 0; e < 8; ++e) { const float sg = __builtin_amdgcn_rcpf(1.0f + __expf(seg < 2 ? -2.0f * x[e] : -x[e])); x[e] = (seg < 2) ? (2.0f * sg - 1.0f) : ((seg >= 4) ? sg : x[e]); }
        u32x4 o; o.x = cvt_pk_bf16(x[0], x[1]); o.y = cvt_pk_bf16(x[2], x[3]); o.z = cvt_pk_bf16(x[4], x[5]); o.w = cvt_pk_bf16(x[6], x[7]);
        *(u32x4*)(B.XL + (size_t)r * 256 + c8) = o; }
}

#ifndef RW_DUPS
#define RW_DUPS 0
#endif
#define RW_REP(bit) _Pragma("unroll 1") for (int rp_ = 0; rp_ < ((((RW_DUPS) >> (bit)) & 1) ? 4 : 1); ++rp_)
__device__ __forceinline__ void rwkv_r1(const Args& a, LAS unsigned char* lds, const RwBufs& B, int bx, int G, int wave, int nitems) {
    const int lane = lane_now(), l15 = lane & 15, kq = lane >> 4, q = kq, n = l15, tid = wave * 64 + lane;
    LAS float* Fw = (LAS float*)lds; LAS float* Fa = Fw + 64 * RW_FS; LAS float* Fg = Fa + 64 * RW_FS;
    LAS float* gsum = (LAS float*)(lds + 15 * RW_SLOT);
    const float* mu = a.in[I_MU];
    const int h = bx % RH, rk = bx / RH, nh = (G - h + RH - 1) / RH, nbc = nitems / RH;
    u32x4 pcw[4]; unsigned pfr[9], pfk[9], pfv[9];
#define RW_ISSUE(bc_) do { const int b_ = (bc_) >> 6, c_ = (bc_) & 63; const size_t r0_ = (size_t)b_ * SEQ + c_ * 64; \
        { const int tid_ = wave * 64 + lane_now(); const int t_ = tid_ >> 3, seg_ = tid_ & 7; const bf16_t* cp_ = B.XL + (r0_ + t_) * 256 + 32 * seg_; \
          _Pragma("unroll") for (int v8 = 0; v8 < 4; ++v8) pcw[v8] = *(const u32x4*)(cp_ + 8 * v8); } \
        { const bf16_t* pr0_ = B.P1 + (r0_ + 8 * wave) * INB + h * 64 + lane_now(); const bool z0_ = (c_ == 0 && wave == 0); \
          _Pragma("unroll") for (int u = 0; u < 9; ++u) { const bf16_t* pp_ = pr0_ + (ptrdiff_t)((u == 0 && z0_) ? 0 : (u - 1)) * INB;        \
              pfr[u] = pp_[0]; pfk[u] = pp_[CS]; pfv[u] = pp_[2 * CS]; } } } while (0)
    const int cgh = h * 64 + lane;
    const float hc_a0 = a.in[I_A0][cgh], hc_kk = a.in[I_KK][cgh], hc_ka = a.in[I_KA][cgh], hc_rk = a.in[I_RK][cgh], hc_lxw = a.in[I_LNXW][cgh], hc_lxb = a.in[I_LNXB][cgh];
    const float hc_mur = mu[cgh], hc_muk = mu[CS + cgh], hc_muv = mu[2 * CS + cgh], hc_w0n = a.in[I_W0][h * 64 + 16 * (wave & 3) + l15];
#define RW_WFR_LOAD \
        { const int ntw = wave & 3; const size_t rw = (size_t)(h * 64 + 16 * ntw + l15); \
    _Pragma("unroll") \
          for (int ks = 0; ks < 2; ++ks) { wfr[ks] = *(const bf16x8*)(B.w2T + rw * 64 + 32 * ks + 8 * kq); wfr[2 + ks] = *(const bf16x8*)(B.a2T + rw * 64 + 32 * ks + 8 * kq); } \
    _Pragma("unroll") \
          for (int ks = 0; ks < 4; ++ks) wfr[4 + ks] = *(const bf16x8*)(B.g2T + rw * 128 + 32 * ks + 8 * kq); } \

    bf16x8 wfr[8];
#if !RW_DUPS
    RW_WFR_LOAD
#endif
    if (rk < nbc) RW_ISSUE(rk);
#pragma unroll 1
    for (int bc = rk; bc < nbc; bc += nh) {
        const int b = bc >> 6, c = bc & 63, item = bc * RH + h;
        const size_t row0 = (size_t)b * SEQ + c * 64;
#if RW_DUPS
        RW_WFR_LOAD
#endif
        __syncthreads();
        { const int tid0 = wave * 64 + lane_now(), t = tid0 >> 3, seg = tid0 & 7;
          LAS unsigned char* dst = rw_slot(lds, 6 + (seg >> 1)) + t * (RW_LS * 2) + (32 * (seg & 1)) * 2;
#pragma unroll
          for (int v8 = 0; v8 < 4; ++v8) *(LAS u32x4*)(dst + 16 * v8) = pcw[v8]; }
        __syncthreads();
        RW_REP(1) {
#pragma unroll
        for (int i6 = 0; i6 < 6; ++i6) { const int ti = wave + 8 * i6, mat = i6 >> 1, mt = (ti >> 2) & 3, nt = wave & 3; f32x4 acc = {0.f, 0.f, 0.f, 0.f};
            if (mat < 2) { const LAS unsigned char* X = rw_slot(lds, 6 + mat);
#pragma unroll
                for (int ks = 0; ks < 2; ++ks) acc = __builtin_amdgcn_mfma_f32_16x16x32_bf16(rw_frag(X, 16 * mt + l15, kq, ks), wfr[2 * mat + ks], acc, 0, 0, 0);
            } else {
#pragma unroll
                for (int ks = 0; ks < 4; ++ks) acc = __builtin_amdgcn_mfma_f32_16x16x32_bf16(rw_frag(rw_slot(lds, 8 + (ks >> 1)), 16 * mt + l15, kq, ks & 1), wfr[4 + ks], acc, 0, 0, 0); }
            LAS float* F = (mat == 0) ? Fw : (mat == 1 ? Fa : Fg);
            if (mat == 0) {
                const float w0n = hc_w0n; float s4 = 0.f;
#pragma unroll
                for (int r = 0; r < 4; ++r) { const float z = -(w0n + acc[r]); acc[r] = -0.6065306597126334f * __builtin_amdgcn_rcpf(1.0f + __expf(z)); s4 += acc[r]; }
                s4 += __shfl_xor(s4, 16);
                if ((q & 1) == 0) gsum[(2 * mt + (q >> 1)) * 64 + 16 * nt + n] = s4; }
#pragma unroll
            for (int r = 0; r < 4; ++r) F[(16 * mt + 4 * q + r) * RW_FS + 16 * nt + n] = acc[r]; }
        __syncthreads();
        }
        RW_REP(2) {
        {   const int j = lane, cg = h * 64 + j, t0 = 8 * wave;
            const float a0 = hc_a0, kkw = hc_kk, kaw = hc_ka, rkw = hc_rk, lxw = hc_lxw, lxb = hc_lxb, mur = hc_mur, muk = hc_muk, muv = hc_muv;
            float ldv[8], av[8], rv[8], kv[8], vv[8], kkv[8];
            const bool zprev = (c == 0 && wave == 0);
            float pr_r = zprev ? 0.f : bflo(pfr[0]), pr_k = zprev ? 0.f : bflo(pfk[0]), pr_v = zprev ? 0.f : bflo(pfv[0]);
#pragma unroll
            for (int u = 0; u < 8; ++u) { const float cr = bflo(pfr[u + 1]), ck = bflo(pfk[u + 1]), cv = bflo(pfv[u + 1]);
                rv[u] = cr + (pr_r - cr) * mur; kv[u] = ck + (pr_k - ck) * muk; vv[u] = cv + (pr_v - cv) * muv; pr_r = cr; pr_k = ck; pr_v = cv;
                ldv[u] = Fw[(t0 + u) * RW_FS + j];
                av[u] = sigmoidf_(a0 + Fa[(t0 + u) * RW_FS + j]);
                const float kx = kv[u] * kkw; const float ss = wave_sum_fast(kx * kx); kkv[u] = kx * __builtin_amdgcn_rsqf(fmaxf(ss, 1e-24f)); }
            float lw[8]; lw[0] = ldv[0];
#pragma unroll
            for (int u = 1; u < 8; ++u) lw[u] = lw[u - 1] + ldv[u];
            float off = 0.f, tot = 0.f;
#pragma unroll
            for (int w8 = 0; w8 < 8; ++w8) { const float gs = gsum[w8 * 64 + j]; tot += gs; if (w8 < wave) off += gs; }
            if (wave == 0) B.WL[(size_t)item * 64 + lane_now()] = __expf(tot);
            unsigned pAt[4], pBh[4], pKh[4], pV[4], pga[4], pgb[4];
            const float WLt = __expf(tot); float Wprev = __expf(off);
#pragma unroll
            for (int u2 = 0; u2 < 4; ++u2) { float tAt[2], tBh[2], tKh[2], ga2[2], gb2[2];
#pragma unroll
                for (int uu = 0; uu < 2; ++uu) { const int u = 2 * u2 + uu; const float lwt = off + lw[u];
                    const float kp = kv[u] * (1.f + (av[u] - 1.f) * kaw), ap = -kkv[u], bb = kkv[u] * av[u];
                    const float Wt = __expf(lwt), Wm1 = Wprev, iW = __builtin_amdgcn_rcpf(Wt), WLr = WLt * iW; Wprev = Wt;
                    const float bonus = wave_sum_fast(rv[u] * kp * rkw);
                    const float gv = Fg[(t0 + u) * RW_FS + j];
                    ga2[uu] = lxw * gv; gb2[uu] = (lxb + bonus * vv[u]) * gv;
                    const int t = t0 + u;
                    *(LAS bf16_t*)(rw_slot(lds, 10) + t * (RW_LS * 2) + j * 2) = f2bf(ap * Wm1);
                    *(LAS bf16_t*)(rw_slot(lds, 11) + t * (RW_LS * 2) + j * 2) = f2bf(bb * iW);
                    *(LAS bf16_t*)(rw_slot(lds, 12) + t * (RW_LS * 2) + j * 2) = f2bf(kp * iW);
                    *(LAS bf16_t*)(rw_slot(lds, 13) + t * (RW_LS * 2) + j * 2) = f2bf(rv[u] * Wt);
                    tAt[uu] = ap * Wm1; tBh[uu] = bb * WLr; tKh[uu] = kp * WLr; }
                pAt[u2] = cvt_pk_bf16(tAt[0], tAt[1]); pBh[u2] = cvt_pk_bf16(tBh[0], tBh[1]); pKh[u2] = cvt_pk_bf16(tKh[0], tKh[1]); pV[u2] = cvt_pk_bf16(vv[2 * u2], vv[2 * u2 + 1]);
                pga[u2] = cvt_pk_bf16(ga2[0], ga2[1]); pgb[u2] = cvt_pk_bf16(gb2[0], gb2[1]); }
            *(LAS u32x4*)(rw_slot(lds, 14) + j * (RW_LS * 2) + t0 * 2) = (u32x4){pAt[0], pAt[1], pAt[2], pAt[3]};
            *(LAS u32x4*)(rw_slot(lds, 6) + j * (RW_LS * 2) + t0 * 2) = (u32x4){pBh[0], pBh[1], pBh[2], pBh[3]};
            *(LAS u32x4*)(rw_slot(lds, 7) + j * (RW_LS * 2) + t0 * 2) = (u32x4){pKh[0], pKh[1], pKh[2], pKh[3]};
            *(LAS u32x4*)(rw_slot(lds, 8) + j * (RW_LS * 2) + t0 * 2) = (u32x4){pV[0], pV[1], pV[2], pV[3]};
            { const int j2 = lane_now(); bf16_t* gap = B.GA + (size_t)item * 4096 + j2 * 64; bf16_t* gbp = B.GB + (size_t)item * 4096 + j2 * 64;
#pragma unroll
              for (int hh = 0; hh < 2; ++hh) { const int pos = (2 * (wave & 1) + hh) * 16 + (wave >> 1) * 4;
                  *(u32x2*)(gap + pos) = (u32x2){pga[2 * hh], pga[2 * hh + 1]}; *(u32x2*)(gbp + pos) = (u32x2){pgb[2 * hh], pgb[2 * hh + 1]}; } }
        }
        __syncthreads();
        }
        if (bc + nh < nbc) RW_ISSUE(bc + nh);
        RW_DBG(10, 0); RW_DBG(11, 1); RW_DBG(12, 2); RW_DBG(13, 3); RW_DBG(14, 4); RW_DBG(6, 5); RW_DBG(7, 6); RW_DBG(8, 7);
        RW_REP(3) {
        {   const int nt = wave & 3, mta = wave >> 2, mtb = mta + 2; const f32x4 z4 = {0.f, 0.f, 0.f, 0.f};
            const int da = 16 * (mta - nt) + 4 * q - n, db = 16 * (mtb - nt) + 4 * q - n;
#define RW_MASK(acc_, d_, MODE) do { _Pragma("unroll") for (int r = 0; r < 4; ++r) { const bool keep = (MODE == 0) ? ((d_) + r > 0) : ((MODE == 1) ? ((d_) + r < 0) : ((d_) + r <= 0)); acc_[r] = keep ? acc_[r] : 0.f; } } while (0)
            {   const RwF2 a10a = rw_ld2(rw_slot(lds, 10), 16 * mta + l15, kq), a10b = rw_ld2(rw_slot(lds, 10), 16 * mtb + l15, kq), b11 = rw_ld2(rw_slot(lds, 11), 16 * nt + l15, kq);
                const RwF2 a12a = rw_ld2(rw_slot(lds, 12), 16 * mta + l15, kq), a12b = rw_ld2(rw_slot(lds, 12), 16 * mtb + l15, kq), b10 = rw_ld2(rw_slot(lds, 10), 16 * nt + l15, kq);
                RW_LOADED();
                f32x4 c0 = rw_mmf(a10a, b11, z4), c1 = rw_mmf(a10b, b11, z4), c2 = rw_mmf(a12a, b10, z4), c3 = rw_mmf(a12b, b10, z4);
                RW_MASK(c0, da, 0); RW_MASK(c1, db, 0); RW_MASK(c2, da, 1); RW_MASK(c3, db, 1);
                rw_store_T(rw_slot(lds, 0), mta, nt, q, n, c0); rw_store_T(rw_slot(lds, 0), mtb, nt, q, n, c1); rw_store_T(rw_slot(lds, 1), mta, nt, q, n, c2); rw_store_T(rw_slot(lds, 1), mtb, nt, q, n, c3);
                RW_LOADED(); }
            {   const RwF2 a11a = rw_ld2(rw_slot(lds, 11), 16 * mta + l15, kq), a11b = rw_ld2(rw_slot(lds, 11), 16 * mtb + l15, kq), b13 = rw_ld2(rw_slot(lds, 13), 16 * nt + l15, kq);
                const RwF2 a12a = rw_ld2(rw_slot(lds, 12), 16 * mta + l15, kq), a12b = rw_ld2(rw_slot(lds, 12), 16 * mtb + l15, kq);
                RW_LOADED();
                f32x4 c0 = rw_mmf(a11a, b13, z4), c1 = rw_mmf(a11b, b13, z4), c2 = rw_mmf(a12a, b13, z4), c3 = rw_mmf(a12b, b13, z4);
                RW_MASK(c0, da, 2); RW_MASK(c1, db, 2); RW_MASK(c2, da, 2); RW_MASK(c3, db, 2);
                rw_store_T(rw_slot(lds, 2), mta, nt, q, n, c0); rw_store_T(rw_slot(lds, 2), mtb, nt, q, n, c1); rw_store_T(rw_slot(lds, 3), mta, nt, q, n, c2); rw_store_T(rw_slot(lds, 3), mtb, nt, q, n, c3);
                RW_LOADED(); } }
        for (int i = wave * 64 + lane_now(); i < 2 * RW_SLOT / 16; i += NTHR) *(LAS u32x4*)(rw_slot(lds, 4) + i * 16) = (u32x4){0u, 0u, 0u, 0u};
        __syncthreads();
        }
        RW_DBG(0, 8); RW_DBG(1, 9); RW_DBG(2, 10); RW_DBG(3, 11);
#ifdef DBG_RWKV
        rw_dbg_max(lds, DBG_MAXSLOT_A, B.dbg + 1, tid);
#endif
        RW_REP(4) {
        if (wave >= 4) {
            {   const int nt = wave & 3; const f32x4 z4 = {0.f, 0.f, 0.f, 0.f};
                const RwF2 a0 = rw_ld2(rw_slot(lds, 1), l15, kq), a1 = rw_ld2(rw_slot(lds, 1), 16 + l15, kq), a2 = rw_ld2(rw_slot(lds, 1), 32 + l15, kq), a3 = rw_ld2(rw_slot(lds, 1), 48 + l15, kq), b8 = rw_ld2(rw_slot(lds, 8), 16 * nt + l15, kq);
                RW_LOADED();
                const f32x4 c0 = rw_mmf(a0, b8, z4), c1 = rw_mmf(a1, b8, z4), c2 = rw_mmf(a2, b8, z4), c3 = rw_mmf(a3, b8, z4);
                rw_store_T(rw_slot(lds, 12), 0, nt, q, n, c0); rw_store_T(rw_slot(lds, 12), 1, nt, q, n, c1); rw_store_T(rw_slot(lds, 12), 2, nt, q, n, c2); rw_store_T(rw_slot(lds, 12), 3, nt, q, n, c3); } }
        if (wave < 4 && lane_now() < 16) { const int i0 = 16 * wave, cc = lane_now(); float Tc[16];
            const LAS unsigned char* AT = rw_slot(lds, 0);
#pragma unroll
            for (int t = 0; t < 16; ++t) { float s = (t == cc) ? 1.f : 0.f;
#pragma unroll
                for (int s2 = 0; s2 < t; ++s2) s += rw_ld1(AT, i0 + s2, i0 + t) * Tc[s2];
                Tc[t] = s; }
#pragma unroll
            for (int t = 0; t < 16; ++t) *(LAS bf16_t*)(rw_slot(lds, 4) + (i0 + t) * (RW_LS * 2) + (i0 + cc) * 2) = f2bf(Tc[t]);
            u32x4 o0, o1; o0.x = cvt_pk_bf16(Tc[0], Tc[1]); o0.y = cvt_pk_bf16(Tc[2], Tc[3]); o0.z = cvt_pk_bf16(Tc[4], Tc[5]); o0.w = cvt_pk_bf16(Tc[6], Tc[7]);
            o1.x = cvt_pk_bf16(Tc[8], Tc[9]); o1.y = cvt_pk_bf16(Tc[10], Tc[11]); o1.z = cvt_pk_bf16(Tc[12], Tc[13]); o1.w = cvt_pk_bf16(Tc[14], Tc[15]);
            *(LAS u32x4*)(rw_slot(lds, 5) + (i0 + cc) * (RW_LS * 2) + i0 * 2) = o0; *(LAS u32x4*)(rw_slot(lds, 5) + (i0 + cc) * (RW_LS * 2) + (i0 + 8) * 2) = o1;
        }
#if RW_DUPS
        __syncthreads();
#endif
        }
        if (wave < 4 && lane_now() < 16) { const int i0 = 16 * wave, cc = lane_now();
            LDS_WAIT();
            *(LAS u32x4*)(rw_slot(lds, 0) + (i0 + cc) * (RW_LS * 2) + i0 * 2) = (u32x4){0u, 0u, 0u, 0u}; *(LAS u32x4*)(rw_slot(lds, 0) + (i0 + cc) * (RW_LS * 2) + (i0 + 8) * 2) = (u32x4){0u, 0u, 0u, 0u};
        }
        __syncthreads();
        RW_DBG(4, 12); RW_DBG(5, 13);
#ifdef DBG_RWKV
        rw_dbg_max(lds, 4, B.dbg + 2, tid);
#endif
        RW_REP(5) {
        {   const int nt = wave & 3, mta = wave >> 2, mtb = mta + 2; const f32x4 z4 = {0.f, 0.f, 0.f, 0.f};
            const RwF2 a4a = rw_ld2(rw_slot(lds, 4), 16 * mta + l15, kq), a4b = rw_ld2(rw_slot(lds, 4), 16 * mtb + l15, kq), b0 = rw_ld2(rw_slot(lds, 0), 16 * nt + l15, kq);
            RW_LOADED();
            const f32x4 c0 = rw_mmf(a4a, b0, z4), c1 = rw_mmf(a4b, b0, z4);
            rw_store_T(rw_slot(lds, 11), mta, nt, q, n, c0); rw_store_D(rw_slot(lds, 9), mta, nt, q, n, c0); rw_store_T(rw_slot(lds, 11), mtb, nt, q, n, c1); rw_store_D(rw_slot(lds, 9), mtb, nt, q, n, c1); }
        __syncthreads();
        }
        RW_DBG(9, 14); RW_DBG(11, 15);
#ifdef DBG_RWKV
        rw_dbg_max(lds, 11, B.dbg + 3, tid);
#endif
        RW_REP(6) {
        {   const int nt = wave & 3, mta = wave >> 2, mtb = mta + 2; const f32x4 z4 = {0.f, 0.f, 0.f, 0.f};
            const RwF2 a11a = rw_ld2(rw_slot(lds, 11), 16 * mta + l15, kq), a11b = rw_ld2(rw_slot(lds, 11), 16 * mtb + l15, kq), b9 = rw_ld2(rw_slot(lds, 9), 16 * nt + l15, kq);
            const RwF2 a9a = rw_ld2(rw_slot(lds, 9), 16 * mta + l15, kq), a9b = rw_ld2(rw_slot(lds, 9), 16 * mtb + l15, kq), b5 = rw_ld2(rw_slot(lds, 5), 16 * nt + l15, kq);
            const u32x2 dga = *(const LAS u32x2*)(rw_slot(lds, 5) + (16 * nt + n) * (RW_LS * 2) + (16 * mta + 4 * q) * 2), dgb = *(const LAS u32x2*)(rw_slot(lds, 5) + (16 * nt + n) * (RW_LS * 2) + (16 * mtb + 4 * q) * 2);
            RW_LOADED();
            const f32x4 c0 = rw_mmf(a11a, b9, z4), c1 = rw_mmf(a11b, b9, z4);
            const f32x4 c2 = rw_mmf(a9a, b5, (f32x4){bflo(dga.x), bfhi(dga.x), bflo(dga.y), bfhi(dga.y)}), c3 = rw_mmf(a9b, b5, (f32x4){bflo(dgb.x), bfhi(dgb.x), bflo(dgb.y), bfhi(dgb.y)});
            rw_store_T(rw_slot(lds, 10), mta, nt, q, n, c0); rw_store_T(rw_slot(lds, 10), mtb, nt, q, n, c1);
            RW_LOADED();
            rw_store_T(rw_slot(lds, 0), mta, nt, q, n, c2); rw_store_T(rw_slot(lds, 0), mtb, nt, q, n, c3); }
        __syncthreads();
        }
        RW_DBG(10, 16); RW_DBG(0, 17);
        RW_REP(7) {
        {   const int nt = wave & 3, mta = wave >> 2, mtb = mta + 2;
            const RwF2 a0a = rw_ld2(rw_slot(lds, 0), 16 * mta + l15, kq), a0b = rw_ld2(rw_slot(lds, 0), 16 * mtb + l15, kq), b10 = rw_ld2(rw_slot(lds, 10), 16 * nt + l15, kq);
            f32x4 za, zb;
#pragma unroll
            for (int r = 0; r < 4; ++r) { za[r] = rw_ld1(rw_slot(lds, 0), 16 * mta + 4 * q + r, 16 * nt + n); zb[r] = rw_ld1(rw_slot(lds, 0), 16 * mtb + 4 * q + r, 16 * nt + n); }
            RW_LOADED();
            const f32x4 c0 = rw_mmf(a0a, b10, za), c1 = rw_mmf(a0b, b10, zb);
            rw_store_T(rw_slot(lds, 4), mta, nt, q, n, c0); rw_store_T(rw_slot(lds, 4), mtb, nt, q, n, c1); }
        __syncthreads();
        }
        RW_DBG(4, 18);
        RW_REP(8) {
        {   const int nt = wave & 3, mta = wave >> 2, mtb = mta + 2; const f32x4 z4 = {0.f, 0.f, 0.f, 0.f};
            const RwF2 a4a = rw_ld2(rw_slot(lds, 4), 16 * mta + l15, kq), a4b = rw_ld2(rw_slot(lds, 4), 16 * mtb + l15, kq), b14 = rw_ld2(rw_slot(lds, 14), 16 * nt + l15, kq), b12 = rw_ld2(rw_slot(lds, 12), 16 * nt + l15, kq);
            RW_LOADED();
            const f32x4 c0 = rw_mmf(a4a, b14, z4), c1 = rw_mmf(a4b, b14, z4), c2 = rw_mmf(a4a, b12, z4), c3 = rw_mmf(a4b, b12, z4);
            rw_store_T(rw_slot(lds, 5), mta, nt, q, n, c0); rw_store_T(rw_slot(lds, 5), mtb, nt, q, n, c1); rw_store_T(rw_slot(lds, 11), mta, nt, q, n, c2); rw_store_T(rw_slot(lds, 11), mtb, nt, q, n, c3); }
        __syncthreads();
        }
        RW_DBG(5, 19); RW_DBG(11, 21);
        RW_REP(10) {
        {   const int nt = wave & 3, mta = wave >> 2, mtb = mta + 2; const f32x4 z4 = {0.f, 0.f, 0.f, 0.f};
#define RW_PK(c_) ((u32x2){cvt_pk_bf16(c_[0], c_[1]), cvt_pk_bf16(c_[2], c_[3])})
            {
                const RwF2 a5a = rw_ld2(rw_slot(lds, 5), 16 * mta + l15, kq), a5b = rw_ld2(rw_slot(lds, 5), 16 * mtb + l15, kq), b6 = rw_ld2(rw_slot(lds, 6), 16 * nt + l15, kq), b2 = rw_ld2(rw_slot(lds, 2), 16 * nt + l15, kq);
                const u32x2 rta = *(const LAS u32x2*)(rw_slot(lds, 13) + (16 * nt + n) * (RW_LS * 2) + (16 * mta + 4 * q) * 2), rtb = *(const LAS u32x2*)(rw_slot(lds, 13) + (16 * nt + n) * (RW_LS * 2) + (16 * mtb + 4 * q) * 2);
                RW_LOADED();
                const f32x4 c0 = rw_mmf(a5a, b6, z4), c1 = rw_mmf(a5b, b6, z4);
                const f32x4 c2 = rw_mmf(a5a, b2, (f32x4){bflo(rta.x), bfhi(rta.x), bflo(rta.y), bfhi(rta.y)}), c3 = rw_mmf(a5b, b2, (f32x4){bflo(rtb.x), bfhi(rtb.x), bflo(rtb.y), bfhi(rtb.y)});
                *(u32x2*)(B.Pp + (size_t)item * 4096 + (size_t)((nt * 2 + (mta >> 1)) * 64 + n + 16 * q) * 8 + 4 * (mta & 1)) = RW_PK(c0);
                *(u32x2*)(B.Pp + (size_t)item * 4096 + (size_t)((nt * 2 + (mtb >> 1)) * 64 + n + 16 * q) * 8 + 4 * (mtb & 1)) = RW_PK(c1);
                *(u32x2*)(B.Rp + (size_t)item * 4096 + (size_t)((nt * 2 + (mta >> 1)) * 64 + n + 16 * q) * 8 + 4 * (mta & 1)) = RW_PK(c2);
                *(u32x2*)(B.Rp + (size_t)item * 4096 + (size_t)((nt * 2 + (mtb >> 1)) * 64 + n + 16 * q) * 8 + 4 * (mtb & 1)) = RW_PK(c3);
                RW_LOADED(); }
            {
                const RwF2 b11 = rw_ld2(rw_slot(lds, 11), 16 * nt + l15, kq), b8 = rw_ld2(rw_slot(lds, 8), 16 * nt + l15, kq);
                const RwF2 a6a = rw_ld2(rw_slot(lds, 6), 16 * mta + l15, kq), a6b = rw_ld2(rw_slot(lds, 6), 16 * mtb + l15, kq), a7a = rw_ld2(rw_slot(lds, 7), 16 * mta + l15, kq), a7b = rw_ld2(rw_slot(lds, 7), 16 * mtb + l15, kq);
                RW_LOADED();
                f32x4 c0 = rw_mmf(a6a, b11, z4), c1 = rw_mmf(a6b, b11, z4); c0 = rw_mmf(a7a, b8, c0); c1 = rw_mmf(a7b, b8, c1);
                *(u32x2*)(B.Qp + (size_t)item * 4096 + (size_t)((nt * 4 + mta) * 64 + lane_now()) * 4) = RW_PK(c0);
                *(u32x2*)(B.Qp + (size_t)item * 4096 + (size_t)((nt * 4 + mtb) * 64 + lane_now()) * 4) = RW_PK(c1);
                RW_LOADED();
                const RwF2 a2a = rw_ld2(rw_slot(lds, 2), 16 * mta + l15, kq), a2b = rw_ld2(rw_slot(lds, 2), 16 * mtb + l15, kq), a3a = rw_ld2(rw_slot(lds, 3), 16 * mta + l15, kq), a3b = rw_ld2(rw_slot(lds, 3), 16 * mtb + l15, kq);
                RW_LOADED();
                f32x4 c2 = rw_mmf(a2a, b11, z4), c3 = rw_mmf(a2b, b11, z4); c2 = rw_mmf(a3a, b8, c2); c3 = rw_mmf(a3b, b8, c3);
                *(u32x2*)(B.CAT + (row0 + 16 * nt + n) * D + h * 64 + q * 16 + mta * 4) = RW_PK(c2);
                *(u32x2*)(B.CAT + (row0 + 16 * nt + n) * D + h * 64 + q * 16 + mtb * 4) = RW_PK(c3); }
        }
#if RW_DUPS
        __syncthreads();
#endif
        }
    }
}

constexpr int R2_SLOT = 2 * 8192 + 256, R2_LA = 7;
#define R2_WAITV(n) asm volatile("s_waitcnt vmcnt(" #n ")" ::: "memory")
struct R2Own { u32x2 qv[4]; u32x4 y0, y1; };
__device__ __forceinline__ void rwkv_r2(LAS unsigned char* lds, const RwBufs& B, int bx, int G, int wave, int nbh, bool dry = false) {
    const int lane = lane_now(), q = lane >> 4, n = lane & 15, wv = wave & 3;
#pragma unroll 1
    for (int bh = bx; bh < nbh; bh += G) {
        const int b = bh / RH, h = bh % RH;
        __syncthreads();
#define R2_ISSUE(c_) do { const int cc_ = (c_); const size_t item_ = (size_t)(b * 64 + cc_) * RH + h; LAS unsigned char* sl_ = lds + (cc_ & 7) * R2_SLOT; \
            const bf16_t* src_ = (wv < 2 ? B.Pp : B.Rp) + item_ * 4096 + (size_t)(wv & 1) * 2048 + lane_now() * 8; \
            _Pragma("unroll") for (int f = 0; f < 4; ++f) __builtin_amdgcn_global_load_lds((const unsigned*)(src_ + f * 512), (LAS unsigned*)(sl_ + (wv >> 1) * 8192 + (wv & 1) * 4096 + f * 1024), 16, 0, 0); \
            if (wv == 3 && lane_now() < 16) __builtin_amdgcn_global_load_lds((const unsigned*)(B.WL + item_ * 64 + lane_now() * 4), (LAS unsigned*)(sl_ + 2 * 8192), 16, 0, 0); } while (0)
#define R2_LANDED(c1_) do { const int af_ = (((c1_) + R2_LA - 1 < 63) ? ((c1_) + R2_LA - 1) : 63) - (c1_); \
            if (wv < 3) { if (af_ >= 6) R2_WAITV(24); else if (af_ == 5) R2_WAITV(20); else if (af_ == 4) R2_WAITV(16); else if (af_ == 3) R2_WAITV(12); else if (af_ == 2) R2_WAITV(8); else if (af_ == 1) R2_WAITV(4); else R2_WAITV(0); } \
            else        { if (af_ >= 6) R2_WAITV(30); else if (af_ == 5) R2_WAITV(25); else if (af_ == 4) R2_WAITV(20); else if (af_ == 3) R2_WAITV(15); else if (af_ == 2) R2_WAITV(10); else if (af_ == 1) R2_WAITV(5); else R2_WAITV(0); } } while (0)
#define R2_OWN(O_, c_) do { const int cc_ = (c_); const size_t item_ = (size_t)(b * 64 + cc_) * RH + h; const size_t rw0_ = (size_t)b * SEQ + cc_ * 64; \
            _Pragma("unroll") for (int mt = 0; mt < 4; ++mt) O_.qv[mt] = *(const u32x2*)(B.Qp + item_ * 4096 + (size_t)((wv * 4 + mt) * 64 + lane) * 4); \
            const bf16_t* yp_ = B.CAT + (rw0_ + 16 * wv + n) * D + h * 64 + q * 16; O_.y0 = *(const u32x4*)yp_; O_.y1 = *(const u32x4*)(yp_ + 8); } while (0)
        f32x4 S[4];
#pragma unroll
        for (int mt = 0; mt < 4; ++mt) S[mt] = (f32x4){0.f, 0.f, 0.f, 0.f};
        R2Own Oa, Ob, Oc, Od;
        if (wave >= 4) { R2_ISSUE(0); R2_ISSUE(1); R2_ISSUE(2); R2_ISSUE(3); R2_ISSUE(4); R2_ISSUE(5); R2_ISSUE(6); R2_LANDED(0); }
        else { R2_OWN(Oa, 0); R2_OWN(Ob, 1); R2_OWN(Oc, 2); R2_OWN(Od, 3); }
        __syncthreads();
#define R2_STEP(O_, c_) do { const int c = (c_); \
            if (wave >= 4) { if (c + R2_LA < 64) R2_ISSUE(c + R2_LA); if (c + 1 < 64) R2_LANDED(c + 1); } \
            else { \
                const size_t row0 = (size_t)b * SEQ + c * 64; const LAS unsigned char* sl = lds + (c & 7) * R2_SLOT; \
                bf16x8 pf[8], rf[8]; \
                _Pragma("unroll") for (int f = 0; f < 8; ++f) { pf[f] = *(const LAS bf16x8*)(sl + f * 1024 + lane * 16); rf[f] = *(const LAS bf16x8*)(sl + 8192 + f * 1024 + lane * 16); } \
                f32x4 wl[4]; \
                _Pragma("unroll") for (int mt = 0; mt < 4; ++mt) wl[mt] = *(const LAS f32x4*)(sl + 2 * 8192 + (16 * mt + 4 * q) * 4); \
                bf16_t* yp = B.CAT + (row0 + 16 * wv + n) * D + h * 64 + q * 16; \
                  \
                bf16x8 sh[2], sl2[2]; \
                _Pragma("unroll") for (int ks = 0; ks < 2; ++ks) { unsigned hw[4], lw[4]; \
                    _Pragma("unroll") for (int hf = 0; hf < 2; ++hf) { const f32x4 s = S[2 * ks + hf]; \
                        const unsigned h01 = cvt_pk_bf16(s[0], s[1]), h23 = cvt_pk_bf16(s[2], s[3]); \
                        hw[2 * hf] = h01; hw[2 * hf + 1] = h23; \
                        lw[2 * hf] = cvt_pk_bf16(s[0] - bflo(h01), s[1] - bfhi(h01)); lw[2 * hf + 1] = cvt_pk_bf16(s[2] - bflo(h23), s[3] - bfhi(h23)); } \
                    u32x4 hv = {hw[0], hw[1], hw[2], hw[3]}, lv = {lw[0], lw[1], lw[2], lw[3]}; \
                    sh[ks] = __builtin_bit_cast(bf16x8, hv); sl2[ks] = __builtin_bit_cast(bf16x8, lv); } \
                  \
                f32x4 ya[4]; \
                { const unsigned yw[8] = {O_.y0.x, O_.y0.y, O_.y0.z, O_.y0.w, O_.y1.x, O_.y1.y, O_.y1.z, O_.y1.w}; \
                  _Pragma("unroll") for (int mt = 0; mt < 4; ++mt) ya[mt] = (f32x4){bflo(yw[2 * mt]), bfhi(yw[2 * mt]), bflo(yw[2 * mt + 1]), bfhi(yw[2 * mt + 1])}; } \
                _Pragma("unroll") for (int mt = 0; mt < 4; ++mt) _Pragma("unroll") for (int ks = 0; ks < 2; ++ks) { \
                    ya[mt] = __builtin_amdgcn_mfma_f32_16x16x32_bf16(rf[mt * 2 + ks], sh[ks], ya[mt], 0, 0, 0); ya[mt] = __builtin_amdgcn_mfma_f32_16x16x32_bf16(rf[mt * 2 + ks], sl2[ks], ya[mt], 0, 0, 0); } \
                { u32x4 o0, o1; o0.x = cvt_pk_bf16(ya[0][0], ya[0][1]); o0.y = cvt_pk_bf16(ya[0][2], ya[0][3]); o0.z = cvt_pk_bf16(ya[1][0], ya[1][1]); o0.w = cvt_pk_bf16(ya[1][2], ya[1][3]); \
                  o1.x = cvt_pk_bf16(ya[2][0], ya[2][1]); o1.y = cvt_pk_bf16(ya[2][2], ya[2][3]); o1.z = cvt_pk_bf16(ya[3][0], ya[3][1]); o1.w = cvt_pk_bf16(ya[3][2], ya[3][3]); \
                  if (!dry) { *(u32x4*)yp = o0; *(u32x4*)(yp + 8) = o1; } } \
                  \
                f32x4 sn[4]; \
                _Pragma("unroll") for (int mt = 0; mt < 4; ++mt) { sn[mt] = (f32x4){bflo(O_.qv[mt].x), bfhi(O_.qv[mt].x), bflo(O_.qv[mt].y), bfhi(O_.qv[mt].y)} + wl[mt] * S[mt]; } \
                _Pragma("unroll") for (int mt = 0; mt < 4; ++mt) _Pragma("unroll") for (int ks = 0; ks < 2; ++ks) { \
                    sn[mt] = __builtin_amdgcn_mfma_f32_16x16x32_bf16(pf[mt * 2 + ks], sh[ks], sn[mt], 0, 0, 0); sn[mt] = __builtin_amdgcn_mfma_f32_16x16x32_bf16(pf[mt * 2 + ks], sl2[ks], sn[mt], 0, 0, 0); } \
                _Pragma("unroll") for (int mt = 0; mt < 4; ++mt) S[mt] = sn[mt]; \
                if (c + 4 < 64) R2_OWN(O_, c + 4);        \
            } \
            __syncthreads(); } while (0)
#pragma unroll 1
        for (int c0 = 0; c0 < 64; c0 += 4) { R2_STEP(Oa, c0); R2_STEP(Ob, c0 + 1); R2_STEP(Oc, c0 + 2); R2_STEP(Od, c0 + 3); }
    }
}

__device__ __forceinline__ void rwkv_r3(const RwBufs& B, int gw, int NGW, int nitems) {
    const int lane = lane_now(), q = lane >> 4, n = lane & 15;
#pragma unroll 1
    for (int item = gw; item < nitems; item += NGW) {
        const int b = item / (64 * RH), c = (item / RH) & 63, h = item % RH; const size_t row0 = (size_t)b * SEQ + c * 64;
        unsigned yw[4][8];
        u32x4 ga[4][2], gb[4][2];
#pragma unroll
        for (int wv = 0; wv < 4; ++wv) { const bf16_t* yp = B.CAT + (row0 + 16 * wv + n) * D + h * 64 + q * 16; const u32x4 y0 = *(const u32x4*)yp, y1 = *(const u32x4*)(yp + 8);
            yw[wv][0] = y0.x; yw[wv][1] = y0.y; yw[wv][2] = y0.z; yw[wv][3] = y0.w; yw[wv][4] = y1.x; yw[wv][5] = y1.y; yw[wv][6] = y1.z; yw[wv][7] = y1.w;
#pragma unroll
            for (int hf = 0; hf < 2; ++hf) { const size_t go = (size_t)item * 4096 + (size_t)(16 * wv + n) * 64 + q * 16 + 8 * hf; ga[wv][hf] = *(const u32x4*)(B.GA + go); gb[wv][hf] = *(const u32x4*)(B.GB + go); } }
        asm volatile("s_waitcnt vmcnt(0)" ::: "memory");
#pragma unroll
        for (int hf = 0; hf < 2; ++hf) {
            float s1[8], s2[8];
#pragma unroll
            for (int e4 = 0; e4 < 8; ++e4) { s1[e4] = 0.f; s2[e4] = 0.f; }
#pragma unroll
            for (int wv = 0; wv < 4; ++wv)
#pragma unroll
                for (int e2 = 0; e2 < 4; ++e2) { const unsigned w = yw[wv][4 * hf + e2]; const float ylo = bflo(w), yhi = bfhi(w); s1[2 * e2] += ylo; s2[2 * e2] += ylo * ylo; s1[2 * e2 + 1] += yhi; s2[2 * e2 + 1] += yhi * yhi; }
#pragma unroll
            for (int e4 = 0; e4 < 8; ++e4) {
#pragma unroll
                for (int o = 1; o < 16; o <<= 1) { s1[e4] += __shfl_xor(s1[e4], o); s2[e4] += __shfl_xor(s2[e4], o); }
                const float mean = s1[e4] * (1.f / 64.f), var = fmaxf(s2[e4] * (1.f / 64.f) - mean * mean, 0.f); s1[e4] = mean; s2[e4] = 1.0f / sqrtf(var + LNX_EPS); }
#pragma unroll
            for (int wv = 0; wv < 4; ++wv) { const u32x4 a0 = ga[wv][hf], b0 = gb[wv][hf];
                const unsigned aw[4] = {a0.x, a0.y, a0.z, a0.w}, bw[4] = {b0.x, b0.y, b0.z, b0.w};
#pragma unroll
                for (int e4 = 0; e4 < 8; ++e4) { const int e = 8 * hf + e4; const unsigned ywd = yw[wv][e >> 1];
                    const float yv = (e & 1) ? bfhi(ywd) : bflo(ywd), gaf = (e & 1) ? bfhi(aw[e4 >> 1]) : bflo(aw[e4 >> 1]), gbf = (e & 1) ? bfhi(bw[e4 >> 1]) : bflo(bw[e4 >> 1]);
                    const float o = (yv - s1[e4]) * s2[e4] * gaf + gbf; const int t = 16 * (e >> 2) + 4 * q + (e & 3);
                    B.CAT[(row0 + t) * D + h * 64 + 16 * wv + n] = f2bf(o); } }
        }
    }
}

constexpr int S5_TAB_EL = 128 * 256 + 256 * 384;
constexpr int S5_US = 264, S5_ZS = 65, S5_XS = 136;
typedef short bf16x4s __attribute__((ext_vector_type(4)));

__device__ __forceinline__ void s5_tables(const Args& a, LAS unsigned char* lds, bf16_t* TAB, float* A16T, int g, int part, int tid) {
    constexpr int CST = 68;
    LAS float* pwr = (LAS float*)lds; LAS float* pwi = pwr + 17 * 64;
    LAS float* bbr = pwi + 17 * 64; LAS float* bbi = bbr + 64 * 16;
    LAS float* crs = bbi + 64 * 16; LAS float* cis = crs + 16 * CST;
    LAS float* Kt = cis + 16 * CST;
    LAS float* zrs = Kt + 4096; LAS float* zis = zrs + 64;
    __syncthreads();
    {   const float dt = expf(a.in[I_LOG_DT][g]);
        for (int idx = tid; idx < 25 * 64; idx += NTHR) { const int t = idx >> 6, p = idx & 63; const float lr = a.in[I_LAM_RE][g * S5P + p], li = a.in[I_LAM_IM][g * S5P + p];
            const float tt = (t <= 16) ? (float)t : 16.0f * (float)(t - 16), m = expf(lr * dt * tt); float sn, cs; sincosf(li * dt * tt, &sn, &cs); const float vr = m * cs, vi = m * sn;
            if (t <= 16) { pwr[t * 64 + p] = vr; pwi[t * 64 + p] = vi; } else if (part == 0) { A16T[(g * 8 + (t - 17)) * 128 + p] = vr; A16T[(g * 8 + (t - 17)) * 128 + 64 + p] = vi; } }
        if (tid < 64) { const int p = tid; const float lr = a.in[I_LAM_RE][g * S5P + p], li = a.in[I_LAM_IM][g * S5P + p];
            float sn, cs, sh, ch; sincosf(li * dt, &sn, &cs); sincosf(0.5f * li * dt, &sh, &ch); const float em1 = expm1f(lr * dt);
            const float nre = em1 * cs - 2.0f * sh * sh, nim = (em1 + 1.0f) * sn, den = lr * lr + li * li;
            zrs[p] = (nre * lr + nim * li) / den; zis[p] = (nim * lr - nre * li) / den; } }
    for (int i = tid; i < 1024; i += NTHR) { crs[(i >> 6) * CST + (i & 63)] = a.in[I_C_RE][(size_t)g * 1024 + i]; cis[(i >> 6) * CST + (i & 63)] = a.in[I_C_IM][(size_t)g * 1024 + i]; }
    __syncthreads();
    for (int i = tid; i < 1024; i += NTHR) { const int p = i >> 4; const float zr = zrs[p], zi = zis[p], br = a.in[I_B_RE][(size_t)g * S5P * 16 + i], bi = a.in[I_B_IM][(size_t)g * S5P * 16 + i];
        bbr[i] = zr * br - zi * bi; bbi[i] = zr * bi + zi * br; }
    __syncthreads();
    for (int w = tid; w < (4 * part + 4) * 64; w += NTHR) { const int t = w >> 6, j = (w >> 2) & 15, jq = w & 3; f32x4 s4 = {0.f, 0.f, 0.f, 0.f};
#pragma unroll 2
        for (int p4 = 0; p4 < 64; p4 += 4) { const f32x4 cr = *(const LAS f32x4*)(crs + j * CST + p4), ci = *(const LAS f32x4*)(cis + j * CST + p4), ar = *(const LAS f32x4*)(pwr + t * 64 + p4), ai = *(const LAS f32x4*)(pwi + t * 64 + p4);
#pragma unroll
            for (int e = 0; e < 4; ++e) { const float wr = cr[e] * ar[e] - ci[e] * ai[e], wi = cr[e] * ai[e] + ci[e] * ar[e];
                const f32x4 br = *(const LAS f32x4*)(bbr + (p4 + e) * 16 + 4 * jq), bi = *(const LAS f32x4*)(bbi + (p4 + e) * 16 + 4 * jq);
                s4 += wr * br - wi * bi; } }
        if (t == 0 && (j >> 2) == jq) s4[j & 3] += a.in[I_S5D][g * 16 + j];
        *(LAS f32x4*)(Kt + (t << 8) + (j << 4) + 4 * jq) = s4; }
    __syncthreads();
    bf16_t* Gt = TAB + (size_t)g * S5_TAB_EL; bf16_t* MH = Gt + 128 * 256;
    for (int idx = part * 32 * 256 + tid; idx < (part + 1) * 32 * 256; idx += NTHR) { const int pp = idx >> 8, k = idx & 255, s = k >> 4, jp = k & 15, p = pp & 63, t = 15 - s;
        const float ar = pwr[t * 64 + p], ai = pwi[t * 64 + p], br = bbr[p * 16 + jp], bi = bbi[p * 16 + jp];
        Gt[idx] = f2bf(pp < 64 ? (ar * br - ai * bi) : (ar * bi + ai * br)); }
    for (int rr = 0; rr < 64; ++rr) { const int row = part * 64 + rr, t = row >> 4, j = row & 15;
        if (tid < 384) { const int k = tid; float v;
            if (k < 256) { const int s = k >> 4, jp = k & 15; v = (s <= t) ? Kt[((t - s) << 8) + (j << 4) + jp] : 0.f; }
            else { const int pp = k - 256, p = pp & 63; const float cr = crs[j * CST + p], ci = cis[j * CST + p], ar = pwr[(t + 1) * 64 + p], ai = pwi[(t + 1) * 64 + p];
                v = pp < 64 ? (cr * ar - ci * ai) : -(cr * ai + ci * ar); }
            MH[(size_t)row * 384 + k] = f2bf(v); } }
}

__device__ __forceinline__ float gelu_fast_(float x) { const float a2 = 1.5957691216057308f * (x + 0.044715f * x * x * x); return x * __builtin_amdgcn_rcpf(1.0f + __expf(-a2)); }
__device__ __forceinline__ f32x4 gelu_fast4_(f32x4 x) {
    const f32x2_t x0 = {x[0], x[1]}, x1 = {x[2], x[3]};
    const float K = -1.5957691216057308f * 1.4426950408889634f;
    const f32x2_t kk = {K, K}, kc = {K * 0.044715f, K * 0.044715f}, one = {1.f, 1.f};
    const f32x2_t a0 = x0 * (x0 * x0 * kc + kk), a1 = x1 * (x1 * x1 * kc + kk);
    const f32x2_t e0 = {__builtin_amdgcn_exp2f(a0[0]), __builtin_amdgcn_exp2f(a0[1])}, e1 = {__builtin_amdgcn_exp2f(a1[0]), __builtin_amdgcn_exp2f(a1[1])};
    const f32x2_t d0 = e0 + one, d1 = e1 + one;
    const f32x2_t r0 = {__builtin_amdgcn_rcpf(d0[0]), __builtin_amdgcn_rcpf(d0[1])}, r1 = {__builtin_amdgcn_rcpf(d1[0]), __builtin_amdgcn_rcpf(d1[1])};
    const f32x2_t y0 = x0 * r0, y1 = x1 * r1;
    return (f32x4){y0[0], y0[1], y1[0], y1[1]}; }
__device__ __forceinline__ f32x4 mul_sigmoid4_(f32x4 y, f32x4 z) {
    const f32x2_t y0 = {y[0], y[1]}, y1 = {y[2], y[3]}, z0 = {z[0], z[1]}, z1 = {z[2], z[3]};
    const f32x2_t nl = {-1.4426950408889634f, -1.4426950408889634f}, one = {1.f, 1.f};
    const f32x2_t a0 = z0 * nl, a1 = z1 * nl;
    const f32x2_t e0 = {__builtin_amdgcn_exp2f(a0[0]), __builtin_amdgcn_exp2f(a0[1])}, e1 = {__builtin_amdgcn_exp2f(a1[0]), __builtin_amdgcn_exp2f(a1[1])};
    const f32x2_t d0 = e0 + one, d1 = e1 + one;
    const f32x2_t r0 = {__builtin_amdgcn_rcpf(d0[0]), __builtin_amdgcn_rcpf(d0[1])}, r1 = {__builtin_amdgcn_rcpf(d1[0]), __builtin_amdgcn_rcpf(d1[1])};
    const f32x2_t o0 = y0 * r0, o1 = y1 * r1;
    return (f32x4){o0[0], o0[1], o1[0], o1[1]}; }

__device__ __forceinline__ void s5_chunked(const Args& a, LAS unsigned char* lds, const bf16_t* U, const bf16_t* TAB, const float* A16T, bf16_t* CAT, int bx, int G, int wave) {
    const int lane = lane_now(), l15 = lane & 15, kq = lane >> 4, q = kq, n = l15, tid = wave * 64 + lane;
    LAS unsigned char* Us0 = lds; LAS float* Zs = (LAS float*)(lds + 64 * S5_US * 2); LAS unsigned char* Xp = lds + 64 * S5_US * 2 + 128 * S5_ZS * 4;
    LAS unsigned char* Us1 = Xp + 64 * S5_XS * 2 + 8 * 128 * 4;
#define S5_UDMA(buf_, nb_) do { const int ln_ = lane_now(); if (ln_ < 32) { const bf16_t* src_ = UT + (size_t)((nb_) * 64 + 8 * wave) * 256 + ln_ * 8; \
        _Pragma("unroll") for (int i = 0; i < 8; ++i) __builtin_amdgcn_global_load_lds((const unsigned*)(src_ + (size_t)i * 256), (LAS unsigned*)((buf_) + (8 * wave + i) * (S5_US * 2)), 16, 0, 0); } } while (0)
#pragma unroll 1
    for (int item = bx; item < NB * S5G; item += G) {
        const int b = item / S5G, g = item % S5G;
        const bf16_t* UT = U + (size_t)(b * S5G + g) * SEQ * 16;
        const bf16_t* Gt = TAB + (size_t)g * S5_TAB_EL; const bf16_t* MH = Gt + 128 * 256;
        bf16x8 ga[8], mh[2][12];
#pragma unroll
        for (int ks = 0; ks < 8; ++ks) ga[ks] = *(const bf16x8*)(Gt + (size_t)(16 * wave + l15) * 256 + 32 * ks + 8 * kq);
        const int tau0 = wave, tau1 = 15 - wave;
#pragma unroll
        for (int ks = 0; ks < 12; ++ks) { mh[0][ks] = *(const bf16x8*)(MH + (size_t)(16 * tau0 + l15) * 384 + 32 * ks + 8 * kq); mh[1][ks] = *(const bf16x8*)(MH + (size_t)(16 * tau1 + l15) * 384 + 32 * ks + 8 * kq); }
        bf16x4s wg; { unsigned short w4[4];
#pragma unroll
            for (int e = 0; e < 4; ++e) w4[e] = f2bf(a.in[I_WGLU][(size_t)(g * 16 + 4 * kq + e) * 16 + l15]);
            wg = (bf16x4s){(short)w4[0], (short)w4[1], (short)w4[2], (short)w4[3]}; }
        const f32x4 bq = *(const f32x4*)(a.in[I_BGLU] + g * 16 + 4 * q);
        float xr = 0.f, xi = 0.f;
        float apr[8], api[8];
#pragma unroll
        for (int k8 = 0; k8 < 8; ++k8) { apr[k8] = A16T[(g * 8 + k8) * 128 + lane]; api[k8] = A16T[(g * 8 + k8) * 128 + 64 + lane]; }
        LAS float* Ex = (LAS float*)(Xp + 64 * S5_XS * 2);
        __syncthreads();
        S5_UDMA(Us0, 0);
#pragma unroll 1
        for (int nb = 0; nb < 4; ++nb) {
            LAS unsigned char* Us = (nb & 1) ? Us1 : Us0;
            asm volatile("s_waitcnt vmcnt(0)" ::: "memory");
            __syncthreads();
            if (nb + 1 < 4) { if (nb & 1) S5_UDMA(Us0, nb + 1); else S5_UDMA(Us1, nb + 1); }
#pragma unroll
            for (int nt = 0; nt < 4; ++nt) { f32x4 acc = {0.f, 0.f, 0.f, 0.f};
#pragma unroll
                for (int ks = 0; ks < 8; ++ks) acc = __builtin_amdgcn_mfma_f32_16x16x32_bf16(ga[ks], *(const LAS bf16x8*)(Us + (16 * nt + l15) * (S5_US * 2) + (32 * ks + 8 * kq) * 2), acc, 0, 0, 0);
#pragma unroll
                for (int r = 0; r < 4; ++r) Zs[(16 * wave + 4 * q + r) * S5_ZS + 16 * nt + n] = acc[r]; }
            __syncthreads();
            {   float lr8[8], li8[8]; float sr = 0.f, si = 0.f;
#pragma unroll
                for (int i = 0; i < 8; ++i) { lr8[i] = sr; li8[i] = si; const int c = 8 * wave + i; const float zr = Zs[lane * S5_ZS + c], zi = Zs[(64 + lane) * S5_ZS + c];
                    const float nr = apr[0] * sr - api[0] * si + zr, ni = apr[0] * si + api[0] * sr + zi; sr = nr; si = ni; }
                Ex[wave * 128 + lane] = sr; Ex[wave * 128 + 64 + lane] = si;
                __syncthreads();
                float cr = xr, ci = xi, myr = xr, myi = xi;
#pragma unroll
                for (int v = 0; v < 8; ++v) { if (v == wave) { myr = cr; myi = ci; }
                    const float er = Ex[v * 128 + lane], ei = Ex[v * 128 + 64 + lane]; const float nr = apr[7] * cr - api[7] * ci + er, ni = apr[7] * ci + api[7] * cr + ei; cr = nr; ci = ni; }
                xr = cr; xi = ci;
#pragma unroll
                for (int i = 0; i < 8; ++i) { float pr = lr8[i], pi = li8[i];
                    if (i == 0) { pr += myr; pi += myi; } else { pr += apr[i - 1] * myr - api[i - 1] * myi; pi += apr[i - 1] * myi + api[i - 1] * myr; }
                    const int c = 8 * wave + i; *(LAS bf16_t*)(Xp + c * (S5_XS * 2) + lane * 2) = f2bf(pr); *(LAS bf16_t*)(Xp + c * (S5_XS * 2) + (64 + lane) * 2) = f2bf(pi); } }
            __syncthreads();
#pragma unroll
            for (int mi = 0; mi < 2; ++mi) { const int tau = mi ? tau1 : tau0, kmax = tau >> 1;
#pragma unroll 1
                for (int nt = 0; nt < 4; ++nt) { f32x4 acc = {0.f, 0.f, 0.f, 0.f};
                    const LAS unsigned char* ub = Us + (16 * nt + l15) * (S5_US * 2) + (8 * kq) * 2; const LAS unsigned char* xb = Xp + (16 * nt + l15) * (S5_XS * 2) + (8 * kq) * 2;
#pragma unroll
                    for (int ks = 0; ks < 8; ++ks) if (ks <= kmax) acc = __builtin_amdgcn_mfma_f32_16x16x32_bf16(mh[mi][ks], *(const LAS bf16x8*)(ub + 64 * ks), acc, 0, 0, 0);
#pragma unroll
                    for (int ks = 0; ks < 4; ++ks) acc = __builtin_amdgcn_mfma_f32_16x16x32_bf16(mh[mi][8 + ks], *(const LAS bf16x8*)(xb + 64 * ks), acc, 0, 0, 0);
                    const f32x4 yg = gelu_fast4_(acc);
                    const unsigned p01 = cvt_pk_bf16(yg[0], yg[1]), p23 = cvt_pk_bf16(yg[2], yg[3]); const u32x2 pk = {p01, p23};
                    const f32x4 z = __builtin_amdgcn_mfma_f32_16x16x16bf16_1k(wg, __builtin_bit_cast(bf16x4s, pk), bq, 0, 0, 0);
                    const int t = (nb * 64 + 16 * nt + n) * 16 + tau;
                    const f32x4 og = mul_sigmoid4_(yg, z); u32x2 o; o.x = cvt_pk_bf16(og[0], og[1]); o.y = cvt_pk_bf16(og[2], og[3]);
                    *(u32x2*)(CAT + ((size_t)b * SEQ + t) * D + g * 16 + 4 * q) = o; } }
        }
    }
}

constexpr int AT_KS = 72, AT_VS = 264;
__device__ __forceinline__ void attn_mfma(LAS unsigned char* lds, const bf16_t* Q, const bf16_t* KV, bf16_t* CAT, int bx, int G, int wave) {
    const int lane = lane_now(), l15 = lane & 15, kq = lane >> 4, q = kq, n = l15, tid = wave * 64 + lane;
    LAS unsigned char* Ks = lds; LAS unsigned char* Vt = lds + 256 * AT_KS * 2;
#pragma unroll 1
    for (int item = bx; item < NB * NH_MEM * 16; item += G) {
        const int b = item >> 6, h = (item >> 4) & 3, qb = item & 15;
        __syncthreads();
#pragma unroll
        for (int i = 0; i < 4; ++i) { const int idx = tid + 512 * i, key = idx >> 3, seg = idx & 7;
            const bf16_t* src = KV + (size_t)(b * MEML + key) * 512 + h * 64 + seg * 8;
            *(LAS u32x4*)(Ks + key * (AT_KS * 2) + seg * 16) = *(const u32x4*)src;
            const u32x4 vw = *(const u32x4*)(src + 256); const unsigned vv[4] = {vw.x, vw.y, vw.z, vw.w};
#pragma unroll
            for (int e = 0; e < 4; ++e) { *(LAS bf16_t*)(Vt + (seg * 8 + 2 * e) * (AT_VS * 2) + key * 2) = (bf16_t)(vv[e] & 0xffffu); *(LAS bf16_t*)(Vt + (seg * 8 + 2 * e + 1) * (AT_VS * 2) + key * 2) = (bf16_t)(vv[e] >> 16); } }
        __syncthreads();
#pragma unroll 1
        for (int tile = 0; tile < 2; ++tile) {
            const size_t qrow = (size_t)b * SEQ + qb * 256 + wave * 32 + tile * 16;
            bf16x8 qf[2];
#pragma unroll
            for (int ks = 0; ks < 2; ++ks) qf[ks] = *(const bf16x8*)(Q + (qrow + l15) * CM + h * 64 + 32 * ks + 8 * kq);
            f32x4 s[16];
#pragma unroll
            for (int kt = 0; kt < 16; ++kt) { f32x4 acc = {0.f, 0.f, 0.f, 0.f};
#pragma unroll
                for (int ks = 0; ks < 2; ++ks) acc = __builtin_amdgcn_mfma_f32_16x16x32_bf16(*(const LAS bf16x8*)(Ks + (16 * kt + l15) * (AT_KS * 2) + (32 * ks + 8 * kq) * 2), qf[ks], acc, 0, 0, 0);
                s[kt] = acc; if (kt & 1) asm volatile("" ::: "memory"); }
            float m = -3.0e38f;
#pragma unroll
            for (int kt = 0; kt < 16; ++kt) m = fmaxf(m, fmaxf(fmaxf(s[kt][0], s[kt][1]), fmaxf(s[kt][2], s[kt][3])));
            m = fmaxf(m, __shfl_xor(m, 16)); m = fmaxf(m, __shfl_xor(m, 32));
            float sum = 0.f; const float c = 0.125f * 1.4426950408889634f;
#pragma unroll
            for (int kt = 0; kt < 16; ++kt)
#pragma unroll
                for (int r = 0; r < 4; ++r) { const float p = __builtin_amdgcn_exp2f((s[kt][r] - m) * c); s[kt][r] = p; sum += p; }
            sum += __shfl_xor(sum, 16); sum += __shfl_xor(sum, 32);
            const float inv = 1.0f / sum;
            bf16x8 pf[8];
#pragma unroll
            for (int k2 = 0; k2 < 8; ++k2) { const u32x4 w = {cvt_pk_bf16(s[2 * k2][0], s[2 * k2][1]), cvt_pk_bf16(s[2 * k2][2], s[2 * k2][3]), cvt_pk_bf16(s[2 * k2 + 1][0], s[2 * k2 + 1][1]), cvt_pk_bf16(s[2 * k2 + 1][2], s[2 * k2 + 1][3])};
                pf[k2] = __builtin_bit_cast(bf16x8, w); }
#pragma unroll 1
            for (int dt = 0; dt < 4; ++dt) { f32x4 acc = {0.f, 0.f, 0.f, 0.f};
#pragma unroll
                for (int k2 = 0; k2 < 8; ++k2) { const LAS unsigned char* vp = Vt + (16 * dt + l15) * (AT_VS * 2) + (32 * k2 + 4 * kq) * 2;
                    const u32x2 v0 = *(const LAS u32x2*)vp, v1 = *(const LAS u32x2*)(vp + 32); const u32x4 vw = {v0.x, v0.y, v1.x, v1.y};
                    acc = __builtin_amdgcn_mfma_f32_16x16x32_bf16(__builtin_bit_cast(bf16x8, vw), pf[k2], acc, 0, 0, 0); }
                u32x2 o; o.x = cvt_pk_bf16(acc[0] * inv, acc[1] * inv); o.y = cvt_pk_bf16(acc[2] * inv, acc[3] * inv);
                *(u32x2*)(CAT + (qrow + n) * D + CS + h * 64 + 16 * dt + 4 * q) = o; }
        }
    }
}
constexpr int N_PHASES = 15;

__device__ __forceinline__ TrJob small_job(const Args& a, int j) {
    unsigned char* ws = a.ws; TrJob r;
    switch (j) {
    case 0: r = TrJob{a.in[I_WINA], (bf16_t*)(ws + WS_WINA), a.in[I_NORM_MIX], D, D, 0, 0, 0.f}; break;
    case 1: r = TrJob{a.in[I_WOUT], (bf16_t*)(ws + WS_WOUT0), nullptr, D, D, 0, 0, 0.f}; break;
    case 2: r = TrJob{a.in[I_WOUT] + (size_t)D * D, (bf16_t*)(ws + WS_WOUT1), nullptr, D, D, 0, 0, 0.f}; break;
    case 3: r = TrJob{a.in[I_WKV], (bf16_t*)(ws + WS_WKV), nullptr, D, 512, 0, 0, 0.f}; break;
    case 4: r = TrJob{a.in[I_WKV] + (size_t)D * 512, (bf16_t*)(ws + WS_WKV) + (size_t)512 * D, nullptr, D, 512, 0, 0, 0.f}; break;
    case 5: r = TrJob{a.in[I_FGATE], (bf16_t*)(ws + WS_WGU0), a.in[I_NORM_FFN], D, FD, 1, 0, 0.f}; break;
    case 6: r = TrJob{a.in[I_FUP], (bf16_t*)(ws + WS_WGU0), a.in[I_NORM_FFN], D, FD, 2, 0, 0.f}; break;
    case 7: r = TrJob{a.in[I_FDOWN], (bf16_t*)(ws + WS_WD0), nullptr, FD, D, 0, 0, 0.f}; break;
    case 8: r = TrJob{a.in[I_WINB], (bf16_t*)(ws + WS_WINB), a.in[I_NORM_MIX] + D, D, INB, 0, 0, 0.f}; break;
    case 9: r = TrJob{a.in[I_W2], (bf16_t*)(ws + WS_W2T), nullptr, 64, CS, 0, 0, 0.f}; break;
    case 10: r = TrJob{a.in[I_A2], (bf16_t*)(ws + WS_A2T), nullptr, 64, CS, 0, 0, 0.f}; break;
    default: r = TrJob{a.in[I_G2], (bf16_t*)(ws + WS_G2T), nullptr, 128, CS, 0, 0, 0.f}; break;
    }
    r.items = (r.K / 64) * (r.N / 32); r.f8s = 0.f; return r;
}
__device__ __forceinline__ TrJob moe_job(const Args& a, int j) {
    unsigned char* ws = a.ws; const int kind = j >> 3, e = j & 7; TrJob r;
    if (kind == 0) r = TrJob{a.in[I_MGATE] + (size_t)e * D * FE, (bf16_t*)(ws + WS_WMOE_GU + (size_t)e * 2 * FE * D), a.in[I_NORM_FFN] + D, D, FE, 1, 0, F8_WGU};
    else if (kind == 1) r = TrJob{a.in[I_MUP] + (size_t)e * D * FE, (bf16_t*)(ws + WS_WMOE_GU + (size_t)e * 2 * FE * D), a.in[I_NORM_FFN] + D, D, FE, 2, 0, F8_WGU};
    else r = TrJob{a.in[I_MDOWN] + (size_t)e * FE * D, (bf16_t*)(ws + WS_WMOE_D + (size_t)e * D * FE), nullptr, FE, D, 0, 0, F8_WD};
    r.items = (r.K / 64) * (r.N / 32); return r;
}

__device__ __forceinline__ void moe_convert(const Args& args, LAS float* scr, int cw, int ncw, int lane) {
    constexpr int JI = (D / 64) * (FE / 32), NGI = 24 * JI; static_assert((FE / 64) * (D / 32) == JI, "moe jobs differ in size");
    TrRegs R0, R1; int g0 = cw, g1 = cw + ncw;
    if (g0 < NGI) tr_load(moe_job(args, g0 / JI), g0 % JI, lane, R0);
    if (g1 < NGI) tr_load(moe_job(args, g1 / JI), g1 % JI, lane, R1);
#pragma unroll 1
    for (; g0 < NGI; g0 += 2 * ncw, g1 += 2 * ncw) {
        __builtin_amdgcn_sched_barrier(0);
        tr_fin(moe_job(args, g0 / JI), g0 % JI, scr, lane, R0);
        { const int gn = (g0 + 2 * ncw < NGI) ? g0 + 2 * ncw : g0; tr_load(moe_job(args, gn / JI), gn % JI, lane, R0); }
        __builtin_amdgcn_sched_barrier(0);
        if (g1 < NGI) tr_fin(moe_job(args, g1 / JI), g1 % JI, scr, lane, R1);
        { const int gn = (g1 + 2 * ncw < NGI) ? g1 + 2 * ncw : g0; tr_load(moe_job(args, gn / JI), gn % JI, lane, R1); } }
}

__device__ __forceinline__ void p0_transposes(const Args& args, LAS unsigned char* lds, int wave, int gw, int NGW) {
    unsigned char* ws = args.ws;
    LAS float* scr = (LAS float*)(lds + wave * 16384);
    {
        int base = 0;
        for (int j = 0; j < 12; ++j) { const TrJob jb = small_job(args, j);
            for (int it = gw - base; it < jb.items; it += NGW) { if (it >= 0) tr_item(jb.W, jb.K, jb.N, jb.WT, jb.gain, jb.mode, scr, it, lane_now()); }
            base = (base + jb.items) % NGW; }
    }
}
__device__ __forceinline__ void p0_memn(const Args& args, int gw, int NGW) {
    unsigned char* ws = args.ws;
    for (int r = gw; r < 2 * MROWS; r += NGW) { const int li = r / MROWS, row = r % MROWS;
        const f32x4* xr = (const f32x4*)(args.in[I_MEM] + (size_t)row * D) + lane_now(); const f32x4* gr = (const f32x4*)(args.in[I_NORM_MEM] + li * D) + lane_now();
        f32x4 v[4]; float s = 0.f;
#pragma unroll
        for (int j = 0; j < 4; ++j) { v[j] = xr[64 * j]; s += (v[j][0] * v[j][0] + v[j][1] * v[j][1]) + (v[j][2] * v[j][2] + v[j][3] * v[j][3]); }
        const float rs = rstd_of(wave_sum_fast(s));
        u32x2* o = (u32x2*)((bf16_t*)(ws + WS_MEMN) + ((size_t)li * MROWS + row) * D) + lane_now();
#pragma unroll
        for (int j = 0; j < 4; ++j) { const f32x4 g = gr[64 * j]; u32x2 w; w.x = cvt_pk_bf16(v[j][0] * rs * g[0], v[j][1] * rs * g[1]); w.y = cvt_pk_bf16(v[j][2] * rs * g[2], v[j][3] * rs * g[3]); o[64 * j] = w; }
    }
}
__device__ __forceinline__ void p0_xconv(const Args& args, bf16_t* HA, rss_t* rowss, int gw, int NGW) {
    for (int r = gw; r < T; r += 2 * NGW) {
        const int r2 = r + NGW; const bool has2 = r2 < T;
        const f32x4* xr = (const f32x4*)(args.in[I_X] + (size_t)r * D) + lane_now(); const f32x4* xq = (const f32x4*)(args.in[I_X] + (size_t)(has2 ? r2 : r) * D) + lane_now();
        f32x4 v[4], w[4]; float s = 0.f, s2 = 0.f;
#pragma unroll
        for (int j = 0; j < 4; ++j) { v[j] = xr[64 * j]; w[j] = xq[64 * j]; }
#pragma unroll
        for (int j = 0; j < 4; ++j) { s += (v[j][0] * v[j][0] + v[j][1] * v[j][1]) + (v[j][2] * v[j][2] + v[j][3] * v[j][3]); s2 += (w[j][0] * w[j][0] + w[j][1] * w[j][1]) + (w[j][2] * w[j][2] + w[j][3] * w[j][3]); }
        s = wave_sum_fast(s); s2 = wave_sum_fast(s2);
        if (lane_now() == 0) { rowss[r] = rss_fx(s); if (has2) rowss[r2] = rss_fx(s2); }
        u32x2* o = (u32x2*)(HA + (size_t)r * D) + lane_now(); u32x2* o2 = (u32x2*)(HA + (size_t)r2 * D) + lane_now();
#pragma unroll
        for (int j = 0; j < 4; ++j) { u32x2 p; p.x = cvt_pk_bf16(v[j][0], v[j][1]); p.y = cvt_pk_bf16(v[j][2], v[j][3]); o[64 * j] = p;
            if (has2) { u32x2 p2; p2.x = cvt_pk_bf16(w[j][0], w[j][1]); p2.y = cvt_pk_bf16(w[j][2], w[j][3]); o2[64 * j] = p2; } }
    }
}

template <int LO, int HI> __global__ void __launch_bounds__(NTHR, 2) fwd(Args args) {
    extern __shared__ __attribute__((aligned(16))) unsigned char lds_raw[];
    LAS unsigned char* lds = (LAS unsigned char*)lds_raw;
    volatile LAS unsigned* MISC = (volatile LAS unsigned*)(lds + LDS_MISC);
    const int wave = __builtin_amdgcn_readfirstlane(threadIdx.x >> 6);
#define lane (lane_now())
#define tid (wave * 64 + lane_now())
    const int G = gridDim.x, bx = blockIdx.x;
    const int gw = bx * NWAVES + wave, NGW = G * NWAVES;
    typedef __attribute__((address_space(1))) unsigned char gbyte_t;
    gbyte_t* wsg = (gbyte_t*)args.ws;
#define ws ((unsigned char*)wsg)
    unsigned* ctl = (unsigned*)(ws + WS_CTL);
    rss_t* rowss = (rss_t*)(ws + WS_CTL + CTL_ROWSS);
    float* X = args.out;
    bf16_t* HA = (bf16_t*)(ws + WS_HA);
    const int lo = args.ph_lo, hi = args.ph_hi;
    for (int u = tid; u < (LDS_BYTES - LDS_MISC) / 4; u += NTHR) ((LAS unsigned*)(lds + LDS_MISC))[u] = 0u;
    __syncthreads();
    XcdBarrier bar; bar.bar = ctl + CW_BAR; bar.x = 0; bar.st = nullptr; bar.wave = wave;
    const bool multi = (hi - lo) > 1;
    if (multi) bar = xcd_barrier_post(ctl + CW_BAR, MISC + 8);
#define IN(k) (LO <= (k) && (k) < HI && lo <= (k) && (k) < hi)
#define WS_FENCE() asm volatile("" : "+s"(wsg))
#ifdef TS_PHASE
    int nst = 0; volatile LAS unsigned long long* TSL = (volatile LAS unsigned long long*)(lds + LDS_MISC + 512);
#define STAMP() do { if (bx == 0 && threadIdx.x == 0) TSL[nst] = __builtin_amdgcn_s_memrealtime(); ++nst; } while (0)
#else
#define STAMP() do {} while (0)
#endif
    STAMP();
#ifdef TS_DUP
#define TS_T0() do { if (lane_now() == 0) *(volatile LAS unsigned long long*)(lds + LDS_MISC + 512 + 8 * wave) = __builtin_amdgcn_s_memrealtime(); } while (0)
#define TS_IDLE(k) do { if (((TS_DUP) >> (k)) & 1) { const unsigned long long t1_ = __builtin_amdgcn_s_memrealtime(), t0_ = *(volatile LAS unsigned long long*)(lds + LDS_MISC + 512 + 8 * wave); \
        const unsigned long long tgt_ = t1_ + (t1_ - t0_); while (__builtin_amdgcn_s_memrealtime() < tgt_) __builtin_amdgcn_s_sleep(8); } } while (0)
#else
#define TS_T0() do {} while (0)
#define TS_IDLE(k) do {} while (0)
#endif
    TS_T0();
#define SEAM(k) do { if (IN(k)) TS_IDLE(k); if (IN(k) && IN((k) + 1)) xcd_barrier(bar); TS_T0(); STAMP(); WS_FENCE(); } while (0)

    if (IN(0)) {
        if (bx < 4 * S5G) { s5_tables(args, lds, (bf16_t*)(ws + WS_S5TAB), (float*)(ws + WS_S5TAB + 12 * MiB), bx >> 2, bx & 3, tid); __syncthreads(); }
        p0_transposes(args, lds, wave, gw, NGW);
        p0_memn(args, gw, NGW);
        {
            constexpr int NTAB = 4 * S5G, KSH = 2; const int vw = (G > NTAB) ? NTAB + (G - NTAB) * KSH : G;
            if (G <= NTAB || bx < NTAB) p0_xconv(args, HA, rowss, gw, vw * NWAVES);
            else for (int j = 0; j < KSH; ++j) p0_xconv(args, HA, rowss, (NTAB + (bx - NTAB) * KSH + j) * NWAVES + wave, vw * NWAVES); }
#ifdef DUP_P0
        xcd_barrier(bar);
#if DUP_P0 & 1
        if (bx < 4 * S5G) { s5_tables(args, lds, (bf16_t*)(ws + WS_S5TAB), (float*)(ws + WS_S5TAB + 12 * MiB), bx >> 2, bx & 3, tid); __syncthreads(); }
#endif
#if DUP_P0 & 2
        p0_transposes(args, lds, wave, gw, NGW);
#endif
#if DUP_P0 & 4
        p0_memn(args, gw, NGW);
#endif
#if DUP_P0 & 8
        p0_xconv(args, HA, rowss, gw, NGW);
#endif
#endif
    }
    SEAM(0);

    if (IN(1)) {
        { pg8::DenseSched S; S.init(HA, ws + WS_WINA, T, D, D, G, bx);
          EpiInA E{(bf16_t*)(ws + WS_P0U), (bf16_t*)(ws + WS_P0Q), rowss};
          pg8::gemm_phase<EpiInA, pg8::DenseSched, true>(lds, D, S, E, 0, wave); }
        __syncthreads();
        { pg8::KvSched S; S.init(ws + WS_MEMN, ws + WS_WKV, G, (bx + 64) % G);
          EpiBf16 E{(bf16_t*)(ws + WS_KV), 512, nullptr, nullptr, 0};
          pg8::gemm_phase<EpiBf16, pg8::KvSched, true>(lds, D, S, E, 0, wave); }
    }
    SEAM(1);

    if (IN(2)) {
        bf16_t* CAT = (bf16_t*)(ws + WS_CAT);
        {
            const int n2 = NB * S5G - G;
            if (n2 > 0 && n2 < G) { if (bx >= n2) attn_mfma(lds, (const bf16_t*)(ws + WS_P0Q), (const bf16_t*)(ws + WS_KV), CAT, bx - n2, G - n2, wave); }
            else attn_mfma(lds, (const bf16_t*)(ws + WS_P0Q), (const bf16_t*)(ws + WS_KV), CAT, bx, G, wave); }
        __syncthreads();
#ifdef S5_NAIVE
        s5_naive(args, lds, (const bf16_t*)(ws + WS_P0U), CAT, bx, G, wave, lane);
#else
        s5_chunked(args, lds, (const bf16_t*)(ws + WS_P0U), (const bf16_t*)(ws + WS_S5TAB), (const float*)(ws + WS_S5TAB + 12 * MiB), CAT, bx, G, wave);
#endif
#ifdef DUP_P2
        xcd_barrier(bar);
#if DUP_P2 & 1
        attn_mfma(lds, (const bf16_t*)(ws + WS_P0Q), (const bf16_t*)(ws + WS_KV), CAT, bx, G, wave);
        __syncthreads();
#endif
#if DUP_P2 & 2
        s5_chunked(args, lds, (const bf16_t*)(ws + WS_P0U), (const bf16_t*)(ws + WS_S5TAB), (const float*)(ws + WS_S5TAB + 12 * MiB), CAT, bx, G, wave);
#endif
#endif
    }
    SEAM(2);

    if (IN(3)) {
        pg8::DenseSched S; S.init(ws + WS_CAT, ws + WS_WOUT0, T, D, D, G, bx);
        EpiRes E{args.in[I_X], nullptr, HA, rowss + T, nullptr};
        pg8::gemm_phase<EpiRes, pg8::DenseSched, true>(lds, D, S, E, 0, wave);
    }
    SEAM(3);

#ifdef DUP_P4
#pragma unroll 1
    for (int rep = 0; rep < 2; ++rep) {
#endif
    if (IN(4)) {
        pg8::DenseSched S; S.init(HA, ws + WS_WGU0, T, 2 * FD, D, G, bx);
        #ifdef DUP_P4
        int sk_ = (rep == 0) ? DUP_SKIP : 0; asm volatile("" : "+s"(sk_));
        EpiSwiglu E{(bf16_t*)(ws + WS_ACT0), FD, rowss + T, nullptr, sk_};
#else
        EpiSwiglu E{(bf16_t*)(ws + WS_ACT0), FD, rowss + T, nullptr, 0};
#endif
#ifdef DUP_P4
        if (rep == 0) pg8::gemm_phase<EpiSwiglu, pg8::DenseSched, true, false, DUP_VAR>(lds, D, S, E, 0, wave); else
#endif
        pg8::gemm_phase<EpiSwiglu, pg8::DenseSched, true>(lds, D, S, E, 0, wave);
    }
#ifdef DUP_P4
    if (rep == 0) xcd_barrier(bar); }
#endif
    SEAM(4);

    if (IN(5)) {
        pg8::DenseSched S; S.init(ws + WS_ACT0, ws + WS_WD0, T, D, FD, G, bx);
        EpiRes E{nullptr, HA, HA, rowss + 2 * T, nullptr};
        pg8::gemm_phase<EpiRes, pg8::DenseSched, true>(lds, FD, S, E, 0, wave);
    }
    SEAM(5);

    if (IN(6)) {
        pg8::DenseSched S; S.init(HA, ws + WS_WINB, T, INB, D, G, bx);
        EpiBf16 E{(bf16_t*)(ws + WS_P1), INB, rowss + 2 * T, (bf16_t*)(ws + WS_P0Q), SHIFTC};
        pg8::gemm_phase<EpiBf16, pg8::DenseSched, true>(lds, D, S, E, 0, wave);
#ifdef DUP_P6
        xcd_barrier(bar); pg8::gemm_phase<EpiBf16, pg8::DenseSched, true>(lds, D, S, E, 0, wave);
#endif
    }
    SEAM(6);

    RwBufs RB; RB.dbg = ctl + 16387;
#ifdef DBG_RWKV
    RB.Pp = (bf16_t*)(ws + 78 * MiB); RB.Qp = (bf16_t*)(ws + 84 * MiB); RB.Rp = (bf16_t*)(ws + 90 * MiB); RB.GA = (bf16_t*)(ws + 96 * MiB); RB.GB = (bf16_t*)(ws + 102 * MiB); RB.WL = (float*)(ws + 108 * MiB);
    RB.CAT = (bf16_t*)(ws + 110 * MiB);
    constexpr int RW_ITEMS = 64 * RH, RW_BH = RH;
#else
    { unsigned char* ob = (unsigned char*)args.out; RB.Pp = (bf16_t*)ob; RB.WL = (float*)(ob + 48 * MiB); RB.XL = (bf16_t*)(ob + 50 * MiB); }
    RB.Qp = (bf16_t*)(ws + WS_RQP); RB.Rp = (bf16_t*)(ws + WS_RRP); RB.GA = (bf16_t*)(ws + WS_RGA); RB.GB = (bf16_t*)(ws + WS_RGB);
    RB.CAT = (bf16_t*)(ws + WS_CAT);
    constexpr int RW_ITEMS = NB * 64 * RH, RW_BH = NB * RH;
#endif
#ifdef DBG_RWKV
    RB.XL = (bf16_t*)(ws + WS_RXL);
#endif
    RB.P1 = (const bf16_t*)(ws + WS_P1); RB.w2T = (const bf16_t*)(ws + WS_W2T); RB.a2T = (const bf16_t*)(ws + WS_A2T); RB.g2T = (const bf16_t*)(ws + WS_G2T);
    if (IN(7)) {
        rwkv_xpre(args, RB, bx, G, wave);
        xcd_barrier(bar);
#ifdef DBG_RWKV
        rwkv_prep(args, lds, (const bf16_t*)(ws + WS_P1), (bf16_t*)(ws + 432 * MiB), (bf16_t*)(ws + 480 * MiB), (bf16_t*)(ws + 128 * MiB), (bf16_t*)(ws + 2 * MiB), bx, G, tid);
        __syncthreads();
#endif
        rwkv_r1(args, lds, RB, bx, G, wave, RW_ITEMS);
#ifdef DUP_R1
        xcd_barrier(bar); rwkv_r1(args, lds, RB, bx, G, wave, RW_ITEMS);
#endif
    }
    SEAM(7);
    if (IN(8)) {
#ifdef DUP_R2
        rwkv_r2(lds, RB, bx, G, wave, RW_BH, true); xcd_barrier(bar);
#endif
        rwkv_r2(lds, RB, bx, G, wave, RW_BH);
        { const int nr2 = (RW_BH < G) ? RW_BH : G;
          if (nr2 < G) { if (bx >= nr2) { attn_mfma(lds, (const bf16_t*)(ws + WS_P0Q), (const bf16_t*)(ws + WS_KV) + (size_t)MROWS * 512, (bf16_t*)(ws + WS_CAT), bx - nr2, G - nr2, wave);
              __syncthreads(); moe_convert(args, (LAS float*)(lds + wave * 16384), (bx - nr2) * NWAVES + wave, (G - nr2) * NWAVES, lane);
          } }
          else { __syncthreads(); attn_mfma(lds, (const bf16_t*)(ws + WS_P0Q), (const bf16_t*)(ws + WS_KV) + (size_t)MROWS * 512, (bf16_t*)(ws + WS_CAT), bx, G, wave);
                 __syncthreads(); moe_convert(args, (LAS float*)(lds + wave * 16384), gw, NGW, lane); } }
    }
    SEAM(8);
    if (IN(9)) { rwkv_r3(RB, gw, NGW, RW_ITEMS);
    }
    SEAM(9);

    if (IN(10)) {
#ifdef DBG_RWKV
        {   const bf16_t* ref = (const bf16_t*)(ws + WS_CAT); const bf16_t* tst = (const bf16_t*)(ws + 110 * MiB); float sd = 0.f, sr = 0.f;
            for (int r = gw; r < SEQ; r += NGW) {
#pragma unroll
                for (int i = 0; i < 12; ++i) { const float a = bf2f(ref[(size_t)r * D + lane + 64 * i]), b = bf2f(tst[(size_t)r * D + lane + 64 * i]); sd += (a - b) * (a - b); sr += a * a; } }
            sd = wave_sum(sd); sr = wave_sum(sr);
            if (lane == 0) { atomicAdd((float*)(ctl + 16384), sd); atomicAdd((float*)(ctl + 16385), sr); }
            unsigned bad = 0u;
            for (int i = gw * 64 + lane; i < 768 * 64; i += NGW * 64) { const float v = RB.WL[i]; if (!(v - v == 0.f)) bad |= 1u; }
            for (int i = gw * 64 + lane; i < 768 * 4096; i += NGW * 64) { float v = bf2f(RB.GA[i]); if (!(v - v == 0.f)) bad |= 2u; v = bf2f(RB.GB[i]); if (!(v - v == 0.f)) bad |= 4u;
                v = bf2f(RB.Pp[i]); if (!(v - v == 0.f)) bad |= 8u; v = bf2f(RB.Qp[i]); if (!(v - v == 0.f)) bad |= 16u; v = bf2f(RB.Rp[i]); if (!(v - v == 0.f)) bad |= 32u; }
            for (int r = gw; r < SEQ; r += NGW) for (int i = 0; i < 12; ++i) { const float v = bf2f(tst[(size_t)r * D + lane + 64 * i]); if (!(v - v == 0.f)) bad |= 64u; }
            if (bad) atomicOr(ctl + 16386, bad); }
#endif
        pg8::DenseSched S; S.init(ws + WS_CAT, ws + WS_WOUT1, T, D, D, G, bx);
        EpiRes E{nullptr, HA, (bf16_t*)(ws + WS_X3), rowss + 3 * T, (unsigned char*)(ws + WS_HA2)};
        pg8::gemm_phase<EpiRes, pg8::DenseSched, true>(lds, D, S, E, 0, wave);
    }
    SEAM(10);

    if (IN(11)) {
        __syncthreads();
        moe_router(args, (const bf16_t*)(ws + WS_X3), ctl, ws, gw, NGW, lane, lds, wave);
    }
    SEAM(11);

    if constexpr (HI > 12 && LO < 14) {
#pragma unroll 1
    for (int pass = args.pass_lo; pass < args.pass_hi; ++pass) {
        constexpr int pg = 12, pd = 13;
        LAS int* tab = (LAS int*)(lds + LDS_MISC + 256);
        if (IN(pg) || IN(pd)) {
            __syncthreads();
            if (tid == 0) { int acc = 0;
#pragma unroll 1
                for (int e = 0; e < 8; ++e) { const int c = (int)__hip_atomic_load(ctl + CW_CNT + 64 * e, __ATOMIC_RELAXED, __HIP_MEMORY_SCOPE_AGENT); tab[e] = acc; tab[16 + e] = c; acc += (c + 255) >> 8; } tab[8] = acc; }
            __syncthreads();
        }
        const int ntile = (IN(pg) || IN(pd)) ? __builtin_amdgcn_readfirstlane(tab[8]) : 0;
        const int tile0 = 128 * pass, nt_pass = min(128, ntile - tile0);
        if (IN(pg) && nt_pass > 0) {
            MoeGuSched S; S.o.init(nt_pass, 2 * FE / 256, G, bx); S.A = (const char*)(ws + WS_HA2); S.W = (const char*)(ws + WS_WMOE_GU); S.list = (const int*)(ws + WS_ROUTE2 + RT_LIST); S.tab = tab; S.tile0 = tile0;
            EpiSwigluF8 E{(unsigned char*)(ws + WS_MACT), FE, (const float*)(ws + WS_ROUTE2 + RT_LRSTD)};
            pg8::gemm_phase<EpiSwigluF8, MoeGuSched, true, true>(lds, D / 2, S, E, 0, wave);
#ifdef DUP_GU
            if (pass == 0) { xcd_barrier(bar); pg8::gemm_phase<EpiSwigluF8, MoeGuSched, true, true>(lds, D / 2, S, E, 0, wave); }
#endif
        }
        SEAM(pg);
        if (IN(pd) && nt_pass > 0 && pass == 2) {
            MoeDownTailSched S; S.o.init(nt_pass, 4 * TAIL_SPLIT, G, bx); S.A = (const char*)(ws + WS_MACT); S.W = (const char*)(ws + WS_WMOE_D); S.tab = tab; S.tile0 = tile0;
            EpiSlotPart E{(bf16_t*)(ws + WS_TAILP)};
            pg8::gemm_phase<EpiSlotPart, MoeDownTailSched, true, true>(lds, TAIL_K / 2, S, E, FE / 2, wave);
        } else if (IN(pd) && nt_pass > 0) {
            MoeDownSched S; S.o.init(nt_pass, D / 256, G, bx); S.A = (const char*)(ws + WS_MACT); S.W = (const char*)(ws + WS_WMOE_D); S.tab = tab; S.tile0 = tile0;
            EpiSlot E{(bf16_t*)(ws + WS_YSLOT)};
            pg8::gemm_phase<EpiSlot, MoeDownSched, true, true>(lds, FE / 2, S, E, 0, wave);
#ifdef DUP_DN
            if (pass == 0) { xcd_barrier(bar); pg8::gemm_phase<EpiSlot, MoeDownSched, true, true>(lds, FE / 2, S, E, 0, wave); }
#endif
        }
        if (IN(pd)) TS_IDLE(pd);
        if (IN(pd) && (pass + 1 < args.pass_hi || IN(14))) xcd_barrier(bar);
        TS_T0(); STAMP(); WS_FENCE();
    }
    }

    if (IN(14)) {
        LAS int* tab = (LAS int*)(lds + LDS_MISC + 256);
        __syncthreads();
        if (tid == 0) { int acc = 0;
#pragma unroll 1
            for (int e = 0; e < 8; ++e) { const int c = (int)__hip_atomic_load(ctl + CW_CNT + 64 * e, __ATOMIC_RELAXED, __HIP_MEMORY_SCOPE_AGENT); tab[e] = acc; acc += (c + 255) >> 8; } }
        __syncthreads();
        const int* toke = (const int*)(ws + WS_ROUTE2 + RT_TOKE); const int* tokr = (const int*)(ws + WS_ROUTE2 + RT_TOKR); const float* tokw = (const float*)(ws + WS_ROUTE2 + RT_TOKW);
        const bf16_t* Y = (const bf16_t*)(ws + WS_YSLOT); const bf16_t* X3 = (const bf16_t*)(ws + WS_X3); const bf16_t* TP = (const bf16_t*)(ws + WS_TAILP);
        int ms0 = 0, ms1 = 0; float mw0 = 0.f, mw1 = 0.f;
        { const int r = gw + NGW * lane; if (r < T) { const int e0 = toke[2 * r], e1 = toke[2 * r + 1]; mw0 = tokw[2 * r]; mw1 = tokw[2 * r + 1]; ms0 = tab[e0] * 256 + tokr[2 * r]; ms1 = tab[e1] * 256 + tokr[2 * r + 1]; } }
        const int nrow = (gw < T) ? (T - 1 - gw) / NGW + 1 : 0;
        f32x4 gn[4];
#pragma unroll
        for (int j = 0; j < 4; ++j) gn[j] = ((const f32x4*)(args.in[I_NORM_FINAL]) + lane)[64 * j];
        struct FinIn { u32x2 x[4], y0[4], y1[4]; };
#define FIN_LOAD(I_, i_) do { const int r_ = gw + NGW * (i_); const int s0_ = __builtin_amdgcn_readlane(ms0, (i_)), s1_ = __builtin_amdgcn_readlane(ms1, (i_)); \
            const u32x2* xr_ = (const u32x2*)(X3 + (size_t)r_ * D) + lane; \
            const u32x2* y0_ = (const u32x2*)((s0_ < 65536) ? Y + (size_t)s0_ * D : TP + (size_t)(s0_ - 65536) * D) + lane; \
            const u32x2* y1_ = (const u32x2*)((s1_ < 65536) ? Y + (size_t)s1_ * D : TP + (size_t)(s1_ - 65536) * D) + lane; \
            _Pragma("unroll") for (int j = 0; j < 4; ++j) { I_.x[j] = xr_[64 * j]; I_.y0[j] = y0_[64 * j]; I_.y1[j] = y1_[64 * j]; } } while (0)
#define FIN_ROW(I_, i_) do { const int r_ = gw + NGW * (i_); const int s0_ = __builtin_amdgcn_readlane(ms0, (i_)), s1_ = __builtin_amdgcn_readlane(ms1, (i_)); \
            const float w0_ = __builtin_bit_cast(float, __builtin_amdgcn_readlane(__builtin_bit_cast(int, mw0), (i_))), w1_ = __builtin_bit_cast(float, __builtin_amdgcn_readlane(__builtin_bit_cast(int, mw1), (i_))); \
            f32x4 v[4]; float s = 0.f; \
            _Pragma("unroll") for (int j = 0; j < 4; ++j) { const u32x2 a = I_.x[j], b0 = I_.y0[j], b1 = I_.y1[j]; \
                v[j] = (f32x4){bflo(a.x) + w0_ * bflo(b0.x) + w1_ * bflo(b1.x), bfhi(a.x) + w0_ * bfhi(b0.x) + w1_ * bfhi(b1.x), bflo(a.y) + w0_ * bflo(b0.y) + w1_ * bflo(b1.y), bfhi(a.y) + w0_ * bfhi(b0.y) + w1_ * bfhi(b1.y)}; } \
            _Pragma("unroll 1") for (int kk = 0; kk < 2; ++kk) { const int sl = kk ? s1_ : s0_; const float wk = kk ? w1_ : w0_; \
                if (sl >= 65536) { _Pragma("unroll 1") for (int sp = 1; sp < TAIL_SPLIT; ++sp) { const u32x2* yp = (const u32x2*)(TP + ((size_t)sp * 2048 + (sl - 65536)) * D) + lane; \
                    _Pragma("unroll") for (int j = 0; j < 4; ++j) { const u32x2 a = yp[64 * j]; v[j][0] += wk * bflo(a.x); v[j][1] += wk * bfhi(a.x); v[j][2] += wk * bflo(a.y); v[j][3] += wk * bfhi(a.y); } } } } \
            _Pragma("unroll") for (int j = 0; j < 4; ++j) s += (v[j][0] * v[j][0] + v[j][1] * v[j][1]) + (v[j][2] * v[j][2] + v[j][3] * v[j][3]); \
            const float rs = rstd_of(wave_sum_fast(s)); f32x4* o = (f32x4*)(X + (size_t)r_ * D) + lane; \
            _Pragma("unroll") for (int j = 0; j < 4; ++j) o[64 * j] = v[j] * rs * gn[j]; } while (0)
        FinIn Fa, Fb;
        if (nrow > 0) FIN_LOAD(Fa, 0);
#pragma unroll 1
        for (int i = 0; i < nrow; i += 2) {
            FIN_LOAD(Fb, (i + 1 < nrow) ? i + 1 : i);
            __builtin_amdgcn_sched_barrier(0);
            FIN_ROW(Fa, i);
            FIN_LOAD(Fa, (i + 2 < nrow) ? i + 2 : i);
            __builtin_amdgcn_sched_barrier(0);
            if (i + 1 < nrow) FIN_ROW(Fb, i + 1);
        }
#undef FIN_LOAD
#undef FIN_ROW
        TS_IDLE(14);
    }
#undef IN
#undef SEAM
#undef lane
#undef tid
#undef ws
}

#ifdef DBG_RWKV
__global__ void __launch_bounds__(NTHR, 2) dbg_naive(Args args) {
    extern __shared__ __attribute__((aligned(16))) unsigned char lds_raw[];
    LAS unsigned char* lds = (LAS unsigned char*)lds_raw; unsigned char* ws = args.ws;
    const int wave = __builtin_amdgcn_readfirstlane(threadIdx.x >> 6);
    rwkv_naive(args, lds, (const bf16_t*)(ws + WS_P1), (const bf16_t*)(ws + 432 * MiB), (const bf16_t*)(ws + 480 * MiB), (const bf16_t*)(ws + 128 * MiB), (const bf16_t*)(ws + 2 * MiB), (bf16_t*)(ws + WS_CAT), blockIdx.x, gridDim.x, wave, lane_now());
}
#endif

#ifndef N_LAUNCH_MODE
#define N_LAUNCH_MODE 1
#endif
extern "C" void kernel_launch(void* const* d_in, const int* in_sizes, int n_in, void* d_out, int out_size, void* d_ws, size_t ws_size, hipStream_t stream) {
    static int grid = 0;
    if (grid == 0) {
        if (n_in != N_IN || in_sizes[0] != T * D || out_size != T * D || ws_size < WS_NEED) {
            fprintf(stderr, "kernel_launch: unexpected shapes/workspace: n_in %d in0 %d out %d ws %zu (need %zu)\n", n_in, n_in > 0 ? in_sizes[0] : -1, out_size, ws_size, (size_t)WS_NEED); grid = -1; return; }
        int dev = 0, cus = 0;
        if (hipGetDevice(&dev) != hipSuccess || hipDeviceGetAttribute(&cus, hipDeviceAttributeMultiprocessorCount, dev) != hipSuccess) { grid = -1; return; }
        bool ok = true;
#define SETATTR(K) ok = ok && (hipFuncSetAttribute((const void*)K, hipFuncAttributeMaxDynamicSharedMemorySize, LDS_BYTES) == hipSuccess)
#if N_LAUNCH_MODE == 1
        SETATTR((fwd<0, N_PHASES>));
#else
        SETATTR((fwd<0, 1>)); SETATTR((fwd<1, 2>)); SETATTR((fwd<2, 3>)); SETATTR((fwd<3, 4>)); SETATTR((fwd<4, 5>)); SETATTR((fwd<5, 6>)); SETATTR((fwd<6, 7>)); SETATTR((fwd<7, 8>));
        SETATTR((fwd<8, 9>)); SETATTR((fwd<9, 10>)); SETATTR((fwd<10, 11>)); SETATTR((fwd<11, 12>)); SETATTR((fwd<12, 13>)); SETATTR((fwd<13, 14>)); SETATTR((fwd<14, 15>));
#endif
        if (!ok) { fprintf(stderr, "kernel_launch: hipFuncSetAttribute failed\n"); grid = -1; return; }
        (void)hipGetLastError();
        grid = cus;
    }
    if (grid < 0) return;
    if (hipMemsetAsync((char*)d_ws + WS_CTL, 0, CTL_BYTES, stream) != hipSuccess) return;
    Args a{};
    for (int i = 0; i < N_IN; ++i) a.in[i] = (const float*)d_in[i];
    a.out = (float*)d_out; a.ws = (unsigned char*)d_ws;
#if N_LAUNCH_MODE == 1
    a.ph_lo = 0; a.ph_hi = N_PHASES; a.pass_lo = 0; a.pass_hi = 3;
    hipLaunchKernelGGL((fwd<0, N_PHASES>), dim3(grid), dim3(NTHR), LDS_BYTES, stream, a);
#else
#define LAUNCH1(P) do { a.ph_lo = (P); a.ph_hi = (P) + 1; hipLaunchKernelGGL((fwd<(P), (P) + 1>), dim3(grid), dim3(NTHR), LDS_BYTES, stream, a); } while (0)
    LAUNCH1(0); LAUNCH1(1); LAUNCH1(2); LAUNCH1(3); LAUNCH1(4); LAUNCH1(5); LAUNCH1(6); LAUNCH1(7);
#ifdef DBG_RWKV
    hipLaunchKernelGGL(dbg_naive, dim3(grid), dim3(NTHR), 4096, stream, a); LAUNCH1(8);
#else
    LAUNCH1(8);
#endif
    LAUNCH1(9); LAUNCH1(10); LAUNCH1(11);
    for (int pass = 0; pass < 5; ++pass) { a.pass_lo = pass; a.pass_hi = pass + 1; LAUNCH1(12); LAUNCH1(13); }
    LAUNCH1(14);
#endif
}
```
